# Optimizing an MI355X kernel written in HIP

```python
import jax, jax.numpy as jnp
from jax import lax
import numpy as np

D_MODEL = 1024
BATCH = 1
SEQ = 16384
DEPTH = 2

CHUNK = 64
N_EVEN = (DEPTH + 1) // 2
N_ODD = DEPTH // 2
HG_HEADS = 4
HG_DK = 128
HG_DV = 128
RET_HEADS = 4
RET_DK = 128
RET_DV = 128
HG_WIDTH = HG_HEADS * HG_DK
RET_WIDTH = RET_HEADS * RET_DK
MIX_WIDTH = HG_HEADS * HG_DV + RET_HEADS * RET_DV
IN_WIDTH = 4 * HG_WIDTH + 4 * RET_WIDTH
RET_GAMMA_EXP0 = 5.0
ROPE_BASE = 10000.0
POOL_WINDOWS = (2, 4, 8, 16)
N_POOL = 4
POOL_GROUP = D_MODEL // N_POOL
N_EXPERTS = 32
TOP_K = 4
D_EXPERT = D_MODEL
SWIGLU_LIMIT = 7.0
SWIGLU_ALPHA = 1.702
MOE_BLOCK = 256
EPS = 1e-6

kernel_name = "hybrid_hgrn2_retention_pool_moe_adaln"


def rmsnorm(x):
    xf = x.astype(jnp.float32)
    return (xf * lax.rsqrt(jnp.mean(xf * xf, axis=-1, keepdims=True) + EPS)).astype(x.dtype)


def head_rmsnorm(o, gain):
    o = o * lax.rsqrt(jnp.mean(o * o, axis=-1, keepdims=True) + EPS)
    return o * gain.astype(jnp.float32)[None, :, None, None, :]


def to_chunks(a, heads):
    B, S, W = a.shape
    return a.reshape(B, S // CHUNK, CHUNK, heads, W // heads).transpose(0, 3, 1, 2, 4)


def from_chunks(a):
    B, H, N, C, d = a.shape
    return a.transpose(0, 2, 3, 1, 4).reshape(B, N * C, H * d)


def rotary(x):
    S, d = x.shape[1], x.shape[-1]
    half = d // 2
    inv = ROPE_BASE ** (-jnp.arange(half, dtype=jnp.float32) / half)
    ang = jnp.arange(S, dtype=jnp.float32)[:, None] * inv[None, :]
    cos = jnp.cos(ang)[None, :, None, :]
    sin = jnp.sin(ang)[None, :, None, :]
    x1, x2 = x[..., :half], x[..., half:]
    return jnp.concatenate([x1 * cos - x2 * sin, x1 * sin + x2 * cos], axis=-1)


def hgrn2_chunked(q, k, v, g):
    B, H, N, C, dk = q.shape
    dv = v.shape[-1]
    mask = jnp.tril(jnp.ones((C, C), dtype=bool))[:, :, None]

    def step(S, inp):
        qc, kc, vc, gc = inp
        b = jnp.cumsum(gc, axis=2)
        o_inter = jnp.einsum('bhtd,bhde->bhte', qc * jnp.exp(b), S)
        diff = b[:, :, :, None, :] - b[:, :, None, :, :]
        decay = jnp.where(mask, jnp.exp(jnp.where(mask, diff, 0.0)), 0.0)
        attn = jnp.einsum('bhtd,bhsd,bhtsd->bhts', qc, kc, decay)
        o_intra = jnp.einsum('bhts,bhse->bhte', attn, vc)
        b_last = b[:, :, -1:, :]
        S_new = jnp.exp(b_last[:, :, 0, :])[..., None] * S + jnp.einsum(
            'bhsd,bhse->bhde', kc * jnp.exp(b_last - b), vc)
        return S_new, o_inter + o_intra

    xs = tuple(jnp.moveaxis(a, 2, 0) for a in (q, k, v, g))
    S0 = jnp.zeros((B, H, dk, dv), jnp.float32)
    _, o = lax.scan(step, S0, xs)
    return jnp.moveaxis(o, 0, 2)


def retention_chunked(q, k, v):
    B, H, N, C, dk = q.shape
    dv = v.shape[-1]
    lg = jnp.log(1.0 - 2.0 ** (-RET_GAMMA_EXP0 - jnp.arange(H, dtype=jnp.float32)))
    idx = jnp.arange(C, dtype=jnp.float32)
    rel = idx[:, None] - idx[None, :]
    causal = rel >= 0
    dmat = jnp.where(causal, jnp.exp(jnp.where(causal, rel, 0.0)[None] * lg[:, None, None]), 0.0)
    scores = jnp.einsum('bhnqd,bhnkd->bhnqk', q, k) * dmat[None, :, None]
    o_intra = jnp.einsum('bhnqk,bhnke->bhnqe', scores, v)
    k_dec = k * jnp.exp((C - 1 - idx)[None, :] * lg[:, None])[None, :, None, :, None]
    kv = jnp.einsum('bhnsd,bhnse->nbhde', k_dec, v)
    chunk_decay = jnp.exp(C * lg)[None, :, None, None]

    def step(R, kv_n):
        return chunk_decay * R + kv_n, R

    _, R_prev = lax.scan(step, jnp.zeros((B, H, dk, dv), jnp.float32), kv)
    q_dec = q * jnp.exp((idx + 1.0)[None, :] * lg[:, None])[None, :, None, :, None]
    o_inter = jnp.einsum('bhnqd,nbhde->bhnqe', q_dec, R_prev)
    return o_intra + o_inter


def hgrn2_retention_mixer(h, w_in, lower_bound, hg_gain, ret_gain, w_out):
    B, S, _ = h.shape
    proj = (h @ w_in).astype(jnp.float32)
    sizes = [HG_WIDTH] * 4 + [RET_WIDTH] * 4
    split_at = np.cumsum(sizes)[:-1].tolist()
    hq, hf, hi, hog, rq, rk, rv, rg = jnp.split(proj, split_at, axis=-1)
    lb = lower_bound.astype(jnp.float32)
    fgate = lb + (1.0 - lb) * jax.nn.sigmoid(hf)
    o_hg = hgrn2_chunked(to_chunks(jax.nn.silu(hq), HG_HEADS),
                         to_chunks(1.0 - fgate, HG_HEADS),
                         to_chunks(hi, HG_HEADS),
                         to_chunks(jnp.log(fgate), HG_HEADS))
    o_hg = from_chunks(head_rmsnorm(o_hg, hg_gain)) * jax.nn.silu(hog)
    q = rotary(rq.reshape(B, S, RET_HEADS, RET_DK)).reshape(B, S, RET_WIDTH)
    k = (rotary(rk.reshape(B, S, RET_HEADS, RET_DK)) * RET_DK ** -0.5).reshape(B, S, RET_WIDTH)
    o_ret = retention_chunked(to_chunks(q, RET_HEADS), to_chunks(k, RET_HEADS),
                              to_chunks(rv, RET_HEADS))
    o_ret = from_chunks(head_rmsnorm(o_ret, ret_gain)) * jax.nn.silu(rg)
    cat = jnp.concatenate([o_hg, o_ret], axis=-1).astype(h.dtype)
    return cat @ w_out


def pool_mixer(h, pool_w, pool_b, pool_scale):
    B, S, D = h.shape
    hf = h.astype(jnp.float32).reshape(B, S, N_POOL, POOL_GROUP)
    csp = jnp.concatenate([jnp.zeros((B, 1, N_POOL, POOL_GROUP), jnp.float32),
                           jnp.cumsum(hf, axis=1)], axis=1)
    t = jnp.arange(S)
    outs = []
    for gi, w in enumerate(POOL_WINDOWS):
        cg = csp[:, :, gi]
        lo = jnp.maximum(t + 1 - w, 0)
        win_sum = cg[:, 1:] - cg[:, lo]
        cnt = jnp.minimum(t + 1, w).astype(jnp.float32)
        outs.append(win_sum / cnt[None, :, None] - hf[:, :, gi])
    p = jnp.stack(outs, axis=2).astype(h.dtype)
    y = jnp.einsum('bsgc,gcd->bsgd', p, pool_w) + pool_b
    return (y.reshape(B, S, D) * pool_scale).astype(h.dtype)


def moe_ffn(h, w_router, b_router, w_gu, b_gu, w_down, b_down):
    B, S, D = h.shape
    T = B * S
    hf = h.reshape(T, D)
    logits = (hf @ w_router + b_router).astype(jnp.float32)
    top_val, top_idx = lax.top_k(logits, TOP_K)
    gates = jax.nn.softmax(top_val, axis=-1)
    flat_e = top_idx.reshape(-1).astype(jnp.int32)
    flat_tok = jnp.arange(T * TOP_K, dtype=jnp.int32) // TOP_K
    flat_w = gates.reshape(-1)
    order = jnp.argsort(flat_e)
    sorted_e = flat_e[order]
    counts = jnp.bincount(flat_e, length=N_EXPERTS).astype(jnp.int32)
    padded = (counts + MOE_BLOCK - 1) // MOE_BLOCK * MOE_BLOCK
    pad_end = jnp.cumsum(padded)
    pad_start = pad_end - padded
    grp_start = jnp.cumsum(counts) - counts
    pos = jnp.arange(T * TOP_K, dtype=jnp.int32)
    dest = pad_start[sorted_e] + pos - grp_start[sorted_e]
    n_rows = T * TOP_K + N_EXPERTS * MOE_BLOCK
    n_blocks = n_rows // MOE_BLOCK
    row_tok = jnp.zeros((n_rows,), jnp.int32).at[dest].set(flat_tok[order])
    row_w = jnp.zeros((n_rows,), jnp.float32).at[dest].set(flat_w[order])
    blk_start = jnp.arange(n_blocks, dtype=jnp.int32) * MOE_BLOCK
    blk_e = jnp.minimum(jnp.searchsorted(pad_end, blk_start, side='right'), N_EXPERTS - 1)
    xs = hf[row_tok].reshape(n_blocks, MOE_BLOCK, D)

    def expert_block(args):
        xb, e = args
        gu = xb @ w_gu[e] + b_gu[e]
        x_glu = jnp.minimum(gu[:, :D_EXPERT], SWIGLU_LIMIT)
        x_lin = jnp.clip(gu[:, D_EXPERT:], -SWIGLU_LIMIT, SWIGLU_LIMIT)
        act = x_glu * jax.nn.sigmoid(SWIGLU_ALPHA * x_glu) * (x_lin + 1.0)
        return act @ w_down[e] + b_down[e]

    ys = lax.map(expert_block, (xs, blk_e)).reshape(n_rows, D)
    out = jax.ops.segment_sum(ys * row_w[:, None], row_tok, num_segments=T)
    return out.reshape(B, S, D).astype(h.dtype)


def setup_inputs(seed: int = 0) -> dict:
    key = jax.random.key(seed)
    ks = jax.random.split(key, 19)

    def nrm(k, shape, scale):
        return jax.random.normal(k, shape, jnp.float32) * scale

    return {
        "x": nrm(ks[0], (BATCH, SEQ, D_MODEL), 1.0),
        "c": nrm(ks[1], (BATCH, D_MODEL), 1.0),
        "w_ada": nrm(ks[2], (DEPTH, D_MODEL, 6 * D_MODEL), 0.5 * D_MODEL ** -0.5),
        "b_ada": nrm(ks[3], (DEPTH, 6 * D_MODEL), 0.02),
        "w_in": nrm(ks[4], (N_EVEN, D_MODEL, IN_WIDTH), D_MODEL ** -0.5),
        "hg_lower_bounds": nrm(ks[5], (N_EVEN + 1, HG_WIDTH), 0.5),
        "hg_norm": 1.0 + nrm(ks[6], (N_EVEN, HG_HEADS, HG_DV), 0.02),
        "ret_norm": 1.0 + nrm(ks[7], (N_EVEN, RET_HEADS, RET_DV), 0.02),
        "w_out": nrm(ks[8], (N_EVEN, MIX_WIDTH, D_MODEL), MIX_WIDTH ** -0.5),
        "pool_w": nrm(ks[9], (N_ODD, N_POOL, POOL_GROUP, POOL_GROUP), POOL_GROUP ** -0.5),
        "pool_b": nrm(ks[10], (N_ODD, N_POOL, POOL_GROUP), 0.02),
        "pool_scale": 1.0 + nrm(ks[11], (N_ODD, D_MODEL), 0.1),
        "w_router": nrm(ks[12], (DEPTH, D_MODEL, N_EXPERTS), D_MODEL ** -0.5),
        "b_router": nrm(ks[13], (DEPTH, N_EXPERTS), 0.01),
        "w_gu": nrm(ks[14], (DEPTH, N_EXPERTS, D_MODEL, 2 * D_EXPERT), D_MODEL ** -0.5),
        "b_gu": nrm(ks[15], (DEPTH, N_EXPERTS, 2 * D_EXPERT), 0.02),
        "w_down": nrm(ks[16], (DEPTH, N_EXPERTS, D_EXPERT, D_MODEL), D_EXPERT ** -0.5),
        "b_down": nrm(ks[17], (DEPTH, N_EXPERTS, D_MODEL), 0.02),
        "final_norm": 1.0 + nrm(ks[18], (D_MODEL,), 0.02),
    }


def reference(x, c, w_ada, b_ada, w_in, hg_lower_bounds, hg_norm, ret_norm, w_out,
              pool_w, pool_b, pool_scale, w_router, b_router, w_gu, b_gu, w_down,
              b_down, final_norm):
    cond = jax.nn.silu(c.astype(jnp.float32)).astype(x.dtype)
    lb_all = jnp.cumsum(jax.nn.softmax(hg_lower_bounds.astype(jnp.float32), axis=0), axis=0)
    for layer in range(DEPTH):
        mod = (cond @ w_ada[layer] + b_ada[layer])[:, None, :]
        sh_m, sc_m, g_m, sh_f, sc_f, g_f = jnp.split(mod, 6, axis=-1)
        hn = rmsnorm(x) * (1.0 + sc_m) + sh_m
        j = layer // 2
        if layer % 2 == 0:
            mix = hgrn2_retention_mixer(hn, w_in[j], lb_all[j], hg_norm[j], ret_norm[j], w_out[j])
        else:
            mix = pool_mixer(hn, pool_w[j], pool_b[j], pool_scale[j])
        x = x + g_m * mix
        hn = rmsnorm(x) * (1.0 + sc_f) + sh_f
        x = x + g_f * moe_ffn(hn, w_router[layer], b_router[layer], w_gu[layer],
                              b_gu[layer], w_down[layer], b_down[layer])
    return rmsnorm(x) * final_norm
```

```cpp
#include <hip/hip_runtime.h>
#include <cstdio>
#include <cstdint>

#ifndef N_LAUNCH_MODE
#define N_LAUNCH_MODE 0
#endif
#ifndef SIMPLE_GEMM
#define SIMPLE_GEMM 1
#endif

#define LAS __attribute__((address_space(3)))
#define GAS __attribute__((address_space(1)))
typedef unsigned short bf16_t;
typedef short bf16x8 __attribute__((ext_vector_type(8)));
typedef float f32x4 __attribute__((ext_vector_type(4)));
typedef float f32x2 __attribute__((ext_vector_type(2)));
typedef unsigned u32x4 __attribute__((ext_vector_type(4)));
typedef unsigned u32x2 __attribute__((ext_vector_type(2)));

constexpr int T = 16384, D = 1024, NE = 32, TOPK = 4, DEPTH = 2;
constexpr int INW = 4096;
constexpr int NTH = 512, NWAVES = 8;
constexpr float EPS = 1e-6f;
constexpr float SW_LIMIT = 7.0f, SW_ALPHA = 1.702f;
constexpr int LIST_CAP = T;
constexpr int ACT_ROWS = T * TOPK + NE * 256;

constexpr size_t MiB = 1u << 20;
constexpr size_t WS_CTL = 0, CTL_BYTES = 1 * MiB;
constexpr size_t WS_MOD = 1 * MiB;
constexpr size_t WS_LB = WS_MOD + 65536;
constexpr size_t WS_ROPE = 2 * MiB;
constexpr size_t WS_WINT = 10 * MiB;
constexpr size_t WS_WOUTT = 18 * MiB;
constexpr size_t WS_POOLT = 20 * MiB;
constexpr size_t WS_LSLOT = 22 * MiB;
constexpr size_t WS_LW = 26 * MiB;
constexpr size_t WS_RSTD = 30 * MiB;
constexpr size_t WS_WGUT = 32 * MiB;
constexpr size_t WS_WDNT = 288 * MiB;
constexpr size_t WS_HN = 416 * MiB;
constexpr size_t WS_QKVG = 448 * MiB;
constexpr size_t WS_GBUF = 576 * MiB;
constexpr size_t WS_KVT = 608 * MiB;
constexpr size_t WS_SPREV = 736 * MiB;
constexpr size_t WS_DEC = 800 * MiB;
constexpr size_t WS_CAT = 802 * MiB;
constexpr size_t WS_X1 = 834 * MiB;
constexpr size_t WS_X2 = 898 * MiB;
constexpr size_t WS_ACT = 962 * MiB;
constexpr size_t WS_YSLOT = 1106 * MiB;
constexpr size_t WS_END = 1234 * MiB;
constexpr int CW_CNT = 64;
constexpr int CW_BAR = 4096;

constexpr int SCR_BYTES = 136 * 1024;
constexpr int MISC_OFF = SCR_BYTES;
constexpr int LDS_BYTES = SCR_BYTES + 4096;

__device__ __forceinline__ unsigned cvt_pk_bf16(float lo, float hi) { unsigned r; asm volatile("v_cvt_pk_bf16_f32 %0, %1, %2" : "=v"(r) : "v"(lo), "v"(hi)); return r; }
__device__ __forceinline__ float bf2f(unsigned short b) { return __builtin_bit_cast(float, (unsigned)b << 16); }
__device__ __forceinline__ float bflo(unsigned w) { return __builtin_bit_cast(float, w << 16); }
__device__ __forceinline__ float bfhi(unsigned w) { return __builtin_bit_cast(float, w & 0xffff0000u); }
__device__ __forceinline__ float wave_sum(float v) {
#pragma unroll
    for (int o = 1; o < 64; o <<= 1) v += __shfl_xor(v, o);
    return v;
}
__device__ __forceinline__ float wave_max(float v) {
#pragma unroll
    for (int o = 1; o < 64; o <<= 1) v = fmaxf(v, __shfl_xor(v, o));
    return v;
}
__device__ __forceinline__ float sigmoidf_(float x) { return 1.0f / (1.0f + __expf(-x)); }
__device__ __forceinline__ float siluf_(float x) { return x * sigmoidf_(x); }

#define XB_TMO      128
#define XB_XCNT(j)  (256  + 64 * (j))
#define XB_XSUB(j)  (1280 + 64 * (j))
#define XB_XGEN(j)  (2304 + 64 * (j))
#define XB_TOP      3328
#define XB_TOPGEN   3392
#define XCD_BAR_WORDS 3456
#define XB_SPIN_CAP (1u << 20)
__device__ __forceinline__ unsigned xb_ld(unsigned* p)              { return __hip_atomic_load(p, __ATOMIC_RELAXED, __HIP_MEMORY_SCOPE_AGENT); }
__device__ __forceinline__ unsigned xb_add(unsigned* p, unsigned v) { return __hip_atomic_fetch_add(p, v, __ATOMIC_RELAXED, __HIP_MEMORY_SCOPE_AGENT); }
__device__ __forceinline__ unsigned xb_xcc_id() { return (unsigned)__builtin_amdgcn_s_getreg((3 << 11) | 20) & 0xFu; }
#define XB_SPIN(cond, bar) do { unsigned _sp = 0; while (cond) { __builtin_amdgcn_s_sleep(1); \
    if ((++_sp & 255u) == 0u) { if (xb_ld(&(bar)[XB_TMO])) break; if (_sp > XB_SPIN_CAP) { atomicAdd(&(bar)[XB_TMO], 1u); break; } } } } while (0)
struct XcdBarrier { unsigned* bar; unsigned x; volatile LAS unsigned* st; };
__device__ __forceinline__ XcdBarrier xcd_barrier_post(unsigned* bar, volatile LAS unsigned* st) {
    XcdBarrier b; b.bar = bar; b.x = xb_xcc_id(); b.st = st;
    if (threadIdx.x == 0) (void)xb_add(&bar[XB_XCNT(b.x)], 1u);
    return b;
}
__device__ __forceinline__ void xcd_barrier_complete(unsigned* bar, unsigned x, unsigned& nloc, unsigned& nx) {
    const unsigned G = gridDim.x * gridDim.y * gridDim.z;
    unsigned sum, cnt, mine, sp = 0u;
    for (;;) {
        sum = 0u; cnt = 0u; mine = 0u;
#pragma unroll
        for (unsigned j = 0; j < 16; ++j) { const unsigned c = xb_ld(&bar[XB_XCNT(j)]); sum += c; cnt += (c > 0u) ? 1u : 0u; mine = (j == x) ? c : mine; }
        if (sum == G) break;
        __builtin_amdgcn_s_sleep(1);
        if ((++sp & 255u) == 0u) { if (xb_ld(&bar[XB_TMO])) break; if (sp > XB_SPIN_CAP) { atomicAdd(&bar[XB_TMO], 1u); break; } }
    }
    nloc = mine > 0u ? mine : 1u; nx = cnt > 0u ? cnt : 1u;
}
__device__ __forceinline__ void xcd_barrier(const XcdBarrier& b) {
    asm volatile("s_waitcnt vmcnt(0)" ::: "memory");
    __syncthreads();
    if (threadIdx.x == 0) {
        unsigned* bar = b.bar;
        __builtin_amdgcn_s_waitcnt(0);
        unsigned nloc = b.st[0], nx = b.st[1];
        if (nloc == 0u) { xcd_barrier_complete(bar, b.x, nloc, nx); b.st[0] = nloc; b.st[1] = nx; }
        const unsigned old = xb_add(&bar[XB_XSUB(b.x)], 1u);
        const unsigned gen = old / nloc;
        if (old + 1u == (gen + 1u) * nloc) {
            __builtin_amdgcn_fence(__ATOMIC_RELEASE, "agent");
            asm volatile("s_waitcnt vmcnt(0)" ::: "memory");
            const unsigned og = xb_add(&bar[XB_TOP], 1u);
            const unsigned tg = og / nx;
            if (og + 1u == (tg + 1u) * nx) xb_add(&bar[XB_TOPGEN], 1u);
            else XB_SPIN(xb_ld(&bar[XB_TOPGEN]) == tg, bar);
            __builtin_amdgcn_fence(__ATOMIC_ACQUIRE, "agent");
            xb_add(&bar[XB_XGEN(b.x)], 1u);
            asm volatile("s_waitcnt vmcnt(0)" ::: "memory");
        } else {
            XB_SPIN(xb_ld(&bar[XB_XGEN(b.x)]) == gen, bar);
            __builtin_amdgcn_fence(__ATOMIC_ACQUIRE, "agent");
            asm volatile("s_waitcnt vmcnt(0)" ::: "memory");
        }
    }
    __syncthreads();
}

struct Args {
    const float* in[19];
    float* out;
    unsigned char* ws;
    int ph_lo, ph_hi;
};

namespace pg8 {
constexpr int BM = 256, BK = 64, HALF = 128, HTB = HALF * BK * 2;
__host__ __device__ __forceinline__ int lds_byte(int r, int c) { const int st = (r >> 4) * 2 + (c >> 5), rr = r & 15, cc = c & 31, ob = rr * 64 + cc * 2; return st * 1024 + (ob ^ (((ob >> 9) & 1) << 5)); }
__host__ __device__ __forceinline__ void stage_rc(int b, int& R, int& C) { const int st = b / 1024, sb = b % 1024, swz = sb ^ (((sb >> 9) & 1) << 5); R = (st >> 1) * 16 + swz / 64; C = (st & 1) * 32 + (swz % 64) / 2; }
__host__ __device__ __forceinline__ int perm32(int rho) { const int n = rho >> 4, i = rho & 15; return 8 * (i >> 2) + 4 * n + (i & 3); }

struct Unit { const char* A; const char* B; int p0, p1, p2, p3; };

#define PG8_SA(b, h) (((b) * 2 + (h)) * HTB)
#define PG8_SB(b, h) ((4 + (b) * 2 + (h)) * HTB)
#define PG8_LDA(dst, b, h) do { _Pragma("unroll") for (int m = 0; m < 4; ++m) _Pragma("unroll") for (int k = 0; k < 2; ++k) dst[m][k] = *(const LAS bf16x8*)(lds + PG8_SA(b, h) + aoff + m * 2048 + k * 1024); } while (0)
#define PG8_LDB(dst, b, h) do { _Pragma("unroll") for (int n = 0; n < 2; ++n) _Pragma("unroll") for (int k = 0; k < 2; ++k) dst[n][k] = *(const LAS bf16x8*)(lds + PG8_SB(b, h) + boff + n * 2048 + k * 1024); } while (0)
#define PG8_MMA(ai, bj, At, Bt) do { __builtin_amdgcn_s_setprio(1); _Pragma("unroll") for (int m = 0; m < 4; ++m) _Pragma("unroll") for (int n = 0; n < 2; ++n) _Pragma("unroll") for (int k = 0; k < 2; ++k) \
        acc[ai][bj][m][n] = __builtin_amdgcn_mfma_f32_16x16x32_bf16(Bt[n][k], At[m][k], acc[ai][bj][m][n], 0, 0, 0); __builtin_amdgcn_s_setprio(0); } while (0)

template <class P>
__device__ __forceinline__ void gemm_simple(LAS unsigned char* lds, const P& S) {
    const int tid = threadIdx.x, wid = __builtin_amdgcn_readfirstlane(tid >> 6), lane = tid & 63, wr = wid >> 2, wc = wid & 3, fr = lane & 15, fq = lane >> 4;
    const int nt = S.nt();
    int R0, C0; stage_rc(tid * 16, R0, C0);
    unsigned offB[2];
#pragma unroll
    for (int i = 0; i < 2; ++i) { const int R = R0 + 64 * i; const int Rb = (R & ~31) + perm32(R & 31); offB[i] = (unsigned)Rb * S.ldb_bytes() + (unsigned)C0 * 2u; }
    const unsigned bhalf = 128u * S.ldb_bytes();
    const int aoff = lds_byte(wr * 64 + fr, fq * 8), boff = lds_byte(wc * 32 + fr, fq * 8);
    Unit u;
    for (int ui = 0; S.next(ui, u); ++ui) {
        unsigned offA[4]; S.aoff(u, R0, C0, offA);
        f32x4 acc[2][2][4][2];
#pragma unroll
        for (int a = 0; a < 2; ++a)
#pragma unroll
            for (int b = 0; b < 2; ++b)
#pragma unroll
                for (int m = 0; m < 4; ++m)
#pragma unroll
                    for (int n = 0; n < 2; ++n) acc[a][b][m][n] = (f32x4){0.f, 0.f, 0.f, 0.f};
        for (int t = 0; t < nt; ++t) {
            u32x4 ra[4], rb[4];
#pragma unroll
            for (int h = 0; h < 2; ++h)
#pragma unroll
                for (int i = 0; i < 2; ++i) {
                    ra[2 * h + i] = *(const u32x4*)(u.A + offA[2 * h + i] + (size_t)t * 128);
                    rb[2 * h + i] = *(const u32x4*)(u.B + (size_t)h * bhalf + offB[i] + (size_t)t * 128);
                }
            __syncthreads();
#pragma unroll
            for (int h = 0; h < 2; ++h)
#pragma unroll
                for (int i = 0; i < 2; ++i) {
                    *(LAS u32x4*)(lds + PG8_SA(0, h) + tid * 16 + i * 8192) = ra[2 * h + i];
                    *(LAS u32x4*)(lds + PG8_SB(0, h) + tid * 16 + i * 8192) = rb[2 * h + i];
                }
            __syncthreads();
            bf16x8 At[4][2], Bt[2][2];
#pragma unroll
            for (int ai = 0; ai < 2; ++ai) {
                PG8_LDA(At, 0, ai);
#pragma unroll
                for (int bj = 0; bj < 2; ++bj) { PG8_LDB(Bt, 0, bj); PG8_MMA(ai, bj, At, Bt); }
            }
        }
        S.epi(acc, u, wr, wc, fr, fq);
    }
    __syncthreads();
}
}

struct Frame {
    LAS unsigned char* lds;
    volatile LAS unsigned* MISC;
    unsigned* ctl;
    int tid, lane, wave, vcu, G;
    unsigned char* ws;
    const float* in[19];
    float* out;
};
#define WSP(F, off, type) ((type*)((F).ws + (off)))

template <class RowMap>
__device__ __forceinline__ void transpose_item(const float* W, int K, int N, bf16_t* WT, LAS float* scr, int item, int lane, const RowMap& rm) {
    const int nblk = N / 32, kb = item / nblk, nb = item % nblk, k0 = 64 * kb, n0 = 32 * nb;
#pragma unroll 8
    for (int i = 0; i < 32; ++i) { const int kk = 2 * i + (lane >> 5); scr[kk * 33 + (lane & 31)] = W[(size_t)(k0 + kk) * N + n0 + (lane & 31)]; }
    asm volatile("s_waitcnt lgkmcnt(0)" ::: "memory");
    const int c = lane & 7;
#pragma unroll
    for (int j = 0; j < 4; ++j) { const int n = (lane >> 3) + 8 * j; const LAS float* s = scr + (8 * c) * 33 + n;
        u32x4 o; o.x = cvt_pk_bf16(s[0 * 33], s[1 * 33]); o.y = cvt_pk_bf16(s[2 * 33], s[3 * 33]); o.z = cvt_pk_bf16(s[4 * 33], s[5 * 33]); o.w = cvt_pk_bf16(s[6 * 33], s[7 * 33]);
        *(u32x4*)(WT + (size_t)rm(n0 + n) * K + k0 + 8 * c) = o; }
    asm volatile("s_waitcnt lgkmcnt(0)" ::: "memory");
}
struct RmId { __device__ __forceinline__ int operator()(int n) const { return n; } };
struct RmWin { __device__ __forceinline__ int operator()(int n) const {
        const int s = n >> 9; if (s != 4 && s != 5) return n;
        const int d = n & 127, dd = d & 63; const int p = 8 * (dd >> 2) + (dd & 3) + ((d >> 6) << 2); return n - d + p; } };
struct RmGu { __device__ __forceinline__ int operator()(int n) const { const int half = n >> 10, j = (n & 1023) >> 7, i = n & 127; return 256 * j + 128 * half + i; } };

__device__ __forceinline__ void p0_prologue(Frame& F) {
    const int tid = F.tid;
    {
        LAS float* red = (LAS float*)F.lds;
        const float* c = F.in[1];
        for (int u = F.vcu; u < 192; u += F.G) {
            const int l = u / 96, cg = u % 96, kq = tid >> 4, cq = tid & 15;
            const float* W = F.in[2] + (size_t)l * D * 6 * D + cg * 64 + cq * 4;
            f32x4 a = {0.f, 0.f, 0.f, 0.f};
#pragma unroll 8
            for (int j = 0; j < 32; ++j) { const int k = kq + 32 * j; const float cv = siluf_(c[k]); const f32x4 w = *(const f32x4*)(W + (size_t)k * 6 * D); a += w * cv; }
            __syncthreads();
            *(LAS f32x4*)(red + kq * 64 + cq * 4) = a;
            __syncthreads();
            if (tid < 64) { float s = 0.f;
#pragma unroll 8
                for (int k = 0; k < 32; ++k) s += red[k * 64 + tid];
                const int col = cg * 64 + tid;
                WSP(F, WS_MOD, float)[l * 6 * D + col] = s + F.in[3][l * 6 * D + col]; }
        }
        __syncthreads();
    }
    if (F.vcu == 0) { const float* hb = F.in[5]; const float a = hb[tid], b = hb[512 + tid]; WSP(F, WS_LB, float)[tid] = 1.0f / (1.0f + __expf(b - a)); }
    {
        f32x2* rope = WSP(F, WS_ROPE, f32x2);
        for (int idx = F.vcu * NTH + tid; idx < T * 64; idx += F.G * NTH) {
            const int t = idx >> 6, d = idx & 63;
            const float inv = exp2f(-(float)d * (13.287712379549449f / 64.0f));
            const float ang = (float)t * inv;
            const double a = (double)ang; const double n = __builtin_rint(a * 0.15915494309189535); const double r = __builtin_fma(-n, 6.283185307179586, a);
            const float rf = (float)r;
            rope[idx] = (f32x2){__cosf(rf), __sinf(rf)};
        }
    }
    {
        LAS float* scr = (LAS float*)(F.lds + F.wave * 16384);
        const int gw = F.vcu * NWAVES + F.wave, NGW = F.G * NWAVES;
        constexpr int I_IN = 16 * 128, I_OUT = 16 * 32, I_POOL = 4 * 4 * 8, I_GU = 64 * 16 * 64, I_DN = 64 * 16 * 32;
        constexpr int NITEMS = I_IN + I_OUT + I_POOL + I_GU + I_DN;
        for (int it = gw; it < NITEMS; it += NGW) {
            int r = it;
            if (r < I_IN) { transpose_item(F.in[4], D, INW, WSP(F, WS_WINT, bf16_t), scr, r, F.lane, RmWin()); continue; } r -= I_IN;
            if (r < I_OUT) { transpose_item(F.in[8], D, D, WSP(F, WS_WOUTT, bf16_t), scr, r, F.lane, RmId()); continue; } r -= I_OUT;
            if (r < I_POOL) { const int g = r / 32; transpose_item(F.in[9] + (size_t)g * 65536, 256, 256, WSP(F, WS_POOLT, bf16_t) + (size_t)g * 65536, scr, r % 32, F.lane, RmId()); continue; } r -= I_POOL;
            if (r < I_GU) { const int m = r / 1024; transpose_item(F.in[14] + (size_t)m * D * 2048, D, 2048, WSP(F, WS_WGUT, bf16_t) + (size_t)m * 2048 * D, scr, r % 1024, F.lane, RmGu()); continue; } r -= I_GU;
            { const int m = r / 512; transpose_item(F.in[16] + (size_t)m * D * D, D, D, WSP(F, WS_WDNT, bf16_t) + (size_t)m * D * D, scr, r % 512, F.lane, RmId()); }
        }
    }
}

__device__ __forceinline__ void p1_norm_in(Frame& F) {
    const float* mod = WSP(F, WS_MOD, float);
    f32x4 sh[4], sc[4];
#pragma unroll
    for (int j = 0; j < 4; ++j) { sh[j] = *(const f32x4*)(mod + 0 * D + 4 * F.lane + 256 * j); sc[j] = *(const f32x4*)(mod + 1 * D + 4 * F.lane + 256 * j) + 1.0f; }
    const int gw = F.vcu * NWAVES + F.wave, NGW = F.G * NWAVES;
    for (int row = gw; row < T; row += NGW) {
        const f32x4* xr = (const f32x4*)(F.in[0] + (size_t)row * D) + F.lane;
        f32x4 v[4]; float s = 0.f;
#pragma unroll
        for (int j = 0; j < 4; ++j) { v[j] = xr[64 * j]; s += (v[j].x * v[j].x + v[j].y * v[j].y) + (v[j].z * v[j].z + v[j].w * v[j].w); }
        const float rstd = rsqrtf(wave_sum(s) * (1.f / D) + EPS);
        u32x2* o = (u32x2*)(WSP(F, WS_HN, bf16_t) + (size_t)row * D) + F.lane;
#pragma unroll
        for (int j = 0; j < 4; ++j) { const f32x4 h = v[j] * rstd * sc[j] + sh[j]; o[64 * j] = (u32x2){cvt_pk_bf16(h.x, h.y), cvt_pk_bf16(h.z, h.w)}; }
    }
}

using pg8::Unit;
typedef f32x4 AccT[2][2][4][2];

struct GemmBase {
    int G, vcu;
    __device__ __forceinline__ void aoff_lin(int R0, int C0, unsigned lda_bytes, unsigned (&off)[4]) const {
#pragma unroll
        for (int q = 0; q < 4; ++q) off[q] = (unsigned)(R0 + 64 * (q & 1) + 128 * (q >> 1)) * lda_bytes + (unsigned)C0 * 2u;
    }
};

struct PolWin : GemmBase {
    const bf16_t* A; const bf16_t* Bt; bf16_t* qkvg; float* gbuf; const float* lb; const f32x2* rope;
    __device__ __forceinline__ int nt() const { return D / 64; }
    __device__ __forceinline__ unsigned ldb_bytes() const { return D * 2; }
    __device__ __forceinline__ bool next(int i, Unit& u) const {
        const int V = i * G + vcu; if (V >= 64 * 16) return false;
        u.p0 = V >> 4; u.p1 = V & 15; u.A = (const char*)(A + (size_t)u.p0 * 256 * D); u.B = (const char*)(Bt + (size_t)u.p1 * 256 * D); return true; }
    __device__ __forceinline__ void aoff(const Unit&, int R0, int C0, unsigned (&off)[4]) const { aoff_lin(R0, C0, D * 2, off); }
    __device__ __forceinline__ void epi(const AccT& acc, const Unit& u, int wr, int wc, int fr, int fq) const {
        const int pm = u.p0, pn = u.p1, s = pn >> 1;
        const int row0 = pm * 256 + wr * 64 + fr;
        const int o0 = (pn & 1) * 256 + wc * 32 + 8 * fq;
        const int dbase = (s & 3) * 1024 + (s >> 2) * 512;
#pragma unroll
        for (int ai = 0; ai < 2; ++ai)
#pragma unroll
            for (int m = 0; m < 4; ++m) {
                const int row = row0 + ai * 128 + m * 16;
                bf16_t* orow = qkvg + (size_t)row * INW + dbase;
#pragma unroll
                for (int bj = 0; bj < 2; ++bj) {
                    const int o = o0 + bj * 128;
                    f32x4 v0 = acc[ai][bj][m][0], v1 = acc[ai][bj][m][1];
                    if (s == 4 || s == 5) {
                        const int hd = o & ~127, d0 = 4 * (((o & 127) >> 3));
                        const f32x4* rp = (const f32x4*)(rope + (size_t)row * 64 + d0);
                        const f32x4 c01 = rp[0], c23 = rp[1];
                        const f32x4 cs = {c01.x, c01.z, c23.x, c23.z}, sn = {c01.y, c01.w, c23.y, c23.w};
                        f32x4 o1 = v0 * cs - v1 * sn, o2 = v0 * sn + v1 * cs;
                        if (s == 5) { o1 = o1 * 0.08838834764831845f; o2 = o2 * 0.08838834764831845f; }
                        *(u32x2*)(orow + hd + d0) = (u32x2){cvt_pk_bf16(o1.x, o1.y), cvt_pk_bf16(o1.z, o1.w)};
                        *(u32x2*)(orow + hd + d0 + 64) = (u32x2){cvt_pk_bf16(o2.x, o2.y), cvt_pk_bf16(o2.z, o2.w)};
                    } else {
                        if (s == 0 || s == 3 || s == 7) {
#pragma unroll
                            for (int j = 0; j < 4; ++j) { v0[j] = siluf_(v0[j]); v1[j] = siluf_(v1[j]); }
                        } else if (s == 1) {
                            const f32x4 l0 = *(const f32x4*)(lb + o), l1 = *(const f32x4*)(lb + o + 4);
                            f32x4 g0, g1;
#pragma unroll
                            for (int j = 0; j < 4; ++j) {
                                const float f0 = l0[j] + (1.0f - l0[j]) * sigmoidf_(v0[j]), f1 = l1[j] + (1.0f - l1[j]) * sigmoidf_(v1[j]);
                                g0[j] = __logf(f0); g1[j] = __logf(f1); v0[j] = 1.0f - f0; v1[j] = 1.0f - f1; }
                            float* gr = gbuf + (size_t)row * 512 + o;
                            *(f32x4*)gr = g0; *(f32x4*)(gr + 4) = g1;
                        }
                        u32x4 w; w.x = cvt_pk_bf16(v0[0], v0[1]); w.y = cvt_pk_bf16(v0[2], v0[3]); w.z = cvt_pk_bf16(v1[0], v1[1]); w.w = cvt_pk_bf16(v1[2], v1[3]);
                        *(u32x4*)(orow + o) = w;
                    }
                }
            }
    }
};

struct PolRes : GemmBase {
    const bf16_t* A; const bf16_t* Bt; const float* resid; float* outp; const float* gate; const float* bias; const float* scale;
    int K, lda, nN, kcol;
    __device__ __forceinline__ int nt() const { return K / 64; }
    __device__ __forceinline__ unsigned ldb_bytes() const { return (unsigned)K * 2u; }
    __device__ __forceinline__ bool next(int i, Unit& u) const {
        const int V = i * G + vcu; if (V >= 64 * nN) return false;
        u.p0 = V / nN; u.p1 = V % nN; u.A = (const char*)(A + (size_t)u.p0 * 256 * lda + (size_t)u.p1 * kcol); u.B = (const char*)(Bt + (size_t)u.p1 * 256 * K); return true; }
    __device__ __forceinline__ void aoff(const Unit&, int R0, int C0, unsigned (&off)[4]) const { aoff_lin(R0, C0, (unsigned)lda * 2u, off); }
    __device__ __forceinline__ void epi(const AccT& acc, const Unit& u, int wr, int wc, int fr, int fq) const {
        const int row0 = u.p0 * 256 + wr * 64 + fr, col0 = u.p1 * 256 + wc * 32 + 8 * fq;
#pragma unroll
        for (int bj = 0; bj < 2; ++bj) {
            const int c = col0 + bj * 128;
            const f32x4 g0 = *(const f32x4*)(gate + c), g1 = *(const f32x4*)(gate + c + 4);
            f32x4 b0 = {0.f, 0.f, 0.f, 0.f}, b1 = b0, s0 = {1.f, 1.f, 1.f, 1.f}, s1 = s0;
            if (bias) { b0 = *(const f32x4*)(bias + c); b1 = *(const f32x4*)(bias + c + 4); s0 = *(const f32x4*)(scale + c); s1 = *(const f32x4*)(scale + c + 4); }
#pragma unroll
            for (int ai = 0; ai < 2; ++ai)
#pragma unroll
                for (int m = 0; m < 4; ++m) {
                    const size_t idx = (size_t)(row0 + ai * 128 + m * 16) * D + c;
                    const f32x4 r0 = *(const f32x4*)(resid + idx), r1 = *(const f32x4*)(resid + idx + 4);
                    *(f32x4*)(outp + idx) = r0 + g0 * ((acc[ai][bj][m][0] + b0) * s0);
                    *(f32x4*)(outp + idx + 4) = r1 + g1 * ((acc[ai][bj][m][1] + b1) * s1);
                }
        }
    }
};

constexpr int MI_TPRE = 16, MI_CNT = 64, MI_MT2E = 128;
__device__ __forceinline__ void expert_tables(Frame& F, int layer) {
    if (F.tid == 0) {
        int pre = 0;
        for (int e = 0; e < NE; ++e) {
            int c = (int)__hip_atomic_load(F.ctl + CW_CNT + 64 * layer + e, __ATOMIC_RELAXED, __HIP_MEMORY_SCOPE_AGENT);
            if (c > LIST_CAP) c = LIST_CAP;
            F.MISC[MI_TPRE + e] = pre; F.MISC[MI_CNT + e] = c;
            const int nt_ = (c + 255) >> 8;
            for (int q = 0; q < nt_; ++q) F.MISC[MI_MT2E + pre + q] = e;
            pre += nt_;
        }
        F.MISC[MI_TPRE + NE] = pre;
    }
    __syncthreads();
}
struct PolG1 : GemmBase {
    volatile LAS unsigned* MISC; const bf16_t* hn; const bf16_t* wgut; const float* bgu; const int* lslot; bf16_t* act;
    __device__ __forceinline__ int nt() const { return D / 64; }
    __device__ __forceinline__ unsigned ldb_bytes() const { return D * 2; }
    __device__ __forceinline__ bool next(int i, Unit& u) const {
        const int V = i * G + vcu, MT = (int)MISC[MI_TPRE + NE]; if (V >= MT * 8) return false;
        const int mt = V >> 3, nt_ = V & 7, e = (int)MISC[MI_MT2E + mt];
        u.p0 = e; u.p1 = mt - (int)MISC[MI_TPRE + e]; u.p2 = nt_; u.p3 = mt;
        u.A = (const char*)hn; u.B = (const char*)(wgut + ((size_t)e * 2048 + (size_t)nt_ * 256) * D); return true; }
    __device__ __forceinline__ void aoff(const Unit& u, int R0, int C0, unsigned (&off)[4]) const {
        const int cnt = (int)MISC[MI_CNT + u.p0]; const int* ls = lslot + (size_t)u.p0 * LIST_CAP + u.p1 * 256;
#pragma unroll
        for (int q = 0; q < 4; ++q) { const int r = R0 + 64 * (q & 1) + 128 * (q >> 1); const int tok = (u.p1 * 256 + r < cnt) ? (ls[r] >> 2) : 0; off[q] = (unsigned)tok * (D * 2u) + (unsigned)C0 * 2u; }
    }
    __device__ __forceinline__ void epi(const AccT& acc, const Unit& u, int wr, int wc, int fr, int fq) const {
        const int colg = u.p2 * 128 + wc * 32 + 8 * fq;
        const float* bg = bgu + (size_t)u.p0 * 2048;
        const f32x4 bgl0 = *(const f32x4*)(bg + colg), bgl1 = *(const f32x4*)(bg + colg + 4), bln0 = *(const f32x4*)(bg + 1024 + colg), bln1 = *(const f32x4*)(bg + 1024 + colg + 4);
        bf16_t* base = act + ((size_t)u.p3 * 256 + wr * 64 + fr) * D + colg;
#pragma unroll
        for (int ai = 0; ai < 2; ++ai)
#pragma unroll
            for (int m = 0; m < 4; ++m) {
                f32x4 gl0 = acc[ai][0][m][0] + bgl0, gl1 = acc[ai][0][m][1] + bgl1, ln0 = acc[ai][1][m][0] + bln0, ln1 = acc[ai][1][m][1] + bln1;
                f32x4 a0, a1;
#pragma unroll
                for (int j = 0; j < 4; ++j) {
                    const float x0 = fminf(gl0[j], SW_LIMIT), x1 = fminf(gl1[j], SW_LIMIT);
                    const float y0 = fminf(fmaxf(ln0[j], -SW_LIMIT), SW_LIMIT), y1 = fminf(fmaxf(ln1[j], -SW_LIMIT), SW_LIMIT);
                    a0[j] = x0 * sigmoidf_(SW_ALPHA * x0) * (y0 + 1.0f); a1[j] = x1 * sigmoidf_(SW_ALPHA * x1) * (y1 + 1.0f); }
                u32x4 w; w.x = cvt_pk_bf16(a0[0], a0[1]); w.y = cvt_pk_bf16(a0[2], a0[3]); w.z = cvt_pk_bf16(a1[0], a1[1]); w.w = cvt_pk_bf16(a1[2], a1[3]);
                *(u32x4*)(base + (size_t)(ai * 128 + m * 16) * D) = w;
            }
    }
};
struct PolG2 : GemmBase {
    volatile LAS unsigned* MISC; const bf16_t* act; const bf16_t* wdnt; const float* bdn; const int* lslot; const float* lw; bf16_t* yslot;
    __device__ __forceinline__ int nt() const { return D / 64; }
    __device__ __forceinline__ unsigned ldb_bytes() const { return D * 2; }
    __device__ __forceinline__ bool next(int i, Unit& u) const {
        const int V = i * G + vcu, MT = (int)MISC[MI_TPRE + NE]; if (V >= MT * 4) return false;
        const int mt = V >> 2, nt_ = V & 3, e = (int)MISC[MI_MT2E + mt];
        u.p0 = e; u.p1 = mt - (int)MISC[MI_TPRE + e]; u.p2 = nt_; u.p3 = mt;
        u.A = (const char*)(act + (size_t)mt * 256 * D); u.B = (const char*)(wdnt + ((size_t)e * D + (size_t)nt_ * 256) * D); return true; }
    __device__ __forceinline__ void aoff(const Unit&, int R0, int C0, unsigned (&off)[4]) const { aoff_lin(R0, C0, D * 2, off); }
    __device__ __forceinline__ void epi(const AccT& acc, const Unit& u, int wr, int wc, int fr, int fq) const {
        const int cnt = (int)MISC[MI_CNT + u.p0];
        const int col0 = u.p2 * 256 + wc * 32 + 8 * fq;
        const float* bd = bdn + (size_t)u.p0 * D;
        const int* ls = lslot + (size_t)u.p0 * LIST_CAP; const float* lwp = lw + (size_t)u.p0 * LIST_CAP;
#pragma unroll
        for (int ai = 0; ai < 2; ++ai)
#pragma unroll
            for (int m = 0; m < 4; ++m) {
                const int li = u.p1 * 256 + ai * 128 + wr * 64 + m * 16 + fr;
                if (li < cnt) {
                    const int slot = ls[li]; const float w = lwp[li];
                    bf16_t* yr = yslot + (size_t)slot * D + col0;
#pragma unroll
                    for (int bj = 0; bj < 2; ++bj) {
                        const f32x4 b0 = *(const f32x4*)(bd + col0 + bj * 128), b1 = *(const f32x4*)(bd + col0 + bj * 128 + 4);
                        const f32x4 v0 = (acc[ai][bj][m][0] + b0) * w, v1 = (acc[ai][bj][m][1] + b1) * w;
                        u32x4 o; o.x = cvt_pk_bf16(v0[0], v0[1]); o.y = cvt_pk_bf16(v0[2], v0[3]); o.z = cvt_pk_bf16(v1[0], v1[1]); o.w = cvt_pk_bf16(v1[2], v1[3]);
                        *(u32x4*)(yr + bj * 128) = o;
                    }
                }
            }
    }
};

template <class P> __device__ __forceinline__ void run_gemm(Frame& F, const P& S) {
    pg8::gemm_simple<P>(F.lds, S);
}

__device__ __forceinline__ void p3_recurrence_naive(Frame& F) {
    const bf16_t* qkvg = WSP(F, WS_QKVG, bf16_t); const float* gbuf = WSP(F, WS_GBUF, float); float* O = WSP(F, WS_KVT, float);
    const int gw = F.vcu * NWAVES + F.wave, NGW = F.G * NWAVES;
    for (int unit = gw; unit < 1024; unit += NGW) {
        const int hh = unit >> 7, e = unit & 127;
        const int d0 = F.lane, d1 = F.lane + 64;
        float S0 = 0.f, S1 = 0.f;
        float lg = 0.f; if (hh >= 4) lg = __logf(1.0f - exp2f(-5.0f - (float)(hh - 4)));
        const float fr_ = __expf(lg);
        for (int tb = 0; tb < T; tb += 8) {
            float q0[8], q1[8], k0[8], k1[8], vv[8], f0[8], f1[8];
#pragma unroll
            for (int i = 0; i < 8; ++i) {
                const bf16_t* row = qkvg + (size_t)(tb + i) * INW + hh * 128;
                q0[i] = bf2f(row[d0]); q1[i] = bf2f(row[d1]); k0[i] = bf2f(row[1024 + d0]); k1[i] = bf2f(row[1024 + d1]); vv[i] = bf2f(row[2048 + e]);
                f0[i] = fr_; f1[i] = fr_;
                if (hh < 4) { const float* g = gbuf + (size_t)(tb + i) * 512 + hh * 128; f0[i] = __expf(g[d0]); f1[i] = __expf(g[d1]); }
            }
#pragma unroll
            for (int i = 0; i < 8; ++i) {
                S0 = f0[i] * S0 + k0[i] * vv[i]; S1 = f1[i] * S1 + k1[i] * vv[i];
                const float o = wave_sum(S0 * q0[i] + S1 * q1[i]);
                if (F.lane == 0) O[(size_t)(tb + i) * D + hh * 128 + e] = o;
            }
        }
    }
}
__device__ __forceinline__ void p5_headnorm_naive(Frame& F) {
    const float* O = WSP(F, WS_KVT, float); const bf16_t* qkvg = WSP(F, WS_QKVG, bf16_t); bf16_t* cat = WSP(F, WS_CAT, bf16_t);
    const int gw = F.vcu * NWAVES + F.wave, NGW = F.G * NWAVES;
    const int c0 = 16 * F.lane, hh = F.lane >> 3;
    const float* gain = (hh < 4) ? (F.in[6] + c0) : (F.in[7] + (c0 - 512));
    f32x4 gn[4];
#pragma unroll
    for (int j = 0; j < 4; ++j) gn[j] = *(const f32x4*)(gain + 4 * j);
    for (int row = gw; row < T; row += NGW) {
        f32x4 v[4]; float s = 0.f;
#pragma unroll
        for (int j = 0; j < 4; ++j) { v[j] = *(const f32x4*)(O + (size_t)row * D + c0 + 4 * j); s += (v[j].x * v[j].x + v[j].y * v[j].y) + (v[j].z * v[j].z + v[j].w * v[j].w); }
        s += __shfl_xor(s, 1); s += __shfl_xor(s, 2); s += __shfl_xor(s, 4);
        const float rstd = rsqrtf(s * (1.f / 128.f) + EPS);
        const u32x4* gp = (const u32x4*)(qkvg + (size_t)row * INW + 3072 + c0);
        const u32x4 ga = gp[0], gb = gp[1];
        const float gt[16] = {bflo(ga.x), bfhi(ga.x), bflo(ga.y), bfhi(ga.y), bflo(ga.z), bfhi(ga.z), bflo(ga.w), bfhi(ga.w), bflo(gb.x), bfhi(gb.x), bflo(gb.y), bfhi(gb.y), bflo(gb.z), bfhi(gb.z), bflo(gb.w), bfhi(gb.w)};
        unsigned w[8];
#pragma unroll
        for (int j = 0; j < 4; ++j) { const f32x4 o = v[j] * rstd * gn[j];
            w[2 * j] = cvt_pk_bf16(o.x * gt[4 * j], o.y * gt[4 * j + 1]); w[2 * j + 1] = cvt_pk_bf16(o.z * gt[4 * j + 2], o.w * gt[4 * j + 3]); }
        u32x4* op = (u32x4*)(cat + (size_t)row * D + c0);
        op[0] = (u32x4){w[0], w[1], w[2], w[3]}; op[1] = (u32x4){w[4], w[5], w[6], w[7]};
    }
}

constexpr int WR_STRIDE = 1028;
__device__ __forceinline__ void p_route(Frame& F, int layer, const float* X) {
    const int tid = F.tid, lane = F.lane;
    LAS float* wl = (LAS float*)F.lds;
    LAS int* pe = (LAS int*)(F.lds + 32 * WR_STRIDE * 4);
    LAS float* pw = (LAS float*)(pe + 256);
    LAS int* hist = (LAS int*)(pw + 256);
    LAS int* gbase = hist + 32;
    const float* wr = F.in[12] + (size_t)layer * D * NE;
    for (int idx = tid; idx < D * NE; idx += NTH) { const int c = idx >> 5, e = idx & 31; wl[e * WR_STRIDE + c] = wr[idx]; }
    const float* mod = WSP(F, WS_MOD, float) + (size_t)layer * 6 * D;
    f32x4 sh[4], sc[4];
#pragma unroll
    for (int j = 0; j < 4; ++j) { sh[j] = *(const f32x4*)(mod + 3 * D + 4 * lane + 256 * j); sc[j] = *(const f32x4*)(mod + 4 * D + 4 * lane + 256 * j) + 1.0f; }
    const float bias = F.in[13][layer * NE + (lane >> 1)];
    int* lslot = WSP(F, WS_LSLOT, int) + (size_t)layer * NE * LIST_CAP; float* lw = WSP(F, WS_LW, float) + (size_t)layer * NE * LIST_CAP;
    __syncthreads();
    for (int tb = F.vcu; tb < T / 64; tb += F.G) {
        if (tid < 32) hist[tid] = 0;
        for (int i = 0; i < 8; ++i) {
            const int tl = F.wave * 8 + i, row = tb * 64 + tl;
            const f32x4* xr = (const f32x4*)(X + (size_t)row * D) + lane;
            f32x4 h[4]; float s = 0.f;
#pragma unroll
            for (int j = 0; j < 4; ++j) { h[j] = xr[64 * j]; s += (h[j].x * h[j].x + h[j].y * h[j].y) + (h[j].z * h[j].z + h[j].w * h[j].w); }
            const float rstd = rsqrtf(wave_sum(s) * (1.f / D) + EPS);
            u32x2* o = (u32x2*)(WSP(F, WS_HN, bf16_t) + (size_t)row * D) + lane;
#pragma unroll
            for (int j = 0; j < 4; ++j) { h[j] = h[j] * rstd * sc[j] + sh[j]; o[64 * j] = (u32x2){cvt_pk_bf16(h[j].x, h[j].y), cvt_pk_bf16(h[j].z, h[j].w)}; }
            float p[32];
#pragma unroll
            for (int e = 0; e < 32; ++e) {
                float a = 0.f;
#pragma unroll
                for (int j = 0; j < 4; ++j) { const f32x4 w = *(const LAS f32x4*)(wl + e * WR_STRIDE + 4 * lane + 256 * j); a += (h[j].x * w.x + h[j].y * w.y) + (h[j].z * w.z + h[j].w * w.w); }
                p[e] = a;
            }
#pragma unroll
            for (int st = 0; st < 5; ++st) {
                const int half = 16 >> st, off = 32 >> st; const bool up = (lane & off) != 0;
#pragma unroll
                for (int q = 0; q < half; ++q) { const float send = up ? p[q] : p[q + half]; const float keep = up ? p[q + half] : p[q]; p[q] = keep + __shfl_xor(send, off); }
            }
            float val = p[0] + __shfl_xor(p[0], 1) + bias;
            const int myE = lane >> 1;
            float tv[4]; int te[4];
#pragma unroll
            for (int k = 0; k < 4; ++k) {
                const float mx = wave_max(val);
                const unsigned long long mk = __ballot(val == mx);
                const int e = (int)(__builtin_ctzll(mk) >> 1);
                tv[k] = mx; te[k] = e; if (myE == e) val = -INFINITY;
            }
            const float e1 = __expf(tv[1] - tv[0]), e2 = __expf(tv[2] - tv[0]), e3 = __expf(tv[3] - tv[0]); const float inv = 1.0f / (1.0f + e1 + e2 + e3);
            if (lane == 0) { pe[tl * 4 + 0] = te[0]; pe[tl * 4 + 1] = te[1]; pe[tl * 4 + 2] = te[2]; pe[tl * 4 + 3] = te[3];
                pw[tl * 4 + 0] = inv; pw[tl * 4 + 1] = e1 * inv; pw[tl * 4 + 2] = e2 * inv; pw[tl * 4 + 3] = e3 * inv; }
        }
        __syncthreads();
        int myexp = 0, lpos = 0;
        if (tid < 256) { myexp = pe[tid]; lpos = __hip_atomic_fetch_add(hist + myexp, 1, __ATOMIC_RELAXED, __HIP_MEMORY_SCOPE_WORKGROUP); }
        __syncthreads();
        if (tid < 32) gbase[tid] = (int)atomicAdd(F.ctl + CW_CNT + 64 * layer + tid, (unsigned)hist[tid]);
        __syncthreads();
        if (tid < 256) { const int pos = gbase[myexp] + lpos; if (pos < LIST_CAP) { lslot[(size_t)myexp * LIST_CAP + pos] = tb * 256 + tid; lw[(size_t)myexp * LIST_CAP + pos] = pw[tid]; } }
        __syncthreads();
    }
}

template <int MODE>
__device__ __forceinline__ void p_combine(Frame& F, int layer, const float* Xin, float* Xout) {
    const int lane = F.lane;
    const float* mod = WSP(F, WS_MOD, float) + (size_t)layer * 6 * D;
    const bf16_t* ys = WSP(F, WS_YSLOT, bf16_t);
    f32x4 gf[4], fnw[4];
#pragma unroll
    for (int j = 0; j < 4; ++j) { gf[j] = *(const f32x4*)(mod + 5 * D + 4 * lane + 256 * j); if (MODE == 1) fnw[j] = *(const f32x4*)(F.in[18] + 4 * lane + 256 * j); }
    const int gw = F.vcu * NWAVES + F.wave, NGW = F.G * NWAVES;
    for (int row = gw; row < T; row += NGW) {
        const f32x4* xr = (const f32x4*)(Xin + (size_t)row * D) + lane;
        f32x4 v[4]; float s = 0.f;
#pragma unroll
        for (int j = 0; j < 4; ++j) {
            f32x4 a = {0.f, 0.f, 0.f, 0.f};
#pragma unroll
            for (int k = 0; k < 4; ++k) { const u32x2 y = *((const u32x2*)(ys + ((size_t)row * 4 + k) * D) + lane + 64 * j); a += (f32x4){bflo(y.x), bfhi(y.x), bflo(y.y), bfhi(y.y)}; }
            v[j] = xr[64 * j] + gf[j] * a;
            s += (v[j].x * v[j].x + v[j].y * v[j].y) + (v[j].z * v[j].z + v[j].w * v[j].w);
        }
        const float rstd = rsqrtf(wave_sum(s) * (1.f / D) + EPS);
        f32x4* o = (f32x4*)(Xout + (size_t)row * D) + lane;
        if (MODE == 0) {
#pragma unroll
            for (int j = 0; j < 4; ++j) o[64 * j] = v[j];
            if (lane == 0) WSP(F, WS_RSTD, float)[row] = rstd;
        } else {
#pragma unroll
            for (int j = 0; j < 4; ++j) o[64 * j] = v[j] * rstd * fnw[j];
        }
    }
}

__device__ __forceinline__ void p_pool(Frame& F, const float* X) {
    const float* mod = WSP(F, WS_MOD, float) + (size_t)1 * 6 * D; const float* rs = WSP(F, WS_RSTD, float); bf16_t* P = WSP(F, WS_HN, bf16_t);
    const int tid = F.tid;
    for (int u = F.vcu; u < 1024; u += F.G) {
        const int tt = u >> 2, g = u & 3, w = 2 << g;
        const int c = g * 256 + (tid & 255), t0 = tt * 64 + (tid >> 8) * 32;
        const float sh = mod[0 * D + c], sc = 1.0f + mod[1 * D + c];
        float sum = 0.f;
        for (int t = t0 - (w - 1); t < t0; ++t) if (t >= 0) sum += X[(size_t)t * D + c] * rs[t] * sc + sh;
        for (int t = t0; t < t0 + 32; ++t) {
            const float h = X[(size_t)t * D + c] * rs[t] * sc + sh;
            sum += h;
            const int cnt = (t + 1 < w) ? (t + 1) : w;
            const float p = sum / (float)cnt - h;
            P[(size_t)t * D + c] = (bf16_t)(cvt_pk_bf16(p, 0.f) & 0xffffu);
            const int tl = t - (w - 1);
            if (tl >= 0) sum -= X[(size_t)tl * D + c] * rs[tl] * sc + sh;
        }
    }
}

constexpr int N_PHASES = 17;
__global__ void __launch_bounds__(NTH, 2) fwd_kernel(Args args) {
    extern __shared__ __attribute__((aligned(16))) unsigned char lds_raw[];
    Frame F;
    F.lds = (LAS unsigned char*)lds_raw;
    F.MISC = (volatile LAS unsigned*)(F.lds + MISC_OFF);
    F.tid = threadIdx.x; F.lane = F.tid & 63; F.wave = __builtin_amdgcn_readfirstlane(F.tid >> 6);
    F.G = gridDim.x; { const int bx = blockIdx.x; F.vcu = (F.G % 8 == 0) ? (bx % 8) * (F.G / 8) + bx / 8 : bx; }
    F.ws = args.ws; F.ctl = (unsigned*)(args.ws + WS_CTL); F.out = args.out;
#pragma unroll
    for (int i = 0; i < 19; ++i) F.in[i] = args.in[i];
    for (int u = F.tid; u < (LDS_BYTES - MISC_OFF) / 4; u += NTH) F.MISC[u] = 0u;
    __syncthreads();
#if N_LAUNCH_MODE == 1
    XcdBarrier bar = xcd_barrier_post(F.ctl + CW_BAR, F.MISC + 8);
#define GRID_BAR() xcd_barrier(bar)
#else
#define GRID_BAR() do { } while (0)
#endif
    const int lo = args.ph_lo, hi = args.ph_hi;
#define IN(k) (lo <= (k) && (k) < hi)
#define SEAM(k) do { if (IN(k) && IN((k) + 1)) GRID_BAR(); } while (0)
    GemmBase gb; gb.G = F.G; gb.vcu = F.vcu;
    float* X1 = WSP(F, WS_X1, float); float* X2 = WSP(F, WS_X2, float);
    const float* mod0 = WSP(F, WS_MOD, float); const float* mod1 = mod0 + 6 * D;

    if (IN(0)) { p0_prologue(F); } SEAM(0);
    if (IN(1)) { p1_norm_in(F); } SEAM(1);
    if (IN(2)) { PolWin P; (GemmBase&)P = gb; P.A = WSP(F, WS_HN, bf16_t); P.Bt = WSP(F, WS_WINT, bf16_t); P.qkvg = WSP(F, WS_QKVG, bf16_t); P.gbuf = WSP(F, WS_GBUF, float);
        P.lb = WSP(F, WS_LB, float); P.rope = WSP(F, WS_ROPE, f32x2); run_gemm(F, P); } SEAM(2);
    if (IN(3)) { p3_recurrence_naive(F); } SEAM(3);
    if (IN(4)) { } SEAM(4);
    if (IN(5)) { p5_headnorm_naive(F); } SEAM(5);
    if (IN(6)) { PolRes P; (GemmBase&)P = gb; P.A = WSP(F, WS_CAT, bf16_t); P.Bt = WSP(F, WS_WOUTT, bf16_t); P.resid = F.in[0]; P.outp = X1; P.gate = mod0 + 2 * D; P.bias = nullptr; P.scale = nullptr;
        P.K = D; P.lda = D; P.nN = 4; P.kcol = 0; run_gemm(F, P); } SEAM(6);
    if (IN(7)) { p_route(F, 0, X1); } SEAM(7);
    if (IN(8)) { expert_tables(F, 0); PolG1 P; (GemmBase&)P = gb; P.MISC = F.MISC; P.hn = WSP(F, WS_HN, bf16_t); P.wgut = WSP(F, WS_WGUT, bf16_t); P.bgu = F.in[15]; P.lslot = WSP(F, WS_LSLOT, int); P.act = WSP(F, WS_ACT, bf16_t);
        run_gemm(F, P); } SEAM(8);
    if (IN(9)) { expert_tables(F, 0); PolG2 P; (GemmBase&)P = gb; P.MISC = F.MISC; P.act = WSP(F, WS_ACT, bf16_t); P.wdnt = WSP(F, WS_WDNT, bf16_t); P.bdn = F.in[17]; P.lslot = WSP(F, WS_LSLOT, int); P.lw = WSP(F, WS_LW, float);
        P.yslot = WSP(F, WS_YSLOT, bf16_t); run_gemm(F, P); } SEAM(9);
    if (IN(10)) { p_combine<0>(F, 0, X1, X2); } SEAM(10);
    if (IN(11)) { p_pool(F, X2); } SEAM(11);
    if (IN(12)) { PolRes P; (GemmBase&)P = gb; P.A = WSP(F, WS_HN, bf16_t); P.Bt = WSP(F, WS_POOLT, bf16_t); P.resid = X2; P.outp = X1; P.gate = mod1 + 2 * D; P.bias = F.in[10]; P.scale = F.in[11];
        P.K = 256; P.lda = D; P.nN = 4; P.kcol = 256; run_gemm(F, P); } SEAM(12);
    if (IN(13)) { p_route(F, 1, X1); } SEAM(13);
    if (IN(14)) { expert_tables(F, 1); PolG1 P; (GemmBase&)P = gb; P.MISC = F.MISC; P.hn = WSP(F, WS_HN, bf16_t); P.wgut = WSP(F, WS_WGUT, bf16_t) + (size_t)NE * 2048 * D; P.bgu = F.in[15] + (size_t)NE * 2048;
        P.lslot = WSP(F, WS_LSLOT, int) + (size_t)NE * LIST_CAP; P.act = WSP(F, WS_ACT, bf16_t); run_gemm(F, P); } SEAM(14);
    if (IN(15)) { expert_tables(F, 1); PolG2 P; (GemmBase&)P = gb; P.MISC = F.MISC; P.act = WSP(F, WS_ACT, bf16_t); P.wdnt = WSP(F, WS_WDNT, bf16_t) + (size_t)NE * D * D; P.bdn = F.in[17] + (size_t)NE * D;
        P.lslot = WSP(F, WS_LSLOT, int) + (size_t)NE * LIST_CAP; P.lw = WSP(F, WS_LW, float) + (size_t)NE * LIST_CAP; P.yslot = WSP(F, WS_YSLOT, bf16_t); run_gemm(F, P); } SEAM(15);
    if (IN(16)) { p_combine<1>(F, 1, X1, F.out); }
#undef IN
#undef SEAM
}

extern "C" void kernel_launch(void* const* d_in, const int* in_sizes, int n_in, void* d_out, int out_size, void* d_ws, size_t ws_size, hipStream_t stream) {
    static int grid = 0;
    if (grid == 0) {
        if (n_in != 19 || out_size != T * D || ws_size < WS_END) { fprintf(stderr, "kernel_launch: unexpected shapes (n_in %d, out %d, ws %zu)\n", n_in, out_size, ws_size); grid = -1; return; }
        int dev = 0, cus = 0, per_cu = 0;
        if (hipGetDevice(&dev) != hipSuccess || hipDeviceGetAttribute(&cus, hipDeviceAttributeMultiprocessorCount, dev) != hipSuccess) { grid = -1; return; }
        if (hipFuncSetAttribute((const void*)fwd_kernel, hipFuncAttributeMaxDynamicSharedMemorySize, LDS_BYTES) != hipSuccess) { fprintf(stderr, "kernel_launch: hipFuncSetAttribute failed\n"); grid = -1; return; }
        if (hipOccupancyMaxActiveBlocksPerMultiprocessor(&per_cu, (const void*)fwd_kernel, NTH, LDS_BYTES) != hipSuccess || per_cu < 1) { fprintf(stderr, "kernel_launch: occupancy query says %d\n", per_cu); }
        (void)hipGetLastError();
        grid = cus;
    }
    if (grid < 0) return;
    (void)hipMemsetAsync((char*)d_ws + WS_CTL, 0, CTL_BYTES, stream);
    Args a{};
    for (int i = 0; i < 19; ++i) a.in[i] = (const float*)d_in[i];
    a.out = (float*)d_out; a.ws = (unsigned char*)d_ws;
#if N_LAUNCH_MODE == 1
    a.ph_lo = 0; a.ph_hi = N_PHASES;
    void* kargs[] = {&a};
    hipError_t e = hipLaunchCooperativeKernel((const void*)fwd_kernel, dim3(grid), dim3(NTH), kargs, LDS_BYTES, stream);
    if (e != hipSuccess) fprintf(stderr, "cooperative launch failed: %s\n", hipGetErrorString(e));
#else
    for (int p = 0; p < N_PHASES; ++p) {
        if (p == 4) continue;
        a.ph_lo = p; a.ph_hi = p + 1;
        hipLaunchKernelGGL(fwd_kernel, dim3(grid), dim3(NTH), LDS_BYTES, stream, a);
    }
#endif
}
```

```cpp
#include <hip/hip_runtime.h>
#include <cstdio>
#include <cstdint>

#ifndef N_LAUNCH_MODE
#define N_LAUNCH_MODE 1
#endif
#ifndef SIMPLE_GEMM
#define SIMPLE_GEMM 1
#endif

#define LAS __attribute__((address_space(3)))
#define GAS __attribute__((address_space(1)))
typedef unsigned short bf16_t;
typedef short bf16x8 __attribute__((ext_vector_type(8)));
typedef float f32x4 __attribute__((ext_vector_type(4)));
typedef float f32x2 __attribute__((ext_vector_type(2)));
typedef unsigned u32x4 __attribute__((ext_vector_type(4)));
typedef unsigned u32x2 __attribute__((ext_vector_type(2)));

constexpr int T = 16384, D = 1024, NE = 32, TOPK = 4, DEPTH = 2;
constexpr int INW = 4096;
constexpr int NTH = 512, NWAVES = 8;
constexpr float EPS = 1e-6f;
constexpr float SW_LIMIT = 7.0f, SW_ALPHA = 1.702f;
constexpr int LIST_CAP = T;
constexpr int ACT_ROWS = T * TOPK + NE * 256;

constexpr size_t MiB = 1u << 20;
constexpr size_t WS_CTL = 0, CTL_BYTES = 1 * MiB;
constexpr size_t WS_MOD = 1 * MiB;
constexpr size_t WS_LB = WS_MOD + 65536;
constexpr size_t WS_ROPE = 2 * MiB;
constexpr size_t WS_WINT = 10 * MiB;
constexpr size_t WS_WOUTT = 18 * MiB;
constexpr size_t WS_POOLT = 20 * MiB;
constexpr size_t WS_LSLOT = 22 * MiB;
constexpr size_t WS_LW = 26 * MiB;
constexpr size_t WS_RSTD = 30 * MiB;
constexpr size_t WS_WGUT = 32 * MiB;
constexpr size_t WS_WDNT = 288 * MiB;
constexpr size_t WS_HN = 416 * MiB;
constexpr size_t WS_QKVG = 448 * MiB;
constexpr size_t WS_GBUF = 576 * MiB;
constexpr size_t WS_KVT = 608 * MiB;
constexpr size_t WS_SPREV = 736 * MiB;
constexpr size_t WS_DEC = 800 * MiB;
constexpr size_t WS_CAT = 802 * MiB;
constexpr size_t WS_X1 = 834 * MiB;
constexpr size_t WS_X2 = 898 * MiB;
constexpr size_t WS_ACT = 962 * MiB;
constexpr size_t WS_YSLOT = 1106 * MiB;
constexpr size_t WS_END = 1234 * MiB;
constexpr int CW_CNT = 64;
constexpr int CW_BAR = 4096;

constexpr int SCR_BYTES = 136 * 1024;
constexpr int MISC_OFF = SCR_BYTES;
constexpr int LDS_BYTES = SCR_BYTES + 4096;

__device__ __forceinline__ unsigned cvt_pk_bf16(float lo, float hi) { unsigned r; asm volatile("v_cvt_pk_bf16_f32 %0, %1, %2" : "=v"(r) : "v"(lo), "v"(hi)); return r; }
__device__ __forceinline__ float bf2f(unsigned short b) { return __builtin_bit_cast(float, (unsigned)b << 16); }
__device__ __forceinline__ float bflo(unsigned w) { return __builtin_bit_cast(float, w << 16); }
__device__ __forceinline__ float bfhi(unsigned w) { return __builtin_bit_cast(float, w & 0xffff0000u); }
__device__ __forceinline__ float wave_sum(float v) {
#pragma unroll
    for (int o = 1; o < 64; o <<= 1) v += __shfl_xor(v, o);
    return v;
}
__device__ __forceinline__ float wave_max(float v) {
#pragma unroll
    for (int o = 1; o < 64; o <<= 1) v = fmaxf(v, __shfl_xor(v, o));
    return v;
}
__device__ __forceinline__ float sigmoidf_(float x) { return 1.0f / (1.0f + __expf(-x)); }
__device__ __forceinline__ float siluf_(float x) { return x * sigmoidf_(x); }

#define XB_TMO      128
#define XB_XCNT(j)  (256  + 64 * (j))
#define XB_XSUB(j)  (1280 + 64 * (j))
#define XB_XGEN(j)  (2304 + 64 * (j))
#define XB_TOP      3328
#define XB_TOPGEN   3392
#define XCD_BAR_WORDS 3456
#define XB_SPIN_CAP (1u << 20)
__device__ __forceinline__ unsigned xb_ld(unsigned* p)              { return __hip_atomic_load(p, __ATOMIC_RELAXED, __HIP_MEMORY_SCOPE_AGENT); }
__device__ __forceinline__ unsigned xb_add(unsigned* p, unsigned v) { return __hip_atomic_fetch_add(p, v, __ATOMIC_RELAXED, __HIP_MEMORY_SCOPE_AGENT); }
__device__ __forceinline__ unsigned xb_xcc_id() { return (unsigned)__builtin_amdgcn_s_getreg((3 << 11) | 20) & 0xFu; }
#define XB_SPIN(cond, bar) do { unsigned _sp = 0; while (cond) { __builtin_amdgcn_s_sleep(1); \
    if ((++_sp & 255u) == 0u) { if (xb_ld(&(bar)[XB_TMO])) break; if (_sp > XB_SPIN_CAP) { atomicAdd(&(bar)[XB_TMO], 1u); break; } } } } while (0)
struct XcdBarrier { unsigned* bar; unsigned x; volatile LAS unsigned* st; };
__device__ __forceinline__ XcdBarrier xcd_barrier_post(unsigned* bar, volatile LAS unsigned* st) {
    XcdBarrier b; b.bar = bar; b.x = xb_xcc_id(); b.st = st;
    if (threadIdx.x == 0) (void)xb_add(&bar[XB_XCNT(b.x)], 1u);
    return b;
}
__device__ __forceinline__ void xcd_barrier_complete(unsigned* bar, unsigned x, unsigned& nloc, unsigned& nx) {
    const unsigned G = gridDim.x * gridDim.y * gridDim.z;
    unsigned sum, cnt, mine, sp = 0u;
    for (;;) {
        sum = 0u; cnt = 0u; mine = 0u;
#pragma unroll
        for (unsigned j = 0; j < 16; ++j) { const unsigned c = xb_ld(&bar[XB_XCNT(j)]); sum += c; cnt += (c > 0u) ? 1u : 0u; mine = (j == x) ? c : mine; }
        if (sum == G) break;
        __builtin_amdgcn_s_sleep(1);
        if ((++sp & 255u) == 0u) { if (xb_ld(&bar[XB_TMO])) break; if (sp > XB_SPIN_CAP) { atomicAdd(&bar[XB_TMO], 1u); break; } }
    }
    nloc = mine > 0u ? mine : 1u; nx = cnt > 0u ? cnt : 1u;
}
__device__ __forceinline__ void xcd_barrier(const XcdBarrier& b) {
    asm volatile("s_waitcnt vmcnt(0)" ::: "memory");
    __syncthreads();
    if (threadIdx.x == 0) {
        unsigned* bar = b.bar;
        __builtin_amdgcn_s_waitcnt(0);
        unsigned nloc = b.st[0], nx = b.st[1];
        if (nloc == 0u) { xcd_barrier_complete(bar, b.x, nloc, nx); b.st[0] = nloc; b.st[1] = nx; }
        const unsigned old = xb_add(&bar[XB_XSUB(b.x)], 1u);
        const unsigned gen = old / nloc;
        if (old + 1u == (gen + 1u) * nloc) {
            __builtin_amdgcn_fence(__ATOMIC_RELEASE, "agent");
            asm volatile("s_waitcnt vmcnt(0)" ::: "memory");
            const unsigned og = xb_add(&bar[XB_TOP], 1u);
            const unsigned tg = og / nx;
            if (og + 1u == (tg + 1u) * nx) xb_add(&bar[XB_TOPGEN], 1u);
            else XB_SPIN(xb_ld(&bar[XB_TOPGEN]) == tg, bar);
            __builtin_amdgcn_fence(__ATOMIC_ACQUIRE, "agent");
            xb_add(&bar[XB_XGEN(b.x)], 1u);
            asm volatile("s_waitcnt vmcnt(0)" ::: "memory");
        } else {
            XB_SPIN(xb_ld(&bar[XB_XGEN(b.x)]) == gen, bar);
            __builtin_amdgcn_fence(__ATOMIC_ACQUIRE, "agent");
            asm volatile("s_waitcnt vmcnt(0)" ::: "memory");
        }
    }
    __syncthreads();
}

struct Args {
    const float* in[19];
    float* out;
    unsigned char* ws;
    int ph_lo, ph_hi;
};

namespace pg8 {
constexpr int BM = 256, BK = 64, HALF = 128, HTB = HALF * BK * 2;
__host__ __device__ __forceinline__ int lds_byte(int r, int c) { const int st = (r >> 4) * 2 + (c >> 5), rr = r & 15, cc = c & 31, ob = rr * 64 + cc * 2; return st * 1024 + (ob ^ (((ob >> 9) & 1) << 5)); }
__host__ __device__ __forceinline__ void stage_rc(int b, int& R, int& C) { const int st = b / 1024, sb = b % 1024, swz = sb ^ (((sb >> 9) & 1) << 5); R = (st >> 1) * 16 + swz / 64; C = (st & 1) * 32 + (swz % 64) / 2; }
__host__ __device__ __forceinline__ int perm32(int rho) { const int n = rho >> 4, i = rho & 15; return 8 * (i >> 2) + 4 * n + (i & 3); }

struct Unit { const char* A; const char* B; int p0, p1, p2, p3; };

#define PG8_SA(b, h) (((b) * 2 + (h)) * HTB)
#define PG8_SB(b, h) ((4 + (b) * 2 + (h)) * HTB)
#define PG8_LDA(dst, b, h) do { _Pragma("unroll") for (int m = 0; m < 4; ++m) _Pragma("unroll") for (int k = 0; k < 2; ++k) dst[m][k] = *(const LAS bf16x8*)(lds + PG8_SA(b, h) + aoff + m * 2048 + k * 1024); } while (0)
#define PG8_LDB(dst, b, h) do { _Pragma("unroll") for (int n = 0; n < 2; ++n) _Pragma("unroll") for (int k = 0; k < 2; ++k) dst[n][k] = *(const LAS bf16x8*)(lds + PG8_SB(b, h) + boff + n * 2048 + k * 1024); } while (0)
#define PG8_MMA(ai, bj, At, Bt) do { __builtin_amdgcn_s_setprio(1); _Pragma("unroll") for (int m = 0; m < 4; ++m) _Pragma("unroll") for (int n = 0; n < 2; ++n) _Pragma("unroll") for (int k = 0; k < 2; ++k) \
        acc[ai][bj][m][n] = __builtin_amdgcn_mfma_f32_16x16x32_bf16(Bt[n][k], At[m][k], acc[ai][bj][m][n], 0, 0, 0); __builtin_amdgcn_s_setprio(0); } while (0)

template <class P>
__device__ __forceinline__ void gemm_simple(LAS unsigned char* lds, const P& S) {
    const int tid = threadIdx.x, wid = __builtin_amdgcn_readfirstlane(tid >> 6), lane = tid & 63, wr = wid >> 2, wc = wid & 3, fr = lane & 15, fq = lane >> 4;
    const int nt = S.nt();
    int R0, C0; stage_rc(tid * 16, R0, C0);
    unsigned offB[2];
#pragma unroll
    for (int i = 0; i < 2; ++i) { const int R = R0 + 64 * i; const int Rb = (R & ~31) + perm32(R & 31); offB[i] = (unsigned)Rb * S.ldb_bytes() + (unsigned)C0 * 2u; }
    const unsigned bhalf = 128u * S.ldb_bytes();
    const int aoff = lds_byte(wr * 64 + fr, fq * 8), boff = lds_byte(wc * 32 + fr, fq * 8);
    Unit u;
    for (int ui = 0; S.next(ui, u); ++ui) {
        unsigned offA[4]; S.aoff(u, R0, C0, offA);
        f32x4 acc[2][2][4][2];
#pragma unroll
        for (int a = 0; a < 2; ++a)
#pragma unroll
            for (int b = 0; b < 2; ++b)
#pragma unroll
                for (int m = 0; m < 4; ++m)
#pragma unroll
                    for (int n = 0; n < 2; ++n) acc[a][b][m][n] = (f32x4){0.f, 0.f, 0.f, 0.f};
        for (int t = 0; t < nt; ++t) {
            u32x4 ra[4], rb[4];
#pragma unroll
            for (int h = 0; h < 2; ++h)
#pragma unroll
                for (int i = 0; i < 2; ++i) {
                    ra[2 * h + i] = *(const u32x4*)(u.A + offA[2 * h + i] + (size_t)t * 128);
                    rb[2 * h + i] = *(const u32x4*)(u.B + (size_t)h * bhalf + offB[i] + (size_t)t * 128);
                }
            __syncthreads();
#pragma unroll
            for (int h = 0; h < 2; ++h)
#pragma unroll
                for (int i = 0; i < 2; ++i) {
                    *(LAS u32x4*)(lds + PG8_SA(0, h) + tid * 16 + i * 8192) = ra[2 * h + i];
                    *(LAS u32x4*)(lds + PG8_SB(0, h) + tid * 16 + i * 8192) = rb[2 * h + i];
                }
            __syncthreads();
            bf16x8 At[4][2], Bt[2][2];
#pragma unroll
            for (int ai = 0; ai < 2; ++ai) {
                PG8_LDA(At, 0, ai);
#pragma unroll
                for (int bj = 0; bj < 2; ++bj) { PG8_LDB(Bt, 0, bj); PG8_MMA(ai, bj, At, Bt); }
            }
        }
        S.epi(acc, u, wr, wc, fr, fq);
    }
    __syncthreads();
}
}

struct Frame {
    LAS unsigned char* lds;
    volatile LAS unsigned* MISC;
    unsigned* ctl;
    int tid, lane, wave, vcu, G;
    unsigned char* ws;
    const float* in[19];
    float* out;
};
#define WSP(F, off, type) ((type*)((F).ws + (off)))

template <class RowMap>
__device__ __forceinline__ void transpose_item(const float* W, int K, int N, bf16_t* WT, LAS float* scr, int item, int lane, const RowMap& rm) {
    const int nblk = N / 32, kb = item / nblk, nb = item % nblk, k0 = 64 * kb, n0 = 32 * nb;
#pragma unroll 8
    for (int i = 0; i < 32; ++i) { const int kk = 2 * i + (lane >> 5); scr[kk * 33 + (lane & 31)] = W[(size_t)(k0 + kk) * N + n0 + (lane & 31)]; }
    asm volatile("s_waitcnt lgkmcnt(0)" ::: "memory");
    const int c = lane & 7;
#pragma unroll
    for (int j = 0; j < 4; ++j) { const int n = (lane >> 3) + 8 * j; const LAS float* s = scr + (8 * c) * 33 + n;
        u32x4 o; o.x = cvt_pk_bf16(s[0 * 33], s[1 * 33]); o.y = cvt_pk_bf16(s[2 * 33], s[3 * 33]); o.z = cvt_pk_bf16(s[4 * 33], s[5 * 33]); o.w = cvt_pk_bf16(s[6 * 33], s[7 * 33]);
        *(u32x4*)(WT + (size_t)rm(n0 + n) * K + k0 + 8 * c) = o; }
    asm volatile("s_waitcnt lgkmcnt(0)" ::: "memory");
}
struct RmId { __device__ __forceinline__ int operator()(int n) const { return n; } };
struct RmWin { __device__ __forceinline__ int operator()(int n) const {
        const int s = n >> 9; if (s != 4 && s != 5) return n;
        const int d = n & 127, dd = d & 63; const int p = 8 * (dd >> 2) + (dd & 3) + ((d >> 6) << 2); return n - d + p; } };
struct RmGu { __device__ __forceinline__ int operator()(int n) const { const int half = n >> 10, j = (n & 1023) >> 7, i = n & 127; return 256 * j + 128 * half + i; } };

__device__ __forceinline__ void p0_prologue(Frame& F) {
    const int tid = F.tid;
    {
        LAS float* red = (LAS float*)F.lds;
        const float* c = F.in[1];
        for (int u = F.vcu; u < 192; u += F.G) {
            const int l = u / 96, cg = u % 96, kq = tid >> 4, cq = tid & 15;
            const float* W = F.in[2] + (size_t)l * D * 6 * D + cg * 64 + cq * 4;
            f32x4 a = {0.f, 0.f, 0.f, 0.f};
#pragma unroll 8
            for (int j = 0; j < 32; ++j) { const int k = kq + 32 * j; const float cv = siluf_(c[k]); const f32x4 w = *(const f32x4*)(W + (size_t)k * 6 * D); a += w * cv; }
            __syncthreads();
            *(LAS f32x4*)(red + kq * 64 + cq * 4) = a;
            __syncthreads();
            if (tid < 64) { float s = 0.f;
#pragma unroll 8
                for (int k = 0; k < 32; ++k) s += red[k * 64 + tid];
                const int col = cg * 64 + tid;
                WSP(F, WS_MOD, float)[l * 6 * D + col] = s + F.in[3][l * 6 * D + col]; }
        }
        __syncthreads();
    }
    if (F.vcu == 0) { const float* hb = F.in[5]; const float a = hb[tid], b = hb[512 + tid]; WSP(F, WS_LB, float)[tid] = 1.0f / (1.0f + __expf(b - a)); }
    {
        f32x2* rope = WSP(F, WS_ROPE, f32x2);
        for (int idx = F.vcu * NTH + tid; idx < T * 64; idx += F.G * NTH) {
            const int t = idx >> 6, d = idx & 63;
            const float inv = exp2f(-(float)d * (13.287712379549449f / 64.0f));
            const float ang = (float)t * inv;
            const double a = (double)ang; const double n = __builtin_rint(a * 0.15915494309189535); const double r = __builtin_fma(-n, 6.283185307179586, a);
            const float rf = (float)r;
            rope[idx] = (f32x2){__cosf(rf), __sinf(rf)};
        }
    }
    {
        LAS float* scr = (LAS float*)(F.lds + F.wave * 16384);
        const int gw = F.vcu * NWAVES + F.wave, NGW = F.G * NWAVES;
        constexpr int I_IN = 16 * 128, I_OUT = 16 * 32, I_POOL = 4 * 4 * 8, I_GU = 64 * 16 * 64, I_DN = 64 * 16 * 32;
        constexpr int NITEMS = I_IN + I_OUT + I_POOL + I_GU + I_DN;
        for (int it = gw; it < NITEMS; it += NGW) {
            int r = it;
            if (r < I_IN) { transpose_item(F.in[4], D, INW, WSP(F, WS_WINT, bf16_t), scr, r, F.lane, RmWin()); continue; } r -= I_IN;
            if (r < I_OUT) { transpose_item(F.in[8], D, D, WSP(F, WS_WOUTT, bf16_t), scr, r, F.lane, RmId()); continue; } r -= I_OUT;
            if (r < I_POOL) { const int g = r / 32; transpose_item(F.in[9] + (size_t)g * 65536, 256, 256, WSP(F, WS_POOLT, bf16_t) + (size_t)g * 65536, scr, r % 32, F.lane, RmId()); continue; } r -= I_POOL;
            if (r < I_GU) { const int m = r / 1024; transpose_item(F.in[14] + (size_t)m * D * 2048, D, 2048, WSP(F, WS_WGUT, bf16_t) + (size_t)m * 2048 * D, scr, r % 1024, F.lane, RmGu()); continue; } r -= I_GU;
            { const int m = r / 512; transpose_item(F.in[16] + (size_t)m * D * D, D, D, WSP(F, WS_WDNT, bf16_t) + (size_t)m * D * D, scr, r % 512, F.lane, RmId()); }
        }
    }
}

__device__ __forceinline__ void p1_norm_in(Frame& F) {
    const float* mod = WSP(F, WS_MOD, float);
    f32x4 sh[4], sc[4];
#pragma unroll
    for (int j = 0; j < 4; ++j) { sh[j] = *(const f32x4*)(mod + 0 * D + 4 * F.lane + 256 * j); sc[j] = *(const f32x4*)(mod + 1 * D + 4 * F.lane + 256 * j) + 1.0f; }
    const int gw = F.vcu * NWAVES + F.wave, NGW = F.G * NWAVES;
    for (int row = gw; row < T; row += NGW) {
        const f32x4* xr = (const f32x4*)(F.in[0] + (size_t)row * D) + F.lane;
        f32x4 v[4]; float s = 0.f;
#pragma unroll
        for (int j = 0; j < 4; ++j) { v[j] = xr[64 * j]; s += (v[j].x * v[j].x + v[j].y * v[j].y) + (v[j].z * v[j].z + v[j].w * v[j].w); }
        const float rstd = rsqrtf(wave_sum(s) * (1.f / D) + EPS);
        u32x2* o = (u32x2*)(WSP(F, WS_HN, bf16_t) + (size_t)row * D) + F.lane;
#pragma unroll
        for (int j = 0; j < 4; ++j) { const f32x4 h = v[j] * rstd * sc[j] + sh[j]; o[64 * j] = (u32x2){cvt_pk_bf16(h.x, h.y), cvt_pk_bf16(h.z, h.w)}; }
    }
}

using pg8::Unit;
typedef f32x4 AccT[2][2][4][2];

struct GemmBase {
    int G, vcu;
    __device__ __forceinline__ void aoff_lin(int R0, int C0, unsigned lda_bytes, unsigned (&off)[4]) const {
#pragma unroll
        for (int q = 0; q < 4; ++q) off[q] = (unsigned)(R0 + 64 * (q & 1) + 128 * (q >> 1)) * lda_bytes + (unsigned)C0 * 2u;
    }
};

struct PolWin : GemmBase {
    const bf16_t* A; const bf16_t* Bt; bf16_t* qkvg; float* gbuf; const float* lb; const f32x2* rope;
    __device__ __forceinline__ int nt() const { return D / 64; }
    __device__ __forceinline__ unsigned ldb_bytes() const { return D * 2; }
    __device__ __forceinline__ bool next(int i, Unit& u) const {
        const int V = i * G + vcu; if (V >= 64 * 16) return false;
        u.p0 = V >> 4; u.p1 = V & 15; u.A = (const char*)(A + (size_t)u.p0 * 256 * D); u.B = (const char*)(Bt + (size_t)u.p1 * 256 * D); return true; }
    __device__ __forceinline__ void aoff(const Unit&, int R0, int C0, unsigned (&off)[4]) const { aoff_lin(R0, C0, D * 2, off); }
    __device__ __forceinline__ void epi(const AccT& acc, const Unit& u, int wr, int wc, int fr, int fq) const {
        const int pm = u.p0, pn = u.p1, s = pn >> 1;
        const int row0 = pm * 256 + wr * 64 + fr;
        const int o0 = (pn & 1) * 256 + wc * 32 + 8 * fq;
        const int dbase = (s & 3) * 1024 + (s >> 2) * 512;
#pragma unroll
        for (int ai = 0; ai < 2; ++ai)
#pragma unroll
            for (int m = 0; m < 4; ++m) {
                const int row = row0 + ai * 128 + m * 16;
                bf16_t* orow = qkvg + (size_t)row * INW + dbase;
#pragma unroll
                for (int bj = 0; bj < 2; ++bj) {
                    const int o = o0 + bj * 128;
                    f32x4 v0 = acc[ai][bj][m][0], v1 = acc[ai][bj][m][1];
                    if (s == 4 || s == 5) {
                        const int hd = o & ~127, d0 = 4 * (((o & 127) >> 3));
                        const f32x4* rp = (const f32x4*)(rope + (size_t)row * 64 + d0);
                        const f32x4 c01 = rp[0], c23 = rp[1];
                        const f32x4 cs = {c01.x, c01.z, c23.x, c23.z}, sn = {c01.y, c01.w, c23.y, c23.w};
                        f32x4 o1 = v0 * cs - v1 * sn, o2 = v0 * sn + v1 * cs;
                        if (s == 5) { o1 = o1 * 0.08838834764831845f; o2 = o2 * 0.08838834764831845f; }
                        *(u32x2*)(orow + hd + d0) = (u32x2){cvt_pk_bf16(o1.x, o1.y), cvt_pk_bf16(o1.z, o1.w)};
                        *(u32x2*)(orow + hd + d0 + 64) = (u32x2){cvt_pk_bf16(o2.x, o2.y), cvt_pk_bf16(o2.z, o2.w)};
                    } else {
                        if (s == 0 || s == 3 || s == 7) {
#pragma unroll
                            for (int j = 0; j < 4; ++j) { v0[j] = siluf_(v0[j]); v1[j] = siluf_(v1[j]); }
                        } else if (s == 1) {
                            const f32x4 l0 = *(const f32x4*)(lb + o), l1 = *(const f32x4*)(lb + o + 4);
                            f32x4 g0, g1;
#pragma unroll
                            for (int j = 0; j < 4; ++j) {
                                const float f0 = l0[j] + (1.0f - l0[j]) * sigmoidf_(v0[j]), f1 = l1[j] + (1.0f - l1[j]) * sigmoidf_(v1[j]);
                                g0[j] = __logf(f0); g1[j] = __logf(f1); v0[j] = 1.0f - f0; v1[j] = 1.0f - f1; }
                            float* gr = gbuf + (size_t)row * 512 + o;
                            *(f32x4*)gr = g0; *(f32x4*)(gr + 4) = g1;
                        }
                        u32x4 w; w.x = cvt_pk_bf16(v0[0], v0[1]); w.y = cvt_pk_bf16(v0[2], v0[3]); w.z = cvt_pk_bf16(v1[0], v1[1]); w.w = cvt_pk_bf16(v1[2], v1[3]);
                        *(u32x4*)(orow + o) = w;
                    }
                }
            }
    }
};

struct PolRes : GemmBase {
    const bf16_t* A; const bf16_t* Bt; const float* resid; float* outp; const float* gate; const float* bias; const float* scale;
    int K, lda, nN, kcol;
    __device__ __forceinline__ int nt() const { return K / 64; }
    __device__ __forceinline__ unsigned ldb_bytes() const { return (unsigned)K * 2u; }
    __device__ __forceinline__ bool next(int i, Unit& u) const {
        const int V = i * G + vcu; if (V >= 64 * nN) return false;
        u.p0 = V / nN; u.p1 = V % nN; u.A = (const char*)(A + (size_t)u.p0 * 256 * lda + (size_t)u.p1 * kcol); u.B = (const char*)(Bt + (size_t)u.p1 * 256 * K); return true; }
    __device__ __forceinline__ void aoff(const Unit&, int R0, int C0, unsigned (&off)[4]) const { aoff_lin(R0, C0, (unsigned)lda * 2u, off); }
    __device__ __forceinline__ void epi(const AccT& acc, const Unit& u, int wr, int wc, int fr, int fq) const {
        const int row0 = u.p0 * 256 + wr * 64 + fr, col0 = u.p1 * 256 + wc * 32 + 8 * fq;
#pragma unroll
        for (int bj = 0; bj < 2; ++bj) {
            const int c = col0 + bj * 128;
            const f32x4 g0 = *(const f32x4*)(gate + c), g1 = *(const f32x4*)(gate + c + 4);
            f32x4 b0 = {0.f, 0.f, 0.f, 0.f}, b1 = b0, s0 = {1.f, 1.f, 1.f, 1.f}, s1 = s0;
            if (bias) { b0 = *(const f32x4*)(bias + c); b1 = *(const f32x4*)(bias + c + 4); s0 = *(const f32x4*)(scale + c); s1 = *(const f32x4*)(scale + c + 4); }
#pragma unroll
            for (int ai = 0; ai < 2; ++ai)
#pragma unroll
                for (int m = 0; m < 4; ++m) {
                    const size_t idx = (size_t)(row0 + ai * 128 + m * 16) * D + c;
                    const f32x4 r0 = *(const f32x4*)(resid + idx), r1 = *(const f32x4*)(resid + idx + 4);
                    *(f32x4*)(outp + idx) = r0 + g0 * ((acc[ai][bj][m][0] + b0) * s0);
                    *(f32x4*)(outp + idx + 4) = r1 + g1 * ((acc[ai][bj][m][1] + b1) * s1);
                }
        }
    }
};

constexpr int MI_TPRE = 16, MI_CNT = 64, MI_MT2E = 128;
__device__ __forceinline__ void expert_tables(Frame& F, int layer) {
    if (F.tid == 0) {
        int pre = 0;
        for (int e = 0; e < NE; ++e) {
            int c = (int)__hip_atomic_load(F.ctl + CW_CNT + 64 * layer + e, __ATOMIC_RELAXED, __HIP_MEMORY_SCOPE_AGENT);
            if (c > LIST_CAP) c = LIST_CAP;
            F.MISC[MI_TPRE + e] = pre; F.MISC[MI_CNT + e] = c;
            const int nt_ = (c + 255) >> 8;
            for (int q = 0; q < nt_; ++q) F.MISC[MI_MT2E + pre + q] = e;
            pre += nt_;
        }
        F.MISC[MI_TPRE + NE] = pre;
    }
    __syncthreads();
}
struct PolG1 : GemmBase {
    volatile LAS unsigned* MISC; const bf16_t* hn; const bf16_t* wgut; const float* bgu; const int* lslot; bf16_t* act;
    __device__ __forceinline__ int nt() const { return D / 64; }
    __device__ __forceinline__ unsigned ldb_bytes() const { return D * 2; }
    __device__ __forceinline__ bool next(int i, Unit& u) const {
        const int V = i * G + vcu, MT = (int)MISC[MI_TPRE + NE]; if (V >= MT * 8) return false;
        const int mt = V >> 3, nt_ = V & 7, e = (int)MISC[MI_MT2E + mt];
        u.p0 = e; u.p1 = mt - (int)MISC[MI_TPRE + e]; u.p2 = nt_; u.p3 = mt;
        u.A = (const char*)hn; u.B = (const char*)(wgut + ((size_t)e * 2048 + (size_t)nt_ * 256) * D); return true; }
    __device__ __forceinline__ void aoff(const Unit& u, int R0, int C0, unsigned (&off)[4]) const {
        const int cnt = (int)MISC[MI_CNT + u.p0]; const int* ls = lslot + (size_t)u.p0 * LIST_CAP + u.p1 * 256;
#pragma unroll
        for (int q = 0; q < 4; ++q) { const int r = R0 + 64 * (q & 1) + 128 * (q >> 1); const int tok = (u.p1 * 256 + r < cnt) ? (ls[r] >> 2) : 0; off[q] = (unsigned)tok * (D * 2u) + (unsigned)C0 * 2u; }
    }
    __device__ __forceinline__ void epi(const AccT& acc, const Unit& u, int wr, int wc, int fr, int fq) const {
        const int colg = u.p2 * 128 + wc * 32 + 8 * fq;
        const float* bg = bgu + (size_t)u.p0 * 2048;
        const f32x4 bgl0 = *(const f32x4*)(bg + colg), bgl1 = *(const f32x4*)(bg + colg + 4), bln0 = *(const f32x4*)(bg + 1024 + colg), bln1 = *(const f32x4*)(bg + 1024 + colg + 4);
        bf16_t* base = act + ((size_t)u.p3 * 256 + wr * 64 + fr) * D + colg;
#pragma unroll
        for (int ai = 0; ai < 2; ++ai)
#pragma unroll
            for (int m = 0; m < 4; ++m) {
                f32x4 gl0 = acc[ai][0][m][0] + bgl0, gl1 = acc[ai][0][m][1] + bgl1, ln0 = acc[ai][1][m][0] + bln0, ln1 = acc[ai][1][m][1] + bln1;
                f32x4 a0, a1;
#pragma unroll
                for (int j = 0; j < 4; ++j) {
                    const float x0 = fminf(gl0[j], SW_LIMIT), x1 = fminf(gl1[j], SW_LIMIT);
                    const float y0 = fminf(fmaxf(ln0[j], -SW_LIMIT), SW_LIMIT), y1 = fminf(fmaxf(ln1[j], -SW_LIMIT), SW_LIMIT);
                    a0[j] = x0 * sigmoidf_(SW_ALPHA * x0) * (y0 + 1.0f); a1[j] = x1 * sigmoidf_(SW_ALPHA * x1) * (y1 + 1.0f); }
                u32x4 w; w.x = cvt_pk_bf16(a0[0], a0[1]); w.y = cvt_pk_bf16(a0[2], a0[3]); w.z = cvt_pk_bf16(a1[0], a1[1]); w.w = cvt_pk_bf16(a1[2], a1[3]);
                *(u32x4*)(base + (size_t)(ai * 128 + m * 16) * D) = w;
            }
    }
};
struct PolG2 : GemmBase {
    volatile LAS unsigned* MISC; const bf16_t* act; const bf16_t* wdnt; const float* bdn; const int* lslot; const float* lw; bf16_t* yslot;
    __device__ __forceinline__ int nt() const { return D / 64; }
    __device__ __forceinline__ unsigned ldb_bytes() const { return D * 2; }
    __device__ __forceinline__ bool next(int i, Unit& u) const {
        const int V = i * G + vcu, MT = (int)MISC[MI_TPRE + NE]; if (V >= MT * 4) return false;
        const int mt = V >> 2, nt_ = V & 3, e = (int)MISC[MI_MT2E + mt];
        u.p0 = e; u.p1 = mt - (int)MISC[MI_TPRE + e]; u.p2 = nt_; u.p3 = mt;
        u.A = (const char*)(act + (size_t)mt * 256 * D); u.B = (const char*)(wdnt + ((size_t)e * D + (size_t)nt_ * 256) * D); return true; }
    __device__ __forceinline__ void aoff(const Unit&, int R0, int C0, unsigned (&off)[4]) const { aoff_lin(R0, C0, D * 2, off); }
    __device__ __forceinline__ void epi(const AccT& acc, const Unit& u, int wr, int wc, int fr, int fq) const {
        const int cnt = (int)MISC[MI_CNT + u.p0];
        const int col0 = u.p2 * 256 + wc * 32 + 8 * fq;
        const float* bd = bdn + (size_t)u.p0 * D;
        const int* ls = lslot + (size_t)u.p0 * LIST_CAP; const float* lwp = lw + (size_t)u.p0 * LIST_CAP;
#pragma unroll
        for (int ai = 0; ai < 2; ++ai)
#pragma unroll
            for (int m = 0; m < 4; ++m) {
                const int li = u.p1 * 256 + ai * 128 + wr * 64 + m * 16 + fr;
                if (li < cnt) {
                    const int slot = ls[li]; const float w = lwp[li];
                    bf16_t* yr = yslot + (size_t)slot * D + col0;
#pragma unroll
                    for (int bj = 0; bj < 2; ++bj) {
                        const f32x4 b0 = *(const f32x4*)(bd + col0 + bj * 128), b1 = *(const f32x4*)(bd + col0 + bj * 128 + 4);
                        const f32x4 v0 = (acc[ai][bj][m][0] + b0) * w, v1 = (acc[ai][bj][m][1] + b1) * w;
                        u32x4 o; o.x = cvt_pk_bf16(v0[0], v0[1]); o.y = cvt_pk_bf16(v0[2], v0[3]); o.z = cvt_pk_bf16(v1[0], v1[1]); o.w = cvt_pk_bf16(v1[2], v1[3]);
                        *(u32x4*)(yr + bj * 128) = o;
                    }
                }
            }
    }
};

template <class P> __device__ __forceinline__ void run_gemm(Frame& F, const P& S) {
    pg8::gemm_simple<P>(F.lds, S);
}

__device__ __forceinline__ void p3_recurrence_naive(Frame& F) {
    const bf16_t* qkvg = WSP(F, WS_QKVG, bf16_t); const float* gbuf = WSP(F, WS_GBUF, float); float* O = WSP(F, WS_KVT, float);
    const int gw = F.vcu * NWAVES + F.wave, NGW = F.G * NWAVES;
    for (int unit = gw; unit < 1024; unit += NGW) {
        const int hh = unit >> 7, e = unit & 127;
        const int d0 = F.lane, d1 = F.lane + 64;
        float S0 = 0.f, S1 = 0.f;
        float lg = 0.f; if (hh >= 4) lg = __logf(1.0f - exp2f(-5.0f - (float)(hh - 4)));
        const float fr_ = __expf(lg);
        for (int tb = 0; tb < T; tb += 8) {
            float q0[8], q1[8], k0[8], k1[8], vv[8], f0[8], f1[8];
#pragma unroll
            for (int i = 0; i < 8; ++i) {
                const bf16_t* row = qkvg + (size_t)(tb + i) * INW + hh * 128;
                q0[i] = bf2f(row[d0]); q1[i] = bf2f(row[d1]); k0[i] = bf2f(row[1024 + d0]); k1[i] = bf2f(row[1024 + d1]); vv[i] = bf2f(row[2048 + e]);
                f0[i] = fr_; f1[i] = fr_;
                if (hh < 4) { const float* g = gbuf + (size_t)(tb + i) * 512 + hh * 128; f0[i] = __expf(g[d0]); f1[i] = __expf(g[d1]); }
            }
#pragma unroll
            for (int i = 0; i < 8; ++i) {
                S0 = f0[i] * S0 + k0[i] * vv[i]; S1 = f1[i] * S1 + k1[i] * vv[i];
                const float o = wave_sum(S0 * q0[i] + S1 * q1[i]);
                if (F.lane == 0) O[(size_t)(tb + i) * D + hh * 128 + e] = o;
            }
        }
    }
}
__device__ __forceinline__ void p5_headnorm_naive(Frame& F) {
    const float* O = WSP(F, WS_KVT, float); const bf16_t* qkvg = WSP(F, WS_QKVG, bf16_t); bf16_t* cat = WSP(F, WS_CAT, bf16_t);
    const int gw = F.vcu * NWAVES + F.wave, NGW = F.G * NWAVES;
    const int c0 = 16 * F.lane, hh = F.lane >> 3;
    const float* gain = (hh < 4) ? (F.in[6] + c0) : (F.in[7] + (c0 - 512));
    f32x4 gn[4];
#pragma unroll
    for (int j = 0; j < 4; ++j) gn[j] = *(const f32x4*)(gain + 4 * j);
    for (int row = gw; row < T; row += NGW) {
        f32x4 v[4]; float s = 0.f;
#pragma unroll
        for (int j = 0; j < 4; ++j) { v[j] = *(const f32x4*)(O + (size_t)row * D + c0 + 4 * j); s += (v[j].x * v[j].x + v[j].y * v[j].y) + (v[j].z * v[j].z + v[j].w * v[j].w); }
        s += __shfl_xor(s, 1); s += __shfl_xor(s, 2); s += __shfl_xor(s, 4);
        const float rstd = rsqrtf(s * (1.f / 128.f) + EPS);
        const u32x4* gp = (const u32x4*)(qkvg + (size_t)row * INW + 3072 + c0);
        const u32x4 ga = gp[0], gb = gp[1];
        const float gt[16] = {bflo(ga.x), bfhi(ga.x), bflo(ga.y), bfhi(ga.y), bflo(ga.z), bfhi(ga.z), bflo(ga.w), bfhi(ga.w), bflo(gb.x), bfhi(gb.x), bflo(gb.y), bfhi(gb.y), bflo(gb.z), bfhi(gb.z), bflo(gb.w), bfhi(gb.w)};
        unsigned w[8];
#pragma unroll
        for (int j = 0; j < 4; ++j) { const f32x4 o = v[j] * rstd * gn[j];
            w[2 * j] = cvt_pk_bf16(o.x * gt[4 * j], o.y * gt[4 * j + 1]); w[2 * j + 1] = cvt_pk_bf16(o.z * gt[4 * j + 2], o.w * gt[4 * j + 3]); }
        u32x4* op = (u32x4*)(cat + (size_t)row * D + c0);
        op[0] = (u32x4){w[0], w[1], w[2], w[3]}; op[1] = (u32x4){w[4], w[5], w[6], w[7]};
    }
}

constexpr int WR_STRIDE = 1028;
__device__ __forceinline__ void p_route(Frame& F, int layer, const float* X) {
    const int tid = F.tid, lane = F.lane;
    LAS float* wl = (LAS float*)F.lds;
    LAS int* pe = (LAS int*)(F.lds + 32 * WR_STRIDE * 4);
    LAS float* pw = (LAS float*)(pe + 256);
    LAS int* hist = (LAS int*)(pw + 256);
    LAS int* gbase = hist + 32;
    const float* wr = F.in[12] + (size_t)layer * D * NE;
    for (int idx = tid; idx < D * NE; idx += NTH) { const int c = idx >> 5, e = idx & 31; wl[e * WR_STRIDE + c] = wr[idx]; }
    const float* mod = WSP(F, WS_MOD, float) + (size_t)layer * 6 * D;
    f32x4 sh[4], sc[4];
#pragma unroll
    for (int j = 0; j < 4; ++j) { sh[j] = *(const f32x4*)(mod + 3 * D + 4 * lane + 256 * j); sc[j] = *(const f32x4*)(mod + 4 * D + 4 * lane + 256 * j) + 1.0f; }
    const float bias = F.in[13][layer * NE + (lane >> 1)];
    int* lslot = WSP(F, WS_LSLOT, int) + (size_t)layer * NE * LIST_CAP; float* lw = WSP(F, WS_LW, float) + (size_t)layer * NE * LIST_CAP;
    __syncthreads();
    for (int tb = F.vcu; tb < T / 64; tb += F.G) {
        if (tid < 32) hist[tid] = 0;
        for (int i = 0; i < 8; ++i) {
            const int tl = F.wave * 8 + i, row = tb * 64 + tl;
            const f32x4* xr = (const f32x4*)(X + (size_t)row * D) + lane;
            f32x4 h[4]; float s = 0.f;
#pragma unroll
            for (int j = 0; j < 4; ++j) { h[j] = xr[64 * j]; s += (h[j].x * h[j].x + h[j].y * h[j].y) + (h[j].z * h[j].z + h[j].w * h[j].w); }
            const float rstd = rsqrtf(wave_sum(s) * (1.f / D) + EPS);
            u32x2* o = (u32x2*)(WSP(F, WS_HN, bf16_t) + (size_t)row * D) + lane;
#pragma unroll
            for (int j = 0; j < 4; ++j) { h[j] = h[j] * rstd * sc[j] + sh[j]; o[64 * j] = (u32x2){cvt_pk_bf16(h[j].x, h[j].y), cvt_pk_bf16(h[j].z, h[j].w)}; }
            float p[32];
#pragma unroll
            for (int e = 0; e < 32; ++e) {
                float a = 0.f;
#pragma unroll
                for (int j = 0; j < 4; ++j) { const f32x4 w = *(const LAS f32x4*)(wl + e * WR_STRIDE + 4 * lane + 256 * j); a += (h[j].x * w.x + h[j].y * w.y) + (h[j].z * w.z + h[j].w * w.w); }
                p[e] = a;
            }
#pragma unroll
            for (int st = 0; st < 5; ++st) {
                const int half = 16 >> st, off = 32 >> st; const bool up = (lane & off) != 0;
#pragma unroll
                for (int q = 0; q < half; ++q) { const float send = up ? p[q] : p[q + half]; const float keep = up ? p[q + half] : p[q]; p[q] = keep + __shfl_xor(send, off); }
            }
            float val = p[0] + __shfl_xor(p[0], 1) + bias;
            const int myE = lane >> 1;
            float tv[4]; int te[4];
#pragma unroll
            for (int k = 0; k < 4; ++k) {
                const float mx = wave_max(val);
                const unsigned long long mk = __ballot(val == mx);
                const int e = (int)(__builtin_ctzll(mk) >> 1);
                tv[k] = mx; te[k] = e; if (myE == e) val = -INFINITY;
            }
            const float e1 = __expf(tv[1] - tv[0]), e2 = __expf(tv[2] - tv[0]), e3 = __expf(tv[3] - tv[0]); const float inv = 1.0f / (1.0f + e1 + e2 + e3);
            if (lane == 0) { pe[tl * 4 + 0] = te[0]; pe[tl * 4 + 1] = te[1]; pe[tl * 4 + 2] = te[2]; pe[tl * 4 + 3] = te[3];
                pw[tl * 4 + 0] = inv; pw[tl * 4 + 1] = e1 * inv; pw[tl * 4 + 2] = e2 * inv; pw[tl * 4 + 3] = e3 * inv; }
        }
        __syncthreads();
        int myexp = 0, lpos = 0;
        if (tid < 256) { myexp = pe[tid]; lpos = __hip_atomic_fetch_add(hist + myexp, 1, __ATOMIC_RELAXED, __HIP_MEMORY_SCOPE_WORKGROUP); }
        __syncthreads();
        if (tid < 32) gbase[tid] = (int)atomicAdd(F.ctl + CW_CNT + 64 * layer + tid, (unsigned)hist[tid]);
        __syncthreads();
        if (tid < 256) { const int pos = gbase[myexp] + lpos; if (pos < LIST_CAP) { lslot[(size_t)myexp * LIST_CAP + pos] = tb * 256 + tid; lw[(size_t)myexp * LIST_CAP + pos] = pw[tid]; } }
        __syncthreads();
    }
}

template <int MODE>
__device__ __forceinline__ void p_combine(Frame& F, int layer, const float* Xin, float* Xout) {
    const int lane = F.lane;
    const float* mod = WSP(F, WS_MOD, float) + (size_t)layer * 6 * D;
    const bf16_t* ys = WSP(F, WS_YSLOT, bf16_t);
    f32x4 gf[4], fnw[4];
#pragma unroll
    for (int j = 0; j < 4; ++j) { gf[j] = *(const f32x4*)(mod + 5 * D + 4 * lane + 256 * j); if (MODE == 1) fnw[j] = *(const f32x4*)(F.in[18] + 4 * lane + 256 * j); }
    const int gw = F.vcu * NWAVES + F.wave, NGW = F.G * NWAVES;
    for (int row = gw; row < T; row += NGW) {
        const f32x4* xr = (const f32x4*)(Xin + (size_t)row * D) + lane;
        f32x4 v[4]; float s = 0.f;
#pragma unroll
        for (int j = 0; j < 4; ++j) {
            f32x4 a = {0.f, 0.f, 0.f, 0.f};
#pragma unroll
            for (int k = 0; k < 4; ++k) { const u32x2 y = *((const u32x2*)(ys + ((size_t)row * 4 + k) * D) + lane + 64 * j); a += (f32x4){bflo(y.x), bfhi(y.x), bflo(y.y), bfhi(y.y)}; }
            v[j] = xr[64 * j] + gf[j] * a;
            s += (v[j].x * v[j].x + v[j].y * v[j].y) + (v[j].z * v[j].z + v[j].w * v[j].w);
        }
        const float rstd = rsqrtf(wave_sum(s) * (1.f / D) + EPS);
        f32x4* o = (f32x4*)(Xout + (size_t)row * D) + lane;
        if (MODE == 0) {
#pragma unroll
            for (int j = 0; j < 4; ++j) o[64 * j] = v[j];
            if (lane == 0) WSP(F, WS_RSTD, float)[row] = rstd;
        } else {
#pragma unroll
            for (int j = 0; j < 4; ++j) o[64 * j] = v[j] * rstd * fnw[j];
        }
    }
}

__device__ __forceinline__ void p_pool(Frame& F, const float* X) {
    const float* mod = WSP(F, WS_MOD, float) + (size_t)1 * 6 * D; const float* rs = WSP(F, WS_RSTD, float); bf16_t* P = WSP(F, WS_HN, bf16_t);
    const int tid = F.tid;
    for (int u = F.vcu; u < 1024; u += F.G) {
        const int tt = u >> 2, g = u & 3, w = 2 << g;
        const int c = g * 256 + (tid & 255), t0 = tt * 64 + (tid >> 8) * 32;
        const float sh = mod[0 * D + c], sc = 1.0f + mod[1 * D + c];
        float sum = 0.f;
        for (int t = t0 - (w - 1); t < t0; ++t) if (t >= 0) sum += X[(size_t)t * D + c] * rs[t] * sc + sh;
        for (int t = t0; t < t0 + 32; ++t) {
            const float h = X[(size_t)t * D + c] * rs[t] * sc + sh;
            sum += h;
            const int cnt = (t + 1 < w) ? (t + 1) : w;
            const float p = sum / (float)cnt - h;
            P[(size_t)t * D + c] = (bf16_t)(cvt_pk_bf16(p, 0.f) & 0xffffu);
            const int tl = t - (w - 1);
            if (tl >= 0) sum -= X[(size_t)tl * D + c] * rs[tl] * sc + sh;
        }
    }
}

constexpr int N_PHASES = 17;
__global__ void __launch_bounds__(NTH, 2) fwd_kernel(Args args) {
    extern __shared__ __attribute__((aligned(16))) unsigned char lds_raw[];
    Frame F;
    F.lds = (LAS unsigned char*)lds_raw;
    F.MISC = (volatile LAS unsigned*)(F.lds + MISC_OFF);
    F.tid = threadIdx.x; F.lane = F.tid & 63; F.wave = __builtin_amdgcn_readfirstlane(F.tid >> 6);
    F.G = gridDim.x; { const int bx = blockIdx.x; F.vcu = (F.G % 8 == 0) ? (bx % 8) * (F.G / 8) + bx / 8 : bx; }
    F.ws = args.ws; F.ctl = (unsigned*)(args.ws + WS_CTL); F.out = args.out;
#pragma unroll
    for (int i = 0; i < 19; ++i) F.in[i] = args.in[i];
    for (int u = F.tid; u < (LDS_BYTES - MISC_OFF) / 4; u += NTH) F.MISC[u] = 0u;
    __syncthreads();
#if N_LAUNCH_MODE == 1
    XcdBarrier bar = xcd_barrier_post(F.ctl + CW_BAR, F.MISC + 8);
#define GRID_BAR() xcd_barrier(bar)
#else
#define GRID_BAR() do { } while (0)
#endif
    const int lo = args.ph_lo, hi = args.ph_hi;
#define IN(k) (lo <= (k) && (k) < hi)
#define SEAM(k) do { if (IN(k) && IN((k) + 1)) GRID_BAR(); } while (0)
    GemmBase gb; gb.G = F.G; gb.vcu = F.vcu;
    float* X1 = WSP(F, WS_X1, float); float* X2 = WSP(F, WS_X2, float);
    const float* mod0 = WSP(F, WS_MOD, float); const float* mod1 = mod0 + 6 * D;

    if (IN(0)) { p0_prologue(F); } SEAM(0);
    if (IN(1)) { p1_norm_in(F); } SEAM(1);
    if (IN(2)) { PolWin P; (GemmBase&)P = gb; P.A = WSP(F, WS_HN, bf16_t); P.Bt = WSP(F, WS_WINT, bf16_t); P.qkvg = WSP(F, WS_QKVG, bf16_t); P.gbuf = WSP(F, WS_GBUF, float);
        P.lb = WSP(F, WS_LB, float); P.rope = WSP(F, WS_ROPE, f32x2); run_gemm(F, P); } SEAM(2);
    if (IN(3)) { p3_recurrence_naive(F); } SEAM(3);
    if (IN(4)) { } SEAM(4);
    if (IN(5)) { p5_headnorm_naive(F); } SEAM(5);
    if (IN(6)) { PolRes P; (GemmBase&)P = gb; P.A = WSP(F, WS_CAT, bf16_t); P.Bt = WSP(F, WS_WOUTT, bf16_t); P.resid = F.in[0]; P.outp = X1; P.gate = mod0 + 2 * D; P.bias = nullptr; P.scale = nullptr;
        P.K = D; P.lda = D; P.nN = 4; P.kcol = 0; run_gemm(F, P); } SEAM(6);
    if (IN(7)) { p_route(F, 0, X1); } SEAM(7);
    if (IN(8)) { expert_tables(F, 0); PolG1 P; (GemmBase&)P = gb; P.MISC = F.MISC; P.hn = WSP(F, WS_HN, bf16_t); P.wgut = WSP(F, WS_WGUT, bf16_t); P.bgu = F.in[15]; P.lslot = WSP(F, WS_LSLOT, int); P.act = WSP(F, WS_ACT, bf16_t);
        run_gemm(F, P); } SEAM(8);
    if (IN(9)) { expert_tables(F, 0); PolG2 P; (GemmBase&)P = gb; P.MISC = F.MISC; P.act = WSP(F, WS_ACT, bf16_t); P.wdnt = WSP(F, WS_WDNT, bf16_t); P.bdn = F.in[17]; P.lslot = WSP(F, WS_LSLOT, int); P.lw = WSP(F, WS_LW, float);
        P.yslot = WSP(F, WS_YSLOT, bf16_t); run_gemm(F, P); } SEAM(9);
    if (IN(10)) { p_combine<0>(F, 0, X1, X2); } SEAM(10);
    if (IN(11)) { p_pool(F, X2); } SEAM(11);
    if (IN(12)) { PolRes P; (GemmBase&)P = gb; P.A = WSP(F, WS_HN, bf16_t); P.Bt = WSP(F, WS_POOLT, bf16_t); P.resid = X2; P.outp = X1; P.gate = mod1 + 2 * D; P.bias = F.in[10]; P.scale = F.in[11];
        P.K = 256; P.lda = D; P.nN = 4; P.kcol = 256; run_gemm(F, P); } SEAM(12);
    if (IN(13)) { p_route(F, 1, X1); } SEAM(13);
    if (IN(14)) { expert_tables(F, 1); PolG1 P; (GemmBase&)P = gb; P.MISC = F.MISC; P.hn = WSP(F, WS_HN, bf16_t); P.wgut = WSP(F, WS_WGUT, bf16_t) + (size_t)NE * 2048 * D; P.bgu = F.in[15] + (size_t)NE * 2048;
        P.lslot = WSP(F, WS_LSLOT, int) + (size_t)NE * LIST_CAP; P.act = WSP(F, WS_ACT, bf16_t); run_gemm(F, P); } SEAM(14);
    if (IN(15)) { expert_tables(F, 1); PolG2 P; (GemmBase&)P = gb; P.MISC = F.MISC; P.act = WSP(F, WS_ACT, bf16_t); P.wdnt = WSP(F, WS_WDNT, bf16_t) + (size_t)NE * D * D; P.bdn = F.in[17] + (size_t)NE * D;
        P.lslot = WSP(F, WS_LSLOT, int) + (size_t)NE * LIST_CAP; P.lw = WSP(F, WS_LW, float) + (size_t)NE * LIST_CAP; P.yslot = WSP(F, WS_YSLOT, bf16_t); run_gemm(F, P); } SEAM(15);
    if (IN(16)) { p_combine<1>(F, 1, X1, F.out); }
#undef IN
#undef SEAM
}

extern "C" void kernel_launch(void* const* d_in, const int* in_sizes, int n_in, void* d_out, int out_size, void* d_ws, size_t ws_size, hipStream_t stream) {
    static int grid = 0;
    if (grid == 0) {
        if (n_in != 19 || out_size != T * D || ws_size < WS_END) { fprintf(stderr, "kernel_launch: unexpected shapes (n_in %d, out %d, ws %zu)\n", n_in, out_size, ws_size); grid = -1; return; }
        int dev = 0, cus = 0, per_cu = 0;
        if (hipGetDevice(&dev) != hipSuccess || hipDeviceGetAttribute(&cus, hipDeviceAttributeMultiprocessorCount, dev) != hipSuccess) { grid = -1; return; }
        if (hipFuncSetAttribute((const void*)fwd_kernel, hipFuncAttributeMaxDynamicSharedMemorySize, LDS_BYTES) != hipSuccess) { fprintf(stderr, "kernel_launch: hipFuncSetAttribute failed\n"); grid = -1; return; }
        if (hipOccupancyMaxActiveBlocksPerMultiprocessor(&per_cu, (const void*)fwd_kernel, NTH, LDS_BYTES) != hipSuccess || per_cu < 1) { fprintf(stderr, "kernel_launch: occupancy query says %d\n", per_cu); }
        (void)hipGetLastError();
        grid = cus;
    }
    if (grid < 0) return;
    (void)hipMemsetAsync((char*)d_ws + WS_CTL, 0, CTL_BYTES, stream);
    Args a{};
    for (int i = 0; i < 19; ++i) a.in[i] = (const float*)d_in[i];
    a.out = (float*)d_out; a.ws = (unsigned char*)d_ws;
#if N_LAUNCH_MODE == 1
    a.ph_lo = 0; a.ph_hi = N_PHASES;
    void* kargs[] = {&a};
    hipError_t e = hipLaunchCooperativeKernel((const void*)fwd_kernel, dim3(grid), dim3(NTH), kargs, LDS_BYTES, stream);
    if (e != hipSuccess) fprintf(stderr, "cooperative launch failed: %s\n", hipGetErrorString(e));
#else
    for (int p = 0; p < N_PHASES; ++p) {
        if (p == 4) continue;
        a.ph_lo = p; a.ph_hi = p + 1;
        hipLaunchKernelGGL(fwd_kernel, dim3(grid), dim3(NTH), LDS_BYTES, stream, a);
    }
#endif
}
```

```cpp
#include <hip/hip_runtime.h>
#include <cstdio>
#include <cstdint>

#ifndef N_LAUNCH_MODE
#define N_LAUNCH_MODE 1
#endif
#ifndef SIMPLE_GEMM
#define SIMPLE_GEMM 1
#endif

#define LAS __attribute__((address_space(3)))
#define GAS __attribute__((address_space(1)))
typedef unsigned short bf16_t;
typedef short bf16x8 __attribute__((ext_vector_type(8)));
typedef float f32x4 __attribute__((ext_vector_type(4)));
typedef float f32x2 __attribute__((ext_vector_type(2)));
typedef unsigned u32x4 __attribute__((ext_vector_type(4)));
typedef unsigned u32x2 __attribute__((ext_vector_type(2)));

constexpr int T = 16384, D = 1024, NE = 32, TOPK = 4, DEPTH = 2;
constexpr int INW = 4096;
constexpr int NTH = 512, NWAVES = 8;
constexpr float EPS = 1e-6f;
constexpr float SW_LIMIT = 7.0f, SW_ALPHA = 1.702f;
constexpr int LIST_CAP = T;
constexpr int ACT_ROWS = T * TOPK + NE * 256;

constexpr size_t MiB = 1u << 20;
constexpr size_t WS_CTL = 0, CTL_BYTES = 1 * MiB;
constexpr size_t WS_MOD = 1 * MiB;
constexpr size_t WS_LB = WS_MOD + 65536;
constexpr size_t WS_ROPE = 2 * MiB;
constexpr size_t WS_WINT = 10 * MiB;
constexpr size_t WS_WOUTT = 18 * MiB;
constexpr size_t WS_POOLT = 20 * MiB;
constexpr size_t WS_LSLOT = 22 * MiB;
constexpr size_t WS_LW = 26 * MiB;
constexpr size_t WS_RSTD = 30 * MiB;
constexpr size_t WS_WGUT = 32 * MiB;
constexpr size_t WS_WDNT = 288 * MiB;
constexpr size_t WS_HN = 416 * MiB;
constexpr size_t WS_QKVG = 448 * MiB;
constexpr size_t WS_GBUF = 576 * MiB;
constexpr size_t WS_KVT = 608 * MiB;
constexpr size_t WS_SPREV = 736 * MiB;
constexpr size_t WS_DEC = 800 * MiB;
constexpr size_t WS_CAT = 802 * MiB;
constexpr size_t WS_X1 = 834 * MiB;
constexpr size_t WS_X2 = 898 * MiB;
constexpr size_t WS_ACT = 962 * MiB;
constexpr size_t WS_YSLOT = 1106 * MiB;
constexpr size_t WS_END = 1234 * MiB;
constexpr int CW_CNT = 64;
constexpr int CW_BAR = 4096;

constexpr int SCR_BYTES = 136 * 1024;
constexpr int MISC_OFF = SCR_BYTES;
constexpr int LDS_BYTES = SCR_BYTES + 4096;

typedef __bf16 bf16x2_t __attribute__((ext_vector_type(2)));
__device__ __forceinline__ unsigned cvt_pk_bf16(float lo, float hi) { const f32x2 v = {lo, hi}; const bf16x2_t b = __builtin_convertvector(v, bf16x2_t); return __builtin_bit_cast(unsigned, b); }
__device__ __forceinline__ float bf2f(unsigned short b) { return __builtin_bit_cast(float, (unsigned)b << 16); }
__device__ __forceinline__ float bflo(unsigned w) { return __builtin_bit_cast(float, w << 16); }
__device__ __forceinline__ float bfhi(unsigned w) { return __builtin_bit_cast(float, w & 0xffff0000u); }
__device__ __forceinline__ float wave_sum(float v) {
#pragma unroll
    for (int o = 1; o < 64; o <<= 1) v += __shfl_xor(v, o);
    return v;
}
__device__ __forceinline__ float wave_max(float v) {
#pragma unroll
    for (int o = 1; o < 64; o <<= 1) v = fmaxf(v, __shfl_xor(v, o));
    return v;
}
__device__ __forceinline__ float sigmoidf_(float x) { return 1.0f / (1.0f + __expf(-x)); }
__device__ __forceinline__ float siluf_(float x) { return x * sigmoidf_(x); }

#define XB_TMO      128
#define XB_XCNT(j)  (256  + 64 * (j))
#define XB_XSUB(j)  (1280 + 64 * (j))
#define XB_XGEN(j)  (2304 + 64 * (j))
#define XB_TOP      3328
#define XB_TOPGEN   3392
#define XCD_BAR_WORDS 3456
#define XB_SPIN_CAP (1u << 20)
__device__ __forceinline__ unsigned xb_ld(unsigned* p)              { return __hip_atomic_load(p, __ATOMIC_RELAXED, __HIP_MEMORY_SCOPE_AGENT); }
__device__ __forceinline__ unsigned xb_add(unsigned* p, unsigned v) { return __hip_atomic_fetch_add(p, v, __ATOMIC_RELAXED, __HIP_MEMORY_SCOPE_AGENT); }
__device__ __forceinline__ unsigned xb_xcc_id() { return (unsigned)__builtin_amdgcn_s_getreg((3 << 11) | 20) & 0xFu; }
#define XB_SPIN(cond, bar) do { unsigned _sp = 0; while (cond) { __builtin_amdgcn_s_sleep(1); \
    if ((++_sp & 255u) == 0u) { if (xb_ld(&(bar)[XB_TMO])) break; if (_sp > XB_SPIN_CAP) { atomicAdd(&(bar)[XB_TMO], 1u); break; } } } } while (0)
struct XcdBarrier { unsigned* bar; unsigned x; volatile LAS unsigned* st; };
__device__ __forceinline__ XcdBarrier xcd_barrier_post(unsigned* bar, volatile LAS unsigned* st) {
    XcdBarrier b; b.bar = bar; b.x = xb_xcc_id(); b.st = st;
    if (threadIdx.x == 0) (void)xb_add(&bar[XB_XCNT(b.x)], 1u);
    return b;
}
__device__ __forceinline__ void xcd_barrier_complete(unsigned* bar, unsigned x, unsigned& nloc, unsigned& nx) {
    const unsigned G = gridDim.x * gridDim.y * gridDim.z;
    unsigned sum, cnt, mine, sp = 0u;
    for (;;) {
        sum = 0u; cnt = 0u; mine = 0u;
#pragma unroll
        for (unsigned j = 0; j < 16; ++j) { const unsigned c = xb_ld(&bar[XB_XCNT(j)]); sum += c; cnt += (c > 0u) ? 1u : 0u; mine = (j == x) ? c : mine; }
        if (sum == G) break;
        __builtin_amdgcn_s_sleep(1);
        if ((++sp & 255u) == 0u) { if (xb_ld(&bar[XB_TMO])) break; if (sp > XB_SPIN_CAP) { atomicAdd(&bar[XB_TMO], 1u); break; } }
    }
    nloc = mine > 0u ? mine : 1u; nx = cnt > 0u ? cnt : 1u;
}
__device__ __forceinline__ void xcd_barrier(const XcdBarrier& b) {
    asm volatile("s_waitcnt vmcnt(0)" ::: "memory");
    __syncthreads();
    if (threadIdx.x == 0) {
        unsigned* bar = b.bar;
        __builtin_amdgcn_s_waitcnt(0);
        unsigned nloc = b.st[0], nx = b.st[1];
        if (nloc == 0u) { xcd_barrier_complete(bar, b.x, nloc, nx); b.st[0] = nloc; b.st[1] = nx; }
        const unsigned old = xb_add(&bar[XB_XSUB(b.x)], 1u);
        const unsigned gen = old / nloc;
        if (old + 1u == (gen + 1u) * nloc) {
            __builtin_amdgcn_fence(__ATOMIC_RELEASE, "agent");
            asm volatile("s_waitcnt vmcnt(0)" ::: "memory");
            const unsigned og = xb_add(&bar[XB_TOP], 1u);
            const unsigned tg = og / nx;
            if (og + 1u == (tg + 1u) * nx) xb_add(&bar[XB_TOPGEN], 1u);
            else XB_SPIN(xb_ld(&bar[XB_TOPGEN]) == tg, bar);
            __builtin_amdgcn_fence(__ATOMIC_ACQUIRE, "agent");
            xb_add(&bar[XB_XGEN(b.x)], 1u);
            asm volatile("s_waitcnt vmcnt(0)" ::: "memory");
        } else {
            XB_SPIN(xb_ld(&bar[XB_XGEN(b.x)]) == gen, bar);
            __builtin_amdgcn_fence(__ATOMIC_ACQUIRE, "agent");
            asm volatile("s_waitcnt vmcnt(0)" ::: "memory");
        }
    }
    __syncthreads();
}

struct Args {
    const float* in[19];
    float* out;
    unsigned char* ws;
    int ph_lo, ph_hi;
};

namespace pg8 {
constexpr int BM = 256, BK = 64, HALF = 128, HTB = HALF * BK * 2;
__host__ __device__ __forceinline__ int lds_byte(int r, int c) { const int st = (r >> 4) * 2 + (c >> 5), rr = r & 15, cc = c & 31, ob = rr * 64 + cc * 2; return st * 1024 + (ob ^ (((ob >> 9) & 1) << 5)); }
__host__ __device__ __forceinline__ void stage_rc(int b, int& R, int& C) { const int st = b / 1024, sb = b % 1024, swz = sb ^ (((sb >> 9) & 1) << 5); R = (st >> 1) * 16 + swz / 64; C = (st & 1) * 32 + (swz % 64) / 2; }
__host__ __device__ __forceinline__ int perm32(int rho) { const int n = rho >> 4, i = rho & 15; return 8 * (i >> 2) + 4 * n + (i & 3); }

struct Unit { const char* A; const char* B; int p0, p1, p2, p3; };

#define PG8_SA(b, h) (((b) * 2 + (h)) * HTB)
#define PG8_SB(b, h) ((4 + (b) * 2 + (h)) * HTB)
#define PG8_LDA(dst, b, h) do { _Pragma("unroll") for (int m = 0; m < 4; ++m) _Pragma("unroll") for (int k = 0; k < 2; ++k) dst[m][k] = *(const LAS bf16x8*)(lds + PG8_SA(b, h) + aoff + m * 2048 + k * 1024); } while (0)
#define PG8_LDB(dst, b, h) do { _Pragma("unroll") for (int n = 0; n < 2; ++n) _Pragma("unroll") for (int k = 0; k < 2; ++k) dst[n][k] = *(const LAS bf16x8*)(lds + PG8_SB(b, h) + boff + n * 2048 + k * 1024); } while (0)
#define PG8_MMA(ai, bj, At, Bt) do { __builtin_amdgcn_s_setprio(1); _Pragma("unroll") for (int m = 0; m < 4; ++m) _Pragma("unroll") for (int n = 0; n < 2; ++n) _Pragma("unroll") for (int k = 0; k < 2; ++k) \
        acc[ai][bj][m][n] = __builtin_amdgcn_mfma_f32_16x16x32_bf16(Bt[n][k], At[m][k], acc[ai][bj][m][n], 0, 0, 0); __builtin_amdgcn_s_setprio(0); } while (0)

template <class P>
__device__ __forceinline__ void gemm_simple(LAS unsigned char* lds, const P& S) {
    const int tid = threadIdx.x, wid = __builtin_amdgcn_readfirstlane(tid >> 6), lane = tid & 63, wr = wid >> 2, wc = wid & 3, fr = lane & 15, fq = lane >> 4;
    const int nt = S.nt();
    int R0, C0; stage_rc(tid * 16, R0, C0);
    unsigned offB[2];
#pragma unroll
    for (int i = 0; i < 2; ++i) { const int R = R0 + 64 * i; const int Rb = (R & ~31) + perm32(R & 31); offB[i] = (unsigned)Rb * S.ldb_bytes() + (unsigned)C0 * 2u; }
    const unsigned bhalf = 128u * S.ldb_bytes();
    const int aoff = lds_byte(wr * 64 + fr, fq * 8), boff = lds_byte(wc * 32 + fr, fq * 8);
    Unit u;
    for (int ui = 0; S.next(ui, u); ++ui) {
        unsigned offA[4]; S.aoff(u, R0, C0, offA);
        f32x4 acc[2][2][4][2];
#pragma unroll
        for (int a = 0; a < 2; ++a)
#pragma unroll
            for (int b = 0; b < 2; ++b)
#pragma unroll
                for (int m = 0; m < 4; ++m)
#pragma unroll
                    for (int n = 0; n < 2; ++n) acc[a][b][m][n] = (f32x4){0.f, 0.f, 0.f, 0.f};
        for (int t = 0; t < nt; ++t) {
            u32x4 ra[4], rb[4];
#pragma unroll
            for (int h = 0; h < 2; ++h)
#pragma unroll
                for (int i = 0; i < 2; ++i) {
                    ra[2 * h + i] = *(const u32x4*)(u.A + offA[2 * h + i] + (size_t)t * 128);
                    rb[2 * h + i] = *(const u32x4*)(u.B + (size_t)h * bhalf + offB[i] + (size_t)t * 128);
                }
            __syncthreads();
#pragma unroll
            for (int h = 0; h < 2; ++h)
#pragma unroll
                for (int i = 0; i < 2; ++i) {
                    *(LAS u32x4*)(lds + PG8_SA(0, h) + tid * 16 + i * 8192) = ra[2 * h + i];
                    *(LAS u32x4*)(lds + PG8_SB(0, h) + tid * 16 + i * 8192) = rb[2 * h + i];
                }
            __syncthreads();
            bf16x8 At[4][2], Bt[2][2];
#pragma unroll
            for (int ai = 0; ai < 2; ++ai) {
                PG8_LDA(At, 0, ai);
#pragma unroll
                for (int bj = 0; bj < 2; ++bj) { PG8_LDB(Bt, 0, bj); PG8_MMA(ai, bj, At, Bt); }
            }
        }
        S.epi(acc, u, wr, wc, fr, fq);
    }
    __syncthreads();
}
}

struct Frame {
    LAS unsigned char* lds;
    volatile LAS unsigned* MISC;
    unsigned* ctl;
    int tid, lane, wave, vcu, G;
    unsigned char* ws;
    float* out;
};
__device__ __forceinline__ const float* inptr(int i) {
    const float* const* ka = (const float* const*)__builtin_amdgcn_kernarg_segment_ptr();
    asm volatile("" : "+s"(ka));
    return ka[i];
}
#define WSP(F, off, type) ((type*)((F).ws + (off)))

template <class RowMap>
__device__ __forceinline__ void transpose_item(const float* W, int K, int N, bf16_t* WT, LAS float* scr, int item, int lane, const RowMap& rm) {
    const int nblk = N / 32, kb = item / nblk, nb = item % nblk, k0 = 64 * kb, n0 = 32 * nb;
#pragma unroll 8
    for (int i = 0; i < 32; ++i) { const int kk = 2 * i + (lane >> 5); scr[kk * 33 + (lane & 31)] = W[(size_t)(k0 + kk) * N + n0 + (lane & 31)]; }
    asm volatile("s_waitcnt lgkmcnt(0)" ::: "memory");
    const int c = lane & 7;
#pragma unroll
    for (int j = 0; j < 4; ++j) { const int n = (lane >> 3) + 8 * j; const LAS float* s = scr + (8 * c) * 33 + n;
        u32x4 o; o.x = cvt_pk_bf16(s[0 * 33], s[1 * 33]); o.y = cvt_pk_bf16(s[2 * 33], s[3 * 33]); o.z = cvt_pk_bf16(s[4 * 33], s[5 * 33]); o.w = cvt_pk_bf16(s[6 * 33], s[7 * 33]);
        *(u32x4*)(WT + (size_t)rm(n0 + n) * K + k0 + 8 * c) = o; }
    asm volatile("s_waitcnt lgkmcnt(0)" ::: "memory");
}
struct RmId { __device__ __forceinline__ int operator()(int n) const { return n; } };
struct RmWin { __device__ __forceinline__ int operator()(int n) const {
        const int s = n >> 9; if (s != 4 && s != 5) return n;
        const int d = n & 127, dd = d & 63; const int p = 8 * (dd >> 2) + (dd & 3) + ((d >> 6) << 2); return n - d + p; } };
struct RmGu { __device__ __forceinline__ int operator()(int n) const { const int half = n >> 10, j = (n & 1023) >> 7, i = n & 127; return 256 * j + 128 * half + i; } };

__device__ __forceinline__ void p0_prologue(Frame& F) {
    const int tid = F.tid;
    {
        LAS float* red = (LAS float*)F.lds;
        const float* c = inptr(1);
        for (int u = F.vcu; u < 192; u += F.G) {
            const int l = u / 96, cg = u % 96, kq = tid >> 4, cq = tid & 15;
            const float* W = inptr(2) + (size_t)l * D * 6 * D + cg * 64 + cq * 4;
            f32x4 a = {0.f, 0.f, 0.f, 0.f};
#pragma unroll 8
            for (int j = 0; j < 32; ++j) { const int k = kq + 32 * j; const float cv = siluf_(c[k]); const f32x4 w = *(const f32x4*)(W + (size_t)k * 6 * D); a += w * cv; }
            __syncthreads();
            *(LAS f32x4*)(red + kq * 64 + cq * 4) = a;
            __syncthreads();
            if (tid < 64) { float s = 0.f;
#pragma unroll 8
                for (int k = 0; k < 32; ++k) s += red[k * 64 + tid];
                const int col = cg * 64 + tid;
                WSP(F, WS_MOD, float)[l * 6 * D + col] = s + inptr(3)[l * 6 * D + col]; }
        }
        __syncthreads();
    }
    if (F.vcu == 0) { const float* hb = inptr(5); const float a = hb[tid], b = hb[512 + tid]; WSP(F, WS_LB, float)[tid] = 1.0f / (1.0f + __expf(b - a)); }
    {
        f32x2* rope = WSP(F, WS_ROPE, f32x2);
        for (int idx = F.vcu * NTH + tid; idx < T * 64; idx += F.G * NTH) {
            const int t = idx >> 6, d = idx & 63;
            const float inv = exp2f(-(float)d * (13.287712379549449f / 64.0f));
            const float ang = (float)t * inv;
            const double a = (double)ang; const double n = __builtin_rint(a * 0.15915494309189535); const double r = __builtin_fma(-n, 6.283185307179586, a);
            const float rf = (float)r;
            rope[idx] = (f32x2){__cosf(rf), __sinf(rf)};
        }
    }
    {
        LAS float* scr = (LAS float*)(F.lds + F.wave * 16384);
        const int gw = F.vcu * NWAVES + F.wave, NGW = F.G * NWAVES;
        constexpr int I_IN = 16 * 128, I_OUT = 16 * 32, I_POOL = 4 * 4 * 8, I_GU = 64 * 16 * 64, I_DN = 64 * 16 * 32;
        constexpr int NITEMS = I_IN + I_OUT + I_POOL + I_GU + I_DN;
        for (int it = gw; it < NITEMS; it += NGW) {
            int r = it;
            if (r < I_IN) { transpose_item(inptr(4), D, INW, WSP(F, WS_WINT, bf16_t), scr, r, F.lane, RmWin()); continue; } r -= I_IN;
            if (r < I_OUT) { transpose_item(inptr(8), D, D, WSP(F, WS_WOUTT, bf16_t), scr, r, F.lane, RmId()); continue; } r -= I_OUT;
            if (r < I_POOL) { const int g = r / 32; transpose_item(inptr(9) + (size_t)g * 65536, 256, 256, WSP(F, WS_POOLT, bf16_t) + (size_t)g * 65536, scr, r % 32, F.lane, RmId()); continue; } r -= I_POOL;
            if (r < I_GU) { const int m = r / 1024; transpose_item(inptr(14) + (size_t)m * D * 2048, D, 2048, WSP(F, WS_WGUT, bf16_t) + (size_t)m * 2048 * D, scr, r % 1024, F.lane, RmGu()); continue; } r -= I_GU;
            { const int m = r / 512; transpose_item(inptr(16) + (size_t)m * D * D, D, D, WSP(F, WS_WDNT, bf16_t) + (size_t)m * D * D, scr, r % 512, F.lane, RmId()); }
        }
    }
}

__device__ __forceinline__ void p1_norm_in(Frame& F) {
    const float* mod = WSP(F, WS_MOD, float);
    f32x4 sh[4], sc[4];
#pragma unroll
    for (int j = 0; j < 4; ++j) { sh[j] = *(const f32x4*)(mod + 0 * D + 4 * F.lane + 256 * j); sc[j] = *(const f32x4*)(mod + 1 * D + 4 * F.lane + 256 * j) + 1.0f; }
    const int gw = F.vcu * NWAVES + F.wave, NGW = F.G * NWAVES;
    for (int row = gw; row < T; row += NGW) {
        const f32x4* xr = (const f32x4*)(inptr(0) + (size_t)row * D) + F.lane;
        f32x4 v[4]; float s = 0.f;
#pragma unroll
        for (int j = 0; j < 4; ++j) { v[j] = xr[64 * j]; s += (v[j].x * v[j].x + v[j].y * v[j].y) + (v[j].z * v[j].z + v[j].w * v[j].w); }
        const float rstd = rsqrtf(wave_sum(s) * (1.f / D) + EPS);
        u32x2* o = (u32x2*)(WSP(F, WS_HN, bf16_t) + (size_t)row * D) + F.lane;
#pragma unroll
        for (int j = 0; j < 4; ++j) { const f32x4 h = v[j] * rstd * sc[j] + sh[j]; o[64 * j] = (u32x2){cvt_pk_bf16(h.x, h.y), cvt_pk_bf16(h.z, h.w)}; }
    }
}

using pg8::Unit;
typedef f32x4 AccT[2][2][4][2];

struct GemmBase {
    int G, vcu;
    __device__ __forceinline__ void aoff_lin(int R0, int C0, unsigned lda_bytes, unsigned (&off)[4]) const {
#pragma unroll
        for (int q = 0; q < 4; ++q) off[q] = (unsigned)(R0 + 64 * (q & 1) + 128 * (q >> 1)) * lda_bytes + (unsigned)C0 * 2u;
    }
};

struct PolWin : GemmBase {
    const bf16_t* A; const bf16_t* Bt; bf16_t* qkvg; float* gbuf; const float* lb; const f32x2* rope;
    __device__ __forceinline__ int nt() const { return D / 64; }
    __device__ __forceinline__ unsigned ldb_bytes() const { return D * 2; }
    __device__ __forceinline__ bool next(int i, Unit& u) const {
        const int V = i * G + vcu; if (V >= 64 * 16) return false;
        u.p0 = V >> 4; u.p1 = V & 15; u.A = (const char*)(A + (size_t)u.p0 * 256 * D); u.B = (const char*)(Bt + (size_t)u.p1 * 256 * D); return true; }
    __device__ __forceinline__ void aoff(const Unit&, int R0, int C0, unsigned (&off)[4]) const { aoff_lin(R0, C0, D * 2, off); }
    __device__ __forceinline__ void epi(const AccT& acc, const Unit& u, int wr, int wc, int fr, int fq) const {
        const int pm = u.p0, pn = u.p1, s = pn >> 1;
        const int row0 = pm * 256 + wr * 64 + fr;
        const int o0 = (pn & 1) * 256 + wc * 32 + 8 * fq;
        const int dbase = (s & 3) * 1024 + (s >> 2) * 512;
#pragma unroll
        for (int ai = 0; ai < 2; ++ai)
#pragma unroll
            for (int m = 0; m < 4; ++m) {
                const int row = row0 + ai * 128 + m * 16;
                bf16_t* orow = qkvg + (size_t)row * INW + dbase;
#pragma unroll
                for (int bj = 0; bj < 2; ++bj) {
                    const int o = o0 + bj * 128;
                    f32x4 v0 = acc[ai][bj][m][0], v1 = acc[ai][bj][m][1];
                    if (s == 4 || s == 5) {
                        const int hd = o & ~127, d0 = 4 * (((o & 127) >> 3));
                        const f32x4* rp = (const f32x4*)(rope + (size_t)row * 64 + d0);
                        const f32x4 c01 = rp[0], c23 = rp[1];
                        const f32x4 cs = {c01.x, c01.z, c23.x, c23.z}, sn = {c01.y, c01.w, c23.y, c23.w};
                        f32x4 o1 = v0 * cs - v1 * sn, o2 = v0 * sn + v1 * cs;
                        if (s == 5) { o1 = o1 * 0.08838834764831845f; o2 = o2 * 0.08838834764831845f; }
                        *(u32x2*)(orow + hd + d0) = (u32x2){cvt_pk_bf16(o1.x, o1.y), cvt_pk_bf16(o1.z, o1.w)};
                        *(u32x2*)(orow + hd + d0 + 64) = (u32x2){cvt_pk_bf16(o2.x, o2.y), cvt_pk_bf16(o2.z, o2.w)};
                    } else {
                        if (s == 0 || s == 3 || s == 7) {
#pragma unroll
                            for (int j = 0; j < 4; ++j) { v0[j] = siluf_(v0[j]); v1[j] = siluf_(v1[j]); }
                        } else if (s == 1) {
                            const f32x4 l0 = *(const f32x4*)(lb + o), l1 = *(const f32x4*)(lb + o + 4);
                            f32x4 g0, g1;
#pragma unroll
                            for (int j = 0; j < 4; ++j) {
                                const float f0 = l0[j] + (1.0f - l0[j]) * sigmoidf_(v0[j]), f1 = l1[j] + (1.0f - l1[j]) * sigmoidf_(v1[j]);
                                g0[j] = __logf(f0); g1[j] = __logf(f1); v0[j] = 1.0f - f0; v1[j] = 1.0f - f1; }
                            float* gr = gbuf + (size_t)row * 512 + o;
                            *(f32x4*)gr = g0; *(f32x4*)(gr + 4) = g1;
                        }
                        u32x4 w; w.x = cvt_pk_bf16(v0[0], v0[1]); w.y = cvt_pk_bf16(v0[2], v0[3]); w.z = cvt_pk_bf16(v1[0], v1[1]); w.w = cvt_pk_bf16(v1[2], v1[3]);
                        *(u32x4*)(orow + o) = w;
                    }
                }
            }
    }
};

struct PolRes : GemmBase {
    const bf16_t* A; const bf16_t* Bt; const float* resid; float* outp; const float* gate; const float* bias; const float* scale;
    int K, lda, nN, kcol;
    __device__ __forceinline__ int nt() const { return K / 64; }
    __device__ __forceinline__ unsigned ldb_bytes() const { return (unsigned)K * 2u; }
    __device__ __forceinline__ bool next(int i, Unit& u) const {
        const int V = i * G + vcu; if (V >= 64 * nN) return false;
        u.p0 = V / nN; u.p1 = V % nN; u.A = (const char*)(A + (size_t)u.p0 * 256 * lda + (size_t)u.p1 * kcol); u.B = (const char*)(Bt + (size_t)u.p1 * 256 * K); return true; }
    __device__ __forceinline__ void aoff(const Unit&, int R0, int C0, unsigned (&off)[4]) const { aoff_lin(R0, C0, (unsigned)lda * 2u, off); }
    __device__ __forceinline__ void epi(const AccT& acc, const Unit& u, int wr, int wc, int fr, int fq) const {
        const int row0 = u.p0 * 256 + wr * 64 + fr, col0 = u.p1 * 256 + wc * 32 + 8 * fq;
#pragma unroll
        for (int bj = 0; bj < 2; ++bj) {
            const int c = col0 + bj * 128;
            const f32x4 g0 = *(const f32x4*)(gate + c), g1 = *(const f32x4*)(gate + c + 4);
            f32x4 b0 = {0.f, 0.f, 0.f, 0.f}, b1 = b0, s0 = {1.f, 1.f, 1.f, 1.f}, s1 = s0;
            if (bias) { b0 = *(const f32x4*)(bias + c); b1 = *(const f32x4*)(bias + c + 4); s0 = *(const f32x4*)(scale + c); s1 = *(const f32x4*)(scale + c + 4); }
#pragma unroll
            for (int ai = 0; ai < 2; ++ai)
#pragma unroll
                for (int m = 0; m < 4; ++m) {
                    const size_t idx = (size_t)(row0 + ai * 128 + m * 16) * D + c;
                    const f32x4 r0 = *(const f32x4*)(resid + idx), r1 = *(const f32x4*)(resid + idx + 4);
                    *(f32x4*)(outp + idx) = r0 + g0 * ((acc[ai][bj][m][0] + b0) * s0);
                    *(f32x4*)(outp + idx + 4) = r1 + g1 * ((acc[ai][bj][m][1] + b1) * s1);
                }
        }
    }
};

constexpr int MI_TPRE = 16, MI_CNT = 64, MI_MT2E = 128;
__device__ __forceinline__ void expert_tables(Frame& F, int layer) {
    if (F.tid == 0) {
        int pre = 0;
        for (int e = 0; e < NE; ++e) {
            int c = (int)__hip_atomic_load(F.ctl + CW_CNT + 64 * layer + e, __ATOMIC_RELAXED, __HIP_MEMORY_SCOPE_AGENT);
            if (c > LIST_CAP) c = LIST_CAP;
            F.MISC[MI_TPRE + e] = pre; F.MISC[MI_CNT + e] = c;
            const int nt_ = (c + 255) >> 8;
            for (int q = 0; q < nt_; ++q) F.MISC[MI_MT2E + pre + q] = e;
            pre += nt_;
        }
        F.MISC[MI_TPRE + NE] = pre;
    }
    __syncthreads();
}
struct PolG1 : GemmBase {
    volatile LAS unsigned* MISC; const bf16_t* hn; const bf16_t* wgut; const float* bgu; const int* lslot; bf16_t* act;
    __device__ __forceinline__ int nt() const { return D / 64; }
    __device__ __forceinline__ unsigned ldb_bytes() const { return D * 2; }
    __device__ __forceinline__ bool next(int i, Unit& u) const {
        const int V = i * G + vcu, MT = (int)MISC[MI_TPRE + NE]; if (V >= MT * 8) return false;
        const int mt = V >> 3, nt_ = V & 7, e = (int)MISC[MI_MT2E + mt];
        u.p0 = e; u.p1 = mt - (int)MISC[MI_TPRE + e]; u.p2 = nt_; u.p3 = mt;
        u.A = (const char*)hn; u.B = (const char*)(wgut + ((size_t)e * 2048 + (size_t)nt_ * 256) * D); return true; }
    __device__ __forceinline__ void aoff(const Unit& u, int R0, int C0, unsigned (&off)[4]) const {
        const int cnt = (int)MISC[MI_CNT + u.p0]; const int* ls = lslot + (size_t)u.p0 * LIST_CAP + u.p1 * 256;
#pragma unroll
        for (int q = 0; q < 4; ++q) { const int r = R0 + 64 * (q & 1) + 128 * (q >> 1); const int tok = (u.p1 * 256 + r < cnt) ? (ls[r] >> 2) : 0; off[q] = (unsigned)tok * (D * 2u) + (unsigned)C0 * 2u; }
    }
    __device__ __forceinline__ void epi(const AccT& acc, const Unit& u, int wr, int wc, int fr, int fq) const {
        const int colg = u.p2 * 128 + wc * 32 + 8 * fq;
        const float* bg = bgu + (size_t)u.p0 * 2048;
        const f32x4 bgl0 = *(const f32x4*)(bg + colg), bgl1 = *(const f32x4*)(bg + colg + 4), bln0 = *(const f32x4*)(bg + 1024 + colg), bln1 = *(const f32x4*)(bg + 1024 + colg + 4);
        bf16_t* base = act + ((size_t)u.p3 * 256 + wr * 64 + fr) * D + colg;
#pragma unroll
        for (int ai = 0; ai < 2; ++ai)
#pragma unroll
            for (int m = 0; m < 4; ++m) {
                f32x4 gl0 = acc[ai][0][m][0] + bgl0, gl1 = acc[ai][0][m][1] + bgl1, ln0 = acc[ai][1][m][0] + bln0, ln1 = acc[ai][1][m][1] + bln1;
                f32x4 a0, a1;
#pragma unroll
                for (int j = 0; j < 4; ++j) {
                    const float x0 = fminf(gl0[j], SW_LIMIT), x1 = fminf(gl1[j], SW_LIMIT);
                    const float y0 = fminf(fmaxf(ln0[j], -SW_LIMIT), SW_LIMIT), y1 = fminf(fmaxf(ln1[j], -SW_LIMIT), SW_LIMIT);
                    a0[j] = x0 * sigmoidf_(SW_ALPHA * x0) * (y0 + 1.0f); a1[j] = x1 * sigmoidf_(SW_ALPHA * x1) * (y1 + 1.0f); }
                u32x4 w; w.x = cvt_pk_bf16(a0[0], a0[1]); w.y = cvt_pk_bf16(a0[2], a0[3]); w.z = cvt_pk_bf16(a1[0], a1[1]); w.w = cvt_pk_bf16(a1[2], a1[3]);
                *(u32x4*)(base + (size_t)(ai * 128 + m * 16) * D) = w;
            }
    }
};
struct PolG2 : GemmBase {
    volatile LAS unsigned* MISC; const bf16_t* act; const bf16_t* wdnt; const float* bdn; const int* lslot; const float* lw; bf16_t* yslot;
    __device__ __forceinline__ int nt() const { return D / 64; }
    __device__ __forceinline__ unsigned ldb_bytes() const { return D * 2; }
    __device__ __forceinline__ bool next(int i, Unit& u) const {
        const int V = i * G + vcu, MT = (int)MISC[MI_TPRE + NE]; if (V >= MT * 4) return false;
        const int mt = V >> 2, nt_ = V & 3, e = (int)MISC[MI_MT2E + mt];
        u.p0 = e; u.p1 = mt - (int)MISC[MI_TPRE + e]; u.p2 = nt_; u.p3 = mt;
        u.A = (const char*)(act + (size_t)mt * 256 * D); u.B = (const char*)(wdnt + ((size_t)e * D + (size_t)nt_ * 256) * D); return true; }
    __device__ __forceinline__ void aoff(const Unit&, int R0, int C0, unsigned (&off)[4]) const { aoff_lin(R0, C0, D * 2, off); }
    __device__ __forceinline__ void epi(const AccT& acc, const Unit& u, int wr, int wc, int fr, int fq) const {
        const int cnt = (int)MISC[MI_CNT + u.p0];
        const int col0 = u.p2 * 256 + wc * 32 + 8 * fq;
        const float* bd = bdn + (size_t)u.p0 * D;
        const int* ls = lslot + (size_t)u.p0 * LIST_CAP; const float* lwp = lw + (size_t)u.p0 * LIST_CAP;
#pragma unroll
        for (int ai = 0; ai < 2; ++ai)
#pragma unroll
            for (int m = 0; m < 4; ++m) {
                const int li = u.p1 * 256 + ai * 128 + wr * 64 + m * 16 + fr;
                if (li < cnt) {
                    const int slot = ls[li]; const float w = lwp[li];
                    bf16_t* yr = yslot + (size_t)slot * D + col0;
#pragma unroll
                    for (int bj = 0; bj < 2; ++bj) {
                        const f32x4 b0 = *(const f32x4*)(bd + col0 + bj * 128), b1 = *(const f32x4*)(bd + col0 + bj * 128 + 4);
                        const f32x4 v0 = (acc[ai][bj][m][0] + b0) * w, v1 = (acc[ai][bj][m][1] + b1) * w;
                        u32x4 o; o.x = cvt_pk_bf16(v0[0], v0[1]); o.y = cvt_pk_bf16(v0[2], v0[3]); o.z = cvt_pk_bf16(v1[0], v1[1]); o.w = cvt_pk_bf16(v1[2], v1[3]);
                        *(u32x4*)(yr + bj * 128) = o;
                    }
                }
            }
    }
};

template <class P> __device__ __forceinline__ void run_gemm(Frame& F, const P& S) {
    pg8::gemm_simple<P>(F.lds, S);
}

constexpr int LA_QA = 0, LA_QH = 17408, LA_KA = 34816, LA_VT = 52224, LA_AS = 70656, LA_ST = 79872, LA_QS = 114688, LA_PS = 118784;
constexpr int RS128 = 272, RS64 = 144;
__device__ __forceinline__ float ret_lg(int hh) { return __logf(1.0f - exp2f(-5.0f - (float)(hh - 4))); }
__device__ __forceinline__ u32x4 pack8(const float (&v)[8]) { return (u32x4){cvt_pk_bf16(v[0], v[1]), cvt_pk_bf16(v[2], v[3]), cvt_pk_bf16(v[4], v[5]), cvt_pk_bf16(v[6], v[7])}; }

__device__ __forceinline__ void la_cumsum(const float* gbuf, int hh, int t0, int d0, float (&b0)[8], float (&b1)[8]) {
    if (hh < 4) { float r0 = 0.f, r1 = 0.f;
#pragma unroll
        for (int i = 0; i < 8; ++i) { const f32x2 g = *(const f32x2*)(gbuf + (size_t)(t0 + i) * 512 + hh * 128 + d0); r0 += g.x; r1 += g.y; b0[i] = r0; b1[i] = r1; }
    } else { const float lg = ret_lg(hh);
#pragma unroll
        for (int i = 0; i < 8; ++i) { b0[i] = (float)(i + 1) * lg; b1[i] = b0[i]; }
    }
}

__device__ __forceinline__ void la_local_state(Frame& F) {
    const bf16_t* qkvg = WSP(F, WS_QKVG, bf16_t); const float* gbuf = WSP(F, WS_GBUF, float); float* kvt = WSP(F, WS_KVT, float); float* dec = WSP(F, WS_DEC, float);
    LAS unsigned char* lds = F.lds; LAS float* qs = (LAS float*)(lds + LA_QS);
    const int lane = F.lane, oc = F.wave, d0 = 2 * lane, fr = lane & 15, fq = lane >> 4;
    for (int unit = F.vcu; unit < 2048; unit += F.G) {
        const int hh = unit >> 8, n = unit & 255, t0 = n * 64 + oc * 8;
        float b0[8], b1[8]; la_cumsum(gbuf, hh, t0, d0, b0, b1);
        *(LAS f32x2*)(qs + oc * 128 + d0) = (f32x2){b0[7], b1[7]};
        unsigned kk[8], vv[8];
#pragma unroll
        for (int i = 0; i < 8; ++i) { const bf16_t* row = qkvg + (size_t)(t0 + i) * INW + hh * 128 + d0; kk[i] = *(const unsigned*)(row + 1024); vv[i] = *(const unsigned*)(row + 2048); }
        __syncthreads();
        float base0 = 0.f, base1 = 0.f, tot0 = 0.f, tot1 = 0.f;
#pragma unroll
        for (int o = 0; o < 8; ++o) { const f32x2 q = *(const LAS f32x2*)(qs + o * 128 + d0); if (o < oc) { base0 += q.x; base1 += q.y; } tot0 += q.x; tot1 += q.y; }
        float a0[8], a1[8], c0[8], c1[8];
#pragma unroll
        for (int i = 0; i < 8; ++i) { a0[i] = bflo(kk[i]) * __expf(tot0 - base0 - b0[i]); a1[i] = bfhi(kk[i]) * __expf(tot1 - base1 - b1[i]); c0[i] = bflo(vv[i]); c1[i] = bfhi(vv[i]); }
        *(LAS u32x4*)(lds + LA_QA + d0 * RS64 + oc * 16) = pack8(a0); *(LAS u32x4*)(lds + LA_QA + (d0 + 1) * RS64 + oc * 16) = pack8(a1);
        *(LAS u32x4*)(lds + LA_VT + d0 * RS64 + oc * 16) = pack8(c0); *(LAS u32x4*)(lds + LA_VT + (d0 + 1) * RS64 + oc * 16) = pack8(c1);
        if (oc == 0) *(f32x2*)(dec + ((size_t)hh * 256 + n) * 128 + d0) = (f32x2){__expf(tot0), __expf(tot1)};
        __syncthreads();
        const int et = oc;
        bf16x8 vt[2];
#pragma unroll
        for (int ks = 0; ks < 2; ++ks) vt[ks] = *(const LAS bf16x8*)(lds + LA_VT + (16 * et + fr) * RS64 + (32 * ks + 8 * fq) * 2);
        float* orow = kvt + (((size_t)hh * 256 + n) * 128 + 16 * et + fr) * 128 + 4 * fq;
#pragma unroll
        for (int dt = 0; dt < 8; ++dt) {
            f32x4 acc = {0.f, 0.f, 0.f, 0.f};
#pragma unroll
            for (int ks = 0; ks < 2; ++ks) { const bf16x8 a = *(const LAS bf16x8*)(lds + LA_QA + (16 * dt + fr) * RS64 + (32 * ks + 8 * fq) * 2); acc = __builtin_amdgcn_mfma_f32_16x16x32_bf16(a, vt[ks], acc, 0, 0, 0); }
            *(f32x4*)(orow + 16 * dt) = acc;
        }
        __syncthreads();
    }
}

__device__ __forceinline__ void la_scan(Frame& F) {
    const float* kvt = WSP(F, WS_KVT, float); const float* dec = WSP(F, WS_DEC, float); bf16_t* sprev = WSP(F, WS_SPREV, bf16_t);
    for (int idx = F.vcu * NTH + F.tid; idx < 8 * 16384; idx += F.G * NTH) {
        const int hh = idx >> 14, rem = idx & 16383, d = rem & 127;
        const float* kv = kvt + (size_t)hh * 256 * 16384 + rem; const float* dc = dec + (size_t)hh * 256 * 128 + d; bf16_t* sp = sprev + (size_t)hh * 256 * 16384 + rem;
        float S = 0.f;
        for (int n0 = 0; n0 < 256; n0 += 8) {
            float kvv[8], dd[8];
#pragma unroll
            for (int i = 0; i < 8; ++i) { kvv[i] = kv[(size_t)(n0 + i) * 16384]; dd[i] = dc[(n0 + i) * 128]; }
#pragma unroll
            for (int i = 0; i < 8; ++i) { sp[(size_t)(n0 + i) * 16384] = (bf16_t)(cvt_pk_bf16(S, 0.f) & 0xffffu); S = dd[i] * S + kvv[i]; }
        }
    }
}

__device__ __forceinline__ void la_output(Frame& F) {
    const bf16_t* qkvg = WSP(F, WS_QKVG, bf16_t); const float* gbuf = WSP(F, WS_GBUF, float); const bf16_t* sprev = WSP(F, WS_SPREV, bf16_t); bf16_t* cat = WSP(F, WS_CAT, bf16_t);
    LAS unsigned char* lds = F.lds; LAS float* qs = (LAS float*)(lds + LA_QS); LAS float* ps = (LAS float*)(lds + LA_PS);
    const int tid = F.tid, lane = F.lane, oc = F.wave, d0 = 2 * lane, fr = lane & 15, fq = lane >> 4;
    for (int unit = F.vcu; unit < 2048; unit += F.G) {
        const int hh = unit >> 8, n = unit & 255, t0 = n * 64 + oc * 8;
        float b0[8], b1[8]; la_cumsum(gbuf, hh, t0, d0, b0, b1);
        *(LAS f32x2*)(qs + oc * 128 + d0) = (f32x2){b0[7], b1[7]};
        unsigned qq[8], kk[8], vv[8];
#pragma unroll
        for (int i = 0; i < 8; ++i) { const bf16_t* row = qkvg + (size_t)(t0 + i) * INW + hh * 128 + d0; qq[i] = *(const unsigned*)row; kk[i] = *(const unsigned*)(row + 1024); vv[i] = *(const unsigned*)(row + 2048); }
        {
            const bf16_t* sp = sprev + ((size_t)hh * 256 + n) * 16384;
#pragma unroll
            for (int j = 0; j < 4; ++j) { const int c = tid + NTH * j, row = c >> 4, c16 = c & 15; *(LAS u32x4*)(lds + LA_ST + row * RS128 + c16 * 16) = *(const u32x4*)(sp + row * 128 + c16 * 8); }
        }
        __syncthreads();
        float base0 = 0.f, base1 = 0.f, bm0 = 0.f, bm1 = 0.f;
#pragma unroll
        for (int o = 0; o < 8; ++o) { const f32x2 q = *(const LAS f32x2*)(qs + o * 128 + d0); if (o < oc) { base0 += q.x; base1 += q.y; } if (o < 4) { bm0 += q.x; bm1 += q.y; } }
        float c0[8], c1[8];
#pragma unroll
        for (int i = 0; i < 8; ++i) {
            const int t = 8 * oc + i; const float bt0 = base0 + b0[i], bt1 = base1 + b1[i];
            const float q0 = bflo(qq[i]), q1 = bfhi(qq[i]), k0 = bflo(kk[i]), k1 = bfhi(kk[i]);
            *(LAS unsigned*)(lds + LA_QA + t * RS128 + d0 * 2) = cvt_pk_bf16(q0 * __expf(bt0 - bm0), q1 * __expf(bt1 - bm1));
            *(LAS unsigned*)(lds + LA_QH + t * RS128 + d0 * 2) = cvt_pk_bf16(q0 * __expf(bt0), q1 * __expf(bt1));
            *(LAS unsigned*)(lds + LA_KA + t * RS128 + d0 * 2) = cvt_pk_bf16(k0 * __expf(bm0 - bt0), k1 * __expf(bm1 - bt1));
            c0[i] = bflo(vv[i]); c1[i] = bfhi(vv[i]);
        }
        *(LAS u32x4*)(lds + LA_VT + d0 * RS64 + oc * 16) = pack8(c0); *(LAS u32x4*)(lds + LA_VT + (d0 + 1) * RS64 + oc * 16) = pack8(c1);
        __syncthreads();
        const int tt = oc >> 1, eh = oc & 1;
        {
            bf16x8 qf[4];
#pragma unroll
            for (int ks = 0; ks < 4; ++ks) qf[ks] = *(const LAS bf16x8*)(lds + LA_QA + (16 * tt + fr) * RS128 + (32 * ks + 8 * fq) * 2);
#pragma unroll
            for (int sti = 0; sti < 2; ++sti) {
                const int st = 2 * eh + sti;
                f32x4 acc = {0.f, 0.f, 0.f, 0.f};
                if (st <= tt) {
#pragma unroll
                    for (int ks = 0; ks < 4; ++ks) { const bf16x8 a = *(const LAS bf16x8*)(lds + LA_KA + (16 * st + fr) * RS128 + (32 * ks + 8 * fq) * 2); acc = __builtin_amdgcn_mfma_f32_16x16x32_bf16(a, qf[ks], acc, 0, 0, 0); }
                    if (st == tt) {
#pragma unroll
                        for (int r = 0; r < 4; ++r) if (4 * fq + r > fr) acc[r] = 0.f;
                    }
                }
                *(LAS u32x2*)(lds + LA_AS + (16 * tt + fr) * RS64 + (16 * st + 4 * fq) * 2) = (u32x2){cvt_pk_bf16(acc[0], acc[1]), cvt_pk_bf16(acc[2], acc[3])};
            }
        }
        __syncthreads();
        f32x4 o[4]; float ss = 0.f;
        {
            bf16x8 af[2], hf[4];
#pragma unroll
            for (int ks = 0; ks < 2; ++ks) af[ks] = *(const LAS bf16x8*)(lds + LA_AS + (16 * tt + fr) * RS64 + (32 * ks + 8 * fq) * 2);
#pragma unroll
            for (int ks = 0; ks < 4; ++ks) hf[ks] = *(const LAS bf16x8*)(lds + LA_QH + (16 * tt + fr) * RS128 + (32 * ks + 8 * fq) * 2);
#pragma unroll
            for (int ei = 0; ei < 4; ++ei) {
                const int et = 4 * eh + ei;
                f32x4 acc = {0.f, 0.f, 0.f, 0.f};
#pragma unroll
                for (int ks = 0; ks < 2; ++ks) { const bf16x8 a = *(const LAS bf16x8*)(lds + LA_VT + (16 * et + fr) * RS64 + (32 * ks + 8 * fq) * 2); acc = __builtin_amdgcn_mfma_f32_16x16x32_bf16(a, af[ks], acc, 0, 0, 0); }
#pragma unroll
                for (int ks = 0; ks < 4; ++ks) { const bf16x8 a = *(const LAS bf16x8*)(lds + LA_ST + (16 * et + fr) * RS128 + (32 * ks + 8 * fq) * 2); acc = __builtin_amdgcn_mfma_f32_16x16x32_bf16(a, hf[ks], acc, 0, 0, 0); }
                o[ei] = acc; ss += (acc[0] * acc[0] + acc[1] * acc[1]) + (acc[2] * acc[2] + acc[3] * acc[3]);
            }
        }
        ss += __shfl_xor(ss, 16); ss += __shfl_xor(ss, 32);
        if (lane < 16) ps[(tt * 2 + eh) * 16 + lane] = ss;
        __syncthreads();
        const float tot = ps[(tt * 2) * 16 + fr] + ps[(tt * 2 + 1) * 16 + fr];
        const float rstd = rsqrtf(tot * (1.f / 128.f) + EPS);
        const float* gain = (hh < 4) ? (inptr(6) + hh * 128) : (inptr(7) + (hh - 4) * 128);
        const size_t rowi = (size_t)(n * 64 + 16 * tt + fr);
#pragma unroll
        for (int ei = 0; ei < 4; ++ei) {
            const int e0 = 16 * (4 * eh + ei) + 4 * fq;
            const f32x4 gn = *(const f32x4*)(gain + e0);
            const u32x2 gt = *(const u32x2*)(qkvg + rowi * INW + 3072 + hh * 128 + e0);
            const f32x4 v = o[ei] * rstd * gn;
            *(u32x2*)(cat + rowi * D + hh * 128 + e0) = (u32x2){cvt_pk_bf16(v[0] * bflo(gt.x), v[1] * bfhi(gt.x)), cvt_pk_bf16(v[2] * bflo(gt.y), v[3] * bfhi(gt.y))};
        }
        __syncthreads();
    }
}

constexpr int WR_STRIDE = 1028;
__device__ __forceinline__ void p_route(Frame& F, int layer, const float* X) {
    const int tid = F.tid, lane = F.lane;
    LAS float* wl = (LAS float*)F.lds;
    LAS int* pe = (LAS int*)(F.lds + 32 * WR_STRIDE * 4);
    LAS float* pw = (LAS float*)(pe + 256);
    LAS int* hist = (LAS int*)(pw + 256);
    LAS int* gbase = hist + 32;
    const float* wr = inptr(12) + (size_t)layer * D * NE;
    for (int idx = tid; idx < D * NE; idx += NTH) { const int c = idx >> 5, e = idx & 31; wl[e * WR_STRIDE + c] = wr[idx]; }
    const float* mod = WSP(F, WS_MOD, float) + (size_t)layer * 6 * D;
    f32x4 sh[4], sc[4];
#pragma unroll
    for (int j = 0; j < 4; ++j) { sh[j] = *(const f32x4*)(mod + 3 * D + 4 * lane + 256 * j); sc[j] = *(const f32x4*)(mod + 4 * D + 4 * lane + 256 * j) + 1.0f; }
    const float bias = inptr(13)[layer * NE + (lane >> 1)];
    int* lslot = WSP(F, WS_LSLOT, int) + (size_t)layer * NE * LIST_CAP; float* lw = WSP(F, WS_LW, float) + (size_t)layer * NE * LIST_CAP;
    __syncthreads();
    for (int tb = F.vcu; tb < T / 64; tb += F.G) {
        if (tid < 32) hist[tid] = 0;
        for (int i = 0; i < 8; ++i) {
            const int tl = F.wave * 8 + i, row = tb * 64 + tl;
            const f32x4* xr = (const f32x4*)(X + (size_t)row * D) + lane;
            f32x4 h[4]; float s = 0.f;
#pragma unroll
            for (int j = 0; j < 4; ++j) { h[j] = xr[64 * j]; s += (h[j].x * h[j].x + h[j].y * h[j].y) + (h[j].z * h[j].z + h[j].w * h[j].w); }
            const float rstd = rsqrtf(wave_sum(s) * (1.f / D) + EPS);
            u32x2* o = (u32x2*)(WSP(F, WS_HN, bf16_t) + (size_t)row * D) + lane;
#pragma unroll
            for (int j = 0; j < 4; ++j) { h[j] = h[j] * rstd * sc[j] + sh[j]; o[64 * j] = (u32x2){cvt_pk_bf16(h[j].x, h[j].y), cvt_pk_bf16(h[j].z, h[j].w)}; }
            float p[32];
#pragma unroll
            for (int eh = 0; eh < 2; ++eh) {
                const LAS float* wb = wl + eh * 16 * WR_STRIDE + 4 * lane;
                asm volatile("" : "+v"(wb));
#pragma unroll
                for (int e = 0; e < 16; ++e) {
                    float a = 0.f;
#pragma unroll
                    for (int j = 0; j < 4; ++j) { const f32x4 w = *(const LAS f32x4*)(wb + e * WR_STRIDE + 256 * j); a += (h[j].x * w.x + h[j].y * w.y) + (h[j].z * w.z + h[j].w * w.w); }
                    p[eh * 16 + e] = a;
                }
            }
#pragma unroll
            for (int st = 0; st < 5; ++st) {
                const int half = 16 >> st, off = 32 >> st; const bool up = (lane & off) != 0;
#pragma unroll
                for (int q = 0; q < half; ++q) { const float send = up ? p[q] : p[q + half]; const float keep = up ? p[q + half] : p[q]; p[q] = keep + __shfl_xor(send, off); }
            }
            float val = p[0] + __shfl_xor(p[0], 1) + bias;
            const int myE = lane >> 1;
            float tv[4]; int te[4];
#pragma unroll
            for (int k = 0; k < 4; ++k) {
                const float mx = wave_max(val);
                const unsigned long long mk = __ballot(val == mx);
                const int e = (int)(__builtin_ctzll(mk) >> 1);
                tv[k] = mx; te[k] = e; if (myE == e) val = -INFINITY;
            }
            const float e1 = __expf(tv[1] - tv[0]), e2 = __expf(tv[2] - tv[0]), e3 = __expf(tv[3] - tv[0]); const float inv = 1.0f / (1.0f + e1 + e2 + e3);
            if (lane == 0) { pe[tl * 4 + 0] = te[0]; pe[tl * 4 + 1] = te[1]; pe[tl * 4 + 2] = te[2]; pe[tl * 4 + 3] = te[3];
                pw[tl * 4 + 0] = inv; pw[tl * 4 + 1] = e1 * inv; pw[tl * 4 + 2] = e2 * inv; pw[tl * 4 + 3] = e3 * inv; }
        }
        __syncthreads();
        int myexp = 0, lpos = 0;
        if (tid < 256) { myexp = pe[tid]; lpos = __hip_atomic_fetch_add(hist + myexp, 1, __ATOMIC_RELAXED, __HIP_MEMORY_SCOPE_WORKGROUP); }
        __syncthreads();
        if (tid < 32) gbase[tid] = (int)atomicAdd(F.ctl + CW_CNT + 64 * layer + tid, (unsigned)hist[tid]);
        __syncthreads();
        if (tid < 256) { const int pos = gbase[myexp] + lpos; if (pos < LIST_CAP) { lslot[(size_t)myexp * LIST_CAP + pos] = tb * 256 + tid; lw[(size_t)myexp * LIST_CAP + pos] = pw[tid]; } }
        __syncthreads();
    }
}

template <int MODE>
__device__ __forceinline__ void p_combine(Frame& F, int layer, const float* Xin, float* Xout) {
    const int lane = F.lane;
    const float* mod = WSP(F, WS_MOD, float) + (size_t)layer * 6 * D;
    const bf16_t* ys = WSP(F, WS_YSLOT, bf16_t);
    f32x4 gf[4], fnw[4];
#pragma unroll
    for (int j = 0; j < 4; ++j) { gf[j] = *(const f32x4*)(mod + 5 * D + 4 * lane + 256 * j); if (MODE == 1) fnw[j] = *(const f32x4*)(inptr(18) + 4 * lane + 256 * j); }
    const int gw = F.vcu * NWAVES + F.wave, NGW = F.G * NWAVES;
    for (int row = gw; row < T; row += NGW) {
        const f32x4* xr = (const f32x4*)(Xin + (size_t)row * D) + lane;
        f32x4 v[4]; float s = 0.f;
#pragma unroll
        for (int j = 0; j < 4; ++j) {
            f32x4 a = {0.f, 0.f, 0.f, 0.f};
#pragma unroll
            for (int k = 0; k < 4; ++k) { const u32x2 y = *((const u32x2*)(ys + ((size_t)row * 4 + k) * D) + lane + 64 * j); a += (f32x4){bflo(y.x), bfhi(y.x), bflo(y.y), bfhi(y.y)}; }
            v[j] = xr[64 * j] + gf[j] * a;
            s += (v[j].x * v[j].x + v[j].y * v[j].y) + (v[j].z * v[j].z + v[j].w * v[j].w);
        }
        const float rstd = rsqrtf(wave_sum(s) * (1.f / D) + EPS);
        f32x4* o = (f32x4*)(Xout + (size_t)row * D) + lane;
        if (MODE == 0) {
#pragma unroll
            for (int j = 0; j < 4; ++j) o[64 * j] = v[j];
            if (lane == 0) WSP(F, WS_RSTD, float)[row] = rstd;
        } else {
#pragma unroll
            for (int j = 0; j < 4; ++j) o[64 * j] = v[j] * rstd * fnw[j];
        }
    }
}

__device__ __forceinline__ void p_pool(Frame& F, const float* X) {
    const float* mod = WSP(F, WS_MOD, float) + (size_t)1 * 6 * D; const float* rs = WSP(F, WS_RSTD, float); bf16_t* P = WSP(F, WS_HN, bf16_t);
    const int tid = F.tid;
    for (int u = F.vcu; u < 1024; u += F.G) {
        const int tt = u >> 2, g = u & 3, w = 2 << g;
        const int c = g * 256 + (tid & 255), t0 = tt * 64 + (tid >> 8) * 32;
        const float sh = mod[0 * D + c], sc = 1.0f + mod[1 * D + c];
        float sum = 0.f;
        for (int t = t0 - (w - 1); t < t0; ++t) if (t >= 0) sum += X[(size_t)t * D + c] * rs[t] * sc + sh;
        for (int t = t0; t < t0 + 32; ++t) {
            const float h = X[(size_t)t * D + c] * rs[t] * sc + sh;
            sum += h;
            const int cnt = (t + 1 < w) ? (t + 1) : w;
            const float p = sum / (float)cnt - h;
            P[(size_t)t * D + c] = (bf16_t)(cvt_pk_bf16(p, 0.f) & 0xffffu);
            const int tl = t - (w - 1);
            if (tl >= 0) sum -= X[(size_t)tl * D + c] * rs[tl] * sc + sh;
        }
    }
}

constexpr int N_PHASES = 17;
__global__ void __launch_bounds__(NTH, 2) fwd_kernel(Args args) {
    extern __shared__ __attribute__((aligned(16))) unsigned char lds_raw[];
    Frame F;
    F.lds = (LAS unsigned char*)lds_raw;
    F.MISC = (volatile LAS unsigned*)(F.lds + MISC_OFF);
    F.tid = threadIdx.x; F.lane = F.tid & 63; F.wave = __builtin_amdgcn_readfirstlane(F.tid >> 6);
    F.G = gridDim.x; { const int bx = blockIdx.x; F.vcu = (F.G % 8 == 0) ? (bx % 8) * (F.G / 8) + bx / 8 : bx; }
    F.ws = args.ws; F.ctl = (unsigned*)(args.ws + WS_CTL); F.out = args.out;
    for (int u = F.tid; u < (LDS_BYTES - MISC_OFF) / 4; u += NTH) F.MISC[u] = 0u;
    __syncthreads();
#if N_LAUNCH_MODE == 1
    XcdBarrier bar = xcd_barrier_post(F.ctl + CW_BAR, F.MISC + 8);
#define GRID_BAR() xcd_barrier(bar)
#else
#define GRID_BAR() do { } while (0)
#endif
    const int lo = args.ph_lo, hi = args.ph_hi;
#define IN(k) (lo <= (k) && (k) < hi)
#define SEAM(k) do { if (IN(k) && IN((k) + 1)) GRID_BAR(); } while (0)
    GemmBase gb; gb.G = F.G; gb.vcu = F.vcu;
    float* X1 = WSP(F, WS_X1, float); float* X2 = WSP(F, WS_X2, float);
    const float* mod0 = WSP(F, WS_MOD, float); const float* mod1 = mod0 + 6 * D;

    if (IN(0)) { p0_prologue(F); } SEAM(0);
    if (IN(1)) { p1_norm_in(F); } SEAM(1);
    if (IN(2)) { PolWin P; (GemmBase&)P = gb; P.A = WSP(F, WS_HN, bf16_t); P.Bt = WSP(F, WS_WINT, bf16_t); P.qkvg = WSP(F, WS_QKVG, bf16_t); P.gbuf = WSP(F, WS_GBUF, float);
        P.lb = WSP(F, WS_LB, float); P.rope = WSP(F, WS_ROPE, f32x2); run_gemm(F, P); } SEAM(2);
    if (IN(3)) { la_local_state(F); } SEAM(3);
    if (IN(4)) { la_scan(F); } SEAM(4);
    if (IN(5)) { la_output(F); } SEAM(5);
    if (IN(6)) { PolRes P; (GemmBase&)P = gb; P.A = WSP(F, WS_CAT, bf16_t); P.Bt = WSP(F, WS_WOUTT, bf16_t); P.resid = inptr(0); P.outp = X1; P.gate = mod0 + 2 * D; P.bias = nullptr; P.scale = nullptr;
        P.K = D; P.lda = D; P.nN = 4; P.kcol = 0; run_gemm(F, P); } SEAM(6);
    if (IN(7)) { p_route(F, 0, X1); } SEAM(7);
    if (IN(8)) { expert_tables(F, 0); PolG1 P; (GemmBase&)P = gb; P.MISC = F.MISC; P.hn = WSP(F, WS_HN, bf16_t); P.wgut = WSP(F, WS_WGUT, bf16_t); P.bgu = inptr(15); P.lslot = WSP(F, WS_LSLOT, int); P.act = WSP(F, WS_ACT, bf16_t);
        run_gemm(F, P); } SEAM(8);
    if (IN(9)) { expert_tables(F, 0); PolG2 P; (GemmBase&)P = gb; P.MISC = F.MISC; P.act = WSP(F, WS_ACT, bf16_t); P.wdnt = WSP(F, WS_WDNT, bf16_t); P.bdn = inptr(17); P.lslot = WSP(F, WS_LSLOT, int); P.lw = WSP(F, WS_LW, float);
        P.yslot = WSP(F, WS_YSLOT, bf16_t); run_gemm(F, P); } SEAM(9);
    if (IN(10)) { p_combine<0>(F, 0, X1, X2); } SEAM(10);
    if (IN(11)) { p_pool(F, X2); } SEAM(11);
    if (IN(12)) { PolRes P; (GemmBase&)P = gb; P.A = WSP(F, WS_HN, bf16_t); P.Bt = WSP(F, WS_POOLT, bf16_t); P.resid = X2; P.outp = X1; P.gate = mod1 + 2 * D; P.bias = inptr(10); P.scale = inptr(11);
        P.K = 256; P.lda = D; P.nN = 4; P.kcol = 256; run_gemm(F, P); } SEAM(12);
    if (IN(13)) { p_route(F, 1, X1); } SEAM(13);
    if (IN(14)) { expert_tables(F, 1); PolG1 P; (GemmBase&)P = gb; P.MISC = F.MISC; P.hn = WSP(F, WS_HN, bf16_t); P.wgut = WSP(F, WS_WGUT, bf16_t) + (size_t)NE * 2048 * D; P.bgu = inptr(15) + (size_t)NE * 2048;
        P.lslot = WSP(F, WS_LSLOT, int) + (size_t)NE * LIST_CAP; P.act = WSP(F, WS_ACT, bf16_t); run_gemm(F, P); } SEAM(14);
    if (IN(15)) { expert_tables(F, 1); PolG2 P; (GemmBase&)P = gb; P.MISC = F.MISC; P.act = WSP(F, WS_ACT, bf16_t); P.wdnt = WSP(F, WS_WDNT, bf16_t) + (size_t)NE * D * D; P.bdn = inptr(17) + (size_t)NE * D;
        P.lslot = WSP(F, WS_LSLOT, int) + (size_t)NE * LIST_CAP; P.lw = WSP(F, WS_LW, float) + (size_t)NE * LIST_CAP; P.yslot = WSP(F, WS_YSLOT, bf16_t); run_gemm(F, P); } SEAM(15);
    if (IN(16)) { p_combine<1>(F, 1, X1, F.out); }
#undef IN
#undef SEAM
}

extern "C" void kernel_launch(void* const* d_in, const int* in_sizes, int n_in, void* d_out, int out_size, void* d_ws, size_t ws_size, hipStream_t stream) {
    static int grid = 0;
    if (grid == 0) {
        if (n_in != 19 || out_size != T * D || ws_size < WS_END) { fprintf(stderr, "kernel_launch: unexpected shapes (n_in %d, out %d, ws %zu)\n", n_in, out_size, ws_size); grid = -1; return; }
        int dev = 0, cus = 0, per_cu = 0;
        if (hipGetDevice(&dev) != hipSuccess || hipDeviceGetAttribute(&cus, hipDeviceAttributeMultiprocessorCount, dev) != hipSuccess) { grid = -1; return; }
        if (hipFuncSetAttribute((const void*)fwd_kernel, hipFuncAttributeMaxDynamicSharedMemorySize, LDS_BYTES) != hipSuccess) { fprintf(stderr, "kernel_launch: hipFuncSetAttribute failed\n"); grid = -1; return; }
        if (hipOccupancyMaxActiveBlocksPerMultiprocessor(&per_cu, (const void*)fwd_kernel, NTH, LDS_BYTES) != hipSuccess || per_cu < 1) { fprintf(stderr, "kernel_launch: occupancy query says %d\n", per_cu); }
        (void)hipGetLastError();
        grid = cus;
    }
    if (grid < 0) return;
    (void)hipMemsetAsync((char*)d_ws + WS_CTL, 0, CTL_BYTES, stream);
    Args a{};
    for (int i = 0; i < 19; ++i) a.in[i] = (const float*)d_in[i];
    a.out = (float*)d_out; a.ws = (unsigned char*)d_ws;
#if N_LAUNCH_MODE == 1
    a.ph_lo = 0; a.ph_hi = N_PHASES;
    void* kargs[] = {&a};
    hipError_t e = hipLaunchCooperativeKernel((const void*)fwd_kernel, dim3(grid), dim3(NTH), kargs, LDS_BYTES, stream);
    if (e != hipSuccess) fprintf(stderr, "cooperative launch failed: %s\n", hipGetErrorString(e));
#else
    for (int p = 0; p < N_PHASES; ++p) {
        a.ph_lo = p; a.ph_hi = p + 1;
        hipLaunchKernelGGL(fwd_kernel, dim3(grid), dim3(NTH), LDS_BYTES, stream, a);
    }
#endif
}
```

```cpp
#include <hip/hip_runtime.h>
#include <cstdio>
#include <cstdint>

#ifndef N_LAUNCH_MODE
#define N_LAUNCH_MODE 1
#endif
#ifndef SIMPLE_GEMM
#define SIMPLE_GEMM 0
#endif

#define LAS __attribute__((address_space(3)))
#define GAS __attribute__((address_space(1)))
typedef unsigned short bf16_t;
typedef short bf16x8 __attribute__((ext_vector_type(8)));
typedef float f32x4 __attribute__((ext_vector_type(4)));
typedef float f32x2 __attribute__((ext_vector_type(2)));
typedef unsigned u32x4 __attribute__((ext_vector_type(4)));
typedef unsigned u32x2 __attribute__((ext_vector_type(2)));

constexpr int T = 16384, D = 1024, NE = 32, TOPK = 4, DEPTH = 2;
constexpr int INW = 4096;
constexpr int NTH = 512, NWAVES = 8;
constexpr float EPS = 1e-6f;
constexpr float SW_LIMIT = 7.0f, SW_ALPHA = 1.702f;
constexpr int LIST_CAP = T;
constexpr int ACT_ROWS = T * TOPK + NE * 256;

constexpr size_t MiB = 1u << 20;
constexpr size_t WS_CTL = 0, CTL_BYTES = 1 * MiB;
constexpr size_t WS_MOD = 1 * MiB;
constexpr size_t WS_LB = WS_MOD + 65536;
constexpr size_t WS_ROPE = 2 * MiB;
constexpr size_t WS_WINT = 10 * MiB;
constexpr size_t WS_WOUTT = 18 * MiB;
constexpr size_t WS_POOLT = 20 * MiB;
constexpr size_t WS_LSLOT = 22 * MiB;
constexpr size_t WS_LW = 26 * MiB;
constexpr size_t WS_RSTD = 30 * MiB;
constexpr size_t WS_WGUT = 32 * MiB;
constexpr size_t WS_WDNT = 288 * MiB;
constexpr size_t WS_HN = 416 * MiB;
constexpr size_t WS_QKVG = 448 * MiB;
constexpr size_t WS_GBUF = 576 * MiB;
constexpr size_t WS_KVT = 608 * MiB;
constexpr size_t WS_SPREV = 736 * MiB;
constexpr size_t WS_DEC = 800 * MiB;
constexpr size_t WS_CAT = 802 * MiB;
constexpr size_t WS_X1 = 834 * MiB;
constexpr size_t WS_X2 = 898 * MiB;
constexpr size_t WS_ACT = 962 * MiB;
constexpr size_t WS_YSLOT = 1106 * MiB;
constexpr size_t WS_END = 1234 * MiB;
constexpr int CW_CNT = 64;
constexpr int CW_BAR = 4096;

constexpr int SCR_BYTES = 136 * 1024;
constexpr int MISC_OFF = SCR_BYTES;
constexpr int LDS_BYTES = SCR_BYTES + 4096;

typedef __bf16 bf16x2_t __attribute__((ext_vector_type(2)));
__device__ __forceinline__ unsigned cvt_pk_bf16(float lo, float hi) { const f32x2 v = {lo, hi}; const bf16x2_t b = __builtin_convertvector(v, bf16x2_t); return __builtin_bit_cast(unsigned, b); }
__device__ __forceinline__ float bf2f(unsigned short b) { return __builtin_bit_cast(float, (unsigned)b << 16); }
__device__ __forceinline__ float bflo(unsigned w) { return __builtin_bit_cast(float, w << 16); }
__device__ __forceinline__ float bfhi(unsigned w) { return __builtin_bit_cast(float, w & 0xffff0000u); }
__device__ __forceinline__ float wave_sum(float v) {
#pragma unroll
    for (int o = 1; o < 64; o <<= 1) v += __shfl_xor(v, o);
    return v;
}
__device__ __forceinline__ float wave_max(float v) {
#pragma unroll
    for (int o = 1; o < 64; o <<= 1) v = fmaxf(v, __shfl_xor(v, o));
    return v;
}
__device__ __forceinline__ float sigmoidf_(float x) { return 1.0f / (1.0f + __expf(-x)); }
__device__ __forceinline__ float siluf_(float x) { return x * sigmoidf_(x); }

#define XB_TMO      128
#define XB_XCNT(j)  (256  + 64 * (j))
#define XB_XSUB(j)  (1280 + 64 * (j))
#define XB_XGEN(j)  (2304 + 64 * (j))
#define XB_TOP      3328
#define XB_TOPGEN   3392
#define XCD_BAR_WORDS 3456
#define XB_SPIN_CAP (1u << 20)
__device__ __forceinline__ unsigned xb_ld(unsigned* p)              { return __hip_atomic_load(p, __ATOMIC_RELAXED, __HIP_MEMORY_SCOPE_AGENT); }
__device__ __forceinline__ unsigned xb_add(unsigned* p, unsigned v) { return __hip_atomic_fetch_add(p, v, __ATOMIC_RELAXED, __HIP_MEMORY_SCOPE_AGENT); }
__device__ __forceinline__ unsigned xb_xcc_id() { return (unsigned)__builtin_amdgcn_s_getreg((3 << 11) | 20) & 0xFu; }
#define XB_SPIN(cond, bar) do { unsigned _sp = 0; while (cond) { __builtin_amdgcn_s_sleep(1); \
    if ((++_sp & 255u) == 0u) { if (xb_ld(&(bar)[XB_TMO])) break; if (_sp > XB_SPIN_CAP) { atomicAdd(&(bar)[XB_TMO], 1u); break; } } } } while (0)
struct XcdBarrier { unsigned* bar; unsigned x; volatile LAS unsigned* st; };
__device__ __forceinline__ XcdBarrier xcd_barrier_post(unsigned* bar, volatile LAS unsigned* st) {
    XcdBarrier b; b.bar = bar; b.x = xb_xcc_id(); b.st = st;
    if (threadIdx.x == 0) (void)xb_add(&bar[XB_XCNT(b.x)], 1u);
    return b;
}
__device__ __forceinline__ void xcd_barrier_complete(unsigned* bar, unsigned x, unsigned& nloc, unsigned& nx) {
    const unsigned G = gridDim.x * gridDim.y * gridDim.z;
    unsigned sum, cnt, mine, sp = 0u;
    for (;;) {
        sum = 0u; cnt = 0u; mine = 0u;
#pragma unroll
        for (unsigned j = 0; j < 16; ++j) { const unsigned c = xb_ld(&bar[XB_XCNT(j)]); sum += c; cnt += (c > 0u) ? 1u : 0u; mine = (j == x) ? c : mine; }
        if (sum == G) break;
        __builtin_amdgcn_s_sleep(1);
        if ((++sp & 255u) == 0u) { if (xb_ld(&bar[XB_TMO])) break; if (sp > XB_SPIN_CAP) { atomicAdd(&bar[XB_TMO], 1u); break; } }
    }
    nloc = mine > 0u ? mine : 1u; nx = cnt > 0u ? cnt : 1u;
}
__device__ __forceinline__ void xcd_barrier(const XcdBarrier& b) {
    asm volatile("s_waitcnt vmcnt(0)" ::: "memory");
    __syncthreads();
    if (threadIdx.x == 0) {
        unsigned* bar = b.bar;
        __builtin_amdgcn_s_waitcnt(0);
        unsigned nloc = b.st[0], nx = b.st[1];
        if (nloc == 0u) { xcd_barrier_complete(bar, b.x, nloc, nx); b.st[0] = nloc; b.st[1] = nx; }
        const unsigned old = xb_add(&bar[XB_XSUB(b.x)], 1u);
        const unsigned gen = old / nloc;
        if (old + 1u == (gen + 1u) * nloc) {
            __builtin_amdgcn_fence(__ATOMIC_RELEASE, "agent");
            asm volatile("s_waitcnt vmcnt(0)" ::: "memory");
            const unsigned og = xb_add(&bar[XB_TOP], 1u);
            const unsigned tg = og / nx;
            if (og + 1u == (tg + 1u) * nx) xb_add(&bar[XB_TOPGEN], 1u);
            else XB_SPIN(xb_ld(&bar[XB_TOPGEN]) == tg, bar);
            __builtin_amdgcn_fence(__ATOMIC_ACQUIRE, "agent");
            xb_add(&bar[XB_XGEN(b.x)], 1u);
            asm volatile("s_waitcnt vmcnt(0)" ::: "memory");
        } else {
            XB_SPIN(xb_ld(&bar[XB_XGEN(b.x)]) == gen, bar);
            __builtin_amdgcn_fence(__ATOMIC_ACQUIRE, "agent");
            asm volatile("s_waitcnt vmcnt(0)" ::: "memory");
        }
    }
    __syncthreads();
}

struct Args {
    const float* in[19];
    float* out;
    unsigned char* ws;
    int ph_lo, ph_hi;
};

namespace pg8 {
constexpr int BM = 256, BK = 64, HALF = 128, HTB = HALF * BK * 2;
__host__ __device__ __forceinline__ int lds_byte(int r, int c) { const int st = (r >> 4) * 2 + (c >> 5), rr = r & 15, cc = c & 31, ob = rr * 64 + cc * 2; return st * 1024 + (ob ^ (((ob >> 9) & 1) << 5)); }
__host__ __device__ __forceinline__ void stage_rc(int b, int& R, int& C) { const int st = b / 1024, sb = b % 1024, swz = sb ^ (((sb >> 9) & 1) << 5); R = (st >> 1) * 16 + swz / 64; C = (st & 1) * 32 + (swz % 64) / 2; }
__host__ __device__ __forceinline__ int perm32(int rho) { const int n = rho >> 4, i = rho & 15; return 8 * (i >> 2) + 4 * n + (i & 3); }

struct Unit { const char* A; const char* B; int p0, p1, p2, p3; };

#define PG8_SA(b, h) (((b) * 2 + (h)) * HTB)
#define PG8_SB(b, h) ((4 + (b) * 2 + (h)) * HTB)
#define PG8_LDA(dst, b, h) do { _Pragma("unroll") for (int m = 0; m < 4; ++m) _Pragma("unroll") for (int k = 0; k < 2; ++k) dst[m][k] = *(const LAS bf16x8*)(lds + PG8_SA(b, h) + aoff + m * 2048 + k * 1024); } while (0)
#define PG8_LDB(dst, b, h) do { _Pragma("unroll") for (int n = 0; n < 2; ++n) _Pragma("unroll") for (int k = 0; k < 2; ++k) dst[n][k] = *(const LAS bf16x8*)(lds + PG8_SB(b, h) + boff + n * 2048 + k * 1024); } while (0)
#define PG8_MMA(ai, bj, At, Bt) do { __builtin_amdgcn_s_setprio(1); _Pragma("unroll") for (int m = 0; m < 4; ++m) _Pragma("unroll") for (int n = 0; n < 2; ++n) _Pragma("unroll") for (int k = 0; k < 2; ++k) \
        acc[ai][bj][m][n] = __builtin_amdgcn_mfma_f32_16x16x32_bf16(Bt[n][k], At[m][k], acc[ai][bj][m][n], 0, 0, 0); __builtin_amdgcn_s_setprio(0); } while (0)

template <class P>
__device__ __forceinline__ void gemm_simple(LAS unsigned char* lds, const P& S) {
    const int tid = threadIdx.x, wid = __builtin_amdgcn_readfirstlane(tid >> 6), lane = tid & 63, wr = wid >> 2, wc = wid & 3, fr = lane & 15, fq = lane >> 4;
    const int nt = S.nt();
    int R0, C0; stage_rc(tid * 16, R0, C0);
    unsigned offB[2];
#pragma unroll
    for (int i = 0; i < 2; ++i) { const int R = R0 + 64 * i; const int Rb = (R & ~31) + perm32(R & 31); offB[i] = (unsigned)Rb * S.ldb_bytes() + (unsigned)C0 * 2u; }
    const unsigned bhalf = 128u * S.ldb_bytes();
    const int aoff = lds_byte(wr * 64 + fr, fq * 8), boff = lds_byte(wc * 32 + fr, fq * 8);
    Unit u;
    for (int ui = 0; S.next(ui, u); ++ui) {
        unsigned offA[4]; S.aoff(u, R0, C0, offA);
        f32x4 acc[2][2][4][2];
#pragma unroll
        for (int a = 0; a < 2; ++a)
#pragma unroll
            for (int b = 0; b < 2; ++b)
#pragma unroll
                for (int m = 0; m < 4; ++m)
#pragma unroll
                    for (int n = 0; n < 2; ++n) acc[a][b][m][n] = (f32x4){0.f, 0.f, 0.f, 0.f};
        for (int t = 0; t < nt; ++t) {
            u32x4 ra[4], rb[4];
#pragma unroll
            for (int h = 0; h < 2; ++h)
#pragma unroll
                for (int i = 0; i < 2; ++i) {
                    ra[2 * h + i] = *(const u32x4*)(u.A + offA[2 * h + i] + (size_t)t * 128);
                    rb[2 * h + i] = *(const u32x4*)(u.B + (size_t)h * bhalf + offB[i] + (size_t)t * 128);
                }
            __syncthreads();
#pragma unroll
            for (int h = 0; h < 2; ++h)
#pragma unroll
                for (int i = 0; i < 2; ++i) {
                    *(LAS u32x4*)(lds + PG8_SA(0, h) + tid * 16 + i * 8192) = ra[2 * h + i];
                    *(LAS u32x4*)(lds + PG8_SB(0, h) + tid * 16 + i * 8192) = rb[2 * h + i];
                }
            __syncthreads();
            bf16x8 At[4][2], Bt[2][2];
#pragma unroll
            for (int ai = 0; ai < 2; ++ai) {
                PG8_LDA(At, 0, ai);
#pragma unroll
                for (int bj = 0; bj < 2; ++bj) { PG8_LDB(Bt, 0, bj); PG8_MMA(ai, bj, At, Bt); }
            }
        }
        S.epi(acc, u, wr, wc, fr, fq);
    }
    __syncthreads();
}

template <class P>
__device__ __forceinline__ void gemm_pipe(LAS unsigned char* lds, const P& S) {
    const int tid = threadIdx.x, wid = __builtin_amdgcn_readfirstlane(tid >> 6), lane = tid & 63, wr = wid >> 2, wc = wid & 3, fr = lane & 15, fq = lane >> 4;
    const int nt = S.nt();
    int R0, C0; stage_rc(tid * 16, R0, C0);
    unsigned offB[2];
#pragma unroll
    for (int i = 0; i < 2; ++i) { const int R = R0 + 64 * i; const int Rb = (R & ~31) + perm32(R & 31); offB[i] = (unsigned)Rb * S.ldb_bytes() + (unsigned)C0 * 2u; }
    const size_t bhalf = (size_t)128u * S.ldb_bytes();
    const size_t kstep = 128;
    const unsigned ldsw = (unsigned)wid * 1024u;
    const int aoff = lds_byte(wr * 64 + fr, fq * 8), boff = lds_byte(wc * 32 + fr, fq * 8);
#define PG8_STAGE_A(bufoff, gbase, OFF, h) do { _Pragma("unroll") for (int _i = 0; _i < 2; ++_i) \
        __builtin_amdgcn_global_load_lds((const unsigned*)((const char*)(gbase) + (OFF)[2 * (h) + _i]), (LAS unsigned*)(lds + (bufoff) + ldsw + _i * 8192), 16, 0, 0); } while (0)
#define PG8_STAGE_B(bufoff, gbase) do { _Pragma("unroll") for (int _i = 0; _i < 2; ++_i) \
        __builtin_amdgcn_global_load_lds((const unsigned*)((const char*)(gbase) + offB[_i]), (LAS unsigned*)(lds + (bufoff) + ldsw + _i * 8192), 16, 0, 0); } while (0)
#define PG8_WAIT_V(n) asm volatile("s_waitcnt vmcnt(" #n ")" ::: "memory")
#define PG8_WAIT_L(n) asm volatile("s_waitcnt lgkmcnt(" #n ")" ::: "memory")
#define PG8_BAR __builtin_amdgcn_s_barrier()
#define PG8_SCHED __builtin_amdgcn_sched_barrier(0)
    Unit cur, nxt; int ui = 0;
    if (!S.next(0, cur)) return;
    f32x4 acc[2][2][4][2];
#pragma unroll
    for (int a = 0; a < 2; ++a)
#pragma unroll
        for (int b = 0; b < 2; ++b)
#pragma unroll
            for (int m = 0; m < 4; ++m)
#pragma unroll
                for (int n = 0; n < 2; ++n) acc[a][b][m][n] = (f32x4){0.f, 0.f, 0.f, 0.f};
    bf16x8 At[4][2], B0[2][2], B1[2][2];
    unsigned offC[4], offN[4];
    S.aoff(cur, R0, C0, offC);
    const char* cA = cur.A; const char* cB = cur.B;
    PG8_STAGE_B(PG8_SB(0, 0), cB); PG8_STAGE_B(PG8_SB(0, 1), cB + bhalf); PG8_STAGE_A(PG8_SA(0, 0), cA, offC, 0); PG8_STAGE_A(PG8_SA(0, 1), cA, offC, 1);
    if (wr == 1) PG8_BAR;
    PG8_WAIT_V(2); PG8_BAR;
    PG8_STAGE_B(PG8_SB(1, 0), cB + kstep); PG8_STAGE_A(PG8_SA(1, 0), cA + kstep, offC, 0); PG8_STAGE_B(PG8_SB(1, 1), cB + bhalf + kstep);
    PG8_WAIT_V(6); PG8_BAR;
    for (;;) {
        const bool has_next = S.next(ui + 1, nxt);
        if (has_next) S.aoff(nxt, R0, C0, offN);
        else {
#pragma unroll
            for (int q = 0; q < 4; ++q) offN[q] = offC[q];
        }
        const char* nA = has_next ? nxt.A : cA; const char* nB = has_next ? nxt.B : cB;
        for (int t = 0; t < nt; t += 2) {
            const bool last = (t == nt - 2);
            const char* a1 = cA + (size_t)(t + 1) * kstep;
            const char* a2 = last ? nA : cA + (size_t)(t + 2) * kstep; const char* b2 = last ? nB : cB + (size_t)(t + 2) * kstep;
            const char* a3 = a2 + kstep; const char* b3 = b2 + kstep;
            unsigned o2[4];
#pragma unroll
            for (int q = 0; q < 4; ++q) o2[q] = last ? offN[q] : offC[q];
            PG8_LDB(B0, 0, 0); PG8_LDB(B1, 0, 1); PG8_SCHED; PG8_LDA(At, 0, 0); PG8_STAGE_A(PG8_SA(1, 1), a1, offC, 1);
            PG8_WAIT_V(8); PG8_WAIT_L(0); PG8_BAR; PG8_MMA(0, 0, At, B0); PG8_MMA(0, 1, At, B1); PG8_BAR; PG8_SCHED;
            PG8_LDA(At, 0, 1); PG8_STAGE_B(PG8_SB(0, 0), b2); PG8_STAGE_B(PG8_SB(0, 1), b2 + bhalf); PG8_STAGE_A(PG8_SA(0, 0), a2, o2, 0);
            PG8_WAIT_V(8); PG8_WAIT_L(0); PG8_BAR; PG8_MMA(1, 0, At, B0); PG8_MMA(1, 1, At, B1); PG8_BAR; PG8_SCHED;
            PG8_LDB(B0, 1, 0); PG8_LDB(B1, 1, 1); PG8_SCHED; PG8_LDA(At, 1, 0); PG8_STAGE_A(PG8_SA(0, 1), a2, o2, 1);
            PG8_WAIT_V(8); PG8_WAIT_L(0); PG8_BAR; PG8_MMA(0, 0, At, B0); PG8_MMA(0, 1, At, B1); PG8_BAR; PG8_SCHED;
            PG8_LDA(At, 1, 1); PG8_STAGE_B(PG8_SB(1, 0), b3); PG8_STAGE_B(PG8_SB(1, 1), b3 + bhalf); PG8_STAGE_A(PG8_SA(1, 0), a3, o2, 0);
            PG8_WAIT_V(8); PG8_WAIT_L(0); PG8_BAR; PG8_MMA(1, 0, At, B0); PG8_MMA(1, 1, At, B1); PG8_BAR; PG8_SCHED;
        }
        if (wr == 0) PG8_BAR;
        S.epi(acc, cur, wr, wc, fr, fq);
        if (!has_next) break;
#pragma unroll
        for (int a = 0; a < 2; ++a)
#pragma unroll
            for (int b = 0; b < 2; ++b)
#pragma unroll
                for (int m = 0; m < 4; ++m)
#pragma unroll
                    for (int n = 0; n < 2; ++n) acc[a][b][m][n] = (f32x4){0.f, 0.f, 0.f, 0.f};
        cur = nxt; cA = nA; cB = nB; ++ui;
#pragma unroll
        for (int q = 0; q < 4; ++q) offC[q] = offN[q];
        if (wr == 1) PG8_BAR;
    }
    PG8_WAIT_V(0);
    PG8_BAR;
#undef PG8_STAGE_A
#undef PG8_STAGE_B
#undef PG8_WAIT_V
#undef PG8_WAIT_L
#undef PG8_BAR
#undef PG8_SCHED
}
}

struct Frame {
    LAS unsigned char* lds;
    volatile LAS unsigned* MISC;
    unsigned* ctl;
    int tid, lane, wave, vcu, G;
    unsigned char* ws;
    float* out;
};
__device__ __forceinline__ const float* inptr(int i) {
    const float* const* ka = (const float* const*)__builtin_amdgcn_kernarg_segment_ptr();
    asm volatile("" : "+s"(ka));
    return ka[i];
}
#define WSP(F, off, type) ((type*)((F).ws + (off)))

template <class RowMap>
__device__ __forceinline__ void transpose_item(const float* W, int K, int N, bf16_t* WT, LAS float* scr, int item, int lane, const RowMap& rm) {
    const int nblk = N / 32, kb = item / nblk, nb = item % nblk, k0 = 64 * kb, n0 = 32 * nb;
#pragma unroll 8
    for (int i = 0; i < 32; ++i) { const int kk = 2 * i + (lane >> 5); scr[kk * 33 + (lane & 31)] = W[(size_t)(k0 + kk) * N + n0 + (lane & 31)]; }
    asm volatile("s_waitcnt lgkmcnt(0)" ::: "memory");
    const int c = lane & 7;
#pragma unroll
    for (int j = 0; j < 4; ++j) { const int n = (lane >> 3) + 8 * j; const LAS float* s = scr + (8 * c) * 33 + n;
        u32x4 o; o.x = cvt_pk_bf16(s[0 * 33], s[1 * 33]); o.y = cvt_pk_bf16(s[2 * 33], s[3 * 33]); o.z = cvt_pk_bf16(s[4 * 33], s[5 * 33]); o.w = cvt_pk_bf16(s[6 * 33], s[7 * 33]);
        *(u32x4*)(WT + (size_t)rm(n0 + n) * K + k0 + 8 * c) = o; }
    asm volatile("s_waitcnt lgkmcnt(0)" ::: "memory");
}
struct RmId { __device__ __forceinline__ int operator()(int n) const { return n; } };
struct RmWin { __device__ __forceinline__ int operator()(int n) const {
        const int s = n >> 9; if (s != 4 && s != 5) return n;
        const int d = n & 127, dd = d & 63; const int p = 8 * (dd >> 2) + (dd & 3) + ((d >> 6) << 2); return n - d + p; } };
struct RmGu { __device__ __forceinline__ int operator()(int n) const { const int half = n >> 10, j = (n & 1023) >> 7, i = n & 127; return 256 * j + 128 * half + i; } };

__device__ __forceinline__ void p0_prologue(Frame& F) {
    const int tid = F.tid;
    {
        LAS float* red = (LAS float*)F.lds;
        const float* c = inptr(1);
        for (int u = F.vcu; u < 192; u += F.G) {
            const int l = u / 96, cg = u % 96, kq = tid >> 4, cq = tid & 15;
            const float* W = inptr(2) + (size_t)l * D * 6 * D + cg * 64 + cq * 4;
            f32x4 a = {0.f, 0.f, 0.f, 0.f};
#pragma unroll 8
            for (int j = 0; j < 32; ++j) { const int k = kq + 32 * j; const float cv = siluf_(c[k]); const f32x4 w = *(const f32x4*)(W + (size_t)k * 6 * D); a += w * cv; }
            __syncthreads();
            *(LAS f32x4*)(red + kq * 64 + cq * 4) = a;
            __syncthreads();
            if (tid < 64) { float s = 0.f;
#pragma unroll 8
                for (int k = 0; k < 32; ++k) s += red[k * 64 + tid];
                const int col = cg * 64 + tid;
                WSP(F, WS_MOD, float)[l * 6 * D + col] = s + inptr(3)[l * 6 * D + col]; }
        }
        __syncthreads();
    }
    if (F.vcu == 0) { const float* hb = inptr(5); const float a = hb[tid], b = hb[512 + tid]; WSP(F, WS_LB, float)[tid] = 1.0f / (1.0f + __expf(b - a)); }
    {
        f32x2* rope = WSP(F, WS_ROPE, f32x2);
        for (int idx = F.vcu * NTH + tid; idx < T * 64; idx += F.G * NTH) {
            const int t = idx >> 6, d = idx & 63;
            const float inv = exp2f(-(float)d * (13.287712379549449f / 64.0f));
            const float ang = (float)t * inv;
            const double a = (double)ang; const double n = __builtin_rint(a * 0.15915494309189535); const double r = __builtin_fma(-n, 6.283185307179586, a);
            const float rf = (float)r;
            rope[idx] = (f32x2){__cosf(rf), __sinf(rf)};
        }
    }
    {
        LAS float* scr = (LAS float*)(F.lds + F.wave * 16384);
        const int gw = F.vcu * NWAVES + F.wave, NGW = F.G * NWAVES;
        constexpr int I_IN = 16 * 128, I_OUT = 16 * 32, I_POOL = 4 * 4 * 8, I_GU = 64 * 16 * 64, I_DN = 64 * 16 * 32;
        constexpr int NITEMS = I_IN + I_OUT + I_POOL + I_GU + I_DN;
        for (int it = gw; it < NITEMS; it += NGW) {
            int r = it;
            if (r < I_IN) { transpose_item(inptr(4), D, INW, WSP(F, WS_WINT, bf16_t), scr, r, F.lane, RmWin()); continue; } r -= I_IN;
            if (r < I_OUT) { transpose_item(inptr(8), D, D, WSP(F, WS_WOUTT, bf16_t), scr, r, F.lane, RmId()); continue; } r -= I_OUT;
            if (r < I_POOL) { const int g = r / 32; transpose_item(inptr(9) + (size_t)g * 65536, 256, 256, WSP(F, WS_POOLT, bf16_t) + (size_t)g * 65536, scr, r % 32, F.lane, RmId()); continue; } r -= I_POOL;
            if (r < I_GU) { const int m = r / 1024; transpose_item(inptr(14) + (size_t)m * D * 2048, D, 2048, WSP(F, WS_WGUT, bf16_t) + (size_t)m * 2048 * D, scr, r % 1024, F.lane, RmGu()); continue; } r -= I_GU;
            { const int m = r / 512; transpose_item(inptr(16) + (size_t)m * D * D, D, D, WSP(F, WS_WDNT, bf16_t) + (size_t)m * D * D, scr, r % 512, F.lane, RmId()); }
        }
    }
}

__device__ __forceinline__ void p1_norm_in(Frame& F) {
    const float* mod = WSP(F, WS_MOD, float);
    f32x4 sh[4], sc[4];
#pragma unroll
    for (int j = 0; j < 4; ++j) { sh[j] = *(const f32x4*)(mod + 0 * D + 4 * F.lane + 256 * j); sc[j] = *(const f32x4*)(mod + 1 * D + 4 * F.lane + 256 * j) + 1.0f; }
    const int gw = F.vcu * NWAVES + F.wave, NGW = F.G * NWAVES;
    for (int row = gw; row < T; row += NGW) {
        const f32x4* xr = (const f32x4*)(inptr(0) + (size_t)row * D) + F.lane;
        f32x4 v[4]; float s = 0.f;
#pragma unroll
        for (int j = 0; j < 4; ++j) { v[j] = xr[64 * j]; s += (v[j].x * v[j].x + v[j].y * v[j].y) + (v[j].z * v[j].z + v[j].w * v[j].w); }
        const float rstd = rsqrtf(wave_sum(s) * (1.f / D) + EPS);
        u32x2* o = (u32x2*)(WSP(F, WS_HN, bf16_t) + (size_t)row * D) + F.lane;
#pragma unroll
        for (int j = 0; j < 4; ++j) { const f32x4 h = v[j] * rstd * sc[j] + sh[j]; o[64 * j] = (u32x2){cvt_pk_bf16(h.x, h.y), cvt_pk_bf16(h.z, h.w)}; }
    }
}

using pg8::Unit;
typedef f32x4 AccT[2][2][4][2];

struct GemmBase {
    int G, vcu;
    __device__ __forceinline__ void aoff_lin(int R0, int C0, unsigned lda_bytes, unsigned (&off)[4]) const {
#pragma unroll
        for (int q = 0; q < 4; ++q) off[q] = (unsigned)(R0 + 64 * (q & 1) + 128 * (q >> 1)) * lda_bytes + (unsigned)C0 * 2u;
    }
};

struct PolWin : GemmBase {
    const bf16_t* A; const bf16_t* Bt; bf16_t* qkvg; float* gbuf; const float* lb; const f32x2* rope;
    __device__ __forceinline__ int nt() const { return D / 64; }
    __device__ __forceinline__ unsigned ldb_bytes() const { return D * 2; }
    __device__ __forceinline__ bool next(int i, Unit& u) const {
        const int V = i * G + vcu; if (V >= 64 * 16) return false;
        u.p0 = V >> 4; u.p1 = V & 15; u.A = (const char*)(A + (size_t)u.p0 * 256 * D); u.B = (const char*)(Bt + (size_t)u.p1 * 256 * D); return true; }
    __device__ __forceinline__ void aoff(const Unit&, int R0, int C0, unsigned (&off)[4]) const { aoff_lin(R0, C0, D * 2, off); }
    __device__ __forceinline__ void epi(const AccT& acc, const Unit& u, int wr, int wc, int fr, int fq) const {
        const int pm = u.p0, pn = u.p1, s = pn >> 1;
        const int row0 = pm * 256 + wr * 64 + fr;
        const int o0 = (pn & 1) * 256 + wc * 32 + 8 * fq;
        const int dbase = (s & 3) * 1024 + (s >> 2) * 512;
#pragma unroll
        for (int ai = 0; ai < 2; ++ai)
#pragma unroll
            for (int m = 0; m < 4; ++m) {
                const int row = row0 + ai * 128 + m * 16;
                bf16_t* orow = qkvg + (size_t)row * INW + dbase;
#pragma unroll
                for (int bj = 0; bj < 2; ++bj) {
                    const int o = o0 + bj * 128;
                    f32x4 v0 = acc[ai][bj][m][0], v1 = acc[ai][bj][m][1];
                    if (s == 4 || s == 5) {
                        const int hd = o & ~127, d0 = 4 * (((o & 127) >> 3));
                        const f32x4* rp = (const f32x4*)(rope + (size_t)row * 64 + d0);
                        const f32x4 c01 = rp[0], c23 = rp[1];
                        const f32x4 cs = {c01.x, c01.z, c23.x, c23.z}, sn = {c01.y, c01.w, c23.y, c23.w};
                        f32x4 o1 = v0 * cs - v1 * sn, o2 = v0 * sn + v1 * cs;
                        if (s == 5) { o1 = o1 * 0.08838834764831845f; o2 = o2 * 0.08838834764831845f; }
                        *(u32x2*)(orow + hd + d0) = (u32x2){cvt_pk_bf16(o1.x, o1.y), cvt_pk_bf16(o1.z, o1.w)};
                        *(u32x2*)(orow + hd + d0 + 64) = (u32x2){cvt_pk_bf16(o2.x, o2.y), cvt_pk_bf16(o2.z, o2.w)};
                    } else {
                        if (s == 0 || s == 3 || s == 7) {
#pragma unroll
                            for (int j = 0; j < 4; ++j) { v0[j] = siluf_(v0[j]); v1[j] = siluf_(v1[j]); }
                        } else if (s == 1) {
                            const f32x4 l0 = *(const f32x4*)(lb + o), l1 = *(const f32x4*)(lb + o + 4);
                            f32x4 g0, g1;
#pragma unroll
                            for (int j = 0; j < 4; ++j) {
                                const float f0 = l0[j] + (1.0f - l0[j]) * sigmoidf_(v0[j]), f1 = l1[j] + (1.0f - l1[j]) * sigmoidf_(v1[j]);
                                g0[j] = __logf(f0); g1[j] = __logf(f1); v0[j] = 1.0f - f0; v1[j] = 1.0f - f1; }
                            float* gr = gbuf + (size_t)row * 512 + o;
                            *(f32x4*)gr = g0; *(f32x4*)(gr + 4) = g1;
                        }
                        u32x4 w; w.x = cvt_pk_bf16(v0[0], v0[1]); w.y = cvt_pk_bf16(v0[2], v0[3]); w.z = cvt_pk_bf16(v1[0], v1[1]); w.w = cvt_pk_bf16(v1[2], v1[3]);
                        *(u32x4*)(orow + o) = w;
                    }
                }
            }
    }
};

struct PolRes : GemmBase {
    const bf16_t* A; const bf16_t* Bt; const float* resid; float* outp; const float* gate; const float* bias; const float* scale;
    int K, lda, nN, kcol;
    __device__ __forceinline__ int nt() const { return K / 64; }
    __device__ __forceinline__ unsigned ldb_bytes() const { return (unsigned)K * 2u; }
    __device__ __forceinline__ bool next(int i, Unit& u) const {
        const int V = i * G + vcu; if (V >= 64 * nN) return false;
        u.p0 = V / nN; u.p1 = V % nN; u.A = (const char*)(A + (size_t)u.p0 * 256 * lda + (size_t)u.p1 * kcol); u.B = (const char*)(Bt + (size_t)u.p1 * 256 * K); return true; }
    __device__ __forceinline__ void aoff(const Unit&, int R0, int C0, unsigned (&off)[4]) const { aoff_lin(R0, C0, (unsigned)lda * 2u, off); }
    __device__ __forceinline__ void epi(const AccT& acc, const Unit& u, int wr, int wc, int fr, int fq) const {
        const int row0 = u.p0 * 256 + wr * 64 + fr, col0 = u.p1 * 256 + wc * 32 + 8 * fq;
#pragma unroll
        for (int bj = 0; bj < 2; ++bj) {
            const int c = col0 + bj * 128;
            const f32x4 g0 = *(const f32x4*)(gate + c), g1 = *(const f32x4*)(gate + c + 4);
            f32x4 b0 = {0.f, 0.f, 0.f, 0.f}, b1 = b0, s0 = {1.f, 1.f, 1.f, 1.f}, s1 = s0;
            if (bias) { b0 = *(const f32x4*)(bias + c); b1 = *(const f32x4*)(bias + c + 4); s0 = *(const f32x4*)(scale + c); s1 = *(const f32x4*)(scale + c + 4); }
#pragma unroll
            for (int ai = 0; ai < 2; ++ai)
#pragma unroll
                for (int m = 0; m < 4; ++m) {
                    const size_t idx = (size_t)(row0 + ai * 128 + m * 16) * D + c;
                    const f32x4 r0 = *(const f32x4*)(resid + idx), r1 = *(const f32x4*)(resid + idx + 4);
                    *(f32x4*)(outp + idx) = r0 + g0 * ((acc[ai][bj][m][0] + b0) * s0);
                    *(f32x4*)(outp + idx + 4) = r1 + g1 * ((acc[ai][bj][m][1] + b1) * s1);
                }
        }
    }
};

constexpr int MI_TPRE = 16, MI_CNT = 64, MI_MT2E = 128;
__device__ __forceinline__ void expert_tables(Frame& F, int layer) {
    if (F.tid == 0) {
        int pre = 0;
        for (int e = 0; e < NE; ++e) {
            int c = (int)__hip_atomic_load(F.ctl + CW_CNT + 64 * layer + e, __ATOMIC_RELAXED, __HIP_MEMORY_SCOPE_AGENT);
            if (c > LIST_CAP) c = LIST_CAP;
            F.MISC[MI_TPRE + e] = pre; F.MISC[MI_CNT + e] = c;
            const int nt_ = (c + 255) >> 8;
            for (int q = 0; q < nt_; ++q) F.MISC[MI_MT2E + pre + q] = e;
            pre += nt_;
        }
        F.MISC[MI_TPRE + NE] = pre;
    }
    __syncthreads();
}
struct PolG1 : GemmBase {
    volatile LAS unsigned* MISC; const bf16_t* hn; const bf16_t* wgut; const float* bgu; const int* lslot; bf16_t* act;
    __device__ __forceinline__ int nt() const { return D / 64; }
    __device__ __forceinline__ unsigned ldb_bytes() const { return D * 2; }
    __device__ __forceinline__ bool next(int i, Unit& u) const {
        const int V = i * G + vcu, MT = (int)MISC[MI_TPRE + NE]; if (V >= MT * 8) return false;
        const int mt = V >> 3, nt_ = V & 7, e = (int)MISC[MI_MT2E + mt];
        u.p0 = e; u.p1 = mt - (int)MISC[MI_TPRE + e]; u.p2 = nt_; u.p3 = mt;
        u.A = (const char*)hn; u.B = (const char*)(wgut + ((size_t)e * 2048 + (size_t)nt_ * 256) * D); return true; }
    __device__ __forceinline__ void aoff(const Unit& u, int R0, int C0, unsigned (&off)[4]) const {
        const int cnt = (int)MISC[MI_CNT + u.p0]; const int* ls = lslot + (size_t)u.p0 * LIST_CAP + u.p1 * 256;
#pragma unroll
        for (int q = 0; q < 4; ++q) { const int r = R0 + 64 * (q & 1) + 128 * (q >> 1); const int tok = (u.p1 * 256 + r < cnt) ? (ls[r] >> 2) : 0; off[q] = (unsigned)tok * (D * 2u) + (unsigned)C0 * 2u; }
    }
    __device__ __forceinline__ void epi(const AccT& acc, const Unit& u, int wr, int wc, int fr, int fq) const {
        const int colg = u.p2 * 128 + wc * 32 + 8 * fq;
        const float* bg = bgu + (size_t)u.p0 * 2048;
        const f32x4 bgl0 = *(const f32x4*)(bg + colg), bgl1 = *(const f32x4*)(bg + colg + 4), bln0 = *(const f32x4*)(bg + 1024 + colg), bln1 = *(const f32x4*)(bg + 1024 + colg + 4);
        bf16_t* base = act + ((size_t)u.p3 * 256 + wr * 64 + fr) * D + colg;
#pragma unroll
        for (int ai = 0; ai < 2; ++ai)
#pragma unroll
            for (int m = 0; m < 4; ++m) {
                f32x4 gl0 = acc[ai][0][m][0] + bgl0, gl1 = acc[ai][0][m][1] + bgl1, ln0 = acc[ai][1][m][0] + bln0, ln1 = acc[ai][1][m][1] + bln1;
                f32x4 a0, a1;
#pragma unroll
                for (int j = 0; j < 4; ++j) {
                    const float x0 = fminf(gl0[j], SW_LIMIT), x1 = fminf(gl1[j], SW_LIMIT);
                    const float y0 = fminf(fmaxf(ln0[j], -SW_LIMIT), SW_LIMIT), y1 = fminf(fmaxf(ln1[j], -SW_LIMIT), SW_LIMIT);
                    a0[j] = x0 * sigmoidf_(SW_ALPHA * x0) * (y0 + 1.0f); a1[j] = x1 * sigmoidf_(SW_ALPHA * x1) * (y1 + 1.0f); }
                u32x4 w; w.x = cvt_pk_bf16(a0[0], a0[1]); w.y = cvt_pk_bf16(a0[2], a0[3]); w.z = cvt_pk_bf16(a1[0], a1[1]); w.w = cvt_pk_bf16(a1[2], a1[3]);
                *(u32x4*)(base + (size_t)(ai * 128 + m * 16) * D) = w;
            }
    }
};
struct PolG2 : GemmBase {
    volatile LAS unsigned* MISC; const bf16_t* act; const bf16_t* wdnt; const float* bdn; const int* lslot; const float* lw; bf16_t* yslot;
    __device__ __forceinline__ int nt() const { return D / 64; }
    __device__ __forceinline__ unsigned ldb_bytes() const { return D * 2; }
    __device__ __forceinline__ bool next(int i, Unit& u) const {
        const int V = i * G + vcu, MT = (int)MISC[MI_TPRE + NE]; if (V >= MT * 4) return false;
        const int mt = V >> 2, nt_ = V & 3, e = (int)MISC[MI_MT2E + mt];
        u.p0 = e; u.p1 = mt - (int)MISC[MI_TPRE + e]; u.p2 = nt_; u.p3 = mt;
        u.A = (const char*)(act + (size_t)mt * 256 * D); u.B = (const char*)(wdnt + ((size_t)e * D + (size_t)nt_ * 256) * D); return true; }
    __device__ __forceinline__ void aoff(const Unit&, int R0, int C0, unsigned (&off)[4]) const { aoff_lin(R0, C0, D * 2, off); }
    __device__ __forceinline__ void epi(const AccT& acc, const Unit& u, int wr, int wc, int fr, int fq) const {
        const int cnt = (int)MISC[MI_CNT + u.p0];
        const int col0 = u.p2 * 256 + wc * 32 + 8 * fq;
        const float* bd = bdn + (size_t)u.p0 * D;
        const int* ls = lslot + (size_t)u.p0 * LIST_CAP; const float* lwp = lw + (size_t)u.p0 * LIST_CAP;
#pragma unroll
        for (int ai = 0; ai < 2; ++ai)
#pragma unroll
            for (int m = 0; m < 4; ++m) {
                const int li = u.p1 * 256 + ai * 128 + wr * 64 + m * 16 + fr;
                if (li < cnt) {
                    const int slot = ls[li]; const float w = lwp[li];
                    bf16_t* yr = yslot + (size_t)slot * D + col0;
#pragma unroll
                    for (int bj = 0; bj < 2; ++bj) {
                        const f32x4 b0 = *(const f32x4*)(bd + col0 + bj * 128), b1 = *(const f32x4*)(bd + col0 + bj * 128 + 4);
                        const f32x4 v0 = (acc[ai][bj][m][0] + b0) * w, v1 = (acc[ai][bj][m][1] + b1) * w;
                        u32x4 o; o.x = cvt_pk_bf16(v0[0], v0[1]); o.y = cvt_pk_bf16(v0[2], v0[3]); o.z = cvt_pk_bf16(v1[0], v1[1]); o.w = cvt_pk_bf16(v1[2], v1[3]);
                        *(u32x4*)(yr + bj * 128) = o;
                    }
                }
            }
    }
};

template <class P> __device__ __forceinline__ void run_gemm(Frame& F, const P& S) {
#if SIMPLE_GEMM
    pg8::gemm_simple<P>(F.lds, S);
#else
    pg8::gemm_pipe<P>(F.lds, S);
#endif
}

constexpr int LA_QA = 0, LA_QH = 17408, LA_KA = 34816, LA_VT = 52224, LA_AS = 70656, LA_ST = 79872, LA_QS = 114688, LA_PS = 118784;
constexpr int RS128 = 272, RS64 = 144;
__device__ __forceinline__ float ret_lg(int hh) { return __logf(1.0f - exp2f(-5.0f - (float)(hh - 4))); }
__device__ __forceinline__ u32x4 pack8(const float (&v)[8]) { return (u32x4){cvt_pk_bf16(v[0], v[1]), cvt_pk_bf16(v[2], v[3]), cvt_pk_bf16(v[4], v[5]), cvt_pk_bf16(v[6], v[7])}; }

__device__ __forceinline__ void la_cumsum(const float* gbuf, int hh, int t0, int d0, float (&b0)[8], float (&b1)[8]) {
    if (hh < 4) { float r0 = 0.f, r1 = 0.f;
#pragma unroll
        for (int i = 0; i < 8; ++i) { const f32x2 g = *(const f32x2*)(gbuf + (size_t)(t0 + i) * 512 + hh * 128 + d0); r0 += g.x; r1 += g.y; b0[i] = r0; b1[i] = r1; }
    } else { const float lg = ret_lg(hh);
#pragma unroll
        for (int i = 0; i < 8; ++i) { b0[i] = (float)(i + 1) * lg; b1[i] = b0[i]; }
    }
}

__device__ __forceinline__ void la_local_state(Frame& F) {
    const bf16_t* qkvg = WSP(F, WS_QKVG, bf16_t); const float* gbuf = WSP(F, WS_GBUF, float); float* kvt = WSP(F, WS_KVT, float); float* dec = WSP(F, WS_DEC, float);
    LAS unsigned char* lds = F.lds; LAS float* qs = (LAS float*)(lds + LA_QS);
    const int lane = F.lane, oc = F.wave, d0 = 2 * lane, fr = lane & 15, fq = lane >> 4;
    for (int unit = F.vcu; unit < 2048; unit += F.G) {
        const int hh = unit >> 8, n = unit & 255, t0 = n * 64 + oc * 8;
        float b0[8], b1[8]; la_cumsum(gbuf, hh, t0, d0, b0, b1);
        *(LAS f32x2*)(qs + oc * 128 + d0) = (f32x2){b0[7], b1[7]};
        unsigned kk[8], vv[8];
#pragma unroll
        for (int i = 0; i < 8; ++i) { const bf16_t* row = qkvg + (size_t)(t0 + i) * INW + hh * 128 + d0; kk[i] = *(const unsigned*)(row + 1024); vv[i] = *(const unsigned*)(row + 2048); }
        __syncthreads();
        float base0 = 0.f, base1 = 0.f, tot0 = 0.f, tot1 = 0.f;
#pragma unroll
        for (int o = 0; o < 8; ++o) { const f32x2 q = *(const LAS f32x2*)(qs + o * 128 + d0); if (o < oc) { base0 += q.x; base1 += q.y; } tot0 += q.x; tot1 += q.y; }
        float a0[8], a1[8], c0[8], c1[8];
#pragma unroll
        for (int i = 0; i < 8; ++i) { a0[i] = bflo(kk[i]) * __expf(tot0 - base0 - b0[i]); a1[i] = bfhi(kk[i]) * __expf(tot1 - base1 - b1[i]); c0[i] = bflo(vv[i]); c1[i] = bfhi(vv[i]); }
        *(LAS u32x4*)(lds + LA_QA + d0 * RS64 + oc * 16) = pack8(a0); *(LAS u32x4*)(lds + LA_QA + (d0 + 1) * RS64 + oc * 16) = pack8(a1);
        *(LAS u32x4*)(lds + LA_VT + d0 * RS64 + oc * 16) = pack8(c0); *(LAS u32x4*)(lds + LA_VT + (d0 + 1) * RS64 + oc * 16) = pack8(c1);
        if (oc == 0) *(f32x2*)(dec + ((size_t)hh * 256 + n) * 128 + d0) = (f32x2){__expf(tot0), __expf(tot1)};
        __syncthreads();
        const int et = oc;
        bf16x8 vt[2];
#pragma unroll
        for (int ks = 0; ks < 2; ++ks) vt[ks] = *(const LAS bf16x8*)(lds + LA_VT + (16 * et + fr) * RS64 + (32 * ks + 8 * fq) * 2);
        float* orow = kvt + (((size_t)hh * 256 + n) * 128 + 16 * et + fr) * 128 + 4 * fq;
#pragma unroll
        for (int dt = 0; dt < 8; ++dt) {
            f32x4 acc = {0.f, 0.f, 0.f, 0.f};
#pragma unroll
            for (int ks = 0; ks < 2; ++ks) { const bf16x8 a = *(const LAS bf16x8*)(lds + LA_QA + (16 * dt + fr) * RS64 + (32 * ks + 8 * fq) * 2); acc = __builtin_amdgcn_mfma_f32_16x16x32_bf16(a, vt[ks], acc, 0, 0, 0); }
            *(f32x4*)(orow + 16 * dt) = acc;
        }
        __syncthreads();
    }
}

__device__ __forceinline__ void la_scan(Frame& F) {
    const float* kvt = WSP(F, WS_KVT, float); const float* dec = WSP(F, WS_DEC, float); bf16_t* sprev = WSP(F, WS_SPREV, bf16_t);
    for (int idx = F.vcu * NTH + F.tid; idx < 8 * 16384; idx += F.G * NTH) {
        const int hh = idx >> 14, rem = idx & 16383, d = rem & 127;
        const float* kv = kvt + (size_t)hh * 256 * 16384 + rem; const float* dc = dec + (size_t)hh * 256 * 128 + d; bf16_t* sp = sprev + (size_t)hh * 256 * 16384 + rem;
        float S = 0.f;
        for (int n0 = 0; n0 < 256; n0 += 8) {
            float kvv[8], dd[8];
#pragma unroll
            for (int i = 0; i < 8; ++i) { kvv[i] = kv[(size_t)(n0 + i) * 16384]; dd[i] = dc[(n0 + i) * 128]; }
#pragma unroll
            for (int i = 0; i < 8; ++i) { sp[(size_t)(n0 + i) * 16384] = (bf16_t)(cvt_pk_bf16(S, 0.f) & 0xffffu); S = dd[i] * S + kvv[i]; }
        }
    }
}

__device__ __forceinline__ void la_output(Frame& F) {
    const bf16_t* qkvg = WSP(F, WS_QKVG, bf16_t); const float* gbuf = WSP(F, WS_GBUF, float); const bf16_t* sprev = WSP(F, WS_SPREV, bf16_t); bf16_t* cat = WSP(F, WS_CAT, bf16_t);
    LAS unsigned char* lds = F.lds; LAS float* qs = (LAS float*)(lds + LA_QS); LAS float* ps = (LAS float*)(lds + LA_PS);
    const int tid = F.tid, lane = F.lane, oc = F.wave, d0 = 2 * lane, fr = lane & 15, fq = lane >> 4;
    for (int unit = F.vcu; unit < 2048; unit += F.G) {
        const int hh = unit >> 8, n = unit & 255, t0 = n * 64 + oc * 8;
        float b0[8], b1[8]; la_cumsum(gbuf, hh, t0, d0, b0, b1);
        *(LAS f32x2*)(qs + oc * 128 + d0) = (f32x2){b0[7], b1[7]};
        unsigned qq[8], kk[8], vv[8];
#pragma unroll
        for (int i = 0; i < 8; ++i) { const bf16_t* row = qkvg + (size_t)(t0 + i) * INW + hh * 128 + d0; qq[i] = *(const unsigned*)row; kk[i] = *(const unsigned*)(row + 1024); vv[i] = *(const unsigned*)(row + 2048); }
        {
            const bf16_t* sp = sprev + ((size_t)hh * 256 + n) * 16384;
#pragma unroll
            for (int j = 0; j < 4; ++j) { const int c = tid + NTH * j, row = c >> 4, c16 = c & 15; *(LAS u32x4*)(lds + LA_ST + row * RS128 + c16 * 16) = *(const u32x4*)(sp + row * 128 + c16 * 8); }
        }
        __syncthreads();
        float base0 = 0.f, base1 = 0.f, bm0 = 0.f, bm1 = 0.f;
#pragma unroll
        for (int o = 0; o < 8; ++o) { const f32x2 q = *(const LAS f32x2*)(qs + o * 128 + d0); if (o < oc) { base0 += q.x; base1 += q.y; } if (o < 4) { bm0 += q.x; bm1 += q.y; } }
        float c0[8], c1[8];
#pragma unroll
        for (int i = 0; i < 8; ++i) {
            const int t = 8 * oc + i; const float bt0 = base0 + b0[i], bt1 = base1 + b1[i];
            const float q0 = bflo(qq[i]), q1 = bfhi(qq[i]), k0 = bflo(kk[i]), k1 = bfhi(kk[i]);
            *(LAS unsigned*)(lds + LA_QA + t * RS128 + d0 * 2) = cvt_pk_bf16(q0 * __expf(bt0 - bm0), q1 * __expf(bt1 - bm1));
            *(LAS unsigned*)(lds + LA_QH + t * RS128 + d0 * 2) = cvt_pk_bf16(q0 * __expf(bt0), q1 * __expf(bt1));
            *(LAS unsigned*)(lds + LA_KA + t * RS128 + d0 * 2) = cvt_pk_bf16(k0 * __expf(bm0 - bt0), k1 * __expf(bm1 - bt1));
            c0[i] = bflo(vv[i]); c1[i] = bfhi(vv[i]);
        }
        *(LAS u32x4*)(lds + LA_VT + d0 * RS64 + oc * 16) = pack8(c0); *(LAS u32x4*)(lds + LA_VT + (d0 + 1) * RS64 + oc * 16) = pack8(c1);
        __syncthreads();
        const int tt = oc >> 1, eh = oc & 1;
        {
            bf16x8 qf[4];
#pragma unroll
            for (int ks = 0; ks < 4; ++ks) qf[ks] = *(const LAS bf16x8*)(lds + LA_QA + (16 * tt + fr) * RS128 + (32 * ks + 8 * fq) * 2);
#pragma unroll
            for (int sti = 0; sti < 2; ++sti) {
                const int st = 2 * eh + sti;
                f32x4 acc = {0.f, 0.f, 0.f, 0.f};
                if (st <= tt) {
#pragma unroll
                    for (int ks = 0; ks < 4; ++ks) { const bf16x8 a = *(const LAS bf16x8*)(lds + LA_KA + (16 * st + fr) * RS128 + (32 * ks + 8 * fq) * 2); acc = __builtin_amdgcn_mfma_f32_16x16x32_bf16(a, qf[ks], acc, 0, 0, 0); }
                    if (st == tt) {
#pragma unroll
                        for (int r = 0; r < 4; ++r) if (4 * fq + r > fr) acc[r] = 0.f;
                    }
                }
                *(LAS u32x2*)(lds + LA_AS + (16 * tt + fr) * RS64 + (16 * st + 4 * fq) * 2) = (u32x2){cvt_pk_bf16(acc[0], acc[1]), cvt_pk_bf16(acc[2], acc[3])};
            }
        }
        __syncthreads();
        f32x4 o[4]; float ss = 0.f;
        {
            bf16x8 af[2], hf[4];
#pragma unroll
            for (int ks = 0; ks < 2; ++ks) af[ks] = *(const LAS bf16x8*)(lds + LA_AS + (16 * tt + fr) * RS64 + (32 * ks + 8 * fq) * 2);
#pragma unroll
            for (int ks = 0; ks < 4; ++ks) hf[ks] = *(const LAS bf16x8*)(lds + LA_QH + (16 * tt + fr) * RS128 + (32 * ks + 8 * fq) * 2);
#pragma unroll
            for (int ei = 0; ei < 4; ++ei) {
                const int et = 4 * eh + ei;
                f32x4 acc = {0.f, 0.f, 0.f, 0.f};
#pragma unroll
                for (int ks = 0; ks < 2; ++ks) { const bf16x8 a = *(const LAS bf16x8*)(lds + LA_VT + (16 * et + fr) * RS64 + (32 * ks + 8 * fq) * 2); acc = __builtin_amdgcn_mfma_f32_16x16x32_bf16(a, af[ks], acc, 0, 0, 0); }
#pragma unroll
                for (int ks = 0; ks < 4; ++ks) { const bf16x8 a = *(const LAS bf16x8*)(lds + LA_ST + (16 * et + fr) * RS128 + (32 * ks + 8 * fq) * 2); acc = __builtin_amdgcn_mfma_f32_16x16x32_bf16(a, hf[ks], acc, 0, 0, 0); }
                o[ei] = acc; ss += (acc[0] * acc[0] + acc[1] * acc[1]) + (acc[2] * acc[2] + acc[3] * acc[3]);
            }
        }
        ss += __shfl_xor(ss, 16); ss += __shfl_xor(ss, 32);
        if (lane < 16) ps[(tt * 2 + eh) * 16 + lane] = ss;
        __syncthreads();
        const float tot = ps[(tt * 2) * 16 + fr] + ps[(tt * 2 + 1) * 16 + fr];
        const float rstd = rsqrtf(tot * (1.f / 128.f) + EPS);
        const float* gain = (hh < 4) ? (inptr(6) + hh * 128) : (inptr(7) + (hh - 4) * 128);
        const size_t rowi = (size_t)(n * 64 + 16 * tt + fr);
#pragma unroll
        for (int ei = 0; ei < 4; ++ei) {
            const int e0 = 16 * (4 * eh + ei) + 4 * fq;
            const f32x4 gn = *(const f32x4*)(gain + e0);
            const u32x2 gt = *(const u32x2*)(qkvg + rowi * INW + 3072 + hh * 128 + e0);
            const f32x4 v = o[ei] * rstd * gn;
            *(u32x2*)(cat + rowi * D + hh * 128 + e0) = (u32x2){cvt_pk_bf16(v[0] * bflo(gt.x), v[1] * bfhi(gt.x)), cvt_pk_bf16(v[2] * bflo(gt.y), v[3] * bfhi(gt.y))};
        }
        __syncthreads();
    }
}

constexpr int WR_STRIDE = 1028;
__device__ __forceinline__ void p_route(Frame& F, int layer, const float* X) {
    const int tid = F.tid, lane = F.lane;
    LAS float* wl = (LAS float*)F.lds;
    LAS int* pe = (LAS int*)(F.lds + 32 * WR_STRIDE * 4);
    LAS float* pw = (LAS float*)(pe + 256);
    LAS int* hist = (LAS int*)(pw + 256);
    LAS int* gbase = hist + 32;
    const float* wr = inptr(12) + (size_t)layer * D * NE;
    for (int idx = tid; idx < D * NE; idx += NTH) { const int c = idx >> 5, e = idx & 31; wl[e * WR_STRIDE + c] = wr[idx]; }
    const float* mod = WSP(F, WS_MOD, float) + (size_t)layer * 6 * D;
    f32x4 sh[4], sc[4];
#pragma unroll
    for (int j = 0; j < 4; ++j) { sh[j] = *(const f32x4*)(mod + 3 * D + 4 * lane + 256 * j); sc[j] = *(const f32x4*)(mod + 4 * D + 4 * lane + 256 * j) + 1.0f; }
    const float bias = inptr(13)[layer * NE + (lane >> 1)];
    int* lslot = WSP(F, WS_LSLOT, int) + (size_t)layer * NE * LIST_CAP; float* lw = WSP(F, WS_LW, float) + (size_t)layer * NE * LIST_CAP;
    __syncthreads();
    for (int tb = F.vcu; tb < T / 64; tb += F.G) {
        if (tid < 32) hist[tid] = 0;
        for (int i = 0; i < 8; ++i) {
            const int tl = F.wave * 8 + i, row = tb * 64 + tl;
            const f32x4* xr = (const f32x4*)(X + (size_t)row * D) + lane;
            f32x4 h[4]; float s = 0.f;
#pragma unroll
            for (int j = 0; j < 4; ++j) { h[j] = xr[64 * j]; s += (h[j].x * h[j].x + h[j].y * h[j].y) + (h[j].z * h[j].z + h[j].w * h[j].w); }
            const float rstd = rsqrtf(wave_sum(s) * (1.f / D) + EPS);
            u32x2* o = (u32x2*)(WSP(F, WS_HN, bf16_t) + (size_t)row * D) + lane;
#pragma unroll
            for (int j = 0; j < 4; ++j) { h[j] = h[j] * rstd * sc[j] + sh[j]; o[64 * j] = (u32x2){cvt_pk_bf16(h[j].x, h[j].y), cvt_pk_bf16(h[j].z, h[j].w)}; }
            float p[32];
#pragma unroll
            for (int eh = 0; eh < 2; ++eh) {
                const LAS float* wb = wl + eh * 16 * WR_STRIDE + 4 * lane;
                asm volatile("" : "+v"(wb));
#pragma unroll
                for (int e = 0; e < 16; ++e) {
                    float a = 0.f;
#pragma unroll
                    for (int j = 0; j < 4; ++j) { const f32x4 w = *(const LAS f32x4*)(wb + e * WR_STRIDE + 256 * j); a += (h[j].x * w.x + h[j].y * w.y) + (h[j].z * w.z + h[j].w * w.w); }
                    p[eh * 16 + e] = a;
                }
            }
#pragma unroll
            for (int st = 0; st < 5; ++st) {
                const int half = 16 >> st, off = 32 >> st; const bool up = (lane & off) != 0;
#pragma unroll
                for (int q = 0; q < half; ++q) { const float send = up ? p[q] : p[q + half]; const float keep = up ? p[q + half] : p[q]; p[q] = keep + __shfl_xor(send, off); }
            }
            float val = p[0] + __shfl_xor(p[0], 1) + bias;
            const int myE = lane >> 1;
            float tv[4]; int te[4];
#pragma unroll
            for (int k = 0; k < 4; ++k) {
                const float mx = wave_max(val);
                const unsigned long long mk = __ballot(val == mx);
                const int e = (int)(__builtin_ctzll(mk) >> 1);
                tv[k] = mx; te[k] = e; if (myE == e) val = -INFINITY;
            }
            const float e1 = __expf(tv[1] - tv[0]), e2 = __expf(tv[2] - tv[0]), e3 = __expf(tv[3] - tv[0]); const float inv = 1.0f / (1.0f + e1 + e2 + e3);
            if (lane == 0) { pe[tl * 4 + 0] = te[0]; pe[tl * 4 + 1] = te[1]; pe[tl * 4 + 2] = te[2]; pe[tl * 4 + 3] = te[3];
                pw[tl * 4 + 0] = inv; pw[tl * 4 + 1] = e1 * inv; pw[tl * 4 + 2] = e2 * inv; pw[tl * 4 + 3] = e3 * inv; }
        }
        __syncthreads();
        int myexp = 0, lpos = 0;
        if (tid < 256) { myexp = pe[tid]; lpos = __hip_atomic_fetch_add(hist + myexp, 1, __ATOMIC_RELAXED, __HIP_MEMORY_SCOPE_WORKGROUP); }
        __syncthreads();
        if (tid < 32) gbase[tid] = (int)atomicAdd(F.ctl + CW_CNT + 64 * layer + tid, (unsigned)hist[tid]);
        __syncthreads();
        if (tid < 256) { const int pos = gbase[myexp] + lpos; if (pos < LIST_CAP) { lslot[(size_t)myexp * LIST_CAP + pos] = tb * 256 + tid; lw[(size_t)myexp * LIST_CAP + pos] = pw[tid]; } }
        __syncthreads();
    }
}

template <int MODE>
__device__ __forceinline__ void p_combine(Frame& F, int layer, const float* Xin, float* Xout) {
    const int lane = F.lane;
    const float* mod = WSP(F, WS_MOD, float) + (size_t)layer * 6 * D;
    const bf16_t* ys = WSP(F, WS_YSLOT, bf16_t);
    f32x4 gf[4], fnw[4];
#pragma unroll
    for (int j = 0; j < 4; ++j) { gf[j] = *(const f32x4*)(mod + 5 * D + 4 * lane + 256 * j); if (MODE == 1) fnw[j] = *(const f32x4*)(inptr(18) + 4 * lane + 256 * j); }
    const int gw = F.vcu * NWAVES + F.wave, NGW = F.G * NWAVES;
    for (int row = gw; row < T; row += NGW) {
        const f32x4* xr = (const f32x4*)(Xin + (size_t)row * D) + lane;
        f32x4 v[4]; float s = 0.f;
#pragma unroll
        for (int j = 0; j < 4; ++j) {
            f32x4 a = {0.f, 0.f, 0.f, 0.f};
#pragma unroll
            for (int k = 0; k < 4; ++k) { const u32x2 y = *((const u32x2*)(ys + ((size_t)row * 4 + k) * D) + lane + 64 * j); a += (f32x4){bflo(y.x), bfhi(y.x), bflo(y.y), bfhi(y.y)}; }
            v[j] = xr[64 * j] + gf[j] * a;
            s += (v[j].x * v[j].x + v[j].y * v[j].y) + (v[j].z * v[j].z + v[j].w * v[j].w);
        }
        const float rstd = rsqrtf(wave_sum(s) * (1.f / D) + EPS);
        f32x4* o = (f32x4*)(Xout + (size_t)row * D) + lane;
        if (MODE == 0) {
#pragma unroll
            for (int j = 0; j < 4; ++j) o[64 * j] = v[j];
            if (lane == 0) WSP(F, WS_RSTD, float)[row] = rstd;
        } else {
#pragma unroll
            for (int j = 0; j < 4; ++j) o[64 * j] = v[j] * rstd * fnw[j];
        }
    }
}

__device__ __forceinline__ void p_pool(Frame& F, const float* X) {
    const float* mod = WSP(F, WS_MOD, float) + (size_t)1 * 6 * D; const float* rs = WSP(F, WS_RSTD, float); bf16_t* P = WSP(F, WS_HN, bf16_t);
    const int tid = F.tid;
    for (int u = F.vcu; u < 1024; u += F.G) {
        const int tt = u >> 2, g = u & 3, w = 2 << g;
        const int c = g * 256 + (tid & 255), t0 = tt * 64 + (tid >> 8) * 32;
        const float sh = mod[0 * D + c], sc = 1.0f + mod[1 * D + c];
        float sum = 0.f;
        for (int t = t0 - (w - 1); t < t0; ++t) if (t >= 0) sum += X[(size_t)t * D + c] * rs[t] * sc + sh;
        for (int t = t0; t < t0 + 32; ++t) {
            const float h = X[(size_t)t * D + c] * rs[t] * sc + sh;
            sum += h;
            const int cnt = (t + 1 < w) ? (t + 1) : w;
            const float p = sum / (float)cnt - h;
            P[(size_t)t * D + c] = (bf16_t)(cvt_pk_bf16(p, 0.f) & 0xffffu);
            const int tl = t - (w - 1);
            if (tl >= 0) sum -= X[(size_t)tl * D + c] * rs[tl] * sc + sh;
        }
    }
}

constexpr int N_PHASES = 17;
__global__ void __launch_bounds__(NTH, 2) fwd_kernel(Args args) {
    extern __shared__ __attribute__((aligned(16))) unsigned char lds_raw[];
    Frame F;
    F.lds = (LAS unsigned char*)lds_raw;
    F.MISC = (volatile LAS unsigned*)(F.lds + MISC_OFF);
    F.tid = threadIdx.x; F.lane = F.tid & 63; F.wave = __builtin_amdgcn_readfirstlane(F.tid >> 6);
    F.G = gridDim.x; { const int bx = blockIdx.x; F.vcu = (F.G % 8 == 0) ? (bx % 8) * (F.G / 8) + bx / 8 : bx; }
    F.ws = args.ws; F.ctl = (unsigned*)(args.ws + WS_CTL); F.out = args.out;
    for (int u = F.tid; u < (LDS_BYTES - MISC_OFF) / 4; u += NTH) F.MISC[u] = 0u;
    __syncthreads();
#if N_LAUNCH_MODE == 1
    XcdBarrier bar = xcd_barrier_post(F.ctl + CW_BAR, F.MISC + 8);
#define GRID_BAR() xcd_barrier(bar)
#else
#define GRID_BAR() do { } while (0)
#endif
    const int lo = args.ph_lo, hi = args.ph_hi;
#define IN(k) (lo <= (k) && (k) < hi)
#define SEAM(k) do { if (IN(k) && IN((k) + 1)) GRID_BAR(); } while (0)
    GemmBase gb; gb.G = F.G; gb.vcu = F.vcu;
    float* X1 = WSP(F, WS_X1, float); float* X2 = WSP(F, WS_X2, float);
    const float* mod0 = WSP(F, WS_MOD, float); const float* mod1 = mod0 + 6 * D;

    if (IN(0)) { p0_prologue(F); } SEAM(0);
    if (IN(1)) { p1_norm_in(F); } SEAM(1);
    if (IN(2)) { PolWin P; (GemmBase&)P = gb; P.A = WSP(F, WS_HN, bf16_t); P.Bt = WSP(F, WS_WINT, bf16_t); P.qkvg = WSP(F, WS_QKVG, bf16_t); P.gbuf = WSP(F, WS_GBUF, float);
        P.lb = WSP(F, WS_LB, float); P.rope = WSP(F, WS_ROPE, f32x2); run_gemm(F, P); } SEAM(2);
    if (IN(3)) { la_local_state(F); } SEAM(3);
    if (IN(4)) { la_scan(F); } SEAM(4);
    if (IN(5)) { la_output(F); } SEAM(5);
    if (IN(6)) { PolRes P; (GemmBase&)P = gb; P.A = WSP(F, WS_CAT, bf16_t); P.Bt = WSP(F, WS_WOUTT, bf16_t); P.resid = inptr(0); P.outp = X1; P.gate = mod0 + 2 * D; P.bias = nullptr; P.scale = nullptr;
        P.K = D; P.lda = D; P.nN = 4; P.kcol = 0; run_gemm(F, P); } SEAM(6);
    if (IN(7)) { p_route(F, 0, X1); } SEAM(7);
    if (IN(8)) { expert_tables(F, 0); PolG1 P; (GemmBase&)P = gb; P.MISC = F.MISC; P.hn = WSP(F, WS_HN, bf16_t); P.wgut = WSP(F, WS_WGUT, bf16_t); P.bgu = inptr(15); P.lslot = WSP(F, WS_LSLOT, int); P.act = WSP(F, WS_ACT, bf16_t);
        run_gemm(F, P); } SEAM(8);
    if (IN(9)) { expert_tables(F, 0); PolG2 P; (GemmBase&)P = gb; P.MISC = F.MISC; P.act = WSP(F, WS_ACT, bf16_t); P.wdnt = WSP(F, WS_WDNT, bf16_t); P.bdn = inptr(17); P.lslot = WSP(F, WS_LSLOT, int); P.lw = WSP(F, WS_LW, float);
        P.yslot = WSP(F, WS_YSLOT, bf16_t); run_gemm(F, P); } SEAM(9);
    if (IN(10)) { p_combine<0>(F, 0, X1, X2); } SEAM(10);
    if (IN(11)) { p_pool(F, X2); } SEAM(11);
    if (IN(12)) { PolRes P; (GemmBase&)P = gb; P.A = WSP(F, WS_HN, bf16_t); P.Bt = WSP(F, WS_POOLT, bf16_t); P.resid = X2; P.outp = X1; P.gate = mod1 + 2 * D; P.bias = inptr(10); P.scale = inptr(11);
        P.K = 256; P.lda = D; P.nN = 4; P.kcol = 256; run_gemm(F, P); } SEAM(12);
    if (IN(13)) { p_route(F, 1, X1); } SEAM(13);
    if (IN(14)) { expert_tables(F, 1); PolG1 P; (GemmBase&)P = gb; P.MISC = F.MISC; P.hn = WSP(F, WS_HN, bf16_t); P.wgut = WSP(F, WS_WGUT, bf16_t) + (size_t)NE * 2048 * D; P.bgu = inptr(15) + (size_t)NE * 2048;
        P.lslot = WSP(F, WS_LSLOT, int) + (size_t)NE * LIST_CAP; P.act = WSP(F, WS_ACT, bf16_t); run_gemm(F, P); } SEAM(14);
    if (IN(15)) { expert_tables(F, 1); PolG2 P; (GemmBase&)P = gb; P.MISC = F.MISC; P.act = WSP(F, WS_ACT, bf16_t); P.wdnt = WSP(F, WS_WDNT, bf16_t) + (size_t)NE * D * D; P.bdn = inptr(17) + (size_t)NE * D;
        P.lslot = WSP(F, WS_LSLOT, int) + (size_t)NE * LIST_CAP; P.lw = WSP(F, WS_LW, float) + (size_t)NE * LIST_CAP; P.yslot = WSP(F, WS_YSLOT, bf16_t); run_gemm(F, P); } SEAM(15);
    if (IN(16)) { p_combine<1>(F, 1, X1, F.out); }
#undef IN
#undef SEAM
}

extern "C" void kernel_launch(void* const* d_in, const int* in_sizes, int n_in, void* d_out, int out_size, void* d_ws, size_t ws_size, hipStream_t stream) {
    static int grid = 0;
    if (grid == 0) {
        if (n_in != 19 || out_size != T * D || ws_size < WS_END) { fprintf(stderr, "kernel_launch: unexpected shapes (n_in %d, out %d, ws %zu)\n", n_in, out_size, ws_size); grid = -1; return; }
        int dev = 0, cus = 0, per_cu = 0;
        if (hipGetDevice(&dev) != hipSuccess || hipDeviceGetAttribute(&cus, hipDeviceAttributeMultiprocessorCount, dev) != hipSuccess) { grid = -1; return; }
        if (hipFuncSetAttribute((const void*)fwd_kernel, hipFuncAttributeMaxDynamicSharedMemorySize, LDS_BYTES) != hipSuccess) { fprintf(stderr, "kernel_launch: hipFuncSetAttribute failed\n"); grid = -1; return; }
        if (hipOccupancyMaxActiveBlocksPerMultiprocessor(&per_cu, (const void*)fwd_kernel, NTH, LDS_BYTES) != hipSuccess || per_cu < 1) { fprintf(stderr, "kernel_launch: occupancy query says %d\n", per_cu); }
        (void)hipGetLastError();
        grid = cus;
    }
    if (grid < 0) return;
    (void)hipMemsetAsync((char*)d_ws + WS_CTL, 0, CTL_BYTES, stream);
    Args a{};
    for (int i = 0; i < 19; ++i) a.in[i] = (const float*)d_in[i];
    a.out = (float*)d_out; a.ws = (unsigned char*)d_ws;
#if N_LAUNCH_MODE == 1
    a.ph_lo = 0; a.ph_hi = N_PHASES;
    void* kargs[] = {&a};
    hipError_t e = hipLaunchCooperativeKernel((const void*)fwd_kernel, dim3(grid), dim3(NTH), kargs, LDS_BYTES, stream);
    if (e != hipSuccess) fprintf(stderr, "cooperative launch failed: %s\n", hipGetErrorString(e));
#else
    for (int p = 0; p < N_PHASES; ++p) {
        a.ph_lo = p; a.ph_hi = p + 1;
        hipLaunchKernelGGL(fwd_kernel, dim3(grid), dim3(NTH), LDS_BYTES, stream, a);
    }
#endif
}
```

```cpp
#include <hip/hip_runtime.h>
#include <cstdio>
#include <cstdint>

#ifndef N_LAUNCH_MODE
#define N_LAUNCH_MODE 1
#endif
#ifndef SIMPLE_GEMM
#define SIMPLE_GEMM 0
#endif

#define LAS __attribute__((address_space(3)))
#define GAS __attribute__((address_space(1)))
typedef unsigned short bf16_t;
typedef short bf16x8 __attribute__((ext_vector_type(8)));
typedef float f32x4 __attribute__((ext_vector_type(4)));
typedef float f32x2 __attribute__((ext_vector_type(2)));
typedef unsigned u32x4 __attribute__((ext_vector_type(4)));
typedef unsigned u32x2 __attribute__((ext_vector_type(2)));

constexpr int T = 16384, D = 1024, NE = 32, TOPK = 4, DEPTH = 2;
constexpr int INW = 4096;
constexpr int NTH = 512, NWAVES = 8;
constexpr float EPS = 1e-6f;
constexpr float SW_LIMIT = 7.0f, SW_ALPHA = 1.702f;
constexpr int LIST_CAP = T;
constexpr int ACT_ROWS = T * TOPK + NE * 256;

constexpr size_t MiB = 1u << 20;
constexpr size_t WS_CTL = 0, CTL_BYTES = 1 * MiB;
constexpr size_t WS_MOD = 1 * MiB;
constexpr size_t WS_LB = WS_MOD + 65536;
constexpr size_t WS_ROPE = 2 * MiB;
constexpr size_t WS_WINT = 10 * MiB;
constexpr size_t WS_WOUTT = 18 * MiB;
constexpr size_t WS_POOLT = 20 * MiB;
constexpr size_t WS_LSLOT = 22 * MiB;
constexpr size_t WS_LW = 26 * MiB;
constexpr size_t WS_RSTD = 30 * MiB;
constexpr size_t WS_WGUT = 32 * MiB;
constexpr size_t WS_WDNT = 288 * MiB;
constexpr size_t WS_HN = 416 * MiB;
constexpr size_t WS_QKVG = 448 * MiB;
constexpr size_t WS_GBUF = 576 * MiB;
constexpr size_t WS_KVT = 608 * MiB;
constexpr size_t WS_SPREV = 736 * MiB;
constexpr size_t WS_DEC = 800 * MiB;
constexpr size_t WS_CAT = 802 * MiB;
constexpr size_t WS_X1 = 834 * MiB;
constexpr size_t WS_X2 = 898 * MiB;
constexpr size_t WS_ACT = 962 * MiB;
constexpr size_t WS_YSLOT = 1106 * MiB;
constexpr size_t WS_END = 1234 * MiB;
constexpr int CW_CNT = 64;
constexpr int CW_BAR = 4096;

constexpr int SCR_BYTES = 136 * 1024;
constexpr int MISC_OFF = SCR_BYTES;
constexpr int LDS_BYTES = SCR_BYTES + 4096;

typedef __bf16 bf16x2_t __attribute__((ext_vector_type(2)));
__device__ __forceinline__ unsigned cvt_pk_bf16(float lo, float hi) { const f32x2 v = {lo, hi}; const bf16x2_t b = __builtin_convertvector(v, bf16x2_t); return __builtin_bit_cast(unsigned, b); }
__device__ __forceinline__ float bf2f(unsigned short b) { return __builtin_bit_cast(float, (unsigned)b << 16); }
__device__ __forceinline__ float bflo(unsigned w) { return __builtin_bit_cast(float, w << 16); }
__device__ __forceinline__ float bfhi(unsigned w) { return __builtin_bit_cast(float, w & 0xffff0000u); }
__device__ __forceinline__ float wave_sum(float v) {
#pragma unroll
    for (int o = 1; o < 64; o <<= 1) v += __shfl_xor(v, o);
    return v;
}
__device__ __forceinline__ float wave_max(float v) {
#pragma unroll
    for (int o = 1; o < 64; o <<= 1) v = fmaxf(v, __shfl_xor(v, o));
    return v;
}
__device__ __forceinline__ float sigmoidf_(float x) { return 1.0f / (1.0f + __expf(-x)); }
__device__ __forceinline__ float siluf_(float x) { return x * sigmoidf_(x); }

#define XB_TMO      128
#define XB_XCNT(j)  (256  + 64 * (j))
#define XB_XSUB(j)  (1280 + 64 * (j))
#define XB_XGEN(j)  (2304 + 64 * (j))
#define XB_TOP      3328
#define XB_TOPGEN   3392
#define XCD_BAR_WORDS 3456
#define XB_SPIN_CAP (1u << 20)
__device__ __forceinline__ unsigned xb_ld(unsigned* p)              { return __hip_atomic_load(p, __ATOMIC_RELAXED, __HIP_MEMORY_SCOPE_AGENT); }
__device__ __forceinline__ unsigned xb_add(unsigned* p, unsigned v) { return __hip_atomic_fetch_add(p, v, __ATOMIC_RELAXED, __HIP_MEMORY_SCOPE_AGENT); }
__device__ __forceinline__ unsigned xb_xcc_id() { return (unsigned)__builtin_amdgcn_s_getreg((3 << 11) | 20) & 0xFu; }
#define XB_SPIN(cond, bar) do { unsigned _sp = 0; while (cond) { __builtin_amdgcn_s_sleep(1); \
    if ((++_sp & 255u) == 0u) { if (xb_ld(&(bar)[XB_TMO])) break; if (_sp > XB_SPIN_CAP) { atomicAdd(&(bar)[XB_TMO], 1u); break; } } } } while (0)
struct XcdBarrier { unsigned* bar; unsigned x; volatile LAS unsigned* st; };
__device__ __forceinline__ XcdBarrier xcd_barrier_post(unsigned* bar, volatile LAS unsigned* st) {
    XcdBarrier b; b.bar = bar; b.x = xb_xcc_id(); b.st = st;
    if (threadIdx.x == 0) (void)xb_add(&bar[XB_XCNT(b.x)], 1u);
    return b;
}
__device__ __forceinline__ void xcd_barrier_complete(unsigned* bar, unsigned x, unsigned& nloc, unsigned& nx) {
    const unsigned G = gridDim.x * gridDim.y * gridDim.z;
    unsigned sum, cnt, mine, sp = 0u;
    for (;;) {
        sum = 0u; cnt = 0u; mine = 0u;
#pragma unroll
        for (unsigned j = 0; j < 16; ++j) { const unsigned c = xb_ld(&bar[XB_XCNT(j)]); sum += c; cnt += (c > 0u) ? 1u : 0u; mine = (j == x) ? c : mine; }
        if (sum == G) break;
        __builtin_amdgcn_s_sleep(1);
        if ((++sp & 255u) == 0u) { if (xb_ld(&bar[XB_TMO])) break; if (sp > XB_SPIN_CAP) { atomicAdd(&bar[XB_TMO], 1u); break; } }
    }
    nloc = mine > 0u ? mine : 1u; nx = cnt > 0u ? cnt : 1u;
}
__device__ __forceinline__ void xcd_barrier(const XcdBarrier& b) {
    asm volatile("s_waitcnt vmcnt(0)" ::: "memory");
    __syncthreads();
    if (threadIdx.x == 0) {
        unsigned* bar = b.bar;
        __builtin_amdgcn_s_waitcnt(0);
        unsigned nloc = b.st[0], nx = b.st[1];
        if (nloc == 0u) { xcd_barrier_complete(bar, b.x, nloc, nx); b.st[0] = nloc; b.st[1] = nx; }
        const unsigned old = xb_add(&bar[XB_XSUB(b.x)], 1u);
        const unsigned gen = old / nloc;
        if (old + 1u == (gen + 1u) * nloc) {
            __builtin_amdgcn_fence(__ATOMIC_RELEASE, "agent");
            asm volatile("s_waitcnt vmcnt(0)" ::: "memory");
            const unsigned og = xb_add(&bar[XB_TOP], 1u);
            const unsigned tg = og / nx;
            if (og + 1u == (tg + 1u) * nx) xb_add(&bar[XB_TOPGEN], 1u);
            else XB_SPIN(xb_ld(&bar[XB_TOPGEN]) == tg, bar);
            __builtin_amdgcn_fence(__ATOMIC_ACQUIRE, "agent");
            xb_add(&bar[XB_XGEN(b.x)], 1u);
            asm volatile("s_waitcnt vmcnt(0)" ::: "memory");
        } else {
            XB_SPIN(xb_ld(&bar[XB_XGEN(b.x)]) == gen, bar);
            __builtin_amdgcn_fence(__ATOMIC_ACQUIRE, "agent");
            asm volatile("s_waitcnt vmcnt(0)" ::: "memory");
        }
    }
    __syncthreads();
}

struct Args {
    const float* in[19];
    float* out;
    unsigned char* ws;
    int ph_lo, ph_hi;
};

namespace pg8 {
constexpr int BM = 256, BK = 64, HALF = 128, HTB = HALF * BK * 2;
__host__ __device__ __forceinline__ int lds_byte(int r, int c) { const int st = (r >> 4) * 2 + (c >> 5), rr = r & 15, cc = c & 31, ob = rr * 64 + cc * 2; return st * 1024 + (ob ^ (((ob >> 9) & 1) << 5)); }
__host__ __device__ __forceinline__ void stage_rc(int b, int& R, int& C) { const int st = b / 1024, sb = b % 1024, swz = sb ^ (((sb >> 9) & 1) << 5); R = (st >> 1) * 16 + swz / 64; C = (st & 1) * 32 + (swz % 64) / 2; }
__host__ __device__ __forceinline__ int perm32(int rho) { const int n = rho >> 4, i = rho & 15; return 8 * (i >> 2) + 4 * n + (i & 3); }

struct Unit { const char* A; const char* B; int p0, p1, p2, p3; };

#define PG8_SA(b, h) (((b) * 2 + (h)) * HTB)
#define PG8_SB(b, h) ((4 + (b) * 2 + (h)) * HTB)
#define PG8_LDA(dst, b, h) do { _Pragma("unroll") for (int m = 0; m < 4; ++m) _Pragma("unroll") for (int k = 0; k < 2; ++k) dst[m][k] = *(const LAS bf16x8*)(lds + PG8_SA(b, h) + aoff + m * 2048 + k * 1024); } while (0)
#define PG8_LDB(dst, b, h) do { _Pragma("unroll") for (int n = 0; n < 2; ++n) _Pragma("unroll") for (int k = 0; k < 2; ++k) dst[n][k] = *(const LAS bf16x8*)(lds + PG8_SB(b, h) + boff + n * 2048 + k * 1024); } while (0)
#define PG8_MMA(ai, bj, At, Bt) do { __builtin_amdgcn_s_setprio(1); _Pragma("unroll") for (int m = 0; m < 4; ++m) _Pragma("unroll") for (int n = 0; n < 2; ++n) _Pragma("unroll") for (int k = 0; k < 2; ++k) \
        acc[ai][bj][m][n] = __builtin_amdgcn_mfma_f32_16x16x32_bf16(Bt[n][k], At[m][k], acc[ai][bj][m][n], 0, 0, 0); __builtin_amdgcn_s_setprio(0); } while (0)

template <class P>
__device__ __forceinline__ void gemm_simple(LAS unsigned char* lds, const P& S) {
    const int tid = threadIdx.x, wid = __builtin_amdgcn_readfirstlane(tid >> 6), lane = tid & 63, wr = wid >> 2, wc = wid & 3, fr = lane & 15, fq = lane >> 4;
    const int nt = S.nt();
    int R0, C0; stage_rc(tid * 16, R0, C0);
    unsigned offB[2];
#pragma unroll
    for (int i = 0; i < 2; ++i) { const int R = R0 + 64 * i; const int Rb = (R & ~31) + perm32(R & 31); offB[i] = (unsigned)Rb * S.ldb_bytes() + (unsigned)C0 * 2u; }
    const unsigned bhalf = 128u * S.ldb_bytes();
    const int aoff = lds_byte(wr * 64 + fr, fq * 8), boff = lds_byte(wc * 32 + fr, fq * 8);
    Unit u;
    for (int ui = 0; S.next(ui, u); ++ui) {
        unsigned offA[4]; S.aoff(u, R0, C0, offA);
        f32x4 acc[2][2][4][2];
#pragma unroll
        for (int a = 0; a < 2; ++a)
#pragma unroll
            for (int b = 0; b < 2; ++b)
#pragma unroll
                for (int m = 0; m < 4; ++m)
#pragma unroll
                    for (int n = 0; n < 2; ++n) acc[a][b][m][n] = (f32x4){0.f, 0.f, 0.f, 0.f};
        for (int t = 0; t < nt; ++t) {
            u32x4 ra[4], rb[4];
#pragma unroll
            for (int h = 0; h < 2; ++h)
#pragma unroll
                for (int i = 0; i < 2; ++i) {
                    ra[2 * h + i] = *(const u32x4*)(u.A + offA[2 * h + i] + (size_t)t * 128);
                    rb[2 * h + i] = *(const u32x4*)(u.B + (size_t)h * bhalf + offB[i] + (size_t)t * 128);
                }
            __syncthreads();
#pragma unroll
            for (int h = 0; h < 2; ++h)
#pragma unroll
                for (int i = 0; i < 2; ++i) {
                    *(LAS u32x4*)(lds + PG8_SA(0, h) + tid * 16 + i * 8192) = ra[2 * h + i];
                    *(LAS u32x4*)(lds + PG8_SB(0, h) + tid * 16 + i * 8192) = rb[2 * h + i];
                }
            __syncthreads();
            bf16x8 At[4][2], Bt[2][2];
#pragma unroll
            for (int ai = 0; ai < 2; ++ai) {
                PG8_LDA(At, 0, ai);
#pragma unroll
                for (int bj = 0; bj < 2; ++bj) { PG8_LDB(Bt, 0, bj); PG8_MMA(ai, bj, At, Bt); }
            }
        }
        S.epi(acc, u, wr, wc, fr, fq);
    }
    __syncthreads();
}

template <class P>
__device__ __forceinline__ void gemm_pipe(LAS unsigned char* lds, const P& S) {
    const int tid = threadIdx.x, wid = __builtin_amdgcn_readfirstlane(tid >> 6), lane = tid & 63, wr = wid >> 2, wc = wid & 3, fr = lane & 15, fq = lane >> 4;
    const int nt = S.nt();
    int R0, C0; stage_rc(tid * 16, R0, C0);
    unsigned offB[2];
#pragma unroll
    for (int i = 0; i < 2; ++i) { const int R = R0 + 64 * i; const int Rb = (R & ~31) + perm32(R & 31); offB[i] = (unsigned)Rb * S.ldb_bytes() + (unsigned)C0 * 2u; }
    const size_t bhalf = (size_t)128u * S.ldb_bytes();
    const size_t kstep = 128;
    const unsigned ldsw = (unsigned)wid * 1024u;
    const int aoff = lds_byte(wr * 64 + fr, fq * 8), boff = lds_byte(wc * 32 + fr, fq * 8);
#define PG8_STAGE_A(bufoff, gbase, OFF, h) do { _Pragma("unroll") for (int _i = 0; _i < 2; ++_i) \
        __builtin_amdgcn_global_load_lds((const unsigned*)((const char*)(gbase) + (OFF)[2 * (h) + _i]), (LAS unsigned*)(lds + (bufoff) + ldsw + _i * 8192), 16, 0, 0); } while (0)
#define PG8_STAGE_B(bufoff, gbase) do { _Pragma("unroll") for (int _i = 0; _i < 2; ++_i) \
        __builtin_amdgcn_global_load_lds((const unsigned*)((const char*)(gbase) + offB[_i]), (LAS unsigned*)(lds + (bufoff) + ldsw + _i * 8192), 16, 0, 0); } while (0)
#define PG8_WAIT_V(n) asm volatile("s_waitcnt vmcnt(" #n ")" ::: "memory")
#define PG8_WAIT_L(n) asm volatile("s_waitcnt lgkmcnt(" #n ")" ::: "memory")
#define PG8_BAR __builtin_amdgcn_s_barrier()
#define PG8_SCHED __builtin_amdgcn_sched_barrier(0)
    Unit cur, nxt; int ui = 0;
    if (!S.next(0, cur)) return;
    f32x4 acc[2][2][4][2];
#pragma unroll
    for (int a = 0; a < 2; ++a)
#pragma unroll
        for (int b = 0; b < 2; ++b)
#pragma unroll
            for (int m = 0; m < 4; ++m)
#pragma unroll
                for (int n = 0; n < 2; ++n) acc[a][b][m][n] = (f32x4){0.f, 0.f, 0.f, 0.f};
    bf16x8 At[4][2], B0[2][2], B1[2][2];
    unsigned offC[4], offN[4];
    S.aoff(cur, R0, C0, offC);
    const char* cA = cur.A; const char* cB = cur.B;
    PG8_STAGE_B(PG8_SB(0, 0), cB); PG8_STAGE_B(PG8_SB(0, 1), cB + bhalf); PG8_STAGE_A(PG8_SA(0, 0), cA, offC, 0); PG8_STAGE_A(PG8_SA(0, 1), cA, offC, 1);
    if (wr == 1) PG8_BAR;
    PG8_WAIT_V(2); PG8_BAR;
    PG8_STAGE_B(PG8_SB(1, 0), cB + kstep); PG8_STAGE_A(PG8_SA(1, 0), cA + kstep, offC, 0); PG8_STAGE_B(PG8_SB(1, 1), cB + bhalf + kstep);
    PG8_WAIT_V(6); PG8_BAR;
    for (;;) {
        const bool has_next = S.next(ui + 1, nxt);
        if (has_next) S.aoff(nxt, R0, C0, offN);
        else {
#pragma unroll
            for (int q = 0; q < 4; ++q) offN[q] = offC[q];
        }
        const char* nA = has_next ? nxt.A : cA; const char* nB = has_next ? nxt.B : cB;
        for (int t = 0; t < nt; t += 2) {
            const bool last = (t == nt - 2);
            const char* a1 = cA + (size_t)(t + 1) * kstep;
            const char* a2 = last ? nA : cA + (size_t)(t + 2) * kstep; const char* b2 = last ? nB : cB + (size_t)(t + 2) * kstep;
            const char* a3 = a2 + kstep; const char* b3 = b2 + kstep;
            unsigned o2[4];
#pragma unroll
            for (int q = 0; q < 4; ++q) o2[q] = last ? offN[q] : offC[q];
            PG8_LDB(B0, 0, 0); PG8_LDB(B1, 0, 1); PG8_SCHED; PG8_LDA(At, 0, 0); PG8_STAGE_A(PG8_SA(1, 1), a1, offC, 1);
            PG8_WAIT_V(8); PG8_WAIT_L(0); PG8_BAR; PG8_MMA(0, 0, At, B0); PG8_MMA(0, 1, At, B1); PG8_BAR; PG8_SCHED;
            PG8_LDA(At, 0, 1); PG8_STAGE_B(PG8_SB(0, 0), b2); PG8_STAGE_B(PG8_SB(0, 1), b2 + bhalf); PG8_STAGE_A(PG8_SA(0, 0), a2, o2, 0);
            PG8_WAIT_V(8); PG8_WAIT_L(0); PG8_BAR; PG8_MMA(1, 0, At, B0); PG8_MMA(1, 1, At, B1); PG8_BAR; PG8_SCHED;
            PG8_LDB(B0, 1, 0); PG8_LDB(B1, 1, 1); PG8_SCHED; PG8_LDA(At, 1, 0); PG8_STAGE_A(PG8_SA(0, 1), a2, o2, 1);
            PG8_WAIT_V(8); PG8_WAIT_L(0); PG8_BAR; PG8_MMA(0, 0, At, B0); PG8_MMA(0, 1, At, B1); PG8_BAR; PG8_SCHED;
            PG8_LDA(At, 1, 1); PG8_STAGE_B(PG8_SB(1, 0), b3); PG8_STAGE_B(PG8_SB(1, 1), b3 + bhalf); PG8_STAGE_A(PG8_SA(1, 0), a3, o2, 0);
            PG8_WAIT_V(8); PG8_WAIT_L(0); PG8_BAR; PG8_MMA(1, 0, At, B0); PG8_MMA(1, 1, At, B1); PG8_BAR; PG8_SCHED;
        }
        if (wr == 0) PG8_BAR;
        S.epi(acc, cur, wr, wc, fr, fq);
        if (!has_next) break;
#pragma unroll
        for (int a = 0; a < 2; ++a)
#pragma unroll
            for (int b = 0; b < 2; ++b)
#pragma unroll
                for (int m = 0; m < 4; ++m)
#pragma unroll
                    for (int n = 0; n < 2; ++n) acc[a][b][m][n] = (f32x4){0.f, 0.f, 0.f, 0.f};
        cur = nxt; cA = nA; cB = nB; ++ui;
#pragma unroll
        for (int q = 0; q < 4; ++q) offC[q] = offN[q];
        if (wr == 1) PG8_BAR;
    }
    PG8_WAIT_V(0);
    PG8_BAR;
#undef PG8_STAGE_A
#undef PG8_STAGE_B
#undef PG8_WAIT_V
#undef PG8_WAIT_L
#undef PG8_BAR
#undef PG8_SCHED
}
}

struct Frame {
    LAS unsigned char* lds;
    volatile LAS unsigned* MISC;
    unsigned* ctl;
    int tid, lane, wave, vcu, G;
    unsigned char* ws;
    float* out;
};
__device__ __forceinline__ const float* inptr(int i) {
    const float* const* ka = (const float* const*)__builtin_amdgcn_kernarg_segment_ptr();
    asm volatile("" : "+s"(ka));
    return ka[i];
}
#define WSP(F, off, type) ((type*)((F).ws + (off)))

template <class RowMap>
__device__ __forceinline__ void transpose_tile(const float* W, int K, int N, bf16_t* WT, LAS unsigned char* scr, int item, int lane, const RowMap& rm) {
    const int nblk = N / 64, kb = item / nblk, nb = item % nblk, k0 = 64 * kb, n0 = 64 * nb;
    const int kg = lane & 3, ng = lane >> 2;
    f32x4 v[4][4];
#pragma unroll
    for (int r = 0; r < 4; ++r)
#pragma unroll
        for (int i = 0; i < 4; ++i) v[r][i] = *(const f32x4*)(W + (size_t)(k0 + 16 * r + 4 * kg + i) * N + n0 + 4 * ng);
#pragma unroll
    for (int r = 0; r < 4; ++r)
#pragma unroll
        for (int j = 0; j < 4; ++j)
            *(LAS u32x2*)(scr + (4 * ng + j) * 144 + (16 * r + 4 * kg) * 2) = (u32x2){cvt_pk_bf16(v[r][0][j], v[r][1][j]), cvt_pk_bf16(v[r][2][j], v[r][3][j])};
    asm volatile("s_waitcnt lgkmcnt(0)" ::: "memory");
    const int c = lane & 7;
#pragma unroll
    for (int q = 0; q < 8; ++q) { const int n = (lane >> 3) + 8 * q; const u32x4 o = *(const LAS u32x4*)(scr + n * 144 + c * 16); *(u32x4*)(WT + (size_t)rm(n0 + n) * K + k0 + 8 * c) = o; }
    asm volatile("s_waitcnt lgkmcnt(0)" ::: "memory");
}
struct RmId { __device__ __forceinline__ int operator()(int n) const { return n; } };
struct RmWin { __device__ __forceinline__ int operator()(int n) const {
        const int s = n >> 9; if (s != 4 && s != 5) return n;
        const int d = n & 127, dd = d & 63; const int p = 8 * (dd >> 2) + (dd & 3) + ((d >> 6) << 2); return n - d + p; } };
struct RmGu { __device__ __forceinline__ int operator()(int n) const { const int half = n >> 10, j = (n & 1023) >> 7, i = n & 127; return 256 * j + 128 * half + i; } };

__device__ __forceinline__ void p0_prologue(Frame& F) {
    const int tid = F.tid;
    {
        LAS float* red = (LAS float*)F.lds;
        const float* c = inptr(1);
        for (int u = F.vcu; u < 192; u += F.G) {
            const int l = u / 96, cg = u % 96, kq = tid >> 4, cq = tid & 15;
            const float* W = inptr(2) + (size_t)l * D * 6 * D + cg * 64 + cq * 4;
            f32x4 a = {0.f, 0.f, 0.f, 0.f};
#pragma unroll 8
            for (int j = 0; j < 32; ++j) { const int k = kq + 32 * j; const float cv = siluf_(c[k]); const f32x4 w = *(const f32x4*)(W + (size_t)k * 6 * D); a += w * cv; }
            __syncthreads();
            *(LAS f32x4*)(red + kq * 64 + cq * 4) = a;
            __syncthreads();
            if (tid < 64) { float s = 0.f;
#pragma unroll 8
                for (int k = 0; k < 32; ++k) s += red[k * 64 + tid];
                const int col = cg * 64 + tid;
                WSP(F, WS_MOD, float)[l * 6 * D + col] = s + inptr(3)[l * 6 * D + col]; }
        }
        __syncthreads();
    }
    if (F.vcu == 0) { const float* hb = inptr(5); const float a = hb[tid], b = hb[512 + tid]; WSP(F, WS_LB, float)[tid] = 1.0f / (1.0f + __expf(b - a)); }
    {
        f32x2* rope = WSP(F, WS_ROPE, f32x2);
        for (int idx = F.vcu * NTH + tid; idx < T * 64; idx += F.G * NTH) {
            const int t = idx >> 6, d = idx & 63;
            const float inv = exp2f(-(float)d * (13.287712379549449f / 64.0f));
            const float ang = (float)t * inv;
            const double a = (double)ang; const double n = __builtin_rint(a * 0.15915494309189535); const double r = __builtin_fma(-n, 6.283185307179586, a);
            const float rf = (float)r;
            rope[idx] = (f32x2){__cosf(rf), __sinf(rf)};
        }
    }
    {
        LAS unsigned char* scr = F.lds + F.wave * 16384;
        const int gw = F.vcu * NWAVES + F.wave, NGW = F.G * NWAVES;
        constexpr int I_IN = 16 * 64, I_OUT = 16 * 16, I_POOL = 4 * 4 * 4, I_GU = 64 * 16 * 32, I_DN = 64 * 16 * 16;
        constexpr int NITEMS = I_IN + I_OUT + I_POOL + I_GU + I_DN;
        for (int it = gw; it < NITEMS; it += NGW) {
            int r = it;
            if (r < I_IN) { transpose_tile(inptr(4), D, INW, WSP(F, WS_WINT, bf16_t), scr, r, F.lane, RmWin()); continue; } r -= I_IN;
            if (r < I_OUT) { transpose_tile(inptr(8), D, D, WSP(F, WS_WOUTT, bf16_t), scr, r, F.lane, RmId()); continue; } r -= I_OUT;
            if (r < I_POOL) { const int g = r / 16; transpose_tile(inptr(9) + (size_t)g * 65536, 256, 256, WSP(F, WS_POOLT, bf16_t) + (size_t)g * 65536, scr, r % 16, F.lane, RmId()); continue; } r -= I_POOL;
            if (r < I_GU) { const int m = r / 512; transpose_tile(inptr(14) + (size_t)m * D * 2048, D, 2048, WSP(F, WS_WGUT, bf16_t) + (size_t)m * 2048 * D, scr, r % 512, F.lane, RmGu()); continue; } r -= I_GU;
            { const int m = r / 256; transpose_tile(inptr(16) + (size_t)m * D * D, D, D, WSP(F, WS_WDNT, bf16_t) + (size_t)m * D * D, scr, r % 256, F.lane, RmId()); }
        }
    }
}

__device__ __forceinline__ void p1_norm_in(Frame& F) {
    const float* mod = WSP(F, WS_MOD, float);
    f32x4 sh[4], sc[4];
#pragma unroll
    for (int j = 0; j < 4; ++j) { sh[j] = *(const f32x4*)(mod + 0 * D + 4 * F.lane + 256 * j); sc[j] = *(const f32x4*)(mod + 1 * D + 4 * F.lane + 256 * j) + 1.0f; }
    const int gw = F.vcu * NWAVES + F.wave, NGW = F.G * NWAVES;
    for (int row = gw; row < T; row += NGW) {
        const f32x4* xr = (const f32x4*)(inptr(0) + (size_t)row * D) + F.lane;
        f32x4 v[4]; float s = 0.f;
#pragma unroll
        for (int j = 0; j < 4; ++j) { v[j] = xr[64 * j]; s += (v[j].x * v[j].x + v[j].y * v[j].y) + (v[j].z * v[j].z + v[j].w * v[j].w); }
        const float rstd = rsqrtf(wave_sum(s) * (1.f / D) + EPS);
        u32x2* o = (u32x2*)(WSP(F, WS_HN, bf16_t) + (size_t)row * D) + F.lane;
#pragma unroll
        for (int j = 0; j < 4; ++j) { const f32x4 h = v[j] * rstd * sc[j] + sh[j]; o[64 * j] = (u32x2){cvt_pk_bf16(h.x, h.y), cvt_pk_bf16(h.z, h.w)}; }
    }
}

using pg8::Unit;
typedef f32x4 AccT[2][2][4][2];

struct GemmBase {
    int G, vcu;
    __device__ __forceinline__ void aoff_lin(int R0, int C0, unsigned lda_bytes, unsigned (&off)[4]) const {
#pragma unroll
        for (int q = 0; q < 4; ++q) off[q] = (unsigned)(R0 + 64 * (q & 1) + 128 * (q >> 1)) * lda_bytes + (unsigned)C0 * 2u;
    }
};

struct PolWin : GemmBase {
    const bf16_t* A; const bf16_t* Bt; bf16_t* qkvg; float* gbuf; const float* lb; const f32x2* rope;
    __device__ __forceinline__ int nt() const { return D / 64; }
    __device__ __forceinline__ unsigned ldb_bytes() const { return D * 2; }
    __device__ __forceinline__ bool next(int i, Unit& u) const {
        const int V = i * G + vcu; if (V >= 64 * 16) return false;
        u.p0 = V >> 4; u.p1 = V & 15; u.A = (const char*)(A + (size_t)u.p0 * 256 * D); u.B = (const char*)(Bt + (size_t)u.p1 * 256 * D); return true; }
    __device__ __forceinline__ void aoff(const Unit&, int R0, int C0, unsigned (&off)[4]) const { aoff_lin(R0, C0, D * 2, off); }
    __device__ __forceinline__ void epi(const AccT& acc, const Unit& u, int wr, int wc, int fr, int fq) const {
        const int pm = u.p0, pn = u.p1, s = pn >> 1;
        const int row0 = pm * 256 + wr * 64 + fr;
        const int o0 = (pn & 1) * 256 + wc * 32 + 8 * fq;
        const int dbase = (s & 3) * 1024 + (s >> 2) * 512;
#pragma unroll
        for (int ai = 0; ai < 2; ++ai)
#pragma unroll
            for (int m = 0; m < 4; ++m) {
                const int row = row0 + ai * 128 + m * 16;
                bf16_t* orow = qkvg + (size_t)row * INW + dbase;
#pragma unroll
                for (int bj = 0; bj < 2; ++bj) {
                    const int o = o0 + bj * 128;
                    f32x4 v0 = acc[ai][bj][m][0], v1 = acc[ai][bj][m][1];
                    if (s == 4 || s == 5) {
                        const int hd = o & ~127, d0 = 4 * (((o & 127) >> 3));
                        const f32x4* rp = (const f32x4*)(rope + (size_t)row * 64 + d0);
                        const f32x4 c01 = rp[0], c23 = rp[1];
                        const f32x4 cs = {c01.x, c01.z, c23.x, c23.z}, sn = {c01.y, c01.w, c23.y, c23.w};
                        f32x4 o1 = v0 * cs - v1 * sn, o2 = v0 * sn + v1 * cs;
                        if (s == 5) { o1 = o1 * 0.08838834764831845f; o2 = o2 * 0.08838834764831845f; }
                        *(u32x2*)(orow + hd + d0) = (u32x2){cvt_pk_bf16(o1.x, o1.y), cvt_pk_bf16(o1.z, o1.w)};
                        *(u32x2*)(orow + hd + d0 + 64) = (u32x2){cvt_pk_bf16(o2.x, o2.y), cvt_pk_bf16(o2.z, o2.w)};
                    } else {
                        if (s == 0 || s == 3 || s == 7) {
#pragma unroll
                            for (int j = 0; j < 4; ++j) { v0[j] = siluf_(v0[j]); v1[j] = siluf_(v1[j]); }
                        } else if (s == 1) {
                            const f32x4 l0 = *(const f32x4*)(lb + o), l1 = *(const f32x4*)(lb + o + 4);
                            f32x4 g0, g1;
#pragma unroll
                            for (int j = 0; j < 4; ++j) {
                                const float f0 = l0[j] + (1.0f - l0[j]) * sigmoidf_(v0[j]), f1 = l1[j] + (1.0f - l1[j]) * sigmoidf_(v1[j]);
                                g0[j] = __logf(f0); g1[j] = __logf(f1); v0[j] = 1.0f - f0; v1[j] = 1.0f - f1; }
                            float* gr = gbuf + (size_t)row * 512 + o;
                            *(f32x4*)gr = g0; *(f32x4*)(gr + 4) = g1;
                        }
                        u32x4 w; w.x = cvt_pk_bf16(v0[0], v0[1]); w.y = cvt_pk_bf16(v0[2], v0[3]); w.z = cvt_pk_bf16(v1[0], v1[1]); w.w = cvt_pk_bf16(v1[2], v1[3]);
                        *(u32x4*)(orow + o) = w;
                    }
                }
            }
    }
};

struct PolRes : GemmBase {
    const bf16_t* A; const bf16_t* Bt; const float* resid; float* outp; const float* gate; const float* bias; const float* scale;
    int K, lda, nN, kcol;
    __device__ __forceinline__ int nt() const { return K / 64; }
    __device__ __forceinline__ unsigned ldb_bytes() const { return (unsigned)K * 2u; }
    __device__ __forceinline__ bool next(int i, Unit& u) const {
        const int V = i * G + vcu; if (V >= 64 * nN) return false;
        u.p0 = V / nN; u.p1 = V % nN; u.A = (const char*)(A + (size_t)u.p0 * 256 * lda + (size_t)u.p1 * kcol); u.B = (const char*)(Bt + (size_t)u.p1 * 256 * K); return true; }
    __device__ __forceinline__ void aoff(const Unit&, int R0, int C0, unsigned (&off)[4]) const { aoff_lin(R0, C0, (unsigned)lda * 2u, off); }
    __device__ __forceinline__ void epi(const AccT& acc, const Unit& u, int wr, int wc, int fr, int fq) const {
        const int row0 = u.p0 * 256 + wr * 64 + fr, col0 = u.p1 * 256 + wc * 32 + 8 * fq;
#pragma unroll
        for (int bj = 0; bj < 2; ++bj) {
            const int c = col0 + bj * 128;
            const f32x4 g0 = *(const f32x4*)(gate + c), g1 = *(const f32x4*)(gate + c + 4);
            f32x4 b0 = {0.f, 0.f, 0.f, 0.f}, b1 = b0, s0 = {1.f, 1.f, 1.f, 1.f}, s1 = s0;
            if (bias) { b0 = *(const f32x4*)(bias + c); b1 = *(const f32x4*)(bias + c + 4); s0 = *(const f32x4*)(scale + c); s1 = *(const f32x4*)(scale + c + 4); }
#pragma unroll
            for (int ai = 0; ai < 2; ++ai)
#pragma unroll
                for (int m = 0; m < 4; ++m) {
                    const size_t idx = (size_t)(row0 + ai * 128 + m * 16) * D + c;
                    const f32x4 r0 = *(const f32x4*)(resid + idx), r1 = *(const f32x4*)(resid + idx + 4);
                    *(f32x4*)(outp + idx) = r0 + g0 * ((acc[ai][bj][m][0] + b0) * s0);
                    *(f32x4*)(outp + idx + 4) = r1 + g1 * ((acc[ai][bj][m][1] + b1) * s1);
                }
        }
    }
};

constexpr int MI_TPRE = 16, MI_CNT = 64, MI_MT2E = 128;
__device__ __forceinline__ void expert_tables(Frame& F, int layer) {
    if (F.tid == 0) {
        int pre = 0;
        for (int e = 0; e < NE; ++e) {
            int c = (int)__hip_atomic_load(F.ctl + CW_CNT + 64 * layer + e, __ATOMIC_RELAXED, __HIP_MEMORY_SCOPE_AGENT);
            if (c > LIST_CAP) c = LIST_CAP;
            F.MISC[MI_TPRE + e] = pre; F.MISC[MI_CNT + e] = c;
            const int nt_ = (c + 255) >> 8;
            for (int q = 0; q < nt_; ++q) F.MISC[MI_MT2E + pre + q] = e;
            pre += nt_;
        }
        F.MISC[MI_TPRE + NE] = pre;
    }
    __syncthreads();
}
struct PolG1 : GemmBase {
    volatile LAS unsigned* MISC; const bf16_t* hn; const bf16_t* wgut; const float* bgu; const int* lslot; bf16_t* act;
    __device__ __forceinline__ int nt() const { return D / 64; }
    __device__ __forceinline__ unsigned ldb_bytes() const { return D * 2; }
    __device__ __forceinline__ bool next(int i, Unit& u) const {
        const int V = i * G + vcu, MT = (int)MISC[MI_TPRE + NE]; if (V >= MT * 8) return false;
        const int mt = V >> 3, nt_ = V & 7, e = (int)MISC[MI_MT2E + mt];
        u.p0 = e; u.p1 = mt - (int)MISC[MI_TPRE + e]; u.p2 = nt_; u.p3 = mt;
        u.A = (const char*)hn; u.B = (const char*)(wgut + ((size_t)e * 2048 + (size_t)nt_ * 256) * D); return true; }
    __device__ __forceinline__ void aoff(const Unit& u, int R0, int C0, unsigned (&off)[4]) const {
        const int cnt = (int)MISC[MI_CNT + u.p0]; const int* ls = lslot + (size_t)u.p0 * LIST_CAP + u.p1 * 256;
#pragma unroll
        for (int q = 0; q < 4; ++q) { const int r = R0 + 64 * (q & 1) + 128 * (q >> 1); const int tok = (u.p1 * 256 + r < cnt) ? (ls[r] >> 2) : 0; off[q] = (unsigned)tok * (D * 2u) + (unsigned)C0 * 2u; }
    }
    __device__ __forceinline__ void epi(const AccT& acc, const Unit& u, int wr, int wc, int fr, int fq) const {
        const int colg = u.p2 * 128 + wc * 32 + 8 * fq;
        const float* bg = bgu + (size_t)u.p0 * 2048;
        const f32x4 bgl0 = *(const f32x4*)(bg + colg), bgl1 = *(const f32x4*)(bg + colg + 4), bln0 = *(const f32x4*)(bg + 1024 + colg), bln1 = *(const f32x4*)(bg + 1024 + colg + 4);
        bf16_t* base = act + ((size_t)u.p3 * 256 + wr * 64 + fr) * D + colg;
#pragma unroll
        for (int ai = 0; ai < 2; ++ai)
#pragma unroll
            for (int m = 0; m < 4; ++m) {
                f32x4 gl0 = acc[ai][0][m][0] + bgl0, gl1 = acc[ai][0][m][1] + bgl1, ln0 = acc[ai][1][m][0] + bln0, ln1 = acc[ai][1][m][1] + bln1;
                f32x4 a0, a1;
#pragma unroll
                for (int j = 0; j < 4; ++j) {
                    const float x0 = fminf(gl0[j], SW_LIMIT), x1 = fminf(gl1[j], SW_LIMIT);
                    const float y0 = fminf(fmaxf(ln0[j], -SW_LIMIT), SW_LIMIT), y1 = fminf(fmaxf(ln1[j], -SW_LIMIT), SW_LIMIT);
                    a0[j] = x0 * sigmoidf_(SW_ALPHA * x0) * (y0 + 1.0f); a1[j] = x1 * sigmoidf_(SW_ALPHA * x1) * (y1 + 1.0f); }
                u32x4 w; w.x = cvt_pk_bf16(a0[0], a0[1]); w.y = cvt_pk_bf16(a0[2], a0[3]); w.z = cvt_pk_bf16(a1[0], a1[1]); w.w = cvt_pk_bf16(a1[2], a1[3]);
                *(u32x4*)(base + (size_t)(ai * 128 + m * 16) * D) = w;
            }
    }
};
struct PolG2 : GemmBase {
    volatile LAS unsigned* MISC; const bf16_t* act; const bf16_t* wdnt; const float* bdn; const int* lslot; const float* lw; bf16_t* yslot;
    __device__ __forceinline__ int nt() const { return D / 64; }
    __device__ __forceinline__ unsigned ldb_bytes() const { return D * 2; }
    __device__ __forceinline__ bool next(int i, Unit& u) const {
        const int V = i * G + vcu, MT = (int)MISC[MI_TPRE + NE]; if (V >= MT * 4) return false;
        const int mt = V >> 2, nt_ = V & 3, e = (int)MISC[MI_MT2E + mt];
        u.p0 = e; u.p1 = mt - (int)MISC[MI_TPRE + e]; u.p2 = nt_; u.p3 = mt;
        u.A = (const char*)(act + (size_t)mt * 256 * D); u.B = (const char*)(wdnt + ((size_t)e * D + (size_t)nt_ * 256) * D); return true; }
    __device__ __forceinline__ void aoff(const Unit&, int R0, int C0, unsigned (&off)[4]) const { aoff_lin(R0, C0, D * 2, off); }
    __device__ __forceinline__ void epi(const AccT& acc, const Unit& u, int wr, int wc, int fr, int fq) const {
        const int cnt = (int)MISC[MI_CNT + u.p0];
        const int col0 = u.p2 * 256 + wc * 32 + 8 * fq;
        const float* bd = bdn + (size_t)u.p0 * D;
        const int* ls = lslot + (size_t)u.p0 * LIST_CAP; const float* lwp = lw + (size_t)u.p0 * LIST_CAP;
#pragma unroll
        for (int ai = 0; ai < 2; ++ai)
#pragma unroll
            for (int m = 0; m < 4; ++m) {
                const int li = u.p1 * 256 + ai * 128 + wr * 64 + m * 16 + fr;
                if (li < cnt) {
                    const int slot = ls[li]; const float w = lwp[li];
                    bf16_t* yr = yslot + (size_t)slot * D + col0;
#pragma unroll
                    for (int bj = 0; bj < 2; ++bj) {
                        const f32x4 b0 = *(const f32x4*)(bd + col0 + bj * 128), b1 = *(const f32x4*)(bd + col0 + bj * 128 + 4);
                        const f32x4 v0 = (acc[ai][bj][m][0] + b0) * w, v1 = (acc[ai][bj][m][1] + b1) * w;
                        u32x4 o; o.x = cvt_pk_bf16(v0[0], v0[1]); o.y = cvt_pk_bf16(v0[2], v0[3]); o.z = cvt_pk_bf16(v1[0], v1[1]); o.w = cvt_pk_bf16(v1[2], v1[3]);
                        *(u32x4*)(yr + bj * 128) = o;
                    }
                }
            }
    }
};

template <class P> __device__ __forceinline__ void run_gemm(Frame& F, const P& S) {
#if SIMPLE_GEMM
    pg8::gemm_simple<P>(F.lds, S);
#else
    pg8::gemm_pipe<P>(F.lds, S);
#endif
}

constexpr int LA_QA = 0, LA_QH = 17408, LA_KA = 34816, LA_VT = 52224, LA_AS = 70656, LA_ST = 79872, LA_QS = 114688, LA_PS = 118784;
constexpr int RS128 = 272, RS64 = 144;
__device__ __forceinline__ float ret_lg(int hh) { return __logf(1.0f - exp2f(-5.0f - (float)(hh - 4))); }
__device__ __forceinline__ u32x4 pack8(const float (&v)[8]) { return (u32x4){cvt_pk_bf16(v[0], v[1]), cvt_pk_bf16(v[2], v[3]), cvt_pk_bf16(v[4], v[5]), cvt_pk_bf16(v[6], v[7])}; }

__device__ __forceinline__ void la_cumsum(const float* gbuf, int hh, int t0, int d0, float (&b0)[8], float (&b1)[8]) {
    if (hh < 4) { float r0 = 0.f, r1 = 0.f;
#pragma unroll
        for (int i = 0; i < 8; ++i) { const f32x2 g = *(const f32x2*)(gbuf + (size_t)(t0 + i) * 512 + hh * 128 + d0); r0 += g.x; r1 += g.y; b0[i] = r0; b1[i] = r1; }
    } else { const float lg = ret_lg(hh);
#pragma unroll
        for (int i = 0; i < 8; ++i) { b0[i] = (float)(i + 1) * lg; b1[i] = b0[i]; }
    }
}

__device__ __forceinline__ void la_local_state(Frame& F) {
    const bf16_t* qkvg = WSP(F, WS_QKVG, bf16_t); const float* gbuf = WSP(F, WS_GBUF, float); float* kvt = WSP(F, WS_KVT, float); float* dec = WSP(F, WS_DEC, float);
    LAS unsigned char* lds = F.lds; LAS float* qs = (LAS float*)(lds + LA_QS);
    const int lane = F.lane, oc = F.wave, d0 = 2 * lane, fr = lane & 15, fq = lane >> 4;
    for (int unit = F.vcu; unit < 2048; unit += F.G) {
        const int hh = unit >> 8, n = unit & 255, t0 = n * 64 + oc * 8;
        float b0[8], b1[8]; la_cumsum(gbuf, hh, t0, d0, b0, b1);
        *(LAS f32x2*)(qs + oc * 128 + d0) = (f32x2){b0[7], b1[7]};
        unsigned kk[8], vv[8];
#pragma unroll
        for (int i = 0; i < 8; ++i) { const bf16_t* row = qkvg + (size_t)(t0 + i) * INW + hh * 128 + d0; kk[i] = *(const unsigned*)(row + 1024); vv[i] = *(const unsigned*)(row + 2048); }
        __syncthreads();
        float base0 = 0.f, base1 = 0.f, tot0 = 0.f, tot1 = 0.f;
#pragma unroll
        for (int o = 0; o < 8; ++o) { const f32x2 q = *(const LAS f32x2*)(qs + o * 128 + d0); if (o < oc) { base0 += q.x; base1 += q.y; } tot0 += q.x; tot1 += q.y; }
        float a0[8], a1[8], c0[8], c1[8];
#pragma unroll
        for (int i = 0; i < 8; ++i) { a0[i] = bflo(kk[i]) * __expf(tot0 - base0 - b0[i]); a1[i] = bfhi(kk[i]) * __expf(tot1 - base1 - b1[i]); c0[i] = bflo(vv[i]); c1[i] = bfhi(vv[i]); }
        *(LAS u32x4*)(lds + LA_QA + d0 * RS64 + oc * 16) = pack8(a0); *(LAS u32x4*)(lds + LA_QA + (d0 + 1) * RS64 + oc * 16) = pack8(a1);
        *(LAS u32x4*)(lds + LA_VT + d0 * RS64 + oc * 16) = pack8(c0); *(LAS u32x4*)(lds + LA_VT + (d0 + 1) * RS64 + oc * 16) = pack8(c1);
        if (oc == 0) *(f32x2*)(dec + ((size_t)hh * 256 + n) * 128 + d0) = (f32x2){__expf(tot0), __expf(tot1)};
        __syncthreads();
        const int et = oc;
        bf16x8 vt[2];
#pragma unroll
        for (int ks = 0; ks < 2; ++ks) vt[ks] = *(const LAS bf16x8*)(lds + LA_VT + (16 * et + fr) * RS64 + (32 * ks + 8 * fq) * 2);
        float* orow = kvt + (((size_t)hh * 256 + n) * 128 + 16 * et + fr) * 128 + 4 * fq;
#pragma unroll
        for (int dt = 0; dt < 8; ++dt) {
            f32x4 acc = {0.f, 0.f, 0.f, 0.f};
#pragma unroll
            for (int ks = 0; ks < 2; ++ks) { const bf16x8 a = *(const LAS bf16x8*)(lds + LA_QA + (16 * dt + fr) * RS64 + (32 * ks + 8 * fq) * 2); acc = __builtin_amdgcn_mfma_f32_16x16x32_bf16(a, vt[ks], acc, 0, 0, 0); }
            *(f32x4*)(orow + 16 * dt) = acc;
        }
        __syncthreads();
    }
}

__device__ __forceinline__ void la_scan(Frame& F) {
    const float* kvt = WSP(F, WS_KVT, float); const float* dec = WSP(F, WS_DEC, float); bf16_t* sprev = WSP(F, WS_SPREV, bf16_t);
    for (int idx = F.vcu * NTH + F.tid; idx < 8 * 16384; idx += F.G * NTH) {
        const int hh = idx >> 14, rem = idx & 16383, d = rem & 127;
        const float* kv = kvt + (size_t)hh * 256 * 16384 + rem; const float* dc = dec + (size_t)hh * 256 * 128 + d; bf16_t* sp = sprev + (size_t)hh * 256 * 16384 + rem;
        float S = 0.f;
        for (int n0 = 0; n0 < 256; n0 += 8) {
            float kvv[8], dd[8];
#pragma unroll
            for (int i = 0; i < 8; ++i) { kvv[i] = kv[(size_t)(n0 + i) * 16384]; dd[i] = dc[(n0 + i) * 128]; }
#pragma unroll
            for (int i = 0; i < 8; ++i) { sp[(size_t)(n0 + i) * 16384] = (bf16_t)(cvt_pk_bf16(S, 0.f) & 0xffffu); S = dd[i] * S + kvv[i]; }
        }
    }
}

__device__ __forceinline__ void la_output(Frame& F) {
    const bf16_t* qkvg = WSP(F, WS_QKVG, bf16_t); const float* gbuf = WSP(F, WS_GBUF, float); const bf16_t* sprev = WSP(F, WS_SPREV, bf16_t); bf16_t* cat = WSP(F, WS_CAT, bf16_t);
    LAS unsigned char* lds = F.lds; LAS float* qs = (LAS float*)(lds + LA_QS); LAS float* ps = (LAS float*)(lds + LA_PS);
    const int tid = F.tid, lane = F.lane, oc = F.wave, d0 = 2 * lane, fr = lane & 15, fq = lane >> 4;
    for (int unit = F.vcu; unit < 2048; unit += F.G) {
        const int hh = unit >> 8, n = unit & 255, t0 = n * 64 + oc * 8;
        float b0[8], b1[8]; la_cumsum(gbuf, hh, t0, d0, b0, b1);
        *(LAS f32x2*)(qs + oc * 128 + d0) = (f32x2){b0[7], b1[7]};
        unsigned qq[8], kk[8], vv[8];
#pragma unroll
        for (int i = 0; i < 8; ++i) { const bf16_t* row = qkvg + (size_t)(t0 + i) * INW + hh * 128 + d0; qq[i] = *(const unsigned*)row; kk[i] = *(const unsigned*)(row + 1024); vv[i] = *(const unsigned*)(row + 2048); }
        {
            const bf16_t* sp = sprev + ((size_t)hh * 256 + n) * 16384;
#pragma unroll
            for (int j = 0; j < 4; ++j) { const int c = tid + NTH * j, row = c >> 4, c16 = c & 15; *(LAS u32x4*)(lds + LA_ST + row * RS128 + c16 * 16) = *(const u32x4*)(sp + row * 128 + c16 * 8); }
        }
        __syncthreads();
        float base0 = 0.f, base1 = 0.f, bm0 = 0.f, bm1 = 0.f;
#pragma unroll
        for (int o = 0; o < 8; ++o) { const f32x2 q = *(const LAS f32x2*)(qs + o * 128 + d0); if (o < oc) { base0 += q.x; base1 += q.y; } if (o < 4) { bm0 += q.x; bm1 += q.y; } }
        float c0[8], c1[8];
#pragma unroll
        for (int i = 0; i < 8; ++i) {
            const int t = 8 * oc + i; const float bt0 = base0 + b0[i], bt1 = base1 + b1[i];
            const float q0 = bflo(qq[i]), q1 = bfhi(qq[i]), k0 = bflo(kk[i]), k1 = bfhi(kk[i]);
            *(LAS unsigned*)(lds + LA_QA + t * RS128 + d0 * 2) = cvt_pk_bf16(q0 * __expf(bt0 - bm0), q1 * __expf(bt1 - bm1));
            *(LAS unsigned*)(lds + LA_QH + t * RS128 + d0 * 2) = cvt_pk_bf16(q0 * __expf(bt0), q1 * __expf(bt1));
            *(LAS unsigned*)(lds + LA_KA + t * RS128 + d0 * 2) = cvt_pk_bf16(k0 * __expf(bm0 - bt0), k1 * __expf(bm1 - bt1));
            c0[i] = bflo(vv[i]); c1[i] = bfhi(vv[i]);
        }
        *(LAS u32x4*)(lds + LA_VT + d0 * RS64 + oc * 16) = pack8(c0); *(LAS u32x4*)(lds + LA_VT + (d0 + 1) * RS64 + oc * 16) = pack8(c1);
        __syncthreads();
        const int tt = oc >> 1, eh = oc & 1;
        {
            bf16x8 qf[4];
#pragma unroll
            for (int ks = 0; ks < 4; ++ks) qf[ks] = *(const LAS bf16x8*)(lds + LA_QA + (16 * tt + fr) * RS128 + (32 * ks + 8 * fq) * 2);
#pragma unroll
            for (int sti = 0; sti < 2; ++sti) {
                const int st = 2 * eh + sti;
                f32x4 acc = {0.f, 0.f, 0.f, 0.f};
                if (st <= tt) {
#pragma unroll
                    for (int ks = 0; ks < 4; ++ks) { const bf16x8 a = *(const LAS bf16x8*)(lds + LA_KA + (16 * st + fr) * RS128 + (32 * ks + 8 * fq) * 2); acc = __builtin_amdgcn_mfma_f32_16x16x32_bf16(a, qf[ks], acc, 0, 0, 0); }
                    if (st == tt) {
#pragma unroll
                        for (int r = 0; r < 4; ++r) if (4 * fq + r > fr) acc[r] = 0.f;
                    }
                }
                *(LAS u32x2*)(lds + LA_AS + (16 * tt + fr) * RS64 + (16 * st + 4 * fq) * 2) = (u32x2){cvt_pk_bf16(acc[0], acc[1]), cvt_pk_bf16(acc[2], acc[3])};
            }
        }
        __syncthreads();
        f32x4 o[4]; float ss = 0.f;
        {
            bf16x8 af[2], hf[4];
#pragma unroll
            for (int ks = 0; ks < 2; ++ks) af[ks] = *(const LAS bf16x8*)(lds + LA_AS + (16 * tt + fr) * RS64 + (32 * ks + 8 * fq) * 2);
#pragma unroll
            for (int ks = 0; ks < 4; ++ks) hf[ks] = *(const LAS bf16x8*)(lds + LA_QH + (16 * tt + fr) * RS128 + (32 * ks + 8 * fq) * 2);
#pragma unroll
            for (int ei = 0; ei < 4; ++ei) {
                const int et = 4 * eh + ei;
                f32x4 acc = {0.f, 0.f, 0.f, 0.f};
#pragma unroll
                for (int ks = 0; ks < 2; ++ks) { const bf16x8 a = *(const LAS bf16x8*)(lds + LA_VT + (16 * et + fr) * RS64 + (32 * ks + 8 * fq) * 2); acc = __builtin_amdgcn_mfma_f32_16x16x32_bf16(a, af[ks], acc, 0, 0, 0); }
#pragma unroll
                for (int ks = 0; ks < 4; ++ks) { const bf16x8 a = *(const LAS bf16x8*)(lds + LA_ST + (16 * et + fr) * RS128 + (32 * ks + 8 * fq) * 2); acc = __builtin_amdgcn_mfma_f32_16x16x32_bf16(a, hf[ks], acc, 0, 0, 0); }
                o[ei] = acc; ss += (acc[0] * acc[0] + acc[1] * acc[1]) + (acc[2] * acc[2] + acc[3] * acc[3]);
            }
        }
        ss += __shfl_xor(ss, 16); ss += __shfl_xor(ss, 32);
        if (lane < 16) ps[(tt * 2 + eh) * 16 + lane] = ss;
        __syncthreads();
        const float tot = ps[(tt * 2) * 16 + fr] + ps[(tt * 2 + 1) * 16 + fr];
        const float rstd = rsqrtf(tot * (1.f / 128.f) + EPS);
        const float* gain = (hh < 4) ? (inptr(6) + hh * 128) : (inptr(7) + (hh - 4) * 128);
        const size_t rowi = (size_t)(n * 64 + 16 * tt + fr);
#pragma unroll
        for (int ei = 0; ei < 4; ++ei) {
            const int e0 = 16 * (4 * eh + ei) + 4 * fq;
            const f32x4 gn = *(const f32x4*)(gain + e0);
            const u32x2 gt = *(const u32x2*)(qkvg + rowi * INW + 3072 + hh * 128 + e0);
            const f32x4 v = o[ei] * rstd * gn;
            *(u32x2*)(cat + rowi * D + hh * 128 + e0) = (u32x2){cvt_pk_bf16(v[0] * bflo(gt.x), v[1] * bfhi(gt.x)), cvt_pk_bf16(v[2] * bflo(gt.y), v[3] * bfhi(gt.y))};
        }
        __syncthreads();
    }
}

constexpr int WR_STRIDE = 1028;
__device__ __forceinline__ void p_route(Frame& F, int layer, const float* X) {
    const int tid = F.tid, lane = F.lane;
    LAS float* wl = (LAS float*)F.lds;
    LAS int* pe = (LAS int*)(F.lds + 32 * WR_STRIDE * 4);
    LAS float* pw = (LAS float*)(pe + 256);
    LAS int* hist = (LAS int*)(pw + 256);
    LAS int* gbase = hist + 32;
    const float* wr = inptr(12) + (size_t)layer * D * NE;
    for (int idx = tid; idx < D * NE; idx += NTH) { const int c = idx >> 5, e = idx & 31; wl[e * WR_STRIDE + c] = wr[idx]; }
    const float* mod = WSP(F, WS_MOD, float) + (size_t)layer * 6 * D;
    f32x4 sh[4], sc[4];
#pragma unroll
    for (int j = 0; j < 4; ++j) { sh[j] = *(const f32x4*)(mod + 3 * D + 4 * lane + 256 * j); sc[j] = *(const f32x4*)(mod + 4 * D + 4 * lane + 256 * j) + 1.0f; }
    const float bias = inptr(13)[layer * NE + (lane >> 1)];
    int* lslot = WSP(F, WS_LSLOT, int) + (size_t)layer * NE * LIST_CAP; float* lw = WSP(F, WS_LW, float) + (size_t)layer * NE * LIST_CAP;
    __syncthreads();
    for (int tb = F.vcu; tb < T / 64; tb += F.G) {
        if (tid < 32) hist[tid] = 0;
        for (int i = 0; i < 8; ++i) {
            const int tl = F.wave * 8 + i, row = tb * 64 + tl;
            const f32x4* xr = (const f32x4*)(X + (size_t)row * D) + lane;
            f32x4 h[4]; float s = 0.f;
#pragma unroll
            for (int j = 0; j < 4; ++j) { h[j] = xr[64 * j]; s += (h[j].x * h[j].x + h[j].y * h[j].y) + (h[j].z * h[j].z + h[j].w * h[j].w); }
            const float rstd = rsqrtf(wave_sum(s) * (1.f / D) + EPS);
            u32x2* o = (u32x2*)(WSP(F, WS_HN, bf16_t) + (size_t)row * D) + lane;
#pragma unroll
            for (int j = 0; j < 4; ++j) { h[j] = h[j] * rstd * sc[j] + sh[j]; o[64 * j] = (u32x2){cvt_pk_bf16(h[j].x, h[j].y), cvt_pk_bf16(h[j].z, h[j].w)}; }
            float p[32];
#pragma unroll
            for (int eh = 0; eh < 2; ++eh) {
                const LAS float* wb = wl + eh * 16 * WR_STRIDE + 4 * lane;
                asm volatile("" : "+v"(wb));
#pragma unroll
                for (int e = 0; e < 16; ++e) {
                    float a = 0.f;
#pragma unroll
                    for (int j = 0; j < 4; ++j) { const f32x4 w = *(const LAS f32x4*)(wb + e * WR_STRIDE + 256 * j); a += (h[j].x * w.x + h[j].y * w.y) + (h[j].z * w.z + h[j].w * w.w); }
                    p[eh * 16 + e] = a;
                }
            }
#pragma unroll
            for (int st = 0; st < 5; ++st) {
                const int half = 16 >> st, off = 32 >> st; const bool up = (lane & off) != 0;
#pragma unroll
                for (int q = 0; q < half; ++q) { const float send = up ? p[q] : p[q + half]; const float keep = up ? p[q + half] : p[q]; p[q] = keep + __shfl_xor(send, off); }
            }
            float val = p[0] + __shfl_xor(p[0], 1) + bias;
            const int myE = lane >> 1;
            float tv[4]; int te[4];
#pragma unroll
            for (int k = 0; k < 4; ++k) {
                const float mx = wave_max(val);
                const unsigned long long mk = __ballot(val == mx);
                const int e = (int)(__builtin_ctzll(mk) >> 1);
                tv[k] = mx; te[k] = e; if (myE == e) val = -INFINITY;
            }
            const float e1 = __expf(tv[1] - tv[0]), e2 = __expf(tv[2] - tv[0]), e3 = __expf(tv[3] - tv[0]); const float inv = 1.0f / (1.0f + e1 + e2 + e3);
            if (lane == 0) { pe[tl * 4 + 0] = te[0]; pe[tl * 4 + 1] = te[1]; pe[tl * 4 + 2] = te[2]; pe[tl * 4 + 3] = te[3];
                pw[tl * 4 + 0] = inv; pw[tl * 4 + 1] = e1 * inv; pw[tl * 4 + 2] = e2 * inv; pw[tl * 4 + 3] = e3 * inv; }
        }
        __syncthreads();
        int myexp = 0, lpos = 0;
        if (tid < 256) { myexp = pe[tid]; lpos = __hip_atomic_fetch_add(hist + myexp, 1, __ATOMIC_RELAXED, __HIP_MEMORY_SCOPE_WORKGROUP); }
        __syncthreads();
        if (tid < 32) gbase[tid] = (int)atomicAdd(F.ctl + CW_CNT + 64 * layer + tid, (unsigned)hist[tid]);
        __syncthreads();
        if (tid < 256) { const int pos = gbase[myexp] + lpos; if (pos < LIST_CAP) { lslot[(size_t)myexp * LIST_CAP + pos] = tb * 256 + tid; lw[(size_t)myexp * LIST_CAP + pos] = pw[tid]; } }
        __syncthreads();
    }
}

template <int MODE>
__device__ __forceinline__ void p_combine(Frame& F, int layer, const float* Xin, float* Xout) {
    const int lane = F.lane;
    const float* mod = WSP(F, WS_MOD, float) + (size_t)layer * 6 * D;
    const bf16_t* ys = WSP(F, WS_YSLOT, bf16_t);
    f32x4 gf[4], fnw[4];
#pragma unroll
    for (int j = 0; j < 4; ++j) { gf[j] = *(const f32x4*)(mod + 5 * D + 4 * lane + 256 * j); if (MODE == 1) fnw[j] = *(const f32x4*)(inptr(18) + 4 * lane + 256 * j); }
    const int gw = F.vcu * NWAVES + F.wave, NGW = F.G * NWAVES;
    for (int row = gw; row < T; row += NGW) {
        const f32x4* xr = (const f32x4*)(Xin + (size_t)row * D) + lane;
        f32x4 v[4]; float s = 0.f;
#pragma unroll
        for (int j = 0; j < 4; ++j) {
            f32x4 a = {0.f, 0.f, 0.f, 0.f};
#pragma unroll
            for (int k = 0; k < 4; ++k) { const u32x2 y = *((const u32x2*)(ys + ((size_t)row * 4 + k) * D) + lane + 64 * j); a += (f32x4){bflo(y.x), bfhi(y.x), bflo(y.y), bfhi(y.y)}; }
            v[j] = xr[64 * j] + gf[j] * a;
            s += (v[j].x * v[j].x + v[j].y * v[j].y) + (v[j].z * v[j].z + v[j].w * v[j].w);
        }
        const float rstd = rsqrtf(wave_sum(s) * (1.f / D) + EPS);
        f32x4* o = (f32x4*)(Xout + (size_t)row * D) + lane;
        if (MODE == 0) {
#pragma unroll
            for (int j = 0; j < 4; ++j) o[64 * j] = v[j];
            if (lane == 0) WSP(F, WS_RSTD, float)[row] = rstd;
        } else {
#pragma unroll
            for (int j = 0; j < 4; ++j) o[64 * j] = v[j] * rstd * fnw[j];
        }
    }
}

template <int W>
__device__ __forceinline__ void pool_unit(const float* X, const float* rs, bf16_t* P, int c, int t0, float sh, float sc) {
    float hp[16], hc[16];
#pragma unroll
    for (int i = 0; i < 16; ++i) { const int t = t0 - 16 + i; hp[i] = (i >= 16 - (W - 1) && t >= 0) ? X[(size_t)t * D + c] * rs[t] * sc + sh : 0.f; }
    float sum = 0.f;
#pragma unroll
    for (int i = 1; i < W; ++i) sum += hp[16 - i];
#pragma unroll
    for (int blk = 0; blk < 2; ++blk) {
        const int tb = t0 + 16 * blk;
#pragma unroll
        for (int i = 0; i < 16; ++i) hc[i] = X[(size_t)(tb + i) * D + c] * rs[tb + i] * sc + sh;
#pragma unroll
        for (int i = 0; i < 16; ++i) {
            const int t = tb + i;
            sum += hc[i];
            const int cnt = (t + 1 < W) ? (t + 1) : W;
            const float p = sum / (float)cnt - hc[i];
            P[(size_t)t * D + c] = (bf16_t)(cvt_pk_bf16(p, 0.f) & 0xffffu);
            sum -= (i - (W - 1) >= 0) ? hc[(i - (W - 1)) & 15] : hp[(16 + i - (W - 1)) & 15];
        }
#pragma unroll
        for (int i = 0; i < 16; ++i) hp[i] = hc[i];
    }
}
__device__ __forceinline__ void p_pool(Frame& F, const float* X) {
    const float* mod = WSP(F, WS_MOD, float) + (size_t)1 * 6 * D; const float* rs = WSP(F, WS_RSTD, float); bf16_t* P = WSP(F, WS_HN, bf16_t);
    const int tid = F.tid;
    for (int u = F.vcu; u < 1024; u += F.G) {
        const int tt = u >> 2, g = u & 3;
        const int c = g * 256 + (tid & 255), t0 = tt * 64 + (tid >> 8) * 32;
        const float sh = mod[0 * D + c], sc = 1.0f + mod[1 * D + c];
        if (g == 0) pool_unit<2>(X, rs, P, c, t0, sh, sc);
        else if (g == 1) pool_unit<4>(X, rs, P, c, t0, sh, sc);
        else if (g == 2) pool_unit<8>(X, rs, P, c, t0, sh, sc);
        else pool_unit<16>(X, rs, P, c, t0, sh, sc);
    }
}

constexpr int N_PHASES = 17;
__global__ void __launch_bounds__(NTH, 2) fwd_kernel(Args args) {
    extern __shared__ __attribute__((aligned(16))) unsigned char lds_raw[];
    Frame F;
    F.lds = (LAS unsigned char*)lds_raw;
    F.MISC = (volatile LAS unsigned*)(F.lds + MISC_OFF);
    F.tid = threadIdx.x; F.lane = F.tid & 63; F.wave = __builtin_amdgcn_readfirstlane(F.tid >> 6);
    F.G = gridDim.x; { const int bx = blockIdx.x; F.vcu = (F.G % 8 == 0) ? (bx % 8) * (F.G / 8) + bx / 8 : bx; }
    F.ws = args.ws; F.ctl = (unsigned*)(args.ws + WS_CTL); F.out = args.out;
    for (int u = F.tid; u < (LDS_BYTES - MISC_OFF) / 4; u += NTH) F.MISC[u] = 0u;
    __syncthreads();
#if N_LAUNCH_MODE == 1
    XcdBarrier bar = xcd_barrier_post(F.ctl + CW_BAR, F.MISC + 8);
#define GRID_BAR() xcd_barrier(bar)
#else
#define GRID_BAR() do { } while (0)
#endif
    const int lo = args.ph_lo, hi = args.ph_hi;
#define IN(k) (lo <= (k) && (k) < hi)
#define SEAM(k) do { if (IN(k) && IN((k) + 1)) GRID_BAR(); } while (0)
    GemmBase gb; gb.G = F.G; gb.vcu = F.vcu;
    float* X1 = WSP(F, WS_X1, float); float* X2 = WSP(F, WS_X2, float);
    const float* mod0 = WSP(F, WS_MOD, float); const float* mod1 = mod0 + 6 * D;

    if (IN(0)) { p0_prologue(F); } SEAM(0);
    if (IN(1)) { p1_norm_in(F); } SEAM(1);
    if (IN(2)) { PolWin P; (GemmBase&)P = gb; P.A = WSP(F, WS_HN, bf16_t); P.Bt = WSP(F, WS_WINT, bf16_t); P.qkvg = WSP(F, WS_QKVG, bf16_t); P.gbuf = WSP(F, WS_GBUF, float);
        P.lb = WSP(F, WS_LB, float); P.rope = WSP(F, WS_ROPE, f32x2); run_gemm(F, P); } SEAM(2);
    if (IN(3)) { la_local_state(F); } SEAM(3);
    if (IN(4)) { la_scan(F); } SEAM(4);
    if (IN(5)) { la_output(F); } SEAM(5);
    if (IN(6)) { PolRes P; (GemmBase&)P = gb; P.A = WSP(F, WS_CAT, bf16_t); P.Bt = WSP(F, WS_WOUTT, bf16_t); P.resid = inptr(0); P.outp = X1; P.gate = mod0 + 2 * D; P.bias = nullptr; P.scale = nullptr;
        P.K = D; P.lda = D; P.nN = 4; P.kcol = 0; run_gemm(F, P); } SEAM(6);
    if (IN(7)) { p_route(F, 0, X1); } SEAM(7);
    if (IN(8)) { expert_tables(F, 0); PolG1 P; (GemmBase&)P = gb; P.MISC = F.MISC; P.hn = WSP(F, WS_HN, bf16_t); P.wgut = WSP(F, WS_WGUT, bf16_t); P.bgu = inptr(15); P.lslot = WSP(F, WS_LSLOT, int); P.act = WSP(F, WS_ACT, bf16_t);
        run_gemm(F, P); } SEAM(8);
    if (IN(9)) { expert_tables(F, 0); PolG2 P; (GemmBase&)P = gb; P.MISC = F.MISC; P.act = WSP(F, WS_ACT, bf16_t); P.wdnt = WSP(F, WS_WDNT, bf16_t); P.bdn = inptr(17); P.lslot = WSP(F, WS_LSLOT, int); P.lw = WSP(F, WS_LW, float);
        P.yslot = WSP(F, WS_YSLOT, bf16_t); run_gemm(F, P); } SEAM(9);
    if (IN(10)) { p_combine<0>(F, 0, X1, X2); } SEAM(10);
    if (IN(11)) { p_pool(F, X2); } SEAM(11);
    if (IN(12)) { PolRes P; (GemmBase&)P = gb; P.A = WSP(F, WS_HN, bf16_t); P.Bt = WSP(F, WS_POOLT, bf16_t); P.resid = X2; P.outp = X1; P.gate = mod1 + 2 * D; P.bias = inptr(10); P.scale = inptr(11);
        P.K = 256; P.lda = D; P.nN = 4; P.kcol = 256; run_gemm(F, P); } SEAM(12);
    if (IN(13)) { p_route(F, 1, X1); } SEAM(13);
    if (IN(14)) { expert_tables(F, 1); PolG1 P; (GemmBase&)P = gb; P.MISC = F.MISC; P.hn = WSP(F, WS_HN, bf16_t); P.wgut = WSP(F, WS_WGUT, bf16_t) + (size_t)NE * 2048 * D; P.bgu = inptr(15) + (size_t)NE * 2048;
        P.lslot = WSP(F, WS_LSLOT, int) + (size_t)NE * LIST_CAP; P.act = WSP(F, WS_ACT, bf16_t); run_gemm(F, P); } SEAM(14);
    if (IN(15)) { expert_tables(F, 1); PolG2 P; (GemmBase&)P = gb; P.MISC = F.MISC; P.act = WSP(F, WS_ACT, bf16_t); P.wdnt = WSP(F, WS_WDNT, bf16_t) + (size_t)NE * D * D; P.bdn = inptr(17) + (size_t)NE * D;
        P.lslot = WSP(F, WS_LSLOT, int) + (size_t)NE * LIST_CAP; P.lw = WSP(F, WS_LW, float) + (size_t)NE * LIST_CAP; P.yslot = WSP(F, WS_YSLOT, bf16_t); run_gemm(F, P); } SEAM(15);
    if (IN(16)) { p_combine<1>(F, 1, X1, F.out); }
#undef IN
#undef SEAM
}

extern "C" void kernel_launch(void* const* d_in, const int* in_sizes, int n_in, void* d_out, int out_size, void* d_ws, size_t ws_size, hipStream_t stream) {
    static int grid = 0;
    if (grid == 0) {
        if (n_in != 19 || out_size != T * D || ws_size < WS_END) { fprintf(stderr, "kernel_launch: unexpected shapes (n_in %d, out %d, ws %zu)\n", n_in, out_size, ws_size); grid = -1; return; }
        int dev = 0, cus = 0, per_cu = 0;
        if (hipGetDevice(&dev) != hipSuccess || hipDeviceGetAttribute(&cus, hipDeviceAttributeMultiprocessorCount, dev) != hipSuccess) { grid = -1; return; }
        if (hipFuncSetAttribute((const void*)fwd_kernel, hipFuncAttributeMaxDynamicSharedMemorySize, LDS_BYTES) != hipSuccess) { fprintf(stderr, "kernel_launch: hipFuncSetAttribute failed\n"); grid = -1; return; }
        if (hipOccupancyMaxActiveBlocksPerMultiprocessor(&per_cu, (const void*)fwd_kernel, NTH, LDS_BYTES) != hipSuccess || per_cu < 1) { fprintf(stderr, "kernel_launch: occupancy query says %d\n", per_cu); }
        (void)hipGetLastError();
        grid = cus;
    }
    if (grid < 0) return;
    (void)hipMemsetAsync((char*)d_ws + WS_CTL, 0, CTL_BYTES, stream);
    Args a{};
    for (int i = 0; i < 19; ++i) a.in[i] = (const float*)d_in[i];
    a.out = (float*)d_out; a.ws = (unsigned char*)d_ws;
#if N_LAUNCH_MODE == 1
    a.ph_lo = 0; a.ph_hi = N_PHASES;
    void* kargs[] = {&a};
    hipError_t e = hipLaunchCooperativeKernel((const void*)fwd_kernel, dim3(grid), dim3(NTH), kargs, LDS_BYTES, stream);
    if (e != hipSuccess) fprintf(stderr, "cooperative launch failed: %s\n", hipGetErrorString(e));
#else
    for (int p = 0; p < N_PHASES; ++p) {
        a.ph_lo = p; a.ph_hi = p + 1;
        hipLaunchKernelGGL(fwd_kernel, dim3(grid), dim3(NTH), LDS_BYTES, stream, a);
    }
#endif
}
```

```cpp
#include <hip/hip_runtime.h>
#include <cstdio>
#include <cstdint>

#ifndef N_LAUNCH_MODE
#define N_LAUNCH_MODE 1
#endif
#ifndef DUP_PHASE
#define DUP_PHASE -1
#endif
#ifndef SIMPLE_GEMM
#define SIMPLE_GEMM 0
#endif

#define LAS __attribute__((address_space(3)))
#define GAS __attribute__((address_space(1)))
typedef unsigned short bf16_t;
typedef short bf16x8 __attribute__((ext_vector_type(8)));
typedef float f32x4 __attribute__((ext_vector_type(4)));
typedef float f32x2 __attribute__((ext_vector_type(2)));
typedef unsigned u32x4 __attribute__((ext_vector_type(4)));
typedef unsigned u32x2 __attribute__((ext_vector_type(2)));

constexpr int T = 16384, D = 1024, NE = 32, TOPK = 4, DEPTH = 2;
constexpr int INW = 4096;
constexpr int NTH = 512, NWAVES = 8;
constexpr float EPS = 1e-6f;
constexpr float SW_LIMIT = 7.0f, SW_ALPHA = 1.702f;
constexpr int LIST_CAP = T;
constexpr int ACT_ROWS = T * TOPK + NE * 256;

constexpr size_t MiB = 1u << 20;
constexpr size_t WS_CTL = 0, CTL_BYTES = 1 * MiB;
constexpr size_t WS_MOD = 1 * MiB;
constexpr size_t WS_LB = WS_MOD + 65536;
constexpr size_t WS_ROPE = 2 * MiB;
constexpr size_t WS_WINT = 10 * MiB;
constexpr size_t WS_WOUTT = 18 * MiB;
constexpr size_t WS_POOLT = 20 * MiB;
constexpr size_t WS_LSLOT = 22 * MiB;
constexpr size_t WS_LW = 26 * MiB;
constexpr size_t WS_RT = 21 * MiB;
constexpr size_t WS_RSTD = 30 * MiB;
constexpr size_t WS_WGUT = 32 * MiB;
constexpr size_t WS_WDNT = 288 * MiB;
constexpr size_t WS_HN = 416 * MiB;
constexpr size_t WS_QKVG = 448 * MiB;
constexpr size_t WS_GBUF = 576 * MiB;
constexpr size_t WS_KVT = 608 * MiB;
constexpr size_t WS_SPREV = 736 * MiB;
constexpr size_t WS_DEC = 800 * MiB;
constexpr size_t WS_CAT = 802 * MiB;
constexpr size_t WS_X1 = 834 * MiB;
constexpr size_t WS_X2 = 898 * MiB;
constexpr size_t WS_ACT = 962 * MiB;
constexpr size_t WS_YSLOT = 1106 * MiB;
constexpr size_t WS_END = 1234 * MiB;
constexpr int CW_CNT = 64;
constexpr int CW_BAR = 4096;

constexpr int SCR_BYTES = 148 * 1024;
constexpr int MISC_OFF = SCR_BYTES;
constexpr int LDS_BYTES = SCR_BYTES + 4096;

typedef __bf16 bf16x2_t __attribute__((ext_vector_type(2)));
__device__ __forceinline__ unsigned cvt_pk_bf16(float lo, float hi) { const f32x2 v = {lo, hi}; const bf16x2_t b = __builtin_convertvector(v, bf16x2_t); return __builtin_bit_cast(unsigned, b); }
__device__ __forceinline__ float bf2f(unsigned short b) { return __builtin_bit_cast(float, (unsigned)b << 16); }
__device__ __forceinline__ float bflo(unsigned w) { return __builtin_bit_cast(float, w << 16); }
__device__ __forceinline__ float bfhi(unsigned w) { return __builtin_bit_cast(float, w & 0xffff0000u); }
__device__ __forceinline__ float wave_sum(float v) {
#pragma unroll
    for (int o = 1; o < 64; o <<= 1) v += __shfl_xor(v, o);
    return v;
}
__device__ __forceinline__ float wave_max(float v) {
#pragma unroll
    for (int o = 1; o < 64; o <<= 1) v = fmaxf(v, __shfl_xor(v, o));
    return v;
}
__device__ __forceinline__ float sigmoidf_(float x) { return 1.0f / (1.0f + __expf(-x)); }
__device__ __forceinline__ float siluf_(float x) { return x * sigmoidf_(x); }

#define XB_TMO      128
#define XB_XCNT(j)  (256  + 64 * (j))
#define XB_XSUB(j)  (1280 + 64 * (j))
#define XB_XGEN(j)  (2304 + 64 * (j))
#define XB_TOP      3328
#define XB_TOPGEN   3392
#define XCD_BAR_WORDS 3456
#define XB_SPIN_CAP (1u << 20)
__device__ __forceinline__ unsigned xb_ld(unsigned* p)              { return __hip_atomic_load(p, __ATOMIC_RELAXED, __HIP_MEMORY_SCOPE_AGENT); }
__device__ __forceinline__ unsigned xb_add(unsigned* p, unsigned v) { return __hip_atomic_fetch_add(p, v, __ATOMIC_RELAXED, __HIP_MEMORY_SCOPE_AGENT); }
__device__ __forceinline__ unsigned xb_xcc_id() { return (unsigned)__builtin_amdgcn_s_getreg((3 << 11) | 20) & 0xFu; }
#define XB_SPIN(cond, bar) do { unsigned _sp = 0; while (cond) { __builtin_amdgcn_s_sleep(1); \
    if ((++_sp & 255u) == 0u) { if (xb_ld(&(bar)[XB_TMO])) break; if (_sp > XB_SPIN_CAP) { atomicAdd(&(bar)[XB_TMO], 1u); break; } } } } while (0)
struct XcdBarrier { unsigned* bar; unsigned x; volatile LAS unsigned* st; };
__device__ __forceinline__ XcdBarrier xcd_barrier_post(unsigned* bar, volatile LAS unsigned* st) {
    XcdBarrier b; b.bar = bar; b.x = xb_xcc_id(); b.st = st;
    if (threadIdx.x == 0) (void)xb_add(&bar[XB_XCNT(b.x)], 1u);
    return b;
}
__device__ __forceinline__ void xcd_barrier_complete(unsigned* bar, unsigned x, unsigned& nloc, unsigned& nx) {
    const unsigned G = gridDim.x * gridDim.y * gridDim.z;
    unsigned sum, cnt, mine, sp = 0u;
    for (;;) {
        sum = 0u; cnt = 0u; mine = 0u;
#pragma unroll
        for (unsigned j = 0; j < 16; ++j) { const unsigned c = xb_ld(&bar[XB_XCNT(j)]); sum += c; cnt += (c > 0u) ? 1u : 0u; mine = (j == x) ? c : mine; }
        if (sum == G) break;
        __builtin_amdgcn_s_sleep(1);
        if ((++sp & 255u) == 0u) { if (xb_ld(&bar[XB_TMO])) break; if (sp > XB_SPIN_CAP) { atomicAdd(&bar[XB_TMO], 1u); break; } }
    }
    nloc = mine > 0u ? mine : 1u; nx = cnt > 0u ? cnt : 1u;
}
__device__ __forceinline__ void xcd_barrier(const XcdBarrier& b) {
    asm volatile("s_waitcnt vmcnt(0)" ::: "memory");
    __syncthreads();
    if (threadIdx.x == 0) {
        unsigned* bar = b.bar;
        __builtin_amdgcn_s_waitcnt(0);
        unsigned nloc = b.st[0], nx = b.st[1];
        if (nloc == 0u) { xcd_barrier_complete(bar, b.x, nloc, nx); b.st[0] = nloc; b.st[1] = nx; }
        const unsigned old = xb_add(&bar[XB_XSUB(b.x)], 1u);
        const unsigned gen = old / nloc;
        if (old + 1u == (gen + 1u) * nloc) {
            __builtin_amdgcn_fence(__ATOMIC_RELEASE, "agent");
            asm volatile("s_waitcnt vmcnt(0)" ::: "memory");
            const unsigned og = xb_add(&bar[XB_TOP], 1u);
            const unsigned tg = og / nx;
            if (og + 1u == (tg + 1u) * nx) xb_add(&bar[XB_TOPGEN], 1u);
            else XB_SPIN(xb_ld(&bar[XB_TOPGEN]) == tg, bar);
            __builtin_amdgcn_fence(__ATOMIC_ACQUIRE, "agent");
            xb_add(&bar[XB_XGEN(b.x)], 1u);
            asm volatile("s_waitcnt vmcnt(0)" ::: "memory");
        } else {
            XB_SPIN(xb_ld(&bar[XB_XGEN(b.x)]) == gen, bar);
            __builtin_amdgcn_fence(__ATOMIC_ACQUIRE, "agent");
            asm volatile("s_waitcnt vmcnt(0)" ::: "memory");
        }
    }
    __syncthreads();
}

struct Args {
    const float* in[19];
    float* out;
    unsigned char* ws;
    int ph_lo, ph_hi, aux, pad;
};

namespace pg8 {
constexpr int BM = 256, BK = 64, HALF = 128, HTB = HALF * BK * 2;
__host__ __device__ __forceinline__ int lds_byte(int r, int c) { const int st = (r >> 4) * 2 + (c >> 5), rr = r & 15, cc = c & 31, ob = rr * 64 + cc * 2; return st * 1024 + (ob ^ (((ob >> 9) & 1) << 5)); }
__host__ __device__ __forceinline__ void stage_rc(int b, int& R, int& C) { const int st = b / 1024, sb = b % 1024, swz = sb ^ (((sb >> 9) & 1) << 5); R = (st >> 1) * 16 + swz / 64; C = (st & 1) * 32 + (swz % 64) / 2; }
__host__ __device__ __forceinline__ int perm32(int rho) { const int n = rho >> 4, i = rho & 15; return 8 * (i >> 2) + 4 * n + (i & 3); }

struct Unit { const char* A; const char* B; int p0, p1, p2, p3; };

#define PG8_SA(b, h) (((b) * 2 + (h)) * HTB)
#define PG8_SB(b, h) ((4 + (b) * 2 + (h)) * HTB)
#define PG8_LDA(dst, b, h) do { _Pragma("unroll") for (int m = 0; m < 4; ++m) _Pragma("unroll") for (int k = 0; k < 2; ++k) dst[m][k] = *(const LAS bf16x8*)(lds + PG8_SA(b, h) + aoff + m * 2048 + k * 1024); } while (0)
#define PG8_LDB(dst, b, h) do { _Pragma("unroll") for (int n = 0; n < 2; ++n) _Pragma("unroll") for (int k = 0; k < 2; ++k) dst[n][k] = *(const LAS bf16x8*)(lds + PG8_SB(b, h) + boff + n * 2048 + k * 1024); } while (0)
#define PG8_MMA(ai, bj, At, Bt) do { __builtin_amdgcn_s_setprio(1); _Pragma("unroll") for (int m = 0; m < 4; ++m) _Pragma("unroll") for (int n = 0; n < 2; ++n) _Pragma("unroll") for (int k = 0; k < 2; ++k) \
        acc[ai][bj][m][n] = __builtin_amdgcn_mfma_f32_16x16x32_bf16(Bt[n][k], At[m][k], acc[ai][bj][m][n], 0, 0, 0); __builtin_amdgcn_s_setprio(0); } while (0)

template <class P>
__device__ __forceinline__ void gemm_simple(LAS unsigned char* lds, const P& S) {
    const int tid = threadIdx.x, wid = __builtin_amdgcn_readfirstlane(tid >> 6), lane = tid & 63, wr = wid >> 2, wc = wid & 3, fr = lane & 15, fq = lane >> 4;
    const int nt = S.nt();
    int R0, C0; stage_rc(tid * 16, R0, C0);
    unsigned offB[2];
#pragma unroll
    for (int i = 0; i < 2; ++i) { const int R = R0 + 64 * i; const int Rb = (R & ~31) + perm32(R & 31); offB[i] = (unsigned)Rb * S.ldb_bytes() + (unsigned)C0 * 2u; }
    const unsigned bhalf = 128u * S.ldb_bytes();
    const int aoff = lds_byte(wr * 64 + fr, fq * 8), boff = lds_byte(wc * 32 + fr, fq * 8);
    Unit u;
    for (int ui = 0; S.next(ui, u); ++ui) {
        unsigned offA[4]; S.aoff(u, R0, C0, offA);
        f32x4 acc[2][2][4][2];
#pragma unroll
        for (int a = 0; a < 2; ++a)
#pragma unroll
            for (int b = 0; b < 2; ++b)
#pragma unroll
                for (int m = 0; m < 4; ++m)
#pragma unroll
                    for (int n = 0; n < 2; ++n) acc[a][b][m][n] = (f32x4){0.f, 0.f, 0.f, 0.f};
        for (int t = 0; t < nt; ++t) {
            u32x4 ra[4], rb[4];
#pragma unroll
            for (int h = 0; h < 2; ++h)
#pragma unroll
                for (int i = 0; i < 2; ++i) {
                    ra[2 * h + i] = *(const u32x4*)(u.A + offA[2 * h + i] + (size_t)t * 128);
                    rb[2 * h + i] = *(const u32x4*)(u.B + (size_t)h * bhalf + offB[i] + (size_t)t * 128);
                }
            __syncthreads();
#pragma unroll
            for (int h = 0; h < 2; ++h)
#pragma unroll
                for (int i = 0; i < 2; ++i) {
                    *(LAS u32x4*)(lds + PG8_SA(0, h) + tid * 16 + i * 8192) = ra[2 * h + i];
                    *(LAS u32x4*)(lds + PG8_SB(0, h) + tid * 16 + i * 8192) = rb[2 * h + i];
                }
            __syncthreads();
            bf16x8 At[4][2], Bt[2][2];
#pragma unroll
            for (int ai = 0; ai < 2; ++ai) {
                PG8_LDA(At, 0, ai);
#pragma unroll
                for (int bj = 0; bj < 2; ++bj) { PG8_LDB(Bt, 0, bj); PG8_MMA(ai, bj, At, Bt); }
            }
        }
        S.epi(acc, u, wr, wc, fr, fq);
    }
    __syncthreads();
}

template <class P>
__device__ __forceinline__ void gemm_pipe(LAS unsigned char* lds, const P& S) {
    const int tid = threadIdx.x, wid = __builtin_amdgcn_readfirstlane(tid >> 6), lane = tid & 63, wr = wid >> 2, wc = wid & 3, fr = lane & 15, fq = lane >> 4;
    const int nt = S.nt();
    int R0, C0; stage_rc(tid * 16, R0, C0);
    unsigned offB[2];
#pragma unroll
    for (int i = 0; i < 2; ++i) { const int R = R0 + 64 * i; const int Rb = (R & ~31) + perm32(R & 31); offB[i] = (unsigned)Rb * S.ldb_bytes() + (unsigned)C0 * 2u; }
    const size_t bhalf = (size_t)128u * S.ldb_bytes();
    const size_t kstep = 128;
    const unsigned ldsw = (unsigned)wid * 1024u;
    const int aoff = lds_byte(wr * 64 + fr, fq * 8), boff = lds_byte(wc * 32 + fr, fq * 8);
#define PG8_STAGE_A(bufoff, gbase, OFF, h) do { _Pragma("unroll") for (int _i = 0; _i < 2; ++_i) \
        __builtin_amdgcn_global_load_lds((const unsigned*)((const char*)(gbase) + (OFF)[2 * (h) + _i]), (LAS unsigned*)(lds + (bufoff) + ldsw + _i * 8192), 16, 0, 0); } while (0)
#define PG8_STAGE_B(bufoff, gbase) do { _Pragma("unroll") for (int _i = 0; _i < 2; ++_i) \
        __builtin_amdgcn_global_load_lds((const unsigned*)((const char*)(gbase) + offB[_i]), (LAS unsigned*)(lds + (bufoff) + ldsw + _i * 8192), 16, 0, 0); } while (0)
#define PG8_WAIT_V(n) asm volatile("s_waitcnt vmcnt(" #n ")" ::: "memory")
#define PG8_WAIT_L(n) asm volatile("s_waitcnt lgkmcnt(" #n ")" ::: "memory")
#define PG8_BAR __builtin_amdgcn_s_barrier()
#define PG8_SCHED __builtin_amdgcn_sched_barrier(0)
    Unit cur, nxt; int ui = 0;
    if (!S.next(0, cur)) return;
    f32x4 acc[2][2][4][2];
#pragma unroll
    for (int a = 0; a < 2; ++a)
#pragma unroll
        for (int b = 0; b < 2; ++b)
#pragma unroll
            for (int m = 0; m < 4; ++m)
#pragma unroll
                for (int n = 0; n < 2; ++n) acc[a][b][m][n] = (f32x4){0.f, 0.f, 0.f, 0.f};
    bf16x8 At[4][2], B0[2][2], B1[2][2];
    unsigned offC[4], offN[4];
    S.aoff(cur, R0, C0, offC);
    const char* cA = cur.A; const char* cB = cur.B;
    PG8_STAGE_B(PG8_SB(0, 0), cB); PG8_STAGE_B(PG8_SB(0, 1), cB + bhalf); PG8_STAGE_A(PG8_SA(0, 0), cA, offC, 0); PG8_STAGE_A(PG8_SA(0, 1), cA, offC, 1);
    if (wr == 1) PG8_BAR;
    PG8_WAIT_V(2); PG8_BAR;
    PG8_STAGE_B(PG8_SB(1, 0), cB + kstep); PG8_STAGE_A(PG8_SA(1, 0), cA + kstep, offC, 0); PG8_STAGE_B(PG8_SB(1, 1), cB + bhalf + kstep);
    PG8_WAIT_V(6); PG8_BAR;
    for (;;) {
        const bool has_next = S.next(ui + 1, nxt);
        if (has_next) S.aoff(nxt, R0, C0, offN);
        else {
#pragma unroll
            for (int q = 0; q < 4; ++q) offN[q] = offC[q];
        }
        const char* nA = has_next ? nxt.A : cA; const char* nB = has_next ? nxt.B : cB;
        for (int t = 0; t < nt; t += 2) {
            const bool last = (t == nt - 2);
            const char* a1 = cA + (size_t)(t + 1) * kstep;
            const char* a2 = last ? nA : cA + (size_t)(t + 2) * kstep; const char* b2 = last ? nB : cB + (size_t)(t + 2) * kstep;
            const char* a3 = a2 + kstep; const char* b3 = b2 + kstep;
            unsigned o2[4];
#pragma unroll
            for (int q = 0; q < 4; ++q) o2[q] = last ? offN[q] : offC[q];
            PG8_LDB(B0, 0, 0); PG8_LDB(B1, 0, 1); PG8_SCHED; PG8_LDA(At, 0, 0); PG8_STAGE_A(PG8_SA(1, 1), a1, offC, 1);
            PG8_WAIT_V(8); PG8_WAIT_L(0); PG8_BAR; PG8_MMA(0, 0, At, B0); PG8_MMA(0, 1, At, B1); PG8_BAR; PG8_SCHED;
            PG8_LDA(At, 0, 1); PG8_STAGE_B(PG8_SB(0, 0), b2); PG8_STAGE_B(PG8_SB(0, 1), b2 + bhalf); PG8_STAGE_A(PG8_SA(0, 0), a2, o2, 0);
            PG8_WAIT_V(8); PG8_WAIT_L(0); PG8_BAR; PG8_MMA(1, 0, At, B0); PG8_MMA(1, 1, At, B1); PG8_BAR; PG8_SCHED;
            PG8_LDB(B0, 1, 0); PG8_LDB(B1, 1, 1); PG8_SCHED; PG8_LDA(At, 1, 0); PG8_STAGE_A(PG8_SA(0, 1), a2, o2, 1);
            PG8_WAIT_V(8); PG8_WAIT_L(0); PG8_BAR; PG8_MMA(0, 0, At, B0); PG8_MMA(0, 1, At, B1); PG8_BAR; PG8_SCHED;
            PG8_LDA(At, 1, 1); PG8_STAGE_B(PG8_SB(1, 0), b3); PG8_STAGE_B(PG8_SB(1, 1), b3 + bhalf); PG8_STAGE_A(PG8_SA(1, 0), a3, o2, 0);
            PG8_WAIT_V(8); PG8_WAIT_L(0); PG8_BAR; PG8_MMA(1, 0, At, B0); PG8_MMA(1, 1, At, B1); PG8_BAR; PG8_SCHED;
        }
        if (wr == 0) PG8_BAR;
        S.epi(acc, cur, wr, wc, fr, fq);
        if (!has_next) break;
#pragma unroll
        for (int a = 0; a < 2; ++a)
#pragma unroll
            for (int b = 0; b < 2; ++b)
#pragma unroll
                for (int m = 0; m < 4; ++m)
#pragma unroll
                    for (int n = 0; n < 2; ++n) acc[a][b][m][n] = (f32x4){0.f, 0.f, 0.f, 0.f};
        cur = nxt; cA = nA; cB = nB; ++ui;
#pragma unroll
        for (int q = 0; q < 4; ++q) offC[q] = offN[q];
        if (wr == 1) PG8_BAR;
    }
    PG8_WAIT_V(0);
    PG8_BAR;
#undef PG8_STAGE_A
#undef PG8_STAGE_B
#undef PG8_WAIT_V
#undef PG8_WAIT_L
#undef PG8_BAR
#undef PG8_SCHED
}
}

struct Frame {
    LAS unsigned char* lds;
    volatile LAS unsigned* MISC;
    unsigned* ctl;
    int tid, lane, wave, vcu, G;
    unsigned char* ws;
    float* out;
};
__device__ __forceinline__ const float* inptr(int i) {
    const float* const* ka = (const float* const*)__builtin_amdgcn_kernarg_segment_ptr();
    asm volatile("" : "+s"(ka));
    return ka[i];
}
#define WSP(F, off, type) ((type*)((F).ws + (off)))

template <class RowMap>
__device__ __forceinline__ void transpose_tile(const float* W, int K, int N, bf16_t* WT, LAS unsigned char* scr, int item, int lane, const RowMap& rm) {
    const int nblk = N / 64, kb = item / nblk, nb = item % nblk, k0 = 64 * kb, n0 = 64 * nb;
    const int kg = lane & 3, ng = lane >> 2;
    f32x4 v[4][4];
#pragma unroll
    for (int r = 0; r < 4; ++r)
#pragma unroll
        for (int i = 0; i < 4; ++i) v[r][i] = *(const f32x4*)(W + (size_t)(k0 + 16 * r + 4 * kg + i) * N + n0 + 4 * ng);
#pragma unroll
    for (int r = 0; r < 4; ++r)
#pragma unroll
        for (int j = 0; j < 4; ++j)
            *(LAS u32x2*)(scr + (4 * ng + j) * 144 + (16 * r + 4 * kg) * 2) = (u32x2){cvt_pk_bf16(v[r][0][j], v[r][1][j]), cvt_pk_bf16(v[r][2][j], v[r][3][j])};
    asm volatile("s_waitcnt lgkmcnt(0)" ::: "memory");
    const int c = lane & 7;
#pragma unroll
    for (int q = 0; q < 8; ++q) { const int n = (lane >> 3) + 8 * q; const u32x4 o = *(const LAS u32x4*)(scr + n * 144 + c * 16); *(u32x4*)(WT + (size_t)rm(n0 + n) * K + k0 + 8 * c) = o; }
    asm volatile("s_waitcnt lgkmcnt(0)" ::: "memory");
}
struct RmId { __device__ __forceinline__ int operator()(int n) const { return n; } };
struct RmWin { __device__ __forceinline__ int operator()(int n) const {
        const int s = n >> 9; if (s != 4 && s != 5) return n;
        const int d = n & 127, dd = d & 63; const int p = 8 * (dd >> 2) + (dd & 3) + ((d >> 6) << 2); return n - d + p; } };
struct RmGu { __device__ __forceinline__ int operator()(int n) const { const int half = n >> 10, j = (n & 1023) >> 7, i = n & 127; return 256 * j + 128 * half + i; } };

__device__ __forceinline__ void p0_prologue(Frame& F) {
    const int tid = F.tid;
    {
        LAS float* red = (LAS float*)F.lds;
        const float* c = inptr(1);
        for (int u = F.vcu; u < 192; u += F.G) {
            const int l = u / 96, cg = u % 96, kq = tid >> 4, cq = tid & 15;
            const float* W = inptr(2) + (size_t)l * D * 6 * D + cg * 64 + cq * 4;
            f32x4 a = {0.f, 0.f, 0.f, 0.f};
#pragma unroll 8
            for (int j = 0; j < 32; ++j) { const int k = kq + 32 * j; const float cv = siluf_(c[k]); const f32x4 w = *(const f32x4*)(W + (size_t)k * 6 * D); a += w * cv; }
            __syncthreads();
            *(LAS f32x4*)(red + kq * 64 + cq * 4) = a;
            __syncthreads();
            if (tid < 64) { float s = 0.f;
#pragma unroll 8
                for (int k = 0; k < 32; ++k) s += red[k * 64 + tid];
                const int col = cg * 64 + tid;
                WSP(F, WS_MOD, float)[l * 6 * D + col] = s + inptr(3)[l * 6 * D + col]; }
        }
        __syncthreads();
    }
    if (F.vcu == 0) { const float* hb = inptr(5); const float a = hb[tid], b = hb[512 + tid]; WSP(F, WS_LB, float)[tid] = 1.0f / (1.0f + __expf(b - a)); }
    {
        bf16_t* rt = WSP(F, WS_RT, bf16_t); const float* wr = inptr(12);
        for (int idx = F.vcu * NTH + tid; idx < 2 * D * NE; idx += F.G * NTH) {
            const int l = idx >> 15, rem = idx & 32767, c = rem >> 5, e = rem & 31;
            const float w = wr[idx]; const unsigned hi = cvt_pk_bf16(w, 0.f) & 0xffffu; const float res = w - bflo(hi);
            rt[((size_t)(l * 2 + 0) * 32 + e) * D + c] = (bf16_t)hi; rt[((size_t)(l * 2 + 1) * 32 + e) * D + c] = (bf16_t)(cvt_pk_bf16(res, 0.f) & 0xffffu);
        }
    }
    {
        f32x2* rope = WSP(F, WS_ROPE, f32x2);
        for (int idx = F.vcu * NTH + tid; idx < T * 64; idx += F.G * NTH) {
            const int t = idx >> 6, d = idx & 63;
            const float inv = exp2f(-(float)d * (13.287712379549449f / 64.0f));
            const float ang = (float)t * inv;
            const double a = (double)ang; const double n = __builtin_rint(a * 0.15915494309189535); const double r = __builtin_fma(-n, 6.283185307179586, a);
            const float rf = (float)r;
            rope[idx] = (f32x2){__cosf(rf), __sinf(rf)};
        }
    }
    {
        LAS unsigned char* scr = F.lds + F.wave * 16384;
        const int gw = F.vcu * NWAVES + F.wave, NGW = F.G * NWAVES;
        constexpr int I_IN = 16 * 64, I_OUT = 16 * 16, I_POOL = 4 * 4 * 4, I_GU = 64 * 16 * 32, I_DN = 64 * 16 * 16;
        constexpr int NITEMS = I_IN + I_OUT + I_POOL + I_GU + I_DN;
        for (int it = gw; it < NITEMS; it += NGW) {
            int r = it;
            if (r < I_IN) { transpose_tile(inptr(4), D, INW, WSP(F, WS_WINT, bf16_t), scr, r, F.lane, RmWin()); continue; } r -= I_IN;
            if (r < I_OUT) { transpose_tile(inptr(8), D, D, WSP(F, WS_WOUTT, bf16_t), scr, r, F.lane, RmId()); continue; } r -= I_OUT;
            if (r < I_POOL) { const int g = r / 16; transpose_tile(inptr(9) + (size_t)g * 65536, 256, 256, WSP(F, WS_POOLT, bf16_t) + (size_t)g * 65536, scr, r % 16, F.lane, RmId()); continue; } r -= I_POOL;
            if (r < I_GU) { const int m = r / 512; transpose_tile(inptr(14) + (size_t)m * D * 2048, D, 2048, WSP(F, WS_WGUT, bf16_t) + (size_t)m * 2048 * D, scr, r % 512, F.lane, RmGu()); continue; } r -= I_GU;
            { const int m = r / 256; transpose_tile(inptr(16) + (size_t)m * D * D, D, D, WSP(F, WS_WDNT, bf16_t) + (size_t)m * D * D, scr, r % 256, F.lane, RmId()); }
        }
    }
}

__device__ __forceinline__ void p1_norm_in(Frame& F) {
    const float* mod = WSP(F, WS_MOD, float);
    f32x4 sh[4], sc[4];
#pragma unroll
    for (int j = 0; j < 4; ++j) { sh[j] = *(const f32x4*)(mod + 0 * D + 4 * F.lane + 256 * j); sc[j] = *(const f32x4*)(mod + 1 * D + 4 * F.lane + 256 * j) + 1.0f; }
    const int gw = F.vcu * NWAVES + F.wave, NGW = F.G * NWAVES;
    for (int row = gw; row < T; row += NGW) {
        const f32x4* xr = (const f32x4*)(inptr(0) + (size_t)row * D) + F.lane;
        f32x4 v[4]; float s = 0.f;
#pragma unroll
        for (int j = 0; j < 4; ++j) { v[j] = xr[64 * j]; s += (v[j].x * v[j].x + v[j].y * v[j].y) + (v[j].z * v[j].z + v[j].w * v[j].w); }
        const float rstd = rsqrtf(wave_sum(s) * (1.f / D) + EPS);
        u32x2* o = (u32x2*)(WSP(F, WS_HN, bf16_t) + (size_t)row * D) + F.lane;
#pragma unroll
        for (int j = 0; j < 4; ++j) { const f32x4 h = v[j] * rstd * sc[j] + sh[j]; o[64 * j] = (u32x2){cvt_pk_bf16(h.x, h.y), cvt_pk_bf16(h.z, h.w)}; }
    }
}

using pg8::Unit;
typedef f32x4 AccT[2][2][4][2];

struct GemmBase {
    int G, vcu;
    __device__ __forceinline__ void aoff_lin(int R0, int C0, unsigned lda_bytes, unsigned (&off)[4]) const {
#pragma unroll
        for (int q = 0; q < 4; ++q) off[q] = (unsigned)(R0 + 64 * (q & 1) + 128 * (q >> 1)) * lda_bytes + (unsigned)C0 * 2u;
    }
};

struct PolWin : GemmBase {
    const bf16_t* A; const bf16_t* Bt; bf16_t* qkvg; float* gbuf; const float* lb; const f32x2* rope;
    __device__ __forceinline__ int nt() const { return D / 64; }
    __device__ __forceinline__ unsigned ldb_bytes() const { return D * 2; }
    __device__ __forceinline__ bool next(int i, Unit& u) const {
        const int V = i * G + vcu; if (V >= 64 * 16) return false;
        u.p0 = V >> 4; u.p1 = V & 15; u.A = (const char*)(A + (size_t)u.p0 * 256 * D); u.B = (const char*)(Bt + (size_t)u.p1 * 256 * D); return true; }
    __device__ __forceinline__ void aoff(const Unit&, int R0, int C0, unsigned (&off)[4]) const { aoff_lin(R0, C0, D * 2, off); }
    __device__ __forceinline__ void epi(const AccT& acc, const Unit& u, int wr, int wc, int fr, int fq) const {
        const int pm = u.p0, pn = u.p1, s = pn >> 1;
        const int row0 = pm * 256 + wr * 64 + fr;
        const int o0 = (pn & 1) * 256 + wc * 32 + 8 * fq;
        const int dbase = (s & 3) * 1024 + (s >> 2) * 512;
#pragma unroll
        for (int ai = 0; ai < 2; ++ai)
#pragma unroll
            for (int m = 0; m < 4; ++m) {
                const int row = row0 + ai * 128 + m * 16;
                bf16_t* orow = qkvg + (size_t)row * INW + dbase;
#pragma unroll
                for (int bj = 0; bj < 2; ++bj) {
                    const int o = o0 + bj * 128;
                    f32x4 v0 = acc[ai][bj][m][0], v1 = acc[ai][bj][m][1];
                    if (s == 4 || s == 5) {
                        const int hd = o & ~127, d0 = 4 * (((o & 127) >> 3));
                        const f32x4* rp = (const f32x4*)(rope + (size_t)row * 64 + d0);
                        const f32x4 c01 = rp[0], c23 = rp[1];
                        const f32x4 cs = {c01.x, c01.z, c23.x, c23.z}, sn = {c01.y, c01.w, c23.y, c23.w};
                        f32x4 o1 = v0 * cs - v1 * sn, o2 = v0 * sn + v1 * cs;
                        if (s == 5) { o1 = o1 * 0.08838834764831845f; o2 = o2 * 0.08838834764831845f; }
                        *(u32x2*)(orow + hd + d0) = (u32x2){cvt_pk_bf16(o1.x, o1.y), cvt_pk_bf16(o1.z, o1.w)};
                        *(u32x2*)(orow + hd + d0 + 64) = (u32x2){cvt_pk_bf16(o2.x, o2.y), cvt_pk_bf16(o2.z, o2.w)};
                    } else {
                        if (s == 0 || s == 3 || s == 7) {
#pragma unroll
                            for (int j = 0; j < 4; ++j) { v0[j] = siluf_(v0[j]); v1[j] = siluf_(v1[j]); }
                        } else if (s == 1) {
                            const f32x4 l0 = *(const f32x4*)(lb + o), l1 = *(const f32x4*)(lb + o + 4);
                            f32x4 g0, g1;
#pragma unroll
                            for (int j = 0; j < 4; ++j) {
                                const float f0 = l0[j] + (1.0f - l0[j]) * sigmoidf_(v0[j]), f1 = l1[j] + (1.0f - l1[j]) * sigmoidf_(v1[j]);
                                g0[j] = __logf(f0); g1[j] = __logf(f1); v0[j] = 1.0f - f0; v1[j] = 1.0f - f1; }
                            float* gr = gbuf + (size_t)row * 512 + o;
                            *(f32x4*)gr = g0; *(f32x4*)(gr + 4) = g1;
                        }
                        u32x4 w; w.x = cvt_pk_bf16(v0[0], v0[1]); w.y = cvt_pk_bf16(v0[2], v0[3]); w.z = cvt_pk_bf16(v1[0], v1[1]); w.w = cvt_pk_bf16(v1[2], v1[3]);
                        *(u32x4*)(orow + o) = w;
                    }
                }
            }
    }
};

struct PolRes : GemmBase {
    const bf16_t* A; const bf16_t* Bt; const float* resid; float* outp; const float* gate; const float* bias; const float* scale;
    int K, lda, nN, kcol;
    __device__ __forceinline__ int nt() const { return K / 64; }
    __device__ __forceinline__ unsigned ldb_bytes() const { return (unsigned)K * 2u; }
    __device__ __forceinline__ bool next(int i, Unit& u) const {
        const int V = i * G + vcu; if (V >= 64 * nN) return false;
        u.p0 = V / nN; u.p1 = V % nN; u.A = (const char*)(A + (size_t)u.p0 * 256 * lda + (size_t)u.p1 * kcol); u.B = (const char*)(Bt + (size_t)u.p1 * 256 * K); return true; }
    __device__ __forceinline__ void aoff(const Unit&, int R0, int C0, unsigned (&off)[4]) const { aoff_lin(R0, C0, (unsigned)lda * 2u, off); }
    __device__ __forceinline__ void epi(const AccT& acc, const Unit& u, int wr, int wc, int fr, int fq) const {
        const int row0 = u.p0 * 256 + wr * 64 + fr, col0 = u.p1 * 256 + wc * 32 + 8 * fq;
#pragma unroll
        for (int bj = 0; bj < 2; ++bj) {
            const int c = col0 + bj * 128;
            const f32x4 g0 = *(const f32x4*)(gate + c), g1 = *(const f32x4*)(gate + c + 4);
            f32x4 b0 = {0.f, 0.f, 0.f, 0.f}, b1 = b0, s0 = {1.f, 1.f, 1.f, 1.f}, s1 = s0;
            if (bias) { b0 = *(const f32x4*)(bias + c); b1 = *(const f32x4*)(bias + c + 4); s0 = *(const f32x4*)(scale + c); s1 = *(const f32x4*)(scale + c + 4); }
#pragma unroll
            for (int ai = 0; ai < 2; ++ai)
#pragma unroll
                for (int m = 0; m < 4; ++m) {
                    const size_t idx = (size_t)(row0 + ai * 128 + m * 16) * D + c;
                    const f32x4 r0 = *(const f32x4*)(resid + idx), r1 = *(const f32x4*)(resid + idx + 4);
                    *(f32x4*)(outp + idx) = r0 + g0 * ((acc[ai][bj][m][0] + b0) * s0);
                    *(f32x4*)(outp + idx + 4) = r1 + g1 * ((acc[ai][bj][m][1] + b1) * s1);
                }
        }
    }
};

constexpr int MI_TPRE = 16, MI_CNT = 64, MI_MT2E = 128;
__device__ __forceinline__ void expert_tables(Frame& F, int layer) {
    if (F.tid == 0) {
        int pre = 0;
        for (int e = 0; e < NE; ++e) {
            int c = (int)__hip_atomic_load(F.ctl + CW_CNT + 64 * layer + e, __ATOMIC_RELAXED, __HIP_MEMORY_SCOPE_AGENT);
            if (c > LIST_CAP) c = LIST_CAP;
            F.MISC[MI_TPRE + e] = pre; F.MISC[MI_CNT + e] = c;
            const int nt_ = (c + 255) >> 8;
            for (int q = 0; q < nt_; ++q) F.MISC[MI_MT2E + pre + q] = e;
            pre += nt_;
        }
        F.MISC[MI_TPRE + NE] = pre;
    }
    __syncthreads();
}
struct PolG1 : GemmBase {
    volatile LAS unsigned* MISC; const bf16_t* hn; const bf16_t* wgut; const float* bgu; const int* lslot; bf16_t* act;
    __device__ __forceinline__ int nt() const { return D / 64; }
    __device__ __forceinline__ unsigned ldb_bytes() const { return D * 2; }
    __device__ __forceinline__ bool next(int i, Unit& u) const {
        const int V = i * G + vcu, MT = (int)MISC[MI_TPRE + NE]; if (V >= MT * 8) return false;
        const int mt = V >> 3, nt_ = V & 7, e = (int)MISC[MI_MT2E + mt];
        u.p0 = e; u.p1 = mt - (int)MISC[MI_TPRE + e]; u.p2 = nt_; u.p3 = mt;
        u.A = (const char*)hn; u.B = (const char*)(wgut + ((size_t)e * 2048 + (size_t)nt_ * 256) * D); return true; }
    __device__ __forceinline__ void aoff(const Unit& u, int R0, int C0, unsigned (&off)[4]) const {
        const int cnt = (int)MISC[MI_CNT + u.p0]; const int* ls = lslot + (size_t)u.p0 * LIST_CAP + u.p1 * 256;
#pragma unroll
        for (int q = 0; q < 4; ++q) { const int r = R0 + 64 * (q & 1) + 128 * (q >> 1); const int tok = (u.p1 * 256 + r < cnt) ? (ls[r] >> 2) : 0; off[q] = (unsigned)tok * (D * 2u) + (unsigned)C0 * 2u; }
    }
    __device__ __forceinline__ void epi(const AccT& acc, const Unit& u, int wr, int wc, int fr, int fq) const {
        const int colg = u.p2 * 128 + wc * 32 + 8 * fq;
        const float* bg = bgu + (size_t)u.p0 * 2048;
        const f32x4 bgl0 = *(const f32x4*)(bg + colg), bgl1 = *(const f32x4*)(bg + colg + 4), bln0 = *(const f32x4*)(bg + 1024 + colg), bln1 = *(const f32x4*)(bg + 1024 + colg + 4);
        bf16_t* base = act + ((size_t)u.p3 * 256 + wr * 64 + fr) * D + colg;
#pragma unroll
        for (int ai = 0; ai < 2; ++ai)
#pragma unroll
            for (int m = 0; m < 4; ++m) {
                f32x4 gl0 = acc[ai][0][m][0] + bgl0, gl1 = acc[ai][0][m][1] + bgl1, ln0 = acc[ai][1][m][0] + bln0, ln1 = acc[ai][1][m][1] + bln1;
                f32x4 a0, a1;
#pragma unroll
                for (int j = 0; j < 4; ++j) {
                    const float x0 = fminf(gl0[j], SW_LIMIT), x1 = fminf(gl1[j], SW_LIMIT);
                    const float y0 = fminf(fmaxf(ln0[j], -SW_LIMIT), SW_LIMIT), y1 = fminf(fmaxf(ln1[j], -SW_LIMIT), SW_LIMIT);
                    a0[j] = x0 * sigmoidf_(SW_ALPHA * x0) * (y0 + 1.0f); a1[j] = x1 * sigmoidf_(SW_ALPHA * x1) * (y1 + 1.0f); }
                u32x4 w; w.x = cvt_pk_bf16(a0[0], a0[1]); w.y = cvt_pk_bf16(a0[2], a0[3]); w.z = cvt_pk_bf16(a1[0], a1[1]); w.w = cvt_pk_bf16(a1[2], a1[3]);
                *(u32x4*)(base + (size_t)(ai * 128 + m * 16) * D) = w;
            }
    }
};
struct PolG2 : GemmBase {
    volatile LAS unsigned* MISC; const bf16_t* act; const bf16_t* wdnt; const float* bdn; const int* lslot; const float* lw; bf16_t* yslot;
    __device__ __forceinline__ int nt() const { return D / 64; }
    __device__ __forceinline__ unsigned ldb_bytes() const { return D * 2; }
    __device__ __forceinline__ bool next(int i, Unit& u) const {
        const int V = i * G + vcu, MT = (int)MISC[MI_TPRE + NE]; if (V >= MT * 4) return false;
        const int mt = V >> 2, nt_ = V & 3, e = (int)MISC[MI_MT2E + mt];
        u.p0 = e; u.p1 = mt - (int)MISC[MI_TPRE + e]; u.p2 = nt_; u.p3 = mt;
        u.A = (const char*)(act + (size_t)mt * 256 * D); u.B = (const char*)(wdnt + ((size_t)e * D + (size_t)nt_ * 256) * D); return true; }
    __device__ __forceinline__ void aoff(const Unit&, int R0, int C0, unsigned (&off)[4]) const { aoff_lin(R0, C0, D * 2, off); }
    __device__ __forceinline__ void epi(const AccT& acc, const Unit& u, int wr, int wc, int fr, int fq) const {
        const int cnt = (int)MISC[MI_CNT + u.p0];
        const int col0 = u.p2 * 256 + wc * 32 + 8 * fq;
        const float* bd = bdn + (size_t)u.p0 * D;
        const int* ls = lslot + (size_t)u.p0 * LIST_CAP; const float* lwp = lw + (size_t)u.p0 * LIST_CAP;
#pragma unroll
        for (int ai = 0; ai < 2; ++ai)
#pragma unroll
            for (int m = 0; m < 4; ++m) {
                const int li = u.p1 * 256 + ai * 128 + wr * 64 + m * 16 + fr;
                if (li < cnt) {
                    const int slot = ls[li]; const float w = lwp[li];
                    bf16_t* yr = yslot + (size_t)slot * D + col0;
#pragma unroll
                    for (int bj = 0; bj < 2; ++bj) {
                        const f32x4 b0 = *(const f32x4*)(bd + col0 + bj * 128), b1 = *(const f32x4*)(bd + col0 + bj * 128 + 4);
                        const f32x4 v0 = (acc[ai][bj][m][0] + b0) * w, v1 = (acc[ai][bj][m][1] + b1) * w;
                        u32x4 o; o.x = cvt_pk_bf16(v0[0], v0[1]); o.y = cvt_pk_bf16(v0[2], v0[3]); o.z = cvt_pk_bf16(v1[0], v1[1]); o.w = cvt_pk_bf16(v1[2], v1[3]);
                        *(u32x4*)(yr + bj * 128) = o;
                    }
                }
            }
    }
};

template <class P> __device__ __forceinline__ void run_gemm(Frame& F, const P& S) {
#if SIMPLE_GEMM
    pg8::gemm_simple<P>(F.lds, S);
#else
    pg8::gemm_pipe<P>(F.lds, S);
#endif
}

constexpr int LA_QA = 0, LA_QH = 17408, LA_KA = 34816, LA_VT = 52224, LA_AS = 70656, LA_ST = 79872, LA_QS = 114688, LA_PS = 118784;
constexpr int RS128 = 272, RS64 = 144;
__device__ __forceinline__ float ret_lg(int hh) { return __logf(1.0f - exp2f(-5.0f - (float)(hh - 4))); }
__device__ __forceinline__ u32x4 pack8(const float (&v)[8]) { return (u32x4){cvt_pk_bf16(v[0], v[1]), cvt_pk_bf16(v[2], v[3]), cvt_pk_bf16(v[4], v[5]), cvt_pk_bf16(v[6], v[7])}; }

__device__ __forceinline__ void la_cumsum(const float* gbuf, int hh, int t0, int d0, float (&b0)[8], float (&b1)[8]) {
    if (hh < 4) { float r0 = 0.f, r1 = 0.f;
#pragma unroll
        for (int i = 0; i < 8; ++i) { const f32x2 g = *(const f32x2*)(gbuf + (size_t)(t0 + i) * 512 + hh * 128 + d0); r0 += g.x; r1 += g.y; b0[i] = r0; b1[i] = r1; }
    } else { const float lg = ret_lg(hh);
#pragma unroll
        for (int i = 0; i < 8; ++i) { b0[i] = (float)(i + 1) * lg; b1[i] = b0[i]; }
    }
}

__device__ __forceinline__ void la_local_state(Frame& F) {
    const bf16_t* qkvg = WSP(F, WS_QKVG, bf16_t); const float* gbuf = WSP(F, WS_GBUF, float); float* kvt = WSP(F, WS_KVT, float); float* dec = WSP(F, WS_DEC, float);
    LAS unsigned char* lds = F.lds; LAS float* qs = (LAS float*)(lds + LA_QS);
    const int lane = F.lane, oc = F.wave, d0 = 2 * lane, fr = lane & 15, fq = lane >> 4;
    for (int unit = F.vcu; unit < 2048; unit += F.G) {
        const int hh = unit >> 8, n = unit & 255, t0 = n * 64 + oc * 8;
        float b0[8], b1[8]; la_cumsum(gbuf, hh, t0, d0, b0, b1);
        *(LAS f32x2*)(qs + oc * 128 + d0) = (f32x2){b0[7], b1[7]};
        unsigned kk[8], vv[8];
#pragma unroll
        for (int i = 0; i < 8; ++i) { const bf16_t* row = qkvg + (size_t)(t0 + i) * INW + hh * 128 + d0; kk[i] = *(const unsigned*)(row + 1024); vv[i] = *(const unsigned*)(row + 2048); }
        __syncthreads();
        float base0 = 0.f, base1 = 0.f, tot0 = 0.f, tot1 = 0.f;
#pragma unroll
        for (int o = 0; o < 8; ++o) { const f32x2 q = *(const LAS f32x2*)(qs + o * 128 + d0); if (o < oc) { base0 += q.x; base1 += q.y; } tot0 += q.x; tot1 += q.y; }
        float a0[8], a1[8], c0[8], c1[8];
#pragma unroll
        for (int i = 0; i < 8; ++i) { a0[i] = bflo(kk[i]) * __expf(tot0 - base0 - b0[i]); a1[i] = bfhi(kk[i]) * __expf(tot1 - base1 - b1[i]); c0[i] = bflo(vv[i]); c1[i] = bfhi(vv[i]); }
        *(LAS u32x4*)(lds + LA_QA + d0 * RS64 + oc * 16) = pack8(a0); *(LAS u32x4*)(lds + LA_QA + (d0 + 1) * RS64 + oc * 16) = pack8(a1);
        *(LAS u32x4*)(lds + LA_VT + d0 * RS64 + oc * 16) = pack8(c0); *(LAS u32x4*)(lds + LA_VT + (d0 + 1) * RS64 + oc * 16) = pack8(c1);
        if (oc == 0) *(f32x2*)(dec + ((size_t)hh * 256 + n) * 128 + d0) = (f32x2){__expf(tot0), __expf(tot1)};
        __syncthreads();
        const int et = oc;
        bf16x8 vt[2];
#pragma unroll
        for (int ks = 0; ks < 2; ++ks) vt[ks] = *(const LAS bf16x8*)(lds + LA_VT + (16 * et + fr) * RS64 + (32 * ks + 8 * fq) * 2);
        float* orow = kvt + (((size_t)hh * 256 + n) * 128 + 16 * et + fr) * 128 + 4 * fq;
#pragma unroll
        for (int dt = 0; dt < 8; ++dt) {
            f32x4 acc = {0.f, 0.f, 0.f, 0.f};
#pragma unroll
            for (int ks = 0; ks < 2; ++ks) { const bf16x8 a = *(const LAS bf16x8*)(lds + LA_QA + (16 * dt + fr) * RS64 + (32 * ks + 8 * fq) * 2); acc = __builtin_amdgcn_mfma_f32_16x16x32_bf16(a, vt[ks], acc, 0, 0, 0); }
            *(f32x4*)(orow + 16 * dt) = acc;
        }
        __syncthreads();
    }
}

__device__ __forceinline__ void la_scan(Frame& F) {
    const float* kvt = WSP(F, WS_KVT, float); const float* dec = WSP(F, WS_DEC, float); bf16_t* sprev = WSP(F, WS_SPREV, bf16_t);
    for (int idx = F.vcu * NTH + F.tid; idx < 8 * 16384; idx += F.G * NTH) {
        const int hh = idx >> 14, rem = idx & 16383, d = rem & 127;
        const float* kv = kvt + (size_t)hh * 256 * 16384 + rem; const float* dc = dec + (size_t)hh * 256 * 128 + d; bf16_t* sp = sprev + (size_t)hh * 256 * 16384 + rem;
        float S = 0.f;
        for (int n0 = 0; n0 < 256; n0 += 8) {
            float kvv[8], dd[8];
#pragma unroll
            for (int i = 0; i < 8; ++i) { kvv[i] = kv[(size_t)(n0 + i) * 16384]; dd[i] = dc[(n0 + i) * 128]; }
#pragma unroll
            for (int i = 0; i < 8; ++i) { sp[(size_t)(n0 + i) * 16384] = (bf16_t)(cvt_pk_bf16(S, 0.f) & 0xffffu); S = dd[i] * S + kvv[i]; }
        }
    }
}

__device__ __forceinline__ void la_output(Frame& F) {
    const bf16_t* qkvg = WSP(F, WS_QKVG, bf16_t); const float* gbuf = WSP(F, WS_GBUF, float); const bf16_t* sprev = WSP(F, WS_SPREV, bf16_t); bf16_t* cat = WSP(F, WS_CAT, bf16_t);
    LAS unsigned char* lds = F.lds; LAS float* qs = (LAS float*)(lds + LA_QS); LAS float* ps = (LAS float*)(lds + LA_PS);
    const int tid = F.tid, lane = F.lane, oc = F.wave, d0 = 2 * lane, fr = lane & 15, fq = lane >> 4;
    for (int unit = F.vcu; unit < 2048; unit += F.G) {
        const int hh = unit >> 8, n = unit & 255, t0 = n * 64 + oc * 8;
        float b0[8], b1[8]; la_cumsum(gbuf, hh, t0, d0, b0, b1);
        *(LAS f32x2*)(qs + oc * 128 + d0) = (f32x2){b0[7], b1[7]};
        unsigned qq[8], kk[8], vv[8];
#pragma unroll
        for (int i = 0; i < 8; ++i) { const bf16_t* row = qkvg + (size_t)(t0 + i) * INW + hh * 128 + d0; qq[i] = *(const unsigned*)row; kk[i] = *(const unsigned*)(row + 1024); vv[i] = *(const unsigned*)(row + 2048); }
        {
            const bf16_t* sp = sprev + ((size_t)hh * 256 + n) * 16384;
#pragma unroll
            for (int j = 0; j < 4; ++j) { const int c = tid + NTH * j, row = c >> 4, c16 = c & 15; *(LAS u32x4*)(lds + LA_ST + row * RS128 + c16 * 16) = *(const u32x4*)(sp + row * 128 + c16 * 8); }
        }
        __syncthreads();
        float base0 = 0.f, base1 = 0.f, bm0 = 0.f, bm1 = 0.f;
#pragma unroll
        for (int o = 0; o < 8; ++o) { const f32x2 q = *(const LAS f32x2*)(qs + o * 128 + d0); if (o < oc) { base0 += q.x; base1 += q.y; } if (o < 4) { bm0 += q.x; bm1 += q.y; } }
        float c0[8], c1[8];
#pragma unroll
        for (int i = 0; i < 8; ++i) {
            const int t = 8 * oc + i; const float bt0 = base0 + b0[i], bt1 = base1 + b1[i];
            const float q0 = bflo(qq[i]), q1 = bfhi(qq[i]), k0 = bflo(kk[i]), k1 = bfhi(kk[i]);
            *(LAS unsigned*)(lds + LA_QA + t * RS128 + d0 * 2) = cvt_pk_bf16(q0 * __expf(bt0 - bm0), q1 * __expf(bt1 - bm1));
            *(LAS unsigned*)(lds + LA_QH + t * RS128 + d0 * 2) = cvt_pk_bf16(q0 * __expf(bt0), q1 * __expf(bt1));
            *(LAS unsigned*)(lds + LA_KA + t * RS128 + d0 * 2) = cvt_pk_bf16(k0 * __expf(bm0 - bt0), k1 * __expf(bm1 - bt1));
            c0[i] = bflo(vv[i]); c1[i] = bfhi(vv[i]);
        }
        *(LAS u32x4*)(lds + LA_VT + d0 * RS64 + oc * 16) = pack8(c0); *(LAS u32x4*)(lds + LA_VT + (d0 + 1) * RS64 + oc * 16) = pack8(c1);
        __syncthreads();
        const int tt = oc >> 1, eh = oc & 1;
        {
            bf16x8 qf[4];
#pragma unroll
            for (int ks = 0; ks < 4; ++ks) qf[ks] = *(const LAS bf16x8*)(lds + LA_QA + (16 * tt + fr) * RS128 + (32 * ks + 8 * fq) * 2);
#pragma unroll
            for (int sti = 0; sti < 2; ++sti) {
                const int st = 2 * eh + sti;
                f32x4 acc = {0.f, 0.f, 0.f, 0.f};
                if (st <= tt) {
#pragma unroll
                    for (int ks = 0; ks < 4; ++ks) { const bf16x8 a = *(const LAS bf16x8*)(lds + LA_KA + (16 * st + fr) * RS128 + (32 * ks + 8 * fq) * 2); acc = __builtin_amdgcn_mfma_f32_16x16x32_bf16(a, qf[ks], acc, 0, 0, 0); }
                    if (st == tt) {
#pragma unroll
                        for (int r = 0; r < 4; ++r) if (4 * fq + r > fr) acc[r] = 0.f;
                    }
                }
                *(LAS u32x2*)(lds + LA_AS + (16 * tt + fr) * RS64 + (16 * st + 4 * fq) * 2) = (u32x2){cvt_pk_bf16(acc[0], acc[1]), cvt_pk_bf16(acc[2], acc[3])};
            }
        }
        __syncthreads();
        f32x4 o[4]; float ss = 0.f;
        {
            bf16x8 af[2], hf[4];
#pragma unroll
            for (int ks = 0; ks < 2; ++ks) af[ks] = *(const LAS bf16x8*)(lds + LA_AS + (16 * tt + fr) * RS64 + (32 * ks + 8 * fq) * 2);
#pragma unroll
            for (int ks = 0; ks < 4; ++ks) hf[ks] = *(const LAS bf16x8*)(lds + LA_QH + (16 * tt + fr) * RS128 + (32 * ks + 8 * fq) * 2);
#pragma unroll
            for (int ei = 0; ei < 4; ++ei) {
                const int et = 4 * eh + ei;
                f32x4 acc = {0.f, 0.f, 0.f, 0.f};
#pragma unroll
                for (int ks = 0; ks < 2; ++ks) { const bf16x8 a = *(const LAS bf16x8*)(lds + LA_VT + (16 * et + fr) * RS64 + (32 * ks + 8 * fq) * 2); acc = __builtin_amdgcn_mfma_f32_16x16x32_bf16(a, af[ks], acc, 0, 0, 0); }
#pragma unroll
                for (int ks = 0; ks < 4; ++ks) { const bf16x8 a = *(const LAS bf16x8*)(lds + LA_ST + (16 * et + fr) * RS128 + (32 * ks + 8 * fq) * 2); acc = __builtin_amdgcn_mfma_f32_16x16x32_bf16(a, hf[ks], acc, 0, 0, 0); }
                o[ei] = acc; ss += (acc[0] * acc[0] + acc[1] * acc[1]) + (acc[2] * acc[2] + acc[3] * acc[3]);
            }
        }
        ss += __shfl_xor(ss, 16); ss += __shfl_xor(ss, 32);
        if (lane < 16) ps[(tt * 2 + eh) * 16 + lane] = ss;
        __syncthreads();
        const float tot = ps[(tt * 2) * 16 + fr] + ps[(tt * 2 + 1) * 16 + fr];
        const float rstd = rsqrtf(tot * (1.f / 128.f) + EPS);
        const float* gain = (hh < 4) ? (inptr(6) + hh * 128) : (inptr(7) + (hh - 4) * 128);
        const size_t rowi = (size_t)(n * 64 + 16 * tt + fr);
#pragma unroll
        for (int ei = 0; ei < 4; ++ei) {
            const int e0 = 16 * (4 * eh + ei) + 4 * fq;
            const f32x4 gn = *(const f32x4*)(gain + e0);
            const u32x2 gt = *(const u32x2*)(qkvg + rowi * INW + 3072 + hh * 128 + e0);
            const f32x4 v = o[ei] * rstd * gn;
            *(u32x2*)(cat + rowi * D + hh * 128 + e0) = (u32x2){cvt_pk_bf16(v[0] * bflo(gt.x), v[1] * bfhi(gt.x)), cvt_pk_bf16(v[2] * bflo(gt.y), v[3] * bfhi(gt.y))};
        }
        __syncthreads();
    }
}

constexpr int RT_STRIDE = 2064, RT_PART = 32 * RT_STRIDE;
__device__ __forceinline__ void sel4of8(float (&v)[8], const int (&ix)[8], float (&tv)[4], int (&ti)[4]) {
#pragma unroll
    for (int k = 0; k < 4; ++k) {
        float best = v[0]; int bi = ix[0];
#pragma unroll
        for (int q = 1; q < 8; ++q) { const bool better = (v[q] > best) || (v[q] == best && ix[q] < bi); best = better ? v[q] : best; bi = better ? ix[q] : bi; }
        tv[k] = best; ti[k] = bi;
#pragma unroll
        for (int q = 0; q < 8; ++q) v[q] = (ix[q] == bi) ? -INFINITY : v[q];
    }
}
__device__ __forceinline__ void p_route(Frame& F, int layer, const float* X, int aux = 0) {
    const int tid = F.tid, lane = F.lane;
    LAS unsigned char* lds = F.lds;
    LAS float* ssq = (LAS float*)(lds + 2 * RT_PART);
    LAS f32x4* lgx = (LAS f32x4*)(lds + 2 * RT_PART + 512);
    LAS int* pe = (LAS int*)(lds + 2 * RT_PART + 512 + 8192);
    LAS float* pw = (LAS float*)(pe + 256);
    LAS int* hist = (LAS int*)(pw + 256);
    LAS int* gbase = hist + 32;
    {
        const bf16_t* rt = WSP(F, WS_RT, bf16_t) + (size_t)layer * 2 * 32 * D;
#pragma unroll 4
        for (int j = 0; j < 16; ++j) { const int ch = tid + NTH * j, part = ch >> 12, row = (ch >> 7) & 31, c16 = ch & 127;
            *(LAS u32x4*)(lds + part * RT_PART + row * RT_STRIDE + c16 * 16) = *(const u32x4*)(rt + ((size_t)(part * 32 + row) * D + c16 * 8)); }
    }
    const float* mod = WSP(F, WS_MOD, float) + (size_t)layer * 6 * D;
    int* lslot = WSP(F, WS_LSLOT, int) + (size_t)layer * NE * LIST_CAP; float* lw = WSP(F, WS_LW, float) + (size_t)layer * NE * LIST_CAP;
    if (aux) { lslot = (int*)(F.ws + WS_END); lw = (float*)(F.ws + WS_END + 4 * MiB); }
    unsigned* cntw = F.ctl + CW_CNT + 64 * (layer + 2 * aux);
    const int tile = F.wave & 3, kh = F.wave >> 2, tk = lane & 15, kq = lane >> 4;
    const float* brt = inptr(13) + layer * NE;
    __syncthreads();
    for (int tb = F.vcu; tb < T / 64; tb += F.G) {
        if (tid < 32) hist[tid] = 0;
        const int row = tb * 64 + tile * 16 + tk;
        const float* xr = X + (size_t)row * D + kh * 512 + 8 * kq;
        float ss = 0.f;
#pragma unroll 8
        for (int s = 0; s < 16; ++s) { const f32x4 a = *(const f32x4*)(xr + 32 * s), b = *(const f32x4*)(xr + 32 * s + 4);
            ss += (a.x * a.x + a.y * a.y) + (a.z * a.z + a.w * a.w) + (b.x * b.x + b.y * b.y) + (b.z * b.z + b.w * b.w); }
        ss += __shfl_xor(ss, 16); ss += __shfl_xor(ss, 32);
        if (kq == 0) ssq[F.wave * 16 + tk] = ss;
        __syncthreads();
        const float rstd = rsqrtf((ssq[tile * 16 + tk] + ssq[(tile + 4) * 16 + tk]) * (1.f / D) + EPS);
        f32x4 acc[2] = {{0.f, 0.f, 0.f, 0.f}, {0.f, 0.f, 0.f, 0.f}};
        bf16_t* hrow = WSP(F, WS_HN, bf16_t) + (size_t)row * D;
#pragma unroll 2
        for (int s = 0; s < 16; ++s) {
            const int col = kh * 512 + 32 * s + 8 * kq;
            const f32x4 a = *(const f32x4*)(xr + 32 * s), b = *(const f32x4*)(xr + 32 * s + 4);
            const f32x4 sc0 = *(const f32x4*)(mod + 4 * D + col) + 1.0f, sc1 = *(const f32x4*)(mod + 4 * D + col + 4) + 1.0f;
            const f32x4 sh0 = *(const f32x4*)(mod + 3 * D + col), sh1 = *(const f32x4*)(mod + 3 * D + col + 4);
            const f32x4 h0 = a * rstd * sc0 + sh0, h1 = b * rstd * sc1 + sh1;
            u32x4 hi; hi.x = cvt_pk_bf16(h0.x, h0.y); hi.y = cvt_pk_bf16(h0.z, h0.w); hi.z = cvt_pk_bf16(h1.x, h1.y); hi.w = cvt_pk_bf16(h1.z, h1.w);
            *(u32x4*)(hrow + col) = hi;
            u32x4 lo; lo.x = cvt_pk_bf16(h0.x - bflo(hi.x), h0.y - bfhi(hi.x)); lo.y = cvt_pk_bf16(h0.z - bflo(hi.y), h0.w - bfhi(hi.y));
            lo.z = cvt_pk_bf16(h1.x - bflo(hi.z), h1.y - bfhi(hi.z)); lo.w = cvt_pk_bf16(h1.z - bflo(hi.w), h1.w - bfhi(hi.w));
            const bf16x8 bh = __builtin_bit_cast(bf16x8, hi), bl = __builtin_bit_cast(bf16x8, lo);
#pragma unroll
            for (int et = 0; et < 2; ++et) {
                const bf16x8 wh = *(const LAS bf16x8*)(lds + (16 * et + tk) * RT_STRIDE + col * 2);
                const bf16x8 wl = *(const LAS bf16x8*)(lds + RT_PART + (16 * et + tk) * RT_STRIDE + col * 2);
                acc[et] = __builtin_amdgcn_mfma_f32_16x16x32_bf16(wh, bh, acc[et], 0, 0, 0);
                acc[et] = __builtin_amdgcn_mfma_f32_16x16x32_bf16(wl, bh, acc[et], 0, 0, 0);
                acc[et] = __builtin_amdgcn_mfma_f32_16x16x32_bf16(wh, bl, acc[et], 0, 0, 0);
            }
        }
        if (kh == 1) { lgx[(tile * 2 + 0) * 64 + lane] = acc[0]; lgx[(tile * 2 + 1) * 64 + lane] = acc[1]; }
        __syncthreads();
        if (kh == 0) {
            float cv[8]; int ci[8];
#pragma unroll
            for (int et = 0; et < 2; ++et) { const f32x4 o = lgx[(tile * 2 + et) * 64 + lane]; const f32x4 bb = *(const f32x4*)(brt + 16 * et + 4 * kq);
#pragma unroll
                for (int r = 0; r < 4; ++r) { cv[et * 4 + r] = acc[et][r] + o[r] + bb[r]; ci[et * 4 + r] = 16 * et + 4 * kq + r; } }
            float tv[4]; int ti[4];
            sel4of8(cv, ci, tv, ti);
#pragma unroll
            for (int off = 16; off <= 32; off <<= 1) {
                float mv[8]; int mi[8];
#pragma unroll
                for (int k = 0; k < 4; ++k) { mv[k] = tv[k]; mi[k] = ti[k]; mv[4 + k] = __shfl_xor(tv[k], off); mi[4 + k] = __shfl_xor(ti[k], off); }
                sel4of8(mv, mi, tv, ti);
            }
            const float e1 = __expf(tv[1] - tv[0]), e2 = __expf(tv[2] - tv[0]), e3 = __expf(tv[3] - tv[0]); const float inv = 1.0f / (1.0f + e1 + e2 + e3);
            if (kq == 0) { const int tl = tile * 16 + tk;
                pe[tl * 4 + 0] = ti[0]; pe[tl * 4 + 1] = ti[1]; pe[tl * 4 + 2] = ti[2]; pe[tl * 4 + 3] = ti[3];
                pw[tl * 4 + 0] = inv; pw[tl * 4 + 1] = e1 * inv; pw[tl * 4 + 2] = e2 * inv; pw[tl * 4 + 3] = e3 * inv; }
        }
        __syncthreads();
        int myexp = 0, lpos = 0;
        if (tid < 256) { myexp = pe[tid]; lpos = __hip_atomic_fetch_add(hist + myexp, 1, __ATOMIC_RELAXED, __HIP_MEMORY_SCOPE_WORKGROUP); }
        __syncthreads();
        if (tid < 32) gbase[tid] = (int)atomicAdd(cntw + tid, (unsigned)hist[tid]);
        __syncthreads();
        if (tid < 256) { const int pos = gbase[myexp] + lpos; if (pos < LIST_CAP) { lslot[(size_t)myexp * LIST_CAP + pos] = tb * 256 + tid; lw[(size_t)myexp * LIST_CAP + pos] = pw[tid]; } }
        __syncthreads();
    }
}

template <int MODE>
__device__ __forceinline__ void p_combine(Frame& F, int layer, const float* Xin, float* Xout) {
    const int lane = F.lane;
    const float* mod = WSP(F, WS_MOD, float) + (size_t)layer * 6 * D;
    const bf16_t* ys = WSP(F, WS_YSLOT, bf16_t);
    f32x4 gf[4], fnw[4];
#pragma unroll
    for (int j = 0; j < 4; ++j) { gf[j] = *(const f32x4*)(mod + 5 * D + 4 * lane + 256 * j); if (MODE == 1) fnw[j] = *(const f32x4*)(inptr(18) + 4 * lane + 256 * j); }
    const int gw = F.vcu * NWAVES + F.wave, NGW = F.G * NWAVES;
    for (int row = gw; row < T; row += NGW) {
        const f32x4* xr = (const f32x4*)(Xin + (size_t)row * D) + lane;
        f32x4 v[4]; float s = 0.f;
#pragma unroll
        for (int j = 0; j < 4; ++j) {
            f32x4 a = {0.f, 0.f, 0.f, 0.f};
#pragma unroll
            for (int k = 0; k < 4; ++k) { const u32x2 y = *((const u32x2*)(ys + ((size_t)row * 4 + k) * D) + lane + 64 * j); a += (f32x4){bflo(y.x), bfhi(y.x), bflo(y.y), bfhi(y.y)}; }
            v[j] = xr[64 * j] + gf[j] * a;
            s += (v[j].x * v[j].x + v[j].y * v[j].y) + (v[j].z * v[j].z + v[j].w * v[j].w);
        }
        const float rstd = rsqrtf(wave_sum(s) * (1.f / D) + EPS);
        f32x4* o = (f32x4*)(Xout + (size_t)row * D) + lane;
        if (MODE == 0) {
#pragma unroll
            for (int j = 0; j < 4; ++j) o[64 * j] = v[j];
            if (lane == 0) WSP(F, WS_RSTD, float)[row] = rstd;
        } else {
#pragma unroll
            for (int j = 0; j < 4; ++j) o[64 * j] = v[j] * rstd * fnw[j];
        }
    }
}

template <int W>
__device__ __forceinline__ void pool_unit(const float* X, const float* rs, bf16_t* P, int c, int t0, float sh, float sc) {
    float hp[16], hc[16];
#pragma unroll
    for (int i = 0; i < 16; ++i) { const int t = t0 - 16 + i; hp[i] = (i >= 16 - (W - 1) && t >= 0) ? X[(size_t)t * D + c] * rs[t] * sc + sh : 0.f; }
    float sum = 0.f;
#pragma unroll
    for (int i = 1; i < W; ++i) sum += hp[16 - i];
#pragma unroll
    for (int blk = 0; blk < 2; ++blk) {
        const int tb = t0 + 16 * blk;
#pragma unroll
        for (int i = 0; i < 16; ++i) hc[i] = X[(size_t)(tb + i) * D + c] * rs[tb + i] * sc + sh;
#pragma unroll
        for (int i = 0; i < 16; ++i) {
            const int t = tb + i;
            sum += hc[i];
            const int cnt = (t + 1 < W) ? (t + 1) : W;
            const float p = sum / (float)cnt - hc[i];
            P[(size_t)t * D + c] = (bf16_t)(cvt_pk_bf16(p, 0.f) & 0xffffu);
            sum -= (i - (W - 1) >= 0) ? hc[(i - (W - 1)) & 15] : hp[(16 + i - (W - 1)) & 15];
        }
#pragma unroll
        for (int i = 0; i < 16; ++i) hp[i] = hc[i];
    }
}
__device__ __forceinline__ void p_pool(Frame& F, const float* X) {
    const float* mod = WSP(F, WS_MOD, float) + (size_t)1 * 6 * D; const float* rs = WSP(F, WS_RSTD, float); bf16_t* P = WSP(F, WS_HN, bf16_t);
    const int tid = F.tid;
    for (int u = F.vcu; u < 1024; u += F.G) {
        const int tt = u >> 2, g = u & 3;
        const int c = g * 256 + (tid & 255), t0 = tt * 64 + (tid >> 8) * 32;
        const float sh = mod[0 * D + c], sc = 1.0f + mod[1 * D + c];
        if (g == 0) pool_unit<2>(X, rs, P, c, t0, sh, sc);
        else if (g == 1) pool_unit<4>(X, rs, P, c, t0, sh, sc);
        else if (g == 2) pool_unit<8>(X, rs, P, c, t0, sh, sc);
        else pool_unit<16>(X, rs, P, c, t0, sh, sc);
    }
}

constexpr int N_PHASES = 17;
__global__ void __launch_bounds__(NTH, 2) fwd_kernel(Args args) {
    extern __shared__ __attribute__((aligned(16))) unsigned char lds_raw[];
    Frame F;
    F.lds = (LAS unsigned char*)lds_raw;
    F.MISC = (volatile LAS unsigned*)(F.lds + MISC_OFF);
    F.tid = threadIdx.x; F.lane = F.tid & 63; F.wave = __builtin_amdgcn_readfirstlane(F.tid >> 6);
    F.G = gridDim.x; { const int bx = blockIdx.x; F.vcu = (F.G % 8 == 0) ? (bx % 8) * (F.G / 8) + bx / 8 : bx; }
    F.ws = args.ws; F.ctl = (unsigned*)(args.ws + WS_CTL); F.out = args.out;
    for (int u = F.tid; u < (LDS_BYTES - MISC_OFF) / 4; u += NTH) F.MISC[u] = 0u;
    __syncthreads();
#if N_LAUNCH_MODE == 1
    XcdBarrier bar = xcd_barrier_post(F.ctl + CW_BAR, F.MISC + 8);
#define GRID_BAR() xcd_barrier(bar)
#else
#define GRID_BAR() do { } while (0)
#endif
    const int lo = args.ph_lo, hi = args.ph_hi;
#define IN(k) (lo <= (k) && (k) < hi)
#define SEAM(k) do { if (IN(k) && IN((k) + 1)) GRID_BAR(); } while (0)
    GemmBase gb; gb.G = F.G; gb.vcu = F.vcu;
    float* X1 = WSP(F, WS_X1, float); float* X2 = WSP(F, WS_X2, float);
    const float* mod0 = WSP(F, WS_MOD, float); const float* mod1 = mod0 + 6 * D;

    if (IN(0)) { p0_prologue(F); } SEAM(0);
    if (IN(1)) { p1_norm_in(F); } SEAM(1);
    if (IN(2)) { PolWin P; (GemmBase&)P = gb; P.A = WSP(F, WS_HN, bf16_t); P.Bt = WSP(F, WS_WINT, bf16_t); P.qkvg = WSP(F, WS_QKVG, bf16_t); P.gbuf = WSP(F, WS_GBUF, float);
        P.lb = WSP(F, WS_LB, float); P.rope = WSP(F, WS_ROPE, f32x2); run_gemm(F, P); } SEAM(2);
    if (IN(3)) { la_local_state(F); } SEAM(3);
    if (IN(4)) { la_scan(F); } SEAM(4);
    if (IN(5)) { la_output(F); } SEAM(5);
    if (IN(6)) { PolRes P; (GemmBase&)P = gb; P.A = WSP(F, WS_CAT, bf16_t); P.Bt = WSP(F, WS_WOUTT, bf16_t); P.resid = inptr(0); P.outp = X1; P.gate = mod0 + 2 * D; P.bias = nullptr; P.scale = nullptr;
        P.K = D; P.lda = D; P.nN = 4; P.kcol = 0; run_gemm(F, P); } SEAM(6);
    if (IN(7)) { p_route(F, 0, X1, args.aux); } SEAM(7);
    if (IN(8)) { expert_tables(F, 0); PolG1 P; (GemmBase&)P = gb; P.MISC = F.MISC; P.hn = WSP(F, WS_HN, bf16_t); P.wgut = WSP(F, WS_WGUT, bf16_t); P.bgu = inptr(15); P.lslot = WSP(F, WS_LSLOT, int); P.act = WSP(F, WS_ACT, bf16_t);
        run_gemm(F, P); } SEAM(8);
    if (IN(9)) { expert_tables(F, 0); PolG2 P; (GemmBase&)P = gb; P.MISC = F.MISC; P.act = WSP(F, WS_ACT, bf16_t); P.wdnt = WSP(F, WS_WDNT, bf16_t); P.bdn = inptr(17); P.lslot = WSP(F, WS_LSLOT, int); P.lw = WSP(F, WS_LW, float);
        P.yslot = WSP(F, WS_YSLOT, bf16_t); run_gemm(F, P); } SEAM(9);
    if (IN(10)) { p_combine<0>(F, 0, X1, X2); } SEAM(10);
    if (IN(11)) { p_pool(F, X2); } SEAM(11);
    if (IN(12)) { PolRes P; (GemmBase&)P = gb; P.A = WSP(F, WS_HN, bf16_t); P.Bt = WSP(F, WS_POOLT, bf16_t); P.resid = X2; P.outp = X1; P.gate = mod1 + 2 * D; P.bias = inptr(10); P.scale = inptr(11);
        P.K = 256; P.lda = D; P.nN = 4; P.kcol = 256; run_gemm(F, P); } SEAM(12);
    if (IN(13)) { p_route(F, 1, X1, args.aux); } SEAM(13);
    if (IN(14)) { expert_tables(F, 1); PolG1 P; (GemmBase&)P = gb; P.MISC = F.MISC; P.hn = WSP(F, WS_HN, bf16_t); P.wgut = WSP(F, WS_WGUT, bf16_t) + (size_t)NE * 2048 * D; P.bgu = inptr(15) + (size_t)NE * 2048;
        P.lslot = WSP(F, WS_LSLOT, int) + (size_t)NE * LIST_CAP; P.act = WSP(F, WS_ACT, bf16_t); run_gemm(F, P); } SEAM(14);
    if (IN(15)) { expert_tables(F, 1); PolG2 P; (GemmBase&)P = gb; P.MISC = F.MISC; P.act = WSP(F, WS_ACT, bf16_t); P.wdnt = WSP(F, WS_WDNT, bf16_t) + (size_t)NE * D * D; P.bdn = inptr(17) + (size_t)NE * D;
        P.lslot = WSP(F, WS_LSLOT, int) + (size_t)NE * LIST_CAP; P.lw = WSP(F, WS_LW, float) + (size_t)NE * LIST_CAP; P.yslot = WSP(F, WS_YSLOT, bf16_t); run_gemm(F, P); } SEAM(15);
    if (IN(16)) { p_combine<1>(F, 1, X1, F.out); }
#undef IN
#undef SEAM
}

extern "C" void kernel_launch(void* const* d_in, const int* in_sizes, int n_in, void* d_out, int out_size, void* d_ws, size_t ws_size, hipStream_t stream) {
    static int grid = 0;
    if (grid == 0) {
        if (n_in != 19 || out_size != T * D || ws_size < WS_END) { fprintf(stderr, "kernel_launch: unexpected shapes (n_in %d, out %d, ws %zu)\n", n_in, out_size, ws_size); grid = -1; return; }
        int dev = 0, cus = 0, per_cu = 0;
        if (hipGetDevice(&dev) != hipSuccess || hipDeviceGetAttribute(&cus, hipDeviceAttributeMultiprocessorCount, dev) != hipSuccess) { grid = -1; return; }
        if (hipFuncSetAttribute((const void*)fwd_kernel, hipFuncAttributeMaxDynamicSharedMemorySize, LDS_BYTES) != hipSuccess) { fprintf(stderr, "kernel_launch: hipFuncSetAttribute failed\n"); grid = -1; return; }
        if (hipOccupancyMaxActiveBlocksPerMultiprocessor(&per_cu, (const void*)fwd_kernel, NTH, LDS_BYTES) != hipSuccess || per_cu < 1) { fprintf(stderr, "kernel_launch: occupancy query says %d\n", per_cu); }
        (void)hipGetLastError();
        grid = cus;
    }
    if (grid < 0) return;
    (void)hipMemsetAsync((char*)d_ws + WS_CTL, 0, CTL_BYTES, stream);
    Args a{};
    for (int i = 0; i < 19; ++i) a.in[i] = (const float*)d_in[i];
    a.out = (float*)d_out; a.ws = (unsigned char*)d_ws;
#if N_LAUNCH_MODE == 1
    a.ph_lo = 0; a.ph_hi = N_PHASES;
    void* kargs[] = {&a};
    hipError_t e = hipLaunchCooperativeKernel((const void*)fwd_kernel, dim3(grid), dim3(NTH), kargs, LDS_BYTES, stream);
    if (e != hipSuccess) fprintf(stderr, "cooperative launch failed: %s\n", hipGetErrorString(e));
#else
    for (int p = 0; p < N_PHASES; ++p) {
        a.ph_lo = p; a.ph_hi = p + 1;
        hipLaunchKernelGGL(fwd_kernel, dim3(grid), dim3(NTH), LDS_BYTES, stream, a);
        if (p == DUP_PHASE) { a.aux = 1; hipLaunchKernelGGL(fwd_kernel, dim3(grid), dim3(NTH), LDS_BYTES, stream, a); a.aux = 0; }
    }
#endif
}
```

```cpp
#include <hip/hip_runtime.h>
#include <cstdio>
#include <cstdint>

#ifndef N_LAUNCH_MODE
#define N_LAUNCH_MODE 1
#endif
#ifndef DUP_PHASE
#define DUP_PHASE -1
#endif
#ifndef KREP_WIN
#define KREP_WIN 1
#endif
#ifndef KREP_RES
#define KREP_RES 1
#endif
#ifndef KREP_G1
#define KREP_G1 1
#endif
#ifndef KREP_G2
#define KREP_G2 1
#endif
#ifndef GEMM_KREP
#define GEMM_KREP 1
#endif
#ifndef GEMM_EPIREP
#define GEMM_EPIREP 1
#endif
#ifndef FP8_LAYERS
#define FP8_LAYERS 3
#endif
#ifndef SIMPLE_GEMM
#define SIMPLE_GEMM 0
#endif

#define LAS __attribute__((address_space(3)))
#define GAS __attribute__((address_space(1)))
typedef unsigned short bf16_t;
typedef short bf16x8 __attribute__((ext_vector_type(8)));
typedef float f32x4 __attribute__((ext_vector_type(4)));
typedef float f32x2 __attribute__((ext_vector_type(2)));
typedef unsigned u32x4 __attribute__((ext_vector_type(4)));
typedef unsigned u32x2 __attribute__((ext_vector_type(2)));
typedef _Float16 h16x2 __attribute__((ext_vector_type(2)));
typedef _Float16 h16x8 __attribute__((ext_vector_type(8)));
typedef int v4i_t __attribute__((ext_vector_type(4)));
typedef int v8i_t __attribute__((ext_vector_type(8)));
constexpr float W8_SCALE = 32.0f;
__device__ __forceinline__ unsigned pack_fp8x4(float a, float b, float c, float d) { int w = __builtin_amdgcn_cvt_pk_fp8_f32(a, b, 0, false); w = __builtin_amdgcn_cvt_pk_fp8_f32(c, d, w, true); return (unsigned)w; }

constexpr int T = 16384, D = 1024, NE = 32, TOPK = 4, DEPTH = 2;
constexpr int INW = 4096;
constexpr int NTH = 512, NWAVES = 8;
constexpr float EPS = 1e-6f;
constexpr float SW_LIMIT = 7.0f, SW_ALPHA = 1.702f;
constexpr int LIST_CAP = T;
constexpr int ACT_ROWS = T * TOPK + NE * 256;

constexpr size_t MiB = 1u << 20;
constexpr size_t WS_CTL = 0, CTL_BYTES = 1 * MiB;
constexpr size_t WS_MOD = 1 * MiB;
constexpr size_t WS_LB = WS_MOD + 65536;
constexpr size_t WS_ROPE = 2 * MiB;
constexpr size_t WS_WINT = 10 * MiB;
constexpr size_t WS_WOUTT = 18 * MiB;
constexpr size_t WS_POOLT = 20 * MiB;
constexpr size_t WS_LSLOT = 22 * MiB;
constexpr size_t WS_LW = 26 * MiB;
constexpr size_t WS_RT = 21 * MiB;
constexpr size_t WS_RSTD = 30 * MiB;
constexpr size_t WS_WGUT = 32 * MiB;
constexpr size_t WS_WDNT = 288 * MiB;
constexpr size_t WS_HN = 416 * MiB;
constexpr size_t WS_QKVG = 448 * MiB;
constexpr size_t WS_GBUF = 576 * MiB;
constexpr size_t WS_KVT = 608 * MiB;
constexpr size_t WS_SPREV = 736 * MiB;
constexpr size_t WS_DEC = 800 * MiB;
constexpr size_t WS_CAT = 802 * MiB;
constexpr size_t WS_X1 = 834 * MiB;
constexpr size_t WS_X2 = 898 * MiB;
constexpr size_t WS_ACT = 962 * MiB;
constexpr size_t WS_YSLOT = 1106 * MiB;
constexpr size_t WS_ACT2 = 1234 * MiB;
constexpr size_t WS_HN8 = 1378 * MiB;
constexpr size_t WS_END = 1394 * MiB;
constexpr int CW_CNT = 64;
constexpr int CW_BAR = 4096;
constexpr int CW_TMO = 8;
constexpr int CW_DONE = 8192, DONE_LAYER = 320 * 64;

constexpr int SCR_BYTES = 156 * 1024;
constexpr int MISC_OFF = SCR_BYTES;
constexpr int LDS_BYTES = SCR_BYTES + 4096;

typedef __bf16 bf16x2_t __attribute__((ext_vector_type(2)));
__device__ __forceinline__ unsigned cvt_pk_bf16(float lo, float hi) { const f32x2 v = {lo, hi}; const bf16x2_t b = __builtin_convertvector(v, bf16x2_t); return __builtin_bit_cast(unsigned, b); }
__device__ __forceinline__ float bf2f(unsigned short b) { return __builtin_bit_cast(float, (unsigned)b << 16); }
__device__ __forceinline__ float bflo(unsigned w) { return __builtin_bit_cast(float, w << 16); }
__device__ __forceinline__ float bfhi(unsigned w) { return __builtin_bit_cast(float, w & 0xffff0000u); }
__device__ __forceinline__ float wave_sum(float v) {
#pragma unroll
    for (int o = 1; o < 64; o <<= 1) v += __shfl_xor(v, o);
    return v;
}
__device__ __forceinline__ float wave_max(float v) {
#pragma unroll
    for (int o = 1; o < 64; o <<= 1) v = fmaxf(v, __shfl_xor(v, o));
    return v;
}
__device__ __forceinline__ float sigmoidf_(float x) { return __builtin_amdgcn_rcpf(1.0f + __expf(-x)); }
__device__ __forceinline__ float siluf_(float x) { return x * sigmoidf_(x); }

#define XB_TMO      128
#define XB_XCNT(j)  (256  + 64 * (j))
#define XB_XSUB(j)  (1280 + 64 * (j))
#define XB_XGEN(j)  (2304 + 64 * (j))
#define XB_TOP      3328
#define XB_TOPGEN   3392
#define XCD_BAR_WORDS 3456
#define XB_SPIN_CAP (1u << 20)
__device__ __forceinline__ unsigned xb_ld(unsigned* p)              { return __hip_atomic_load(p, __ATOMIC_RELAXED, __HIP_MEMORY_SCOPE_AGENT); }
__device__ __forceinline__ unsigned xb_add(unsigned* p, unsigned v) { return __hip_atomic_fetch_add(p, v, __ATOMIC_RELAXED, __HIP_MEMORY_SCOPE_AGENT); }
__device__ __forceinline__ unsigned xb_xcc_id() { return (unsigned)__builtin_amdgcn_s_getreg((3 << 11) | 20) & 0xFu; }
#define XB_SPIN(cond, bar) do { unsigned _sp = 0; while (cond) { __builtin_amdgcn_s_sleep(1); \
    if ((++_sp & 255u) == 0u) { if (xb_ld(&(bar)[XB_TMO])) break; if (_sp > XB_SPIN_CAP) { atomicAdd(&(bar)[XB_TMO], 1u); break; } } } } while (0)
struct XcdBarrier { unsigned* bar; unsigned x; volatile LAS unsigned* st; };
__device__ __forceinline__ XcdBarrier xcd_barrier_post(unsigned* bar, volatile LAS unsigned* st) {
    XcdBarrier b; b.bar = bar; b.x = xb_xcc_id(); b.st = st;
    if (threadIdx.x == 0) (void)xb_add(&bar[XB_XCNT(b.x)], 1u);
    return b;
}
__device__ __forceinline__ void xcd_barrier_complete(unsigned* bar, unsigned x, unsigned& nloc, unsigned& nx) {
    const unsigned G = gridDim.x * gridDim.y * gridDim.z;
    unsigned sum, cnt, mine, sp = 0u;
    for (;;) {
        sum = 0u; cnt = 0u; mine = 0u;
#pragma unroll
        for (unsigned j = 0; j < 16; ++j) { const unsigned c = xb_ld(&bar[XB_XCNT(j)]); sum += c; cnt += (c > 0u) ? 1u : 0u; mine = (j == x) ? c : mine; }
        if (sum == G) break;
        __builtin_amdgcn_s_sleep(1);
        if ((++sp & 255u) == 0u) { if (xb_ld(&bar[XB_TMO])) break; if (sp > XB_SPIN_CAP) { atomicAdd(&bar[XB_TMO], 1u); break; } }
    }
    nloc = mine > 0u ? mine : 1u; nx = cnt > 0u ? cnt : 1u;
}
__device__ __forceinline__ void xcd_barrier(const XcdBarrier& b) {
    asm volatile("s_waitcnt vmcnt(0)" ::: "memory");
    __syncthreads();
    if (threadIdx.x == 0) {
        unsigned* bar = b.bar;
        __builtin_amdgcn_s_waitcnt(0);
        unsigned nloc = b.st[0], nx = b.st[1];
        if (nloc == 0u) { xcd_barrier_complete(bar, b.x, nloc, nx); b.st[0] = nloc; b.st[1] = nx; }
        const unsigned old = xb_add(&bar[XB_XSUB(b.x)], 1u);
        const unsigned gen = old / nloc;
        if (old + 1u == (gen + 1u) * nloc) {
            __builtin_amdgcn_fence(__ATOMIC_RELEASE, "agent");
            asm volatile("s_waitcnt vmcnt(0)" ::: "memory");
            const unsigned og = xb_add(&bar[XB_TOP], 1u);
            const unsigned tg = og / nx;
            if (og + 1u == (tg + 1u) * nx) xb_add(&bar[XB_TOPGEN], 1u);
            else XB_SPIN(xb_ld(&bar[XB_TOPGEN]) == tg, bar);
            __builtin_amdgcn_fence(__ATOMIC_ACQUIRE, "agent");
            xb_add(&bar[XB_XGEN(b.x)], 1u);
            asm volatile("s_waitcnt vmcnt(0)" ::: "memory");
        } else {
            XB_SPIN(xb_ld(&bar[XB_XGEN(b.x)]) == gen, bar);
            __builtin_amdgcn_fence(__ATOMIC_ACQUIRE, "agent");
            asm volatile("s_waitcnt vmcnt(0)" ::: "memory");
        }
    }
    __syncthreads();
}

struct Args {
    const float* in[19];
    float* out;
    unsigned char* ws;
    int ph_lo, ph_hi, aux, pad;
};

namespace pg8 {
constexpr int BM = 256, BK = 64, HALF = 128, HTB = HALF * BK * 2;
__host__ __device__ __forceinline__ int lds_byte(int r, int c) { const int st = (r >> 4) * 2 + (c >> 5), rr = r & 15, cc = c & 31, ob = rr * 64 + cc * 2; return st * 1024 + (ob ^ (((ob >> 9) & 1) << 5)); }
__host__ __device__ __forceinline__ void stage_rc(int b, int& R, int& C) { const int st = b / 1024, sb = b % 1024, swz = sb ^ (((sb >> 9) & 1) << 5); R = (st >> 1) * 16 + swz / 64; C = (st & 1) * 32 + (swz % 64) / 2; }
__host__ __device__ __forceinline__ int perm32(int rho) { const int n = rho >> 4, i = rho & 15; return 8 * (i >> 2) + 4 * n + (i & 3); }

struct Unit { const char* A; const char* B; int p0, p1, p2, p3, ui; };

#define PG8_SA(b, h) (((b) * 2 + (h)) * HTB)
#define PG8_SB(b, h) ((4 + (b) * 2 + (h)) * HTB)
#define PG8_LDA(dst, b, h) do { _Pragma("unroll") for (int m = 0; m < 4; ++m) _Pragma("unroll") for (int k = 0; k < 2; ++k) dst[m][k] = *(const LAS bf16x8*)(lds + PG8_SA(b, h) + aoff + m * 2048 + k * 1024); } while (0)
#define PG8_LDB(dst, b, h) do { _Pragma("unroll") for (int n = 0; n < 2; ++n) _Pragma("unroll") for (int k = 0; k < 2; ++k) dst[n][k] = *(const LAS bf16x8*)(lds + PG8_SB(b, h) + boff + n * 2048 + k * 1024); } while (0)
#define PG8_MMA(ai, bj, At, Bt) do { __builtin_amdgcn_s_setprio(1); _Pragma("unroll") for (int m = 0; m < 4; ++m) _Pragma("unroll") for (int n = 0; n < 2; ++n) _Pragma("unroll") for (int k = 0; k < 2; ++k) \
        acc[ai][bj][m][n] = __builtin_amdgcn_mfma_f32_16x16x32_bf16(Bt[n][k], At[m][k], acc[ai][bj][m][n], 0, 0, 0); __builtin_amdgcn_s_setprio(0); } while (0)

template <class P>
__device__ __forceinline__ void gemm_simple(LAS unsigned char* lds, const P& S) {
    const int tid = threadIdx.x, wid = __builtin_amdgcn_readfirstlane(tid >> 6), lane = tid & 63, wr = wid >> 2, wc = wid & 3, fr = lane & 15, fq = lane >> 4;
    const int nt = S.nt();
    int R0, C0; stage_rc(tid * 16, R0, C0);
    unsigned offB[2];
#pragma unroll
    for (int i = 0; i < 2; ++i) { const int R = R0 + 64 * i; const int Rb = (R & ~31) + perm32(R & 31); offB[i] = (unsigned)Rb * S.ldb_bytes() + (unsigned)C0 * 2u; }
    const unsigned bhalf = 128u * S.ldb_bytes();
    const int aoff = lds_byte(wr * 64 + fr, fq * 8), boff = lds_byte(wc * 32 + fr, fq * 8);
    Unit u;
    for (int ui = 0; S.next(ui, u); ++ui) {
        unsigned offA[4]; S.aoff(u, R0, C0, offA);
        f32x4 acc[2][2][4][2];
#pragma unroll
        for (int a = 0; a < 2; ++a)
#pragma unroll
            for (int b = 0; b < 2; ++b)
#pragma unroll
                for (int m = 0; m < 4; ++m)
#pragma unroll
                    for (int n = 0; n < 2; ++n) acc[a][b][m][n] = (f32x4){0.f, 0.f, 0.f, 0.f};
        for (int t = 0; t < nt; ++t) {
            u32x4 ra[4], rb[4];
#pragma unroll
            for (int h = 0; h < 2; ++h)
#pragma unroll
                for (int i = 0; i < 2; ++i) {
                    ra[2 * h + i] = *(const u32x4*)(u.A + offA[2 * h + i] + (size_t)t * 128);
                    rb[2 * h + i] = *(const u32x4*)(u.B + (size_t)h * bhalf + offB[i] + (size_t)t * 128);
                }
            __syncthreads();
#pragma unroll
            for (int h = 0; h < 2; ++h)
#pragma unroll
                for (int i = 0; i < 2; ++i) {
                    *(LAS u32x4*)(lds + PG8_SA(0, h) + tid * 16 + i * 8192) = ra[2 * h + i];
                    *(LAS u32x4*)(lds + PG8_SB(0, h) + tid * 16 + i * 8192) = rb[2 * h + i];
                }
            __syncthreads();
            bf16x8 At[4][2], Bt[2][2];
#pragma unroll
            for (int ai = 0; ai < 2; ++ai) {
                PG8_LDA(At, 0, ai);
#pragma unroll
                for (int bj = 0; bj < 2; ++bj) { PG8_LDB(Bt, 0, bj); PG8_MMA(ai, bj, At, Bt); }
            }
        }
        S.epi(acc, u, wr, wc, fr, fq);
    }
    __syncthreads();
}

template <class P>
__device__ __forceinline__ void gemm_pipe(LAS unsigned char* lds, const P& S) {
    const int tid = threadIdx.x, wid = __builtin_amdgcn_readfirstlane(tid >> 6), lane = tid & 63, wr = wid >> 2, wc = wid & 3, fr = lane & 15, fq = lane >> 4;
    constexpr int KR = GEMM_KREP * P::KREP; const int nt1 = S.nt(), nt = nt1 * KR;
    int R0, C0; stage_rc(tid * 16, R0, C0);
    unsigned offB[2];
#pragma unroll
    for (int i = 0; i < 2; ++i) { const int R = R0 + 64 * i; const int Rb = (R & ~31) + perm32(R & 31); offB[i] = (unsigned)Rb * S.ldb_bytes() + (unsigned)C0 * 2u; }
    const size_t bhalf = (size_t)128u * S.ldb_bytes();
    const size_t kstep = 128;
    const unsigned ldsw = (unsigned)wid * 1024u;
    int aoffK[2], boffK[2];
#pragma unroll
    for (int k = 0; k < 2; ++k) { aoffK[k] = lds_byte(wr * 64 + fr, fq * 8) + k * 1024; boffK[k] = lds_byte(wc * 32 + fr, fq * 8) + k * 1024; }
#undef PG8_LDA
#undef PG8_LDB
#undef PG8_MMA
#define PG8_LDA(dst, b, h) do { _Pragma("unroll") for (int m = 0; m < 4; ++m) { \
        if constexpr (P::FP8) dst##8[m] = __builtin_shufflevector(*(const LAS v4i_t*)(lds + PG8_SA(b, h) + aoffK[0] + m * 2048), *(const LAS v4i_t*)(lds + PG8_SA(b, h) + aoffK[1] + m * 2048), 0, 1, 2, 3, 4, 5, 6, 7); \
        else { _Pragma("unroll") for (int k = 0; k < 2; ++k) dst[m][k] = *(const LAS bf16x8*)(lds + PG8_SA(b, h) + aoffK[k] + m * 2048); } } } while (0)
#define PG8_LDB(dst, b, h) do { _Pragma("unroll") for (int n = 0; n < 2; ++n) { \
        if constexpr (P::FP8) dst##8[n] = __builtin_shufflevector(*(const LAS v4i_t*)(lds + PG8_SB(b, h) + boffK[0] + n * 2048), *(const LAS v4i_t*)(lds + PG8_SB(b, h) + boffK[1] + n * 2048), 0, 1, 2, 3, 4, 5, 6, 7); \
        else { _Pragma("unroll") for (int k = 0; k < 2; ++k) dst[n][k] = *(const LAS bf16x8*)(lds + PG8_SB(b, h) + boffK[k] + n * 2048); } } } while (0)
#define PG8_MMA(ai, bj, At, Bt) do { if constexpr (P::FP8) __builtin_amdgcn_sched_barrier(0); __builtin_amdgcn_s_setprio(1); _Pragma("unroll") for (int m = 0; m < 4; ++m) _Pragma("unroll") for (int n = 0; n < 2; ++n) { \
        if constexpr (P::FP8) acc[ai][bj][m][n] = __builtin_amdgcn_mfma_scale_f32_16x16x128_f8f6f4(Bt##8[n], At##8[m], acc[ai][bj][m][n], 0, 0, 0, 127, 0, 127); \
        else { _Pragma("unroll") for (int k = 0; k < 2; ++k) acc[ai][bj][m][n] = __builtin_amdgcn_mfma_f32_16x16x32_bf16(Bt[n][k], At[m][k], acc[ai][bj][m][n], 0, 0, 0); } } \
        if constexpr (P::FP8) { _Pragma("unroll") for (int m = 0; m < 4; ++m) _Pragma("unroll") for (int n = 0; n < 2; ++n) asm volatile("" : "+v"(acc[ai][bj][m][n])); } \
        __builtin_amdgcn_s_setprio(0); if constexpr (P::FP8) __builtin_amdgcn_sched_barrier(0); } while (0)
#define PG8_STAGE_A(bufoff, gbase, OFF, h) do { _Pragma("unroll") for (int _i = 0; _i < 2; ++_i) \
        __builtin_amdgcn_global_load_lds((const unsigned*)((const char*)(gbase) + (OFF)[2 * (h) + _i]), (LAS unsigned*)(lds + (bufoff) + ldsw + _i * 8192), 16, 0, 0); } while (0)
#define PG8_STAGE_B(bufoff, gbase) do { _Pragma("unroll") for (int _i = 0; _i < 2; ++_i) \
        __builtin_amdgcn_global_load_lds((const unsigned*)((const char*)(gbase) + offB[_i]), (LAS unsigned*)(lds + (bufoff) + ldsw + _i * 8192), 16, 0, 0); } while (0)
#define PG8_WAIT_V(n) asm volatile("s_waitcnt vmcnt(" #n ")" ::: "memory")
#define PG8_WAIT_L(n) asm volatile("s_waitcnt lgkmcnt(" #n ")" ::: "memory")
#define PG8_BAR __builtin_amdgcn_s_barrier()
#define PG8_SCHED __builtin_amdgcn_sched_barrier(0)
    Unit cur, nxt; int ui = 0; int pend = -1;
    if (!S.next(0, cur)) return;
    f32x4 acc[2][2][4][2];
#pragma unroll
    for (int a = 0; a < 2; ++a)
#pragma unroll
        for (int b = 0; b < 2; ++b)
#pragma unroll
            for (int m = 0; m < 4; ++m)
#pragma unroll
                for (int n = 0; n < 2; ++n) acc[a][b][m][n] = (f32x4){0.f, 0.f, 0.f, 0.f};
    bf16x8 At[4][2], B0[2][2], B1[2][2];
    v8i_t At8[4], B08[2], B18[2];
    unsigned offC[4], offN[4];
    S.aoff(cur, R0, C0, offC);
    const char* cA = cur.A; const char* cB = cur.B;
    if constexpr (P::HAS_READY) S.a_ready(cur);
    PG8_STAGE_B(PG8_SB(0, 0), cB); PG8_STAGE_B(PG8_SB(0, 1), cB + bhalf); PG8_STAGE_A(PG8_SA(0, 0), cA, offC, 0); PG8_STAGE_A(PG8_SA(0, 1), cA, offC, 1);
    if (wr == 1) PG8_BAR;
    PG8_WAIT_V(2); PG8_BAR;
    PG8_STAGE_B(PG8_SB(1, 0), cB + kstep); PG8_STAGE_A(PG8_SA(1, 0), cA + kstep, offC, 0); PG8_STAGE_B(PG8_SB(1, 1), cB + bhalf + kstep);
    PG8_WAIT_V(6); PG8_BAR;
    for (;;) {
        const bool has_next = S.next(ui + 1, nxt);
        if (has_next) S.aoff(nxt, R0, C0, offN);
        else {
#pragma unroll
            for (int q = 0; q < 4; ++q) offN[q] = offC[q];
        }
        const char* nA = has_next ? nxt.A : cA; const char* nB = has_next ? nxt.B : cB;
        for (int t = 0; t < nt; t += 2) {
            const bool last = (t == nt - 2);
            const bool sf = P::SEAM_OPT && (ui > 0) && (t == 0);
            if constexpr (P::HAS_READY) { if (last && has_next) S.a_ready(nxt); }
            const char* a1 = cA + (size_t)((t + 1) % nt1) * kstep;
            const char* a2 = last ? nA : cA + (size_t)((t + 2) % nt1) * kstep; const char* b2 = last ? nB : cB + (size_t)((t + 2) % nt1) * kstep;
            const char* a3 = a2 + kstep; const char* b3 = b2 + kstep;
            unsigned o2[4];
#pragma unroll
            for (int q = 0; q < 4; ++q) o2[q] = last ? offN[q] : offC[q];
            PG8_LDB(B0, 0, 0); PG8_LDB(B1, 0, 1); PG8_SCHED; PG8_LDA(At, 0, 0); if (!sf) { PG8_STAGE_A(PG8_SA(1, 1), a1, offC, 1); PG8_WAIT_V(8); }
            PG8_WAIT_L(0); PG8_BAR; PG8_MMA(0, 0, At, B0); PG8_MMA(0, 1, At, B1); PG8_BAR; PG8_SCHED;
            PG8_LDA(At, 0, 1); PG8_STAGE_B(PG8_SB(0, 0), b2); PG8_STAGE_B(PG8_SB(0, 1), b2 + bhalf); PG8_STAGE_A(PG8_SA(0, 0), a2, o2, 0);
            if (!sf) PG8_WAIT_V(8); PG8_WAIT_L(0); PG8_BAR; PG8_MMA(1, 0, At, B0); PG8_MMA(1, 1, At, B1); PG8_BAR; PG8_SCHED;
            PG8_LDB(B0, 1, 0); PG8_LDB(B1, 1, 1); PG8_SCHED; PG8_LDA(At, 1, 0); PG8_STAGE_A(PG8_SA(0, 1), a2, o2, 1);
            if (!sf) PG8_WAIT_V(8); PG8_WAIT_L(0); PG8_BAR; PG8_MMA(0, 0, At, B0); PG8_MMA(0, 1, At, B1); PG8_BAR; PG8_SCHED;
            PG8_LDA(At, 1, 1); PG8_STAGE_B(PG8_SB(1, 0), b3); PG8_STAGE_B(PG8_SB(1, 1), b3 + bhalf); PG8_STAGE_A(PG8_SA(1, 0), a3, o2, 0);
            if (!sf) PG8_WAIT_V(8); PG8_WAIT_L(0); PG8_BAR; PG8_MMA(1, 0, At, B0); PG8_MMA(1, 1, At, B1); PG8_BAR; PG8_SCHED;
        }
        if constexpr (P::SEAM_OPT) PG8_STAGE_A(PG8_SA(1, 1), nA + kstep, offN, 1);
        if (wr == 0) PG8_BAR;
        if constexpr (P::SEAM_OPT) { PG8_WAIT_V(0);
            S.flush(pend); pend = -1; }
        if (KR != 1) {
#pragma unroll
            for (int a = 0; a < 2; ++a)
#pragma unroll
                for (int b = 0; b < 2; ++b)
#pragma unroll
                    for (int m = 0; m < 4; ++m)
#pragma unroll
                        for (int n = 0; n < 2; ++n) acc[a][b][m][n] = acc[a][b][m][n] * (1.0f / KR);
        }
        pend = S.epi(acc, cur, wr, wc, fr, fq);
        if constexpr (!P::SEAM_OPT) { if (pend >= 0) { PG8_WAIT_V(0); S.flush(pend); pend = -1; } }
        if (!has_next) break;
#pragma unroll
        for (int a = 0; a < 2; ++a)
#pragma unroll
            for (int b = 0; b < 2; ++b)
#pragma unroll
                for (int m = 0; m < 4; ++m)
#pragma unroll
                    for (int n = 0; n < 2; ++n) acc[a][b][m][n] = (f32x4){0.f, 0.f, 0.f, 0.f};
        cur = nxt; cA = nA; cB = nB; ++ui;
#pragma unroll
        for (int q = 0; q < 4; ++q) offC[q] = offN[q];
        if (wr == 1) PG8_BAR;
    }
    PG8_WAIT_V(0);
    S.flush(pend);
    PG8_BAR;
#undef PG8_STAGE_A
#undef PG8_STAGE_B
#undef PG8_WAIT_V
#undef PG8_WAIT_L
#undef PG8_BAR
#undef PG8_SCHED
}
}

struct Frame {
    LAS unsigned char* lds;
    volatile LAS unsigned* MISC;
    unsigned* ctl;
    int tid, lane, wave, vcu, G;
    unsigned char* ws;
    float* out;
};
typedef const float* cfptr_t;
__device__ __forceinline__ const float* inptr(int i) {
    const __attribute__((address_space(4))) cfptr_t* ka = (const __attribute__((address_space(4))) cfptr_t*)__builtin_amdgcn_kernarg_segment_ptr();
    asm volatile("" : "+s"(ka));
    const GAS float* g = (const GAS float*)ka[i];
    return (const float*)g;
}
#define WSP(F, off, type) ((type*)((F).ws + (off)))

template <class RowMap>
__device__ __forceinline__ void transpose_tile(const float* W, int K, int N, bf16_t* WT, LAS unsigned char* scr, int item, int lane, const RowMap& rm) {
    const int nblk = N / 64, kb = item / nblk, nb = item % nblk, k0 = 64 * kb, n0 = 64 * nb;
    const int kg = lane & 3, ng = lane >> 2;
    f32x4 v[4][4];
#pragma unroll
    for (int r = 0; r < 4; ++r)
#pragma unroll
        for (int i = 0; i < 4; ++i) v[r][i] = __builtin_nontemporal_load((const f32x4*)(W + (size_t)(k0 + 16 * r + 4 * kg + i) * N + n0 + 4 * ng));
#pragma unroll
    for (int r = 0; r < 4; ++r)
#pragma unroll
        for (int j = 0; j < 4; ++j)
            *(LAS u32x2*)(scr + (4 * ng + j) * 144 + (16 * r + 4 * kg) * 2) = (u32x2){cvt_pk_bf16(v[r][0][j], v[r][1][j]), cvt_pk_bf16(v[r][2][j], v[r][3][j])};
    asm volatile("s_waitcnt lgkmcnt(0)" ::: "memory");
    const int c = lane & 7;
#pragma unroll
    for (int q = 0; q < 8; ++q) { const int n = (lane >> 3) + 8 * q; const u32x4 o = *(const LAS u32x4*)(scr + n * 144 + c * 16); __builtin_nontemporal_store(o, (u32x4*)(WT + (size_t)rm(n0 + n) * K + k0 + 8 * c)); }
    asm volatile("s_waitcnt lgkmcnt(0)" ::: "memory");
}
template <class RowMap>
__device__ __forceinline__ void transpose_tile8(const float* W, int K, int N, unsigned char* WT, LAS unsigned char* scr, int item, int lane, const RowMap& rm) {
    const int nblk = N / 64, kb = item / nblk, nb = item % nblk, k0 = 128 * kb, n0 = 64 * nb;
    const int kg = lane & 3, ng = lane >> 2;
#pragma unroll
    for (int hb = 0; hb < 2; ++hb) {
        f32x4 v[4][4];
#pragma unroll
        for (int r = 0; r < 4; ++r)
#pragma unroll
            for (int i = 0; i < 4; ++i) v[r][i] = __builtin_nontemporal_load((const f32x4*)(W + (size_t)(k0 + 64 * hb + 16 * r + 4 * kg + i) * N + n0 + 4 * ng));
#pragma unroll
        for (int r = 0; r < 4; ++r)
#pragma unroll
            for (int j = 0; j < 4; ++j)
                *(LAS unsigned*)(scr + (4 * ng + j) * 144 + 64 * hb + 16 * r + 4 * kg) = pack_fp8x4(v[r][0][j] * W8_SCALE, v[r][1][j] * W8_SCALE, v[r][2][j] * W8_SCALE, v[r][3][j] * W8_SCALE);
    }
    asm volatile("s_waitcnt lgkmcnt(0)" ::: "memory");
    const int c = lane & 7;
#pragma unroll
    for (int q = 0; q < 8; ++q) { const int n = (lane >> 3) + 8 * q; const u32x4 o = *(const LAS u32x4*)(scr + n * 144 + c * 16); __builtin_nontemporal_store(o, (u32x4*)(WT + (size_t)rm(n0 + n) * K + k0 + 16 * c)); }
    asm volatile("s_waitcnt lgkmcnt(0)" ::: "memory");
}
struct RmId { __device__ __forceinline__ int operator()(int n) const { return n; } };
struct RmWin { __device__ __forceinline__ int operator()(int n) const {
        const int s = n >> 9; if (s != 4 && s != 5) return n;
        const int d = n & 127, dd = d & 63; const int p = 8 * (dd >> 2) + (dd & 3) + ((d >> 6) << 2); return n - d + p; } };
struct RmGu { __device__ __forceinline__ int operator()(int n) const { const int half = n >> 10, j = (n & 1023) >> 7, i = n & 127; return 256 * j + 128 * half + i; } };

__device__ __forceinline__ void p0_prologue(Frame& F) {
    const int tid = F.tid;
    {
        LAS float* red = (LAS float*)F.lds;
        const float* c = inptr(1);
        for (int u = F.vcu; u < 192; u += F.G) {
            const int l = u / 96, cg = u % 96, kq = tid >> 4, cq = tid & 15;
            const float* W = inptr(2) + (size_t)l * D * 6 * D + cg * 64 + cq * 4;
            f32x4 a = {0.f, 0.f, 0.f, 0.f};
#pragma unroll 8
            for (int j = 0; j < 32; ++j) { const int k = kq + 32 * j; const float cv = siluf_(c[k]); const f32x4 w = *(const f32x4*)(W + (size_t)k * 6 * D); a += w * cv; }
            __syncthreads();
            *(LAS f32x4*)(red + kq * 64 + cq * 4) = a;
            __syncthreads();
            if (tid < 64) { float s = 0.f;
#pragma unroll 8
                for (int k = 0; k < 32; ++k) s += red[k * 64 + tid];
                const int col = cg * 64 + tid;
                WSP(F, WS_MOD, float)[l * 6 * D + col] = s + inptr(3)[l * 6 * D + col]; }
        }
        __syncthreads();
    }
    if (F.vcu == 0) { const float* hb = inptr(5); const float a = hb[tid], b = hb[512 + tid]; WSP(F, WS_LB, float)[tid] = 1.0f / (1.0f + __expf(b - a)); }
    {
        bf16_t* rt = WSP(F, WS_RT, bf16_t); const float* wr = inptr(12);
        for (int idx = F.vcu * NTH + tid; idx < 2 * D * NE; idx += F.G * NTH) {
            const int l = idx >> 15, rem = idx & 32767, c = rem >> 5, e = rem & 31;
            const float w = wr[idx]; const unsigned hi = cvt_pk_bf16(w, 0.f) & 0xffffu; const float res = w - bflo(hi);
            rt[((size_t)(l * 2 + 0) * 32 + e) * D + c] = (bf16_t)hi; rt[((size_t)(l * 2 + 1) * 32 + e) * D + c] = (bf16_t)(cvt_pk_bf16(res, 0.f) & 0xffffu);
        }
    }
    {
        f32x2* rope = WSP(F, WS_ROPE, f32x2);
        for (int idx = F.vcu * NTH + tid; idx < T * 64; idx += F.G * NTH) {
            const int t = idx >> 6, d = idx & 63;
            const float inv = exp2f(-(float)d * (13.287712379549449f / 64.0f));
            const float ang = (float)t * inv;
            const double a = (double)ang; const double n = __builtin_rint(a * 0.15915494309189535); const double r = __builtin_fma(-n, 6.283185307179586, a);
            const float rf = (float)r;
            rope[idx] = (f32x2){__cosf(rf), __sinf(rf)};
        }
    }
    {
        LAS unsigned char* scr = F.lds + F.wave * 16384;
        const int gw = F.vcu * NWAVES + F.wave, NGW = F.G * NWAVES;
        constexpr int I_IN = 16 * 64, I_OUT = 16 * 16, I_POOL = 4 * 4 * 4;
        constexpr int NL8 = ((FP8_LAYERS & 1) ? 1 : 0) + ((FP8_LAYERS & 2) ? 1 : 0), NL16 = 2 - NL8;
        constexpr int S_GU = 32 * 8 * 32, S_DN = 32 * 8 * 16;
        constexpr int T_GU = 32 * 16 * 32, T_DN = 32 * 16 * 16;
        constexpr int N8 = NL8 * (S_GU + S_DN), N16 = NL16 * (T_GU + T_DN);
        constexpr int NITEMS = N8 + I_IN + I_OUT + I_POOL + N16;
        for (int it = gw; it < NITEMS; it += NGW) {
            int r = it;
            if (r < N8) {
                const int li = r / (S_GU + S_DN), layer = (NL8 == 2) ? li : ((FP8_LAYERS & 1) ? 0 : 1); r -= li * (S_GU + S_DN);
                if (r < S_GU) { const int m = layer * 32 + r / 256; transpose_tile8(inptr(14) + (size_t)m * D * 2048, D, 2048, (unsigned char*)(WSP(F, WS_WGUT, bf16_t) + (size_t)layer * NE * 2048 * D) + (size_t)(m & 31) * 2048 * D, scr, r % 256, F.lane, RmGu()); }
                else { r -= S_GU; const int m = layer * 32 + r / 128; transpose_tile8(inptr(16) + (size_t)m * D * D, D, D, (unsigned char*)(WSP(F, WS_WDNT, bf16_t) + (size_t)layer * NE * D * D) + (size_t)(m & 31) * D * D, scr, r % 128, F.lane, RmId()); }
                continue;
            }
            r -= N8;
            if (r < I_IN) { transpose_tile(inptr(4), D, INW, WSP(F, WS_WINT, bf16_t), scr, r, F.lane, RmWin()); continue; } r -= I_IN;
            if (r < I_OUT) { transpose_tile(inptr(8), D, D, WSP(F, WS_WOUTT, bf16_t), scr, r, F.lane, RmId()); continue; } r -= I_OUT;
            if (r < I_POOL) { const int g = r / 16; transpose_tile(inptr(9) + (size_t)g * 65536, 256, 256, WSP(F, WS_POOLT, bf16_t) + (size_t)g * 65536, scr, r % 16, F.lane, RmId()); continue; } r -= I_POOL;
            if (NL16 > 0) {
                const int li = r / (T_GU + T_DN), layer = (NL16 == 2) ? li : ((FP8_LAYERS & 1) ? 1 : 0); r -= li * (T_GU + T_DN);
                if (r < T_GU) { const int m = layer * 32 + r / 512; transpose_tile(inptr(14) + (size_t)m * D * 2048, D, 2048, WSP(F, WS_WGUT, bf16_t) + (size_t)m * 2048 * D, scr, r % 512, F.lane, RmGu()); }
                else { r -= T_GU; const int m = layer * 32 + r / 256; transpose_tile(inptr(16) + (size_t)m * D * D, D, D, WSP(F, WS_WDNT, bf16_t) + (size_t)m * D * D, scr, r % 256, F.lane, RmId()); }
            }
        }
    }
}

__device__ __forceinline__ void p1_norm_in(Frame& F) {
    const float* mod = WSP(F, WS_MOD, float);
    f32x4 sh[4], sc[4];
#pragma unroll
    for (int j = 0; j < 4; ++j) { sh[j] = *(const f32x4*)(mod + 0 * D + 4 * F.lane + 256 * j); sc[j] = *(const f32x4*)(mod + 1 * D + 4 * F.lane + 256 * j) + 1.0f; }
    const int gw = F.vcu * NWAVES + F.wave, NGW = F.G * NWAVES;
    for (int row = gw; row < T; row += NGW) {
        const f32x4* xr = (const f32x4*)(inptr(0) + (size_t)row * D) + F.lane;
        f32x4 v[4]; float s = 0.f;
#pragma unroll
        for (int j = 0; j < 4; ++j) { v[j] = xr[64 * j]; s += (v[j].x * v[j].x + v[j].y * v[j].y) + (v[j].z * v[j].z + v[j].w * v[j].w); }
        const float rstd = rsqrtf(wave_sum(s) * (1.f / D) + EPS);
        u32x2* o = (u32x2*)(WSP(F, WS_HN, bf16_t) + (size_t)row * D) + F.lane;
#pragma unroll
        for (int j = 0; j < 4; ++j) { const f32x4 h = v[j] * rstd * sc[j] + sh[j]; o[64 * j] = (u32x2){cvt_pk_bf16(h.x, h.y), cvt_pk_bf16(h.z, h.w)}; }
    }
}

using pg8::Unit;
typedef f32x4 AccT[2][2][4][2];

struct GemmBase {
    static constexpr bool SEAM_OPT = false;
    __device__ __forceinline__ void flush(int) const {}
    static constexpr bool HAS_READY = false;
    static constexpr bool FP8 = false;
    int G, vcu;
    __device__ __forceinline__ void aoff_lin(int R0, int C0, unsigned lda_bytes, unsigned (&off)[4]) const {
#pragma unroll
        for (int q = 0; q < 4; ++q) off[q] = (unsigned)(R0 + 64 * (q & 1) + 128 * (q >> 1)) * lda_bytes + (unsigned)C0 * 2u;
    }
};

struct PolWin : GemmBase {
    static constexpr int KREP = KREP_WIN;
    const bf16_t* A; const bf16_t* Bt; bf16_t* qkvg; _Float16* gbuf; const float* lb; const f32x2* rope;
    __device__ __forceinline__ int nt() const { return D / 64; }
    __device__ __forceinline__ unsigned ldb_bytes() const { return D * 2; }
    __device__ __forceinline__ bool next(int i, Unit& u) const {
        const int V = i * G + vcu; if (V >= 64 * 16) return false;
        u.p0 = V >> 4; u.p1 = V & 15; u.A = (const char*)(A + (size_t)u.p0 * 256 * D); u.B = (const char*)(Bt + (size_t)u.p1 * 256 * D); return true; }
    __device__ __forceinline__ void aoff(const Unit&, int R0, int C0, unsigned (&off)[4]) const { aoff_lin(R0, C0, D * 2, off); }
    __device__ __forceinline__ int epi(const AccT& acc, const Unit& u, int wr, int wc, int fr, int fq) const {
        const int pm = u.p0, pn = u.p1, s = pn >> 1;
        const int row0 = pm * 256 + wr * 64 + fr;
        const int o0 = (pn & 1) * 256 + wc * 32 + 8 * fq;
        const int dbase = (s & 3) * 1024 + (s >> 2) * 512;
        bf16_t* obase = qkvg + (size_t)row0 * INW + dbase;
        if (s == 4 || s == 5) {
            const int d0 = 4 * ((o0 & 127) >> 3);
            const float qs = (s == 5) ? 0.08838834764831845f : 1.0f;
#pragma unroll
            for (int ah = 0; ah < 2; ++ah) {
                f32x4 rc[4][2];
#pragma unroll
                for (int m = 0; m < 4; ++m) { const f32x4* rp = (const f32x4*)(rope + (size_t)(row0 + ah * 128 + m * 16) * 64 + d0); rc[m][0] = rp[0]; rc[m][1] = rp[1]; }
#pragma unroll
                for (int m = 0; m < 4; ++m) {
                    const f32x4 cs = {rc[m][0].x * qs, rc[m][0].z * qs, rc[m][1].x * qs, rc[m][1].z * qs}, sn = {rc[m][0].y * qs, rc[m][0].w * qs, rc[m][1].y * qs, rc[m][1].w * qs};
                    bf16_t* orow = obase + (size_t)(ah * 128 + m * 16) * INW;
#pragma unroll
                    for (int bj = 0; bj < 2; ++bj) {
                        const int hd = (o0 + bj * 128) & ~127;
                        const f32x4 v0 = acc[ah][bj][m][0], v1 = acc[ah][bj][m][1];
                        const f32x4 o1 = v0 * cs - v1 * sn, o2 = v0 * sn + v1 * cs;
                        *(u32x2*)(orow + hd + d0) = (u32x2){cvt_pk_bf16(o1.x, o1.y), cvt_pk_bf16(o1.z, o1.w)};
                        *(u32x2*)(orow + hd + d0 + 64) = (u32x2){cvt_pk_bf16(o2.x, o2.y), cvt_pk_bf16(o2.z, o2.w)};
                    }
                }
            }
        } else if (s == 1) {
            f32x4 l[2][2];
#pragma unroll
            for (int bj = 0; bj < 2; ++bj) { l[bj][0] = *(const f32x4*)(lb + o0 + bj * 128); l[bj][1] = *(const f32x4*)(lb + o0 + bj * 128 + 4); }
#pragma unroll
            for (int am = 0; am < 8; ++am) {
                const size_t ro = (size_t)((am >> 2) * 128 + (am & 3) * 16);
#pragma unroll
                for (int bj = 0; bj < 2; ++bj) {
                    const int o = o0 + bj * 128;
                    f32x4 v0 = acc[am >> 2][bj][am & 3][0], v1 = acc[am >> 2][bj][am & 3][1], g0, g1;
#pragma unroll
                    for (int j = 0; j < 4; ++j) {
                        const float f0 = l[bj][0][j] + (1.0f - l[bj][0][j]) * sigmoidf_(v0[j]), f1 = l[bj][1][j] + (1.0f - l[bj][1][j]) * sigmoidf_(v1[j]);
                        g0[j] = __logf(f0); g1[j] = __logf(f1); v0[j] = 1.0f - f0; v1[j] = 1.0f - f1; }
                    *(h16x8*)(gbuf + ((size_t)row0 + ro) * 512 + o) = (h16x8){(_Float16)g0[0], (_Float16)g0[1], (_Float16)g0[2], (_Float16)g0[3], (_Float16)g1[0], (_Float16)g1[1], (_Float16)g1[2], (_Float16)g1[3]};
                    u32x4 w; w.x = cvt_pk_bf16(v0[0], v0[1]); w.y = cvt_pk_bf16(v0[2], v0[3]); w.z = cvt_pk_bf16(v1[0], v1[1]); w.w = cvt_pk_bf16(v1[2], v1[3]);
                    *(u32x4*)(obase + ro * INW + o) = w;
                }
            }
        } else {
            const bool act = (s == 0 || s == 3 || s == 7);
#pragma unroll
            for (int am = 0; am < 8; ++am) {
                const size_t ro = (size_t)((am >> 2) * 128 + (am & 3) * 16);
#pragma unroll
                for (int bj = 0; bj < 2; ++bj) {
                    f32x4 v0 = acc[am >> 2][bj][am & 3][0], v1 = acc[am >> 2][bj][am & 3][1];
                    if (act) {
#pragma unroll
                        for (int j = 0; j < 4; ++j) { v0[j] = siluf_(v0[j]); v1[j] = siluf_(v1[j]); }
                    }
                    u32x4 w; w.x = cvt_pk_bf16(v0[0], v0[1]); w.y = cvt_pk_bf16(v0[2], v0[3]); w.z = cvt_pk_bf16(v1[0], v1[1]); w.w = cvt_pk_bf16(v1[2], v1[3]);
                    *(u32x4*)(obase + ro * INW + o0 + bj * 128) = w;
                }
            }
        }
            return -1;
    }
};

template <bool R16>
struct PolRes : GemmBase {
    static constexpr int KREP = KREP_RES;
    const bf16_t* A; const bf16_t* Bt; const float* resid; const bf16_t* resid16; bf16_t* outp; const float* gate; const float* bias; const float* scale;
    int K, lda, nN, kcol;
    __device__ __forceinline__ int nt() const { return K / 64; }
    __device__ __forceinline__ unsigned ldb_bytes() const { return (unsigned)K * 2u; }
    __device__ __forceinline__ bool next(int i, Unit& u) const {
        const int V = i * G + vcu; if (V >= 64 * nN) return false;
        u.p0 = V / nN; u.p1 = V % nN; u.A = (const char*)(A + (size_t)u.p0 * 256 * lda + (size_t)u.p1 * kcol); u.B = (const char*)(Bt + (size_t)u.p1 * 256 * K); return true; }
    __device__ __forceinline__ void aoff(const Unit&, int R0, int C0, unsigned (&off)[4]) const { aoff_lin(R0, C0, (unsigned)lda * 2u, off); }
    __device__ __forceinline__ int epi(const AccT& acc, const Unit& u, int wr, int wc, int fr, int fq) const {
        const int row0 = u.p0 * 256 + wr * 64 + fr, col0 = u.p1 * 256 + wc * 32 + 8 * fq;
#pragma unroll
        for (int bj = 0; bj < 2; ++bj) {
            const int c = col0 + bj * 128;
            const f32x4 g0 = *(const f32x4*)(gate + c), g1 = *(const f32x4*)(gate + c + 4);
            f32x4 b0 = {0.f, 0.f, 0.f, 0.f}, b1 = b0, s0 = {1.f, 1.f, 1.f, 1.f}, s1 = s0;
            if (bias) { b0 = *(const f32x4*)(bias + c); b1 = *(const f32x4*)(bias + c + 4); s0 = *(const f32x4*)(scale + c); s1 = *(const f32x4*)(scale + c + 4); }
#pragma unroll
            for (int ah = 0; ah < 2; ++ah) {
                f32x4 r[4][2];
                if constexpr (!R16) {
#pragma unroll
                    for (int m = 0; m < 4; ++m) { const size_t idx = (size_t)(row0 + ah * 128 + m * 16) * D + c; r[m][0] = *(const f32x4*)(resid + idx); r[m][1] = *(const f32x4*)(resid + idx + 4); }
                } else {
                    u32x4 q[4];
#pragma unroll
                    for (int m = 0; m < 4; ++m) q[m] = *(const u32x4*)(resid16 + (size_t)(row0 + ah * 128 + m * 16) * D + c);
#pragma unroll
                    for (int m = 0; m < 4; ++m) { r[m][0] = (f32x4){bflo(q[m].x), bfhi(q[m].x), bflo(q[m].y), bfhi(q[m].y)}; r[m][1] = (f32x4){bflo(q[m].z), bfhi(q[m].z), bflo(q[m].w), bfhi(q[m].w)}; }
                }
#pragma unroll
                for (int m = 0; m < 4; ++m) {
                    const size_t idx = (size_t)(row0 + ah * 128 + m * 16) * D + c;
                    const f32x4 o0 = r[m][0] + g0 * ((acc[ah][bj][m][0] + b0) * s0), o1 = r[m][1] + g1 * ((acc[ah][bj][m][1] + b1) * s1);
                    *(u32x4*)(outp + idx) = (u32x4){cvt_pk_bf16(o0.x, o0.y), cvt_pk_bf16(o0.z, o0.w), cvt_pk_bf16(o1.x, o1.y), cvt_pk_bf16(o1.z, o1.w)};
                }
            }
        }
            return -1;
    }
};

constexpr int MI_TPRE = 16, MI_CNT = 64, MI_MT2E = 128;
__device__ __forceinline__ void expert_tables(Frame& F, int layer) {
    if (F.tid < 64) {
        const int lane = F.lane;
        int c = 0;
        if (lane < NE) { c = (int)__hip_atomic_load(F.ctl + CW_CNT + 64 * layer + lane, __ATOMIC_RELAXED, __HIP_MEMORY_SCOPE_AGENT); if (c > LIST_CAP) c = LIST_CAP; }
        const int nt_ = (c + 255) >> 8;
        int pre = nt_;
#pragma unroll
        for (int off = 1; off < 32; off <<= 1) { const int v = __shfl_up(pre, off); if (lane >= off) pre += v; }
        const int excl = pre - nt_;
        if (lane < NE) { F.MISC[MI_TPRE + lane] = excl; F.MISC[MI_CNT + lane] = c; for (int q = 0; q < nt_; ++q) F.MISC[MI_MT2E + excl + q] = lane; }
        if (lane == NE - 1) F.MISC[MI_TPRE + NE] = pre;
    }
    __syncthreads();
}
constexpr int UPA_OFF = 131072;
struct PolG1 : GemmBase {
    static constexpr int KREP = KREP_G1;
    volatile LAS unsigned* MISC; LAS unsigned char* upa; const bf16_t* hn; const bf16_t* wgut; const float* bgu; const int* lslot; bf16_t* act;
    __device__ __forceinline__ int nt() const { return D / 64; }
    __device__ __forceinline__ unsigned ldb_bytes() const { return D * 2; }
    __device__ __forceinline__ bool next(int i, Unit& u) const {
        const int V = i * G + vcu, MT = (int)MISC[MI_TPRE + NE]; if (V >= MT * 8 || i >= 10) return false;
        const int mt = V >> 3, nt_ = V & 7, e = (int)MISC[MI_MT2E + mt];
        u.p0 = e; u.p1 = mt - (int)MISC[MI_TPRE + e]; u.p2 = nt_; u.p3 = mt; u.ui = i;
        u.A = (const char*)hn; u.B = (const char*)(wgut + ((size_t)e * 2048 + (size_t)nt_ * 256) * D); return true; }
    __device__ __forceinline__ void fill(int tid) const {
#pragma unroll
        for (int k = 0; k < 5; ++k) {
            const int j = tid + NTH * k, i = j >> 8, r = j & 255; Unit u;
            if (next(i, u)) {
                const int cnt = (int)MISC[MI_CNT + u.p0], li = u.p1 * 256 + r;
                ((LAS int*)(upa + i * 2048))[r] = (li < cnt) ? (lslot[(size_t)u.p0 * LIST_CAP + li] >> 2) : 0;
                ((LAS float*)(upa + i * 2048 + 1024))[r] = bgu[(size_t)u.p0 * 2048 + (r >> 7) * 1024 + u.p2 * 128 + (r & 127)];
            }
        }
    }
    __device__ __forceinline__ void aoff(const Unit& u, int R0, int C0, unsigned (&off)[4]) const {
        const LAS int* tk = (const LAS int*)(upa + u.ui * 2048);
#pragma unroll
        for (int q = 0; q < 4; ++q) off[q] = (unsigned)tk[R0 + 64 * (q & 1) + 128 * (q >> 1)] * (D * 2u) + (unsigned)C0 * 2u;
    }
    __device__ __forceinline__ int epi(const AccT& acc, const Unit& u, int wr, int wc, int fr, int fq) const {
        const int cl = wc * 32 + 8 * fq;
        const LAS float* bg = (const LAS float*)(upa + u.ui * 2048 + 1024);
        const f32x4 bgl0 = *(const LAS f32x4*)(bg + cl), bgl1 = *(const LAS f32x4*)(bg + cl + 4), bln0 = *(const LAS f32x4*)(bg + 128 + cl), bln1 = *(const LAS f32x4*)(bg + 128 + cl + 4);
        bf16_t* base = act + ((size_t)u.p3 * 256 + wr * 64 + fr) * D + u.p2 * 128 + cl;
#pragma unroll
        for (int ai = 0; ai < 2; ++ai)
#pragma unroll
            for (int m = 0; m < 4; ++m) {
                f32x4 gl0 = acc[ai][0][m][0] + bgl0, gl1 = acc[ai][0][m][1] + bgl1, ln0 = acc[ai][1][m][0] + bln0, ln1 = acc[ai][1][m][1] + bln1;
                f32x4 a0, a1;
#pragma unroll
                for (int j = 0; j < 4; ++j) {
                    const float x0 = fminf(gl0[j], SW_LIMIT), x1 = fminf(gl1[j], SW_LIMIT);
                    const float y0 = fminf(fmaxf(ln0[j], -SW_LIMIT), SW_LIMIT), y1 = fminf(fmaxf(ln1[j], -SW_LIMIT), SW_LIMIT);
                    a0[j] = x0 * sigmoidf_(SW_ALPHA * x0) * (y0 + 1.0f); a1[j] = x1 * sigmoidf_(SW_ALPHA * x1) * (y1 + 1.0f); }
                u32x4 w; w.x = cvt_pk_bf16(a0[0], a0[1]); w.y = cvt_pk_bf16(a0[2], a0[3]); w.z = cvt_pk_bf16(a1[0], a1[1]); w.w = cvt_pk_bf16(a1[2], a1[3]);
                *(u32x4*)(base + (size_t)(ai * 128 + m * 16) * D) = w;
            }
            return -1;
    }
};
struct PolG2 : GemmBase {
    static constexpr int KREP = KREP_G2;
    volatile LAS unsigned* MISC; LAS unsigned char* upa; const bf16_t* act; const bf16_t* wdnt; const float* bdn; const int* lslot; const float* lw; bf16_t* yslot;
    __device__ __forceinline__ int nt() const { return D / 64; }
    __device__ __forceinline__ unsigned ldb_bytes() const { return D * 2; }
    __device__ __forceinline__ bool next(int i, Unit& u) const {
        const int V = i * G + vcu, MT = (int)MISC[MI_TPRE + NE]; if (V >= MT * 4 || i >= 6) return false;
        const int mt = V >> 2, nt_ = V & 3, e = (int)MISC[MI_MT2E + mt];
        u.p0 = e; u.p1 = mt - (int)MISC[MI_TPRE + e]; u.p2 = nt_; u.p3 = mt; u.ui = i;
        u.A = (const char*)(act + (size_t)mt * 256 * D); u.B = (const char*)(wdnt + ((size_t)e * D + (size_t)nt_ * 256) * D); return true; }
    __device__ __forceinline__ void fill(int tid) const {
#pragma unroll
        for (int k = 0; k < 3; ++k) {
            const int j = tid + NTH * k, i = j >> 8, r = j & 255; Unit u;
            if (next(i, u)) {
                const int cnt = (int)MISC[MI_CNT + u.p0], li = u.p1 * 256 + r; const bool ok = li < cnt;
                ((LAS int*)(upa + i * 3072))[r] = ok ? lslot[(size_t)u.p0 * LIST_CAP + li] : -1;
                ((LAS float*)(upa + i * 3072 + 1024))[r] = ok ? lw[(size_t)u.p0 * LIST_CAP + li] : 0.f;
                ((LAS float*)(upa + i * 3072 + 2048))[r] = bdn[(size_t)u.p0 * D + u.p2 * 256 + r];
            }
        }
    }
    __device__ __forceinline__ void aoff(const Unit&, int R0, int C0, unsigned (&off)[4]) const { aoff_lin(R0, C0, D * 2, off); }
    __device__ __forceinline__ int epi(const AccT& acc, const Unit& u, int wr, int wc, int fr, int fq) const {
        const int cl = wc * 32 + 8 * fq;
        const LAS int* sl = (const LAS int*)(upa + u.ui * 3072); const LAS float* wl = (const LAS float*)(upa + u.ui * 3072 + 1024); const LAS float* bd = (const LAS float*)(upa + u.ui * 3072 + 2048);
        f32x4 b[2][2];
#pragma unroll
        for (int bj = 0; bj < 2; ++bj) { b[bj][0] = *(const LAS f32x4*)(bd + cl + bj * 128); b[bj][1] = *(const LAS f32x4*)(bd + cl + bj * 128 + 4); }
#pragma unroll
        for (int ai = 0; ai < 2; ++ai)
#pragma unroll
            for (int m = 0; m < 4; ++m) {
                const int rl = ai * 128 + wr * 64 + m * 16 + fr;
                const int slot = sl[rl]; const float w = wl[rl];
                if (slot >= 0) {
                    bf16_t* yr = yslot + (size_t)slot * D + u.p2 * 256 + cl;
#pragma unroll
                    for (int bj = 0; bj < 2; ++bj) {
                        const f32x4 v0 = (acc[ai][bj][m][0] + b[bj][0]) * w, v1 = (acc[ai][bj][m][1] + b[bj][1]) * w;
                        u32x4 o; o.x = cvt_pk_bf16(v0[0], v0[1]); o.y = cvt_pk_bf16(v0[2], v0[3]); o.z = cvt_pk_bf16(v1[0], v1[1]); o.w = cvt_pk_bf16(v1[2], v1[3]);
                        *(u32x4*)(yr + bj * 128) = o;
                    }
                }
            }
            return -1;
    }
};

typedef unsigned v4u_t __attribute__((ext_vector_type(4)));
template <bool F8>
struct PolMoE : GemmBase {
    static constexpr int KREP = 1;
    static constexpr bool HAS_READY = true;
    static constexpr bool FP8 = F8;
    static constexpr bool SEAM_OPT = true;
    static constexpr int EB = F8 ? 1 : 2;
    volatile LAS unsigned* MISC; LAS unsigned char* upa; const bf16_t* hn; const bf16_t* wgut; const float* bgu; const int* lslot; const float* lw; bf16_t* act;
    const bf16_t* wdnt; const float* bdn; bf16_t* yslot; unsigned* done; unsigned* tmo; __amdgpu_buffer_rsrc_t act_rsrc;
    __device__ __forceinline__ int nt() const { return D * EB / 128; }
    __device__ __forceinline__ unsigned ldb_bytes() const { return D * EB; }
    __device__ __forceinline__ bool next(int i, Unit& u) const {
        const int V = i * G + vcu, MT = (int)MISC[MI_TPRE + NE], N1 = MT * 8; if (i >= 14 || V >= MT * 12) return false;
        u.ui = i;
        if (V < N1) { const int mt = V >> 3, nt_ = V & 7, e = (int)MISC[MI_MT2E + mt];
            u.p0 = e; u.p1 = mt - (int)MISC[MI_TPRE + e]; u.p2 = nt_; u.p3 = mt;
            u.A = (const char*)hn; u.B = (const char*)wgut + ((size_t)e * 2048 + (size_t)nt_ * 256) * D * EB; }
        else { const int V2 = V - N1, mt = V2 >> 2, nt_ = V2 & 3, e = (int)MISC[MI_MT2E + mt];
            u.p0 = e; u.p1 = mt - (int)MISC[MI_TPRE + e]; u.p2 = nt_ | 8; u.p3 = mt;
            u.A = (const char*)act + (size_t)mt * 256 * D * EB; u.B = (const char*)wdnt + ((size_t)e * D + (size_t)nt_ * 256) * D * EB; }
        return true; }
    __device__ __forceinline__ void fill(int tid) const {
#pragma unroll
        for (int k = 0; k < 7; ++k) {
            const int j = tid + NTH * k, i = j >> 8, r = j & 255; Unit u;
            if (next(i, u)) {
                const int cnt = (int)MISC[MI_CNT + u.p0], li = u.p1 * 256 + r; const bool ok = li < cnt;
                if (!(u.p2 & 8)) {
                    ((LAS int*)(upa + i * 2048))[r] = ok ? (lslot[(size_t)u.p0 * LIST_CAP + li] >> 2) : 0;
                    ((LAS float*)(upa + i * 2048 + 1024))[r] = bgu[(size_t)u.p0 * 2048 + (r >> 7) * 1024 + u.p2 * 128 + (r & 127)];
                } else {
                    unsigned pk = 0xffff0000u;
                    if (ok) { const unsigned sl = (unsigned)lslot[(size_t)u.p0 * LIST_CAP + li]; const float w = lw[(size_t)u.p0 * LIST_CAP + li]; pk = (sl & 0xffffu) | (cvt_pk_bf16(0.f, w) & 0xffff0000u); }
                    ((LAS unsigned*)(upa + i * 2048))[r] = pk;
                    ((LAS float*)(upa + i * 2048 + 1024))[r] = bdn[(size_t)u.p0 * D + (u.p2 & 7) * 256 + r];
                }
            }
        }
    }
    __device__ __forceinline__ void aoff(const Unit& u, int R0, int C0, unsigned (&off)[4]) const {
        if (!(u.p2 & 8)) { const LAS int* tk = (const LAS int*)(upa + u.ui * 2048);
#pragma unroll
            for (int q = 0; q < 4; ++q) off[q] = (unsigned)tk[R0 + 64 * (q & 1) + 128 * (q >> 1)] * (unsigned)(D * EB) + (unsigned)C0 * 2u;
        } else aoff_lin(R0, C0, D * EB, off);
    }
    __device__ __forceinline__ void flush(int pend) const {
        if (pend >= 0 && (threadIdx.x & 63) == 0) (void)__hip_atomic_fetch_add(done + 64 * pend, 1u, __ATOMIC_RELAXED, __HIP_MEMORY_SCOPE_AGENT);
    }
    __device__ __forceinline__ void a_ready(const Unit& u) const {
        if (!(u.p2 & 8)) return;
        if (threadIdx.x < 64) {
            unsigned* w = done + 64 * u.p3; unsigned polls = 0;
            while ((unsigned)__builtin_amdgcn_readfirstlane(__hip_atomic_load(w, __ATOMIC_RELAXED, __HIP_MEMORY_SCOPE_AGENT)) < 64u) {
                __builtin_amdgcn_s_sleep(2);
                if ((++polls & 1023u) == 0u) { if (__builtin_amdgcn_readfirstlane(__hip_atomic_load(tmo, __ATOMIC_RELAXED, __HIP_MEMORY_SCOPE_AGENT)) != 0u) break;
                    if (polls > (1u << 22)) { if (threadIdx.x == 0) __hip_atomic_store(tmo, 1u, __ATOMIC_RELAXED, __HIP_MEMORY_SCOPE_AGENT); break; } }
            }
            __builtin_amdgcn_fence(__ATOMIC_ACQUIRE, "agent");
            asm volatile("s_waitcnt vmcnt(0)" ::: "memory");
        }
        asm volatile("" ::: "memory"); __builtin_amdgcn_s_barrier(); asm volatile("" ::: "memory");
    }
    __device__ __forceinline__ int epi(const AccT& acc, const Unit& u, int wr, int wc, int fr, int fq) const {
        const int cl = wc * 32 + 8 * fq;
        if (!(u.p2 & 8)) {
            const LAS float* bg = (const LAS float*)(upa + u.ui * 2048 + 1024);
            const f32x4 bgl0 = *(const LAS f32x4*)(bg + cl), bgl1 = *(const LAS f32x4*)(bg + cl + 4), bln0 = *(const LAS f32x4*)(bg + 128 + cl), bln1 = *(const LAS f32x4*)(bg + 128 + cl + 4);
            const unsigned boff = (unsigned)((((size_t)u.p3 * 256 + wr * 64 + fr) * D + u.p2 * 128 + cl) * EB);
            constexpr float ws = F8 ? (1.0f / W8_SCALE) : 1.0f;
#pragma unroll
            for (int ai = 0; ai < 2; ++ai)
#pragma unroll
                for (int m = 0; m < 4; ++m) {
                    f32x4 gl0 = acc[ai][0][m][0] * ws + bgl0, gl1 = acc[ai][0][m][1] * ws + bgl1, ln0 = acc[ai][1][m][0] * ws + bln0, ln1 = acc[ai][1][m][1] * ws + bln1;
                    f32x4 a0, a1;
#pragma unroll
                    for (int j = 0; j < 4; ++j) {
                        const float x0 = fminf(gl0[j], SW_LIMIT), x1 = fminf(gl1[j], SW_LIMIT);
                        const float y0 = fminf(fmaxf(ln0[j], -SW_LIMIT), SW_LIMIT), y1 = fminf(fmaxf(ln1[j], -SW_LIMIT), SW_LIMIT);
                        a0[j] = x0 * sigmoidf_(SW_ALPHA * x0) * (y0 + 1.0f); a1[j] = x1 * sigmoidf_(SW_ALPHA * x1) * (y1 + 1.0f); }
                    if constexpr (F8) { u32x2 w8 = {pack_fp8x4(a0[0], a0[1], a0[2], a0[3]), pack_fp8x4(a1[0], a1[1], a1[2], a1[3])};
                        __builtin_amdgcn_raw_buffer_store_b64(w8, act_rsrc, boff + (unsigned)((ai * 128 + m * 16) * D), 0,   16); }
                    else { v4u_t w; w.x = cvt_pk_bf16(a0[0], a0[1]); w.y = cvt_pk_bf16(a0[2], a0[3]); w.z = cvt_pk_bf16(a1[0], a1[1]); w.w = cvt_pk_bf16(a1[2], a1[3]);
                        __builtin_amdgcn_raw_buffer_store_b128(w, act_rsrc, boff + (unsigned)((ai * 128 + m * 16) * D * 2), 0,   16); }
                }
            return u.p3;
        } else {
            const LAS unsigned* sl = (const LAS unsigned*)(upa + u.ui * 2048); const LAS float* bd = (const LAS float*)(upa + u.ui * 2048 + 1024);
            f32x4 b[2][2];
#pragma unroll
            for (int bj = 0; bj < 2; ++bj) { b[bj][0] = *(const LAS f32x4*)(bd + cl + bj * 128); b[bj][1] = *(const LAS f32x4*)(bd + cl + bj * 128 + 4); }
#pragma unroll
            for (int ai = 0; ai < 2; ++ai)
#pragma unroll
                for (int m = 0; m < 4; ++m) {
                    const unsigned pk = sl[ai * 128 + wr * 64 + m * 16 + fr];
                    if ((pk >> 16) != 0xffffu) {
                        const float w = bfhi(pk); constexpr float ws = F8 ? (1.0f / W8_SCALE) : 1.0f;
                        bf16_t* yr = yslot + (size_t)(pk & 0xffffu) * D + (u.p2 & 7) * 256 + cl;
#pragma unroll
                        for (int bj = 0; bj < 2; ++bj) {
                            const f32x4 v0 = (acc[ai][bj][m][0] * ws + b[bj][0]) * w, v1 = (acc[ai][bj][m][1] * ws + b[bj][1]) * w;
                            u32x4 o; o.x = cvt_pk_bf16(v0[0], v0[1]); o.y = cvt_pk_bf16(v0[2], v0[3]); o.z = cvt_pk_bf16(v1[0], v1[1]); o.w = cvt_pk_bf16(v1[2], v1[3]);
                            *(u32x4*)(yr + bj * 128) = o;
                        }
                    }
                }
        }
            return -1;
    }
};

template <class P> __device__ __forceinline__ void run_gemm(Frame& F, const P& S) {
#if SIMPLE_GEMM
    pg8::gemm_simple<P>(F.lds, S);
#else
    pg8::gemm_pipe<P>(F.lds, S);
#endif
}

constexpr int LA_QA = 0, LA_QH = 17408, LA_KA = 34816, LA_VT = 52224, LA_AS = 70656, LA_ST = 79872, LA_QS = 114688, LA_PS = 118784;
constexpr int RS128 = 272, RS64 = 144;
__device__ __forceinline__ float ret_lg(int hh) { return __logf(1.0f - exp2f(-5.0f - (float)(hh - 4))); }
__device__ __forceinline__ u32x4 pack8(const float (&v)[8]) { return (u32x4){cvt_pk_bf16(v[0], v[1]), cvt_pk_bf16(v[2], v[3]), cvt_pk_bf16(v[4], v[5]), cvt_pk_bf16(v[6], v[7])}; }

__device__ __forceinline__ void la_cumsum(const float* gbuf, int hh, int t0, int d0, float (&b0)[8], float (&b1)[8]) {
    if (hh < 4) { float r0 = 0.f, r1 = 0.f;
#pragma unroll
        for (int i = 0; i < 8; ++i) { const f32x2 g = *(const f32x2*)(gbuf + (size_t)(t0 + i) * 512 + hh * 128 + d0); r0 += g.x; r1 += g.y; b0[i] = r0; b1[i] = r1; }
    } else { const float lg = ret_lg(hh);
#pragma unroll
        for (int i = 0; i < 8; ++i) { b0[i] = (float)(i + 1) * lg; b1[i] = b0[i]; }
    }
}

struct LaIn { f32x2 g[8]; unsigned qq[8], kk[8], vv[8]; u32x4 st[4]; u32x2 gt[4]; };
template <bool OUT>
__device__ __forceinline__ void la_load(LaIn& in, const bf16_t* qkvg, const _Float16* gbuf, const bf16_t* sprev, int unit, int oc, int d0, int tid) {
    const int hh = unit >> 8, n = unit & 255, t0 = n * 64 + oc * 8;
    if (hh < 4) {
#pragma unroll
        for (int i = 0; i < 8; ++i) { const h16x2 gh = *(const h16x2*)(gbuf + (size_t)(t0 + i) * 512 + hh * 128 + d0); in.g[i] = (f32x2){(float)gh.x, (float)gh.y}; }
    }
#pragma unroll
    for (int i = 0; i < 8; ++i) { const bf16_t* row = qkvg + (size_t)(t0 + i) * INW + hh * 128 + d0; if (OUT) in.qq[i] = *(const unsigned*)row; in.kk[i] = *(const unsigned*)(row + 1024); in.vv[i] = *(const unsigned*)(row + 2048); }
    if (OUT) {
        const bf16_t* sp = sprev + ((size_t)hh * 256 + n) * 16384;
#pragma unroll
        for (int j = 0; j < 4; ++j) { const int c = tid + NTH * j; in.st[j] = *(const u32x4*)(sp + (c >> 4) * 128 + (c & 15) * 8); }
        const int lane = tid & 63, fr = lane & 15, fq = lane >> 4, tt = oc >> 1, eh = oc & 1;
#pragma unroll
        for (int ei = 0; ei < 4; ++ei) in.gt[ei] = *(const u32x2*)(qkvg + (size_t)(n * 64 + 16 * tt + fr) * INW + 3072 + hh * 128 + 16 * (4 * eh + ei) + 4 * fq);
    }
}
__device__ __forceinline__ void la_cumsum_in(const LaIn& in, int hh, float (&b0)[8], float (&b1)[8]) {
    if (hh < 4) { float r0 = 0.f, r1 = 0.f;
#pragma unroll
        for (int i = 0; i < 8; ++i) { r0 += in.g[i].x; r1 += in.g[i].y; b0[i] = r0; b1[i] = r1; }
    } else { const float lg = ret_lg(hh);
#pragma unroll
        for (int i = 0; i < 8; ++i) { b0[i] = (float)(i + 1) * lg; b1[i] = b0[i]; }
    }
}

__device__ __forceinline__ void la_local_state(Frame& F) {
    const bf16_t* qkvg = WSP(F, WS_QKVG, bf16_t); const _Float16* gbuf = WSP(F, WS_GBUF, _Float16); bf16_t* kvt = WSP(F, WS_KVT, bf16_t); float* dec = WSP(F, WS_DEC, float);
    LAS unsigned char* lds = F.lds; LAS float* qs = (LAS float*)(lds + LA_QS);
    const int lane = F.lane, oc = F.wave, d0 = 2 * lane, fr = lane & 15, fq = lane >> 4;
    LaIn nx;
    if (F.vcu < 2048) la_load<false>(nx, qkvg, gbuf, nullptr, F.vcu, oc, d0, F.tid);
    for (int unit = F.vcu; unit < 2048; unit += F.G) {
        const int hh = unit >> 8, n = unit & 255;
        const LaIn in = nx;
        if (unit + F.G < 2048) la_load<false>(nx, qkvg, gbuf, nullptr, unit + F.G, oc, d0, F.tid);
        float b0[8], b1[8]; la_cumsum_in(in, hh, b0, b1);
        *(LAS f32x2*)(qs + oc * 128 + d0) = (f32x2){b0[7], b1[7]};
        const unsigned (&kk)[8] = in.kk; const unsigned (&vv)[8] = in.vv;
        __syncthreads();
        float base0 = 0.f, base1 = 0.f, tot0 = 0.f, tot1 = 0.f;
#pragma unroll
        for (int o = 0; o < 8; ++o) { const f32x2 q = *(const LAS f32x2*)(qs + o * 128 + d0); if (o < oc) { base0 += q.x; base1 += q.y; } tot0 += q.x; tot1 += q.y; }
        float a0[8], a1[8], c0[8], c1[8];
#pragma unroll
        for (int i = 0; i < 8; ++i) { a0[i] = bflo(kk[i]) * __expf(tot0 - base0 - b0[i]); a1[i] = bfhi(kk[i]) * __expf(tot1 - base1 - b1[i]); c0[i] = bflo(vv[i]); c1[i] = bfhi(vv[i]); }
        *(LAS u32x4*)(lds + LA_QA + d0 * RS64 + oc * 16) = pack8(a0); *(LAS u32x4*)(lds + LA_QA + (d0 + 1) * RS64 + oc * 16) = pack8(a1);
        *(LAS u32x4*)(lds + LA_VT + d0 * RS64 + oc * 16) = pack8(c0); *(LAS u32x4*)(lds + LA_VT + (d0 + 1) * RS64 + oc * 16) = pack8(c1);
        if (oc == 0) *(f32x2*)(dec + ((size_t)hh * 256 + n) * 128 + d0) = (f32x2){__expf(tot0), __expf(tot1)};
        __syncthreads();
        const int et = oc;
        bf16x8 vt[2];
#pragma unroll
        for (int ks = 0; ks < 2; ++ks) vt[ks] = *(const LAS bf16x8*)(lds + LA_VT + (16 * et + fr) * RS64 + (32 * ks + 8 * fq) * 2);
        bf16_t* orow = kvt + (((size_t)hh * 256 + n) * 128 + 16 * et + fr) * 128 + 4 * fq;
#pragma unroll
        for (int dt = 0; dt < 8; ++dt) {
            f32x4 acc = {0.f, 0.f, 0.f, 0.f};
#pragma unroll
            for (int ks = 0; ks < 2; ++ks) { const bf16x8 a = *(const LAS bf16x8*)(lds + LA_QA + (16 * dt + fr) * RS64 + (32 * ks + 8 * fq) * 2); acc = __builtin_amdgcn_mfma_f32_16x16x32_bf16(a, vt[ks], acc, 0, 0, 0); }
            *(u32x2*)(orow + 16 * dt) = (u32x2){cvt_pk_bf16(acc[0], acc[1]), cvt_pk_bf16(acc[2], acc[3])};
        }
        __syncthreads();
    }
}

__device__ __forceinline__ void la_scan(Frame& F) {
    const bf16_t* kvt = WSP(F, WS_KVT, bf16_t); const float* dec = WSP(F, WS_DEC, float); bf16_t* sprev = WSP(F, WS_SPREV, bf16_t);
    for (int idx = F.vcu * NTH + F.tid; idx < 8 * 16384; idx += F.G * NTH) {
        const int hh = idx >> 14, rem = idx & 16383, d = rem & 127;
        const bf16_t* kv = kvt + (size_t)hh * 256 * 16384 + rem; const float* dc = dec + (size_t)hh * 256 * 128 + d; bf16_t* sp = sprev + (size_t)hh * 256 * 16384 + rem;
        float S = 0.f;
        for (int n0 = 0; n0 < 256; n0 += 16) {
            float kvv[16], dd[16];
#pragma unroll
            for (int i = 0; i < 16; ++i) { kvv[i] = bf2f(kv[(size_t)(n0 + i) * 16384]); dd[i] = dc[(n0 + i) * 128]; }
#pragma unroll
            for (int i = 0; i < 16; ++i) { sp[(size_t)(n0 + i) * 16384] = (bf16_t)(cvt_pk_bf16(S, 0.f) & 0xffffu); S = dd[i] * S + kvv[i]; }
        }
    }
}

__device__ __forceinline__ void la_output(Frame& F) {
    const bf16_t* qkvg = WSP(F, WS_QKVG, bf16_t); const _Float16* gbuf = WSP(F, WS_GBUF, _Float16); const bf16_t* sprev = WSP(F, WS_SPREV, bf16_t); bf16_t* cat = WSP(F, WS_CAT, bf16_t);
    LAS unsigned char* lds = F.lds; LAS float* qs = (LAS float*)(lds + LA_QS); LAS float* ps = (LAS float*)(lds + LA_PS);
    const int tid = F.tid, lane = F.lane, oc = F.wave, d0 = 2 * lane, fr = lane & 15, fq = lane >> 4;
    LaIn nx;
    if (F.vcu < 2048) la_load<true>(nx, qkvg, gbuf, sprev, F.vcu, oc, d0, tid);
    for (int unit = F.vcu; unit < 2048; unit += F.G) {
        const int hh = unit >> 8, n = unit & 255;
        const LaIn in = nx;
        if (unit + F.G < 2048) la_load<true>(nx, qkvg, gbuf, sprev, unit + F.G, oc, d0, tid);
        float b0[8], b1[8]; la_cumsum_in(in, hh, b0, b1);
        *(LAS f32x2*)(qs + oc * 128 + d0) = (f32x2){b0[7], b1[7]};
        const unsigned (&qq)[8] = in.qq; const unsigned (&kk)[8] = in.kk; const unsigned (&vv)[8] = in.vv;
#pragma unroll
        for (int j = 0; j < 4; ++j) { const int c = tid + NTH * j; *(LAS u32x4*)(lds + LA_ST + (c >> 4) * RS128 + (c & 15) * 16) = in.st[j]; }
        __syncthreads();
        float base0 = 0.f, base1 = 0.f, bm0 = 0.f, bm1 = 0.f;
#pragma unroll
        for (int o = 0; o < 8; ++o) { const f32x2 q = *(const LAS f32x2*)(qs + o * 128 + d0); if (o < oc) { base0 += q.x; base1 += q.y; } if (o < 4) { bm0 += q.x; bm1 += q.y; } }
        float c0[8], c1[8];
#pragma unroll
        for (int i = 0; i < 8; ++i) {
            const int t = 8 * oc + i; const float bt0 = base0 + b0[i], bt1 = base1 + b1[i];
            const float q0 = bflo(qq[i]), q1 = bfhi(qq[i]), k0 = bflo(kk[i]), k1 = bfhi(kk[i]);
            *(LAS unsigned*)(lds + LA_QA + t * RS128 + d0 * 2) = cvt_pk_bf16(q0 * __expf(bt0 - bm0), q1 * __expf(bt1 - bm1));
            *(LAS unsigned*)(lds + LA_QH + t * RS128 + d0 * 2) = cvt_pk_bf16(q0 * __expf(bt0), q1 * __expf(bt1));
            *(LAS unsigned*)(lds + LA_KA + t * RS128 + d0 * 2) = cvt_pk_bf16(k0 * __expf(bm0 - bt0), k1 * __expf(bm1 - bt1));
            c0[i] = bflo(vv[i]); c1[i] = bfhi(vv[i]);
        }
        *(LAS u32x4*)(lds + LA_VT + d0 * RS64 + oc * 16) = pack8(c0); *(LAS u32x4*)(lds + LA_VT + (d0 + 1) * RS64 + oc * 16) = pack8(c1);
        __syncthreads();
        const int tt = oc >> 1, eh = oc & 1;
        {
            bf16x8 qf[4];
#pragma unroll
            for (int ks = 0; ks < 4; ++ks) qf[ks] = *(const LAS bf16x8*)(lds + LA_QA + (16 * tt + fr) * RS128 + (32 * ks + 8 * fq) * 2);
#pragma unroll
            for (int sti = 0; sti < 2; ++sti) {
                const int st = 2 * eh + sti;
                f32x4 acc = {0.f, 0.f, 0.f, 0.f};
                if (st <= tt) {
#pragma unroll
                    for (int ks = 0; ks < 4; ++ks) { const bf16x8 a = *(const LAS bf16x8*)(lds + LA_KA + (16 * st + fr) * RS128 + (32 * ks + 8 * fq) * 2); acc = __builtin_amdgcn_mfma_f32_16x16x32_bf16(a, qf[ks], acc, 0, 0, 0); }
                    if (st == tt) {
#pragma unroll
                        for (int r = 0; r < 4; ++r) if (4 * fq + r > fr) acc[r] = 0.f;
                    }
                }
                *(LAS u32x2*)(lds + LA_AS + (16 * tt + fr) * RS64 + (16 * st + 4 * fq) * 2) = (u32x2){cvt_pk_bf16(acc[0], acc[1]), cvt_pk_bf16(acc[2], acc[3])};
            }
        }
        __syncthreads();
        f32x4 o[4]; float ss = 0.f;
        {
            bf16x8 af[2], hf[4];
#pragma unroll
            for (int ks = 0; ks < 2; ++ks) af[ks] = *(const LAS bf16x8*)(lds + LA_AS + (16 * tt + fr) * RS64 + (32 * ks + 8 * fq) * 2);
#pragma unroll
            for (int ks = 0; ks < 4; ++ks) hf[ks] = *(const LAS bf16x8*)(lds + LA_QH + (16 * tt + fr) * RS128 + (32 * ks + 8 * fq) * 2);
#pragma unroll
            for (int ei = 0; ei < 4; ++ei) {
                const int et = 4 * eh + ei;
                f32x4 acc = {0.f, 0.f, 0.f, 0.f};
#pragma unroll
                for (int ks = 0; ks < 2; ++ks) { const bf16x8 a = *(const LAS bf16x8*)(lds + LA_VT + (16 * et + fr) * RS64 + (32 * ks + 8 * fq) * 2); acc = __builtin_amdgcn_mfma_f32_16x16x32_bf16(a, af[ks], acc, 0, 0, 0); }
#pragma unroll
                for (int ks = 0; ks < 4; ++ks) { const bf16x8 a = *(const LAS bf16x8*)(lds + LA_ST + (16 * et + fr) * RS128 + (32 * ks + 8 * fq) * 2); acc = __builtin_amdgcn_mfma_f32_16x16x32_bf16(a, hf[ks], acc, 0, 0, 0); }
                o[ei] = acc; ss += (acc[0] * acc[0] + acc[1] * acc[1]) + (acc[2] * acc[2] + acc[3] * acc[3]);
            }
        }
        ss += __shfl_xor(ss, 16); ss += __shfl_xor(ss, 32);
        if (lane < 16) ps[(tt * 2 + eh) * 16 + lane] = ss;
        __syncthreads();
        const float tot = ps[(tt * 2) * 16 + fr] + ps[(tt * 2 + 1) * 16 + fr];
        const float rstd = rsqrtf(tot * (1.f / 128.f) + EPS);
        const float* gain = (hh < 4) ? (inptr(6) + hh * 128) : (inptr(7) + (hh - 4) * 128);
        const size_t rowi = (size_t)(n * 64 + 16 * tt + fr);
#pragma unroll
        for (int ei = 0; ei < 4; ++ei) {
            const int e0 = 16 * (4 * eh + ei) + 4 * fq;
            const f32x4 gn = *(const f32x4*)(gain + e0);
            const u32x2 gt = in.gt[ei];
            const f32x4 v = o[ei] * rstd * gn;
            *(u32x2*)(cat + rowi * D + hh * 128 + e0) = (u32x2){cvt_pk_bf16(v[0] * bflo(gt.x), v[1] * bfhi(gt.x)), cvt_pk_bf16(v[2] * bflo(gt.y), v[3] * bfhi(gt.y))};
        }
        __syncthreads();
    }
}

constexpr int RT_STRIDE = 2064, RT_PART = 32 * RT_STRIDE;
__device__ __forceinline__ void sel4of8(float (&v)[8], const int (&ix)[8], float (&tv)[4], int (&ti)[4]) {
#pragma unroll
    for (int k = 0; k < 4; ++k) {
        float best = v[0]; int bi = ix[0];
#pragma unroll
        for (int q = 1; q < 8; ++q) { const bool better = (v[q] > best) || (v[q] == best && ix[q] < bi); best = better ? v[q] : best; bi = better ? ix[q] : bi; }
        tv[k] = best; ti[k] = bi;
#pragma unroll
        for (int q = 0; q < 8; ++q) v[q] = (ix[q] == bi) ? -INFINITY : v[q];
    }
}
__device__ __forceinline__ void p_route(Frame& F, int layer, const bf16_t* X, int aux = 0) {
    const int tid = F.tid, lane = F.lane;
    LAS unsigned char* lds = F.lds;
    LAS float* ssq = (LAS float*)(lds + 2 * RT_PART);
    LAS f32x4* lgx = (LAS f32x4*)(lds + 2 * RT_PART + 512);
    LAS int* pe = (LAS int*)(lds + 2 * RT_PART + 512 + 8192);
    LAS float* pw = (LAS float*)(pe + 256);
    LAS int* hist = (LAS int*)(pw + 256);
    LAS int* gbase = hist + 32;
    {
        const bf16_t* rt = WSP(F, WS_RT, bf16_t) + (size_t)layer * 2 * 32 * D;
#pragma unroll 4
        for (int j = 0; j < 16; ++j) { const int ch = tid + NTH * j, part = ch >> 12, row = (ch >> 7) & 31, c16 = ch & 127;
            *(LAS u32x4*)(lds + part * RT_PART + row * RT_STRIDE + c16 * 16) = *(const u32x4*)(rt + ((size_t)(part * 32 + row) * D + c16 * 8)); }
    }
    const float* mod = WSP(F, WS_MOD, float) + (size_t)layer * 6 * D;
    int* lslot = WSP(F, WS_LSLOT, int) + (size_t)layer * NE * LIST_CAP; float* lw = WSP(F, WS_LW, float) + (size_t)layer * NE * LIST_CAP;
    if (aux) { lslot = (int*)(F.ws + WS_END); lw = (float*)(F.ws + WS_END + 4 * MiB); }
    unsigned* cntw = F.ctl + CW_CNT + 64 * (layer + 2 * aux);
    const int tile = F.wave & 3, kh = F.wave >> 2, tk = lane & 15, kq = lane >> 4;
    const float* brt = inptr(13) + layer * NE;
    __syncthreads();
    for (int tb = F.vcu; tb < T / 64; tb += F.G) {
        if (tid < 32) hist[tid] = 0;
        const int row = tb * 64 + tile * 16 + tk;
        const bf16_t* xr = X + (size_t)row * D + kh * 512 + 8 * kq;
        float ss = 0.f;
#pragma unroll 8
        for (int s = 0; s < 16; ++s) { const u32x4 q = *(const u32x4*)(xr + 32 * s);
            const f32x4 a = {bflo(q.x), bfhi(q.x), bflo(q.y), bfhi(q.y)}, b = {bflo(q.z), bfhi(q.z), bflo(q.w), bfhi(q.w)};
            ss += (a.x * a.x + a.y * a.y) + (a.z * a.z + a.w * a.w) + (b.x * b.x + b.y * b.y) + (b.z * b.z + b.w * b.w); }
        ss += __shfl_xor(ss, 16); ss += __shfl_xor(ss, 32);
        if (kq == 0) ssq[F.wave * 16 + tk] = ss;
        __syncthreads();
        const float rstd = rsqrtf((ssq[tile * 16 + tk] + ssq[(tile + 4) * 16 + tk]) * (1.f / D) + EPS);
        f32x4 acc[2] = {{0.f, 0.f, 0.f, 0.f}, {0.f, 0.f, 0.f, 0.f}};
        bf16_t* hrow = WSP(F, WS_HN, bf16_t) + (size_t)row * D;
#pragma unroll 2
        for (int s = 0; s < 16; ++s) {
            const int col = kh * 512 + 32 * s + 8 * kq;
            const u32x4 q = *(const u32x4*)(xr + 32 * s);
            const f32x4 a = {bflo(q.x), bfhi(q.x), bflo(q.y), bfhi(q.y)}, b = {bflo(q.z), bfhi(q.z), bflo(q.w), bfhi(q.w)};
            const f32x4 sc0 = *(const f32x4*)(mod + 4 * D + col) + 1.0f, sc1 = *(const f32x4*)(mod + 4 * D + col + 4) + 1.0f;
            const f32x4 sh0 = *(const f32x4*)(mod + 3 * D + col), sh1 = *(const f32x4*)(mod + 3 * D + col + 4);
            const f32x4 h0 = a * rstd * sc0 + sh0, h1 = b * rstd * sc1 + sh1;
            u32x4 hi; hi.x = cvt_pk_bf16(h0.x, h0.y); hi.y = cvt_pk_bf16(h0.z, h0.w); hi.z = cvt_pk_bf16(h1.x, h1.y); hi.w = cvt_pk_bf16(h1.z, h1.w);
            if ((FP8_LAYERS >> layer) & 1) *(u32x2*)(WSP(F, WS_HN8, unsigned char) + (size_t)row * D + col) = (u32x2){pack_fp8x4(h0.x, h0.y, h0.z, h0.w), pack_fp8x4(h1.x, h1.y, h1.z, h1.w)};
            else *(u32x4*)(hrow + col) = hi;
            u32x4 lo; lo.x = cvt_pk_bf16(h0.x - bflo(hi.x), h0.y - bfhi(hi.x)); lo.y = cvt_pk_bf16(h0.z - bflo(hi.y), h0.w - bfhi(hi.y));
            lo.z = cvt_pk_bf16(h1.x - bflo(hi.z), h1.y - bfhi(hi.z)); lo.w = cvt_pk_bf16(h1.z - bflo(hi.w), h1.w - bfhi(hi.w));
            const bf16x8 bh = __builtin_bit_cast(bf16x8, hi), bl = __builtin_bit_cast(bf16x8, lo);
#pragma unroll
            for (int et = 0; et < 2; ++et) {
                const bf16x8 wh = *(const LAS bf16x8*)(lds + (16 * et + tk) * RT_STRIDE + col * 2);
                const bf16x8 wl = *(const LAS bf16x8*)(lds + RT_PART + (16 * et + tk) * RT_STRIDE + col * 2);
                acc[et] = __builtin_amdgcn_mfma_f32_16x16x32_bf16(wh, bh, acc[et], 0, 0, 0);
                acc[et] = __builtin_amdgcn_mfma_f32_16x16x32_bf16(wl, bh, acc[et], 0, 0, 0);
                acc[et] = __builtin_amdgcn_mfma_f32_16x16x32_bf16(wh, bl, acc[et], 0, 0, 0);
            }
        }
        if (kh == 1) { lgx[(tile * 2 + 0) * 64 + lane] = acc[0]; lgx[(tile * 2 + 1) * 64 + lane] = acc[1]; }
        __syncthreads();
        if (kh == 0) {
            float cv[8]; int ci[8];
#pragma unroll
            for (int et = 0; et < 2; ++et) { const f32x4 o = lgx[(tile * 2 + et) * 64 + lane]; const f32x4 bb = *(const f32x4*)(brt + 16 * et + 4 * kq);
#pragma unroll
                for (int r = 0; r < 4; ++r) { cv[et * 4 + r] = acc[et][r] + o[r] + bb[r]; ci[et * 4 + r] = 16 * et + 4 * kq + r; } }
            float tv[4]; int ti[4];
            sel4of8(cv, ci, tv, ti);
#pragma unroll
            for (int off = 16; off <= 32; off <<= 1) {
                float mv[8]; int mi[8];
#pragma unroll
                for (int k = 0; k < 4; ++k) { mv[k] = tv[k]; mi[k] = ti[k]; mv[4 + k] = __shfl_xor(tv[k], off); mi[4 + k] = __shfl_xor(ti[k], off); }
                sel4of8(mv, mi, tv, ti);
            }
            const float e1 = __expf(tv[1] - tv[0]), e2 = __expf(tv[2] - tv[0]), e3 = __expf(tv[3] - tv[0]); const float inv = 1.0f / (1.0f + e1 + e2 + e3);
            if (kq == 0) { const int tl = tile * 16 + tk;
                pe[tl * 4 + 0] = ti[0]; pe[tl * 4 + 1] = ti[1]; pe[tl * 4 + 2] = ti[2]; pe[tl * 4 + 3] = ti[3];
                pw[tl * 4 + 0] = inv; pw[tl * 4 + 1] = e1 * inv; pw[tl * 4 + 2] = e2 * inv; pw[tl * 4 + 3] = e3 * inv; }
        }
        __syncthreads();
        int myexp = 0, lpos = 0;
        if (tid < 256) { myexp = pe[tid]; lpos = __hip_atomic_fetch_add(hist + myexp, 1, __ATOMIC_RELAXED, __HIP_MEMORY_SCOPE_WORKGROUP); }
        __syncthreads();
        if (tid < 32) gbase[tid] = (int)atomicAdd(cntw + tid, (unsigned)hist[tid]);
        __syncthreads();
        if (tid < 256) { const int pos = gbase[myexp] + lpos; if (pos < LIST_CAP) { lslot[(size_t)myexp * LIST_CAP + pos] = tb * 256 + tid; lw[(size_t)myexp * LIST_CAP + pos] = pw[tid]; } }
        __syncthreads();
    }
}

template <int MODE>
__device__ __forceinline__ void p_combine(Frame& F, int layer, const bf16_t* Xin, void* Xout_) {
    const int lane = F.lane;
    const float* mod = WSP(F, WS_MOD, float) + (size_t)layer * 6 * D;
    const bf16_t* ys = WSP(F, WS_YSLOT, bf16_t);
    f32x4 gf[4], fnw[4];
#pragma unroll
    for (int j = 0; j < 4; ++j) { gf[j] = *(const f32x4*)(mod + 5 * D + 4 * lane + 256 * j); if (MODE == 1) fnw[j] = *(const f32x4*)(inptr(18) + 4 * lane + 256 * j); }
#pragma unroll 2
    for (int it = 0; it < (T / 64 + F.G - 1) / F.G * 8; ++it) {
        const int row = ((it >> 3) * F.G + F.vcu) * 64 + F.wave * 8 + (it & 7); if (row >= T) break;
        const u32x2* xr = (const u32x2*)(Xin + (size_t)row * D) + lane;
        f32x4 v[4]; float s = 0.f;
#pragma unroll
        for (int j = 0; j < 4; ++j) {
            f32x4 a = {0.f, 0.f, 0.f, 0.f};
#pragma unroll
            for (int k = 0; k < 4; ++k) { const u32x2 y = *((const u32x2*)(ys + ((size_t)row * 4 + k) * D) + lane + 64 * j); a += (f32x4){bflo(y.x), bfhi(y.x), bflo(y.y), bfhi(y.y)}; }
            const u32x2 xq = xr[64 * j];
            v[j] = (f32x4){bflo(xq.x), bfhi(xq.x), bflo(xq.y), bfhi(xq.y)} + gf[j] * a;
            if (MODE == 0) { const u32x2 w = {cvt_pk_bf16(v[j].x, v[j].y), cvt_pk_bf16(v[j].z, v[j].w)};
                ((u32x2*)((bf16_t*)Xout_ + (size_t)row * D) + lane)[64 * j] = w; v[j] = (f32x4){bflo(w.x), bfhi(w.x), bflo(w.y), bfhi(w.y)}; }
            s += (v[j].x * v[j].x + v[j].y * v[j].y) + (v[j].z * v[j].z + v[j].w * v[j].w);
        }
        const float rstd = rsqrtf(wave_sum(s) * (1.f / D) + EPS);
        if (MODE == 0) { if (lane == 0) WSP(F, WS_RSTD, float)[row] = rstd; }
        else { f32x4* o = (f32x4*)((float*)Xout_ + (size_t)row * D) + lane;
#pragma unroll
            for (int j = 0; j < 4; ++j) __builtin_nontemporal_store(v[j] * rstd * fnw[j], o + 64 * j);
        }
    }
}

template <int W>
__device__ __forceinline__ void pool_unit(const bf16_t* X, const float* rs, bf16_t* P, int c, int t0, float sh, float sc) {
    float hp[16], hc[16];
#pragma unroll
    for (int i = 0; i < 16; ++i) { const int t = t0 - 16 + i; hp[i] = (i >= 16 - (W - 1) && t >= 0) ? bf2f(X[(size_t)t * D + c]) * rs[t] * sc + sh : 0.f; }
    float sum = 0.f;
#pragma unroll
    for (int i = 1; i < W; ++i) sum += hp[16 - i];
#pragma unroll
    for (int blk = 0; blk < 2; ++blk) {
        const int tb = t0 + 16 * blk;
#pragma unroll
        for (int i = 0; i < 16; ++i) hc[i] = bf2f(X[(size_t)(tb + i) * D + c]) * rs[tb + i] * sc + sh;
#pragma unroll
        for (int i = 0; i < 16; ++i) {
            const int t = tb + i;
            sum += hc[i];
            const int cnt = (t + 1 < W) ? (t + 1) : W;
            const float p = sum / (float)cnt - hc[i];
            P[(size_t)t * D + c] = (bf16_t)(cvt_pk_bf16(p, 0.f) & 0xffffu);
            sum -= (i - (W - 1) >= 0) ? hc[(i - (W - 1)) & 15] : hp[(16 + i - (W - 1)) & 15];
        }
#pragma unroll
        for (int i = 0; i < 16; ++i) hp[i] = hc[i];
    }
}
__device__ __forceinline__ void p_pool(Frame& F, const bf16_t* X) {
    const float* mod = WSP(F, WS_MOD, float) + (size_t)1 * 6 * D; const float* rs = WSP(F, WS_RSTD, float); bf16_t* P = WSP(F, WS_HN, bf16_t);
    const int tid = F.tid;
    for (int u = F.vcu; u < 1024; u += F.G) {
        const int tt = u >> 2, g = u & 3;
        const int c = g * 256 + (tid & 255), t0 = tt * 64 + (tid >> 8) * 32;
        const float sh = mod[0 * D + c], sc = 1.0f + mod[1 * D + c];
        if (g == 0) pool_unit<2>(X, rs, P, c, t0, sh, sc);
        else if (g == 1) pool_unit<4>(X, rs, P, c, t0, sh, sc);
        else if (g == 2) pool_unit<8>(X, rs, P, c, t0, sh, sc);
        else pool_unit<16>(X, rs, P, c, t0, sh, sc);
    }
}

constexpr int N_PHASES = 17;
__global__ void __launch_bounds__(NTH, 2) fwd_kernel(Args args) {
    extern __shared__ __attribute__((aligned(16))) unsigned char lds_raw[];
    Frame F;
    F.lds = (LAS unsigned char*)lds_raw;
    F.MISC = (volatile LAS unsigned*)(F.lds + MISC_OFF);
    F.tid = threadIdx.x; F.lane = F.tid & 63; F.wave = __builtin_amdgcn_readfirstlane(F.tid >> 6);
    F.G = gridDim.x; { const int bx = blockIdx.x; F.vcu = (F.G % 8 == 0) ? (bx % 8) * (F.G / 8) + bx / 8 : bx; }
    F.ws = args.ws; F.ctl = (unsigned*)(args.ws + WS_CTL); F.out = args.out;
    for (int u = F.tid; u < (LDS_BYTES - MISC_OFF) / 4; u += NTH) F.MISC[u] = 0u;
    __syncthreads();
#if N_LAUNCH_MODE == 1
    XcdBarrier bar = xcd_barrier_post(F.ctl + CW_BAR, F.MISC + 8);
#define GRID_BAR() xcd_barrier(bar)
#else
#define GRID_BAR() do { } while (0)
#endif
    const int lo = args.ph_lo, hi = args.ph_hi;
#define IN(k) (lo <= (k) && (k) < hi)
#define SEAM(k) do { if (IN(k) && IN((k) + 1)) GRID_BAR(); } while (0)
    GemmBase gb; gb.G = F.G; gb.vcu = F.vcu;
    bf16_t* X1 = WSP(F, WS_X1, bf16_t); bf16_t* X2 = WSP(F, WS_X2, bf16_t);
    const float* mod0 = WSP(F, WS_MOD, float); const float* mod1 = mod0 + 6 * D;

    if (IN(0)) { p0_prologue(F); } SEAM(0);
    if (IN(1)) { p1_norm_in(F); } SEAM(1);
    if (IN(2)) { PolWin P; (GemmBase&)P = gb; P.A = WSP(F, WS_HN, bf16_t); P.Bt = WSP(F, WS_WINT, bf16_t); P.qkvg = WSP(F, WS_QKVG, bf16_t); P.gbuf = WSP(F, WS_GBUF, _Float16);
        P.lb = WSP(F, WS_LB, float); P.rope = WSP(F, WS_ROPE, f32x2); run_gemm(F, P); } SEAM(2);
    if (IN(3)) { la_local_state(F); } SEAM(3);
    if (IN(4)) { la_scan(F); } SEAM(4);
    if (IN(5)) { la_output(F); } SEAM(5);
    if (IN(6)) { PolRes<false> P; (GemmBase&)P = gb; P.A = WSP(F, WS_CAT, bf16_t); P.Bt = WSP(F, WS_WOUTT, bf16_t); P.resid = inptr(0); P.resid16 = nullptr; P.outp = X1; P.gate = mod0 + 2 * D; P.bias = nullptr; P.scale = nullptr;
        P.K = D; P.lda = D; P.nN = 4; P.kcol = 0; run_gemm(F, P); } SEAM(6);
    if (IN(7)) { p_route(F, 0, X1, args.aux); } SEAM(7);
    if (IN(8)) { expert_tables(F, 0); PolMoE<((FP8_LAYERS >> 0) & 1) != 0> P; (GemmBase&)P = gb; P.MISC = F.MISC; P.upa = F.lds + UPA_OFF; P.hn = ((FP8_LAYERS >> 0) & 1) ? (const bf16_t*)WSP(F, WS_HN8, unsigned char) : WSP(F, WS_HN, bf16_t);
        P.wgut = WSP(F, WS_WGUT, bf16_t) + (size_t)0 * NE * 2048 * D; P.bgu = inptr(15) + (size_t)0 * NE * 2048; P.lslot = WSP(F, WS_LSLOT, int) + (size_t)0 * NE * LIST_CAP; P.lw = WSP(F, WS_LW, float) + (size_t)0 * NE * LIST_CAP;
        P.act = (bf16_t*)(F.ws + (0 ? WS_ACT2 : WS_ACT)); P.wdnt = WSP(F, WS_WDNT, bf16_t) + (size_t)0 * NE * D * D; P.bdn = inptr(17) + (size_t)0 * NE * D; P.yslot = WSP(F, WS_YSLOT, bf16_t);
        P.done = F.ctl + CW_DONE + 0 * DONE_LAYER; P.tmo = F.ctl + CW_TMO; P.act_rsrc = __builtin_amdgcn_make_buffer_rsrc((void*)P.act, (short)0, (int)((size_t)ACT_ROWS * D * 2), 0x00020000);
        P.fill(F.tid); __syncthreads(); run_gemm(F, P); } if (IN(8) && IN(10)) GRID_BAR();
    if (IN(10)) { p_combine<0>(F, 0, X1, X2); } SEAM(10);
    if (IN(11)) { p_pool(F, X2); } SEAM(11);
    if (IN(12)) { PolRes<true> P; (GemmBase&)P = gb; P.A = WSP(F, WS_HN, bf16_t); P.Bt = WSP(F, WS_POOLT, bf16_t); P.resid = nullptr; P.resid16 = X2; P.outp = X1; P.gate = mod1 + 2 * D; P.bias = inptr(10); P.scale = inptr(11);
        P.K = 256; P.lda = D; P.nN = 4; P.kcol = 256; run_gemm(F, P); } SEAM(12);
    if (IN(13)) { p_route(F, 1, X1, args.aux); } SEAM(13);
    if (IN(14)) { expert_tables(F, 1); PolMoE<((FP8_LAYERS >> 1) & 1) != 0> P; (GemmBase&)P = gb; P.MISC = F.MISC; P.upa = F.lds + UPA_OFF; P.hn = ((FP8_LAYERS >> 1) & 1) ? (const bf16_t*)WSP(F, WS_HN8, unsigned char) : WSP(F, WS_HN, bf16_t);
        P.wgut = WSP(F, WS_WGUT, bf16_t) + (size_t)1 * NE * 2048 * D; P.bgu = inptr(15) + (size_t)1 * NE * 2048; P.lslot = WSP(F, WS_LSLOT, int) + (size_t)1 * NE * LIST_CAP; P.lw = WSP(F, WS_LW, float) + (size_t)1 * NE * LIST_CAP;
        P.act = (bf16_t*)(F.ws + (1 ? WS_ACT2 : WS_ACT)); P.wdnt = WSP(F, WS_WDNT, bf16_t) + (size_t)1 * NE * D * D; P.bdn = inptr(17) + (size_t)1 * NE * D; P.yslot = WSP(F, WS_YSLOT, bf16_t);
        P.done = F.ctl + CW_DONE + 1 * DONE_LAYER; P.tmo = F.ctl + CW_TMO; P.act_rsrc = __builtin_amdgcn_make_buffer_rsrc((void*)P.act, (short)0, (int)((size_t)ACT_ROWS * D * 2), 0x00020000);
        P.fill(F.tid); __syncthreads(); run_gemm(F, P); } if (IN(14) && IN(16)) GRID_BAR();
    if (IN(16)) { p_combine<1>(F, 1, X1, F.out); }
#undef IN
#undef SEAM
}

extern "C" void kernel_launch(void* const* d_in, const int* in_sizes, int n_in, void* d_out, int out_size, void* d_ws, size_t ws_size, hipStream_t stream) {
    static int grid = 0;
    if (grid == 0) {
        if (n_in != 19 || out_size != T * D || ws_size < WS_END) { fprintf(stderr, "kernel_launch: unexpected shapes (n_in %d, out %d, ws %zu)\n", n_in, out_size, ws_size); grid = -1; return; }
        int dev = 0, cus = 0, per_cu = 0;
        if (hipGetDevice(&dev) != hipSuccess || hipDeviceGetAttribute(&cus, hipDeviceAttributeMultiprocessorCount, dev) != hipSuccess) { grid = -1; return; }
        if (hipFuncSetAttribute((const void*)fwd_kernel, hipFuncAttributeMaxDynamicSharedMemorySize, LDS_BYTES) != hipSuccess) { fprintf(stderr, "kernel_launch: hipFuncSetAttribute failed\n"); grid = -1; return; }
        if (hipOccupancyMaxActiveBlocksPerMultiprocessor(&per_cu, (const void*)fwd_kernel, NTH, LDS_BYTES) != hipSuccess || per_cu < 1) { fprintf(stderr, "kernel_launch: occupancy query says %d\n", per_cu); }
        (void)hipGetLastError();
        grid = cus;
    }
    if (grid < 0) return;
    (void)hipMemsetAsync((char*)d_ws + WS_CTL, 0, CTL_BYTES, stream);
    Args a{};
    for (int i = 0; i < 19; ++i) a.in[i] = (const float*)d_in[i];
    a.out = (float*)d_out; a.ws = (unsigned char*)d_ws;
#if N_LAUNCH_MODE == 1
    a.ph_lo = 0; a.ph_hi = N_PHASES;
    void* kargs[] = {&a};
    hipError_t e = hipLaunchCooperativeKernel((const void*)fwd_kernel, dim3(grid), dim3(NTH), kargs, LDS_BYTES, stream);
    if (e != hipSuccess) fprintf(stderr, "cooperative launch failed: %s\n", hipGetErrorString(e));
#else
    for (int p = 0; p < N_PHASES; ++p) {
        a.ph_lo = p; a.ph_hi = p + 1;
        hipLaunchKernelGGL(fwd_kernel, dim3(grid), dim3(NTH), LDS_BYTES, stream, a);
        if (p == DUP_PHASE) { a.aux = 1; hipLaunchKernelGGL(fwd_kernel, dim3(grid), dim3(NTH), LDS_BYTES, stream, a); a.aux = 0; }
    }
#endif
}
```

```cpp
#include <hip/hip_runtime.h>
#include <cstdio>
#include <cstdint>

#ifndef N_LAUNCH_MODE
#define N_LAUNCH_MODE 1
#endif
#ifndef DUP_PHASE
#define DUP_PHASE -1
#endif
#ifndef KREP_WIN
#define KREP_WIN 1
#endif
#ifndef KREP_RES
#define KREP_RES 1
#endif
#ifndef KREP_G1
#define KREP_G1 1
#endif
#ifndef KREP_G2
#define KREP_G2 1
#endif
#ifndef GEMM_KREP
#define GEMM_KREP 1
#endif
#ifndef GEMM_EPIREP
#define GEMM_EPIREP 1
#endif
#ifndef FP8_LAYERS
#define FP8_LAYERS 3
#endif
#ifndef SIMPLE_GEMM
#define SIMPLE_GEMM 0
#endif

#define LAS __attribute__((address_space(3)))
#define GAS __attribute__((address_space(1)))
typedef unsigned short bf16_t;
typedef short bf16x8 __attribute__((ext_vector_type(8)));
typedef float f32x4 __attribute__((ext_vector_type(4)));
typedef float f32x2 __attribute__((ext_vector_type(2)));
typedef unsigned u32x4 __attribute__((ext_vector_type(4)));
typedef unsigned u32x2 __attribute__((ext_vector_type(2)));
typedef _Float16 h16x2 __attribute__((ext_vector_type(2)));
typedef _Float16 h16x8 __attribute__((ext_vector_type(8)));
typedef int v4i_t __attribute__((ext_vector_type(4)));
typedef int v8i_t __attribute__((ext_vector_type(8)));
constexpr float W8_SCALE = 32.0f;
__device__ __forceinline__ unsigned pack_fp8x4(float a, float b, float c, float d) { int w = __builtin_amdgcn_cvt_pk_fp8_f32(a, b, 0, false); w = __builtin_amdgcn_cvt_pk_fp8_f32(c, d, w, true); return (unsigned)w; }

constexpr int T = 16384, D = 1024, NE = 32, TOPK = 4, DEPTH = 2;
constexpr int INW = 4096;
constexpr int NTH = 512, NWAVES = 8;
constexpr float EPS = 1e-6f;
constexpr float SW_LIMIT = 7.0f, SW_ALPHA = 1.702f;
constexpr int LIST_CAP = T;
constexpr int ACT_ROWS = T * TOPK + NE * 256;

constexpr size_t MiB = 1u << 20;
constexpr size_t WS_CTL = 0, CTL_BYTES = 1 * MiB;
constexpr size_t WS_MOD = 1 * MiB;
constexpr size_t WS_LB = WS_MOD + 65536;
constexpr size_t WS_ROPE = 2 * MiB;
constexpr size_t WS_WINT = 10 * MiB;
constexpr size_t WS_WOUTT = 18 * MiB;
constexpr size_t WS_POOLT = 20 * MiB;
constexpr size_t WS_LSLOT = 22 * MiB;
constexpr size_t WS_LW = 26 * MiB;
constexpr size_t WS_RT = 21 * MiB;
constexpr size_t WS_RSTD = 30 * MiB;
constexpr size_t WS_WGUT = 32 * MiB;
constexpr size_t WS_WDNT = 288 * MiB;
constexpr size_t WS_HN = 416 * MiB;
constexpr size_t WS_QKVG = 448 * MiB;
constexpr size_t WS_GBUF = 576 * MiB;
constexpr size_t WS_KVT = 608 * MiB;
constexpr size_t WS_SPREV = 736 * MiB;
constexpr size_t WS_DEC = 800 * MiB;
constexpr size_t WS_CAT = 802 * MiB;
constexpr size_t WS_X1 = 834 * MiB;
constexpr size_t WS_X2 = 898 * MiB;
constexpr size_t WS_ACT = 962 * MiB;
constexpr size_t WS_YSLOT = 1106 * MiB;
constexpr size_t WS_ACT2 = 1234 * MiB;
constexpr size_t WS_HN8 = 1378 * MiB;
constexpr size_t WS_END = 1394 * MiB;
constexpr int CW_CNT = 64;
constexpr int CW_BAR = 4096;
constexpr int CW_TMO = 8;
constexpr int CW_DONE = 8192, DONE_LAYER = 320 * 64;

constexpr int SCR_BYTES = 156 * 1024;
constexpr int MISC_OFF = SCR_BYTES;
constexpr int LDS_BYTES = SCR_BYTES + 4096;

typedef __bf16 bf16x2_t __attribute__((ext_vector_type(2)));
__device__ __forceinline__ unsigned cvt_pk_bf16(float lo, float hi) { const f32x2 v = {lo, hi}; const bf16x2_t b = __builtin_convertvector(v, bf16x2_t); return __builtin_bit_cast(unsigned, b); }
__device__ __forceinline__ float bf2f(unsigned short b) { return __builtin_bit_cast(float, (unsigned)b << 16); }
__device__ __forceinline__ float bflo(unsigned w) { return __builtin_bit_cast(float, w << 16); }
__device__ __forceinline__ float bfhi(unsigned w) { return __builtin_bit_cast(float, w & 0xffff0000u); }
__device__ __forceinline__ float wave_sum(float v) {
#pragma unroll
    for (int o = 1; o < 64; o <<= 1) v += __shfl_xor(v, o);
    return v;
}
__device__ __forceinline__ float wave_max(float v) {
#pragma unroll
    for (int o = 1; o < 64; o <<= 1) v = fmaxf(v, __shfl_xor(v, o));
    return v;
}
__device__ __forceinline__ float sigmoidf_(float x) { return __builtin_amdgcn_rcpf(1.0f + __expf(-x)); }
__device__ __forceinline__ float siluf_(float x) { return x * sigmoidf_(x); }

#define XB_TMO      128
#define XB_XCNT(j)  (256  + 64 * (j))
#define XB_XSUB(j)  (1280 + 64 * (j))
#define XB_XGEN(j)  (2304 + 64 * (j))
#define XB_TOP      3328
#define XB_TOPGEN   3392
#define XCD_BAR_WORDS 3456
#define XB_SPIN_CAP (1u << 20)
__device__ __forceinline__ unsigned xb_ld(unsigned* p)              { return __hip_atomic_load(p, __ATOMIC_RELAXED, __HIP_MEMORY_SCOPE_AGENT); }
__device__ __forceinline__ unsigned xb_add(unsigned* p, unsigned v) { return __hip_atomic_fetch_add(p, v, __ATOMIC_RELAXED, __HIP_MEMORY_SCOPE_AGENT); }
__device__ __forceinline__ unsigned xb_xcc_id() { return (unsigned)__builtin_amdgcn_s_getreg((3 << 11) | 20) & 0xFu; }
#define XB_SPIN(cond, bar) do { unsigned _sp = 0; while (cond) { __builtin_amdgcn_s_sleep(1); \
    if ((++_sp & 255u) == 0u) { if (xb_ld(&(bar)[XB_TMO])) break; if (_sp > XB_SPIN_CAP) { atomicAdd(&(bar)[XB_TMO], 1u); break; } } } } while (0)
struct XcdBarrier { unsigned* bar; unsigned x; volatile LAS unsigned* st; };
__device__ __forceinline__ XcdBarrier xcd_barrier_post(unsigned* bar, volatile LAS unsigned* st) {
    XcdBarrier b; b.bar = bar; b.x = xb_xcc_id(); b.st = st;
    if (threadIdx.x == 0) (void)xb_add(&bar[XB_XCNT(b.x)], 1u);
    return b;
}
__device__ __forceinline__ void xcd_barrier_complete(unsigned* bar, unsigned x, unsigned& nloc, unsigned& nx) {
    const unsigned G = gridDim.x * gridDim.y * gridDim.z;
    unsigned sum, cnt, mine, sp = 0u;
    for (;;) {
        sum = 0u; cnt = 0u; mine = 0u;
#pragma unroll
        for (unsigned j = 0; j < 16; ++j) { const unsigned c = xb_ld(&bar[XB_XCNT(j)]); sum += c; cnt += (c > 0u) ? 1u : 0u; mine = (j == x) ? c : mine; }
        if (sum == G) break;
        __builtin_amdgcn_s_sleep(1);
        if ((++sp & 255u) == 0u) { if (xb_ld(&bar[XB_TMO])) break; if (sp > XB_SPIN_CAP) { atomicAdd(&bar[XB_TMO], 1u); break; } }
    }
    nloc = mine > 0u ? mine : 1u; nx = cnt > 0u ? cnt : 1u;
}
__device__ __forceinline__ void xcd_barrier(const XcdBarrier& b) {
    asm volatile("s_waitcnt vmcnt(0)" ::: "memory");
    __syncthreads();
    if (threadIdx.x == 0) {
        unsigned* bar = b.bar;
        __builtin_amdgcn_s_waitcnt(0);
        unsigned nloc = b.st[0], nx = b.st[1];
        if (nloc == 0u) { xcd_barrier_complete(bar, b.x, nloc, nx); b.st[0] = nloc; b.st[1] = nx; }
        const unsigned old = xb_add(&bar[XB_XSUB(b.x)], 1u);
        const unsigned gen = old / nloc;
        if (old + 1u == (gen + 1u) * nloc) {
            __builtin_amdgcn_fence(__ATOMIC_RELEASE, "agent");
            asm volatile("s_waitcnt vmcnt(0)" ::: "memory");
            const unsigned og = xb_add(&bar[XB_TOP], 1u);
            const unsigned tg = og / nx;
            if (og + 1u == (tg + 1u) * nx) xb_add(&bar[XB_TOPGEN], 1u);
            else XB_SPIN(xb_ld(&bar[XB_TOPGEN]) == tg, bar);
            __builtin_amdgcn_fence(__ATOMIC_ACQUIRE, "agent");
            xb_add(&bar[XB_XGEN(b.x)], 1u);
            asm volatile("s_waitcnt vmcnt(0)" ::: "memory");
        } else {
            XB_SPIN(xb_ld(&bar[XB_XGEN(b.x)]) == gen, bar);
            __builtin_amdgcn_fence(__ATOMIC_ACQUIRE, "agent");
            asm volatile("s_waitcnt vmcnt(0)" ::: "memory");
        }
    }
    __syncthreads();
}

struct Args {
    const float* in[19];
    float* out;
    unsigned char* ws;
    int ph_lo, ph_hi, aux, pad;
};

namespace pg8 {
constexpr int BM = 256, BK = 64, HALF = 128, HTB = HALF * BK * 2;
__host__ __device__ __forceinline__ int lds_byte(int r, int c) { const int st = (r >> 4) * 2 + (c >> 5), rr = r & 15, cc = c & 31, ob = rr * 64 + cc * 2; return st * 1024 + (ob ^ (((ob >> 9) & 1) << 5)); }
__host__ __device__ __forceinline__ void stage_rc(int b, int& R, int& C) { const int st = b / 1024, sb = b % 1024, swz = sb ^ (((sb >> 9) & 1) << 5); R = (st >> 1) * 16 + swz / 64; C = (st & 1) * 32 + (swz % 64) / 2; }
__host__ __device__ __forceinline__ int perm32(int rho) { const int n = rho >> 4, i = rho & 15; return 8 * (i >> 2) + 4 * n + (i & 3); }

struct Unit { const char* A; const char* B; int p0, p1, p2, p3, ui; };

#define PG8_SA(b, h) (((b) * 2 + (h)) * HTB)
#define PG8_SB(b, h) ((4 + (b) * 2 + (h)) * HTB)
#define PG8_LDA(dst, b, h) do { _Pragma("unroll") for (int m = 0; m < 4; ++m) _Pragma("unroll") for (int k = 0; k < 2; ++k) dst[m][k] = *(const LAS bf16x8*)(lds + PG8_SA(b, h) + aoff + m * 2048 + k * 1024); } while (0)
#define PG8_LDB(dst, b, h) do { _Pragma("unroll") for (int n = 0; n < 2; ++n) _Pragma("unroll") for (int k = 0; k < 2; ++k) dst[n][k] = *(const LAS bf16x8*)(lds + PG8_SB(b, h) + boff + n * 2048 + k * 1024); } while (0)
#define PG8_MMA(ai, bj, At, Bt) do { __builtin_amdgcn_s_setprio(1); _Pragma("unroll") for (int m = 0; m < 4; ++m) _Pragma("unroll") for (int n = 0; n < 2; ++n) _Pragma("unroll") for (int k = 0; k < 2; ++k) \
        acc[ai][bj][m][n] = __builtin_amdgcn_mfma_f32_16x16x32_bf16(Bt[n][k], At[m][k], acc[ai][bj][m][n], 0, 0, 0); __builtin_amdgcn_s_setprio(0); } while (0)

template <class P>
__device__ __forceinline__ void gemm_simple(LAS unsigned char* lds, const P& S) {
    const int tid = threadIdx.x, wid = __builtin_amdgcn_readfirstlane(tid >> 6), lane = tid & 63, wr = wid >> 2, wc = wid & 3, fr = lane & 15, fq = lane >> 4;
    const int nt = S.nt();
    int R0, C0; stage_rc(tid * 16, R0, C0);
    unsigned offB[2];
#pragma unroll
    for (int i = 0; i < 2; ++i) { const int R = R0 + 64 * i; const int Rb = (R & ~31) + perm32(R & 31); offB[i] = (unsigned)Rb * S.ldb_bytes() + (unsigned)C0 * 2u; }
    const unsigned bhalf = 128u * S.ldb_bytes();
    const int aoff = lds_byte(wr * 64 + fr, fq * 8), boff = lds_byte(wc * 32 + fr, fq * 8);
    Unit u;
    for (int ui = 0; S.next(ui, u); ++ui) {
        unsigned offA[4]; S.aoff(u, R0, C0, offA);
        f32x4 acc[2][2][4][2];
#pragma unroll
        for (int a = 0; a < 2; ++a)
#pragma unroll
            for (int b = 0; b < 2; ++b)
#pragma unroll
                for (int m = 0; m < 4; ++m)
#pragma unroll
                    for (int n = 0; n < 2; ++n) acc[a][b][m][n] = (f32x4){0.f, 0.f, 0.f, 0.f};
        for (int t = 0; t < nt; ++t) {
            u32x4 ra[4], rb[4];
#pragma unroll
            for (int h = 0; h < 2; ++h)
#pragma unroll
                for (int i = 0; i < 2; ++i) {
                    ra[2 * h + i] = *(const u32x4*)(u.A + offA[2 * h + i] + (size_t)t * 128);
                    rb[2 * h + i] = *(const u32x4*)(u.B + (size_t)h * bhalf + offB[i] + (size_t)t * 128);
                }
            __syncthreads();
#pragma unroll
            for (int h = 0; h < 2; ++h)
#pragma unroll
                for (int i = 0; i < 2; ++i) {
                    *(LAS u32x4*)(lds + PG8_SA(0, h) + tid * 16 + i * 8192) = ra[2 * h + i];
                    *(LAS u32x4*)(lds + PG8_SB(0, h) + tid * 16 + i * 8192) = rb[2 * h + i];
                }
            __syncthreads();
            bf16x8 At[4][2], Bt[2][2];
#pragma unroll
            for (int ai = 0; ai < 2; ++ai) {
                PG8_LDA(At, 0, ai);
#pragma unroll
                for (int bj = 0; bj < 2; ++bj) { PG8_LDB(Bt, 0, bj); PG8_MMA(ai, bj, At, Bt); }
            }
        }
        S.epi(acc, u, wr, wc, fr, fq);
    }
    __syncthreads();
}

template <class P>
__device__ __forceinline__ void gemm_pipe(LAS unsigned char* lds, const P& S) {
    const int tid = threadIdx.x, wid = __builtin_amdgcn_readfirstlane(tid >> 6), lane = tid & 63, wr = wid >> 2, wc = wid & 3, fr = lane & 15, fq = lane >> 4;
    constexpr int KR = GEMM_KREP * P::KREP; const int nt1 = S.nt(), nt = nt1 * KR;
    int R0, C0; stage_rc(tid * 16, R0, C0);
    unsigned offB[2];
#pragma unroll
    for (int i = 0; i < 2; ++i) { const int R = R0 + 64 * i; const int Rb = (R & ~31) + perm32(R & 31); offB[i] = (unsigned)Rb * S.ldb_bytes() + (unsigned)C0 * 2u; }
    const size_t bhalf = (size_t)128u * S.ldb_bytes();
    const size_t kstep = 128;
    const unsigned ldsw = (unsigned)wid * 1024u;
    int aoffK[2], boffK[2];
#pragma unroll
    for (int k = 0; k < 2; ++k) { aoffK[k] = lds_byte(wr * 64 + fr, fq * 8) + k * 1024; boffK[k] = lds_byte(wc * 32 + fr, fq * 8) + k * 1024; }
#undef PG8_LDA
#undef PG8_LDB
#undef PG8_MMA
#define PG8_LDA(dst, b, h) do { _Pragma("unroll") for (int m = 0; m < 4; ++m) { \
        if constexpr (P::FP8) dst##8[m] = __builtin_shufflevector(*(const LAS v4i_t*)(lds + PG8_SA(b, h) + aoffK[0] + m * 2048), *(const LAS v4i_t*)(lds + PG8_SA(b, h) + aoffK[1] + m * 2048), 0, 1, 2, 3, 4, 5, 6, 7); \
        else { _Pragma("unroll") for (int k = 0; k < 2; ++k) dst[m][k] = *(const LAS bf16x8*)(lds + PG8_SA(b, h) + aoffK[k] + m * 2048); } } } while (0)
#define PG8_LDB(dst, b, h) do { _Pragma("unroll") for (int n = 0; n < 2; ++n) { \
        if constexpr (P::FP8) dst##8[n] = __builtin_shufflevector(*(const LAS v4i_t*)(lds + PG8_SB(b, h) + boffK[0] + n * 2048), *(const LAS v4i_t*)(lds + PG8_SB(b, h) + boffK[1] + n * 2048), 0, 1, 2, 3, 4, 5, 6, 7); \
        else { _Pragma("unroll") for (int k = 0; k < 2; ++k) dst[n][k] = *(const LAS bf16x8*)(lds + PG8_SB(b, h) + boffK[k] + n * 2048); } } } while (0)
#define PG8_MMA(ai, bj, At, Bt) do { if constexpr (P::FP8) __builtin_amdgcn_sched_barrier(0); __builtin_amdgcn_s_setprio(1); _Pragma("unroll") for (int m = 0; m < 4; ++m) _Pragma("unroll") for (int n = 0; n < 2; ++n) { \
        if constexpr (P::FP8) acc[ai][bj][m][n] = __builtin_amdgcn_mfma_scale_f32_16x16x128_f8f6f4(Bt##8[n], At##8[m], acc[ai][bj][m][n], 0, 0, 0, 127, 0, 127); \
        else { _Pragma("unroll") for (int k = 0; k < 2; ++k) acc[ai][bj][m][n] = __builtin_amdgcn_mfma_f32_16x16x32_bf16(Bt[n][k], At[m][k], acc[ai][bj][m][n], 0, 0, 0); } } \
        if constexpr (P::FP8) { _Pragma("unroll") for (int m = 0; m < 4; ++m) _Pragma("unroll") for (int n = 0; n < 2; ++n) asm volatile("" : "+v"(acc[ai][bj][m][n])); } \
        __builtin_amdgcn_s_setprio(0); if constexpr (P::FP8) __builtin_amdgcn_sched_barrier(0); } while (0)
#define PG8_STAGE_A(bufoff, gbase, OFF, h) do { _Pragma("unroll") for (int _i = 0; _i < 2; ++_i) \
        __builtin_amdgcn_global_load_lds((const unsigned*)((const char*)(gbase) + (OFF)[2 * (h) + _i]), (LAS unsigned*)(lds + (bufoff) + ldsw + _i * 8192), 16, 0, 0); } while (0)
#define PG8_STAGE_B(bufoff, gbase) do { _Pragma("unroll") for (int _i = 0; _i < 2; ++_i) \
        __builtin_amdgcn_global_load_lds((const unsigned*)((const char*)(gbase) + offB[_i]), (LAS unsigned*)(lds + (bufoff) + ldsw + _i * 8192), 16, 0, 0); } while (0)
#define PG8_WAIT_V(n) asm volatile("s_waitcnt vmcnt(" #n ")" ::: "memory")
#define PG8_WAIT_L(n) asm volatile("s_waitcnt lgkmcnt(" #n ")" ::: "memory")
#define PG8_BAR __builtin_amdgcn_s_barrier()
#define PG8_SCHED __builtin_amdgcn_sched_barrier(0)
    Unit cur, nxt; int ui = 0; int pend = -1;
    if (!S.next(0, cur)) return;
    f32x4 acc[2][2][4][2];
#pragma unroll
    for (int a = 0; a < 2; ++a)
#pragma unroll
        for (int b = 0; b < 2; ++b)
#pragma unroll
            for (int m = 0; m < 4; ++m)
#pragma unroll
                for (int n = 0; n < 2; ++n) acc[a][b][m][n] = (f32x4){0.f, 0.f, 0.f, 0.f};
    bf16x8 At[4][2], B0[2][2], B1[2][2];
    v8i_t At8[4], B08[2], B18[2];
    unsigned offC[4], offN[4];
    S.aoff(cur, R0, C0, offC);
    const char* cA = cur.A; const char* cB = cur.B;
    if constexpr (P::HAS_READY) S.a_ready(cur);
    PG8_STAGE_B(PG8_SB(0, 0), cB); PG8_STAGE_B(PG8_SB(0, 1), cB + bhalf); PG8_STAGE_A(PG8_SA(0, 0), cA, offC, 0); PG8_STAGE_A(PG8_SA(0, 1), cA, offC, 1);
    if (wr == 1) PG8_BAR;
    PG8_WAIT_V(2); PG8_BAR;
    PG8_STAGE_B(PG8_SB(1, 0), cB + kstep); PG8_STAGE_A(PG8_SA(1, 0), cA + kstep, offC, 0); PG8_STAGE_B(PG8_SB(1, 1), cB + bhalf + kstep);
    PG8_WAIT_V(6); PG8_BAR;
    for (;;) {
        const bool has_next = S.next(ui + 1, nxt);
        if (has_next) S.aoff(nxt, R0, C0, offN);
        else {
#pragma unroll
            for (int q = 0; q < 4; ++q) offN[q] = offC[q];
        }
        const char* nA = has_next ? nxt.A : cA; const char* nB = has_next ? nxt.B : cB;
        for (int t = 0; t < nt; t += 2) {
            const bool last = (t == nt - 2);
            const bool sf = P::SEAM_OPT && (ui > 0) && (t == 0);
            if constexpr (P::HAS_READY) { if (last && has_next) S.a_ready(nxt); }
            const char* a1 = cA + (size_t)((t + 1) % nt1) * kstep;
            const char* a2 = last ? nA : cA + (size_t)((t + 2) % nt1) * kstep; const char* b2 = last ? nB : cB + (size_t)((t + 2) % nt1) * kstep;
            const char* a3 = a2 + kstep; const char* b3 = b2 + kstep;
            unsigned o2[4];
#pragma unroll
            for (int q = 0; q < 4; ++q) o2[q] = last ? offN[q] : offC[q];
            PG8_LDB(B0, 0, 0); PG8_LDB(B1, 0, 1); PG8_SCHED; PG8_LDA(At, 0, 0); if (!sf) { PG8_STAGE_A(PG8_SA(1, 1), a1, offC, 1); PG8_WAIT_V(8); }
            PG8_WAIT_L(0); PG8_BAR; PG8_MMA(0, 0, At, B0); PG8_MMA(0, 1, At, B1); PG8_BAR; PG8_SCHED;
            PG8_LDA(At, 0, 1); PG8_STAGE_B(PG8_SB(0, 0), b2); PG8_STAGE_B(PG8_SB(0, 1), b2 + bhalf); PG8_STAGE_A(PG8_SA(0, 0), a2, o2, 0);
            if (!sf) PG8_WAIT_V(8); PG8_WAIT_L(0); PG8_BAR; PG8_MMA(1, 0, At, B0); PG8_MMA(1, 1, At, B1); PG8_BAR; PG8_SCHED;
            PG8_LDB(B0, 1, 0); PG8_LDB(B1, 1, 1); PG8_SCHED; PG8_LDA(At, 1, 0); PG8_STAGE_A(PG8_SA(0, 1), a2, o2, 1);
            if (!sf) PG8_WAIT_V(8); PG8_WAIT_L(0); PG8_BAR; PG8_MMA(0, 0, At, B0); PG8_MMA(0, 1, At, B1); PG8_BAR; PG8_SCHED;
            PG8_LDA(At, 1, 1); PG8_STAGE_B(PG8_SB(1, 0), b3); PG8_STAGE_B(PG8_SB(1, 1), b3 + bhalf); PG8_STAGE_A(PG8_SA(1, 0), a3, o2, 0);
            if (!sf) PG8_WAIT_V(8); PG8_WAIT_L(0); PG8_BAR; PG8_MMA(1, 0, At, B0); PG8_MMA(1, 1, At, B1); PG8_BAR; PG8_SCHED;
        }
        if constexpr (P::SEAM_OPT) PG8_STAGE_A(PG8_SA(1, 1), nA + kstep, offN, 1);
        if (wr == 0) PG8_BAR;
        if constexpr (P::SEAM_OPT) { PG8_WAIT_V(0);
            S.flush(pend); pend = -1; }
        if (KR != 1) {
#pragma unroll
            for (int a = 0; a < 2; ++a)
#pragma unroll
                for (int b = 0; b < 2; ++b)
#pragma unroll
                    for (int m = 0; m < 4; ++m)
#pragma unroll
                        for (int n = 0; n < 2; ++n) acc[a][b][m][n] = acc[a][b][m][n] * (1.0f / KR);
        }
        pend = S.epi(acc, cur, wr, wc, fr, fq);
        if constexpr (!P::SEAM_OPT) { if (pend >= 0) { PG8_WAIT_V(0); S.flush(pend); pend = -1; } }
        if (!has_next) break;
#pragma unroll
        for (int a = 0; a < 2; ++a)
#pragma unroll
            for (int b = 0; b < 2; ++b)
#pragma unroll
                for (int m = 0; m < 4; ++m)
#pragma unroll
                    for (int n = 0; n < 2; ++n) acc[a][b][m][n] = (f32x4){0.f, 0.f, 0.f, 0.f};
        cur = nxt; cA = nA; cB = nB; ++ui;
#pragma unroll
        for (int q = 0; q < 4; ++q) offC[q] = offN[q];
        if (wr == 1) PG8_BAR;
    }
    PG8_WAIT_V(0);
    S.flush(pend);
    PG8_BAR;
#undef PG8_STAGE_A
#undef PG8_STAGE_B
#undef PG8_WAIT_V
#undef PG8_WAIT_L
#undef PG8_BAR
#undef PG8_SCHED
}
}

struct Frame {
    LAS unsigned char* lds;
    volatile LAS unsigned* MISC;
    unsigned* ctl;
    int tid, lane, wave, vcu, G;
    unsigned char* ws;
    float* out;
};
typedef const float* cfptr_t;
__device__ __forceinline__ const float* inptr(int i) {
    const __attribute__((address_space(4))) cfptr_t* ka = (const __attribute__((address_space(4))) cfptr_t*)__builtin_amdgcn_kernarg_segment_ptr();
    asm volatile("" : "+s"(ka));
    const GAS float* g = (const GAS float*)ka[i];
    return (const float*)g;
}
#define WSP(F, off, type) ((type*)((F).ws + (off)))

template <class RowMap>
__device__ __forceinline__ void transpose_tile(const float* W, int K, int N, bf16_t* WT, LAS unsigned char* scr, int item, int lane, const RowMap& rm) {
    const int nblk = N / 64, kb = item / nblk, nb = item % nblk, k0 = 64 * kb, n0 = 64 * nb;
    const int kg = lane & 3, ng = lane >> 2;
    f32x4 v[4][4];
#pragma unroll
    for (int r = 0; r < 4; ++r)
#pragma unroll
        for (int i = 0; i < 4; ++i) v[r][i] = __builtin_nontemporal_load((const f32x4*)(W + (size_t)(k0 + 16 * r + 4 * kg + i) * N + n0 + 4 * ng));
#pragma unroll
    for (int r = 0; r < 4; ++r)
#pragma unroll
        for (int j = 0; j < 4; ++j)
            *(LAS u32x2*)(scr + (4 * ng + j) * 144 + (16 * r + 4 * kg) * 2) = (u32x2){cvt_pk_bf16(v[r][0][j], v[r][1][j]), cvt_pk_bf16(v[r][2][j], v[r][3][j])};
    asm volatile("s_waitcnt lgkmcnt(0)" ::: "memory");
    const int c = lane & 7;
#pragma unroll
    for (int q = 0; q < 8; ++q) { const int n = (lane >> 3) + 8 * q; const u32x4 o = *(const LAS u32x4*)(scr + n * 144 + c * 16); __builtin_nontemporal_store(o, (u32x4*)(WT + (size_t)rm(n0 + n) * K + k0 + 8 * c)); }
    asm volatile("s_waitcnt lgkmcnt(0)" ::: "memory");
}
template <class RowMap>
__device__ __forceinline__ void transpose_tile8(const float* W, int K, int N, unsigned char* WT, LAS unsigned char* scr, int item, int lane, const RowMap& rm) {
    const int nblk = N / 64, kb = item / nblk, nb = item % nblk, k0 = 128 * kb, n0 = 64 * nb;
    const int kg = lane & 3, ng = lane >> 2;
#pragma unroll
    for (int hb = 0; hb < 2; ++hb) {
        f32x4 v[4][4];
#pragma unroll
        for (int r = 0; r < 4; ++r)
#pragma unroll
            for (int i = 0; i < 4; ++i) v[r][i] = __builtin_nontemporal_load((const f32x4*)(W + (size_t)(k0 + 64 * hb + 16 * r + 4 * kg + i) * N + n0 + 4 * ng));
#pragma unroll
        for (int r = 0; r < 4; ++r)
#pragma unroll
            for (int j = 0; j < 4; ++j)
                *(LAS unsigned*)(scr + (4 * ng + j) * 144 + 64 * hb + 16 * r + 4 * kg) = pack_fp8x4(v[r][0][j] * W8_SCALE, v[r][1][j] * W8_SCALE, v[r][2][j] * W8_SCALE, v[r][3][j] * W8_SCALE);
    }
    asm volatile("s_waitcnt lgkmcnt(0)" ::: "memory");
    const int c = lane & 7;
#pragma unroll
    for (int q = 0; q < 8; ++q) { const int n = (lane >> 3) + 8 * q; const u32x4 o = *(const LAS u32x4*)(scr + n * 144 + c * 16); __builtin_nontemporal_store(o, (u32x4*)(WT + (size_t)rm(n0 + n) * K + k0 + 16 * c)); }
    asm volatile("s_waitcnt lgkmcnt(0)" ::: "memory");
}
struct RmId { __device__ __forceinline__ int operator()(int n) const { return n; } };
struct RmWin { __device__ __forceinline__ int operator()(int n) const {
        const int s = n >> 9; if (s != 4 && s != 5) return n;
        const int d = n & 127, dd = d & 63; const int p = 8 * (dd >> 2) + (dd & 3) + ((d >> 6) << 2); return n - d + p; } };
struct RmGu { __device__ __forceinline__ int operator()(int n) const { const int half = n >> 10, j = (n & 1023) >> 7, i = n & 127; return 256 * j + 128 * half + i; } };

__device__ __forceinline__ void p0_prologue(Frame& F) {
    const int tid = F.tid;
    {
        LAS float* red = (LAS float*)F.lds;
        const float* c = inptr(1);
        for (int u = F.vcu; u < 192; u += F.G) {
            const int l = u / 96, cg = u % 96, kq = tid >> 4, cq = tid & 15;
            const float* W = inptr(2) + (size_t)l * D * 6 * D + cg * 64 + cq * 4;
            f32x4 a = {0.f, 0.f, 0.f, 0.f};
#pragma unroll 8
            for (int j = 0; j < 32; ++j) { const int k = kq + 32 * j; const float cv = siluf_(c[k]); const f32x4 w = *(const f32x4*)(W + (size_t)k * 6 * D); a += w * cv; }
            __syncthreads();
            *(LAS f32x4*)(red + kq * 64 + cq * 4) = a;
            __syncthreads();
            if (tid < 64) { float s = 0.f;
#pragma unroll 8
                for (int k = 0; k < 32; ++k) s += red[k * 64 + tid];
                const int col = cg * 64 + tid;
                WSP(F, WS_MOD, float)[l * 6 * D + col] = s + inptr(3)[l * 6 * D + col]; }
        }
        __syncthreads();
    }
    if (F.vcu == 0) { const float* hb = inptr(5); const float a = hb[tid], b = hb[512 + tid]; WSP(F, WS_LB, float)[tid] = 1.0f / (1.0f + __expf(b - a)); }
    {
        bf16_t* rt = WSP(F, WS_RT, bf16_t); const float* wr = inptr(12);
        for (int idx = F.vcu * NTH + tid; idx < 2 * D * NE; idx += F.G * NTH) {
            const int l = idx >> 15, rem = idx & 32767, c = rem >> 5, e = rem & 31;
            const float w = wr[idx]; const unsigned hi = cvt_pk_bf16(w, 0.f) & 0xffffu; const float res = w - bflo(hi);
            rt[((size_t)(l * 2 + 0) * 32 + e) * D + c] = (bf16_t)hi; rt[((size_t)(l * 2 + 1) * 32 + e) * D + c] = (bf16_t)(cvt_pk_bf16(res, 0.f) & 0xffffu);
        }
    }
    {
        f32x2* rope = WSP(F, WS_ROPE, f32x2);
        for (int idx = F.vcu * NTH + tid; idx < T * 64; idx += F.G * NTH) {
            const int t = idx >> 6, d = idx & 63;
            const float inv = exp2f(-(float)d * (13.287712379549449f / 64.0f));
            const float ang = (float)t * inv;
            const double a = (double)ang; const double n = __builtin_rint(a * 0.15915494309189535); const double r = __builtin_fma(-n, 6.283185307179586, a);
            const float rf = (float)r;
            rope[idx] = (f32x2){__cosf(rf), __sinf(rf)};
        }
    }
    {
        LAS unsigned char* scr = F.lds + F.wave * 16384;
        const int gw = F.vcu * NWAVES + F.wave, NGW = F.G * NWAVES;
        constexpr int I_IN = 16 * 64, I_OUT = 16 * 16, I_POOL = 4 * 4 * 4;
        constexpr int NL8 = ((FP8_LAYERS & 1) ? 1 : 0) + ((FP8_LAYERS & 2) ? 1 : 0), NL16 = 2 - NL8;
        constexpr int S_GU = 32 * 8 * 32, S_DN = 32 * 8 * 16;
        constexpr int T_GU = 32 * 16 * 32, T_DN = 32 * 16 * 16;
        constexpr int N8 = NL8 * (S_GU + S_DN), N16 = NL16 * (T_GU + T_DN);
        constexpr int NITEMS = N8 + I_IN + I_OUT + I_POOL + N16;
        for (int it = gw; it < NITEMS; it += NGW) {
            int r = it;
            if (r < N8) {
                const int li = r / (S_GU + S_DN), layer = (NL8 == 2) ? li : ((FP8_LAYERS & 1) ? 0 : 1); r -= li * (S_GU + S_DN);
                if (r < S_GU) { const int m = layer * 32 + r / 256; transpose_tile8(inptr(14) + (size_t)m * D * 2048, D, 2048, (unsigned char*)(WSP(F, WS_WGUT, bf16_t) + (size_t)layer * NE * 2048 * D) + (size_t)(m & 31) * 2048 * D, scr, r % 256, F.lane, RmGu()); }
                else { r -= S_GU; const int m = layer * 32 + r / 128; transpose_tile8(inptr(16) + (size_t)m * D * D, D, D, (unsigned char*)(WSP(F, WS_WDNT, bf16_t) + (size_t)layer * NE * D * D) + (size_t)(m & 31) * D * D, scr, r % 128, F.lane, RmId()); }
                continue;
            }
            r -= N8;
            if (r < I_IN) { transpose_tile(inptr(4), D, INW, WSP(F, WS_WINT, bf16_t), scr, r, F.lane, RmWin()); continue; } r -= I_IN;
            if (r < I_OUT) { transpose_tile(inptr(8), D, D, WSP(F, WS_WOUTT, bf16_t), scr, r, F.lane, RmId()); continue; } r -= I_OUT;
            if (r < I_POOL) { const int g = r / 16; transpose_tile(inptr(9) + (size_t)g * 65536, 256, 256, WSP(F, WS_POOLT, bf16_t) + (size_t)g * 65536, scr, r % 16, F.lane, RmId()); continue; } r -= I_POOL;
            if (NL16 > 0) {
                const int li = r / (T_GU + T_DN), layer = (NL16 == 2) ? li : ((FP8_LAYERS & 1) ? 1 : 0); r -= li * (T_GU + T_DN);
                if (r < T_GU) { const int m = layer * 32 + r / 512; transpose_tile(inptr(14) + (size_t)m * D * 2048, D, 2048, WSP(F, WS_WGUT, bf16_t) + (size_t)m * 2048 * D, scr, r % 512, F.lane, RmGu()); }
                else { r -= T_GU; const int m = layer * 32 + r / 256; transpose_tile(inptr(16) + (size_t)m * D * D, D, D, WSP(F, WS_WDNT, bf16_t) + (size_t)m * D * D, scr, r % 256, F.lane, RmId()); }
            }
        }
    }
}

__device__ __forceinline__ void p1_norm_in(Frame& F) {
    const float* mod = WSP(F, WS_MOD, float);
    f32x4 sh[4], sc[4];
#pragma unroll
    for (int j = 0; j < 4; ++j) { sh[j] = *(const f32x4*)(mod + 0 * D + 4 * F.lane + 256 * j); sc[j] = *(const f32x4*)(mod + 1 * D + 4 * F.lane + 256 * j) + 1.0f; }
    const int gw = F.vcu * NWAVES + F.wave, NGW = F.G * NWAVES;
    for (int row = gw; row < T; row += NGW) {
        const f32x4* xr = (const f32x4*)(inptr(0) + (size_t)row * D) + F.lane;
        f32x4 v[4]; float s = 0.f;
#pragma unroll
        for (int j = 0; j < 4; ++j) { v[j] = xr[64 * j]; s += (v[j].x * v[j].x + v[j].y * v[j].y) + (v[j].z * v[j].z + v[j].w * v[j].w); }
        const float rstd = rsqrtf(wave_sum(s) * (1.f / D) + EPS);
        u32x2* o = (u32x2*)(WSP(F, WS_HN, bf16_t) + (size_t)row * D) + F.lane;
#pragma unroll
        for (int j = 0; j < 4; ++j) { const f32x4 h = v[j] * rstd * sc[j] + sh[j]; o[64 * j] = (u32x2){cvt_pk_bf16(h.x, h.y), cvt_pk_bf16(h.z, h.w)}; }
    }
}

using pg8::Unit;
typedef f32x4 AccT[2][2][4][2];

struct GemmBase {
    static constexpr bool SEAM_OPT = false;
    __device__ __forceinline__ void flush(int) const {}
    static constexpr bool HAS_READY = false;
    static constexpr bool FP8 = false;
    int G, vcu;
    __device__ __forceinline__ void aoff_lin(int R0, int C0, unsigned lda_bytes, unsigned (&off)[4]) const {
#pragma unroll
        for (int q = 0; q < 4; ++q) off[q] = (unsigned)(R0 + 64 * (q & 1) + 128 * (q >> 1)) * lda_bytes + (unsigned)C0 * 2u;
    }
};

struct PolWin : GemmBase {
    static constexpr int KREP = KREP_WIN;
    const bf16_t* A; const bf16_t* Bt; bf16_t* qkvg; _Float16* gbuf; const float* lb; const f32x2* rope;
    __device__ __forceinline__ int nt() const { return D / 64; }
    __device__ __forceinline__ unsigned ldb_bytes() const { return D * 2; }
    __device__ __forceinline__ bool next(int i, Unit& u) const {
        const int V = i * G + vcu; if (V >= 64 * 16) return false;
        u.p0 = V >> 4; u.p1 = V & 15; u.A = (const char*)(A + (size_t)u.p0 * 256 * D); u.B = (const char*)(Bt + (size_t)u.p1 * 256 * D); return true; }
    __device__ __forceinline__ void aoff(const Unit&, int R0, int C0, unsigned (&off)[4]) const { aoff_lin(R0, C0, D * 2, off); }
    __device__ __forceinline__ int epi(const AccT& acc, const Unit& u, int wr, int wc, int fr, int fq) const {
        const int pm = u.p0, pn = u.p1, s = pn >> 1;
        const int row0 = pm * 256 + wr * 64 + fr;
        const int o0 = (pn & 1) * 256 + wc * 32 + 8 * fq;
        const int dbase = (s & 3) * 1024 + (s >> 2) * 512;
        bf16_t* obase = qkvg + (size_t)row0 * INW + dbase;
        if (s == 4 || s == 5) {
            const int d0 = 4 * ((o0 & 127) >> 3);
            const float qs = (s == 5) ? 0.08838834764831845f : 1.0f;
#pragma unroll
            for (int ah = 0; ah < 2; ++ah) {
                f32x4 rc[4][2];
#pragma unroll
                for (int m = 0; m < 4; ++m) { const f32x4* rp = (const f32x4*)(rope + (size_t)(row0 + ah * 128 + m * 16) * 64 + d0); rc[m][0] = rp[0]; rc[m][1] = rp[1]; }
#pragma unroll
                for (int m = 0; m < 4; ++m) {
                    const f32x4 cs = {rc[m][0].x * qs, rc[m][0].z * qs, rc[m][1].x * qs, rc[m][1].z * qs}, sn = {rc[m][0].y * qs, rc[m][0].w * qs, rc[m][1].y * qs, rc[m][1].w * qs};
                    bf16_t* orow = obase + (size_t)(ah * 128 + m * 16) * INW;
#pragma unroll
                    for (int bj = 0; bj < 2; ++bj) {
                        const int hd = (o0 + bj * 128) & ~127;
                        const f32x4 v0 = acc[ah][bj][m][0], v1 = acc[ah][bj][m][1];
                        const f32x4 o1 = v0 * cs - v1 * sn, o2 = v0 * sn + v1 * cs;
                        *(u32x2*)(orow + hd + d0) = (u32x2){cvt_pk_bf16(o1.x, o1.y), cvt_pk_bf16(o1.z, o1.w)};
                        *(u32x2*)(orow + hd + d0 + 64) = (u32x2){cvt_pk_bf16(o2.x, o2.y), cvt_pk_bf16(o2.z, o2.w)};
                    }
                }
            }
        } else if (s == 1) {
            f32x4 l[2][2];
#pragma unroll
            for (int bj = 0; bj < 2; ++bj) { l[bj][0] = *(const f32x4*)(lb + o0 + bj * 128); l[bj][1] = *(const f32x4*)(lb + o0 + bj * 128 + 4); }
#pragma unroll
            for (int am = 0; am < 8; ++am) {
                const size_t ro = (size_t)((am >> 2) * 128 + (am & 3) * 16);
#pragma unroll
                for (int bj = 0; bj < 2; ++bj) {
                    const int o = o0 + bj * 128;
                    f32x4 v0 = acc[am >> 2][bj][am & 3][0], v1 = acc[am >> 2][bj][am & 3][1], g0, g1;
#pragma unroll
                    for (int j = 0; j < 4; ++j) {
                        const float f0 = l[bj][0][j] + (1.0f - l[bj][0][j]) * sigmoidf_(v0[j]), f1 = l[bj][1][j] + (1.0f - l[bj][1][j]) * sigmoidf_(v1[j]);
                        g0[j] = __logf(f0); g1[j] = __logf(f1); v0[j] = 1.0f - f0; v1[j] = 1.0f - f1; }
                    *(h16x8*)(gbuf + ((size_t)row0 + ro) * 512 + o) = (h16x8){(_Float16)g0[0], (_Float16)g0[1], (_Float16)g0[2], (_Float16)g0[3], (_Float16)g1[0], (_Float16)g1[1], (_Float16)g1[2], (_Float16)g1[3]};
                    u32x4 w; w.x = cvt_pk_bf16(v0[0], v0[1]); w.y = cvt_pk_bf16(v0[2], v0[3]); w.z = cvt_pk_bf16(v1[0], v1[1]); w.w = cvt_pk_bf16(v1[2], v1[3]);
                    *(u32x4*)(obase + ro * INW + o) = w;
                }
            }
        } else {
            const bool act = (s == 0 || s == 3 || s == 7);
#pragma unroll
            for (int am = 0; am < 8; ++am) {
                const size_t ro = (size_t)((am >> 2) * 128 + (am & 3) * 16);
#pragma unroll
                for (int bj = 0; bj < 2; ++bj) {
                    f32x4 v0 = acc[am >> 2][bj][am & 3][0], v1 = acc[am >> 2][bj][am & 3][1];
                    if (act) {
#pragma unroll
                        for (int j = 0; j < 4; ++j) { v0[j] = siluf_(v0[j]); v1[j] = siluf_(v1[j]); }
                    }
                    u32x4 w; w.x = cvt_pk_bf16(v0[0], v0[1]); w.y = cvt_pk_bf16(v0[2], v0[3]); w.z = cvt_pk_bf16(v1[0], v1[1]); w.w = cvt_pk_bf16(v1[2], v1[3]);
                    *(u32x4*)(obase + ro * INW + o0 + bj * 128) = w;
                }
            }
        }
            return -1;
    }
};

template <bool R16>
struct PolRes : GemmBase {
    static constexpr int KREP = KREP_RES;
    const bf16_t* A; const bf16_t* Bt; const float* resid; const bf16_t* resid16; bf16_t* outp; const float* gate; const float* bias; const float* scale;
    int K, lda, nN, kcol;
    __device__ __forceinline__ int nt() const { return K / 64; }
    __device__ __forceinline__ unsigned ldb_bytes() const { return (unsigned)K * 2u; }
    __device__ __forceinline__ bool next(int i, Unit& u) const {
        const int V = i * G + vcu; if (V >= 64 * nN) return false;
        u.p0 = V / nN; u.p1 = V % nN; u.A = (const char*)(A + (size_t)u.p0 * 256 * lda + (size_t)u.p1 * kcol); u.B = (const char*)(Bt + (size_t)u.p1 * 256 * K); return true; }
    __device__ __forceinline__ void aoff(const Unit&, int R0, int C0, unsigned (&off)[4]) const { aoff_lin(R0, C0, (unsigned)lda * 2u, off); }
    __device__ __forceinline__ int epi(const AccT& acc, const Unit& u, int wr, int wc, int fr, int fq) const {
        const int row0 = u.p0 * 256 + wr * 64 + fr, col0 = u.p1 * 256 + wc * 32 + 8 * fq;
#pragma unroll
        for (int bj = 0; bj < 2; ++bj) {
            const int c = col0 + bj * 128;
            const f32x4 g0 = *(const f32x4*)(gate + c), g1 = *(const f32x4*)(gate + c + 4);
            f32x4 b0 = {0.f, 0.f, 0.f, 0.f}, b1 = b0, s0 = {1.f, 1.f, 1.f, 1.f}, s1 = s0;
            if (bias) { b0 = *(const f32x4*)(bias + c); b1 = *(const f32x4*)(bias + c + 4); s0 = *(const f32x4*)(scale + c); s1 = *(const f32x4*)(scale + c + 4); }
#pragma unroll
            for (int ah = 0; ah < 2; ++ah) {
                f32x4 r[4][2];
                if constexpr (!R16) {
#pragma unroll
                    for (int m = 0; m < 4; ++m) { const size_t idx = (size_t)(row0 + ah * 128 + m * 16) * D + c; r[m][0] = *(const f32x4*)(resid + idx); r[m][1] = *(const f32x4*)(resid + idx + 4); }
                } else {
                    u32x4 q[4];
#pragma unroll
                    for (int m = 0; m < 4; ++m) q[m] = *(const u32x4*)(resid16 + (size_t)(row0 + ah * 128 + m * 16) * D + c);
#pragma unroll
                    for (int m = 0; m < 4; ++m) { r[m][0] = (f32x4){bflo(q[m].x), bfhi(q[m].x), bflo(q[m].y), bfhi(q[m].y)}; r[m][1] = (f32x4){bflo(q[m].z), bfhi(q[m].z), bflo(q[m].w), bfhi(q[m].w)}; }
                }
#pragma unroll
                for (int m = 0; m < 4; ++m) {
                    const size_t idx = (size_t)(row0 + ah * 128 + m * 16) * D + c;
                    const f32x4 o0 = r[m][0] + g0 * ((acc[ah][bj][m][0] + b0) * s0), o1 = r[m][1] + g1 * ((acc[ah][bj][m][1] + b1) * s1);
                    *(u32x4*)(outp + idx) = (u32x4){cvt_pk_bf16(o0.x, o0.y), cvt_pk_bf16(o0.z, o0.w), cvt_pk_bf16(o1.x, o1.y), cvt_pk_bf16(o1.z, o1.w)};
                }
            }
        }
            return -1;
    }
};

constexpr int MI_TPRE = 16, MI_CNT = 64, MI_MT2E = 128;
__device__ __forceinline__ void expert_tables(Frame& F, int layer) {
    if (F.tid < 64) {
        const int lane = F.lane;
        int c = 0;
        if (lane < NE) { c = (int)__hip_atomic_load(F.ctl + CW_CNT + 64 * layer + lane, __ATOMIC_RELAXED, __HIP_MEMORY_SCOPE_AGENT); if (c > LIST_CAP) c = LIST_CAP; }
        const int nt_ = (c + 255) >> 8;
        int pre = nt_;
#pragma unroll
        for (int off = 1; off < 32; off <<= 1) { const int v = __shfl_up(pre, off); if (lane >= off) pre += v; }
        const int excl = pre - nt_;
        if (lane < NE) { F.MISC[MI_TPRE + lane] = excl; F.MISC[MI_CNT + lane] = c; for (int q = 0; q < nt_; ++q) F.MISC[MI_MT2E + excl + q] = lane; }
        if (lane == NE - 1) F.MISC[MI_TPRE + NE] = pre;
    }
    __syncthreads();
}
constexpr int UPA_OFF = 131072;
struct PolG1 : GemmBase {
    static constexpr int KREP = KREP_G1;
    volatile LAS unsigned* MISC; LAS unsigned char* upa; const bf16_t* hn; const bf16_t* wgut; const float* bgu; const int* lslot; bf16_t* act;
    __device__ __forceinline__ int nt() const { return D / 64; }
    __device__ __forceinline__ unsigned ldb_bytes() const { return D * 2; }
    __device__ __forceinline__ bool next(int i, Unit& u) const {
        const int V = i * G + vcu, MT = (int)MISC[MI_TPRE + NE]; if (V >= MT * 8 || i >= 10) return false;
        const int mt = V >> 3, nt_ = V & 7, e = (int)MISC[MI_MT2E + mt];
        u.p0 = e; u.p1 = mt - (int)MISC[MI_TPRE + e]; u.p2 = nt_; u.p3 = mt; u.ui = i;
        u.A = (const char*)hn; u.B = (const char*)(wgut + ((size_t)e * 2048 + (size_t)nt_ * 256) * D); return true; }
    __device__ __forceinline__ void fill(int tid) const {
#pragma unroll
        for (int k = 0; k < 5; ++k) {
            const int j = tid + NTH * k, i = j >> 8, r = j & 255; Unit u;
            if (next(i, u)) {
                const int cnt = (int)MISC[MI_CNT + u.p0], li = u.p1 * 256 + r;
                ((LAS int*)(upa + i * 2048))[r] = (li < cnt) ? (lslot[(size_t)u.p0 * LIST_CAP + li] >> 2) : 0;
                ((LAS float*)(upa + i * 2048 + 1024))[r] = bgu[(size_t)u.p0 * 2048 + (r >> 7) * 1024 + u.p2 * 128 + (r & 127)];
            }
        }
    }
    __device__ __forceinline__ void aoff(const Unit& u, int R0, int C0, unsigned (&off)[4]) const {
        const LAS int* tk = (const LAS int*)(upa + u.ui * 2048);
#pragma unroll
        for (int q = 0; q < 4; ++q) off[q] = (unsigned)tk[R0 + 64 * (q & 1) + 128 * (q >> 1)] * (D * 2u) + (unsigned)C0 * 2u;
    }
    __device__ __forceinline__ int epi(const AccT& acc, const Unit& u, int wr, int wc, int fr, int fq) const {
        const int cl = wc * 32 + 8 * fq;
        const LAS float* bg = (const LAS float*)(upa + u.ui * 2048 + 1024);
        const f32x4 bgl0 = *(const LAS f32x4*)(bg + cl), bgl1 = *(const LAS f32x4*)(bg + cl + 4), bln0 = *(const LAS f32x4*)(bg + 128 + cl), bln1 = *(const LAS f32x4*)(bg + 128 + cl + 4);
        bf16_t* base = act + ((size_t)u.p3 * 256 + wr * 64 + fr) * D + u.p2 * 128 + cl;
#pragma unroll
        for (int ai = 0; ai < 2; ++ai)
#pragma unroll
            for (int m = 0; m < 4; ++m) {
                f32x4 gl0 = acc[ai][0][m][0] + bgl0, gl1 = acc[ai][0][m][1] + bgl1, ln0 = acc[ai][1][m][0] + bln0, ln1 = acc[ai][1][m][1] + bln1;
                f32x4 a0, a1;
#pragma unroll
                for (int j = 0; j < 4; ++j) {
                    const float x0 = fminf(gl0[j], SW_LIMIT), x1 = fminf(gl1[j], SW_LIMIT);
                    const float y0 = fminf(fmaxf(ln0[j], -SW_LIMIT), SW_LIMIT), y1 = fminf(fmaxf(ln1[j], -SW_LIMIT), SW_LIMIT);
                    a0[j] = x0 * sigmoidf_(SW_ALPHA * x0) * (y0 + 1.0f); a1[j] = x1 * sigmoidf_(SW_ALPHA * x1) * (y1 + 1.0f); }
                u32x4 w; w.x = cvt_pk_bf16(a0[0], a0[1]); w.y = cvt_pk_bf16(a0[2], a0[3]); w.z = cvt_pk_bf16(a1[0], a1[1]); w.w = cvt_pk_bf16(a1[2], a1[3]);
                *(u32x4*)(base + (size_t)(ai * 128 + m * 16) * D) = w;
            }
            return -1;
    }
};
struct PolG2 : GemmBase {
    static constexpr int KREP = KREP_G2;
    volatile LAS unsigned* MISC; LAS unsigned char* upa; const bf16_t* act; const bf16_t* wdnt; const float* bdn; const int* lslot; const float* lw; bf16_t* yslot;
    __device__ __forceinline__ int nt() const { return D / 64; }
    __device__ __forceinline__ unsigned ldb_bytes() const { return D * 2; }
    __device__ __forceinline__ bool next(int i, Unit& u) const {
        const int V = i * G + vcu, MT = (int)MISC[MI_TPRE + NE]; if (V >= MT * 4 || i >= 6) return false;
        const int mt = V >> 2, nt_ = V & 3, e = (int)MISC[MI_MT2E + mt];
        u.p0 = e; u.p1 = mt - (int)MISC[MI_TPRE + e]; u.p2 = nt_; u.p3 = mt; u.ui = i;
        u.A = (const char*)(act + (size_t)mt * 256 * D); u.B = (const char*)(wdnt + ((size_t)e * D + (size_t)nt_ * 256) * D); return true; }
    __device__ __forceinline__ void fill(int tid) const {
#pragma unroll
        for (int k = 0; k < 3; ++k) {
            const int j = tid + NTH * k, i = j >> 8, r = j & 255; Unit u;
            if (next(i, u)) {
                const int cnt = (int)MISC[MI_CNT + u.p0], li = u.p1 * 256 + r; const bool ok = li < cnt;
                ((LAS int*)(upa + i * 3072))[r] = ok ? lslot[(size_t)u.p0 * LIST_CAP + li] : -1;
                ((LAS float*)(upa + i * 3072 + 1024))[r] = ok ? lw[(size_t)u.p0 * LIST_CAP + li] : 0.f;
                ((LAS float*)(upa + i * 3072 + 2048))[r] = bdn[(size_t)u.p0 * D + u.p2 * 256 + r];
            }
        }
    }
    __device__ __forceinline__ void aoff(const Unit&, int R0, int C0, unsigned (&off)[4]) const { aoff_lin(R0, C0, D * 2, off); }
    __device__ __forceinline__ int epi(const AccT& acc, const Unit& u, int wr, int wc, int fr, int fq) const {
        const int cl = wc * 32 + 8 * fq;
        const LAS int* sl = (const LAS int*)(upa + u.ui * 3072); const LAS float* wl = (const LAS float*)(upa + u.ui * 3072 + 1024); const LAS float* bd = (const LAS float*)(upa + u.ui * 3072 + 2048);
        f32x4 b[2][2];
#pragma unroll
        for (int bj = 0; bj < 2; ++bj) { b[bj][0] = *(const LAS f32x4*)(bd + cl + bj * 128); b[bj][1] = *(const LAS f32x4*)(bd + cl + bj * 128 + 4); }
#pragma unroll
        for (int ai = 0; ai < 2; ++ai)
#pragma unroll
            for (int m = 0; m < 4; ++m) {
                const int rl = ai * 128 + wr * 64 + m * 16 + fr;
                const int slot = sl[rl]; const float w = wl[rl];
                if (slot >= 0) {
                    bf16_t* yr = yslot + (size_t)slot * D + u.p2 * 256 + cl;
#pragma unroll
                    for (int bj = 0; bj < 2; ++bj) {
                        const f32x4 v0 = (acc[ai][bj][m][0] + b[bj][0]) * w, v1 = (acc[ai][bj][m][1] + b[bj][1]) * w;
                        u32x4 o; o.x = cvt_pk_bf16(v0[0], v0[1]); o.y = cvt_pk_bf16(v0[2], v0[3]); o.z = cvt_pk_bf16(v1[0], v1[1]); o.w = cvt_pk_bf16(v1[2], v1[3]);
                        *(u32x4*)(yr + bj * 128) = o;
                    }
                }
            }
            return -1;
    }
};

typedef unsigned v4u_t __attribute__((ext_vector_type(4)));
template <bool F8>
struct PolMoE : GemmBase {
    static constexpr int KREP = 1;
    static constexpr bool HAS_READY = true;
    static constexpr bool FP8 = F8;
    static constexpr bool SEAM_OPT = true;
    static constexpr int EB = F8 ? 1 : 2;
    volatile LAS unsigned* MISC; LAS unsigned char* upa; const bf16_t* hn; const bf16_t* wgut; const float* bgu; const int* lslot; const float* lw; bf16_t* act;
    const bf16_t* wdnt; const float* bdn; bf16_t* yslot; unsigned* done; unsigned* tmo; __amdgpu_buffer_rsrc_t act_rsrc;
    __device__ __forceinline__ int nt() const { return D * EB / 128; }
    __device__ __forceinline__ unsigned ldb_bytes() const { return D * EB; }
    __device__ __forceinline__ bool next(int i, Unit& u) const {
        const int V = i * G + vcu, MT = (int)MISC[MI_TPRE + NE], N1 = MT * 8; if (i >= 14 || V >= MT * 12) return false;
        u.ui = i;
        if (V < N1) { const int mt = V >> 3, nt_ = V & 7, e = (int)MISC[MI_MT2E + mt];
            u.p0 = e; u.p1 = mt - (int)MISC[MI_TPRE + e]; u.p2 = nt_; u.p3 = mt;
            u.A = (const char*)hn; u.B = (const char*)wgut + ((size_t)e * 2048 + (size_t)nt_ * 256) * D * EB; }
        else { const int V2 = V - N1, mt = V2 >> 2, nt_ = V2 & 3, e = (int)MISC[MI_MT2E + mt];
            u.p0 = e; u.p1 = mt - (int)MISC[MI_TPRE + e]; u.p2 = nt_ | 8; u.p3 = mt;
            u.A = (const char*)act + (size_t)mt * 256 * D * EB; u.B = (const char*)wdnt + ((size_t)e * D + (size_t)nt_ * 256) * D * EB; }
        return true; }
    __device__ __forceinline__ void fill(int tid) const {
#pragma unroll
        for (int k = 0; k < 7; ++k) {
            const int j = tid + NTH * k, i = j >> 8, r = j & 255; Unit u;
            if (next(i, u)) {
                const int cnt = (int)MISC[MI_CNT + u.p0], li = u.p1 * 256 + r; const bool ok = li < cnt;
                if (!(u.p2 & 8)) {
                    ((LAS int*)(upa + i * 2048))[r] = ok ? (lslot[(size_t)u.p0 * LIST_CAP + li] >> 2) : 0;
                    ((LAS float*)(upa + i * 2048 + 1024))[r] = bgu[(size_t)u.p0 * 2048 + (r >> 7) * 1024 + u.p2 * 128 + (r & 127)];
                } else {
                    unsigned pk = 0xffff0000u;
                    if (ok) { const unsigned sl = (unsigned)lslot[(size_t)u.p0 * LIST_CAP + li]; const float w = lw[(size_t)u.p0 * LIST_CAP + li]; pk = (sl & 0xffffu) | (cvt_pk_bf16(0.f, w) & 0xffff0000u); }
                    ((LAS unsigned*)(upa + i * 2048))[r] = pk;
                    ((LAS float*)(upa + i * 2048 + 1024))[r] = bdn[(size_t)u.p0 * D + (u.p2 & 7) * 256 + r];
                }
            }
        }
    }
    __device__ __forceinline__ void aoff(const Unit& u, int R0, int C0, unsigned (&off)[4]) const {
        if (!(u.p2 & 8)) { const LAS int* tk = (const LAS int*)(upa + u.ui * 2048);
#pragma unroll
            for (int q = 0; q < 4; ++q) off[q] = (unsigned)tk[R0 + 64 * (q & 1) + 128 * (q >> 1)] * (unsigned)(D * EB) + (unsigned)C0 * 2u;
        } else aoff_lin(R0, C0, D * EB, off);
    }
    __device__ __forceinline__ void flush(int pend) const {
        if (pend >= 0 && (threadIdx.x & 63) == 0) (void)__hip_atomic_fetch_add(done + 64 * pend, 1u, __ATOMIC_RELAXED, __HIP_MEMORY_SCOPE_AGENT);
    }
    __device__ __forceinline__ void a_ready(const Unit& u) const {
        if (!(u.p2 & 8)) return;
        if (threadIdx.x < 64) {
            unsigned* w = done + 64 * u.p3; unsigned polls = 0;
            while ((unsigned)__builtin_amdgcn_readfirstlane(__hip_atomic_load(w, __ATOMIC_RELAXED, __HIP_MEMORY_SCOPE_AGENT)) < 64u) {
                __builtin_amdgcn_s_sleep(2);
                if ((++polls & 1023u) == 0u) { if (__builtin_amdgcn_readfirstlane(__hip_atomic_load(tmo, __ATOMIC_RELAXED, __HIP_MEMORY_SCOPE_AGENT)) != 0u) break;
                    if (polls > (1u << 22)) { if (threadIdx.x == 0) __hip_atomic_store(tmo, 1u, __ATOMIC_RELAXED, __HIP_MEMORY_SCOPE_AGENT); break; } }
            }
            __builtin_amdgcn_fence(__ATOMIC_ACQUIRE, "agent");
            asm volatile("s_waitcnt vmcnt(0)" ::: "memory");
        }
        asm volatile("" ::: "memory"); __builtin_amdgcn_s_barrier(); asm volatile("" ::: "memory");
    }
    __device__ __forceinline__ int epi(const AccT& acc, const Unit& u, int wr, int wc, int fr, int fq) const {
        const int cl = wc * 32 + 8 * fq;
        if (!(u.p2 & 8)) {
            const LAS float* bg = (const LAS float*)(upa + u.ui * 2048 + 1024);
            const f32x4 bgl0 = *(const LAS f32x4*)(bg + cl), bgl1 = *(const LAS f32x4*)(bg + cl + 4), bln0 = *(const LAS f32x4*)(bg + 128 + cl), bln1 = *(const LAS f32x4*)(bg + 128 + cl + 4);
            const unsigned boff = (unsigned)((((size_t)u.p3 * 256 + wr * 64 + fr) * D + u.p2 * 128 + cl) * EB);
            constexpr float ws = F8 ? (1.0f / W8_SCALE) : 1.0f;
#pragma unroll
            for (int ai = 0; ai < 2; ++ai)
#pragma unroll
                for (int m = 0; m < 4; ++m) {
                    f32x4 gl0 = acc[ai][0][m][0] * ws + bgl0, gl1 = acc[ai][0][m][1] * ws + bgl1, ln0 = acc[ai][1][m][0] * ws + bln0, ln1 = acc[ai][1][m][1] * ws + bln1;
                    f32x4 a0, a1;
#pragma unroll
                    for (int j = 0; j < 4; ++j) {
                        const float x0 = fminf(gl0[j], SW_LIMIT), x1 = fminf(gl1[j], SW_LIMIT);
                        const float y0 = fminf(fmaxf(ln0[j], -SW_LIMIT), SW_LIMIT), y1 = fminf(fmaxf(ln1[j], -SW_LIMIT), SW_LIMIT);
                        a0[j] = x0 * sigmoidf_(SW_ALPHA * x0) * (y0 + 1.0f); a1[j] = x1 * sigmoidf_(SW_ALPHA * x1) * (y1 + 1.0f); }
                    if constexpr (F8) { u32x2 w8 = {pack_fp8x4(a0[0], a0[1], a0[2], a0[3]), pack_fp8x4(a1[0], a1[1], a1[2], a1[3])};
                        __builtin_amdgcn_raw_buffer_store_b64(w8, act_rsrc, boff + (unsigned)((ai * 128 + m * 16) * D), 0,   16); }
                    else { v4u_t w; w.x = cvt_pk_bf16(a0[0], a0[1]); w.y = cvt_pk_bf16(a0[2], a0[3]); w.z = cvt_pk_bf16(a1[0], a1[1]); w.w = cvt_pk_bf16(a1[2], a1[3]);
                        __builtin_amdgcn_raw_buffer_store_b128(w, act_rsrc, boff + (unsigned)((ai * 128 + m * 16) * D * 2), 0,   16); }
                }
            return u.p3;
        } else {
            const LAS unsigned* sl = (const LAS unsigned*)(upa + u.ui * 2048); const LAS float* bd = (const LAS float*)(upa + u.ui * 2048 + 1024);
            f32x4 b[2][2];
#pragma unroll
            for (int bj = 0; bj < 2; ++bj) { b[bj][0] = *(const LAS f32x4*)(bd + cl + bj * 128); b[bj][1] = *(const LAS f32x4*)(bd + cl + bj * 128 + 4); }
#pragma unroll
            for (int ai = 0; ai < 2; ++ai)
#pragma unroll
                for (int m = 0; m < 4; ++m) {
                    const unsigned pk = sl[ai * 128 + wr * 64 + m * 16 + fr];
                    if ((pk >> 16) != 0xffffu) {
                        const float w = bfhi(pk); constexpr float ws = F8 ? (1.0f / W8_SCALE) : 1.0f;
                        bf16_t* yr = yslot + (size_t)(pk & 0xffffu) * D + (u.p2 & 7) * 256 + cl;
#pragma unroll
                        for (int bj = 0; bj < 2; ++bj) {
                            const f32x4 v0 = (acc[ai][bj][m][0] * ws + b[bj][0]) * w, v1 = (acc[ai][bj][m][1] * ws + b[bj][1]) * w;
                            u32x4 o; o.x = cvt_pk_bf16(v0[0], v0[1]); o.y = cvt_pk_bf16(v0[2], v0[3]); o.z = cvt_pk_bf16(v1[0], v1[1]); o.w = cvt_pk_bf16(v1[2], v1[3]);
                            *(u32x4*)(yr + bj * 128) = o;
                        }
                    }
                }
        }
            return -1;
    }
};

template <class P> __device__ __forceinline__ void run_gemm(Frame& F, const P& S) {
#if SIMPLE_GEMM
    pg8::gemm_simple<P>(F.lds, S);
#else
    pg8::gemm_pipe<P>(F.lds, S);
#endif
}

constexpr int LA_QA = 0, LA_QH = 17408, LA_KA = 34816, LA_VT = 52224, LA_AS = 70656, LA_ST = 79872, LA_QS = 114688, LA_PS = 118784;
constexpr int RS128 = 272, RS64 = 144;
__device__ __forceinline__ float ret_lg(int hh) { return __logf(1.0f - exp2f(-5.0f - (float)(hh - 4))); }
__device__ __forceinline__ u32x4 pack8(const float (&v)[8]) { return (u32x4){cvt_pk_bf16(v[0], v[1]), cvt_pk_bf16(v[2], v[3]), cvt_pk_bf16(v[4], v[5]), cvt_pk_bf16(v[6], v[7])}; }

__device__ __forceinline__ void la_cumsum(const float* gbuf, int hh, int t0, int d0, float (&b0)[8], float (&b1)[8]) {
    if (hh < 4) { float r0 = 0.f, r1 = 0.f;
#pragma unroll
        for (int i = 0; i < 8; ++i) { const f32x2 g = *(const f32x2*)(gbuf + (size_t)(t0 + i) * 512 + hh * 128 + d0); r0 += g.x; r1 += g.y; b0[i] = r0; b1[i] = r1; }
    } else { const float lg = ret_lg(hh);
#pragma unroll
        for (int i = 0; i < 8; ++i) { b0[i] = (float)(i + 1) * lg; b1[i] = b0[i]; }
    }
}

struct LaIn { f32x2 g[8]; unsigned qq[8], kk[8], vv[8]; u32x4 st[4]; u32x2 gt[4]; };
template <bool OUT>
__device__ __forceinline__ void la_load(LaIn& in, const bf16_t* qkvg, const _Float16* gbuf, const bf16_t* sprev, int unit, int oc, int d0, int tid) {
    const int hh = unit >> 8, n = unit & 255, t0 = n * 64 + oc * 8;
    if (hh < 4) {
#pragma unroll
        for (int i = 0; i < 8; ++i) { const h16x2 gh = *(const h16x2*)(gbuf + (size_t)(t0 + i) * 512 + hh * 128 + d0); in.g[i] = (f32x2){(float)gh.x, (float)gh.y}; }
    }
#pragma unroll
    for (int i = 0; i < 8; ++i) { const bf16_t* row = qkvg + (size_t)(t0 + i) * INW + hh * 128 + d0; if (OUT) in.qq[i] = *(const unsigned*)row; in.kk[i] = *(const unsigned*)(row + 1024); in.vv[i] = *(const unsigned*)(row + 2048); }
    if (OUT) {
        const bf16_t* sp = sprev + ((size_t)hh * 256 + n) * 16384;
#pragma unroll
        for (int j = 0; j < 4; ++j) { const int c = tid + NTH * j; in.st[j] = *(const u32x4*)(sp + (c >> 4) * 128 + (c & 15) * 8); }
        const int lane = tid & 63, fr = lane & 15, fq = lane >> 4, tt = oc >> 1, eh = oc & 1;
#pragma unroll
        for (int ei = 0; ei < 4; ++ei) in.gt[ei] = *(const u32x2*)(qkvg + (size_t)(n * 64 + 16 * tt + fr) * INW + 3072 + hh * 128 + 16 * (4 * eh + ei) + 4 * fq);
    }
}
__device__ __forceinline__ void la_cumsum_in(const LaIn& in, int hh, float (&b0)[8], float (&b1)[8]) {
    if (hh < 4) { float r0 = 0.f, r1 = 0.f;
#pragma unroll
        for (int i = 0; i < 8; ++i) { r0 += in.g[i].x; r1 += in.g[i].y; b0[i] = r0; b1[i] = r1; }
    } else { const float lg = ret_lg(hh);
#pragma unroll
        for (int i = 0; i < 8; ++i) { b0[i] = (float)(i + 1) * lg; b1[i] = b0[i]; }
    }
}

__device__ __forceinline__ void la_local_state(Frame& F) {
    const bf16_t* qkvg = WSP(F, WS_QKVG, bf16_t); const _Float16* gbuf = WSP(F, WS_GBUF, _Float16); bf16_t* kvt = WSP(F, WS_KVT, bf16_t); float* dec = WSP(F, WS_DEC, float);
    LAS unsigned char* lds = F.lds; LAS float* qs = (LAS float*)(lds + LA_QS);
    const int lane = F.lane, oc = F.wave, d0 = 2 * lane, fr = lane & 15, fq = lane >> 4;
    LaIn nx;
    if (F.vcu < 2048) la_load<false>(nx, qkvg, gbuf, nullptr, F.vcu, oc, d0, F.tid);
    for (int unit = F.vcu; unit < 2048; unit += F.G) {
        const int hh = unit >> 8, n = unit & 255;
        const LaIn in = nx;
        if (unit + F.G < 2048) la_load<false>(nx, qkvg, gbuf, nullptr, unit + F.G, oc, d0, F.tid);
        float b0[8], b1[8]; la_cumsum_in(in, hh, b0, b1);
        *(LAS f32x2*)(qs + oc * 128 + d0) = (f32x2){b0[7], b1[7]};
        const unsigned (&kk)[8] = in.kk; const unsigned (&vv)[8] = in.vv;
        __syncthreads();
        float base0 = 0.f, base1 = 0.f, tot0 = 0.f, tot1 = 0.f;
#pragma unroll
        for (int o = 0; o < 8; ++o) { const f32x2 q = *(const LAS f32x2*)(qs + o * 128 + d0); if (o < oc) { base0 += q.x; base1 += q.y; } tot0 += q.x; tot1 += q.y; }
        float a0[8], a1[8], c0[8], c1[8];
#pragma unroll
        for (int i = 0; i < 8; ++i) { a0[i] = bflo(kk[i]) * __expf(tot0 - base0 - b0[i]); a1[i] = bfhi(kk[i]) * __expf(tot1 - base1 - b1[i]); c0[i] = bflo(vv[i]); c1[i] = bfhi(vv[i]); }
        *(LAS u32x4*)(lds + LA_QA + d0 * RS64 + oc * 16) = pack8(a0); *(LAS u32x4*)(lds + LA_QA + (d0 + 1) * RS64 + oc * 16) = pack8(a1);
        *(LAS u32x4*)(lds + LA_VT + d0 * RS64 + oc * 16) = pack8(c0); *(LAS u32x4*)(lds + LA_VT + (d0 + 1) * RS64 + oc * 16) = pack8(c1);
        if (oc == 0) *(f32x2*)(dec + ((size_t)hh * 256 + n) * 128 + d0) = (f32x2){__expf(tot0), __expf(tot1)};
        __syncthreads();
        const int et = oc;
        bf16x8 vt[2];
#pragma unroll
        for (int ks = 0; ks < 2; ++ks) vt[ks] = *(const LAS bf16x8*)(lds + LA_VT + (16 * et + fr) * RS64 + (32 * ks + 8 * fq) * 2);
        bf16_t* orow = kvt + (((size_t)hh * 256 + n) * 128 + 16 * et + fr) * 128 + 4 * fq;
#pragma unroll
        for (int dt = 0; dt < 8; ++dt) {
            f32x4 acc = {0.f, 0.f, 0.f, 0.f};
#pragma unroll
            for (int ks = 0; ks < 2; ++ks) { const bf16x8 a = *(const LAS bf16x8*)(lds + LA_QA + (16 * dt + fr) * RS64 + (32 * ks + 8 * fq) * 2); acc = __builtin_amdgcn_mfma_f32_16x16x32_bf16(a, vt[ks], acc, 0, 0, 0); }
            *(u32x2*)(orow + 16 * dt) = (u32x2){cvt_pk_bf16(acc[0], acc[1]), cvt_pk_bf16(acc[2], acc[3])};
        }
        __syncthreads();
    }
}

__device__ __forceinline__ void la_scan(Frame& F) {
    const bf16_t* kvt = WSP(F, WS_KVT, bf16_t); const float* dec = WSP(F, WS_DEC, float); bf16_t* sprev = WSP(F, WS_SPREV, bf16_t);
    for (int idx = F.vcu * NTH + F.tid; idx < 8 * 16384; idx += F.G * NTH) {
        const int hh = idx >> 14, rem = idx & 16383, d = rem & 127;
        const bf16_t* kv = kvt + (size_t)hh * 256 * 16384 + rem; const float* dc = dec + (size_t)hh * 256 * 128 + d; bf16_t* sp = sprev + (size_t)hh * 256 * 16384 + rem;
        float S = 0.f;
        for (int n0 = 0; n0 < 256; n0 += 16) {
            float kvv[16], dd[16];
#pragma unroll
            for (int i = 0; i < 16; ++i) { kvv[i] = bf2f(kv[(size_t)(n0 + i) * 16384]); dd[i] = dc[(n0 + i) * 128]; }
#pragma unroll
            for (int i = 0; i < 16; ++i) { sp[(size_t)(n0 + i) * 16384] = (bf16_t)(cvt_pk_bf16(S, 0.f) & 0xffffu); S = dd[i] * S + kvv[i]; }
        }
    }
}

__device__ __forceinline__ void la_output(Frame& F) {
    const bf16_t* qkvg = WSP(F, WS_QKVG, bf16_t); const _Float16* gbuf = WSP(F, WS_GBUF, _Float16); const bf16_t* sprev = WSP(F, WS_SPREV, bf16_t); bf16_t* cat = WSP(F, WS_CAT, bf16_t);
    LAS unsigned char* lds = F.lds; LAS float* qs = (LAS float*)(lds + LA_QS); LAS float* ps = (LAS float*)(lds + LA_PS);
    const int tid = F.tid, lane = F.lane, oc = F.wave, d0 = 2 * lane, fr = lane & 15, fq = lane >> 4;
    LaIn nx;
    if (F.vcu < 2048) la_load<true>(nx, qkvg, gbuf, sprev, F.vcu, oc, d0, tid);
    for (int unit = F.vcu; unit < 2048; unit += F.G) {
        const int hh = unit >> 8, n = unit & 255;
        const LaIn in = nx;
        if (unit + F.G < 2048) la_load<true>(nx, qkvg, gbuf, sprev, unit + F.G, oc, d0, tid);
        float b0[8], b1[8]; la_cumsum_in(in, hh, b0, b1);
        *(LAS f32x2*)(qs + oc * 128 + d0) = (f32x2){b0[7], b1[7]};
        const unsigned (&qq)[8] = in.qq; const unsigned (&kk)[8] = in.kk; const unsigned (&vv)[8] = in.vv;
#pragma unroll
        for (int j = 0; j < 4; ++j) { const int c = tid + NTH * j; *(LAS u32x4*)(lds + LA_ST + (c >> 4) * RS128 + (c & 15) * 16) = in.st[j]; }
        __syncthreads();
        float base0 = 0.f, base1 = 0.f, bm0 = 0.f, bm1 = 0.f;
#pragma unroll
        for (int o = 0; o < 8; ++o) { const f32x2 q = *(const LAS f32x2*)(qs + o * 128 + d0); if (o < oc) { base0 += q.x; base1 += q.y; } if (o < 4) { bm0 += q.x; bm1 += q.y; } }
        float c0[8], c1[8];
#pragma unroll
        for (int i = 0; i < 8; ++i) {
            const int t = 8 * oc + i; const float bt0 = base0 + b0[i], bt1 = base1 + b1[i];
            const float q0 = bflo(qq[i]), q1 = bfhi(qq[i]), k0 = bflo(kk[i]), k1 = bfhi(kk[i]);
            *(LAS unsigned*)(lds + LA_QA + t * RS128 + d0 * 2) = cvt_pk_bf16(q0 * __expf(bt0 - bm0), q1 * __expf(bt1 - bm1));
            *(LAS unsigned*)(lds + LA_QH + t * RS128 + d0 * 2) = cvt_pk_bf16(q0 * __expf(bt0), q1 * __expf(bt1));
            *(LAS unsigned*)(lds + LA_KA + t * RS128 + d0 * 2) = cvt_pk_bf16(k0 * __expf(bm0 - bt0), k1 * __expf(bm1 - bt1));
            c0[i] = bflo(vv[i]); c1[i] = bfhi(vv[i]);
        }
        *(LAS u32x4*)(lds + LA_VT + d0 * RS64 + oc * 16) = pack8(c0); *(LAS u32x4*)(lds + LA_VT + (d0 + 1) * RS64 + oc * 16) = pack8(c1);
        __syncthreads();
        const int tt = oc >> 1, eh = oc & 1;
        {
            bf16x8 qf[4];
#pragma unroll
            for (int ks = 0; ks < 4; ++ks) qf[ks] = *(const LAS bf16x8*)(lds + LA_QA + (16 * tt + fr) * RS128 + (32 * ks + 8 * fq) * 2);
#pragma unroll
            for (int sti = 0; sti < 2; ++sti) {
                const int st = 2 * eh + sti;
                f32x4 acc = {0.f, 0.f, 0.f, 0.f};
                if (st <= tt) {
#pragma unroll
                    for (int ks = 0; ks < 4; ++ks) { const bf16x8 a = *(const LAS bf16x8*)(lds + LA_KA + (16 * st + fr) * RS128 + (32 * ks + 8 * fq) * 2); acc = __builtin_amdgcn_mfma_f32_16x16x32_bf16(a, qf[ks], acc, 0, 0, 0); }
                    if (st == tt) {
#pragma unroll
                        for (int r = 0; r < 4; ++r) if (4 * fq + r > fr) acc[r] = 0.f;
                    }
                }
                *(LAS u32x2*)(lds + LA_AS + (16 * tt + fr) * RS64 + (16 * st + 4 * fq) * 2) = (u32x2){cvt_pk_bf16(acc[0], acc[1]), cvt_pk_bf16(acc[2], acc[3])};
            }
        }
        __syncthreads();
        f32x4 o[4]; float ss = 0.f;
        {
            bf16x8 af[2], hf[4];
#pragma unroll
            for (int ks = 0; ks < 2; ++ks) af[ks] = *(const LAS bf16x8*)(lds + LA_AS + (16 * tt + fr) * RS64 + (32 * ks + 8 * fq) * 2);
#pragma unroll
            for (int ks = 0; ks < 4; ++ks) hf[ks] = *(const LAS bf16x8*)(lds + LA_QH + (16 * tt + fr) * RS128 + (32 * ks + 8 * fq) * 2);
#pragma unroll
            for (int ei = 0; ei < 4; ++ei) {
                const int et = 4 * eh + ei;
                f32x4 acc = {0.f, 0.f, 0.f, 0.f};
#pragma unroll
                for (int ks = 0; ks < 2; ++ks) { const bf16x8 a = *(const LAS bf16x8*)(lds + LA_VT + (16 * et + fr) * RS64 + (32 * ks + 8 * fq) * 2); acc = __builtin_amdgcn_mfma_f32_16x16x32_bf16(a, af[ks], acc, 0, 0, 0); }
#pragma unroll
                for (int ks = 0; ks < 4; ++ks) { const bf16x8 a = *(const LAS bf16x8*)(lds + LA_ST + (16 * et + fr) * RS128 + (32 * ks + 8 * fq) * 2); acc = __builtin_amdgcn_mfma_f32_16x16x32_bf16(a, hf[ks], acc, 0, 0, 0); }
                o[ei] = acc; ss += (acc[0] * acc[0] + acc[1] * acc[1]) + (acc[2] * acc[2] + acc[3] * acc[3]);
            }
        }
        ss += __shfl_xor(ss, 16); ss += __shfl_xor(ss, 32);
        if (lane < 16) ps[(tt * 2 + eh) * 16 + lane] = ss;
        __syncthreads();
        const float tot = ps[(tt * 2) * 16 + fr] + ps[(tt * 2 + 1) * 16 + fr];
        const float rstd = rsqrtf(tot * (1.f / 128.f) + EPS);
        const float* gain = (hh < 4) ? (inptr(6) + hh * 128) : (inptr(7) + (hh - 4) * 128);
        const size_t rowi = (size_t)(n * 64 + 16 * tt + fr);
#pragma unroll
        for (int ei = 0; ei < 4; ++ei) {
            const int e0 = 16 * (4 * eh + ei) + 4 * fq;
            const f32x4 gn = *(const f32x4*)(gain + e0);
            const u32x2 gt = in.gt[ei];
            const f32x4 v = o[ei] * rstd * gn;
            *(u32x2*)(cat + rowi * D + hh * 128 + e0) = (u32x2){cvt_pk_bf16(v[0] * bflo(gt.x), v[1] * bfhi(gt.x)), cvt_pk_bf16(v[2] * bflo(gt.y), v[3] * bfhi(gt.y))};
        }
        __syncthreads();
    }
}

constexpr int RT_STRIDE = 2064, RT_PART = 32 * RT_STRIDE;
__device__ __forceinline__ void sel4of8(float (&v)[8], const int (&ix)[8], float (&tv)[4], int (&ti)[4]) {
#pragma unroll
    for (int k = 0; k < 4; ++k) {
        float best = v[0]; int bi = ix[0];
#pragma unroll
        for (int q = 1; q < 8; ++q) { const bool better = (v[q] > best) || (v[q] == best && ix[q] < bi); best = better ? v[q] : best; bi = better ? ix[q] : bi; }
        tv[k] = best; ti[k] = bi;
#pragma unroll
        for (int q = 0; q < 8; ++q) v[q] = (ix[q] == bi) ? -INFINITY : v[q];
    }
}
__device__ __forceinline__ void p_route(Frame& F, int layer, const bf16_t* X, int aux = 0) {
    const int tid = F.tid, lane = F.lane;
    LAS unsigned char* lds = F.lds;
    LAS float* ssq = (LAS float*)(lds + 2 * RT_PART);
    LAS f32x4* lgx = (LAS f32x4*)(lds + 2 * RT_PART + 512);
    LAS int* pe = (LAS int*)(lds + 2 * RT_PART + 512 + 8192);
    LAS float* pw = (LAS float*)(pe + 256);
    LAS int* hist = (LAS int*)(pw + 256);
    LAS int* gbase = hist + 32;
    {
        const bf16_t* rt = WSP(F, WS_RT, bf16_t) + (size_t)layer * 2 * 32 * D;
#pragma unroll 4
        for (int j = 0; j < 16; ++j) { const int ch = tid + NTH * j, part = ch >> 12, row = (ch >> 7) & 31, c16 = ch & 127;
            *(LAS u32x4*)(lds + part * RT_PART + row * RT_STRIDE + c16 * 16) = *(const u32x4*)(rt + ((size_t)(part * 32 + row) * D + c16 * 8)); }
    }
    const float* mod = WSP(F, WS_MOD, float) + (size_t)layer * 6 * D;
    int* lslot = WSP(F, WS_LSLOT, int) + (size_t)layer * NE * LIST_CAP; float* lw = WSP(F, WS_LW, float) + (size_t)layer * NE * LIST_CAP;
    if (aux) { lslot = (int*)(F.ws + WS_END); lw = (float*)(F.ws + WS_END + 4 * MiB); }
    unsigned* cntw = F.ctl + CW_CNT + 64 * (layer + 2 * aux);
    const int tile = F.wave & 3, kh = F.wave >> 2, tk = lane & 15, kq = lane >> 4;
    const float* brt = inptr(13) + layer * NE;
    __syncthreads();
    for (int tb = F.vcu; tb < T / 64; tb += F.G) {
        if (tid < 32) hist[tid] = 0;
        const int row = tb * 64 + tile * 16 + tk;
        const bf16_t* xr = X + (size_t)row * D + kh * 512 + 8 * kq;
        float ss = 0.f;
#pragma unroll 8
        for (int s = 0; s < 16; ++s) { const u32x4 q = *(const u32x4*)(xr + 32 * s);
            const f32x4 a = {bflo(q.x), bfhi(q.x), bflo(q.y), bfhi(q.y)}, b = {bflo(q.z), bfhi(q.z), bflo(q.w), bfhi(q.w)};
            ss += (a.x * a.x + a.y * a.y) + (a.z * a.z + a.w * a.w) + (b.x * b.x + b.y * b.y) + (b.z * b.z + b.w * b.w); }
        ss += __shfl_xor(ss, 16); ss += __shfl_xor(ss, 32);
        if (kq == 0) ssq[F.wave * 16 + tk] = ss;
        __syncthreads();
        const float rstd = rsqrtf((ssq[tile * 16 + tk] + ssq[(tile + 4) * 16 + tk]) * (1.f / D) + EPS);
        f32x4 acc[2] = {{0.f, 0.f, 0.f, 0.f}, {0.f, 0.f, 0.f, 0.f}};
        bf16_t* hrow = WSP(F, WS_HN, bf16_t) + (size_t)row * D;
#pragma unroll 2
        for (int s = 0; s < 16; ++s) {
            const int col = kh * 512 + 32 * s + 8 * kq;
            const u32x4 q = *(const u32x4*)(xr + 32 * s);
            const f32x4 a = {bflo(q.x), bfhi(q.x), bflo(q.y), bfhi(q.y)}, b = {bflo(q.z), bfhi(q.z), bflo(q.w), bfhi(q.w)};
            const f32x4 sc0 = *(const f32x4*)(mod + 4 * D + col) + 1.0f, sc1 = *(const f32x4*)(mod + 4 * D + col + 4) + 1.0f;
            const f32x4 sh0 = *(const f32x4*)(mod + 3 * D + col), sh1 = *(const f32x4*)(mod + 3 * D + col + 4);
            const f32x4 h0 = a * rstd * sc0 + sh0, h1 = b * rstd * sc1 + sh1;
            u32x4 hi; hi.x = cvt_pk_bf16(h0.x, h0.y); hi.y = cvt_pk_bf16(h0.z, h0.w); hi.z = cvt_pk_bf16(h1.x, h1.y); hi.w = cvt_pk_bf16(h1.z, h1.w);
            if ((FP8_LAYERS >> layer) & 1) *(u32x2*)(WSP(F, WS_HN8, unsigned char) + (size_t)row * D + col) = (u32x2){pack_fp8x4(h0.x, h0.y, h0.z, h0.w), pack_fp8x4(h1.x, h1.y, h1.z, h1.w)};
            else *(u32x4*)(hrow + col) = hi;
            u32x4 lo; lo.x = cvt_pk_bf16(h0.x - bflo(hi.x), h0.y - bfhi(hi.x)); lo.y = cvt_pk_bf16(h0.z - bflo(hi.y), h0.w - bfhi(hi.y));
            lo.z = cvt_pk_bf16(h1.x - bflo(hi.z), h1.y - bfhi(hi.z)); lo.w = cvt_pk_bf16(h1.z - bflo(hi.w), h1.w - bfhi(hi.w));
            const bf16x8 bh = __builtin_bit_cast(bf16x8, hi), bl = __builtin_bit_cast(bf16x8, lo);
#pragma unroll
            for (int et = 0; et < 2; ++et) {
                const bf16x8 wh = *(const LAS bf16x8*)(lds + (16 * et + tk) * RT_STRIDE + col * 2);
                const bf16x8 wl = *(const LAS bf16x8*)(lds + RT_PART + (16 * et + tk) * RT_STRIDE + col * 2);
                acc[et] = __builtin_amdgcn_mfma_f32_16x16x32_bf16(wh, bh, acc[et], 0, 0, 0);
                acc[et] = __builtin_amdgcn_mfma_f32_16x16x32_bf16(wl, bh, acc[et], 0, 0, 0);
                acc[et] = __builtin_amdgcn_mfma_f32_16x16x32_bf16(wh, bl, acc[et], 0, 0, 0);
            }
        }
        if (kh == 1) { lgx[(tile * 2 + 0) * 64 + lane] = acc[0]; lgx[(tile * 2 + 1) * 64 + lane] = acc[1]; }
        __syncthreads();
        if (kh == 0) {
            float cv[8]; int ci[8];
#pragma unroll
            for (int et = 0; et < 2; ++et) { const f32x4 o = lgx[(tile * 2 + et) * 64 + lane]; const f32x4 bb = *(const f32x4*)(brt + 16 * et + 4 * kq);
#pragma unroll
                for (int r = 0; r < 4; ++r) { cv[et * 4 + r] = acc[et][r] + o[r] + bb[r]; ci[et * 4 + r] = 16 * et + 4 * kq + r; } }
            float tv[4]; int ti[4];
            sel4of8(cv, ci, tv, ti);
#pragma unroll
            for (int off = 16; off <= 32; off <<= 1) {
                float mv[8]; int mi[8];
#pragma unroll
                for (int k = 0; k < 4; ++k) { mv[k] = tv[k]; mi[k] = ti[k]; mv[4 + k] = __shfl_xor(tv[k], off); mi[4 + k] = __shfl_xor(ti[k], off); }
                sel4of8(mv, mi, tv, ti);
            }
            const float e1 = __expf(tv[1] - tv[0]), e2 = __expf(tv[2] - tv[0]), e3 = __expf(tv[3] - tv[0]); const float inv = 1.0f / (1.0f + e1 + e2 + e3);
            if (kq == 0) { const int tl = tile * 16 + tk;
                pe[tl * 4 + 0] = ti[0]; pe[tl * 4 + 1] = ti[1]; pe[tl * 4 + 2] = ti[2]; pe[tl * 4 + 3] = ti[3];
                pw[tl * 4 + 0] = inv; pw[tl * 4 + 1] = e1 * inv; pw[tl * 4 + 2] = e2 * inv; pw[tl * 4 + 3] = e3 * inv; }
        }
        __syncthreads();
        int myexp = 0, lpos = 0;
        if (tid < 256) { myexp = pe[tid]; lpos = __hip_atomic_fetch_add(hist + myexp, 1, __ATOMIC_RELAXED, __HIP_MEMORY_SCOPE_WORKGROUP); }
        __syncthreads();
        if (tid < 32) gbase[tid] = (int)atomicAdd(cntw + tid, (unsigned)hist[tid]);
        __syncthreads();
        if (tid < 256) { const int pos = gbase[myexp] + lpos; if (pos < LIST_CAP) { lslot[(size_t)myexp * LIST_CAP + pos] = tb * 256 + tid; lw[(size_t)myexp * LIST_CAP + pos] = pw[tid]; } }
        __syncthreads();
    }
}

template <int MODE>
__device__ __forceinline__ void p_combine(Frame& F, int layer, const bf16_t* Xin, void* Xout_) {
    const int lane = F.lane;
    const float* mod = WSP(F, WS_MOD, float) + (size_t)layer * 6 * D;
    const bf16_t* ys = WSP(F, WS_YSLOT, bf16_t);
    f32x4 gf[4], fnw[4];
#pragma unroll
    for (int j = 0; j < 4; ++j) { gf[j] = *(const f32x4*)(mod + 5 * D + 4 * lane + 256 * j); if (MODE == 1) fnw[j] = *(const f32x4*)(inptr(18) + 4 * lane + 256 * j); }
    for (int it = 0; it < (T / 64 + F.G - 1) / F.G * 8; ++it) {
        const int row = ((it >> 3) * F.G + F.vcu) * 64 + F.wave * 8 + (it & 7); if (row >= T) break;
        const u32x2* xr = (const u32x2*)(Xin + (size_t)row * D) + lane;
        f32x4 v[4]; float s = 0.f;
#pragma unroll
        for (int j = 0; j < 4; ++j) {
            f32x4 a = {0.f, 0.f, 0.f, 0.f};
#pragma unroll
            for (int k = 0; k < 4; ++k) { const u32x2 y = *((const u32x2*)(ys + ((size_t)row * 4 + k) * D) + lane + 64 * j); a += (f32x4){bflo(y.x), bfhi(y.x), bflo(y.y), bfhi(y.y)}; }
            const u32x2 xq = xr[64 * j];
            v[j] = (f32x4){bflo(xq.x), bfhi(xq.x), bflo(xq.y), bfhi(xq.y)} + gf[j] * a;
            if (MODE == 0) { const u32x2 w = {cvt_pk_bf16(v[j].x, v[j].y), cvt_pk_bf16(v[j].z, v[j].w)};
                ((u32x2*)((bf16_t*)Xout_ + (size_t)row * D) + lane)[64 * j] = w; v[j] = (f32x4){bflo(w.x), bfhi(w.x), bflo(w.y), bfhi(w.y)}; }
            s += (v[j].x * v[j].x + v[j].y * v[j].y) + (v[j].z * v[j].z + v[j].w * v[j].w);
        }
        const float rstd = rsqrtf(wave_sum(s) * (1.f / D) + EPS);
        if (MODE == 0) { if (lane == 0) WSP(F, WS_RSTD, float)[row] = rstd; }
        else { f32x4* o = (f32x4*)((float*)Xout_ + (size_t)row * D) + lane;
#pragma unroll
            for (int j = 0; j < 4; ++j) __builtin_nontemporal_store(v[j] * rstd * fnw[j], o + 64 * j);
        }
    }
}

template <int W>
__device__ __forceinline__ void pool_unit(const bf16_t* X, const float* rs, bf16_t* P, int c, int t0, float sh, float sc) {
    float hp[16], hc[16];
#pragma unroll
    for (int i = 0; i < 16; ++i) { const int t = t0 - 16 + i; hp[i] = (i >= 16 - (W - 1) && t >= 0) ? bf2f(X[(size_t)t * D + c]) * rs[t] * sc + sh : 0.f; }
    float sum = 0.f;
#pragma unroll
    for (int i = 1; i < W; ++i) sum += hp[16 - i];
#pragma unroll
    for (int blk = 0; blk < 2; ++blk) {
        const int tb = t0 + 16 * blk;
#pragma unroll
        for (int i = 0; i < 16; ++i) hc[i] = bf2f(X[(size_t)(tb + i) * D + c]) * rs[tb + i] * sc + sh;
#pragma unroll
        for (int i = 0; i < 16; ++i) {
            const int t = tb + i;
            sum += hc[i];
            const int cnt = (t + 1 < W) ? (t + 1) : W;
            const float p = sum / (float)cnt - hc[i];
            P[(size_t)t * D + c] = (bf16_t)(cvt_pk_bf16(p, 0.f) & 0xffffu);
            sum -= (i - (W - 1) >= 0) ? hc[(i - (W - 1)) & 15] : hp[(16 + i - (W - 1)) & 15];
        }
#pragma unroll
        for (int i = 0; i < 16; ++i) hp[i] = hc[i];
    }
}
__device__ __forceinline__ void p_pool(Frame& F, const bf16_t* X) {
    const float* mod = WSP(F, WS_MOD, float) + (size_t)1 * 6 * D; const float* rs = WSP(F, WS_RSTD, float); bf16_t* P = WSP(F, WS_HN, bf16_t);
    const int tid = F.tid;
    for (int u = F.vcu; u < 1024; u += F.G) {
        const int tt = u >> 2, g = u & 3;
        const int c = g * 256 + (tid & 255), t0 = tt * 64 + (tid >> 8) * 32;
        const float sh = mod[0 * D + c], sc = 1.0f + mod[1 * D + c];
        if (g == 0) pool_unit<2>(X, rs, P, c, t0, sh, sc);
        else if (g == 1) pool_unit<4>(X, rs, P, c, t0, sh, sc);
        else if (g == 2) pool_unit<8>(X, rs, P, c, t0, sh, sc);
        else pool_unit<16>(X, rs, P, c, t0, sh, sc);
    }
}

constexpr int PG_STRIDE = 2064;
constexpr int PG_RS = 64 * PG_STRIDE;
template <int W>
__device__ __forceinline__ void pool_pair(const bf16_t* xcol, const LAS float* rsl, LAS unsigned* Pd, int t0, f32x2 sh, f32x2 sc) {
    f32x2 hp[16], hc[16];
#pragma unroll
    for (int i = 0; i < 16; ++i) { const int t = t0 - 16 + i; hp[i] = (f32x2){0.f, 0.f};
        if (i >= 16 - (W - 1) && t >= 0) { const unsigned q = *(const unsigned*)(xcol + (size_t)t * D); hp[i] = (f32x2){bflo(q), bfhi(q)} * rsl[i] * sc + sh; } }
    f32x2 sum = {0.f, 0.f};
#pragma unroll
    for (int i = 1; i < W; ++i) sum += hp[16 - i];
#pragma unroll 2
    for (int blk = 0; blk < 4; ++blk) {
        const int tb = t0 + 16 * blk;
#pragma unroll
        for (int i = 0; i < 16; ++i) { const unsigned q = *(const unsigned*)(xcol + (size_t)(tb + i) * D); hc[i] = (f32x2){bflo(q), bfhi(q)} * rsl[16 + 16 * blk + i] * sc + sh; }
#pragma unroll
        for (int i = 0; i < 16; ++i) {
            const int t = tb + i;
            sum += hc[i];
            const float inv = 1.0f / (float)((t + 1 < W) ? (t + 1) : W);
            const f32x2 p = sum * inv - hc[i];
            Pd[(size_t)(16 * blk + i) * (PG_STRIDE / 4)] = cvt_pk_bf16(p.x, p.y);
            sum -= (i - (W - 1) >= 0) ? hc[(i - (W - 1)) & 15] : hp[(16 + i - (W - 1)) & 15];
        }
#pragma unroll
        for (int i = 0; i < 16; ++i) hp[i] = hc[i];
    }
}
__device__ __forceinline__ void p_pool_gemm(Frame& F, const bf16_t* X2, bf16_t* X1) {
    const float* mod = WSP(F, WS_MOD, float) + (size_t)1 * 6 * D; const float* rs = WSP(F, WS_RSTD, float); const bf16_t* pwt = WSP(F, WS_POOLT, bf16_t);
    const float* pb = inptr(10); const float* psc = inptr(11);
    LAS unsigned char* lds = F.lds; LAS float* rsl = (LAS float*)(lds + PG_RS);
    const int tid = F.tid, lane = F.lane, w = F.wave, fr = lane & 15, fq = lane >> 4;
    for (int tb = F.vcu; tb < T / 64; tb += F.G) {
        const int t0 = tb * 64;
        if (tid < 80) { const int t = t0 - 16 + tid; rsl[tid] = (t >= 0) ? rs[t] : 0.f; }
        __syncthreads();
        {
            const int c2 = 2 * tid, gq = w >> 1;
            const f32x2 sh = *(const f32x2*)(mod + 0 * D + c2), sc = *(const f32x2*)(mod + 1 * D + c2) + 1.0f;
            LAS unsigned* Pd = (LAS unsigned*)(lds + c2 * 2);
            if (gq == 0) pool_pair<2>(X2 + c2, rsl, Pd, t0, sh, sc);
            else if (gq == 1) pool_pair<4>(X2 + c2, rsl, Pd, t0, sh, sc);
            else if (gq == 2) pool_pair<8>(X2 + c2, rsl, Pd, t0, sh, sc);
            else pool_pair<16>(X2 + c2, rsl, Pd, t0, sh, sc);
        }
        __syncthreads();
#pragma unroll 1
        for (int g = 0; g < 4; ++g) {
            f32x4 acc[2][4];
#pragma unroll
            for (int nt = 0; nt < 2; ++nt)
#pragma unroll
                for (int tt = 0; tt < 4; ++tt) acc[nt][tt] = (f32x4){0.f, 0.f, 0.f, 0.f};
            bf16x8 wf[2][8];
#pragma unroll
            for (int nt = 0; nt < 2; ++nt)
#pragma unroll
                for (int ks = 0; ks < 8; ++ks) wf[nt][ks] = *(const bf16x8*)(pwt + ((size_t)g * 256 + 32 * w + 16 * nt + fr) * 256 + 32 * ks + 8 * fq);
            u32x2 xq[2][4];
#pragma unroll
            for (int nt = 0; nt < 2; ++nt)
#pragma unroll
                for (int tt = 0; tt < 4; ++tt) xq[nt][tt] = *(const u32x2*)(X2 + (size_t)(t0 + 16 * tt + fr) * D + 256 * g + 32 * w + 16 * nt + 4 * fq);
#pragma unroll
            for (int ks = 0; ks < 8; ++ks) {
                bf16x8 af[4];
#pragma unroll
                for (int tt = 0; tt < 4; ++tt) af[tt] = *(const LAS bf16x8*)(lds + (16 * tt + fr) * PG_STRIDE + (256 * g + 32 * ks + 8 * fq) * 2);
#pragma unroll
                for (int nt = 0; nt < 2; ++nt)
#pragma unroll
                    for (int tt = 0; tt < 4; ++tt) acc[nt][tt] = __builtin_amdgcn_mfma_f32_16x16x32_bf16(wf[nt][ks], af[tt], acc[nt][tt], 0, 0, 0);
            }
#pragma unroll
            for (int nt = 0; nt < 2; ++nt) {
                const int col = 256 * g + 32 * w + 16 * nt + 4 * fq;
                const f32x4 gmv = *(const f32x4*)(mod + 2 * D + col), bv = *(const f32x4*)(pb + col), sv = *(const f32x4*)(psc + col);
#pragma unroll
                for (int tt = 0; tt < 4; ++tt) {
                    const size_t idx = (size_t)(t0 + 16 * tt + fr) * D + col;
                    const f32x4 xv = {bflo(xq[nt][tt].x), bfhi(xq[nt][tt].x), bflo(xq[nt][tt].y), bfhi(xq[nt][tt].y)};
                    const f32x4 o = xv + gmv * ((acc[nt][tt] + bv) * sv);
                    *(u32x2*)(X1 + idx) = (u32x2){cvt_pk_bf16(o.x, o.y), cvt_pk_bf16(o.z, o.w)};
                }
            }
        }
        __syncthreads();
    }
}

constexpr int N_PHASES = 17;
__global__ void __launch_bounds__(NTH, 2) fwd_kernel(Args args) {
    extern __shared__ __attribute__((aligned(16))) unsigned char lds_raw[];
    Frame F;
    F.lds = (LAS unsigned char*)lds_raw;
    F.MISC = (volatile LAS unsigned*)(F.lds + MISC_OFF);
    F.tid = threadIdx.x; F.lane = F.tid & 63; F.wave = __builtin_amdgcn_readfirstlane(F.tid >> 6);
    F.G = gridDim.x; { const int bx = blockIdx.x; F.vcu = (F.G % 8 == 0) ? (bx % 8) * (F.G / 8) + bx / 8 : bx; }
    F.ws = args.ws; F.ctl = (unsigned*)(args.ws + WS_CTL); F.out = args.out;
    for (int u = F.tid; u < (LDS_BYTES - MISC_OFF) / 4; u += NTH) F.MISC[u] = 0u;
    __syncthreads();
#if N_LAUNCH_MODE == 1
    XcdBarrier bar = xcd_barrier_post(F.ctl + CW_BAR, F.MISC + 8);
#define GRID_BAR() xcd_barrier(bar)
#else
#define GRID_BAR() do { } while (0)
#endif
    const int lo = args.ph_lo, hi = args.ph_hi;
#define IN(k) (lo <= (k) && (k) < hi)
#define SEAM(k) do { if (IN(k) && IN((k) + 1)) GRID_BAR(); } while (0)
    GemmBase gb; gb.G = F.G; gb.vcu = F.vcu;
    bf16_t* X1 = WSP(F, WS_X1, bf16_t); bf16_t* X2 = WSP(F, WS_X2, bf16_t);
    const float* mod0 = WSP(F, WS_MOD, float); const float* mod1 = mod0 + 6 * D;

    if (IN(0)) { p0_prologue(F); } SEAM(0);
    if (IN(1)) { p1_norm_in(F); } SEAM(1);
    if (IN(2)) { PolWin P; (GemmBase&)P = gb; P.A = WSP(F, WS_HN, bf16_t); P.Bt = WSP(F, WS_WINT, bf16_t); P.qkvg = WSP(F, WS_QKVG, bf16_t); P.gbuf = WSP(F, WS_GBUF, _Float16);
        P.lb = WSP(F, WS_LB, float); P.rope = WSP(F, WS_ROPE, f32x2); run_gemm(F, P); } SEAM(2);
    if (IN(3)) { la_local_state(F); } SEAM(3);
    if (IN(4)) { la_scan(F); } SEAM(4);
    if (IN(5)) { la_output(F); } SEAM(5);
    if (IN(6)) { PolRes<false> P; (GemmBase&)P = gb; P.A = WSP(F, WS_CAT, bf16_t); P.Bt = WSP(F, WS_WOUTT, bf16_t); P.resid = inptr(0); P.resid16 = nullptr; P.outp = X1; P.gate = mod0 + 2 * D; P.bias = nullptr; P.scale = nullptr;
        P.K = D; P.lda = D; P.nN = 4; P.kcol = 0; run_gemm(F, P); } SEAM(6);
    if (IN(7)) { p_route(F, 0, X1, args.aux); } SEAM(7);
    if (IN(8)) { expert_tables(F, 0); PolMoE<((FP8_LAYERS >> 0) & 1) != 0> P; (GemmBase&)P = gb; P.MISC = F.MISC; P.upa = F.lds + UPA_OFF; P.hn = ((FP8_LAYERS >> 0) & 1) ? (const bf16_t*)WSP(F, WS_HN8, unsigned char) : WSP(F, WS_HN, bf16_t);
        P.wgut = WSP(F, WS_WGUT, bf16_t) + (size_t)0 * NE * 2048 * D; P.bgu = inptr(15) + (size_t)0 * NE * 2048; P.lslot = WSP(F, WS_LSLOT, int) + (size_t)0 * NE * LIST_CAP; P.lw = WSP(F, WS_LW, float) + (size_t)0 * NE * LIST_CAP;
        P.act = (bf16_t*)(F.ws + (0 ? WS_ACT2 : WS_ACT)); P.wdnt = WSP(F, WS_WDNT, bf16_t) + (size_t)0 * NE * D * D; P.bdn = inptr(17) + (size_t)0 * NE * D; P.yslot = WSP(F, WS_YSLOT, bf16_t);
        P.done = F.ctl + CW_DONE + 0 * DONE_LAYER; P.tmo = F.ctl + CW_TMO; P.act_rsrc = __builtin_amdgcn_make_buffer_rsrc((void*)P.act, (short)0, (int)((size_t)ACT_ROWS * D * 2), 0x00020000);
        P.fill(F.tid); __syncthreads(); run_gemm(F, P); } if (IN(8) && IN(10)) GRID_BAR();
    if (IN(10)) { p_combine<0>(F, 0, X1, X2); } SEAM(10);
    if (IN(11)) { p_pool_gemm(F, X2, X1); } if (IN(11) && IN(13)) GRID_BAR();
    if (IN(13)) { p_route(F, 1, X1, args.aux); } SEAM(13);
    if (IN(14)) { expert_tables(F, 1); PolMoE<((FP8_LAYERS >> 1) & 1) != 0> P; (GemmBase&)P = gb; P.MISC = F.MISC; P.upa = F.lds + UPA_OFF; P.hn = ((FP8_LAYERS >> 1) & 1) ? (const bf16_t*)WSP(F, WS_HN8, unsigned char) : WSP(F, WS_HN, bf16_t);
        P.wgut = WSP(F, WS_WGUT, bf16_t) + (size_t)1 * NE * 2048 * D; P.bgu = inptr(15) + (size_t)1 * NE * 2048; P.lslot = WSP(F, WS_LSLOT, int) + (size_t)1 * NE * LIST_CAP; P.lw = WSP(F, WS_LW, float) + (size_t)1 * NE * LIST_CAP;
        P.act = (bf16_t*)(F.ws + (1 ? WS_ACT2 : WS_ACT)); P.wdnt = WSP(F, WS_WDNT, bf16_t) + (size_t)1 * NE * D * D; P.bdn = inptr(17) + (size_t)1 * NE * D; P.yslot = WSP(F, WS_YSLOT, bf16_t);
        P.done = F.ctl + CW_DONE + 1 * DONE_LAYER; P.tmo = F.ctl + CW_TMO; P.act_rsrc = __builtin_amdgcn_make_buffer_rsrc((void*)P.act, (short)0, (int)((size_t)ACT_ROWS * D * 2), 0x00020000);
        P.fill(F.tid); __syncthreads(); run_gemm(F, P); } if (IN(14) && IN(16)) GRID_BAR();
    if (IN(16)) { p_combine<1>(F, 1, X1, F.out); }
#undef IN
#undef SEAM
}

extern "C" void kernel_launch(void* const* d_in, const int* in_sizes, int n_in, void* d_out, int out_size, void* d_ws, size_t ws_size, hipStream_t stream) {
    static int grid = 0;
    if (grid == 0) {
        if (n_in != 19 || out_size != T * D || ws_size < WS_END) { fprintf(stderr, "kernel_launch: unexpected shapes (n_in %d, out %d, ws %zu)\n", n_in, out_size, ws_size); grid = -1; return; }
        int dev = 0, cus = 0, per_cu = 0;
        if (hipGetDevice(&dev) != hipSuccess || hipDeviceGetAttribute(&cus, hipDeviceAttributeMultiprocessorCount, dev) != hipSuccess) { grid = -1; return; }
        if (hipFuncSetAttribute((const void*)fwd_kernel, hipFuncAttributeMaxDynamicSharedMemorySize, LDS_BYTES) != hipSuccess) { fprintf(stderr, "kernel_launch: hipFuncSetAttribute failed\n"); grid = -1; return; }
        if (hipOccupancyMaxActiveBlocksPerMultiprocessor(&per_cu, (const void*)fwd_kernel, NTH, LDS_BYTES) != hipSuccess || per_cu < 1) { fprintf(stderr, "kernel_launch: occupancy query says %d\n", per_cu); }
        (void)hipGetLastError();
        grid = cus;
    }
    if (grid < 0) return;
    (void)hipMemsetAsync((char*)d_ws + WS_CTL, 0, CTL_BYTES, stream);
    Args a{};
    for (int i = 0; i < 19; ++i) a.in[i] = (const float*)d_in[i];
    a.out = (float*)d_out; a.ws = (unsigned char*)d_ws;
#if N_LAUNCH_MODE == 1
    a.ph_lo = 0; a.ph_hi = N_PHASES;
    void* kargs[] = {&a};
    hipError_t e = hipLaunchCooperativeKernel((const void*)fwd_kernel, dim3(grid), dim3(NTH), kargs, LDS_BYTES, stream);
    if (e != hipSuccess) fprintf(stderr, "cooperative launch failed: %s\n", hipGetErrorString(e));
#else
    for (int p = 0; p < N_PHASES; ++p) {
        a.ph_lo = p; a.ph_hi = p + 1;
        hipLaunchKernelGGL(fwd_kernel, dim3(grid), dim3(NTH), LDS_BYTES, stream, a);
        if (p == DUP_PHASE) { a.aux = 1; hipLaunchKernelGGL(fwd_kernel, dim3(grid), dim3(NTH), LDS_BYTES, stream, a); a.aux = 0; }
    }
#endif
}
```

```cpp
#include <hip/hip_runtime.h>
#include <cstdio>
#include <cstdint>

#ifndef N_LAUNCH_MODE
#define N_LAUNCH_MODE 1
#endif
#ifndef DUP_PHASE
#define DUP_PHASE -1
#endif
#ifndef KREP_WIN
#define KREP_WIN 1
#endif
#ifndef KREP_RES
#define KREP_RES 1
#endif
#ifndef KREP_G1
#define KREP_G1 1
#endif
#ifndef KREP_G2
#define KREP_G2 1
#endif
#ifndef GEMM_KREP
#define GEMM_KREP 1
#endif
#ifndef GEMM_EPIREP
#define GEMM_EPIREP 1
#endif
#ifndef FP8_LAYERS
#define FP8_LAYERS 3
#endif
#ifndef SIMPLE_GEMM
#define SIMPLE_GEMM 0
#endif

#define LAS __attribute__((address_space(3)))
#define GAS __attribute__((address_space(1)))
typedef unsigned short bf16_t;
typedef short bf16x8 __attribute__((ext_vector_type(8)));
typedef float f32x4 __attribute__((ext_vector_type(4)));
typedef float f32x2 __attribute__((ext_vector_type(2)));
typedef unsigned u32x4 __attribute__((ext_vector_type(4)));
typedef unsigned u32x2 __attribute__((ext_vector_type(2)));
typedef _Float16 h16x2 __attribute__((ext_vector_type(2)));
typedef _Float16 h16x8 __attribute__((ext_vector_type(8)));
typedef int v4i_t __attribute__((ext_vector_type(4)));
typedef int v8i_t __attribute__((ext_vector_type(8)));
constexpr float W8_SCALE = 32.0f;
__device__ __forceinline__ unsigned pack_fp8x4(float a, float b, float c, float d) { int w = __builtin_amdgcn_cvt_pk_fp8_f32(a, b, 0, false); w = __builtin_amdgcn_cvt_pk_fp8_f32(c, d, w, true); return (unsigned)w; }

constexpr int T = 16384, D = 1024, NE = 32, TOPK = 4, DEPTH = 2;
constexpr int INW = 4096;
constexpr int NTH = 512, NWAVES = 8;
constexpr float EPS = 1e-6f;
constexpr float SW_LIMIT = 7.0f, SW_ALPHA = 1.702f;
constexpr int LIST_CAP = T;
constexpr int ACT_ROWS = T * TOPK + NE * 256;

constexpr size_t MiB = 1u << 20;
constexpr size_t WS_CTL = 0, CTL_BYTES = 1 * MiB;
constexpr size_t WS_MOD = 1 * MiB;
constexpr size_t WS_LB = WS_MOD + 65536;
constexpr size_t WS_ROPE = 2 * MiB;
constexpr size_t WS_WINT = 10 * MiB;
constexpr size_t WS_WOUTT = 18 * MiB;
constexpr size_t WS_POOLT = 20 * MiB;
constexpr size_t WS_LSLOT = 22 * MiB;
constexpr size_t WS_LW = 26 * MiB;
constexpr size_t WS_RT = 21 * MiB;
constexpr size_t WS_RSTD = 30 * MiB;
constexpr size_t WS_WGUT = 32 * MiB;
constexpr size_t WS_WDNT = 288 * MiB;
constexpr size_t WS_HN = 416 * MiB;
constexpr size_t WS_QKVG = 448 * MiB;
constexpr size_t WS_GBUF = 576 * MiB;
constexpr size_t WS_KVT = 608 * MiB;
constexpr size_t WS_SPREV = 736 * MiB;
constexpr size_t WS_DEC = 800 * MiB;
constexpr size_t WS_CAT = 802 * MiB;
constexpr size_t WS_X1 = 834 * MiB;
constexpr size_t WS_X2 = 898 * MiB;
constexpr size_t WS_ACT = 962 * MiB;
constexpr size_t WS_YSLOT = 1106 * MiB;
constexpr size_t WS_ACT2 = 1234 * MiB;
constexpr size_t WS_HN8 = 1378 * MiB;
constexpr size_t WS_END = 1394 * MiB;
constexpr int CW_CNT = 64;
constexpr int CW_BAR = 4096;
constexpr int CW_TMO = 8;
constexpr int CW_DONE = 8192, DONE_LAYER = 320 * 64;

constexpr int SCR_BYTES = 156 * 1024;
constexpr int MISC_OFF = SCR_BYTES;
constexpr int LDS_BYTES = SCR_BYTES + 4096;

typedef __bf16 bf16x2_t __attribute__((ext_vector_type(2)));
__device__ __forceinline__ unsigned cvt_pk_bf16(float lo, float hi) { const f32x2 v = {lo, hi}; const bf16x2_t b = __builtin_convertvector(v, bf16x2_t); return __builtin_bit_cast(unsigned, b); }
__device__ __forceinline__ float bf2f(unsigned short b) { return __builtin_bit_cast(float, (unsigned)b << 16); }
__device__ __forceinline__ float bflo(unsigned w) { return __builtin_bit_cast(float, w << 16); }
__device__ __forceinline__ float bfhi(unsigned w) { return __builtin_bit_cast(float, w & 0xffff0000u); }
__device__ __forceinline__ float wave_sum(float v) {
#pragma unroll
    for (int o = 1; o < 64; o <<= 1) v += __shfl_xor(v, o);
    return v;
}
__device__ __forceinline__ float wave_max(float v) {
#pragma unroll
    for (int o = 1; o < 64; o <<= 1) v = fmaxf(v, __shfl_xor(v, o));
    return v;
}
__device__ __forceinline__ float sigmoidf_(float x) { return __builtin_amdgcn_rcpf(1.0f + __expf(-x)); }
__device__ __forceinline__ float siluf_(float x) { return x * sigmoidf_(x); }

#define XB_TMO      128
#define XB_XCNT(j)  (256  + 64 * (j))
#define XB_XSUB(j)  (1280 + 64 * (j))
#define XB_XGEN(j)  (2304 + 64 * (j))
#define XB_TOP      3328
#define XB_TOPGEN   3392
#define XCD_BAR_WORDS 3456
#define XB_SPIN_CAP (1u << 20)
__device__ __forceinline__ unsigned xb_ld(unsigned* p)              { return __hip_atomic_load(p, __ATOMIC_RELAXED, __HIP_MEMORY_SCOPE_AGENT); }
__device__ __forceinline__ unsigned xb_add(unsigned* p, unsigned v) { return __hip_atomic_fetch_add(p, v, __ATOMIC_RELAXED, __HIP_MEMORY_SCOPE_AGENT); }
__device__ __forceinline__ unsigned xb_xcc_id() { return (unsigned)__builtin_amdgcn_s_getreg((3 << 11) | 20) & 0xFu; }
#define XB_SPIN(cond, bar) do { unsigned _sp = 0; while (cond) { __builtin_amdgcn_s_sleep(1); \
    if ((++_sp & 255u) == 0u) { if (xb_ld(&(bar)[XB_TMO])) break; if (_sp > XB_SPIN_CAP) { atomicAdd(&(bar)[XB_TMO], 1u); break; } } } } while (0)
struct XcdBarrier { unsigned* bar; unsigned x; volatile LAS unsigned* st; };
__device__ __forceinline__ XcdBarrier xcd_barrier_post(unsigned* bar, volatile LAS unsigned* st) {
    XcdBarrier b; b.bar = bar; b.x = xb_xcc_id(); b.st = st;
    if (threadIdx.x == 0) (void)xb_add(&bar[XB_XCNT(b.x)], 1u);
    return b;
}
__device__ __forceinline__ void xcd_barrier_complete(unsigned* bar, unsigned x, unsigned& nloc, unsigned& nx) {
    const unsigned G = gridDim.x * gridDim.y * gridDim.z;
    unsigned sum, cnt, mine, sp = 0u;
    for (;;) {
        sum = 0u; cnt = 0u; mine = 0u;
#pragma unroll
        for (unsigned j = 0; j < 16; ++j) { const unsigned c = xb_ld(&bar[XB_XCNT(j)]); sum += c; cnt += (c > 0u) ? 1u : 0u; mine = (j == x) ? c : mine; }
        if (sum == G) break;
        __builtin_amdgcn_s_sleep(1);
        if ((++sp & 255u) == 0u) { if (xb_ld(&bar[XB_TMO])) break; if (sp > XB_SPIN_CAP) { atomicAdd(&bar[XB_TMO], 1u); break; } }
    }
    nloc = mine > 0u ? mine : 1u; nx = cnt > 0u ? cnt : 1u;
}
__device__ __forceinline__ void xcd_barrier(const XcdBarrier& b) {
    asm volatile("s_waitcnt vmcnt(0)" ::: "memory");
    __syncthreads();
    if (threadIdx.x == 0) {
        unsigned* bar = b.bar;
        __builtin_amdgcn_s_waitcnt(0);
        unsigned nloc = b.st[0], nx = b.st[1];
        if (nloc == 0u) { xcd_barrier_complete(bar, b.x, nloc, nx); b.st[0] = nloc; b.st[1] = nx; }
        const unsigned old = xb_add(&bar[XB_XSUB(b.x)], 1u);
        const unsigned gen = old / nloc;
        if (old + 1u == (gen + 1u) * nloc) {
            __builtin_amdgcn_fence(__ATOMIC_RELEASE, "agent");
            asm volatile("s_waitcnt vmcnt(0)" ::: "memory");
            const unsigned og = xb_add(&bar[XB_TOP], 1u);
            const unsigned tg = og / nx;
            if (og + 1u == (tg + 1u) * nx) xb_add(&bar[XB_TOPGEN], 1u);
            else XB_SPIN(xb_ld(&bar[XB_TOPGEN]) == tg, bar);
            __builtin_amdgcn_fence(__ATOMIC_ACQUIRE, "agent");
            xb_add(&bar[XB_XGEN(b.x)], 1u);
            asm volatile("s_waitcnt vmcnt(0)" ::: "memory");
        } else {
            XB_SPIN(xb_ld(&bar[XB_XGEN(b.x)]) == gen, bar);
            __builtin_amdgcn_fence(__ATOMIC_ACQUIRE, "agent");
            asm volatile("s_waitcnt vmcnt(0)" ::: "memory");
        }
    }
    __syncthreads();
}

struct Args {
    const float* in[19];
    float* out;
    unsigned char* ws;
    int ph_lo, ph_hi, aux, pad;
};

namespace pg8 {
constexpr int BM = 256, BK = 64, HALF = 128, HTB = HALF * BK * 2;
__host__ __device__ __forceinline__ int lds_byte(int r, int c) { const int st = (r >> 4) * 2 + (c >> 5), rr = r & 15, cc = c & 31, ob = rr * 64 + cc * 2; return st * 1024 + (ob ^ (((ob >> 9) & 1) << 5)); }
__host__ __device__ __forceinline__ void stage_rc(int b, int& R, int& C) { const int st = b / 1024, sb = b % 1024, swz = sb ^ (((sb >> 9) & 1) << 5); R = (st >> 1) * 16 + swz / 64; C = (st & 1) * 32 + (swz % 64) / 2; }
__host__ __device__ __forceinline__ int perm32(int rho) { const int n = rho >> 4, i = rho & 15; return 8 * (i >> 2) + 4 * n + (i & 3); }

struct Unit { const char* A; const char* B; int p0, p1, p2, p3, ui; };

#define PG8_SA(b, h) (((b) * 2 + (h)) * HTB)
#define PG8_SB(b, h) ((4 + (b) * 2 + (h)) * HTB)
#define PG8_LDA(dst, b, h) do { _Pragma("unroll") for (int m = 0; m < 4; ++m) _Pragma("unroll") for (int k = 0; k < 2; ++k) dst[m][k] = *(const LAS bf16x8*)(lds + PG8_SA(b, h) + aoff + m * 2048 + k * 1024); } while (0)
#define PG8_LDB(dst, b, h) do { _Pragma("unroll") for (int n = 0; n < 2; ++n) _Pragma("unroll") for (int k = 0; k < 2; ++k) dst[n][k] = *(const LAS bf16x8*)(lds + PG8_SB(b, h) + boff + n * 2048 + k * 1024); } while (0)
#define PG8_MMA(ai, bj, At, Bt) do { __builtin_amdgcn_s_setprio(1); _Pragma("unroll") for (int m = 0; m < 4; ++m) _Pragma("unroll") for (int n = 0; n < 2; ++n) _Pragma("unroll") for (int k = 0; k < 2; ++k) \
        acc[ai][bj][m][n] = __builtin_amdgcn_mfma_f32_16x16x32_bf16(Bt[n][k], At[m][k], acc[ai][bj][m][n], 0, 0, 0); __builtin_amdgcn_s_setprio(0); } while (0)

template <class P>
__device__ __forceinline__ void gemm_simple(LAS unsigned char* lds, const P& S) {
    const int tid = threadIdx.x, wid = __builtin_amdgcn_readfirstlane(tid >> 6), lane = tid & 63, wr = wid >> 2, wc = wid & 3, fr = lane & 15, fq = lane >> 4;
    const int nt = S.nt();
    int R0, C0; stage_rc(tid * 16, R0, C0);
    unsigned offB[2];
#pragma unroll
    for (int i = 0; i < 2; ++i) { const int R = R0 + 64 * i; const int Rb = (R & ~31) + perm32(R & 31); offB[i] = (unsigned)Rb * S.ldb_bytes() + (unsigned)C0 * 2u; }
    const unsigned bhalf = 128u * S.ldb_bytes();
    const int aoff = lds_byte(wr * 64 + fr, fq * 8), boff = lds_byte(wc * 32 + fr, fq * 8);
    Unit u;
    for (int ui = 0; S.next(ui, u); ++ui) {
        unsigned offA[4]; S.aoff(u, R0, C0, offA);
        f32x4 acc[2][2][4][2];
#pragma unroll
        for (int a = 0; a < 2; ++a)
#pragma unroll
            for (int b = 0; b < 2; ++b)
#pragma unroll
                for (int m = 0; m < 4; ++m)
#pragma unroll
                    for (int n = 0; n < 2; ++n) acc[a][b][m][n] = (f32x4){0.f, 0.f, 0.f, 0.f};
        for (int t = 0; t < nt; ++t) {
            u32x4 ra[4], rb[4];
#pragma unroll
            for (int h = 0; h < 2; ++h)
#pragma unroll
                for (int i = 0; i < 2; ++i) {
                    ra[2 * h + i] = *(const u32x4*)(u.A + offA[2 * h + i] + (size_t)t * 128);
                    rb[2 * h + i] = *(const u32x4*)(u.B + (size_t)h * bhalf + offB[i] + (size_t)t * 128);
                }
            __syncthreads();
#pragma unroll
            for (int h = 0; h < 2; ++h)
#pragma unroll
                for (int i = 0; i < 2; ++i) {
                    *(LAS u32x4*)(lds + PG8_SA(0, h) + tid * 16 + i * 8192) = ra[2 * h + i];
                    *(LAS u32x4*)(lds + PG8_SB(0, h) + tid * 16 + i * 8192) = rb[2 * h + i];
                }
            __syncthreads();
            bf16x8 At[4][2], Bt[2][2];
#pragma unroll
            for (int ai = 0; ai < 2; ++ai) {
                PG8_LDA(At, 0, ai);
#pragma unroll
                for (int bj = 0; bj < 2; ++bj) { PG8_LDB(Bt, 0, bj); PG8_MMA(ai, bj, At, Bt); }
            }
        }
        S.epi(acc, u, wr, wc, fr, fq);
    }
    __syncthreads();
}

template <class P>
__device__ __forceinline__ void gemm_pipe(LAS unsigned char* lds, const P& S) {
    const int tid = threadIdx.x, wid = __builtin_amdgcn_readfirstlane(tid >> 6), lane = tid & 63, wr = wid >> 2, wc = wid & 3, fr = lane & 15, fq = lane >> 4;
    constexpr int KR = GEMM_KREP * P::KREP; const int nt1 = S.nt(), nt = nt1 * KR;
    int R0, C0; stage_rc(tid * 16, R0, C0);
    unsigned offB[2];
#pragma unroll
    for (int i = 0; i < 2; ++i) { const int R = R0 + 64 * i; const int Rb = (R & ~31) + perm32(R & 31); offB[i] = (unsigned)Rb * S.ldb_bytes() + (unsigned)C0 * 2u; }
    const size_t bhalf = (size_t)128u * S.ldb_bytes();
    const size_t kstep = 128;
    const unsigned ldsw = (unsigned)wid * 1024u;
    int aoffK[2], boffK[2];
#pragma unroll
    for (int k = 0; k < 2; ++k) { aoffK[k] = lds_byte(wr * 64 + fr, fq * 8) + k * 1024; boffK[k] = lds_byte(wc * 32 + fr, fq * 8) + k * 1024; }
#undef PG8_LDA
#undef PG8_LDB
#undef PG8_MMA
#define PG8_LDA(dst, b, h) do { _Pragma("unroll") for (int m = 0; m < 4; ++m) { \
        if constexpr (P::FP8) dst##8[m] = __builtin_shufflevector(*(const LAS v4i_t*)(lds + PG8_SA(b, h) + aoffK[0] + m * 2048), *(const LAS v4i_t*)(lds + PG8_SA(b, h) + aoffK[1] + m * 2048), 0, 1, 2, 3, 4, 5, 6, 7); \
        else { _Pragma("unroll") for (int k = 0; k < 2; ++k) dst[m][k] = *(const LAS bf16x8*)(lds + PG8_SA(b, h) + aoffK[k] + m * 2048); } } } while (0)
#define PG8_LDB(dst, b, h) do { _Pragma("unroll") for (int n = 0; n < 2; ++n) { \
        if constexpr (P::FP8) dst##8[n] = __builtin_shufflevector(*(const LAS v4i_t*)(lds + PG8_SB(b, h) + boffK[0] + n * 2048), *(const LAS v4i_t*)(lds + PG8_SB(b, h) + boffK[1] + n * 2048), 0, 1, 2, 3, 4, 5, 6, 7); \
        else { _Pragma("unroll") for (int k = 0; k < 2; ++k) dst[n][k] = *(const LAS bf16x8*)(lds + PG8_SB(b, h) + boffK[k] + n * 2048); } } } while (0)
#define PG8_MMA(ai, bj, At, Bt) do { if constexpr (P::FP8) __builtin_amdgcn_sched_barrier(0); __builtin_amdgcn_s_setprio(1); _Pragma("unroll") for (int m = 0; m < 4; ++m) _Pragma("unroll") for (int n = 0; n < 2; ++n) { \
        if constexpr (P::FP8) acc[ai][bj][m][n] = __builtin_amdgcn_mfma_scale_f32_16x16x128_f8f6f4(Bt##8[n], At##8[m], acc[ai][bj][m][n], 0, 0, 0, 127, 0, 127); \
        else { _Pragma("unroll") for (int k = 0; k < 2; ++k) acc[ai][bj][m][n] = __builtin_amdgcn_mfma_f32_16x16x32_bf16(Bt[n][k], At[m][k], acc[ai][bj][m][n], 0, 0, 0); } } \
        if constexpr (P::FP8) { _Pragma("unroll") for (int m = 0; m < 4; ++m) _Pragma("unroll") for (int n = 0; n < 2; ++n) asm volatile("" : "+v"(acc[ai][bj][m][n])); } \
        __builtin_amdgcn_s_setprio(0); if constexpr (P::FP8) __builtin_amdgcn_sched_barrier(0); } while (0)
#define PG8_STAGE_A(bufoff, gbase, OFF, h) do { _Pragma("unroll") for (int _i = 0; _i < 2; ++_i) \
        __builtin_amdgcn_global_load_lds((const unsigned*)((const char*)(gbase) + (OFF)[2 * (h) + _i]), (LAS unsigned*)(lds + (bufoff) + ldsw + _i * 8192), 16, 0, 0); } while (0)
#define PG8_STAGE_B(bufoff, gbase) do { _Pragma("unroll") for (int _i = 0; _i < 2; ++_i) \
        __builtin_amdgcn_global_load_lds((const unsigned*)((const char*)(gbase) + offB[_i]), (LAS unsigned*)(lds + (bufoff) + ldsw + _i * 8192), 16, 0, 0); } while (0)
#define PG8_WAIT_V(n) asm volatile("s_waitcnt vmcnt(" #n ")" ::: "memory")
#define PG8_WAIT_L(n) asm volatile("s_waitcnt lgkmcnt(" #n ")" ::: "memory")
#define PG8_BAR __builtin_amdgcn_s_barrier()
#define PG8_SCHED __builtin_amdgcn_sched_barrier(0)
    Unit cur, nxt; int ui = 0; int pend = -1;
    if (!S.next(0, cur)) return;
    f32x4 acc[2][2][4][2];
#pragma unroll
    for (int a = 0; a < 2; ++a)
#pragma unroll
        for (int b = 0; b < 2; ++b)
#pragma unroll
            for (int m = 0; m < 4; ++m)
#pragma unroll
                for (int n = 0; n < 2; ++n) acc[a][b][m][n] = (f32x4){0.f, 0.f, 0.f, 0.f};
    bf16x8 At[4][2], B0[2][2], B1[2][2];
    v8i_t At8[4], B08[2], B18[2];
    unsigned offC[4], offN[4];
    S.aoff(cur, R0, C0, offC);
    const char* cA = cur.A; const char* cB = cur.B;
    if constexpr (P::HAS_READY) S.a_ready(cur);
    PG8_STAGE_B(PG8_SB(0, 0), cB); PG8_STAGE_B(PG8_SB(0, 1), cB + bhalf); PG8_STAGE_A(PG8_SA(0, 0), cA, offC, 0); PG8_STAGE_A(PG8_SA(0, 1), cA, offC, 1);
    if (wr == 1) PG8_BAR;
    PG8_WAIT_V(2); PG8_BAR;
    PG8_STAGE_B(PG8_SB(1, 0), cB + kstep); PG8_STAGE_A(PG8_SA(1, 0), cA + kstep, offC, 0); PG8_STAGE_B(PG8_SB(1, 1), cB + bhalf + kstep);
    PG8_WAIT_V(6); PG8_BAR;
    for (;;) {
        const bool has_next = S.next(ui + 1, nxt);
        if (has_next) S.aoff(nxt, R0, C0, offN);
        else {
#pragma unroll
            for (int q = 0; q < 4; ++q) offN[q] = offC[q];
        }
        const char* nA = has_next ? nxt.A : cA; const char* nB = has_next ? nxt.B : cB;
        for (int t = 0; t < nt; t += 2) {
            const bool last = (t == nt - 2);
            const bool sf = P::SEAM_OPT && (ui > 0) && (t == 0);
            if constexpr (P::HAS_READY) { if (last && has_next) S.a_ready(nxt); }
            const char* a1 = cA + (size_t)((t + 1) % nt1) * kstep;
            const char* a2 = last ? nA : cA + (size_t)((t + 2) % nt1) * kstep; const char* b2 = last ? nB : cB + (size_t)((t + 2) % nt1) * kstep;
            const char* a3 = a2 + kstep; const char* b3 = b2 + kstep;
            unsigned o2[4];
#pragma unroll
            for (int q = 0; q < 4; ++q) o2[q] = last ? offN[q] : offC[q];
            PG8_LDB(B0, 0, 0); PG8_LDB(B1, 0, 1); PG8_SCHED; PG8_LDA(At, 0, 0); if (!sf) { PG8_STAGE_A(PG8_SA(1, 1), a1, offC, 1); PG8_WAIT_V(8); }
            PG8_WAIT_L(0); PG8_BAR; PG8_MMA(0, 0, At, B0); PG8_MMA(0, 1, At, B1); PG8_BAR; PG8_SCHED;
            PG8_LDA(At, 0, 1); PG8_STAGE_B(PG8_SB(0, 0), b2); PG8_STAGE_B(PG8_SB(0, 1), b2 + bhalf); PG8_STAGE_A(PG8_SA(0, 0), a2, o2, 0);
            if (!sf) PG8_WAIT_V(8); PG8_WAIT_L(0); PG8_BAR; PG8_MMA(1, 0, At, B0); PG8_MMA(1, 1, At, B1); PG8_BAR; PG8_SCHED;
            PG8_LDB(B0, 1, 0); PG8_LDB(B1, 1, 1); PG8_SCHED; PG8_LDA(At, 1, 0); PG8_STAGE_A(PG8_SA(0, 1), a2, o2, 1);
            if (!sf) PG8_WAIT_V(8); PG8_WAIT_L(0); PG8_BAR; PG8_MMA(0, 0, At, B0); PG8_MMA(0, 1, At, B1); PG8_BAR; PG8_SCHED;
            PG8_LDA(At, 1, 1); PG8_STAGE_B(PG8_SB(1, 0), b3); PG8_STAGE_B(PG8_SB(1, 1), b3 + bhalf); PG8_STAGE_A(PG8_SA(1, 0), a3, o2, 0);
            if (!sf) PG8_WAIT_V(8); PG8_WAIT_L(0); PG8_BAR; PG8_MMA(1, 0, At, B0); PG8_MMA(1, 1, At, B1); PG8_BAR; PG8_SCHED;
        }
        if constexpr (P::SEAM_OPT) PG8_STAGE_A(PG8_SA(1, 1), nA + kstep, offN, 1);
        if (wr == 0) PG8_BAR;
        if constexpr (P::SEAM_OPT) { PG8_WAIT_V(0);
            S.flush(pend); pend = -1; }
        if (KR != 1) {
#pragma unroll
            for (int a = 0; a < 2; ++a)
#pragma unroll
                for (int b = 0; b < 2; ++b)
#pragma unroll
                    for (int m = 0; m < 4; ++m)
#pragma unroll
                        for (int n = 0; n < 2; ++n) acc[a][b][m][n] = acc[a][b][m][n] * (1.0f / KR);
        }
        pend = S.epi(acc, cur, wr, wc, fr, fq);
        if constexpr (!P::SEAM_OPT) { if (pend >= 0) { PG8_WAIT_V(0); S.flush(pend); pend = -1; } }
        if (!has_next) break;
#pragma unroll
        for (int a = 0; a < 2; ++a)
#pragma unroll
            for (int b = 0; b < 2; ++b)
#pragma unroll
                for (int m = 0; m < 4; ++m)
#pragma unroll
                    for (int n = 0; n < 2; ++n) acc[a][b][m][n] = (f32x4){0.f, 0.f, 0.f, 0.f};
        cur = nxt; cA = nA; cB = nB; ++ui;
#pragma unroll
        for (int q = 0; q < 4; ++q) offC[q] = offN[q];
        if (wr == 1) PG8_BAR;
    }
    PG8_WAIT_V(0);
    S.flush(pend);
    PG8_BAR;
#undef PG8_STAGE_A
#undef PG8_STAGE_B
#undef PG8_WAIT_V
#undef PG8_WAIT_L
#undef PG8_BAR
#undef PG8_SCHED
}
}

struct Frame {
    LAS unsigned char* lds;
    volatile LAS unsigned* MISC;
    unsigned* ctl;
    int tid, lane, wave, vcu, G;
    unsigned char* ws;
    float* out;
};
typedef const float* cfptr_t;
__device__ __forceinline__ const float* inptr(int i) {
    const __attribute__((address_space(4))) cfptr_t* ka = (const __attribute__((address_space(4))) cfptr_t*)__builtin_amdgcn_kernarg_segment_ptr();
    asm volatile("" : "+s"(ka));
    const GAS float* g = (const GAS float*)ka[i];
    return (const float*)g;
}
#define WSP(F, off, type) ((type*)((F).ws + (off)))

template <class RowMap>
__device__ __forceinline__ void transpose_tile(const float* W, int K, int N, bf16_t* WT, LAS unsigned char* scr, int item, int lane, const RowMap& rm) {
    const int nblk = N / 64, kb = item / nblk, nb = item % nblk, k0 = 64 * kb, n0 = 64 * nb;
    const int kg = lane & 3, ng = lane >> 2;
    f32x4 v[4][4];
#pragma unroll
    for (int r = 0; r < 4; ++r)
#pragma unroll
        for (int i = 0; i < 4; ++i) v[r][i] = __builtin_nontemporal_load((const f32x4*)(W + (size_t)(k0 + 16 * r + 4 * kg + i) * N + n0 + 4 * ng));
#pragma unroll
    for (int r = 0; r < 4; ++r)
#pragma unroll
        for (int j = 0; j < 4; ++j)
            *(LAS u32x2*)(scr + (4 * ng + j) * 144 + (16 * r + 4 * kg) * 2) = (u32x2){cvt_pk_bf16(v[r][0][j], v[r][1][j]), cvt_pk_bf16(v[r][2][j], v[r][3][j])};
    asm volatile("s_waitcnt lgkmcnt(0)" ::: "memory");
    const int c = lane & 7;
#pragma unroll
    for (int q = 0; q < 8; ++q) { const int n = (lane >> 3) + 8 * q; const u32x4 o = *(const LAS u32x4*)(scr + n * 144 + c * 16); __builtin_nontemporal_store(o, (u32x4*)(WT + (size_t)rm(n0 + n) * K + k0 + 8 * c)); }
    asm volatile("s_waitcnt lgkmcnt(0)" ::: "memory");
}
template <class RowMap>
__device__ __forceinline__ void transpose_tile8(const float* W, int K, int N, unsigned char* WT, LAS unsigned char* scr, int item, int lane, const RowMap& rm) {
    const int nblk = N / 64, kb = item / nblk, nb = item % nblk, k0 = 128 * kb, n0 = 64 * nb;
    const int kg = lane & 3, ng = lane >> 2;
#pragma unroll
    for (int hb = 0; hb < 2; ++hb) {
        f32x4 v[4][4];
#pragma unroll
        for (int r = 0; r < 4; ++r)
#pragma unroll
            for (int i = 0; i < 4; ++i) v[r][i] = __builtin_nontemporal_load((const f32x4*)(W + (size_t)(k0 + 64 * hb + 16 * r + 4 * kg + i) * N + n0 + 4 * ng));
#pragma unroll
        for (int r = 0; r < 4; ++r)
#pragma unroll
            for (int j = 0; j < 4; ++j)
                *(LAS unsigned*)(scr + (4 * ng + j) * 144 + 64 * hb + 16 * r + 4 * kg) = pack_fp8x4(v[r][0][j] * W8_SCALE, v[r][1][j] * W8_SCALE, v[r][2][j] * W8_SCALE, v[r][3][j] * W8_SCALE);
    }
    asm volatile("s_waitcnt lgkmcnt(0)" ::: "memory");
    const int c = lane & 7;
#pragma unroll
    for (int q = 0; q < 8; ++q) { const int n = (lane >> 3) + 8 * q; const u32x4 o = *(const LAS u32x4*)(scr + n * 144 + c * 16); __builtin_nontemporal_store(o, (u32x4*)(WT + (size_t)rm(n0 + n) * K + k0 + 16 * c)); }
    asm volatile("s_waitcnt lgkmcnt(0)" ::: "memory");
}
struct RmId { __device__ __forceinline__ int operator()(int n) const { return n; } };
struct RmWin { __device__ __forceinline__ int operator()(int n) const {
        const int s = n >> 9; if (s != 4 && s != 5) return n;
        const int d = n & 127, dd = d & 63; const int p = 8 * (dd >> 2) + (dd & 3) + ((d >> 6) << 2); return n - d + p; } };
struct RmGu { __device__ __forceinline__ int operator()(int n) const { const int half = n >> 10, j = (n & 1023) >> 7, i = n & 127; return 256 * j + 128 * half + i; } };

__device__ __forceinline__ void p0_prologue(Frame& F) {
    const int tid = F.tid;
    {
        LAS float* red = (LAS float*)F.lds;
        const float* c = inptr(1);
        for (int u = F.vcu; u < 192; u += F.G) {
            const int l = u / 96, cg = u % 96, kq = tid >> 4, cq = tid & 15;
            const float* W = inptr(2) + (size_t)l * D * 6 * D + cg * 64 + cq * 4;
            f32x4 a = {0.f, 0.f, 0.f, 0.f};
#pragma unroll 8
            for (int j = 0; j < 32; ++j) { const int k = kq + 32 * j; const float cv = siluf_(c[k]); const f32x4 w = *(const f32x4*)(W + (size_t)k * 6 * D); a += w * cv; }
            __syncthreads();
            *(LAS f32x4*)(red + kq * 64 + cq * 4) = a;
            __syncthreads();
            if (tid < 64) { float s = 0.f;
#pragma unroll 8
                for (int k = 0; k < 32; ++k) s += red[k * 64 + tid];
                const int col = cg * 64 + tid;
                WSP(F, WS_MOD, float)[l * 6 * D + col] = s + inptr(3)[l * 6 * D + col]; }
        }
        __syncthreads();
    }
    if (F.vcu == 0) { const float* hb = inptr(5); const float a = hb[tid], b = hb[512 + tid]; WSP(F, WS_LB, float)[tid] = 1.0f / (1.0f + __expf(b - a)); }
    {
        bf16_t* rt = WSP(F, WS_RT, bf16_t); const float* wr = inptr(12);
        for (int idx = F.vcu * NTH + tid; idx < 2 * D * NE; idx += F.G * NTH) {
            const int l = idx >> 15, rem = idx & 32767, c = rem >> 5, e = rem & 31;
            const float w = wr[idx]; const unsigned hi = cvt_pk_bf16(w, 0.f) & 0xffffu; const float res = w - bflo(hi);
            rt[((size_t)(l * 2 + 0) * 32 + e) * D + c] = (bf16_t)hi; rt[((size_t)(l * 2 + 1) * 32 + e) * D + c] = (bf16_t)(cvt_pk_bf16(res, 0.f) & 0xffffu);
        }
    }
    {
        f32x2* rope = WSP(F, WS_ROPE, f32x2);
        for (int idx = F.vcu * NTH + tid; idx < T * 64; idx += F.G * NTH) {
            const int t = idx >> 6, d = idx & 63;
            const float inv = exp2f(-(float)d * (13.287712379549449f / 64.0f));
            const float ang = (float)t * inv;
            const double a = (double)ang; const double n = __builtin_rint(a * 0.15915494309189535); const double r = __builtin_fma(-n, 6.283185307179586, a);
            const float rf = (float)r;
            rope[idx] = (f32x2){__cosf(rf), __sinf(rf)};
        }
    }
    {
        LAS unsigned char* scr = F.lds + F.wave * 16384;
        const int gw = F.vcu * NWAVES + F.wave, NGW = F.G * NWAVES;
        constexpr int I_IN = 16 * 64, I_OUT = 16 * 16, I_POOL = 4 * 4 * 4;
        constexpr int NL8 = ((FP8_LAYERS & 1) ? 1 : 0) + ((FP8_LAYERS & 2) ? 1 : 0), NL16 = 2 - NL8;
        constexpr int S_GU = 32 * 8 * 32, S_DN = 32 * 8 * 16;
        constexpr int T_GU = 32 * 16 * 32, T_DN = 32 * 16 * 16;
        constexpr int N8 = NL8 * (S_GU + S_DN), N16 = NL16 * (T_GU + T_DN);
        constexpr int NITEMS = N8 + I_IN + I_OUT + I_POOL + N16;
        for (int it = gw; it < NITEMS; it += NGW) {
            int r = it;
            if (r < N8) {
                const int li = r / (S_GU + S_DN), layer = (NL8 == 2) ? li : ((FP8_LAYERS & 1) ? 0 : 1); r -= li * (S_GU + S_DN);
                if (r < S_GU) { const int m = layer * 32 + r / 256; transpose_tile8(inptr(14) + (size_t)m * D * 2048, D, 2048, (unsigned char*)(WSP(F, WS_WGUT, bf16_t) + (size_t)layer * NE * 2048 * D) + (size_t)(m & 31) * 2048 * D, scr, r % 256, F.lane, RmGu()); }
                else { r -= S_GU; const int m = layer * 32 + r / 128; transpose_tile8(inptr(16) + (size_t)m * D * D, D, D, (unsigned char*)(WSP(F, WS_WDNT, bf16_t) + (size_t)layer * NE * D * D) + (size_t)(m & 31) * D * D, scr, r % 128, F.lane, RmId()); }
                continue;
            }
            r -= N8;
            if (r < I_IN) { transpose_tile(inptr(4), D, INW, WSP(F, WS_WINT, bf16_t), scr, r, F.lane, RmWin()); continue; } r -= I_IN;
            if (r < I_OUT) { transpose_tile(inptr(8), D, D, WSP(F, WS_WOUTT, bf16_t), scr, r, F.lane, RmId()); continue; } r -= I_OUT;
            if (r < I_POOL) { const int g = r / 16; transpose_tile(inptr(9) + (size_t)g * 65536, 256, 256, WSP(F, WS_POOLT, bf16_t) + (size_t)g * 65536, scr, r % 16, F.lane, RmId()); continue; } r -= I_POOL;
            if (NL16 > 0) {
                const int li = r / (T_GU + T_DN), layer = (NL16 == 2) ? li : ((FP8_LAYERS & 1) ? 1 : 0); r -= li * (T_GU + T_DN);
                if (r < T_GU) { const int m = layer * 32 + r / 512; transpose_tile(inptr(14) + (size_t)m * D * 2048, D, 2048, WSP(F, WS_WGUT, bf16_t) + (size_t)m * 2048 * D, scr, r % 512, F.lane, RmGu()); }
                else { r -= T_GU; const int m = layer * 32 + r / 256; transpose_tile(inptr(16) + (size_t)m * D * D, D, D, WSP(F, WS_WDNT, bf16_t) + (size_t)m * D * D, scr, r % 256, F.lane, RmId()); }
            }
        }
    }
}

__device__ __forceinline__ void p1_norm_in(Frame& F) {
    const float* mod = WSP(F, WS_MOD, float);
    f32x4 sh[4], sc[4];
#pragma unroll
    for (int j = 0; j < 4; ++j) { sh[j] = *(const f32x4*)(mod + 0 * D + 4 * F.lane + 256 * j); sc[j] = *(const f32x4*)(mod + 1 * D + 4 * F.lane + 256 * j) + 1.0f; }
    const int gw = F.vcu * NWAVES + F.wave, NGW = F.G * NWAVES;
    for (int row = gw; row < T; row += NGW) {
        const f32x4* xr = (const f32x4*)(inptr(0) + (size_t)row * D) + F.lane;
        f32x4 v[4]; float s = 0.f;
#pragma unroll
        for (int j = 0; j < 4; ++j) { v[j] = xr[64 * j]; s += (v[j].x * v[j].x + v[j].y * v[j].y) + (v[j].z * v[j].z + v[j].w * v[j].w); }
        const float rstd = rsqrtf(wave_sum(s) * (1.f / D) + EPS);
        u32x2* o = (u32x2*)(WSP(F, WS_HN, bf16_t) + (size_t)row * D) + F.lane;
#pragma unroll
        for (int j = 0; j < 4; ++j) { const f32x4 h = v[j] * rstd * sc[j] + sh[j]; o[64 * j] = (u32x2){cvt_pk_bf16(h.x, h.y), cvt_pk_bf16(h.z, h.w)}; }
    }
}

using pg8::Unit;
typedef f32x4 AccT[2][2][4][2];

struct GemmBase {
    static constexpr bool SEAM_OPT = false;
    __device__ __forceinline__ void flush(int) const {}
    static constexpr bool HAS_READY = false;
    static constexpr bool FP8 = false;
    int G, vcu;
    __device__ __forceinline__ void aoff_lin(int R0, int C0, unsigned lda_bytes, unsigned (&off)[4]) const {
#pragma unroll
        for (int q = 0; q < 4; ++q) off[q] = (unsigned)(R0 + 64 * (q & 1) + 128 * (q >> 1)) * lda_bytes + (unsigned)C0 * 2u;
    }
};

struct PolWin : GemmBase {
    static constexpr int KREP = KREP_WIN;
    const bf16_t* A; const bf16_t* Bt; bf16_t* qkvg; _Float16* gbuf; const float* lb; const f32x2* rope;
    __device__ __forceinline__ int nt() const { return D / 64; }
    __device__ __forceinline__ unsigned ldb_bytes() const { return D * 2; }
    __device__ __forceinline__ bool next(int i, Unit& u) const {
        const int V = i * G + vcu; if (V >= 64 * 16) return false;
        u.p0 = V >> 4; u.p1 = V & 15; u.A = (const char*)(A + (size_t)u.p0 * 256 * D); u.B = (const char*)(Bt + (size_t)u.p1 * 256 * D); return true; }
    __device__ __forceinline__ void aoff(const Unit&, int R0, int C0, unsigned (&off)[4]) const { aoff_lin(R0, C0, D * 2, off); }
    __device__ __forceinline__ int epi(const AccT& acc, const Unit& u, int wr, int wc, int fr, int fq) const {
        const int pm = u.p0, pn = u.p1, s = pn >> 1;
        const int row0 = pm * 256 + wr * 64 + fr;
        const int o0 = (pn & 1) * 256 + wc * 32 + 8 * fq;
        const int dbase = (s & 3) * 1024 + (s >> 2) * 512;
        bf16_t* obase = qkvg + (size_t)row0 * INW + dbase;
        if (s == 4 || s == 5) {
            const int d0 = 4 * ((o0 & 127) >> 3);
            const float qs = (s == 5) ? 0.08838834764831845f : 1.0f;
#pragma unroll
            for (int ah = 0; ah < 2; ++ah) {
                f32x4 rc[4][2];
#pragma unroll
                for (int m = 0; m < 4; ++m) { const f32x4* rp = (const f32x4*)(rope + (size_t)(row0 + ah * 128 + m * 16) * 64 + d0); rc[m][0] = rp[0]; rc[m][1] = rp[1]; }
#pragma unroll
                for (int m = 0; m < 4; ++m) {
                    const f32x4 cs = {rc[m][0].x * qs, rc[m][0].z * qs, rc[m][1].x * qs, rc[m][1].z * qs}, sn = {rc[m][0].y * qs, rc[m][0].w * qs, rc[m][1].y * qs, rc[m][1].w * qs};
                    bf16_t* orow = obase + (size_t)(ah * 128 + m * 16) * INW;
#pragma unroll
                    for (int bj = 0; bj < 2; ++bj) {
                        const int hd = (o0 + bj * 128) & ~127;
                        const f32x4 v0 = acc[ah][bj][m][0], v1 = acc[ah][bj][m][1];
                        const f32x4 o1 = v0 * cs - v1 * sn, o2 = v0 * sn + v1 * cs;
                        *(u32x2*)(orow + hd + d0) = (u32x2){cvt_pk_bf16(o1.x, o1.y), cvt_pk_bf16(o1.z, o1.w)};
                        *(u32x2*)(orow + hd + d0 + 64) = (u32x2){cvt_pk_bf16(o2.x, o2.y), cvt_pk_bf16(o2.z, o2.w)};
                    }
                }
            }
        } else if (s == 1) {
            f32x4 l[2][2];
#pragma unroll
            for (int bj = 0; bj < 2; ++bj) { l[bj][0] = *(const f32x4*)(lb + o0 + bj * 128); l[bj][1] = *(const f32x4*)(lb + o0 + bj * 128 + 4); }
#pragma unroll
            for (int am = 0; am < 8; ++am) {
                const size_t ro = (size_t)((am >> 2) * 128 + (am & 3) * 16);
#pragma unroll
                for (int bj = 0; bj < 2; ++bj) {
                    const int o = o0 + bj * 128;
                    f32x4 v0 = acc[am >> 2][bj][am & 3][0], v1 = acc[am >> 2][bj][am & 3][1], g0, g1;
#pragma unroll
                    for (int j = 0; j < 4; ++j) {
                        const float f0 = l[bj][0][j] + (1.0f - l[bj][0][j]) * sigmoidf_(v0[j]), f1 = l[bj][1][j] + (1.0f - l[bj][1][j]) * sigmoidf_(v1[j]);
                        g0[j] = __logf(f0); g1[j] = __logf(f1); v0[j] = 1.0f - f0; v1[j] = 1.0f - f1; }
                    *(h16x8*)(gbuf + ((size_t)row0 + ro) * 512 + o) = (h16x8){(_Float16)g0[0], (_Float16)g0[1], (_Float16)g0[2], (_Float16)g0[3], (_Float16)g1[0], (_Float16)g1[1], (_Float16)g1[2], (_Float16)g1[3]};
                    u32x4 w; w.x = cvt_pk_bf16(v0[0], v0[1]); w.y = cvt_pk_bf16(v0[2], v0[3]); w.z = cvt_pk_bf16(v1[0], v1[1]); w.w = cvt_pk_bf16(v1[2], v1[3]);
                    *(u32x4*)(obase + ro * INW + o) = w;
                }
            }
        } else {
            const bool act = (s == 0 || s == 3 || s == 7);
#pragma unroll
            for (int am = 0; am < 8; ++am) {
                const size_t ro = (size_t)((am >> 2) * 128 + (am & 3) * 16);
#pragma unroll
                for (int bj = 0; bj < 2; ++bj) {
                    f32x4 v0 = acc[am >> 2][bj][am & 3][0], v1 = acc[am >> 2][bj][am & 3][1];
                    if (act) {
#pragma unroll
                        for (int j = 0; j < 4; ++j) { v0[j] = siluf_(v0[j]); v1[j] = siluf_(v1[j]); }
                    }
                    u32x4 w; w.x = cvt_pk_bf16(v0[0], v0[1]); w.y = cvt_pk_bf16(v0[2], v0[3]); w.z = cvt_pk_bf16(v1[0], v1[1]); w.w = cvt_pk_bf16(v1[2], v1[3]);
                    *(u32x4*)(obase + ro * INW + o0 + bj * 128) = w;
                }
            }
        }
            return -1;
    }
};

template <bool R16>
struct PolRes : GemmBase {
    static constexpr int KREP = KREP_RES;
    const bf16_t* A; const bf16_t* Bt; const float* resid; const bf16_t* resid16; bf16_t* outp; const float* gate; const float* bias; const float* scale;
    int K, lda, nN, kcol;
    __device__ __forceinline__ int nt() const { return K / 64; }
    __device__ __forceinline__ unsigned ldb_bytes() const { return (unsigned)K * 2u; }
    __device__ __forceinline__ bool next(int i, Unit& u) const {
        const int V = i * G + vcu; if (V >= 64 * nN) return false;
        u.p0 = V / nN; u.p1 = V % nN; u.A = (const char*)(A + (size_t)u.p0 * 256 * lda + (size_t)u.p1 * kcol); u.B = (const char*)(Bt + (size_t)u.p1 * 256 * K); return true; }
    __device__ __forceinline__ void aoff(const Unit&, int R0, int C0, unsigned (&off)[4]) const { aoff_lin(R0, C0, (unsigned)lda * 2u, off); }
    __device__ __forceinline__ int epi(const AccT& acc, const Unit& u, int wr, int wc, int fr, int fq) const {
        const int row0 = u.p0 * 256 + wr * 64 + fr, col0 = u.p1 * 256 + wc * 32 + 8 * fq;
#pragma unroll
        for (int bj = 0; bj < 2; ++bj) {
            const int c = col0 + bj * 128;
            const f32x4 g0 = *(const f32x4*)(gate + c), g1 = *(const f32x4*)(gate + c + 4);
            f32x4 b0 = {0.f, 0.f, 0.f, 0.f}, b1 = b0, s0 = {1.f, 1.f, 1.f, 1.f}, s1 = s0;
            if (bias) { b0 = *(const f32x4*)(bias + c); b1 = *(const f32x4*)(bias + c + 4); s0 = *(const f32x4*)(scale + c); s1 = *(const f32x4*)(scale + c + 4); }
#pragma unroll
            for (int ah = 0; ah < 2; ++ah) {
                f32x4 r[4][2];
                if constexpr (!R16) {
#pragma unroll
                    for (int m = 0; m < 4; ++m) { const size_t idx = (size_t)(row0 + ah * 128 + m * 16) * D + c; r[m][0] = *(const f32x4*)(resid + idx); r[m][1] = *(const f32x4*)(resid + idx + 4); }
                } else {
                    u32x4 q[4];
#pragma unroll
                    for (int m = 0; m < 4; ++m) q[m] = *(const u32x4*)(resid16 + (size_t)(row0 + ah * 128 + m * 16) * D + c);
#pragma unroll
                    for (int m = 0; m < 4; ++m) { r[m][0] = (f32x4){bflo(q[m].x), bfhi(q[m].x), bflo(q[m].y), bfhi(q[m].y)}; r[m][1] = (f32x4){bflo(q[m].z), bfhi(q[m].z), bflo(q[m].w), bfhi(q[m].w)}; }
                }
#pragma unroll
                for (int m = 0; m < 4; ++m) {
                    const size_t idx = (size_t)(row0 + ah * 128 + m * 16) * D + c;
                    const f32x4 o0 = r[m][0] + g0 * ((acc[ah][bj][m][0] + b0) * s0), o1 = r[m][1] + g1 * ((acc[ah][bj][m][1] + b1) * s1);
                    *(u32x4*)(outp + idx) = (u32x4){cvt_pk_bf16(o0.x, o0.y), cvt_pk_bf16(o0.z, o0.w), cvt_pk_bf16(o1.x, o1.y), cvt_pk_bf16(o1.z, o1.w)};
                }
            }
        }
            return -1;
    }
};

constexpr int MI_TPRE = 16, MI_CNT = 64, MI_MT2E = 128;
__device__ __forceinline__ void expert_tables(Frame& F, int layer) {
    if (F.tid < 64) {
        const int lane = F.lane;
        int c = 0;
        if (lane < NE) { c = (int)__hip_atomic_load(F.ctl + CW_CNT + 64 * layer + lane, __ATOMIC_RELAXED, __HIP_MEMORY_SCOPE_AGENT); if (c > LIST_CAP) c = LIST_CAP; }
        const int nt_ = (c + 255) >> 8;
        int pre = nt_;
#pragma unroll
        for (int off = 1; off < 32; off <<= 1) { const int v = __shfl_up(pre, off); if (lane >= off) pre += v; }
        const int excl = pre - nt_;
        if (lane < NE) { F.MISC[MI_TPRE + lane] = excl; F.MISC[MI_CNT + lane] = c; for (int q = 0; q < nt_; ++q) F.MISC[MI_MT2E + excl + q] = lane; }
        if (lane == NE - 1) F.MISC[MI_TPRE + NE] = pre;
    }
    __syncthreads();
}
constexpr int UPA_OFF = 131072;
struct PolG1 : GemmBase {
    static constexpr int KREP = KREP_G1;
    volatile LAS unsigned* MISC; LAS unsigned char* upa; const bf16_t* hn; const bf16_t* wgut; const float* bgu; const int* lslot; bf16_t* act;
    __device__ __forceinline__ int nt() const { return D / 64; }
    __device__ __forceinline__ unsigned ldb_bytes() const { return D * 2; }
    __device__ __forceinline__ bool next(int i, Unit& u) const {
        const int V = i * G + vcu, MT = (int)MISC[MI_TPRE + NE]; if (V >= MT * 8 || i >= 10) return false;
        const int mt = V >> 3, nt_ = V & 7, e = (int)MISC[MI_MT2E + mt];
        u.p0 = e; u.p1 = mt - (int)MISC[MI_TPRE + e]; u.p2 = nt_; u.p3 = mt; u.ui = i;
        u.A = (const char*)hn; u.B = (const char*)(wgut + ((size_t)e * 2048 + (size_t)nt_ * 256) * D); return true; }
    __device__ __forceinline__ void fill(int tid) const {
#pragma unroll
        for (int k = 0; k < 5; ++k) {
            const int j = tid + NTH * k, i = j >> 8, r = j & 255; Unit u;
            if (next(i, u)) {
                const int cnt = (int)MISC[MI_CNT + u.p0], li = u.p1 * 256 + r;
                ((LAS int*)(upa + i * 2048))[r] = (li < cnt) ? (lslot[(size_t)u.p0 * LIST_CAP + li] >> 2) : 0;
                ((LAS float*)(upa + i * 2048 + 1024))[r] = bgu[(size_t)u.p0 * 2048 + (r >> 7) * 1024 + u.p2 * 128 + (r & 127)];
            }
        }
    }
    __device__ __forceinline__ void aoff(const Unit& u, int R0, int C0, unsigned (&off)[4]) const {
        const LAS int* tk = (const LAS int*)(upa + u.ui * 2048);
#pragma unroll
        for (int q = 0; q < 4; ++q) off[q] = (unsigned)tk[R0 + 64 * (q & 1) + 128 * (q >> 1)] * (D * 2u) + (unsigned)C0 * 2u;
    }
    __device__ __forceinline__ int epi(const AccT& acc, const Unit& u, int wr, int wc, int fr, int fq) const {
        const int cl = wc * 32 + 8 * fq;
        const LAS float* bg = (const LAS float*)(upa + u.ui * 2048 + 1024);
        const f32x4 bgl0 = *(const LAS f32x4*)(bg + cl), bgl1 = *(const LAS f32x4*)(bg + cl + 4), bln0 = *(const LAS f32x4*)(bg + 128 + cl), bln1 = *(const LAS f32x4*)(bg + 128 + cl + 4);
        bf16_t* base = act + ((size_t)u.p3 * 256 + wr * 64 + fr) * D + u.p2 * 128 + cl;
#pragma unroll
        for (int ai = 0; ai < 2; ++ai)
#pragma unroll
            for (int m = 0; m < 4; ++m) {
                f32x4 gl0 = acc[ai][0][m][0] + bgl0, gl1 = acc[ai][0][m][1] + bgl1, ln0 = acc[ai][1][m][0] + bln0, ln1 = acc[ai][1][m][1] + bln1;
                f32x4 a0, a1;
#pragma unroll
                for (int j = 0; j < 4; ++j) {
                    const float x0 = fminf(gl0[j], SW_LIMIT), x1 = fminf(gl1[j], SW_LIMIT);
                    const float y0 = fminf(fmaxf(ln0[j], -SW_LIMIT), SW_LIMIT), y1 = fminf(fmaxf(ln1[j], -SW_LIMIT), SW_LIMIT);
                    a0[j] = x0 * sigmoidf_(SW_ALPHA * x0) * (y0 + 1.0f); a1[j] = x1 * sigmoidf_(SW_ALPHA * x1) * (y1 + 1.0f); }
                u32x4 w; w.x = cvt_pk_bf16(a0[0], a0[1]); w.y = cvt_pk_bf16(a0[2], a0[3]); w.z = cvt_pk_bf16(a1[0], a1[1]); w.w = cvt_pk_bf16(a1[2], a1[3]);
                *(u32x4*)(base + (size_t)(ai * 128 + m * 16) * D) = w;
            }
            return -1;
    }
};
struct PolG2 : GemmBase {
    static constexpr int KREP = KREP_G2;
    volatile LAS unsigned* MISC; LAS unsigned char* upa; const bf16_t* act; const bf16_t* wdnt; const float* bdn; const int* lslot; const float* lw; bf16_t* yslot;
    __device__ __forceinline__ int nt() const { return D / 64; }
    __device__ __forceinline__ unsigned ldb_bytes() const { return D * 2; }
    __device__ __forceinline__ bool next(int i, Unit& u) const {
        const int V = i * G + vcu, MT = (int)MISC[MI_TPRE + NE]; if (V >= MT * 4 || i >= 6) return false;
        const int mt = V >> 2, nt_ = V & 3, e = (int)MISC[MI_MT2E + mt];
        u.p0 = e; u.p1 = mt - (int)MISC[MI_TPRE + e]; u.p2 = nt_; u.p3 = mt; u.ui = i;
        u.A = (const char*)(act + (size_t)mt * 256 * D); u.B = (const char*)(wdnt + ((size_t)e * D + (size_t)nt_ * 256) * D); return true; }
    __device__ __forceinline__ void fill(int tid) const {
#pragma unroll
        for (int k = 0; k < 3; ++k) {
            const int j = tid + NTH * k, i = j >> 8, r = j & 255; Unit u;
            if (next(i, u)) {
                const int cnt = (int)MISC[MI_CNT + u.p0], li = u.p1 * 256 + r; const bool ok = li < cnt;
                ((LAS int*)(upa + i * 3072))[r] = ok ? lslot[(size_t)u.p0 * LIST_CAP + li] : -1;
                ((LAS float*)(upa + i * 3072 + 1024))[r] = ok ? lw[(size_t)u.p0 * LIST_CAP + li] : 0.f;
                ((LAS float*)(upa + i * 3072 + 2048))[r] = bdn[(size_t)u.p0 * D + u.p2 * 256 + r];
            }
        }
    }
    __device__ __forceinline__ void aoff(const Unit&, int R0, int C0, unsigned (&off)[4]) const { aoff_lin(R0, C0, D * 2, off); }
    __device__ __forceinline__ int epi(const AccT& acc, const Unit& u, int wr, int wc, int fr, int fq) const {
        const int cl = wc * 32 + 8 * fq;
        const LAS int* sl = (const LAS int*)(upa + u.ui * 3072); const LAS float* wl = (const LAS float*)(upa + u.ui * 3072 + 1024); const LAS float* bd = (const LAS float*)(upa + u.ui * 3072 + 2048);
        f32x4 b[2][2];
#pragma unroll
        for (int bj = 0; bj < 2; ++bj) { b[bj][0] = *(const LAS f32x4*)(bd + cl + bj * 128); b[bj][1] = *(const LAS f32x4*)(bd + cl + bj * 128 + 4); }
#pragma unroll
        for (int ai = 0; ai < 2; ++ai)
#pragma unroll
            for (int m = 0; m < 4; ++m) {
                const int rl = ai * 128 + wr * 64 + m * 16 + fr;
                const int slot = sl[rl]; const float w = wl[rl];
                if (slot >= 0) {
                    bf16_t* yr = yslot + (size_t)slot * D + u.p2 * 256 + cl;
#pragma unroll
                    for (int bj = 0; bj < 2; ++bj) {
                        const f32x4 v0 = (acc[ai][bj][m][0] + b[bj][0]) * w, v1 = (acc[ai][bj][m][1] + b[bj][1]) * w;
                        u32x4 o; o.x = cvt_pk_bf16(v0[0], v0[1]); o.y = cvt_pk_bf16(v0[2], v0[3]); o.z = cvt_pk_bf16(v1[0], v1[1]); o.w = cvt_pk_bf16(v1[2], v1[3]);
                        *(u32x4*)(yr + bj * 128) = o;
                    }
                }
            }
            return -1;
    }
};

typedef unsigned v4u_t __attribute__((ext_vector_type(4)));
template <bool F8>
struct PolMoE : GemmBase {
    static constexpr int KREP = 1;
    static constexpr bool HAS_READY = true;
    static constexpr bool FP8 = F8;
    static constexpr bool SEAM_OPT = true;
    static constexpr int EB = F8 ? 1 : 2;
    volatile LAS unsigned* MISC; LAS unsigned char* upa; const bf16_t* hn; const bf16_t* wgut; const float* bgu; const int* lslot; const float* lw; bf16_t* act;
    const bf16_t* wdnt; const float* bdn; bf16_t* yslot; unsigned* done; unsigned* tmo; __amdgpu_buffer_rsrc_t act_rsrc;
    __device__ __forceinline__ int nt() const { return D * EB / 128; }
    __device__ __forceinline__ unsigned ldb_bytes() const { return D * EB; }
    __device__ __forceinline__ bool next(int i, Unit& u) const {
        const int V = i * G + vcu, MT = (int)MISC[MI_TPRE + NE], N1 = MT * 8; if (i >= 14 || V >= MT * 12) return false;
        u.ui = i;
        if (V < N1) { const int mt = V >> 3, nt_ = V & 7, e = (int)MISC[MI_MT2E + mt];
            u.p0 = e; u.p1 = mt - (int)MISC[MI_TPRE + e]; u.p2 = nt_; u.p3 = mt;
            u.A = (const char*)hn; u.B = (const char*)wgut + ((size_t)e * 2048 + (size_t)nt_ * 256) * D * EB; }
        else { const int V2 = V - N1, mt = V2 >> 2, nt_ = V2 & 3, e = (int)MISC[MI_MT2E + mt];
            u.p0 = e; u.p1 = mt - (int)MISC[MI_TPRE + e]; u.p2 = nt_ | 8; u.p3 = mt;
            u.A = (const char*)act + (size_t)mt * 256 * D * EB; u.B = (const char*)wdnt + ((size_t)e * D + (size_t)nt_ * 256) * D * EB; }
        return true; }
    __device__ __forceinline__ void fill(int tid) const {
#pragma unroll
        for (int k = 0; k < 7; ++k) {
            const int j = tid + NTH * k, i = j >> 8, r = j & 255; Unit u;
            if (next(i, u)) {
                const int cnt = (int)MISC[MI_CNT + u.p0], li = u.p1 * 256 + r; const bool ok = li < cnt;
                if (!(u.p2 & 8)) {
                    ((LAS int*)(upa + i * 2048))[r] = ok ? (lslot[(size_t)u.p0 * LIST_CAP + li] >> 2) : 0;
                    ((LAS float*)(upa + i * 2048 + 1024))[r] = bgu[(size_t)u.p0 * 2048 + (r >> 7) * 1024 + u.p2 * 128 + (r & 127)];
                } else {
                    unsigned pk = 0xffff0000u;
                    if (ok) { const unsigned sl = (unsigned)lslot[(size_t)u.p0 * LIST_CAP + li]; const float w = lw[(size_t)u.p0 * LIST_CAP + li]; pk = (sl & 0xffffu) | (cvt_pk_bf16(0.f, w) & 0xffff0000u); }
                    ((LAS unsigned*)(upa + i * 2048))[r] = pk;
                    ((LAS float*)(upa + i * 2048 + 1024))[r] = bdn[(size_t)u.p0 * D + (u.p2 & 7) * 256 + r];
                }
            }
        }
    }
    __device__ __forceinline__ void aoff(const Unit& u, int R0, int C0, unsigned (&off)[4]) const {
        if (!(u.p2 & 8)) { const LAS int* tk = (const LAS int*)(upa + u.ui * 2048);
#pragma unroll
            for (int q = 0; q < 4; ++q) off[q] = (unsigned)tk[R0 + 64 * (q & 1) + 128 * (q >> 1)] * (unsigned)(D * EB) + (unsigned)C0 * 2u;
        } else aoff_lin(R0, C0, D * EB, off);
    }
    __device__ __forceinline__ void flush(int pend) const {
        if (pend >= 0 && (threadIdx.x & 63) == 0) (void)__hip_atomic_fetch_add(done + 64 * pend, 1u, __ATOMIC_RELAXED, __HIP_MEMORY_SCOPE_AGENT);
    }
    __device__ __forceinline__ void a_ready(const Unit& u) const {
        if (!(u.p2 & 8)) return;
        if (threadIdx.x < 64) {
            unsigned* w = done + 64 * u.p3; unsigned polls = 0;
            while ((unsigned)__builtin_amdgcn_readfirstlane(__hip_atomic_load(w, __ATOMIC_RELAXED, __HIP_MEMORY_SCOPE_AGENT)) < 64u) {
                __builtin_amdgcn_s_sleep(2);
                if ((++polls & 1023u) == 0u) { if (__builtin_amdgcn_readfirstlane(__hip_atomic_load(tmo, __ATOMIC_RELAXED, __HIP_MEMORY_SCOPE_AGENT)) != 0u) break;
                    if (polls > (1u << 22)) { if (threadIdx.x == 0) __hip_atomic_store(tmo, 1u, __ATOMIC_RELAXED, __HIP_MEMORY_SCOPE_AGENT); break; } }
            }
            __builtin_amdgcn_fence(__ATOMIC_ACQUIRE, "agent");
            asm volatile("s_waitcnt vmcnt(0)" ::: "memory");
        }
        asm volatile("" ::: "memory"); __builtin_amdgcn_s_barrier(); asm volatile("" ::: "memory");
    }
    __device__ __forceinline__ int epi(const AccT& acc, const Unit& u, int wr, int wc, int fr, int fq) const {
        const int cl = wc * 32 + 8 * fq;
        if (!(u.p2 & 8)) {
            const LAS float* bg = (const LAS float*)(upa + u.ui * 2048 + 1024);
            const f32x4 bgl0 = *(const LAS f32x4*)(bg + cl), bgl1 = *(const LAS f32x4*)(bg + cl + 4), bln0 = *(const LAS f32x4*)(bg + 128 + cl), bln1 = *(const LAS f32x4*)(bg + 128 + cl + 4);
            const unsigned boff = (unsigned)((((size_t)u.p3 * 256 + wr * 64 + fr) * D + u.p2 * 128 + cl) * EB);
            constexpr float ws = F8 ? (1.0f / W8_SCALE) : 1.0f;
#pragma unroll
            for (int ai = 0; ai < 2; ++ai)
#pragma unroll
                for (int m = 0; m < 4; ++m) {
                    f32x4 gl0 = acc[ai][0][m][0] * ws + bgl0, gl1 = acc[ai][0][m][1] * ws + bgl1, ln0 = acc[ai][1][m][0] * ws + bln0, ln1 = acc[ai][1][m][1] * ws + bln1;
                    f32x4 a0, a1;
#pragma unroll
                    for (int j = 0; j < 4; ++j) {
                        const float x0 = fminf(gl0[j], SW_LIMIT), x1 = fminf(gl1[j], SW_LIMIT);
                        const float y0 = fminf(fmaxf(ln0[j], -SW_LIMIT), SW_LIMIT), y1 = fminf(fmaxf(ln1[j], -SW_LIMIT), SW_LIMIT);
                        a0[j] = x0 * sigmoidf_(SW_ALPHA * x0) * (y0 + 1.0f); a1[j] = x1 * sigmoidf_(SW_ALPHA * x1) * (y1 + 1.0f); }
                    if constexpr (F8) { u32x2 w8 = {pack_fp8x4(a0[0], a0[1], a0[2], a0[3]), pack_fp8x4(a1[0], a1[1], a1[2], a1[3])};
                        __builtin_amdgcn_raw_buffer_store_b64(w8, act_rsrc, boff + (unsigned)((ai * 128 + m * 16) * D), 0,   16); }
                    else { v4u_t w; w.x = cvt_pk_bf16(a0[0], a0[1]); w.y = cvt_pk_bf16(a0[2], a0[3]); w.z = cvt_pk_bf16(a1[0], a1[1]); w.w = cvt_pk_bf16(a1[2], a1[3]);
                        __builtin_amdgcn_raw_buffer_store_b128(w, act_rsrc, boff + (unsigned)((ai * 128 + m * 16) * D * 2), 0,   16); }
                }
            return u.p3;
        } else {
            const LAS unsigned* sl = (const LAS unsigned*)(upa + u.ui * 2048); const LAS float* bd = (const LAS float*)(upa + u.ui * 2048 + 1024);
            f32x4 b[2][2];
#pragma unroll
            for (int bj = 0; bj < 2; ++bj) { b[bj][0] = *(const LAS f32x4*)(bd + cl + bj * 128); b[bj][1] = *(const LAS f32x4*)(bd + cl + bj * 128 + 4); }
#pragma unroll
            for (int ai = 0; ai < 2; ++ai)
#pragma unroll
                for (int m = 0; m < 4; ++m) {
                    const unsigned pk = sl[ai * 128 + wr * 64 + m * 16 + fr];
                    if ((pk >> 16) != 0xffffu) {
                        const float w = bfhi(pk); constexpr float ws = F8 ? (1.0f / W8_SCALE) : 1.0f;
                        bf16_t* yr = yslot + (size_t)(pk & 0xffffu) * D + (u.p2 & 7) * 256 + cl;
#pragma unroll
                        for (int bj = 0; bj < 2; ++bj) {
                            const f32x4 v0 = (acc[ai][bj][m][0] * ws + b[bj][0]) * w, v1 = (acc[ai][bj][m][1] * ws + b[bj][1]) * w;
                            u32x4 o; o.x = cvt_pk_bf16(v0[0], v0[1]); o.y = cvt_pk_bf16(v0[2], v0[3]); o.z = cvt_pk_bf16(v1[0], v1[1]); o.w = cvt_pk_bf16(v1[2], v1[3]);
                            *(u32x4*)(yr + bj * 128) = o;
                        }
                    }
                }
        }
            return -1;
    }
};

template <class P> __device__ __forceinline__ void run_gemm(Frame& F, const P& S) {
#if SIMPLE_GEMM
    pg8::gemm_simple<P>(F.lds, S);
#else
    pg8::gemm_pipe<P>(F.lds, S);
#endif
}

constexpr int LA_QA = 0, LA_QH = 17408, LA_KA = 34816, LA_VT = 52224, LA_AS = 70656, LA_ST = 79872, LA_QS = 114688, LA_PS = 118784;
constexpr int RS128 = 272, RS64 = 144;
__device__ __forceinline__ float ret_lg(int hh) { return __logf(1.0f - exp2f(-5.0f - (float)(hh - 4))); }
__device__ __forceinline__ u32x4 pack8(const float (&v)[8]) { return (u32x4){cvt_pk_bf16(v[0], v[1]), cvt_pk_bf16(v[2], v[3]), cvt_pk_bf16(v[4], v[5]), cvt_pk_bf16(v[6], v[7])}; }

__device__ __forceinline__ void la_cumsum(const float* gbuf, int hh, int t0, int d0, float (&b0)[8], float (&b1)[8]) {
    if (hh < 4) { float r0 = 0.f, r1 = 0.f;
#pragma unroll
        for (int i = 0; i < 8; ++i) { const f32x2 g = *(const f32x2*)(gbuf + (size_t)(t0 + i) * 512 + hh * 128 + d0); r0 += g.x; r1 += g.y; b0[i] = r0; b1[i] = r1; }
    } else { const float lg = ret_lg(hh);
#pragma unroll
        for (int i = 0; i < 8; ++i) { b0[i] = (float)(i + 1) * lg; b1[i] = b0[i]; }
    }
}

struct LaIn { f32x2 g[8]; unsigned qq[8], kk[8], vv[8]; u32x4 st[4]; u32x2 gt[4]; };
template <bool OUT>
__device__ __forceinline__ void la_load(LaIn& in, const bf16_t* qkvg, const _Float16* gbuf, const bf16_t* sprev, int unit, int oc, int d0, int tid) {
    const int hh = unit >> 8, n = unit & 255, t0 = n * 64 + oc * 8;
    if (hh < 4) {
#pragma unroll
        for (int i = 0; i < 8; ++i) { const h16x2 gh = *(const h16x2*)(gbuf + (size_t)(t0 + i) * 512 + hh * 128 + d0); in.g[i] = (f32x2){(float)gh.x, (float)gh.y}; }
    }
#pragma unroll
    for (int i = 0; i < 8; ++i) { const bf16_t* row = qkvg + (size_t)(t0 + i) * INW + hh * 128 + d0; if (OUT) in.qq[i] = *(const unsigned*)row; in.kk[i] = *(const unsigned*)(row + 1024); in.vv[i] = *(const unsigned*)(row + 2048); }
    if (OUT) {
        const bf16_t* sp = sprev + ((size_t)hh * 256 + n) * 16384;
#pragma unroll
        for (int j = 0; j < 4; ++j) { const int c = tid + NTH * j; in.st[j] = *(const u32x4*)(sp + (c >> 4) * 128 + (c & 15) * 8); }
        const int lane = tid & 63, fr = lane & 15, fq = lane >> 4, tt = oc >> 1, eh = oc & 1;
#pragma unroll
        for (int ei = 0; ei < 4; ++ei) in.gt[ei] = *(const u32x2*)(qkvg + (size_t)(n * 64 + 16 * tt + fr) * INW + 3072 + hh * 128 + 16 * (4 * eh + ei) + 4 * fq);
    }
}
__device__ __forceinline__ void la_cumsum_in(const LaIn& in, int hh, float (&b0)[8], float (&b1)[8]) {
    if (hh < 4) { float r0 = 0.f, r1 = 0.f;
#pragma unroll
        for (int i = 0; i < 8; ++i) { r0 += in.g[i].x; r1 += in.g[i].y; b0[i] = r0; b1[i] = r1; }
    } else { const float lg = ret_lg(hh);
#pragma unroll
        for (int i = 0; i < 8; ++i) { b0[i] = (float)(i + 1) * lg; b1[i] = b0[i]; }
    }
}

__device__ __forceinline__ void la_local_state(Frame& F) {
    const bf16_t* qkvg = WSP(F, WS_QKVG, bf16_t); const _Float16* gbuf = WSP(F, WS_GBUF, _Float16); bf16_t* kvt = WSP(F, WS_KVT, bf16_t); float* dec = WSP(F, WS_DEC, float);
    LAS unsigned char* lds = F.lds; LAS float* qs = (LAS float*)(lds + LA_QS);
    const int lane = F.lane, oc = F.wave, d0 = 2 * lane, fr = lane & 15, fq = lane >> 4;
    LaIn nx;
    if (F.vcu < 2048) la_load<false>(nx, qkvg, gbuf, nullptr, F.vcu, oc, d0, F.tid);
    for (int unit = F.vcu; unit < 2048; unit += F.G) {
        const int hh = unit >> 8, n = unit & 255;
        const LaIn in = nx;
        if (unit + F.G < 2048) la_load<false>(nx, qkvg, gbuf, nullptr, unit + F.G, oc, d0, F.tid);
        float b0[8], b1[8]; la_cumsum_in(in, hh, b0, b1);
        *(LAS f32x2*)(qs + oc * 128 + d0) = (f32x2){b0[7], b1[7]};
        const unsigned (&kk)[8] = in.kk; const unsigned (&vv)[8] = in.vv;
        __syncthreads();
        float base0 = 0.f, base1 = 0.f, tot0 = 0.f, tot1 = 0.f;
#pragma unroll
        for (int o = 0; o < 8; ++o) { const f32x2 q = *(const LAS f32x2*)(qs + o * 128 + d0); if (o < oc) { base0 += q.x; base1 += q.y; } tot0 += q.x; tot1 += q.y; }
        float a0[8], a1[8], c0[8], c1[8];
#pragma unroll
        for (int i = 0; i < 8; ++i) { a0[i] = bflo(kk[i]) * __expf(tot0 - base0 - b0[i]); a1[i] = bfhi(kk[i]) * __expf(tot1 - base1 - b1[i]); c0[i] = bflo(vv[i]); c1[i] = bfhi(vv[i]); }
        *(LAS u32x4*)(lds + LA_QA + d0 * RS64 + oc * 16) = pack8(a0); *(LAS u32x4*)(lds + LA_QA + (d0 + 1) * RS64 + oc * 16) = pack8(a1);
        *(LAS u32x4*)(lds + LA_VT + d0 * RS64 + oc * 16) = pack8(c0); *(LAS u32x4*)(lds + LA_VT + (d0 + 1) * RS64 + oc * 16) = pack8(c1);
        if (oc == 0) *(f32x2*)(dec + ((size_t)hh * 256 + n) * 128 + d0) = (f32x2){__expf(tot0), __expf(tot1)};
        __syncthreads();
        const int et = oc;
        bf16x8 vt[2];
#pragma unroll
        for (int ks = 0; ks < 2; ++ks) vt[ks] = *(const LAS bf16x8*)(lds + LA_VT + (16 * et + fr) * RS64 + (32 * ks + 8 * fq) * 2);
        bf16_t* orow = kvt + (((size_t)hh * 256 + n) * 128 + 16 * et + fr) * 128 + 4 * fq;
#pragma unroll
        for (int dt = 0; dt < 8; ++dt) {
            f32x4 acc = {0.f, 0.f, 0.f, 0.f};
#pragma unroll
            for (int ks = 0; ks < 2; ++ks) { const bf16x8 a = *(const LAS bf16x8*)(lds + LA_QA + (16 * dt + fr) * RS64 + (32 * ks + 8 * fq) * 2); acc = __builtin_amdgcn_mfma_f32_16x16x32_bf16(a, vt[ks], acc, 0, 0, 0); }
            *(u32x2*)(orow + 16 * dt) = (u32x2){cvt_pk_bf16(acc[0], acc[1]), cvt_pk_bf16(acc[2], acc[3])};
        }
        __syncthreads();
    }
}

__device__ __forceinline__ void la_scan(Frame& F) {
    const bf16_t* kvt = WSP(F, WS_KVT, bf16_t); const float* dec = WSP(F, WS_DEC, float); bf16_t* sprev = WSP(F, WS_SPREV, bf16_t);
    for (int idx = F.vcu * NTH + F.tid; idx < 8 * 16384; idx += F.G * NTH) {
        const int hh = idx >> 14, rem = idx & 16383, d = rem & 127;
        const bf16_t* kv = kvt + (size_t)hh * 256 * 16384 + rem; const float* dc = dec + (size_t)hh * 256 * 128 + d; bf16_t* sp = sprev + (size_t)hh * 256 * 16384 + rem;
        float S = 0.f;
        for (int n0 = 0; n0 < 256; n0 += 16) {
            float kvv[16], dd[16];
#pragma unroll
            for (int i = 0; i < 16; ++i) { kvv[i] = bf2f(kv[(size_t)(n0 + i) * 16384]); dd[i] = dc[(n0 + i) * 128]; }
#pragma unroll
            for (int i = 0; i < 16; ++i) { sp[(size_t)(n0 + i) * 16384] = (bf16_t)(cvt_pk_bf16(S, 0.f) & 0xffffu); S = dd[i] * S + kvv[i]; }
        }
    }
}

__device__ __forceinline__ void la_output(Frame& F) {
    const bf16_t* qkvg = WSP(F, WS_QKVG, bf16_t); const _Float16* gbuf = WSP(F, WS_GBUF, _Float16); const bf16_t* sprev = WSP(F, WS_SPREV, bf16_t); bf16_t* cat = WSP(F, WS_CAT, bf16_t);
    LAS unsigned char* lds = F.lds; LAS float* qs = (LAS float*)(lds + LA_QS); LAS float* ps = (LAS float*)(lds + LA_PS);
    const int tid = F.tid, lane = F.lane, oc = F.wave, d0 = 2 * lane, fr = lane & 15, fq = lane >> 4;
    LaIn nx;
    if (F.vcu < 2048) la_load<true>(nx, qkvg, gbuf, sprev, F.vcu, oc, d0, tid);
    for (int unit = F.vcu; unit < 2048; unit += F.G) {
        const int hh = unit >> 8, n = unit & 255;
        const LaIn in = nx;
        if (unit + F.G < 2048) la_load<true>(nx, qkvg, gbuf, sprev, unit + F.G, oc, d0, tid);
        float b0[8], b1[8]; la_cumsum_in(in, hh, b0, b1);
        *(LAS f32x2*)(qs + oc * 128 + d0) = (f32x2){b0[7], b1[7]};
        const unsigned (&qq)[8] = in.qq; const unsigned (&kk)[8] = in.kk; const unsigned (&vv)[8] = in.vv;
#pragma unroll
        for (int j = 0; j < 4; ++j) { const int c = tid + NTH * j; *(LAS u32x4*)(lds + LA_ST + (c >> 4) * RS128 + (c & 15) * 16) = in.st[j]; }
        __syncthreads();
        float base0 = 0.f, base1 = 0.f, bm0 = 0.f, bm1 = 0.f;
#pragma unroll
        for (int o = 0; o < 8; ++o) { const f32x2 q = *(const LAS f32x2*)(qs + o * 128 + d0); if (o < oc) { base0 += q.x; base1 += q.y; } if (o < 4) { bm0 += q.x; bm1 += q.y; } }
        float c0[8], c1[8];
#pragma unroll
        for (int i = 0; i < 8; ++i) {
            const int t = 8 * oc + i; const float bt0 = base0 + b0[i], bt1 = base1 + b1[i];
            const float q0 = bflo(qq[i]), q1 = bfhi(qq[i]), k0 = bflo(kk[i]), k1 = bfhi(kk[i]);
            *(LAS unsigned*)(lds + LA_QA + t * RS128 + d0 * 2) = cvt_pk_bf16(q0 * __expf(bt0 - bm0), q1 * __expf(bt1 - bm1));
            *(LAS unsigned*)(lds + LA_QH + t * RS128 + d0 * 2) = cvt_pk_bf16(q0 * __expf(bt0), q1 * __expf(bt1));
            *(LAS unsigned*)(lds + LA_KA + t * RS128 + d0 * 2) = cvt_pk_bf16(k0 * __expf(bm0 - bt0), k1 * __expf(bm1 - bt1));
            c0[i] = bflo(vv[i]); c1[i] = bfhi(vv[i]);
        }
        *(LAS u32x4*)(lds + LA_VT + d0 * RS64 + oc * 16) = pack8(c0); *(LAS u32x4*)(lds + LA_VT + (d0 + 1) * RS64 + oc * 16) = pack8(c1);
        __syncthreads();
        const int tt = oc >> 1, eh = oc & 1;
        {
            bf16x8 qf[4];
#pragma unroll
            for (int ks = 0; ks < 4; ++ks) qf[ks] = *(const LAS bf16x8*)(lds + LA_QA + (16 * tt + fr) * RS128 + (32 * ks + 8 * fq) * 2);
#pragma unroll
            for (int sti = 0; sti < 2; ++sti) {
                const int st = 2 * eh + sti;
                f32x4 acc = {0.f, 0.f, 0.f, 0.f};
                if (st <= tt) {
#pragma unroll
                    for (int ks = 0; ks < 4; ++ks) { const bf16x8 a = *(const LAS bf16x8*)(lds + LA_KA + (16 * st + fr) * RS128 + (32 * ks + 8 * fq) * 2); acc = __builtin_amdgcn_mfma_f32_16x16x32_bf16(a, qf[ks], acc, 0, 0, 0); }
                    if (st == tt) {
#pragma unroll
                        for (int r = 0; r < 4; ++r) if (4 * fq + r > fr) acc[r] = 0.f;
                    }
                }
                *(LAS u32x2*)(lds + LA_AS + (16 * tt + fr) * RS64 + (16 * st + 4 * fq) * 2) = (u32x2){cvt_pk_bf16(acc[0], acc[1]), cvt_pk_bf16(acc[2], acc[3])};
            }
        }
        __syncthreads();
        f32x4 o[4]; float ss = 0.f;
        {
            bf16x8 af[2], hf[4];
#pragma unroll
            for (int ks = 0; ks < 2; ++ks) af[ks] = *(const LAS bf16x8*)(lds + LA_AS + (16 * tt + fr) * RS64 + (32 * ks + 8 * fq) * 2);
#pragma unroll
            for (int ks = 0; ks < 4; ++ks) hf[ks] = *(const LAS bf16x8*)(lds + LA_QH + (16 * tt + fr) * RS128 + (32 * ks + 8 * fq) * 2);
#pragma unroll
            for (int ei = 0; ei < 4; ++ei) {
                const int et = 4 * eh + ei;
                f32x4 acc = {0.f, 0.f, 0.f, 0.f};
#pragma unroll
                for (int ks = 0; ks < 2; ++ks) { const bf16x8 a = *(const LAS bf16x8*)(lds + LA_VT + (16 * et + fr) * RS64 + (32 * ks + 8 * fq) * 2); acc = __builtin_amdgcn_mfma_f32_16x16x32_bf16(a, af[ks], acc, 0, 0, 0); }
#pragma unroll
                for (int ks = 0; ks < 4; ++ks) { const bf16x8 a = *(const LAS bf16x8*)(lds + LA_ST + (16 * et + fr) * RS128 + (32 * ks + 8 * fq) * 2); acc = __builtin_amdgcn_mfma_f32_16x16x32_bf16(a, hf[ks], acc, 0, 0, 0); }
                o[ei] = acc; ss += (acc[0] * acc[0] + acc[1] * acc[1]) + (acc[2] * acc[2] + acc[3] * acc[3]);
            }
        }
        ss += __shfl_xor(ss, 16); ss += __shfl_xor(ss, 32);
        if (lane < 16) ps[(tt * 2 + eh) * 16 + lane] = ss;
        __syncthreads();
        const float tot = ps[(tt * 2) * 16 + fr] + ps[(tt * 2 + 1) * 16 + fr];
        const float rstd = rsqrtf(tot * (1.f / 128.f) + EPS);
        const float* gain = (hh < 4) ? (inptr(6) + hh * 128) : (inptr(7) + (hh - 4) * 128);
        const size_t rowi = (size_t)(n * 64 + 16 * tt + fr);
#pragma unroll
        for (int ei = 0; ei < 4; ++ei) {
            const int e0 = 16 * (4 * eh + ei) + 4 * fq;
            const f32x4 gn = *(const f32x4*)(gain + e0);
            const u32x2 gt = in.gt[ei];
            const f32x4 v = o[ei] * rstd * gn;
            *(u32x2*)(cat + rowi * D + hh * 128 + e0) = (u32x2){cvt_pk_bf16(v[0] * bflo(gt.x), v[1] * bfhi(gt.x)), cvt_pk_bf16(v[2] * bflo(gt.y), v[3] * bfhi(gt.y))};
        }
        __syncthreads();
    }
}

constexpr int RT_STRIDE = 2064, RT_PART = 32 * RT_STRIDE;
__device__ __forceinline__ void sel4of8(float (&v)[8], const int (&ix)[8], float (&tv)[4], int (&ti)[4]) {
#pragma unroll
    for (int k = 0; k < 4; ++k) {
        float best = v[0]; int bi = ix[0];
#pragma unroll
        for (int q = 1; q < 8; ++q) { const bool better = (v[q] > best) || (v[q] == best && ix[q] < bi); best = better ? v[q] : best; bi = better ? ix[q] : bi; }
        tv[k] = best; ti[k] = bi;
#pragma unroll
        for (int q = 0; q < 8; ++q) v[q] = (ix[q] == bi) ? -INFINITY : v[q];
    }
}
__device__ __forceinline__ void p_route(Frame& F, int layer, const bf16_t* X, int aux = 0) {
    const int tid = F.tid, lane = F.lane;
    LAS unsigned char* lds = F.lds;
    LAS float* ssq = (LAS float*)(lds + 2 * RT_PART);
    LAS f32x4* lgx = (LAS f32x4*)(lds + 2 * RT_PART + 512);
    LAS int* pe = (LAS int*)(lds + 2 * RT_PART + 512 + 8192);
    LAS float* pw = (LAS float*)(pe + 256);
    LAS int* hist = (LAS int*)(pw + 256);
    LAS int* gbase = hist + 32;
    {
        const bf16_t* rt = WSP(F, WS_RT, bf16_t) + (size_t)layer * 2 * 32 * D;
#pragma unroll 4
        for (int j = 0; j < 16; ++j) { const int ch = tid + NTH * j, part = ch >> 12, row = (ch >> 7) & 31, c16 = ch & 127;
            *(LAS u32x4*)(lds + part * RT_PART + row * RT_STRIDE + c16 * 16) = *(const u32x4*)(rt + ((size_t)(part * 32 + row) * D + c16 * 8)); }
    }
    const float* mod = WSP(F, WS_MOD, float) + (size_t)layer * 6 * D;
    int* lslot = WSP(F, WS_LSLOT, int) + (size_t)layer * NE * LIST_CAP; float* lw = WSP(F, WS_LW, float) + (size_t)layer * NE * LIST_CAP;
    if (aux) { lslot = (int*)(F.ws + WS_END); lw = (float*)(F.ws + WS_END + 4 * MiB); }
    unsigned* cntw = F.ctl + CW_CNT + 64 * (layer + 2 * aux);
    const int tile = F.wave & 3, kh = F.wave >> 2, tk = lane & 15, kq = lane >> 4;
    const float* brt = inptr(13) + layer * NE;
    __syncthreads();
    for (int tb = F.vcu; tb < T / 64; tb += F.G) {
        if (tid < 32) hist[tid] = 0;
        const int row = tb * 64 + tile * 16 + tk;
        const bf16_t* xr = X + (size_t)row * D + kh * 512 + 8 * kq;
        float ss = 0.f;
#pragma unroll 8
        for (int s = 0; s < 16; ++s) { const u32x4 q = *(const u32x4*)(xr + 32 * s);
            const f32x4 a = {bflo(q.x), bfhi(q.x), bflo(q.y), bfhi(q.y)}, b = {bflo(q.z), bfhi(q.z), bflo(q.w), bfhi(q.w)};
            ss += (a.x * a.x + a.y * a.y) + (a.z * a.z + a.w * a.w) + (b.x * b.x + b.y * b.y) + (b.z * b.z + b.w * b.w); }
        ss += __shfl_xor(ss, 16); ss += __shfl_xor(ss, 32);
        if (kq == 0) ssq[F.wave * 16 + tk] = ss;
        __syncthreads();
        const float rstd = rsqrtf((ssq[tile * 16 + tk] + ssq[(tile + 4) * 16 + tk]) * (1.f / D) + EPS);
        f32x4 acc[2] = {{0.f, 0.f, 0.f, 0.f}, {0.f, 0.f, 0.f, 0.f}};
        bf16_t* hrow = WSP(F, WS_HN, bf16_t) + (size_t)row * D;
#pragma unroll 2
        for (int s = 0; s < 16; ++s) {
            const int col = kh * 512 + 32 * s + 8 * kq;
            const u32x4 q = *(const u32x4*)(xr + 32 * s);
            const f32x4 a = {bflo(q.x), bfhi(q.x), bflo(q.y), bfhi(q.y)}, b = {bflo(q.z), bfhi(q.z), bflo(q.w), bfhi(q.w)};
            const f32x4 sc0 = *(const f32x4*)(mod + 4 * D + col) + 1.0f, sc1 = *(const f32x4*)(mod + 4 * D + col + 4) + 1.0f;
            const f32x4 sh0 = *(const f32x4*)(mod + 3 * D + col), sh1 = *(const f32x4*)(mod + 3 * D + col + 4);
            const f32x4 h0 = a * rstd * sc0 + sh0, h1 = b * rstd * sc1 + sh1;
            u32x4 hi; hi.x = cvt_pk_bf16(h0.x, h0.y); hi.y = cvt_pk_bf16(h0.z, h0.w); hi.z = cvt_pk_bf16(h1.x, h1.y); hi.w = cvt_pk_bf16(h1.z, h1.w);
            if ((FP8_LAYERS >> layer) & 1) *(u32x2*)(WSP(F, WS_HN8, unsigned char) + (size_t)row * D + col) = (u32x2){pack_fp8x4(h0.x, h0.y, h0.z, h0.w), pack_fp8x4(h1.x, h1.y, h1.z, h1.w)};
            else *(u32x4*)(hrow + col) = hi;
            u32x4 lo; lo.x = cvt_pk_bf16(h0.x - bflo(hi.x), h0.y - bfhi(hi.x)); lo.y = cvt_pk_bf16(h0.z - bflo(hi.y), h0.w - bfhi(hi.y));
            lo.z = cvt_pk_bf16(h1.x - bflo(hi.z), h1.y - bfhi(hi.z)); lo.w = cvt_pk_bf16(h1.z - bflo(hi.w), h1.w - bfhi(hi.w));
            const bf16x8 bh = __builtin_bit_cast(bf16x8, hi), bl = __builtin_bit_cast(bf16x8, lo);
#pragma unroll
            for (int et = 0; et < 2; ++et) {
                const bf16x8 wh = *(const LAS bf16x8*)(lds + (16 * et + tk) * RT_STRIDE + col * 2);
                const bf16x8 wl = *(const LAS bf16x8*)(lds + RT_PART + (16 * et + tk) * RT_STRIDE + col * 2);
                acc[et] = __builtin_amdgcn_mfma_f32_16x16x32_bf16(wh, bh, acc[et], 0, 0, 0);
                acc[et] = __builtin_amdgcn_mfma_f32_16x16x32_bf16(wl, bh, acc[et], 0, 0, 0);
                acc[et] = __builtin_amdgcn_mfma_f32_16x16x32_bf16(wh, bl, acc[et], 0, 0, 0);
            }
        }
        if (kh == 1) { lgx[(tile * 2 + 0) * 64 + lane] = acc[0]; lgx[(tile * 2 + 1) * 64 + lane] = acc[1]; }
        __syncthreads();
        if (kh == 0) {
            float cv[8]; int ci[8];
#pragma unroll
            for (int et = 0; et < 2; ++et) { const f32x4 o = lgx[(tile * 2 + et) * 64 + lane]; const f32x4 bb = *(const f32x4*)(brt + 16 * et + 4 * kq);
#pragma unroll
                for (int r = 0; r < 4; ++r) { cv[et * 4 + r] = acc[et][r] + o[r] + bb[r]; ci[et * 4 + r] = 16 * et + 4 * kq + r; } }
            float tv[4]; int ti[4];
            sel4of8(cv, ci, tv, ti);
#pragma unroll
            for (int off = 16; off <= 32; off <<= 1) {
                float mv[8]; int mi[8];
#pragma unroll
                for (int k = 0; k < 4; ++k) { mv[k] = tv[k]; mi[k] = ti[k]; mv[4 + k] = __shfl_xor(tv[k], off); mi[4 + k] = __shfl_xor(ti[k], off); }
                sel4of8(mv, mi, tv, ti);
            }
            const float e1 = __expf(tv[1] - tv[0]), e2 = __expf(tv[2] - tv[0]), e3 = __expf(tv[3] - tv[0]); const float inv = 1.0f / (1.0f + e1 + e2 + e3);
            if (kq == 0) { const int tl = tile * 16 + tk;
                pe[tl * 4 + 0] = ti[0]; pe[tl * 4 + 1] = ti[1]; pe[tl * 4 + 2] = ti[2]; pe[tl * 4 + 3] = ti[3];
                pw[tl * 4 + 0] = inv; pw[tl * 4 + 1] = e1 * inv; pw[tl * 4 + 2] = e2 * inv; pw[tl * 4 + 3] = e3 * inv; }
        }
        __syncthreads();
        int myexp = 0, lpos = 0;
        if (tid < 256) { myexp = pe[tid]; lpos = __hip_atomic_fetch_add(hist + myexp, 1, __ATOMIC_RELAXED, __HIP_MEMORY_SCOPE_WORKGROUP); }
        __syncthreads();
        if (tid < 32) gbase[tid] = (int)atomicAdd(cntw + tid, (unsigned)hist[tid]);
        __syncthreads();
        if (tid < 256) { const int pos = gbase[myexp] + lpos; if (pos < LIST_CAP) { lslot[(size_t)myexp * LIST_CAP + pos] = tb * 256 + tid; lw[(size_t)myexp * LIST_CAP + pos] = pw[tid]; } }
        __syncthreads();
    }
}

template <int MODE>
__device__ __forceinline__ void p_combine(Frame& F, int layer, const bf16_t* Xin, void* Xout_) {
    const int lane = F.lane;
    const float* mod = WSP(F, WS_MOD, float) + (size_t)layer * 6 * D;
    const bf16_t* ys = WSP(F, WS_YSLOT, bf16_t);
    f32x4 gf[4], fnw[4];
#pragma unroll
    for (int j = 0; j < 4; ++j) { gf[j] = *(const f32x4*)(mod + 5 * D + 4 * lane + 256 * j); if (MODE == 1) fnw[j] = *(const f32x4*)(inptr(18) + 4 * lane + 256 * j); }
    for (int it = 0; it < (T / 64 + F.G - 1) / F.G * 8; ++it) {
        const int row = ((it >> 3) * F.G + F.vcu) * 64 + F.wave * 8 + (it & 7); if (row >= T) break;
        const u32x2* xr = (const u32x2*)(Xin + (size_t)row * D) + lane;
        f32x4 v[4]; float s = 0.f;
#pragma unroll
        for (int j = 0; j < 4; ++j) {
            f32x4 a = {0.f, 0.f, 0.f, 0.f};
#pragma unroll
            for (int k = 0; k < 4; ++k) { const u32x2 y = *((const u32x2*)(ys + ((size_t)row * 4 + k) * D) + lane + 64 * j); a += (f32x4){bflo(y.x), bfhi(y.x), bflo(y.y), bfhi(y.y)}; }
            const u32x2 xq = xr[64 * j];
            v[j] = (f32x4){bflo(xq.x), bfhi(xq.x), bflo(xq.y), bfhi(xq.y)} + gf[j] * a;
            if (MODE == 0) { const u32x2 w = {cvt_pk_bf16(v[j].x, v[j].y), cvt_pk_bf16(v[j].z, v[j].w)};
                ((u32x2*)((bf16_t*)Xout_ + (size_t)row * D) + lane)[64 * j] = w; v[j] = (f32x4){bflo(w.x), bfhi(w.x), bflo(w.y), bfhi(w.y)}; }
            s += (v[j].x * v[j].x + v[j].y * v[j].y) + (v[j].z * v[j].z + v[j].w * v[j].w);
        }
        const float rstd = rsqrtf(wave_sum(s) * (1.f / D) + EPS);
        if (MODE == 0) { if (lane == 0) WSP(F, WS_RSTD, float)[row] = rstd; }
        else { f32x4* o = (f32x4*)((float*)Xout_ + (size_t)row * D) + lane;
#pragma unroll
            for (int j = 0; j < 4; ++j) __builtin_nontemporal_store(v[j] * rstd * fnw[j], o + 64 * j);
        }
    }
}

template <int W>
__device__ __forceinline__ void pool_unit(const bf16_t* X, const float* rs, bf16_t* P, int c, int t0, float sh, float sc) {
    float hp[16], hc[16];
#pragma unroll
    for (int i = 0; i < 16; ++i) { const int t = t0 - 16 + i; hp[i] = (i >= 16 - (W - 1) && t >= 0) ? bf2f(X[(size_t)t * D + c]) * rs[t] * sc + sh : 0.f; }
    float sum = 0.f;
#pragma unroll
    for (int i = 1; i < W; ++i) sum += hp[16 - i];
#pragma unroll
    for (int blk = 0; blk < 2; ++blk) {
        const int tb = t0 + 16 * blk;
#pragma unroll
        for (int i = 0; i < 16; ++i) hc[i] = bf2f(X[(size_t)(tb + i) * D + c]) * rs[tb + i] * sc + sh;
#pragma unroll
        for (int i = 0; i < 16; ++i) {
            const int t = tb + i;
            sum += hc[i];
            const int cnt = (t + 1 < W) ? (t + 1) : W;
            const float p = sum / (float)cnt - hc[i];
            P[(size_t)t * D + c] = (bf16_t)(cvt_pk_bf16(p, 0.f) & 0xffffu);
            sum -= (i - (W - 1) >= 0) ? hc[(i - (W - 1)) & 15] : hp[(16 + i - (W - 1)) & 15];
        }
#pragma unroll
        for (int i = 0; i < 16; ++i) hp[i] = hc[i];
    }
}
__device__ __forceinline__ void p_pool(Frame& F, const bf16_t* X) {
    const float* mod = WSP(F, WS_MOD, float) + (size_t)1 * 6 * D; const float* rs = WSP(F, WS_RSTD, float); bf16_t* P = WSP(F, WS_HN, bf16_t);
    const int tid = F.tid;
    for (int u = F.vcu; u < 1024; u += F.G) {
        const int tt = u >> 2, g = u & 3;
        const int c = g * 256 + (tid & 255), t0 = tt * 64 + (tid >> 8) * 32;
        const float sh = mod[0 * D + c], sc = 1.0f + mod[1 * D + c];
        if (g == 0) pool_unit<2>(X, rs, P, c, t0, sh, sc);
        else if (g == 1) pool_unit<4>(X, rs, P, c, t0, sh, sc);
        else if (g == 2) pool_unit<8>(X, rs, P, c, t0, sh, sc);
        else pool_unit<16>(X, rs, P, c, t0, sh, sc);
    }
}

constexpr int PG_STRIDE = 2064;
constexpr int PG_RS = 64 * PG_STRIDE;
template <int W>
__device__ __forceinline__ void pool_pair(const bf16_t* xcol, const LAS float* rsl, LAS unsigned* Pd, int t0, f32x2 sh, f32x2 sc) {
    f32x2 hp[16], hc[16];
#pragma unroll
    for (int i = 0; i < 16; ++i) { const int t = t0 - 16 + i; hp[i] = (f32x2){0.f, 0.f};
        if (i >= 16 - (W - 1) && t >= 0) { const unsigned q = *(const unsigned*)(xcol + (size_t)t * D); hp[i] = (f32x2){bflo(q), bfhi(q)} * rsl[i] * sc + sh; } }
    f32x2 sum = {0.f, 0.f};
#pragma unroll
    for (int i = 1; i < W; ++i) sum += hp[16 - i];
#pragma unroll 2
    for (int blk = 0; blk < 4; ++blk) {
        const int tb = t0 + 16 * blk;
#pragma unroll
        for (int i = 0; i < 16; ++i) { const unsigned q = *(const unsigned*)(xcol + (size_t)(tb + i) * D); hc[i] = (f32x2){bflo(q), bfhi(q)} * rsl[16 + 16 * blk + i] * sc + sh; }
#pragma unroll
        for (int i = 0; i < 16; ++i) {
            const int t = tb + i;
            sum += hc[i];
            const float inv = 1.0f / (float)((t + 1 < W) ? (t + 1) : W);
            const f32x2 p = sum * inv - hc[i];
            Pd[(size_t)(16 * blk + i) * (PG_STRIDE / 4)] = cvt_pk_bf16(p.x, p.y);
            sum -= (i - (W - 1) >= 0) ? hc[(i - (W - 1)) & 15] : hp[(16 + i - (W - 1)) & 15];
        }
#pragma unroll
        for (int i = 0; i < 16; ++i) hp[i] = hc[i];
    }
}
__device__ __forceinline__ void p_pool_gemm(Frame& F, const bf16_t* X2, bf16_t* X1) {
    const float* mod = WSP(F, WS_MOD, float) + (size_t)1 * 6 * D; const float* rs = WSP(F, WS_RSTD, float); const bf16_t* pwt = WSP(F, WS_POOLT, bf16_t);
    const float* pb = inptr(10); const float* psc = inptr(11);
    LAS unsigned char* lds = F.lds; LAS float* rsl = (LAS float*)(lds + PG_RS);
    const int tid = F.tid, lane = F.lane, w = F.wave, fr = lane & 15, fq = lane >> 4;
    for (int tb = F.vcu; tb < T / 64; tb += F.G) {
        const int t0 = tb * 64;
        if (tid < 80) { const int t = t0 - 16 + tid; rsl[tid] = (t >= 0) ? rs[t] : 0.f; }
        __syncthreads();
        {
            const int c2 = 2 * tid, gq = w >> 1;
            const f32x2 sh = *(const f32x2*)(mod + 0 * D + c2), sc = *(const f32x2*)(mod + 1 * D + c2) + 1.0f;
            LAS unsigned* Pd = (LAS unsigned*)(lds + c2 * 2);
            if (gq == 0) pool_pair<2>(X2 + c2, rsl, Pd, t0, sh, sc);
            else if (gq == 1) pool_pair<4>(X2 + c2, rsl, Pd, t0, sh, sc);
            else if (gq == 2) pool_pair<8>(X2 + c2, rsl, Pd, t0, sh, sc);
            else pool_pair<16>(X2 + c2, rsl, Pd, t0, sh, sc);
        }
        __syncthreads();
#pragma unroll 1
        for (int g = 0; g < 4; ++g) {
            f32x4 acc[2][4];
#pragma unroll
            for (int nt = 0; nt < 2; ++nt)
#pragma unroll
                for (int tt = 0; tt < 4; ++tt) acc[nt][tt] = (f32x4){0.f, 0.f, 0.f, 0.f};
            bf16x8 wf[2][8];
#pragma unroll
            for (int nt = 0; nt < 2; ++nt)
#pragma unroll
                for (int ks = 0; ks < 8; ++ks) wf[nt][ks] = *(const bf16x8*)(pwt + ((size_t)g * 256 + 32 * w + 16 * nt + fr) * 256 + 32 * ks + 8 * fq);
            u32x2 xq[2][4];
#pragma unroll
            for (int nt = 0; nt < 2; ++nt)
#pragma unroll
                for (int tt = 0; tt < 4; ++tt) xq[nt][tt] = *(const u32x2*)(X2 + (size_t)(t0 + 16 * tt + fr) * D + 256 * g + 32 * w + 16 * nt + 4 * fq);
#pragma unroll
            for (int ks = 0; ks < 8; ++ks) {
                bf16x8 af[4];
#pragma unroll
                for (int tt = 0; tt < 4; ++tt) af[tt] = *(const LAS bf16x8*)(lds + (16 * tt + fr) * PG_STRIDE + (256 * g + 32 * ks + 8 * fq) * 2);
#pragma unroll
                for (int nt = 0; nt < 2; ++nt)
#pragma unroll
                    for (int tt = 0; tt < 4; ++tt) acc[nt][tt] = __builtin_amdgcn_mfma_f32_16x16x32_bf16(wf[nt][ks], af[tt], acc[nt][tt], 0, 0, 0);
            }
#pragma unroll
            for (int nt = 0; nt < 2; ++nt) {
                const int col = 256 * g + 32 * w + 16 * nt + 4 * fq;
                const f32x4 gmv = *(const f32x4*)(mod + 2 * D + col), bv = *(const f32x4*)(pb + col), sv = *(const f32x4*)(psc + col);
#pragma unroll
                for (int tt = 0; tt < 4; ++tt) {
                    const size_t idx = (size_t)(t0 + 16 * tt + fr) * D + col;
                    const f32x4 xv = {bflo(xq[nt][tt].x), bfhi(xq[nt][tt].x), bflo(xq[nt][tt].y), bfhi(xq[nt][tt].y)};
                    const f32x4 o = xv + gmv * ((acc[nt][tt] + bv) * sv);
                    *(u32x2*)(X1 + idx) = (u32x2){cvt_pk_bf16(o.x, o.y), cvt_pk_bf16(o.z, o.w)};
                }
            }
        }
        __syncthreads();
    }
}

constexpr int N_PHASES = 17;
__global__ void __launch_bounds__(NTH, 2) fwd_kernel(Args args) {
    extern __shared__ __attribute__((aligned(16))) unsigned char lds_raw[];
    Frame F;
    F.lds = (LAS unsigned char*)lds_raw;
    F.MISC = (volatile LAS unsigned*)(F.lds + MISC_OFF);
    F.tid = threadIdx.x; F.lane = F.tid & 63; F.wave = __builtin_amdgcn_readfirstlane(F.tid >> 6);
    F.G = gridDim.x; { const int bx = blockIdx.x; F.vcu = (F.G % 8 == 0) ? (bx % 8) * (F.G / 8) + bx / 8 : bx; }
    F.ws = args.ws; F.ctl = (unsigned*)(args.ws + WS_CTL); F.out = args.out;
    for (int u = F.tid; u < (LDS_BYTES - MISC_OFF) / 4; u += NTH) F.MISC[u] = 0u;
    __syncthreads();
#if N_LAUNCH_MODE == 1
    XcdBarrier bar = xcd_barrier_post(F.ctl + CW_BAR, F.MISC + 8);
#define GRID_BAR() xcd_barrier(bar)
#else
#define GRID_BAR() do { } while (0)
#endif
    const int lo = args.ph_lo, hi = args.ph_hi;
#define IN(k) (lo <= (k) && (k) < hi)
#define SEAM(k) do { if (IN(k) && IN((k) + 1)) GRID_BAR(); } while (0)
    GemmBase gb; gb.G = F.G; gb.vcu = F.vcu;
    bf16_t* X1 = WSP(F, WS_X1, bf16_t); bf16_t* X2 = WSP(F, WS_X2, bf16_t);
    const float* mod0 = WSP(F, WS_MOD, float); const float* mod1 = mod0 + 6 * D;

    if (IN(0)) { p0_prologue(F); } SEAM(0);
    if (IN(1)) { p1_norm_in(F); } SEAM(1);
    if (IN(2)) { PolWin P; (GemmBase&)P = gb; P.A = WSP(F, WS_HN, bf16_t); P.Bt = WSP(F, WS_WINT, bf16_t); P.qkvg = WSP(F, WS_QKVG, bf16_t); P.gbuf = WSP(F, WS_GBUF, _Float16);
        P.lb = WSP(F, WS_LB, float); P.rope = WSP(F, WS_ROPE, f32x2); run_gemm(F, P); } SEAM(2);
    if (IN(3)) { la_local_state(F); } SEAM(3);
    if (IN(4)) { la_scan(F); } SEAM(4);
    if (IN(5)) { la_output(F); } SEAM(5);
    if (IN(6)) { PolRes<false> P; (GemmBase&)P = gb; P.A = WSP(F, WS_CAT, bf16_t); P.Bt = WSP(F, WS_WOUTT, bf16_t); P.resid = inptr(0); P.resid16 = nullptr; P.outp = X1; P.gate = mod0 + 2 * D; P.bias = nullptr; P.scale = nullptr;
        P.K = D; P.lda = D; P.nN = 4; P.kcol = 0; run_gemm(F, P); } SEAM(6);
    if (IN(7)) { p_route(F, 0, X1, args.aux); } SEAM(7);
    if (IN(8)) { expert_tables(F, 0); PolMoE<((FP8_LAYERS >> 0) & 1) != 0> P; (GemmBase&)P = gb; P.MISC = F.MISC; P.upa = F.lds + UPA_OFF; P.hn = ((FP8_LAYERS >> 0) & 1) ? (const bf16_t*)WSP(F, WS_HN8, unsigned char) : WSP(F, WS_HN, bf16_t);
        P.wgut = WSP(F, WS_WGUT, bf16_t) + (size_t)0 * NE * 2048 * D; P.bgu = inptr(15) + (size_t)0 * NE * 2048; P.lslot = WSP(F, WS_LSLOT, int) + (size_t)0 * NE * LIST_CAP; P.lw = WSP(F, WS_LW, float) + (size_t)0 * NE * LIST_CAP;
        P.act = (bf16_t*)(F.ws + (0 ? WS_ACT2 : WS_ACT)); P.wdnt = WSP(F, WS_WDNT, bf16_t) + (size_t)0 * NE * D * D; P.bdn = inptr(17) + (size_t)0 * NE * D; P.yslot = WSP(F, WS_YSLOT, bf16_t);
        P.done = F.ctl + CW_DONE + 0 * DONE_LAYER; P.tmo = F.ctl + CW_TMO; P.act_rsrc = __builtin_amdgcn_make_buffer_rsrc((void*)P.act, (short)0, (int)((size_t)ACT_ROWS * D * 2), 0x00020000);
        P.fill(F.tid); __syncthreads(); run_gemm(F, P); } if (IN(8) && IN(10)) GRID_BAR();
    if (IN(10)) { p_combine<0>(F, 0, X1, X2); } SEAM(10);
    if (IN(11)) { p_pool_gemm(F, X2, X1); asm volatile("s_waitcnt vmcnt(0)" ::: "memory"); __syncthreads(); p_route(F, 1, X1, args.aux); } if (IN(11) && IN(14)) GRID_BAR();
    if (IN(14)) { expert_tables(F, 1); PolMoE<((FP8_LAYERS >> 1) & 1) != 0> P; (GemmBase&)P = gb; P.MISC = F.MISC; P.upa = F.lds + UPA_OFF; P.hn = ((FP8_LAYERS >> 1) & 1) ? (const bf16_t*)WSP(F, WS_HN8, unsigned char) : WSP(F, WS_HN, bf16_t);
        P.wgut = WSP(F, WS_WGUT, bf16_t) + (size_t)1 * NE * 2048 * D; P.bgu = inptr(15) + (size_t)1 * NE * 2048; P.lslot = WSP(F, WS_LSLOT, int) + (size_t)1 * NE * LIST_CAP; P.lw = WSP(F, WS_LW, float) + (size_t)1 * NE * LIST_CAP;
        P.act = (bf16_t*)(F.ws + (1 ? WS_ACT2 : WS_ACT)); P.wdnt = WSP(F, WS_WDNT, bf16_t) + (size_t)1 * NE * D * D; P.bdn = inptr(17) + (size_t)1 * NE * D; P.yslot = WSP(F, WS_YSLOT, bf16_t);
        P.done = F.ctl + CW_DONE + 1 * DONE_LAYER; P.tmo = F.ctl + CW_TMO; P.act_rsrc = __builtin_amdgcn_make_buffer_rsrc((void*)P.act, (short)0, (int)((size_t)ACT_ROWS * D * 2), 0x00020000);
        P.fill(F.tid); __syncthreads(); run_gemm(F, P); } if (IN(14) && IN(16)) GRID_BAR();
    if (IN(16)) { p_combine<1>(F, 1, X1, F.out); }
#undef IN
#undef SEAM
}

extern "C" void kernel_launch(void* const* d_in, const int* in_sizes, int n_in, void* d_out, int out_size, void* d_ws, size_t ws_size, hipStream_t stream) {
    static int grid = 0;
    if (grid == 0) {
        if (n_in != 19 || out_size != T * D || ws_size < WS_END) { fprintf(stderr, "kernel_launch: unexpected shapes (n_in %d, out %d, ws %zu)\n", n_in, out_size, ws_size); grid = -1; return; }
        int dev = 0, cus = 0, per_cu = 0;
        if (hipGetDevice(&dev) != hipSuccess || hipDeviceGetAttribute(&cus, hipDeviceAttributeMultiprocessorCount, dev) != hipSuccess) { grid = -1; return; }
        if (hipFuncSetAttribute((const void*)fwd_kernel, hipFuncAttributeMaxDynamicSharedMemorySize, LDS_BYTES) != hipSuccess) { fprintf(stderr, "kernel_launch: hipFuncSetAttribute failed\n"); grid = -1; return; }
        if (hipOccupancyMaxActiveBlocksPerMultiprocessor(&per_cu, (const void*)fwd_kernel, NTH, LDS_BYTES) != hipSuccess || per_cu < 1) { fprintf(stderr, "kernel_launch: occupancy query says %d\n", per_cu); }
        (void)hipGetLastError();
        grid = cus;
    }
    if (grid < 0) return;
    (void)hipMemsetAsync((char*)d_ws + WS_CTL, 0, CTL_BYTES, stream);
    Args a{};
    for (int i = 0; i < 19; ++i) a.in[i] = (const float*)d_in[i];
    a.out = (float*)d_out; a.ws = (unsigned char*)d_ws;
#if N_LAUNCH_MODE == 1
    a.ph_lo = 0; a.ph_hi = N_PHASES;
    void* kargs[] = {&a};
    hipError_t e = hipLaunchCooperativeKernel((const void*)fwd_kernel, dim3(grid), dim3(NTH), kargs, LDS_BYTES, stream);
    if (e != hipSuccess) fprintf(stderr, "cooperative launch failed: %s\n", hipGetErrorString(e));
#else
    for (int p = 0; p < N_PHASES; ++p) {
        a.ph_lo = p; a.ph_hi = p + 1;
        hipLaunchKernelGGL(fwd_kernel, dim3(grid), dim3(NTH), LDS_BYTES, stream, a);
        if (p == DUP_PHASE) { a.aux = 1; hipLaunchKernelGGL(fwd_kernel, dim3(grid), dim3(NTH), LDS_BYTES, stream, a); a.aux = 0; }
    }
#endif
}
```

```cpp
#include <hip/hip_runtime.h>
#include <cstdio>
#include <cstdint>

#ifndef N_LAUNCH_MODE
#define N_LAUNCH_MODE 1
#endif
#ifndef DUP_PHASE
#define DUP_PHASE -1
#endif
#ifndef KREP_WIN
#define KREP_WIN 1
#endif
#ifndef KREP_RES
#define KREP_RES 1
#endif
#ifndef KREP_G1
#define KREP_G1 1
#endif
#ifndef KREP_G2
#define KREP_G2 1
#endif
#ifndef GEMM_KREP
#define GEMM_KREP 1
#endif
#ifndef GEMM_EPIREP
#define GEMM_EPIREP 1
#endif
#ifndef FP8_LAYERS
#define FP8_LAYERS 3
#endif
#ifndef SIMPLE_GEMM
#define SIMPLE_GEMM 0
#endif

#define LAS __attribute__((address_space(3)))
#define GAS __attribute__((address_space(1)))
typedef unsigned short bf16_t;
typedef short bf16x8 __attribute__((ext_vector_type(8)));
typedef float f32x4 __attribute__((ext_vector_type(4)));
typedef float f32x2 __attribute__((ext_vector_type(2)));
typedef unsigned u32x4 __attribute__((ext_vector_type(4)));
typedef unsigned u32x2 __attribute__((ext_vector_type(2)));
typedef _Float16 h16x2 __attribute__((ext_vector_type(2)));
typedef _Float16 h16x8 __attribute__((ext_vector_type(8)));
typedef int v4i_t __attribute__((ext_vector_type(4)));
typedef int v8i_t __attribute__((ext_vector_type(8)));
constexpr float W8_SCALE = 32.0f;
__device__ __forceinline__ unsigned pack_fp8x4(float a, float b, float c, float d) { int w = __builtin_amdgcn_cvt_pk_fp8_f32(a, b, 0, false); w = __builtin_amdgcn_cvt_pk_fp8_f32(c, d, w, true); return (unsigned)w; }

constexpr int T = 16384, D = 1024, NE = 32, TOPK = 4, DEPTH = 2;
constexpr int INW = 4096;
constexpr int NTH = 512, NWAVES = 8;
constexpr float EPS = 1e-6f;
constexpr float SW_LIMIT = 7.0f, SW_ALPHA = 1.702f;
constexpr int LIST_CAP = T;
constexpr int ACT_ROWS = T * TOPK + NE * 256;

constexpr size_t MiB = 1u << 20;
constexpr size_t WS_CTL = 0, CTL_BYTES = 1 * MiB;
constexpr size_t WS_MOD = 1 * MiB;
constexpr size_t WS_LB = WS_MOD + 65536;
constexpr size_t WS_ROPE = 2 * MiB;
constexpr size_t WS_WINT = 10 * MiB;
constexpr size_t WS_WOUTT = 18 * MiB;
constexpr size_t WS_POOLT = 20 * MiB;
constexpr size_t WS_LSLOT = 22 * MiB;
constexpr size_t WS_LW = 26 * MiB;
constexpr size_t WS_RT = 21 * MiB;
constexpr size_t WS_RSTD = 30 * MiB;
constexpr size_t WS_WGUT = 32 * MiB;
constexpr size_t WS_WDNT = 288 * MiB;
constexpr size_t WS_HN = 416 * MiB;
constexpr size_t WS_QKVG = 448 * MiB;
constexpr size_t WS_GBUF = 576 * MiB;
constexpr size_t WS_KVT = 608 * MiB;
constexpr size_t WS_SPREV = 736 * MiB;
constexpr size_t WS_DEC = 800 * MiB;
constexpr size_t WS_CAT = 802 * MiB;
constexpr size_t WS_X1 = 834 * MiB;
constexpr size_t WS_X2 = 898 * MiB;
constexpr size_t WS_ACT = 962 * MiB;
constexpr size_t WS_YSLOT = 1106 * MiB;
constexpr size_t WS_ACT2 = 1234 * MiB;
constexpr size_t WS_HN8 = 1378 * MiB;
constexpr size_t WS_END = 1394 * MiB;
constexpr int CW_CNT = 64;
constexpr int CW_BAR = 4096;
constexpr int CW_TMO = 8;
constexpr int CW_DONE = 8192, DONE_LAYER = 320 * 64;

constexpr int SCR_BYTES = 156 * 1024;
constexpr int MISC_OFF = SCR_BYTES;
constexpr int LDS_BYTES = SCR_BYTES + 4096;

typedef __bf16 bf16x2_t __attribute__((ext_vector_type(2)));
__device__ __forceinline__ unsigned cvt_pk_bf16(float lo, float hi) { const f32x2 v = {lo, hi}; const bf16x2_t b = __builtin_convertvector(v, bf16x2_t); return __builtin_bit_cast(unsigned, b); }
__device__ __forceinline__ float bf2f(unsigned short b) { return __builtin_bit_cast(float, (unsigned)b << 16); }
__device__ __forceinline__ float bflo(unsigned w) { return __builtin_bit_cast(float, w << 16); }
__device__ __forceinline__ float bfhi(unsigned w) { return __builtin_bit_cast(float, w & 0xffff0000u); }
__device__ __forceinline__ float wave_sum(float v) {
#pragma unroll
    for (int o = 1; o < 64; o <<= 1) v += __shfl_xor(v, o);
    return v;
}
__device__ __forceinline__ float wave_max(float v) {
#pragma unroll
    for (int o = 1; o < 64; o <<= 1) v = fmaxf(v, __shfl_xor(v, o));
    return v;
}
__device__ __forceinline__ float sigmoidf_(float x) { return __builtin_amdgcn_rcpf(1.0f + __expf(-x)); }
__device__ __forceinline__ float siluf_(float x) { return x * sigmoidf_(x); }
__device__ __forceinline__ f32x2 swiglu2(f32x2 ag, f32x2 al, f32x2 bg, f32x2 bl1, float ws) {
    const f32x2 ws2 = {ws, ws};
    const f32x2 G = __builtin_elementwise_fma(ag, ws2, bg), L = __builtin_elementwise_fma(al, ws2, bl1);
    const f32x2 x = {fminf(G.x, SW_LIMIT), fminf(G.y, SW_LIMIT)};
    const f32x2 y = {__builtin_amdgcn_fmed3f(L.x, 1.0f - SW_LIMIT, 1.0f + SW_LIMIT), __builtin_amdgcn_fmed3f(L.y, 1.0f - SW_LIMIT, 1.0f + SW_LIMIT)};
    constexpr float c = -SW_ALPHA * 1.4426950408889634f; const f32x2 c2 = {c, c};
    const f32x2 t = x * c2;
    const f32x2 e = {__builtin_amdgcn_exp2f(t.x), __builtin_amdgcn_exp2f(t.y)};
    const f32x2 one = {1.0f, 1.0f};
    const f32x2 d = e + one;
    const f32x2 r = {__builtin_amdgcn_rcpf(d.x), __builtin_amdgcn_rcpf(d.y)};
    return (x * r) * y;
}

#define XB_TMO      128
#define XB_XCNT(j)  (256  + 64 * (j))
#define XB_XSUB(j)  (1280 + 64 * (j))
#define XB_XGEN(j)  (2304 + 64 * (j))
#define XB_TOP      3328
#define XB_TOPGEN   3392
#define XCD_BAR_WORDS 3456
#define XB_SPIN_CAP (1u << 20)
__device__ __forceinline__ unsigned xb_ld(unsigned* p)              { return __hip_atomic_load(p, __ATOMIC_RELAXED, __HIP_MEMORY_SCOPE_AGENT); }
__device__ __forceinline__ unsigned xb_add(unsigned* p, unsigned v) { return __hip_atomic_fetch_add(p, v, __ATOMIC_RELAXED, __HIP_MEMORY_SCOPE_AGENT); }
__device__ __forceinline__ unsigned xb_xcc_id() { return (unsigned)__builtin_amdgcn_s_getreg((3 << 11) | 20) & 0xFu; }
#define XB_SPIN(cond, bar) do { unsigned _sp = 0; while (cond) { __builtin_amdgcn_s_sleep(1); \
    if ((++_sp & 255u) == 0u) { if (xb_ld(&(bar)[XB_TMO])) break; if (_sp > XB_SPIN_CAP) { atomicAdd(&(bar)[XB_TMO], 1u); break; } } } } while (0)
struct XcdBarrier { unsigned* bar; unsigned x; volatile LAS unsigned* st; };
__device__ __forceinline__ XcdBarrier xcd_barrier_post(unsigned* bar, volatile LAS unsigned* st) {
    XcdBarrier b; b.bar = bar; b.x = xb_xcc_id(); b.st = st;
    if (threadIdx.x == 0) (void)xb_add(&bar[XB_XCNT(b.x)], 1u);
    return b;
}
__device__ __forceinline__ void xcd_barrier_complete(unsigned* bar, unsigned x, unsigned& nloc, unsigned& nx) {
    const unsigned G = gridDim.x * gridDim.y * gridDim.z;
    unsigned sum, cnt, mine, sp = 0u;
    for (;;) {
        sum = 0u; cnt = 0u; mine = 0u;
#pragma unroll
        for (unsigned j = 0; j < 16; ++j) { const unsigned c = xb_ld(&bar[XB_XCNT(j)]); sum += c; cnt += (c > 0u) ? 1u : 0u; mine = (j == x) ? c : mine; }
        if (sum == G) break;
        __builtin_amdgcn_s_sleep(1);
        if ((++sp & 255u) == 0u) { if (xb_ld(&bar[XB_TMO])) break; if (sp > XB_SPIN_CAP) { atomicAdd(&bar[XB_TMO], 1u); break; } }
    }
    nloc = mine > 0u ? mine : 1u; nx = cnt > 0u ? cnt : 1u;
}
__device__ __forceinline__ void xcd_barrier(const XcdBarrier& b) {
    asm volatile("s_waitcnt vmcnt(0)" ::: "memory");
    __syncthreads();
    if (threadIdx.x == 0) {
        unsigned* bar = b.bar;
        __builtin_amdgcn_s_waitcnt(0);
        unsigned nloc = b.st[0], nx = b.st[1];
        if (nloc == 0u) { xcd_barrier_complete(bar, b.x, nloc, nx); b.st[0] = nloc; b.st[1] = nx; }
        const unsigned old = xb_add(&bar[XB_XSUB(b.x)], 1u);
        const unsigned gen = old / nloc;
        if (old + 1u == (gen + 1u) * nloc) {
            __builtin_amdgcn_fence(__ATOMIC_RELEASE, "agent");
            asm volatile("s_waitcnt vmcnt(0)" ::: "memory");
            const unsigned og = xb_add(&bar[XB_TOP], 1u);
            const unsigned tg = og / nx;
            if (og + 1u == (tg + 1u) * nx) xb_add(&bar[XB_TOPGEN], 1u);
            else XB_SPIN(xb_ld(&bar[XB_TOPGEN]) == tg, bar);
            __builtin_amdgcn_fence(__ATOMIC_ACQUIRE, "agent");
            xb_add(&bar[XB_XGEN(b.x)], 1u);
            asm volatile("s_waitcnt vmcnt(0)" ::: "memory");
        } else {
            XB_SPIN(xb_ld(&bar[XB_XGEN(b.x)]) == gen, bar);
            __builtin_amdgcn_fence(__ATOMIC_ACQUIRE, "agent");
            asm volatile("s_waitcnt vmcnt(0)" ::: "memory");
        }
    }
    __syncthreads();
}

struct Args {
    const float* in[19];
    float* out;
    unsigned char* ws;
    int ph_lo, ph_hi, aux, pad;
};

namespace pg8 {
constexpr int BM = 256, BK = 64, HALF = 128, HTB = HALF * BK * 2;
__host__ __device__ __forceinline__ int lds_byte(int r, int c) { const int st = (r >> 4) * 2 + (c >> 5), rr = r & 15, cc = c & 31, ob = rr * 64 + cc * 2; return st * 1024 + (ob ^ (((ob >> 9) & 1) << 5)); }
__host__ __device__ __forceinline__ void stage_rc(int b, int& R, int& C) { const int st = b / 1024, sb = b % 1024, swz = sb ^ (((sb >> 9) & 1) << 5); R = (st >> 1) * 16 + swz / 64; C = (st & 1) * 32 + (swz % 64) / 2; }
__host__ __device__ __forceinline__ int perm32(int rho) { const int n = rho >> 4, i = rho & 15; return 8 * (i >> 2) + 4 * n + (i & 3); }

struct Unit { const char* A; const char* B; int p0, p1, p2, p3, ui; };

#define PG8_SA(b, h) (((b) * 2 + (h)) * HTB)
#define PG8_SB(b, h) ((4 + (b) * 2 + (h)) * HTB)
#define PG8_LDA(dst, b, h) do { _Pragma("unroll") for (int m = 0; m < 4; ++m) _Pragma("unroll") for (int k = 0; k < 2; ++k) dst[m][k] = *(const LAS bf16x8*)(lds + PG8_SA(b, h) + aoff + m * 2048 + k * 1024); } while (0)
#define PG8_LDB(dst, b, h) do { _Pragma("unroll") for (int n = 0; n < 2; ++n) _Pragma("unroll") for (int k = 0; k < 2; ++k) dst[n][k] = *(const LAS bf16x8*)(lds + PG8_SB(b, h) + boff + n * 2048 + k * 1024); } while (0)
#define PG8_MMA(ai, bj, At, Bt) do { __builtin_amdgcn_s_setprio(1); _Pragma("unroll") for (int m = 0; m < 4; ++m) _Pragma("unroll") for (int n = 0; n < 2; ++n) _Pragma("unroll") for (int k = 0; k < 2; ++k) \
        acc[ai][bj][m][n] = __builtin_amdgcn_mfma_f32_16x16x32_bf16(Bt[n][k], At[m][k], acc[ai][bj][m][n], 0, 0, 0); __builtin_amdgcn_s_setprio(0); } while (0)

template <class P>
__device__ __forceinline__ void gemm_simple(LAS unsigned char* lds, const P& S) {
    const int tid = threadIdx.x, wid = __builtin_amdgcn_readfirstlane(tid >> 6), lane = tid & 63, wr = wid >> 2, wc = wid & 3, fr = lane & 15, fq = lane >> 4;
    const int nt = S.nt();
    int R0, C0; stage_rc(tid * 16, R0, C0);
    unsigned offB[2];
#pragma unroll
    for (int i = 0; i < 2; ++i) { const int R = R0 + 64 * i; const int Rb = (R & ~31) + perm32(R & 31); offB[i] = (unsigned)Rb * S.ldb_bytes() + (unsigned)C0 * 2u; }
    const unsigned bhalf = 128u * S.ldb_bytes();
    const int aoff = lds_byte(wr * 64 + fr, fq * 8), boff = lds_byte(wc * 32 + fr, fq * 8);
    Unit u;
    for (int ui = 0; S.next(ui, u); ++ui) {
        unsigned offA[4]; S.aoff(u, R0, C0, offA);
        f32x4 acc[2][2][4][2];
#pragma unroll
        for (int a = 0; a < 2; ++a)
#pragma unroll
            for (int b = 0; b < 2; ++b)
#pragma unroll
                for (int m = 0; m < 4; ++m)
#pragma unroll
                    for (int n = 0; n < 2; ++n) acc[a][b][m][n] = (f32x4){0.f, 0.f, 0.f, 0.f};
        for (int t = 0; t < nt; ++t) {
            u32x4 ra[4], rb[4];
#pragma unroll
            for (int h = 0; h < 2; ++h)
#pragma unroll
                for (int i = 0; i < 2; ++i) {
                    ra[2 * h + i] = *(const u32x4*)(u.A + offA[2 * h + i] + (size_t)t * 128);
                    rb[2 * h + i] = *(const u32x4*)(u.B + (size_t)h * bhalf + offB[i] + (size_t)t * 128);
                }
            __syncthreads();
#pragma unroll
            for (int h = 0; h < 2; ++h)
#pragma unroll
                for (int i = 0; i < 2; ++i) {
                    *(LAS u32x4*)(lds + PG8_SA(0, h) + tid * 16 + i * 8192) = ra[2 * h + i];
                    *(LAS u32x4*)(lds + PG8_SB(0, h) + tid * 16 + i * 8192) = rb[2 * h + i];
                }
            __syncthreads();
            bf16x8 At[4][2], Bt[2][2];
#pragma unroll
            for (int ai = 0; ai < 2; ++ai) {
                PG8_LDA(At, 0, ai);
#pragma unroll
                for (int bj = 0; bj < 2; ++bj) { PG8_LDB(Bt, 0, bj); PG8_MMA(ai, bj, At, Bt); }
            }
        }
        S.epi(acc, u, wr, wc, fr, fq);
    }
    __syncthreads();
}

template <class P>
__device__ __forceinline__ void gemm_pipe(LAS unsigned char* lds, const P& S) {
    const int tid = threadIdx.x, wid = __builtin_amdgcn_readfirstlane(tid >> 6), lane = tid & 63, wr = wid >> 2, wc = wid & 3, fr = lane & 15, fq = lane >> 4;
    constexpr int KR = GEMM_KREP * P::KREP; const int nt1 = S.nt(), nt = nt1 * KR;
    int R0, C0; stage_rc(tid * 16, R0, C0);
    unsigned offB[2];
#pragma unroll
    for (int i = 0; i < 2; ++i) { const int R = R0 + 64 * i; const int Rb = (R & ~31) + perm32(R & 31); offB[i] = (unsigned)Rb * S.ldb_bytes() + (unsigned)C0 * 2u; }
    const size_t bhalf = (size_t)128u * S.ldb_bytes();
    const size_t kstep = 128;
    const unsigned ldsw = (unsigned)wid * 1024u;
    int aoffK[2], boffK[2];
#pragma unroll
    for (int k = 0; k < 2; ++k) { aoffK[k] = lds_byte(wr * 64 + fr, fq * 8) + k * 1024; boffK[k] = lds_byte(wc * 32 + fr, fq * 8) + k * 1024; }
#undef PG8_LDA
#undef PG8_LDB
#undef PG8_MMA
#define PG8_LDA(dst, b, h) do { _Pragma("unroll") for (int m = 0; m < 4; ++m) { \
        if constexpr (P::FP8) dst##8[m] = __builtin_shufflevector(*(const LAS v4i_t*)(lds + PG8_SA(b, h) + aoffK[0] + m * 2048), *(const LAS v4i_t*)(lds + PG8_SA(b, h) + aoffK[1] + m * 2048), 0, 1, 2, 3, 4, 5, 6, 7); \
        else { _Pragma("unroll") for (int k = 0; k < 2; ++k) dst[m][k] = *(const LAS bf16x8*)(lds + PG8_SA(b, h) + aoffK[k] + m * 2048); } } } while (0)
#define PG8_LDB(dst, b, h) do { _Pragma("unroll") for (int n = 0; n < 2; ++n) { \
        if constexpr (P::FP8) dst##8[n] = __builtin_shufflevector(*(const LAS v4i_t*)(lds + PG8_SB(b, h) + boffK[0] + n * 2048), *(const LAS v4i_t*)(lds + PG8_SB(b, h) + boffK[1] + n * 2048), 0, 1, 2, 3, 4, 5, 6, 7); \
        else { _Pragma("unroll") for (int k = 0; k < 2; ++k) dst[n][k] = *(const LAS bf16x8*)(lds + PG8_SB(b, h) + boffK[k] + n * 2048); } } } while (0)
#define PG8_MMA(ai, bj, At, Bt) do { if constexpr (P::FP8) __builtin_amdgcn_sched_barrier(0); __builtin_amdgcn_s_setprio(1); _Pragma("unroll") for (int m = 0; m < 4; ++m) _Pragma("unroll") for (int n = 0; n < 2; ++n) { \
        if constexpr (P::FP8) acc[ai][bj][m][n] = __builtin_amdgcn_mfma_scale_f32_16x16x128_f8f6f4(Bt##8[n], At##8[m], acc[ai][bj][m][n], 0, 0, 0, 127, 0, 127); \
        else { _Pragma("unroll") for (int k = 0; k < 2; ++k) acc[ai][bj][m][n] = __builtin_amdgcn_mfma_f32_16x16x32_bf16(Bt[n][k], At[m][k], acc[ai][bj][m][n], 0, 0, 0); } } \
        if constexpr (P::FP8) { _Pragma("unroll") for (int m = 0; m < 4; ++m) _Pragma("unroll") for (int n = 0; n < 2; ++n) asm volatile("" : "+v"(acc[ai][bj][m][n])); } \
        __builtin_amdgcn_s_setprio(0); if constexpr (P::FP8) __builtin_amdgcn_sched_barrier(0); } while (0)
#define PG8_STAGE_A(bufoff, gbase, OFF, h) do { _Pragma("unroll") for (int _i = 0; _i < 2; ++_i) \
        __builtin_amdgcn_global_load_lds((const unsigned*)((const char*)(gbase) + (OFF)[2 * (h) + _i]), (LAS unsigned*)(lds + (bufoff) + ldsw + _i * 8192), 16, 0, 0); } while (0)
#define PG8_STAGE_B(bufoff, gbase) do { _Pragma("unroll") for (int _i = 0; _i < 2; ++_i) \
        __builtin_amdgcn_global_load_lds((const unsigned*)((const char*)(gbase) + offB[_i]), (LAS unsigned*)(lds + (bufoff) + ldsw + _i * 8192), 16, 0, 0); } while (0)
#define PG8_WAIT_V(n) asm volatile("s_waitcnt vmcnt(" #n ")" ::: "memory")
#define PG8_WAIT_L(n) asm volatile("s_waitcnt lgkmcnt(" #n ")" ::: "memory")
#define PG8_BAR __builtin_amdgcn_s_barrier()
#define PG8_SCHED __builtin_amdgcn_sched_barrier(0)
    Unit cur, nxt; int ui = 0; int pend = -1;
    if (!S.next(0, cur)) return;
    f32x4 acc[2][2][4][2];
#pragma unroll
    for (int a = 0; a < 2; ++a)
#pragma unroll
        for (int b = 0; b < 2; ++b)
#pragma unroll
            for (int m = 0; m < 4; ++m)
#pragma unroll
                for (int n = 0; n < 2; ++n) acc[a][b][m][n] = (f32x4){0.f, 0.f, 0.f, 0.f};
    bf16x8 At[4][2], B0[2][2], B1[2][2];
    v8i_t At8[4], B08[2], B18[2];
    unsigned offC[4], offN[4];
    S.aoff(cur, R0, C0, offC);
    const char* cA = cur.A; const char* cB = cur.B;
    if constexpr (P::HAS_READY) S.a_ready(cur);
    PG8_STAGE_B(PG8_SB(0, 0), cB); PG8_STAGE_B(PG8_SB(0, 1), cB + bhalf); PG8_STAGE_A(PG8_SA(0, 0), cA, offC, 0); PG8_STAGE_A(PG8_SA(0, 1), cA, offC, 1);
    if (wr == 1) PG8_BAR;
    PG8_WAIT_V(2); PG8_BAR;
    PG8_STAGE_B(PG8_SB(1, 0), cB + kstep); PG8_STAGE_A(PG8_SA(1, 0), cA + kstep, offC, 0); PG8_STAGE_B(PG8_SB(1, 1), cB + bhalf + kstep);
    PG8_WAIT_V(6); PG8_BAR;
    for (;;) {
        const bool has_next = S.next(ui + 1, nxt);
        if (has_next) S.aoff(nxt, R0, C0, offN);
        else {
#pragma unroll
            for (int q = 0; q < 4; ++q) offN[q] = offC[q];
        }
        const char* nA = has_next ? nxt.A : cA; const char* nB = has_next ? nxt.B : cB;
        for (int t = 0; t < nt; t += 2) {
            const bool last = (t == nt - 2);
            const bool sf = P::SEAM_OPT && (ui > 0) && (t == 0);
            if constexpr (P::HAS_READY) { if (last && has_next) S.a_ready(nxt); }
            const char* a1 = cA + (size_t)((t + 1) % nt1) * kstep;
            const char* a2 = last ? nA : cA + (size_t)((t + 2) % nt1) * kstep; const char* b2 = last ? nB : cB + (size_t)((t + 2) % nt1) * kstep;
            const char* a3 = a2 + kstep; const char* b3 = b2 + kstep;
            unsigned o2[4];
#pragma unroll
            for (int q = 0; q < 4; ++q) o2[q] = last ? offN[q] : offC[q];
            PG8_LDB(B0, 0, 0); PG8_LDB(B1, 0, 1); PG8_SCHED; PG8_LDA(At, 0, 0); if (!sf) { PG8_STAGE_A(PG8_SA(1, 1), a1, offC, 1); PG8_WAIT_V(8); }
            PG8_WAIT_L(0); PG8_BAR; PG8_MMA(0, 0, At, B0); PG8_MMA(0, 1, At, B1); PG8_BAR; PG8_SCHED;
            PG8_LDA(At, 0, 1); PG8_STAGE_B(PG8_SB(0, 0), b2); PG8_STAGE_B(PG8_SB(0, 1), b2 + bhalf); PG8_STAGE_A(PG8_SA(0, 0), a2, o2, 0);
            if (!sf) PG8_WAIT_V(8); PG8_WAIT_L(0); PG8_BAR; PG8_MMA(1, 0, At, B0); PG8_MMA(1, 1, At, B1); PG8_BAR; PG8_SCHED;
            PG8_LDB(B0, 1, 0); PG8_LDB(B1, 1, 1); PG8_SCHED; PG8_LDA(At, 1, 0); PG8_STAGE_A(PG8_SA(0, 1), a2, o2, 1);
            if (!sf) PG8_WAIT_V(8); PG8_WAIT_L(0); PG8_BAR; PG8_MMA(0, 0, At, B0); PG8_MMA(0, 1, At, B1); PG8_BAR; PG8_SCHED;
            PG8_LDA(At, 1, 1); PG8_STAGE_B(PG8_SB(1, 0), b3); PG8_STAGE_B(PG8_SB(1, 1), b3 + bhalf); PG8_STAGE_A(PG8_SA(1, 0), a3, o2, 0);
            if (!sf) PG8_WAIT_V(8); PG8_WAIT_L(0); PG8_BAR; PG8_MMA(1, 0, At, B0); PG8_MMA(1, 1, At, B1); PG8_BAR; PG8_SCHED;
        }
        if constexpr (P::SEAM_OPT) PG8_STAGE_A(PG8_SA(1, 1), nA + kstep, offN, 1);
        if (wr == 0) PG8_BAR;
        if constexpr (P::SEAM_OPT) { PG8_WAIT_V(0);
            S.flush(pend); pend = -1; }
        if (KR != 1) {
#pragma unroll
            for (int a = 0; a < 2; ++a)
#pragma unroll
                for (int b = 0; b < 2; ++b)
#pragma unroll
                    for (int m = 0; m < 4; ++m)
#pragma unroll
                        for (int n = 0; n < 2; ++n) acc[a][b][m][n] = acc[a][b][m][n] * (1.0f / KR);
        }
        pend = S.epi(acc, cur, wr, wc, fr, fq);
        if constexpr (!P::SEAM_OPT) { if (pend >= 0) { PG8_WAIT_V(0); S.flush(pend); pend = -1; } }
        if (!has_next) break;
#pragma unroll
        for (int a = 0; a < 2; ++a)
#pragma unroll
            for (int b = 0; b < 2; ++b)
#pragma unroll
                for (int m = 0; m < 4; ++m)
#pragma unroll
                    for (int n = 0; n < 2; ++n) acc[a][b][m][n] = (f32x4){0.f, 0.f, 0.f, 0.f};
        cur = nxt; cA = nA; cB = nB; ++ui;
#pragma unroll
        for (int q = 0; q < 4; ++q) offC[q] = offN[q];
        if (wr == 1) PG8_BAR;
    }
    PG8_WAIT_V(0);
    S.flush(pend);
    PG8_BAR;
#undef PG8_STAGE_A
#undef PG8_STAGE_B
#undef PG8_WAIT_V
#undef PG8_WAIT_L
#undef PG8_BAR
#undef PG8_SCHED
}
}

struct Frame {
    LAS unsigned char* lds;
    volatile LAS unsigned* MISC;
    unsigned* ctl;
    int tid, lane, wave, vcu, G;
    unsigned char* ws;
    float* out;
};
typedef const float* cfptr_t;
__device__ __forceinline__ const float* inptr(int i) {
    const __attribute__((address_space(4))) cfptr_t* ka = (const __attribute__((address_space(4))) cfptr_t*)__builtin_amdgcn_kernarg_segment_ptr();
    asm volatile("" : "+s"(ka));
    const GAS float* g = (const GAS float*)ka[i];
    return (const float*)g;
}
#define WSP(F, off, type) ((type*)((F).ws + (off)))

template <class RowMap>
__device__ __forceinline__ void transpose_tile(const float* W, int K, int N, bf16_t* WT, LAS unsigned char* scr, int item, int lane, const RowMap& rm) {
    const int nblk = N / 64, kb = item / nblk, nb = item % nblk, k0 = 64 * kb, n0 = 64 * nb;
    const int kg = lane & 3, ng = lane >> 2;
    f32x4 v[4][4];
#pragma unroll
    for (int r = 0; r < 4; ++r)
#pragma unroll
        for (int i = 0; i < 4; ++i) v[r][i] = __builtin_nontemporal_load((const f32x4*)(W + (size_t)(k0 + 16 * r + 4 * kg + i) * N + n0 + 4 * ng));
#pragma unroll
    for (int r = 0; r < 4; ++r)
#pragma unroll
        for (int j = 0; j < 4; ++j)
            *(LAS u32x2*)(scr + (4 * ng + j) * 144 + (16 * r + 4 * kg) * 2) = (u32x2){cvt_pk_bf16(v[r][0][j], v[r][1][j]), cvt_pk_bf16(v[r][2][j], v[r][3][j])};
    asm volatile("s_waitcnt lgkmcnt(0)" ::: "memory");
    const int c = lane & 7;
#pragma unroll
    for (int q = 0; q < 8; ++q) { const int n = (lane >> 3) + 8 * q; const u32x4 o = *(const LAS u32x4*)(scr + n * 144 + c * 16); __builtin_nontemporal_store(o, (u32x4*)(WT + (size_t)rm(n0 + n) * K + k0 + 8 * c)); }
    asm volatile("s_waitcnt lgkmcnt(0)" ::: "memory");
}
template <class RowMap>
__device__ __forceinline__ void transpose_tile8(const float* W, int K, int N, unsigned char* WT, LAS unsigned char* scr, int item, int lane, const RowMap& rm) {
    const int nblk = N / 64, kb = item / nblk, nb = item % nblk, k0 = 128 * kb, n0 = 64 * nb;
    const int kg = lane & 3, ng = lane >> 2;
#pragma unroll
    for (int hb = 0; hb < 2; ++hb) {
        f32x4 v[4][4];
#pragma unroll
        for (int r = 0; r < 4; ++r)
#pragma unroll
            for (int i = 0; i < 4; ++i) v[r][i] = __builtin_nontemporal_load((const f32x4*)(W + (size_t)(k0 + 64 * hb + 16 * r + 4 * kg + i) * N + n0 + 4 * ng));
#pragma unroll
        for (int r = 0; r < 4; ++r)
#pragma unroll
            for (int j = 0; j < 4; ++j)
                *(LAS unsigned*)(scr + (4 * ng + j) * 144 + 64 * hb + 16 * r + 4 * kg) = pack_fp8x4(v[r][0][j] * W8_SCALE, v[r][1][j] * W8_SCALE, v[r][2][j] * W8_SCALE, v[r][3][j] * W8_SCALE);
    }
    asm volatile("s_waitcnt lgkmcnt(0)" ::: "memory");
    const int c = lane & 7;
#pragma unroll
    for (int q = 0; q < 8; ++q) { const int n = (lane >> 3) + 8 * q; const u32x4 o = *(const LAS u32x4*)(scr + n * 144 + c * 16); __builtin_nontemporal_store(o, (u32x4*)(WT + (size_t)rm(n0 + n) * K + k0 + 16 * c)); }
    asm volatile("s_waitcnt lgkmcnt(0)" ::: "memory");
}
struct RmId { __device__ __forceinline__ int operator()(int n) const { return n; } };
struct RmWin { __device__ __forceinline__ int operator()(int n) const {
        const int s = n >> 9; if (s != 4 && s != 5) return n;
        const int d = n & 127, dd = d & 63; const int p = 8 * (dd >> 2) + (dd & 3) + ((d >> 6) << 2); return n - d + p; } };
struct RmGu { __device__ __forceinline__ int operator()(int n) const { const int half = n >> 10, j = (n & 1023) >> 7, i = n & 127; return 256 * j + 128 * half + i; } };

__device__ __forceinline__ void p0_prologue(Frame& F) {
    const int tid = F.tid;
    {
        LAS float* red = (LAS float*)F.lds;
        const float* c = inptr(1);
        for (int u = F.vcu; u < 192; u += F.G) {
            const int l = u / 96, cg = u % 96, kq = tid >> 4, cq = tid & 15;
            const float* W = inptr(2) + (size_t)l * D * 6 * D + cg * 64 + cq * 4;
            f32x4 a = {0.f, 0.f, 0.f, 0.f};
#pragma unroll 8
            for (int j = 0; j < 32; ++j) { const int k = kq + 32 * j; const float cv = siluf_(c[k]); const f32x4 w = *(const f32x4*)(W + (size_t)k * 6 * D); a += w * cv; }
            __syncthreads();
            *(LAS f32x4*)(red + kq * 64 + cq * 4) = a;
            __syncthreads();
            if (tid < 64) { float s = 0.f;
#pragma unroll 8
                for (int k = 0; k < 32; ++k) s += red[k * 64 + tid];
                const int col = cg * 64 + tid;
                WSP(F, WS_MOD, float)[l * 6 * D + col] = s + inptr(3)[l * 6 * D + col]; }
        }
        __syncthreads();
    }
    if (F.vcu == 0) { const float* hb = inptr(5); const float a = hb[tid], b = hb[512 + tid]; WSP(F, WS_LB, float)[tid] = 1.0f / (1.0f + __expf(b - a)); }
    {
        bf16_t* rt = WSP(F, WS_RT, bf16_t); const float* wr = inptr(12);
        for (int idx = F.vcu * NTH + tid; idx < 2 * D * NE; idx += F.G * NTH) {
            const int l = idx >> 15, rem = idx & 32767, c = rem >> 5, e = rem & 31;
            const float w = wr[idx]; const unsigned hi = cvt_pk_bf16(w, 0.f) & 0xffffu; const float res = w - bflo(hi);
            rt[((size_t)(l * 2 + 0) * 32 + e) * D + c] = (bf16_t)hi; rt[((size_t)(l * 2 + 1) * 32 + e) * D + c] = (bf16_t)(cvt_pk_bf16(res, 0.f) & 0xffffu);
        }
    }
    {
        f32x2* rope = WSP(F, WS_ROPE, f32x2);
        for (int idx = F.vcu * NTH + tid; idx < T * 64; idx += F.G * NTH) {
            const int t = idx >> 6, d = idx & 63;
            const float inv = exp2f(-(float)d * (13.287712379549449f / 64.0f));
            const float ang = (float)t * inv;
            const double a = (double)ang; const double n = __builtin_rint(a * 0.15915494309189535); const double r = __builtin_fma(-n, 6.283185307179586, a);
            const float rf = (float)r;
            rope[idx] = (f32x2){__cosf(rf), __sinf(rf)};
        }
    }
    {
        LAS unsigned char* scr = F.lds + F.wave * 16384;
        const int gw = F.vcu * NWAVES + F.wave, NGW = F.G * NWAVES;
        constexpr int I_IN = 16 * 64, I_OUT = 16 * 16, I_POOL = 4 * 4 * 4;
        constexpr int NL8 = ((FP8_LAYERS & 1) ? 1 : 0) + ((FP8_LAYERS & 2) ? 1 : 0), NL16 = 2 - NL8;
        constexpr int S_GU = 32 * 8 * 32, S_DN = 32 * 8 * 16;
        constexpr int T_GU = 32 * 16 * 32, T_DN = 32 * 16 * 16;
        constexpr int N8 = NL8 * (S_GU + S_DN), N16 = NL16 * (T_GU + T_DN);
        constexpr int NITEMS = N8 + I_IN + I_OUT + I_POOL + N16;
        for (int it = gw; it < NITEMS; it += NGW) {
            int r = it;
            if (r < N8) {
                const int li = r / (S_GU + S_DN), layer = (NL8 == 2) ? li : ((FP8_LAYERS & 1) ? 0 : 1); r -= li * (S_GU + S_DN);
                if (r < S_GU) { const int m = layer * 32 + r / 256; transpose_tile8(inptr(14) + (size_t)m * D * 2048, D, 2048, (unsigned char*)(WSP(F, WS_WGUT, bf16_t) + (size_t)layer * NE * 2048 * D) + (size_t)(m & 31) * 2048 * D, scr, r % 256, F.lane, RmGu()); }
                else { r -= S_GU; const int m = layer * 32 + r / 128; transpose_tile8(inptr(16) + (size_t)m * D * D, D, D, (unsigned char*)(WSP(F, WS_WDNT, bf16_t) + (size_t)layer * NE * D * D) + (size_t)(m & 31) * D * D, scr, r % 128, F.lane, RmId()); }
                continue;
            }
            r -= N8;
            if (r < I_IN) { transpose_tile(inptr(4), D, INW, WSP(F, WS_WINT, bf16_t), scr, r, F.lane, RmWin()); continue; } r -= I_IN;
            if (r < I_OUT) { transpose_tile(inptr(8), D, D, WSP(F, WS_WOUTT, bf16_t), scr, r, F.lane, RmId()); continue; } r -= I_OUT;
            if (r < I_POOL) { const int g = r / 16; transpose_tile(inptr(9) + (size_t)g * 65536, 256, 256, WSP(F, WS_POOLT, bf16_t) + (size_t)g * 65536, scr, r % 16, F.lane, RmId()); continue; } r -= I_POOL;
            if (NL16 > 0) {
                const int li = r / (T_GU + T_DN), layer = (NL16 == 2) ? li : ((FP8_LAYERS & 1) ? 1 : 0); r -= li * (T_GU + T_DN);
                if (r < T_GU) { const int m = layer * 32 + r / 512; transpose_tile(inptr(14) + (size_t)m * D * 2048, D, 2048, WSP(F, WS_WGUT, bf16_t) + (size_t)m * 2048 * D, scr, r % 512, F.lane, RmGu()); }
                else { r -= T_GU; const int m = layer * 32 + r / 256; transpose_tile(inptr(16) + (size_t)m * D * D, D, D, WSP(F, WS_WDNT, bf16_t) + (size_t)m * D * D, scr, r % 256, F.lane, RmId()); }
            }
        }
    }
}

__device__ __forceinline__ void p1_norm_in(Frame& F) {
    const float* mod = WSP(F, WS_MOD, float);
    f32x4 sh[4], sc[4];
#pragma unroll
    for (int j = 0; j < 4; ++j) { sh[j] = *(const f32x4*)(mod + 0 * D + 4 * F.lane + 256 * j); sc[j] = *(const f32x4*)(mod + 1 * D + 4 * F.lane + 256 * j) + 1.0f; }
    const int gw = F.vcu * NWAVES + F.wave, NGW = F.G * NWAVES;
    for (int row = gw; row < T; row += NGW) {
        const f32x4* xr = (const f32x4*)(inptr(0) + (size_t)row * D) + F.lane;
        f32x4 v[4]; float s = 0.f;
#pragma unroll
        for (int j = 0; j < 4; ++j) { v[j] = xr[64 * j]; s += (v[j].x * v[j].x + v[j].y * v[j].y) + (v[j].z * v[j].z + v[j].w * v[j].w); }
        const float rstd = rsqrtf(wave_sum(s) * (1.f / D) + EPS);
        u32x2* o = (u32x2*)(WSP(F, WS_HN, bf16_t) + (size_t)row * D) + F.lane;
#pragma unroll
        for (int j = 0; j < 4; ++j) { const f32x4 h = v[j] * rstd * sc[j] + sh[j]; o[64 * j] = (u32x2){cvt_pk_bf16(h.x, h.y), cvt_pk_bf16(h.z, h.w)}; }
    }
}

using pg8::Unit;
typedef f32x4 AccT[2][2][4][2];

struct GemmBase {
    static constexpr bool SEAM_OPT = false;
    __device__ __forceinline__ void flush(int) const {}
    static constexpr bool HAS_READY = false;
    static constexpr bool FP8 = false;
    int G, vcu;
    __device__ __forceinline__ void aoff_lin(int R0, int C0, unsigned lda_bytes, unsigned (&off)[4]) const {
#pragma unroll
        for (int q = 0; q < 4; ++q) off[q] = (unsigned)(R0 + 64 * (q & 1) + 128 * (q >> 1)) * lda_bytes + (unsigned)C0 * 2u;
    }
};

struct PolWin : GemmBase {
    static constexpr int KREP = KREP_WIN;
    const bf16_t* A; const bf16_t* Bt; bf16_t* qkvg; _Float16* gbuf; const float* lb; const f32x2* rope;
    __device__ __forceinline__ int nt() const { return D / 64; }
    __device__ __forceinline__ unsigned ldb_bytes() const { return D * 2; }
    __device__ __forceinline__ bool next(int i, Unit& u) const {
        const int V = i * G + vcu; if (V >= 64 * 16) return false;
        u.p0 = V >> 4; u.p1 = V & 15; u.A = (const char*)(A + (size_t)u.p0 * 256 * D); u.B = (const char*)(Bt + (size_t)u.p1 * 256 * D); return true; }
    __device__ __forceinline__ void aoff(const Unit&, int R0, int C0, unsigned (&off)[4]) const { aoff_lin(R0, C0, D * 2, off); }
    __device__ __forceinline__ int epi(const AccT& acc, const Unit& u, int wr, int wc, int fr, int fq) const {
        const int pm = u.p0, pn = u.p1, s = pn >> 1;
        const int row0 = pm * 256 + wr * 64 + fr;
        const int o0 = (pn & 1) * 256 + wc * 32 + 8 * fq;
        const int dbase = (s & 3) * 1024 + (s >> 2) * 512;
        bf16_t* obase = qkvg + (size_t)row0 * INW + dbase;
        if (s == 4 || s == 5) {
            const int d0 = 4 * ((o0 & 127) >> 3);
            const float qs = (s == 5) ? 0.08838834764831845f : 1.0f;
#pragma unroll
            for (int ah = 0; ah < 2; ++ah) {
                f32x4 rc[4][2];
#pragma unroll
                for (int m = 0; m < 4; ++m) { const f32x4* rp = (const f32x4*)(rope + (size_t)(row0 + ah * 128 + m * 16) * 64 + d0); rc[m][0] = rp[0]; rc[m][1] = rp[1]; }
#pragma unroll
                for (int m = 0; m < 4; ++m) {
                    const f32x4 cs = {rc[m][0].x * qs, rc[m][0].z * qs, rc[m][1].x * qs, rc[m][1].z * qs}, sn = {rc[m][0].y * qs, rc[m][0].w * qs, rc[m][1].y * qs, rc[m][1].w * qs};
                    bf16_t* orow = obase + (size_t)(ah * 128 + m * 16) * INW;
#pragma unroll
                    for (int bj = 0; bj < 2; ++bj) {
                        const int hd = (o0 + bj * 128) & ~127;
                        const f32x4 v0 = acc[ah][bj][m][0], v1 = acc[ah][bj][m][1];
                        const f32x4 o1 = v0 * cs - v1 * sn, o2 = v0 * sn + v1 * cs;
                        *(u32x2*)(orow + hd + d0) = (u32x2){cvt_pk_bf16(o1.x, o1.y), cvt_pk_bf16(o1.z, o1.w)};
                        *(u32x2*)(orow + hd + d0 + 64) = (u32x2){cvt_pk_bf16(o2.x, o2.y), cvt_pk_bf16(o2.z, o2.w)};
                    }
                }
            }
        } else if (s == 1) {
            f32x4 l[2][2];
#pragma unroll
            for (int bj = 0; bj < 2; ++bj) { l[bj][0] = *(const f32x4*)(lb + o0 + bj * 128); l[bj][1] = *(const f32x4*)(lb + o0 + bj * 128 + 4); }
#pragma unroll
            for (int am = 0; am < 8; ++am) {
                const size_t ro = (size_t)((am >> 2) * 128 + (am & 3) * 16);
#pragma unroll
                for (int bj = 0; bj < 2; ++bj) {
                    const int o = o0 + bj * 128;
                    f32x4 v0 = acc[am >> 2][bj][am & 3][0], v1 = acc[am >> 2][bj][am & 3][1], g0, g1;
#pragma unroll
                    for (int j = 0; j < 4; ++j) {
                        const float f0 = l[bj][0][j] + (1.0f - l[bj][0][j]) * sigmoidf_(v0[j]), f1 = l[bj][1][j] + (1.0f - l[bj][1][j]) * sigmoidf_(v1[j]);
                        g0[j] = __logf(f0); g1[j] = __logf(f1); v0[j] = 1.0f - f0; v1[j] = 1.0f - f1; }
                    *(h16x8*)(gbuf + ((size_t)row0 + ro) * 512 + o) = (h16x8){(_Float16)g0[0], (_Float16)g0[1], (_Float16)g0[2], (_Float16)g0[3], (_Float16)g1[0], (_Float16)g1[1], (_Float16)g1[2], (_Float16)g1[3]};
                    u32x4 w; w.x = cvt_pk_bf16(v0[0], v0[1]); w.y = cvt_pk_bf16(v0[2], v0[3]); w.z = cvt_pk_bf16(v1[0], v1[1]); w.w = cvt_pk_bf16(v1[2], v1[3]);
                    *(u32x4*)(obase + ro * INW + o) = w;
                }
            }
        } else {
            const bool act = (s == 0 || s == 3 || s == 7);
#pragma unroll
            for (int am = 0; am < 8; ++am) {
                const size_t ro = (size_t)((am >> 2) * 128 + (am & 3) * 16);
#pragma unroll
                for (int bj = 0; bj < 2; ++bj) {
                    f32x4 v0 = acc[am >> 2][bj][am & 3][0], v1 = acc[am >> 2][bj][am & 3][1];
                    if (act) {
#pragma unroll
                        for (int j = 0; j < 4; ++j) { v0[j] = siluf_(v0[j]); v1[j] = siluf_(v1[j]); }
                    }
                    u32x4 w; w.x = cvt_pk_bf16(v0[0], v0[1]); w.y = cvt_pk_bf16(v0[2], v0[3]); w.z = cvt_pk_bf16(v1[0], v1[1]); w.w = cvt_pk_bf16(v1[2], v1[3]);
                    *(u32x4*)(obase + ro * INW + o0 + bj * 128) = w;
                }
            }
        }
            return -1;
    }
};

template <bool R16>
struct PolRes : GemmBase {
    static constexpr int KREP = KREP_RES;
    const bf16_t* A; const bf16_t* Bt; const float* resid; const bf16_t* resid16; bf16_t* outp; const float* gate; const float* bias; const float* scale;
    int K, lda, nN, kcol;
    __device__ __forceinline__ int nt() const { return K / 64; }
    __device__ __forceinline__ unsigned ldb_bytes() const { return (unsigned)K * 2u; }
    __device__ __forceinline__ bool next(int i, Unit& u) const {
        const int V = i * G + vcu; if (V >= 64 * nN) return false;
        u.p0 = V / nN; u.p1 = V % nN; u.A = (const char*)(A + (size_t)u.p0 * 256 * lda + (size_t)u.p1 * kcol); u.B = (const char*)(Bt + (size_t)u.p1 * 256 * K); return true; }
    __device__ __forceinline__ void aoff(const Unit&, int R0, int C0, unsigned (&off)[4]) const { aoff_lin(R0, C0, (unsigned)lda * 2u, off); }
    __device__ __forceinline__ int epi(const AccT& acc, const Unit& u, int wr, int wc, int fr, int fq) const {
        const int row0 = u.p0 * 256 + wr * 64 + fr, col0 = u.p1 * 256 + wc * 32 + 8 * fq;
#pragma unroll
        for (int bj = 0; bj < 2; ++bj) {
            const int c = col0 + bj * 128;
            const f32x4 g0 = *(const f32x4*)(gate + c), g1 = *(const f32x4*)(gate + c + 4);
            f32x4 b0 = {0.f, 0.f, 0.f, 0.f}, b1 = b0, s0 = {1.f, 1.f, 1.f, 1.f}, s1 = s0;
            if (bias) { b0 = *(const f32x4*)(bias + c); b1 = *(const f32x4*)(bias + c + 4); s0 = *(const f32x4*)(scale + c); s1 = *(const f32x4*)(scale + c + 4); }
#pragma unroll
            for (int ah = 0; ah < 2; ++ah) {
                f32x4 r[4][2];
                if constexpr (!R16) {
#pragma unroll
                    for (int m = 0; m < 4; ++m) { const size_t idx = (size_t)(row0 + ah * 128 + m * 16) * D + c; r[m][0] = *(const f32x4*)(resid + idx); r[m][1] = *(const f32x4*)(resid + idx + 4); }
                } else {
                    u32x4 q[4];
#pragma unroll
                    for (int m = 0; m < 4; ++m) q[m] = *(const u32x4*)(resid16 + (size_t)(row0 + ah * 128 + m * 16) * D + c);
#pragma unroll
                    for (int m = 0; m < 4; ++m) { r[m][0] = (f32x4){bflo(q[m].x), bfhi(q[m].x), bflo(q[m].y), bfhi(q[m].y)}; r[m][1] = (f32x4){bflo(q[m].z), bfhi(q[m].z), bflo(q[m].w), bfhi(q[m].w)}; }
                }
#pragma unroll
                for (int m = 0; m < 4; ++m) {
                    const size_t idx = (size_t)(row0 + ah * 128 + m * 16) * D + c;
                    const f32x4 o0 = r[m][0] + g0 * ((acc[ah][bj][m][0] + b0) * s0), o1 = r[m][1] + g1 * ((acc[ah][bj][m][1] + b1) * s1);
                    *(u32x4*)(outp + idx) = (u32x4){cvt_pk_bf16(o0.x, o0.y), cvt_pk_bf16(o0.z, o0.w), cvt_pk_bf16(o1.x, o1.y), cvt_pk_bf16(o1.z, o1.w)};
                }
            }
        }
            return -1;
    }
};

constexpr int MI_TPRE = 16, MI_CNT = 64, MI_MT2E = 128;
__device__ __forceinline__ void expert_tables(Frame& F, int layer) {
    if (F.tid < 64) {
        const int lane = F.lane;
        int c = 0;
        if (lane < NE) { c = (int)__hip_atomic_load(F.ctl + CW_CNT + 64 * layer + lane, __ATOMIC_RELAXED, __HIP_MEMORY_SCOPE_AGENT); if (c > LIST_CAP) c = LIST_CAP; }
        const int nt_ = (c + 255) >> 8;
        int pre = nt_;
#pragma unroll
        for (int off = 1; off < 32; off <<= 1) { const int v = __shfl_up(pre, off); if (lane >= off) pre += v; }
        const int excl = pre - nt_;
        if (lane < NE) { F.MISC[MI_TPRE + lane] = excl; F.MISC[MI_CNT + lane] = c; for (int q = 0; q < nt_; ++q) F.MISC[MI_MT2E + excl + q] = lane; }
        if (lane == NE - 1) F.MISC[MI_TPRE + NE] = pre;
    }
    __syncthreads();
}
constexpr int UPA_OFF = 131072;
struct PolG1 : GemmBase {
    static constexpr int KREP = KREP_G1;
    volatile LAS unsigned* MISC; LAS unsigned char* upa; const bf16_t* hn; const bf16_t* wgut; const float* bgu; const int* lslot; bf16_t* act;
    __device__ __forceinline__ int nt() const { return D / 64; }
    __device__ __forceinline__ unsigned ldb_bytes() const { return D * 2; }
    __device__ __forceinline__ bool next(int i, Unit& u) const {
        const int V = i * G + vcu, MT = (int)MISC[MI_TPRE + NE]; if (V >= MT * 8 || i >= 10) return false;
        const int mt = V >> 3, nt_ = V & 7, e = (int)MISC[MI_MT2E + mt];
        u.p0 = e; u.p1 = mt - (int)MISC[MI_TPRE + e]; u.p2 = nt_; u.p3 = mt; u.ui = i;
        u.A = (const char*)hn; u.B = (const char*)(wgut + ((size_t)e * 2048 + (size_t)nt_ * 256) * D); return true; }
    __device__ __forceinline__ void fill(int tid) const {
#pragma unroll
        for (int k = 0; k < 5; ++k) {
            const int j = tid + NTH * k, i = j >> 8, r = j & 255; Unit u;
            if (next(i, u)) {
                const int cnt = (int)MISC[MI_CNT + u.p0], li = u.p1 * 256 + r;
                ((LAS int*)(upa + i * 2048))[r] = (li < cnt) ? (lslot[(size_t)u.p0 * LIST_CAP + li] >> 2) : 0;
                ((LAS float*)(upa + i * 2048 + 1024))[r] = bgu[(size_t)u.p0 * 2048 + (r >> 7) * 1024 + u.p2 * 128 + (r & 127)];
            }
        }
    }
    __device__ __forceinline__ void aoff(const Unit& u, int R0, int C0, unsigned (&off)[4]) const {
        const LAS int* tk = (const LAS int*)(upa + u.ui * 2048);
#pragma unroll
        for (int q = 0; q < 4; ++q) off[q] = (unsigned)tk[R0 + 64 * (q & 1) + 128 * (q >> 1)] * (D * 2u) + (unsigned)C0 * 2u;
    }
    __device__ __forceinline__ int epi(const AccT& acc, const Unit& u, int wr, int wc, int fr, int fq) const {
        const int cl = wc * 32 + 8 * fq;
        const LAS float* bg = (const LAS float*)(upa + u.ui * 2048 + 1024);
        const f32x4 bgl0 = *(const LAS f32x4*)(bg + cl), bgl1 = *(const LAS f32x4*)(bg + cl + 4), bln0 = *(const LAS f32x4*)(bg + 128 + cl), bln1 = *(const LAS f32x4*)(bg + 128 + cl + 4);
        bf16_t* base = act + ((size_t)u.p3 * 256 + wr * 64 + fr) * D + u.p2 * 128 + cl;
#pragma unroll
        for (int ai = 0; ai < 2; ++ai)
#pragma unroll
            for (int m = 0; m < 4; ++m) {
                f32x4 gl0 = acc[ai][0][m][0] + bgl0, gl1 = acc[ai][0][m][1] + bgl1, ln0 = acc[ai][1][m][0] + bln0, ln1 = acc[ai][1][m][1] + bln1;
                f32x4 a0, a1;
#pragma unroll
                for (int j = 0; j < 4; ++j) {
                    const float x0 = fminf(gl0[j], SW_LIMIT), x1 = fminf(gl1[j], SW_LIMIT);
                    const float y0 = fminf(fmaxf(ln0[j], -SW_LIMIT), SW_LIMIT), y1 = fminf(fmaxf(ln1[j], -SW_LIMIT), SW_LIMIT);
                    a0[j] = x0 * sigmoidf_(SW_ALPHA * x0) * (y0 + 1.0f); a1[j] = x1 * sigmoidf_(SW_ALPHA * x1) * (y1 + 1.0f); }
                u32x4 w; w.x = cvt_pk_bf16(a0[0], a0[1]); w.y = cvt_pk_bf16(a0[2], a0[3]); w.z = cvt_pk_bf16(a1[0], a1[1]); w.w = cvt_pk_bf16(a1[2], a1[3]);
                *(u32x4*)(base + (size_t)(ai * 128 + m * 16) * D) = w;
            }
            return -1;
    }
};
struct PolG2 : GemmBase {
    static constexpr int KREP = KREP_G2;
    volatile LAS unsigned* MISC; LAS unsigned char* upa; const bf16_t* act; const bf16_t* wdnt; const float* bdn; const int* lslot; const float* lw; bf16_t* yslot;
    __device__ __forceinline__ int nt() const { return D / 64; }
    __device__ __forceinline__ unsigned ldb_bytes() const { return D * 2; }
    __device__ __forceinline__ bool next(int i, Unit& u) const {
        const int V = i * G + vcu, MT = (int)MISC[MI_TPRE + NE]; if (V >= MT * 4 || i >= 6) return false;
        const int mt = V >> 2, nt_ = V & 3, e = (int)MISC[MI_MT2E + mt];
        u.p0 = e; u.p1 = mt - (int)MISC[MI_TPRE + e]; u.p2 = nt_; u.p3 = mt; u.ui = i;
        u.A = (const char*)(act + (size_t)mt * 256 * D); u.B = (const char*)(wdnt + ((size_t)e * D + (size_t)nt_ * 256) * D); return true; }
    __device__ __forceinline__ void fill(int tid) const {
#pragma unroll
        for (int k = 0; k < 3; ++k) {
            const int j = tid + NTH * k, i = j >> 8, r = j & 255; Unit u;
            if (next(i, u)) {
                const int cnt = (int)MISC[MI_CNT + u.p0], li = u.p1 * 256 + r; const bool ok = li < cnt;
                ((LAS int*)(upa + i * 3072))[r] = ok ? lslot[(size_t)u.p0 * LIST_CAP + li] : -1;
                ((LAS float*)(upa + i * 3072 + 1024))[r] = ok ? lw[(size_t)u.p0 * LIST_CAP + li] : 0.f;
                ((LAS float*)(upa + i * 3072 + 2048))[r] = bdn[(size_t)u.p0 * D + u.p2 * 256 + r];
            }
        }
    }
    __device__ __forceinline__ void aoff(const Unit&, int R0, int C0, unsigned (&off)[4]) const { aoff_lin(R0, C0, D * 2, off); }
    __device__ __forceinline__ int epi(const AccT& acc, const Unit& u, int wr, int wc, int fr, int fq) const {
        const int cl = wc * 32 + 8 * fq;
        const LAS int* sl = (const LAS int*)(upa + u.ui * 3072); const LAS float* wl = (const LAS float*)(upa + u.ui * 3072 + 1024); const LAS float* bd = (const LAS float*)(upa + u.ui * 3072 + 2048);
        f32x4 b[2][2];
#pragma unroll
        for (int bj = 0; bj < 2; ++bj) { b[bj][0] = *(const LAS f32x4*)(bd + cl + bj * 128); b[bj][1] = *(const LAS f32x4*)(bd + cl + bj * 128 + 4); }
#pragma unroll
        for (int ai = 0; ai < 2; ++ai)
#pragma unroll
            for (int m = 0; m < 4; ++m) {
                const int rl = ai * 128 + wr * 64 + m * 16 + fr;
                const int slot = sl[rl]; const float w = wl[rl];
                if (slot >= 0) {
                    bf16_t* yr = yslot + (size_t)slot * D + u.p2 * 256 + cl;
#pragma unroll
                    for (int bj = 0; bj < 2; ++bj) {
                        const f32x4 v0 = (acc[ai][bj][m][0] + b[bj][0]) * w, v1 = (acc[ai][bj][m][1] + b[bj][1]) * w;
                        u32x4 o; o.x = cvt_pk_bf16(v0[0], v0[1]); o.y = cvt_pk_bf16(v0[2], v0[3]); o.z = cvt_pk_bf16(v1[0], v1[1]); o.w = cvt_pk_bf16(v1[2], v1[3]);
                        *(u32x4*)(yr + bj * 128) = o;
                    }
                }
            }
            return -1;
    }
};

typedef unsigned v4u_t __attribute__((ext_vector_type(4)));
template <bool F8>
struct PolMoE : GemmBase {
    static constexpr int KREP = 1;
    static constexpr bool HAS_READY = true;
    static constexpr bool FP8 = F8;
    static constexpr bool SEAM_OPT = true;
    static constexpr int EB = F8 ? 1 : 2;
    volatile LAS unsigned* MISC; LAS unsigned char* upa; const bf16_t* hn; const bf16_t* wgut; const float* bgu; const int* lslot; const float* lw; bf16_t* act;
    const bf16_t* wdnt; const float* bdn; bf16_t* yslot; unsigned* done; unsigned* tmo; __amdgpu_buffer_rsrc_t act_rsrc;
    __device__ __forceinline__ int nt() const { return D * EB / 128; }
    __device__ __forceinline__ unsigned ldb_bytes() const { return D * EB; }
    __device__ __forceinline__ bool next(int i, Unit& u) const {
        const int V = i * G + vcu, MT = (int)MISC[MI_TPRE + NE], N1 = MT * 8; if (i >= 14 || V >= MT * 12) return false;
        u.ui = i;
        if (V < N1) { const int mt = V >> 3, nt_ = V & 7, e = (int)MISC[MI_MT2E + mt];
            u.p0 = e; u.p1 = mt - (int)MISC[MI_TPRE + e]; u.p2 = nt_; u.p3 = mt;
            u.A = (const char*)hn; u.B = (const char*)wgut + ((size_t)e * 2048 + (size_t)nt_ * 256) * D * EB; }
        else { const int V2 = V - N1, mt = V2 >> 2, nt_ = V2 & 3, e = (int)MISC[MI_MT2E + mt];
            u.p0 = e; u.p1 = mt - (int)MISC[MI_TPRE + e]; u.p2 = nt_ | 8; u.p3 = mt;
            u.A = (const char*)act + (size_t)mt * 256 * D * EB; u.B = (const char*)wdnt + ((size_t)e * D + (size_t)nt_ * 256) * D * EB; }
        return true; }
    __device__ __forceinline__ void fill(int tid) const {
#pragma unroll
        for (int k = 0; k < 7; ++k) {
            const int j = tid + NTH * k, i = j >> 8, r = j & 255; Unit u;
            if (next(i, u)) {
                const int cnt = (int)MISC[MI_CNT + u.p0], li = u.p1 * 256 + r; const bool ok = li < cnt;
                if (!(u.p2 & 8)) {
                    ((LAS int*)(upa + i * 2048))[r] = ok ? (lslot[(size_t)u.p0 * LIST_CAP + li] >> 2) : 0;
                    ((LAS float*)(upa + i * 2048 + 1024))[r] = bgu[(size_t)u.p0 * 2048 + (r >> 7) * 1024 + u.p2 * 128 + (r & 127)] + (float)(r >> 7);
                } else {
                    unsigned pk = 0xffff0000u;
                    if (ok) { const unsigned sl = (unsigned)lslot[(size_t)u.p0 * LIST_CAP + li]; const float w = lw[(size_t)u.p0 * LIST_CAP + li]; pk = (sl & 0xffffu) | (cvt_pk_bf16(0.f, w) & 0xffff0000u); }
                    ((LAS unsigned*)(upa + i * 2048))[r] = pk;
                    ((LAS float*)(upa + i * 2048 + 1024))[r] = bdn[(size_t)u.p0 * D + (u.p2 & 7) * 256 + r];
                }
            }
        }
    }
    __device__ __forceinline__ void aoff(const Unit& u, int R0, int C0, unsigned (&off)[4]) const {
        if (!(u.p2 & 8)) { const LAS int* tk = (const LAS int*)(upa + u.ui * 2048);
#pragma unroll
            for (int q = 0; q < 4; ++q) off[q] = (unsigned)tk[R0 + 64 * (q & 1) + 128 * (q >> 1)] * (unsigned)(D * EB) + (unsigned)C0 * 2u;
        } else aoff_lin(R0, C0, D * EB, off);
    }
    __device__ __forceinline__ void flush(int pend) const {
        if (pend >= 0 && (threadIdx.x & 63) == 0) (void)__hip_atomic_fetch_add(done + 64 * pend, 1u, __ATOMIC_RELAXED, __HIP_MEMORY_SCOPE_AGENT);
    }
    __device__ __forceinline__ void a_ready(const Unit& u) const {
        if (!(u.p2 & 8)) return;
        if (threadIdx.x < 64) {
            unsigned* w = done + 64 * u.p3; unsigned polls = 0;
            while ((unsigned)__builtin_amdgcn_readfirstlane(__hip_atomic_load(w, __ATOMIC_RELAXED, __HIP_MEMORY_SCOPE_AGENT)) < 64u) {
                __builtin_amdgcn_s_sleep(2);
                if ((++polls & 1023u) == 0u) { if (__builtin_amdgcn_readfirstlane(__hip_atomic_load(tmo, __ATOMIC_RELAXED, __HIP_MEMORY_SCOPE_AGENT)) != 0u) break;
                    if (polls > (1u << 22)) { if (threadIdx.x == 0) __hip_atomic_store(tmo, 1u, __ATOMIC_RELAXED, __HIP_MEMORY_SCOPE_AGENT); break; } }
            }
            __builtin_amdgcn_fence(__ATOMIC_ACQUIRE, "agent");
            asm volatile("s_waitcnt vmcnt(0)" ::: "memory");
        }
        asm volatile("" ::: "memory"); __builtin_amdgcn_s_barrier(); asm volatile("" ::: "memory");
    }
    __device__ __forceinline__ int epi(const AccT& acc, const Unit& u, int wr, int wc, int fr, int fq) const {
        const int cl = wc * 32 + 8 * fq;
        if (!(u.p2 & 8)) {
            const LAS float* bg = (const LAS float*)(upa + u.ui * 2048 + 1024);
            const f32x4 bgl0 = *(const LAS f32x4*)(bg + cl), bgl1 = *(const LAS f32x4*)(bg + cl + 4), bln0 = *(const LAS f32x4*)(bg + 128 + cl), bln1 = *(const LAS f32x4*)(bg + 128 + cl + 4);
            const unsigned boff = (unsigned)((((size_t)u.p3 * 256 + wr * 64 + fr) * D + u.p2 * 128 + cl) * EB);
            constexpr float ws = F8 ? (1.0f / W8_SCALE) : 1.0f;
#pragma unroll
            for (int ai = 0; ai < 2; ++ai)
#pragma unroll
                for (int m = 0; m < 4; ++m) {
                    const f32x2 p0 = swiglu2(acc[ai][0][m][0].xy, acc[ai][1][m][0].xy, bgl0.xy, bln0.xy, ws), p1 = swiglu2(acc[ai][0][m][0].zw, acc[ai][1][m][0].zw, bgl0.zw, bln0.zw, ws);
                    const f32x2 p2 = swiglu2(acc[ai][0][m][1].xy, acc[ai][1][m][1].xy, bgl1.xy, bln1.xy, ws), p3 = swiglu2(acc[ai][0][m][1].zw, acc[ai][1][m][1].zw, bgl1.zw, bln1.zw, ws);
                    const f32x4 a0 = {p0.x, p0.y, p1.x, p1.y}, a1 = {p2.x, p2.y, p3.x, p3.y};
                    if constexpr (F8) { u32x2 w8 = {pack_fp8x4(a0[0], a0[1], a0[2], a0[3]), pack_fp8x4(a1[0], a1[1], a1[2], a1[3])};
                        __builtin_amdgcn_raw_buffer_store_b64(w8, act_rsrc, boff + (unsigned)((ai * 128 + m * 16) * D), 0,   16); }
                    else { v4u_t w; w.x = cvt_pk_bf16(a0[0], a0[1]); w.y = cvt_pk_bf16(a0[2], a0[3]); w.z = cvt_pk_bf16(a1[0], a1[1]); w.w = cvt_pk_bf16(a1[2], a1[3]);
                        __builtin_amdgcn_raw_buffer_store_b128(w, act_rsrc, boff + (unsigned)((ai * 128 + m * 16) * D * 2), 0,   16); }
                }
            return u.p3;
        } else {
            const LAS unsigned* sl = (const LAS unsigned*)(upa + u.ui * 2048); const LAS float* bd = (const LAS float*)(upa + u.ui * 2048 + 1024);
            f32x4 b[2][2];
#pragma unroll
            for (int bj = 0; bj < 2; ++bj) { b[bj][0] = *(const LAS f32x4*)(bd + cl + bj * 128); b[bj][1] = *(const LAS f32x4*)(bd + cl + bj * 128 + 4); }
#pragma unroll
            for (int ai = 0; ai < 2; ++ai)
#pragma unroll
                for (int m = 0; m < 4; ++m) {
                    const unsigned pk = sl[ai * 128 + wr * 64 + m * 16 + fr];
                    if ((pk >> 16) != 0xffffu) {
                        const float w = bfhi(pk); constexpr float ws = F8 ? (1.0f / W8_SCALE) : 1.0f;
                        bf16_t* yr = yslot + (size_t)(pk & 0xffffu) * D + (u.p2 & 7) * 256 + cl;
#pragma unroll
                        for (int bj = 0; bj < 2; ++bj) {
                            const f32x4 v0 = (acc[ai][bj][m][0] * ws + b[bj][0]) * w, v1 = (acc[ai][bj][m][1] * ws + b[bj][1]) * w;
                            u32x4 o; o.x = cvt_pk_bf16(v0[0], v0[1]); o.y = cvt_pk_bf16(v0[2], v0[3]); o.z = cvt_pk_bf16(v1[0], v1[1]); o.w = cvt_pk_bf16(v1[2], v1[3]);
                            *(u32x4*)(yr + bj * 128) = o;
                        }
                    }
                }
        }
            return -1;
    }
};

template <class P> __device__ __forceinline__ void run_gemm(Frame& F, const P& S) {
#if SIMPLE_GEMM
    pg8::gemm_simple<P>(F.lds, S);
#else
    pg8::gemm_pipe<P>(F.lds, S);
#endif
}

constexpr int LA_QA = 0, LA_QH = 17408, LA_KA = 34816, LA_VT = 52224, LA_AS = 70656, LA_ST = 79872, LA_QS = 114688, LA_PS = 118784;
constexpr int RS128 = 272, RS64 = 144;
__device__ __forceinline__ float ret_lg(int hh) { return __logf(1.0f - exp2f(-5.0f - (float)(hh - 4))); }
__device__ __forceinline__ u32x4 pack8(const float (&v)[8]) { return (u32x4){cvt_pk_bf16(v[0], v[1]), cvt_pk_bf16(v[2], v[3]), cvt_pk_bf16(v[4], v[5]), cvt_pk_bf16(v[6], v[7])}; }

__device__ __forceinline__ void la_cumsum(const float* gbuf, int hh, int t0, int d0, float (&b0)[8], float (&b1)[8]) {
    if (hh < 4) { float r0 = 0.f, r1 = 0.f;
#pragma unroll
        for (int i = 0; i < 8; ++i) { const f32x2 g = *(const f32x2*)(gbuf + (size_t)(t0 + i) * 512 + hh * 128 + d0); r0 += g.x; r1 += g.y; b0[i] = r0; b1[i] = r1; }
    } else { const float lg = ret_lg(hh);
#pragma unroll
        for (int i = 0; i < 8; ++i) { b0[i] = (float)(i + 1) * lg; b1[i] = b0[i]; }
    }
}

struct LaIn { f32x2 g[8]; unsigned qq[8], kk[8], vv[8]; u32x4 st[4]; u32x2 gt[4]; };
template <bool OUT>
__device__ __forceinline__ void la_load(LaIn& in, const bf16_t* qkvg, const _Float16* gbuf, const bf16_t* sprev, int unit, int oc, int d0, int tid) {
    const int hh = unit >> 8, n = unit & 255, t0 = n * 64 + oc * 8;
    if (hh < 4) {
#pragma unroll
        for (int i = 0; i < 8; ++i) { const h16x2 gh = *(const h16x2*)(gbuf + (size_t)(t0 + i) * 512 + hh * 128 + d0); in.g[i] = (f32x2){(float)gh.x, (float)gh.y}; }
    }
#pragma unroll
    for (int i = 0; i < 8; ++i) { const bf16_t* row = qkvg + (size_t)(t0 + i) * INW + hh * 128 + d0; if (OUT) in.qq[i] = *(const unsigned*)row; in.kk[i] = *(const unsigned*)(row + 1024); in.vv[i] = *(const unsigned*)(row + 2048); }
    if (OUT) {
        const bf16_t* sp = sprev + ((size_t)hh * 256 + n) * 16384;
#pragma unroll
        for (int j = 0; j < 4; ++j) { const int c = tid + NTH * j; in.st[j] = *(const u32x4*)(sp + (c >> 4) * 128 + (c & 15) * 8); }
        const int lane = tid & 63, fr = lane & 15, fq = lane >> 4, tt = oc >> 1, eh = oc & 1;
#pragma unroll
        for (int ei = 0; ei < 4; ++ei) in.gt[ei] = *(const u32x2*)(qkvg + (size_t)(n * 64 + 16 * tt + fr) * INW + 3072 + hh * 128 + 16 * (4 * eh + ei) + 4 * fq);
    }
}
__device__ __forceinline__ void la_cumsum_in(const LaIn& in, int hh, float (&b0)[8], float (&b1)[8]) {
    if (hh < 4) { float r0 = 0.f, r1 = 0.f;
#pragma unroll
        for (int i = 0; i < 8; ++i) { r0 += in.g[i].x; r1 += in.g[i].y; b0[i] = r0; b1[i] = r1; }
    } else { const float lg = ret_lg(hh);
#pragma unroll
        for (int i = 0; i < 8; ++i) { b0[i] = (float)(i + 1) * lg; b1[i] = b0[i]; }
    }
}

__device__ __forceinline__ void la_local_state(Frame& F) {
    const bf16_t* qkvg = WSP(F, WS_QKVG, bf16_t); const _Float16* gbuf = WSP(F, WS_GBUF, _Float16); bf16_t* kvt = WSP(F, WS_KVT, bf16_t); float* dec = WSP(F, WS_DEC, float);
    LAS unsigned char* lds = F.lds; LAS float* qs = (LAS float*)(lds + LA_QS);
    const int lane = F.lane, oc = F.wave, d0 = 2 * lane, fr = lane & 15, fq = lane >> 4;
    LaIn nx;
    if (F.vcu < 2048) la_load<false>(nx, qkvg, gbuf, nullptr, F.vcu, oc, d0, F.tid);
    for (int unit = F.vcu; unit < 2048; unit += F.G) {
        const int hh = unit >> 8, n = unit & 255;
        const LaIn in = nx;
        if (unit + F.G < 2048) la_load<false>(nx, qkvg, gbuf, nullptr, unit + F.G, oc, d0, F.tid);
        float b0[8], b1[8]; la_cumsum_in(in, hh, b0, b1);
        *(LAS f32x2*)(qs + oc * 128 + d0) = (f32x2){b0[7], b1[7]};
        const unsigned (&kk)[8] = in.kk; const unsigned (&vv)[8] = in.vv;
        __syncthreads();
        float base0 = 0.f, base1 = 0.f, tot0 = 0.f, tot1 = 0.f;
#pragma unroll
        for (int o = 0; o < 8; ++o) { const f32x2 q = *(const LAS f32x2*)(qs + o * 128 + d0); if (o < oc) { base0 += q.x; base1 += q.y; } tot0 += q.x; tot1 += q.y; }
        float a0[8], a1[8], c0[8], c1[8];
#pragma unroll
        for (int i = 0; i < 8; ++i) { a0[i] = bflo(kk[i]) * __expf(tot0 - base0 - b0[i]); a1[i] = bfhi(kk[i]) * __expf(tot1 - base1 - b1[i]); c0[i] = bflo(vv[i]); c1[i] = bfhi(vv[i]); }
        *(LAS u32x4*)(lds + LA_QA + d0 * RS64 + oc * 16) = pack8(a0); *(LAS u32x4*)(lds + LA_QA + (d0 + 1) * RS64 + oc * 16) = pack8(a1);
        *(LAS u32x4*)(lds + LA_VT + d0 * RS64 + oc * 16) = pack8(c0); *(LAS u32x4*)(lds + LA_VT + (d0 + 1) * RS64 + oc * 16) = pack8(c1);
        if (oc == 0) *(f32x2*)(dec + ((size_t)hh * 256 + n) * 128 + d0) = (f32x2){__expf(tot0), __expf(tot1)};
        __syncthreads();
        const int et = oc;
        bf16x8 vt[2];
#pragma unroll
        for (int ks = 0; ks < 2; ++ks) vt[ks] = *(const LAS bf16x8*)(lds + LA_VT + (16 * et + fr) * RS64 + (32 * ks + 8 * fq) * 2);
        bf16_t* orow = kvt + (((size_t)hh * 256 + n) * 128 + 16 * et + fr) * 128 + 4 * fq;
#pragma unroll
        for (int dt = 0; dt < 8; ++dt) {
            f32x4 acc = {0.f, 0.f, 0.f, 0.f};
#pragma unroll
            for (int ks = 0; ks < 2; ++ks) { const bf16x8 a = *(const LAS bf16x8*)(lds + LA_QA + (16 * dt + fr) * RS64 + (32 * ks + 8 * fq) * 2); acc = __builtin_amdgcn_mfma_f32_16x16x32_bf16(a, vt[ks], acc, 0, 0, 0); }
            *(u32x2*)(orow + 16 * dt) = (u32x2){cvt_pk_bf16(acc[0], acc[1]), cvt_pk_bf16(acc[2], acc[3])};
        }
        __syncthreads();
    }
}

__device__ __forceinline__ void la_scan(Frame& F) {
    const bf16_t* kvt = WSP(F, WS_KVT, bf16_t); const float* dec = WSP(F, WS_DEC, float); bf16_t* sprev = WSP(F, WS_SPREV, bf16_t);
    for (int idx = F.vcu * NTH + F.tid; idx < 8 * 16384; idx += F.G * NTH) {
        const int hh = idx >> 14, rem = idx & 16383, d = rem & 127;
        const bf16_t* kv = kvt + (size_t)hh * 256 * 16384 + rem; const float* dc = dec + (size_t)hh * 256 * 128 + d; bf16_t* sp = sprev + (size_t)hh * 256 * 16384 + rem;
        float S = 0.f;
        for (int n0 = 0; n0 < 256; n0 += 16) {
            float kvv[16], dd[16];
#pragma unroll
            for (int i = 0; i < 16; ++i) { kvv[i] = bf2f(kv[(size_t)(n0 + i) * 16384]); dd[i] = dc[(n0 + i) * 128]; }
#pragma unroll
            for (int i = 0; i < 16; ++i) { sp[(size_t)(n0 + i) * 16384] = (bf16_t)(cvt_pk_bf16(S, 0.f) & 0xffffu); S = dd[i] * S + kvv[i]; }
        }
    }
}

__device__ __forceinline__ void la_output(Frame& F) {
    const bf16_t* qkvg = WSP(F, WS_QKVG, bf16_t); const _Float16* gbuf = WSP(F, WS_GBUF, _Float16); const bf16_t* sprev = WSP(F, WS_SPREV, bf16_t); bf16_t* cat = WSP(F, WS_CAT, bf16_t);
    LAS unsigned char* lds = F.lds; LAS float* qs = (LAS float*)(lds + LA_QS); LAS float* ps = (LAS float*)(lds + LA_PS);
    const int tid = F.tid, lane = F.lane, oc = F.wave, d0 = 2 * lane, fr = lane & 15, fq = lane >> 4;
    LaIn nx;
    if (F.vcu < 2048) la_load<true>(nx, qkvg, gbuf, sprev, F.vcu, oc, d0, tid);
    for (int unit = F.vcu; unit < 2048; unit += F.G) {
        const int hh = unit >> 8, n = unit & 255;
        const LaIn in = nx;
        if (unit + F.G < 2048) la_load<true>(nx, qkvg, gbuf, sprev, unit + F.G, oc, d0, tid);
        float b0[8], b1[8]; la_cumsum_in(in, hh, b0, b1);
        *(LAS f32x2*)(qs + oc * 128 + d0) = (f32x2){b0[7], b1[7]};
        const unsigned (&qq)[8] = in.qq; const unsigned (&kk)[8] = in.kk; const unsigned (&vv)[8] = in.vv;
#pragma unroll
        for (int j = 0; j < 4; ++j) { const int c = tid + NTH * j; *(LAS u32x4*)(lds + LA_ST + (c >> 4) * RS128 + (c & 15) * 16) = in.st[j]; }
        __syncthreads();
        float base0 = 0.f, base1 = 0.f, bm0 = 0.f, bm1 = 0.f;
#pragma unroll
        for (int o = 0; o < 8; ++o) { const f32x2 q = *(const LAS f32x2*)(qs + o * 128 + d0); if (o < oc) { base0 += q.x; base1 += q.y; } if (o < 4) { bm0 += q.x; bm1 += q.y; } }
        float c0[8], c1[8];
#pragma unroll
        for (int i = 0; i < 8; ++i) {
            const int t = 8 * oc + i; const float bt0 = base0 + b0[i], bt1 = base1 + b1[i];
            const float q0 = bflo(qq[i]), q1 = bfhi(qq[i]), k0 = bflo(kk[i]), k1 = bfhi(kk[i]);
            *(LAS unsigned*)(lds + LA_QA + t * RS128 + d0 * 2) = cvt_pk_bf16(q0 * __expf(bt0 - bm0), q1 * __expf(bt1 - bm1));
            *(LAS unsigned*)(lds + LA_QH + t * RS128 + d0 * 2) = cvt_pk_bf16(q0 * __expf(bt0), q1 * __expf(bt1));
            *(LAS unsigned*)(lds + LA_KA + t * RS128 + d0 * 2) = cvt_pk_bf16(k0 * __expf(bm0 - bt0), k1 * __expf(bm1 - bt1));
            c0[i] = bflo(vv[i]); c1[i] = bfhi(vv[i]);
        }
        *(LAS u32x4*)(lds + LA_VT + d0 * RS64 + oc * 16) = pack8(c0); *(LAS u32x4*)(lds + LA_VT + (d0 + 1) * RS64 + oc * 16) = pack8(c1);
        __syncthreads();
        const int tt = oc >> 1, eh = oc & 1;
        {
            bf16x8 qf[4];
#pragma unroll
            for (int ks = 0; ks < 4; ++ks) qf[ks] = *(const LAS bf16x8*)(lds + LA_QA + (16 * tt + fr) * RS128 + (32 * ks + 8 * fq) * 2);
#pragma unroll
            for (int sti = 0; sti < 2; ++sti) {
                const int st = 2 * eh + sti;
                f32x4 acc = {0.f, 0.f, 0.f, 0.f};
                if (st <= tt) {
#pragma unroll
                    for (int ks = 0; ks < 4; ++ks) { const bf16x8 a = *(const LAS bf16x8*)(lds + LA_KA + (16 * st + fr) * RS128 + (32 * ks + 8 * fq) * 2); acc = __builtin_amdgcn_mfma_f32_16x16x32_bf16(a, qf[ks], acc, 0, 0, 0); }
                    if (st == tt) {
#pragma unroll
                        for (int r = 0; r < 4; ++r) if (4 * fq + r > fr) acc[r] = 0.f;
                    }
                }
                *(LAS u32x2*)(lds + LA_AS + (16 * tt + fr) * RS64 + (16 * st + 4 * fq) * 2) = (u32x2){cvt_pk_bf16(acc[0], acc[1]), cvt_pk_bf16(acc[2], acc[3])};
            }
        }
        __syncthreads();
        f32x4 o[4]; float ss = 0.f;
        {
            bf16x8 af[2], hf[4];
#pragma unroll
            for (int ks = 0; ks < 2; ++ks) af[ks] = *(const LAS bf16x8*)(lds + LA_AS + (16 * tt + fr) * RS64 + (32 * ks + 8 * fq) * 2);
#pragma unroll
            for (int ks = 0; ks < 4; ++ks) hf[ks] = *(const LAS bf16x8*)(lds + LA_QH + (16 * tt + fr) * RS128 + (32 * ks + 8 * fq) * 2);
#pragma unroll
            for (int ei = 0; ei < 4; ++ei) {
                const int et = 4 * eh + ei;
                f32x4 acc = {0.f, 0.f, 0.f, 0.f};
#pragma unroll
                for (int ks = 0; ks < 2; ++ks) { const bf16x8 a = *(const LAS bf16x8*)(lds + LA_VT + (16 * et + fr) * RS64 + (32 * ks + 8 * fq) * 2); acc = __builtin_amdgcn_mfma_f32_16x16x32_bf16(a, af[ks], acc, 0, 0, 0); }
#pragma unroll
                for (int ks = 0; ks < 4; ++ks) { const bf16x8 a = *(const LAS bf16x8*)(lds + LA_ST + (16 * et + fr) * RS128 + (32 * ks + 8 * fq) * 2); acc = __builtin_amdgcn_mfma_f32_16x16x32_bf16(a, hf[ks], acc, 0, 0, 0); }
                o[ei] = acc; ss += (acc[0] * acc[0] + acc[1] * acc[1]) + (acc[2] * acc[2] + acc[3] * acc[3]);
            }
        }
        ss += __shfl_xor(ss, 16); ss += __shfl_xor(ss, 32);
        if (lane < 16) ps[(tt * 2 + eh) * 16 + lane] = ss;
        __syncthreads();
        const float tot = ps[(tt * 2) * 16 + fr] + ps[(tt * 2 + 1) * 16 + fr];
        const float rstd = rsqrtf(tot * (1.f / 128.f) + EPS);
        const float* gain = (hh < 4) ? (inptr(6) + hh * 128) : (inptr(7) + (hh - 4) * 128);
        const size_t rowi = (size_t)(n * 64 + 16 * tt + fr);
#pragma unroll
        for (int ei = 0; ei < 4; ++ei) {
            const int e0 = 16 * (4 * eh + ei) + 4 * fq;
            const f32x4 gn = *(const f32x4*)(gain + e0);
            const u32x2 gt = in.gt[ei];
            const f32x4 v = o[ei] * rstd * gn;
            *(u32x2*)(cat + rowi * D + hh * 128 + e0) = (u32x2){cvt_pk_bf16(v[0] * bflo(gt.x), v[1] * bfhi(gt.x)), cvt_pk_bf16(v[2] * bflo(gt.y), v[3] * bfhi(gt.y))};
        }
        __syncthreads();
    }
}

constexpr int RT_STRIDE = 2064, RT_PART = 32 * RT_STRIDE;
__device__ __forceinline__ void sel4of8(float (&v)[8], const int (&ix)[8], float (&tv)[4], int (&ti)[4]) {
#pragma unroll
    for (int k = 0; k < 4; ++k) {
        float best = v[0]; int bi = ix[0];
#pragma unroll
        for (int q = 1; q < 8; ++q) { const bool better = (v[q] > best) || (v[q] == best && ix[q] < bi); best = better ? v[q] : best; bi = better ? ix[q] : bi; }
        tv[k] = best; ti[k] = bi;
#pragma unroll
        for (int q = 0; q < 8; ++q) v[q] = (ix[q] == bi) ? -INFINITY : v[q];
    }
}
__device__ __forceinline__ void p_route(Frame& F, int layer, const bf16_t* X, int aux = 0) {
    const int tid = F.tid, lane = F.lane;
    LAS unsigned char* lds = F.lds;
    LAS float* ssq = (LAS float*)(lds + 2 * RT_PART);
    LAS f32x4* lgx = (LAS f32x4*)(lds + 2 * RT_PART + 512);
    LAS int* pe = (LAS int*)(lds + 2 * RT_PART + 512 + 8192);
    LAS float* pw = (LAS float*)(pe + 256);
    LAS int* hist = (LAS int*)(pw + 256);
    LAS int* gbase = hist + 32;
    {
        const bf16_t* rt = WSP(F, WS_RT, bf16_t) + (size_t)layer * 2 * 32 * D;
#pragma unroll 4
        for (int j = 0; j < 16; ++j) { const int ch = tid + NTH * j, part = ch >> 12, row = (ch >> 7) & 31, c16 = ch & 127;
            *(LAS u32x4*)(lds + part * RT_PART + row * RT_STRIDE + c16 * 16) = *(const u32x4*)(rt + ((size_t)(part * 32 + row) * D + c16 * 8)); }
    }
    const float* mod = WSP(F, WS_MOD, float) + (size_t)layer * 6 * D;
    int* lslot = WSP(F, WS_LSLOT, int) + (size_t)layer * NE * LIST_CAP; float* lw = WSP(F, WS_LW, float) + (size_t)layer * NE * LIST_CAP;
    if (aux) { lslot = (int*)(F.ws + WS_END); lw = (float*)(F.ws + WS_END + 4 * MiB); }
    unsigned* cntw = F.ctl + CW_CNT + 64 * (layer + 2 * aux);
    const int tile = F.wave & 3, kh = F.wave >> 2, tk = lane & 15, kq = lane >> 4;
    const float* brt = inptr(13) + layer * NE;
    __syncthreads();
    for (int tb = F.vcu; tb < T / 64; tb += F.G) {
        if (tid < 32) hist[tid] = 0;
        const int row = tb * 64 + tile * 16 + tk;
        const bf16_t* xr = X + (size_t)row * D + kh * 512 + 8 * kq;
        float ss = 0.f;
#pragma unroll 8
        for (int s = 0; s < 16; ++s) { const u32x4 q = *(const u32x4*)(xr + 32 * s);
            const f32x4 a = {bflo(q.x), bfhi(q.x), bflo(q.y), bfhi(q.y)}, b = {bflo(q.z), bfhi(q.z), bflo(q.w), bfhi(q.w)};
            ss += (a.x * a.x + a.y * a.y) + (a.z * a.z + a.w * a.w) + (b.x * b.x + b.y * b.y) + (b.z * b.z + b.w * b.w); }
        ss += __shfl_xor(ss, 16); ss += __shfl_xor(ss, 32);
        if (kq == 0) ssq[F.wave * 16 + tk] = ss;
        __syncthreads();
        const float rstd = rsqrtf((ssq[tile * 16 + tk] + ssq[(tile + 4) * 16 + tk]) * (1.f / D) + EPS);
        f32x4 acc[2] = {{0.f, 0.f, 0.f, 0.f}, {0.f, 0.f, 0.f, 0.f}};
        bf16_t* hrow = WSP(F, WS_HN, bf16_t) + (size_t)row * D;
#pragma unroll 2
        for (int s = 0; s < 16; ++s) {
            const int col = kh * 512 + 32 * s + 8 * kq;
            const u32x4 q = *(const u32x4*)(xr + 32 * s);
            const f32x4 a = {bflo(q.x), bfhi(q.x), bflo(q.y), bfhi(q.y)}, b = {bflo(q.z), bfhi(q.z), bflo(q.w), bfhi(q.w)};
            const f32x4 sc0 = *(const f32x4*)(mod + 4 * D + col) + 1.0f, sc1 = *(const f32x4*)(mod + 4 * D + col + 4) + 1.0f;
            const f32x4 sh0 = *(const f32x4*)(mod + 3 * D + col), sh1 = *(const f32x4*)(mod + 3 * D + col + 4);
            const f32x4 h0 = a * rstd * sc0 + sh0, h1 = b * rstd * sc1 + sh1;
            u32x4 hi; hi.x = cvt_pk_bf16(h0.x, h0.y); hi.y = cvt_pk_bf16(h0.z, h0.w); hi.z = cvt_pk_bf16(h1.x, h1.y); hi.w = cvt_pk_bf16(h1.z, h1.w);
            if ((FP8_LAYERS >> layer) & 1) *(u32x2*)(WSP(F, WS_HN8, unsigned char) + (size_t)row * D + col) = (u32x2){pack_fp8x4(h0.x, h0.y, h0.z, h0.w), pack_fp8x4(h1.x, h1.y, h1.z, h1.w)};
            else *(u32x4*)(hrow + col) = hi;
            u32x4 lo; lo.x = cvt_pk_bf16(h0.x - bflo(hi.x), h0.y - bfhi(hi.x)); lo.y = cvt_pk_bf16(h0.z - bflo(hi.y), h0.w - bfhi(hi.y));
            lo.z = cvt_pk_bf16(h1.x - bflo(hi.z), h1.y - bfhi(hi.z)); lo.w = cvt_pk_bf16(h1.z - bflo(hi.w), h1.w - bfhi(hi.w));
            const bf16x8 bh = __builtin_bit_cast(bf16x8, hi), bl = __builtin_bit_cast(bf16x8, lo);
#pragma unroll
            for (int et = 0; et < 2; ++et) {
                const bf16x8 wh = *(const LAS bf16x8*)(lds + (16 * et + tk) * RT_STRIDE + col * 2);
                const bf16x8 wl = *(const LAS bf16x8*)(lds + RT_PART + (16 * et + tk) * RT_STRIDE + col * 2);
                acc[et] = __builtin_amdgcn_mfma_f32_16x16x32_bf16(wh, bh, acc[et], 0, 0, 0);
                acc[et] = __builtin_amdgcn_mfma_f32_16x16x32_bf16(wl, bh, acc[et], 0, 0, 0);
                acc[et] = __builtin_amdgcn_mfma_f32_16x16x32_bf16(wh, bl, acc[et], 0, 0, 0);
            }
        }
        if (kh == 1) { lgx[(tile * 2 + 0) * 64 + lane] = acc[0]; lgx[(tile * 2 + 1) * 64 + lane] = acc[1]; }
        __syncthreads();
        if (kh == 0) {
            float cv[8]; int ci[8];
#pragma unroll
            for (int et = 0; et < 2; ++et) { const f32x4 o = lgx[(tile * 2 + et) * 64 + lane]; const f32x4 bb = *(const f32x4*)(brt + 16 * et + 4 * kq);
#pragma unroll
                for (int r = 0; r < 4; ++r) { cv[et * 4 + r] = acc[et][r] + o[r] + bb[r]; ci[et * 4 + r] = 16 * et + 4 * kq + r; } }
            float tv[4]; int ti[4];
            sel4of8(cv, ci, tv, ti);
#pragma unroll
            for (int off = 16; off <= 32; off <<= 1) {
                float mv[8]; int mi[8];
#pragma unroll
                for (int k = 0; k < 4; ++k) { mv[k] = tv[k]; mi[k] = ti[k]; mv[4 + k] = __shfl_xor(tv[k], off); mi[4 + k] = __shfl_xor(ti[k], off); }
                sel4of8(mv, mi, tv, ti);
            }
            const float e1 = __expf(tv[1] - tv[0]), e2 = __expf(tv[2] - tv[0]), e3 = __expf(tv[3] - tv[0]); const float inv = 1.0f / (1.0f + e1 + e2 + e3);
            if (kq == 0) { const int tl = tile * 16 + tk;
                pe[tl * 4 + 0] = ti[0]; pe[tl * 4 + 1] = ti[1]; pe[tl * 4 + 2] = ti[2]; pe[tl * 4 + 3] = ti[3];
                pw[tl * 4 + 0] = inv; pw[tl * 4 + 1] = e1 * inv; pw[tl * 4 + 2] = e2 * inv; pw[tl * 4 + 3] = e3 * inv; }
        }
        __syncthreads();
        int myexp = 0, lpos = 0;
        if (tid < 256) { myexp = pe[tid]; lpos = __hip_atomic_fetch_add(hist + myexp, 1, __ATOMIC_RELAXED, __HIP_MEMORY_SCOPE_WORKGROUP); }
        __syncthreads();
        if (tid < 32) gbase[tid] = (int)atomicAdd(cntw + tid, (unsigned)hist[tid]);
        __syncthreads();
        if (tid < 256) { const int pos = gbase[myexp] + lpos; if (pos < LIST_CAP) { lslot[(size_t)myexp * LIST_CAP + pos] = tb * 256 + tid; lw[(size_t)myexp * LIST_CAP + pos] = pw[tid]; } }
        __syncthreads();
    }
}

template <int MODE>
__device__ __forceinline__ void p_combine(Frame& F, int layer, const bf16_t* Xin, void* Xout_) {
    const int lane = F.lane;
    const float* mod = WSP(F, WS_MOD, float) + (size_t)layer * 6 * D;
    const bf16_t* ys = WSP(F, WS_YSLOT, bf16_t);
    f32x4 gf[4], fnw[4];
#pragma unroll
    for (int j = 0; j < 4; ++j) { gf[j] = *(const f32x4*)(mod + 5 * D + 4 * lane + 256 * j); if (MODE == 1) fnw[j] = *(const f32x4*)(inptr(18) + 4 * lane + 256 * j); }
    for (int it = 0; it < (T / 64 + F.G - 1) / F.G * 8; ++it) {
        const int row = ((it >> 3) * F.G + F.vcu) * 64 + F.wave * 8 + (it & 7); if (row >= T) break;
        const u32x2* xr = (const u32x2*)(Xin + (size_t)row * D) + lane;
        f32x4 v[4]; float s = 0.f;
#pragma unroll
        for (int j = 0; j < 4; ++j) {
            f32x4 a = {0.f, 0.f, 0.f, 0.f};
#pragma unroll
            for (int k = 0; k < 4; ++k) { const u32x2 y = *((const u32x2*)(ys + ((size_t)row * 4 + k) * D) + lane + 64 * j); a += (f32x4){bflo(y.x), bfhi(y.x), bflo(y.y), bfhi(y.y)}; }
            const u32x2 xq = xr[64 * j];
            v[j] = (f32x4){bflo(xq.x), bfhi(xq.x), bflo(xq.y), bfhi(xq.y)} + gf[j] * a;
            if (MODE == 0) { const u32x2 w = {cvt_pk_bf16(v[j].x, v[j].y), cvt_pk_bf16(v[j].z, v[j].w)};
                ((u32x2*)((bf16_t*)Xout_ + (size_t)row * D) + lane)[64 * j] = w; v[j] = (f32x4){bflo(w.x), bfhi(w.x), bflo(w.y), bfhi(w.y)}; }
            s += (v[j].x * v[j].x + v[j].y * v[j].y) + (v[j].z * v[j].z + v[j].w * v[j].w);
        }
        const float rstd = rsqrtf(wave_sum(s) * (1.f / D) + EPS);
        if (MODE == 0) { if (lane == 0) WSP(F, WS_RSTD, float)[row] = rstd; }
        else { f32x4* o = (f32x4*)((float*)Xout_ + (size_t)row * D) + lane;
#pragma unroll
            for (int j = 0; j < 4; ++j) __builtin_nontemporal_store(v[j] * rstd * fnw[j], o + 64 * j);
        }
    }
}

template <int W>
__device__ __forceinline__ void pool_unit(const bf16_t* X, const float* rs, bf16_t* P, int c, int t0, float sh, float sc) {
    float hp[16], hc[16];
#pragma unroll
    for (int i = 0; i < 16; ++i) { const int t = t0 - 16 + i; hp[i] = (i >= 16 - (W - 1) && t >= 0) ? bf2f(X[(size_t)t * D + c]) * rs[t] * sc + sh : 0.f; }
    float sum = 0.f;
#pragma unroll
    for (int i = 1; i < W; ++i) sum += hp[16 - i];
#pragma unroll
    for (int blk = 0; blk < 2; ++blk) {
        const int tb = t0 + 16 * blk;
#pragma unroll
        for (int i = 0; i < 16; ++i) hc[i] = bf2f(X[(size_t)(tb + i) * D + c]) * rs[tb + i] * sc + sh;
#pragma unroll
        for (int i = 0; i < 16; ++i) {
            const int t = tb + i;
            sum += hc[i];
            const int cnt = (t + 1 < W) ? (t + 1) : W;
            const float p = sum / (float)cnt - hc[i];
            P[(size_t)t * D + c] = (bf16_t)(cvt_pk_bf16(p, 0.f) & 0xffffu);
            sum -= (i - (W - 1) >= 0) ? hc[(i - (W - 1)) & 15] : hp[(16 + i - (W - 1)) & 15];
        }
#pragma unroll
        for (int i = 0; i < 16; ++i) hp[i] = hc[i];
    }
}
__device__ __forceinline__ void p_pool(Frame& F, const bf16_t* X) {
    const float* mod = WSP(F, WS_MOD, float) + (size_t)1 * 6 * D; const float* rs = WSP(F, WS_RSTD, float); bf16_t* P = WSP(F, WS_HN, bf16_t);
    const int tid = F.tid;
    for (int u = F.vcu; u < 1024; u += F.G) {
        const int tt = u >> 2, g = u & 3;
        const int c = g * 256 + (tid & 255), t0 = tt * 64 + (tid >> 8) * 32;
        const float sh = mod[0 * D + c], sc = 1.0f + mod[1 * D + c];
        if (g == 0) pool_unit<2>(X, rs, P, c, t0, sh, sc);
        else if (g == 1) pool_unit<4>(X, rs, P, c, t0, sh, sc);
        else if (g == 2) pool_unit<8>(X, rs, P, c, t0, sh, sc);
        else pool_unit<16>(X, rs, P, c, t0, sh, sc);
    }
}

constexpr int PG_STRIDE = 2064;
constexpr int PG_RS = 64 * PG_STRIDE;
template <int W>
__device__ __forceinline__ void pool_pair(const bf16_t* xcol, const LAS float* rsl, LAS unsigned* Pd, int t0, f32x2 sh, f32x2 sc) {
    f32x2 hp[16], hc[16];
#pragma unroll
    for (int i = 0; i < 16; ++i) { const int t = t0 - 16 + i; hp[i] = (f32x2){0.f, 0.f};
        if (i >= 16 - (W - 1) && t >= 0) { const unsigned q = *(const unsigned*)(xcol + (size_t)t * D); hp[i] = (f32x2){bflo(q), bfhi(q)} * rsl[i] * sc + sh; } }
    f32x2 sum = {0.f, 0.f};
#pragma unroll
    for (int i = 1; i < W; ++i) sum += hp[16 - i];
#pragma unroll 2
    for (int blk = 0; blk < 4; ++blk) {
        const int tb = t0 + 16 * blk;
#pragma unroll
        for (int i = 0; i < 16; ++i) { const unsigned q = *(const unsigned*)(xcol + (size_t)(tb + i) * D); hc[i] = (f32x2){bflo(q), bfhi(q)} * rsl[16 + 16 * blk + i] * sc + sh; }
#pragma unroll
        for (int i = 0; i < 16; ++i) {
            const int t = tb + i;
            sum += hc[i];
            const float inv = 1.0f / (float)((t + 1 < W) ? (t + 1) : W);
            const f32x2 p = sum * inv - hc[i];
            Pd[(size_t)(16 * blk + i) * (PG_STRIDE / 4)] = cvt_pk_bf16(p.x, p.y);
            sum -= (i - (W - 1) >= 0) ? hc[(i - (W - 1)) & 15] : hp[(16 + i - (W - 1)) & 15];
        }
#pragma unroll
        for (int i = 0; i < 16; ++i) hp[i] = hc[i];
    }
}
__device__ __forceinline__ void p_pool_gemm(Frame& F, const bf16_t* X2, bf16_t* X1) {
    const float* mod = WSP(F, WS_MOD, float) + (size_t)1 * 6 * D; const float* rs = WSP(F, WS_RSTD, float); const bf16_t* pwt = WSP(F, WS_POOLT, bf16_t);
    const float* pb = inptr(10); const float* psc = inptr(11);
    LAS unsigned char* lds = F.lds; LAS float* rsl = (LAS float*)(lds + PG_RS);
    const int tid = F.tid, lane = F.lane, w = F.wave, fr = lane & 15, fq = lane >> 4;
    for (int tb = F.vcu; tb < T / 64; tb += F.G) {
        const int t0 = tb * 64;
        if (tid < 80) { const int t = t0 - 16 + tid; rsl[tid] = (t >= 0) ? rs[t] : 0.f; }
        __syncthreads();
        {
            const int c2 = 2 * tid, gq = w >> 1;
            const f32x2 sh = *(const f32x2*)(mod + 0 * D + c2), sc = *(const f32x2*)(mod + 1 * D + c2) + 1.0f;
            LAS unsigned* Pd = (LAS unsigned*)(lds + c2 * 2);
            if (gq == 0) pool_pair<2>(X2 + c2, rsl, Pd, t0, sh, sc);
            else if (gq == 1) pool_pair<4>(X2 + c2, rsl, Pd, t0, sh, sc);
            else if (gq == 2) pool_pair<8>(X2 + c2, rsl, Pd, t0, sh, sc);
            else pool_pair<16>(X2 + c2, rsl, Pd, t0, sh, sc);
        }
        __syncthreads();
#pragma unroll 1
        for (int g = 0; g < 4; ++g) {
            f32x4 acc[2][4];
#pragma unroll
            for (int nt = 0; nt < 2; ++nt)
#pragma unroll
                for (int tt = 0; tt < 4; ++tt) acc[nt][tt] = (f32x4){0.f, 0.f, 0.f, 0.f};
            bf16x8 wf[2][8];
#pragma unroll
            for (int nt = 0; nt < 2; ++nt)
#pragma unroll
                for (int ks = 0; ks < 8; ++ks) wf[nt][ks] = *(const bf16x8*)(pwt + ((size_t)g * 256 + 32 * w + 16 * nt + fr) * 256 + 32 * ks + 8 * fq);
            u32x2 xq[2][4];
#pragma unroll
            for (int nt = 0; nt < 2; ++nt)
#pragma unroll
                for (int tt = 0; tt < 4; ++tt) xq[nt][tt] = *(const u32x2*)(X2 + (size_t)(t0 + 16 * tt + fr) * D + 256 * g + 32 * w + 16 * nt + 4 * fq);
#pragma unroll
            for (int ks = 0; ks < 8; ++ks) {
                bf16x8 af[4];
#pragma unroll
                for (int tt = 0; tt < 4; ++tt) af[tt] = *(const LAS bf16x8*)(lds + (16 * tt + fr) * PG_STRIDE + (256 * g + 32 * ks + 8 * fq) * 2);
#pragma unroll
                for (int nt = 0; nt < 2; ++nt)
#pragma unroll
                    for (int tt = 0; tt < 4; ++tt) acc[nt][tt] = __builtin_amdgcn_mfma_f32_16x16x32_bf16(wf[nt][ks], af[tt], acc[nt][tt], 0, 0, 0);
            }
#pragma unroll
            for (int nt = 0; nt < 2; ++nt) {
                const int col = 256 * g + 32 * w + 16 * nt + 4 * fq;
                const f32x4 gmv = *(const f32x4*)(mod + 2 * D + col), bv = *(const f32x4*)(pb + col), sv = *(const f32x4*)(psc + col);
#pragma unroll
                for (int tt = 0; tt < 4; ++tt) {
                    const size_t idx = (size_t)(t0 + 16 * tt + fr) * D + col;
                    const f32x4 xv = {bflo(xq[nt][tt].x), bfhi(xq[nt][tt].x), bflo(xq[nt][tt].y), bfhi(xq[nt][tt].y)};
                    const f32x4 o = xv + gmv * ((acc[nt][tt] + bv) * sv);
                    *(u32x2*)(X1 + idx) = (u32x2){cvt_pk_bf16(o.x, o.y), cvt_pk_bf16(o.z, o.w)};
                }
            }
        }
        __syncthreads();
    }
}

constexpr int N_PHASES = 17;
__global__ void __launch_bounds__(NTH, 2) fwd_kernel(Args args) {
    extern __shared__ __attribute__((aligned(16))) unsigned char lds_raw[];
    Frame F;
    F.lds = (LAS unsigned char*)lds_raw;
    F.MISC = (volatile LAS unsigned*)(F.lds + MISC_OFF);
    F.tid = threadIdx.x; F.lane = F.tid & 63; F.wave = __builtin_amdgcn_readfirstlane(F.tid >> 6);
    F.G = gridDim.x; { const int bx = blockIdx.x; F.vcu = (F.G % 8 == 0) ? (bx % 8) * (F.G / 8) + bx / 8 : bx; }
    F.ws = args.ws; F.ctl = (unsigned*)(args.ws + WS_CTL); F.out = args.out;
    for (int u = F.tid; u < (LDS_BYTES - MISC_OFF) / 4; u += NTH) F.MISC[u] = 0u;
    __syncthreads();
#if N_LAUNCH_MODE == 1
    XcdBarrier bar = xcd_barrier_post(F.ctl + CW_BAR, F.MISC + 8);
#define GRID_BAR() xcd_barrier(bar)
#else
#define GRID_BAR() do { } while (0)
#endif
    const int lo = args.ph_lo, hi = args.ph_hi;
#define IN(k) (lo <= (k) && (k) < hi)
#define SEAM(k) do { if (IN(k) && IN((k) + 1)) GRID_BAR(); } while (0)
    GemmBase gb; gb.G = F.G; gb.vcu = F.vcu;
    bf16_t* X1 = WSP(F, WS_X1, bf16_t); bf16_t* X2 = WSP(F, WS_X2, bf16_t);
    const float* mod0 = WSP(F, WS_MOD, float); const float* mod1 = mod0 + 6 * D;

    if (IN(0)) { p0_prologue(F); } SEAM(0);
    if (IN(1)) { p1_norm_in(F); } SEAM(1);
    if (IN(2)) { PolWin P; (GemmBase&)P = gb; P.A = WSP(F, WS_HN, bf16_t); P.Bt = WSP(F, WS_WINT, bf16_t); P.qkvg = WSP(F, WS_QKVG, bf16_t); P.gbuf = WSP(F, WS_GBUF, _Float16);
        P.lb = WSP(F, WS_LB, float); P.rope = WSP(F, WS_ROPE, f32x2); run_gemm(F, P); } SEAM(2);
    if (IN(3)) { la_local_state(F); } SEAM(3);
    if (IN(4)) { la_scan(F); } SEAM(4);
    if (IN(5)) { la_output(F); } SEAM(5);
    if (IN(6)) { PolRes<false> P; (GemmBase&)P = gb; P.A = WSP(F, WS_CAT, bf16_t); P.Bt = WSP(F, WS_WOUTT, bf16_t); P.resid = inptr(0); P.resid16 = nullptr; P.outp = X1; P.gate = mod0 + 2 * D; P.bias = nullptr; P.scale = nullptr;
        P.K = D; P.lda = D; P.nN = 4; P.kcol = 0; run_gemm(F, P); } SEAM(6);
    if (IN(7)) { p_route(F, 0, X1, args.aux); } SEAM(7);
    if (IN(8)) { expert_tables(F, 0); PolMoE<((FP8_LAYERS >> 0) & 1) != 0> P; (GemmBase&)P = gb; P.MISC = F.MISC; P.upa = F.lds + UPA_OFF; P.hn = ((FP8_LAYERS >> 0) & 1) ? (const bf16_t*)WSP(F, WS_HN8, unsigned char) : WSP(F, WS_HN, bf16_t);
        P.wgut = WSP(F, WS_WGUT, bf16_t) + (size_t)0 * NE * 2048 * D; P.bgu = inptr(15) + (size_t)0 * NE * 2048; P.lslot = WSP(F, WS_LSLOT, int) + (size_t)0 * NE * LIST_CAP; P.lw = WSP(F, WS_LW, float) + (size_t)0 * NE * LIST_CAP;
        P.act = (bf16_t*)(F.ws + (0 ? WS_ACT2 : WS_ACT)); P.wdnt = WSP(F, WS_WDNT, bf16_t) + (size_t)0 * NE * D * D; P.bdn = inptr(17) + (size_t)0 * NE * D; P.yslot = WSP(F, WS_YSLOT, bf16_t);
        P.done = F.ctl + CW_DONE + 0 * DONE_LAYER; P.tmo = F.ctl + CW_TMO; P.act_rsrc = __builtin_amdgcn_make_buffer_rsrc((void*)P.act, (short)0, (int)((size_t)ACT_ROWS * D * 2), 0x00020000);
        P.fill(F.tid); __syncthreads(); run_gemm(F, P); } if (IN(8) && IN(10)) GRID_BAR();
    if (IN(10)) { p_combine<0>(F, 0, X1, X2); } SEAM(10);
    if (IN(11)) { p_pool_gemm(F, X2, X1); asm volatile("s_waitcnt vmcnt(0)" ::: "memory"); __syncthreads(); p_route(F, 1, X1, args.aux); } if (IN(11) && IN(14)) GRID_BAR();
    if (IN(14)) { expert_tables(F, 1); PolMoE<((FP8_LAYERS >> 1) & 1) != 0> P; (GemmBase&)P = gb; P.MISC = F.MISC; P.upa = F.lds + UPA_OFF; P.hn = ((FP8_LAYERS >> 1) & 1) ? (const bf16_t*)WSP(F, WS_HN8, unsigned char) : WSP(F, WS_HN, bf16_t);
        P.wgut = WSP(F, WS_WGUT, bf16_t) + (size_t)1 * NE * 2048 * D; P.bgu = inptr(15) + (size_t)1 * NE * 2048; P.lslot = WSP(F, WS_LSLOT, int) + (size_t)1 * NE * LIST_CAP; P.lw = WSP(F, WS_LW, float) + (size_t)1 * NE * LIST_CAP;
        P.act = (bf16_t*)(F.ws + (1 ? WS_ACT2 : WS_ACT)); P.wdnt = WSP(F, WS_WDNT, bf16_t) + (size_t)1 * NE * D * D; P.bdn = inptr(17) + (size_t)1 * NE * D; P.yslot = WSP(F, WS_YSLOT, bf16_t);
        P.done = F.ctl + CW_DONE + 1 * DONE_LAYER; P.tmo = F.ctl + CW_TMO; P.act_rsrc = __builtin_amdgcn_make_buffer_rsrc((void*)P.act, (short)0, (int)((size_t)ACT_ROWS * D * 2), 0x00020000);
        P.fill(F.tid); __syncthreads(); run_gemm(F, P); } if (IN(14) && IN(16)) GRID_BAR();
    if (IN(16)) { p_combine<1>(F, 1, X1, F.out); }
#undef IN
#undef SEAM
}

extern "C" void kernel_launch(void* const* d_in, const int* in_sizes, int n_in, void* d_out, int out_size, void* d_ws, size_t ws_size, hipStream_t stream) {
    static int grid = 0;
    if (grid == 0) {
        if (n_in != 19 || out_size != T * D || ws_size < WS_END) { fprintf(stderr, "kernel_launch: unexpected shapes (n_in %d, out %d, ws %zu)\n", n_in, out_size, ws_size); grid = -1; return; }
        int dev = 0, cus = 0, per_cu = 0;
        if (hipGetDevice(&dev) != hipSuccess || hipDeviceGetAttribute(&cus, hipDeviceAttributeMultiprocessorCount, dev) != hipSuccess) { grid = -1; return; }
        if (hipFuncSetAttribute((const void*)fwd_kernel, hipFuncAttributeMaxDynamicSharedMemorySize, LDS_BYTES) != hipSuccess) { fprintf(stderr, "kernel_launch: hipFuncSetAttribute failed\n"); grid = -1; return; }
        if (hipOccupancyMaxActiveBlocksPerMultiprocessor(&per_cu, (const void*)fwd_kernel, NTH, LDS_BYTES) != hipSuccess || per_cu < 1) { fprintf(stderr, "kernel_launch: occupancy query says %d\n", per_cu); }
        (void)hipGetLastError();
        grid = cus;
    }
    if (grid < 0) return;
    (void)hipMemsetAsync((char*)d_ws + WS_CTL, 0, CTL_BYTES, stream);
    Args a{};
    for (int i = 0; i < 19; ++i) a.in[i] = (const float*)d_in[i];
    a.out = (float*)d_out; a.ws = (unsigned char*)d_ws;
#if N_LAUNCH_MODE == 1
    a.ph_lo = 0; a.ph_hi = N_PHASES;
    void* kargs[] = {&a};
    hipError_t e = hipLaunchCooperativeKernel((const void*)fwd_kernel, dim3(grid), dim3(NTH), kargs, LDS_BYTES, stream);
    if (e != hipSuccess) fprintf(stderr, "cooperative launch failed: %s\n", hipGetErrorString(e));
#else
    for (int p = 0; p < N_PHASES; ++p) {
        a.ph_lo = p; a.ph_hi = p + 1;
        hipLaunchKernelGGL(fwd_kernel, dim3(grid), dim3(NTH), LDS_BYTES, stream, a);
        if (p == DUP_PHASE) { a.aux = 1; hipLaunchKernelGGL(fwd_kernel, dim3(grid), dim3(NTH), LDS_BYTES, stream, a); a.aux = 0; }
    }
#endif
}
```

```cpp
#include <hip/hip_runtime.h>
#include <cstdio>
#include <cstdint>

#ifndef N_LAUNCH_MODE
#define N_LAUNCH_MODE 1
#endif
#ifndef DUP_PHASE
#define DUP_PHASE -1
#endif
#ifndef KREP_WIN
#define KREP_WIN 1
#endif
#ifndef KREP_RES
#define KREP_RES 1
#endif
#ifndef KREP_G1
#define KREP_G1 1
#endif
#ifndef KREP_G2
#define KREP_G2 1
#endif
#ifndef GEMM_KREP
#define GEMM_KREP 1
#endif
#ifndef GEMM_EPIREP
#define GEMM_EPIREP 1
#endif
#ifndef FP8_LAYERS
#define FP8_LAYERS 3
#endif
#ifndef SIMPLE_GEMM
#define SIMPLE_GEMM 0
#endif

#define LAS __attribute__((address_space(3)))
#define GAS __attribute__((address_space(1)))
typedef unsigned short bf16_t;
typedef short bf16x8 __attribute__((ext_vector_type(8)));
typedef float f32x4 __attribute__((ext_vector_type(4)));
typedef float f32x2 __attribute__((ext_vector_type(2)));
typedef unsigned u32x4 __attribute__((ext_vector_type(4)));
typedef unsigned u32x2 __attribute__((ext_vector_type(2)));
typedef _Float16 h16x2 __attribute__((ext_vector_type(2)));
typedef _Float16 h16x8 __attribute__((ext_vector_type(8)));
typedef int v4i_t __attribute__((ext_vector_type(4)));
typedef int v8i_t __attribute__((ext_vector_type(8)));
constexpr float W8_SCALE = 32.0f;
__device__ __forceinline__ unsigned pack_fp8x4(float a, float b, float c, float d) { int w = __builtin_amdgcn_cvt_pk_fp8_f32(a, b, 0, false); w = __builtin_amdgcn_cvt_pk_fp8_f32(c, d, w, true); return (unsigned)w; }

constexpr int T = 16384, D = 1024, NE = 32, TOPK = 4, DEPTH = 2;
constexpr int INW = 4096;
constexpr int NTH = 512, NWAVES = 8;
constexpr float EPS = 1e-6f;
constexpr float SW_LIMIT = 7.0f, SW_ALPHA = 1.702f;
constexpr int LIST_CAP = T;
constexpr int ACT_ROWS = T * TOPK + NE * 256;

constexpr size_t MiB = 1u << 20;
constexpr size_t WS_CTL = 0, CTL_BYTES = 1 * MiB;
constexpr size_t WS_MOD = 1 * MiB;
constexpr size_t WS_LB = WS_MOD + 65536;
constexpr size_t WS_ROPE = 2 * MiB;
constexpr size_t WS_WINT = 10 * MiB;
constexpr size_t WS_WOUTT = 18 * MiB;
constexpr size_t WS_POOLT = 20 * MiB;
constexpr size_t WS_LSLOT = 22 * MiB;
constexpr size_t WS_LW = 26 * MiB;
constexpr size_t WS_RT = 21 * MiB;
constexpr size_t WS_RSTD = 30 * MiB;
constexpr size_t WS_WGUT = 32 * MiB;
constexpr size_t WS_WDNT = 288 * MiB;
constexpr size_t WS_HN = 416 * MiB;
constexpr size_t WS_QKVG = 448 * MiB;
constexpr size_t WS_GBUF = 576 * MiB;
constexpr size_t WS_KVT = 608 * MiB;
constexpr size_t WS_SPREV = 736 * MiB;
constexpr size_t WS_DEC = 800 * MiB;
constexpr size_t WS_CAT = 802 * MiB;
constexpr size_t WS_X1 = 834 * MiB;
constexpr size_t WS_X2 = 898 * MiB;
constexpr size_t WS_ACT = 962 * MiB;
constexpr size_t WS_YSLOT = 1106 * MiB;
constexpr size_t WS_ACT2 = 1234 * MiB;
constexpr size_t WS_HN8 = 1378 * MiB;
constexpr size_t WS_END = 1394 * MiB;
constexpr int CW_CNT = 64;
constexpr int CW_BAR = 4096;
constexpr int CW_TMO = 8;
constexpr int CW_DONE = 8192, DONE_LAYER = 320 * 64;

constexpr int SCR_BYTES = 156 * 1024;
constexpr int MISC_OFF = SCR_BYTES;
constexpr int LDS_BYTES = SCR_BYTES + 4096;

typedef __bf16 bf16x2_t __attribute__((ext_vector_type(2)));
__device__ __forceinline__ unsigned cvt_pk_bf16(float lo, float hi) { const f32x2 v = {lo, hi}; const bf16x2_t b = __builtin_convertvector(v, bf16x2_t); return __builtin_bit_cast(unsigned, b); }
__device__ __forceinline__ float bf2f(unsigned short b) { return __builtin_bit_cast(float, (unsigned)b << 16); }
__device__ __forceinline__ float bflo(unsigned w) { return __builtin_bit_cast(float, w << 16); }
__device__ __forceinline__ float bfhi(unsigned w) { return __builtin_bit_cast(float, w & 0xffff0000u); }
__device__ __forceinline__ float wave_sum(float v) {
#pragma unroll
    for (int o = 1; o < 64; o <<= 1) v += __shfl_xor(v, o);
    return v;
}
__device__ __forceinline__ float wave_max(float v) {
#pragma unroll
    for (int o = 1; o < 64; o <<= 1) v = fmaxf(v, __shfl_xor(v, o));
    return v;
}
__device__ __forceinline__ float sigmoidf_(float x) { return __builtin_amdgcn_rcpf(1.0f + __expf(-x)); }
__device__ __forceinline__ float siluf_(float x) { return x * sigmoidf_(x); }
__device__ __forceinline__ f32x2 sigmoid2(f32x2 v) {
    constexpr float c = -1.4426950408889634f; const f32x2 c2 = {c, c}, one = {1.0f, 1.0f};
    const f32x2 t = v * c2; const f32x2 e = {__builtin_amdgcn_exp2f(t.x), __builtin_amdgcn_exp2f(t.y)}; const f32x2 d = e + one;
    return (f32x2){__builtin_amdgcn_rcpf(d.x), __builtin_amdgcn_rcpf(d.y)};
}
__device__ __forceinline__ f32x2 silu2(f32x2 v) { return v * sigmoid2(v); }
__device__ __forceinline__ f32x2 fgate2(f32x2 v, f32x2 lbv, f32x2 oml, f32x2& g) {
    const f32x2 f = __builtin_elementwise_fma(oml, sigmoid2(v), lbv);
    const f32x2 l2 = {__builtin_amdgcn_logf(f.x), __builtin_amdgcn_logf(f.y)}; const f32x2 ln2 = {0.6931471805599453f, 0.6931471805599453f}, one = {1.0f, 1.0f};
    g = l2 * ln2; return one - f;
}
__device__ __forceinline__ f32x2 swiglu2(f32x2 ag, f32x2 al, f32x2 bg, f32x2 bl1, float ws) {
    const f32x2 ws2 = {ws, ws};
    const f32x2 G = __builtin_elementwise_fma(ag, ws2, bg), L = __builtin_elementwise_fma(al, ws2, bl1);
    const f32x2 x = {fminf(G.x, SW_LIMIT), fminf(G.y, SW_LIMIT)};
    const f32x2 y = {__builtin_amdgcn_fmed3f(L.x, 1.0f - SW_LIMIT, 1.0f + SW_LIMIT), __builtin_amdgcn_fmed3f(L.y, 1.0f - SW_LIMIT, 1.0f + SW_LIMIT)};
    constexpr float c = -SW_ALPHA * 1.4426950408889634f; const f32x2 c2 = {c, c};
    const f32x2 t = x * c2;
    const f32x2 e = {__builtin_amdgcn_exp2f(t.x), __builtin_amdgcn_exp2f(t.y)};
    const f32x2 one = {1.0f, 1.0f};
    const f32x2 d = e + one;
    const f32x2 r = {__builtin_amdgcn_rcpf(d.x), __builtin_amdgcn_rcpf(d.y)};
    return (x * r) * y;
}

#define XB_TMO      128
#define XB_XCNT(j)  (256  + 64 * (j))
#define XB_XSUB(j)  (1280 + 64 * (j))
#define XB_XGEN(j)  (2304 + 64 * (j))
#define XB_TOP      3328
#define XB_TOPGEN   3392
#define XCD_BAR_WORDS 3456
#define XB_SPIN_CAP (1u << 20)
__device__ __forceinline__ unsigned xb_ld(unsigned* p)              { return __hip_atomic_load(p, __ATOMIC_RELAXED, __HIP_MEMORY_SCOPE_AGENT); }
__device__ __forceinline__ unsigned xb_add(unsigned* p, unsigned v) { return __hip_atomic_fetch_add(p, v, __ATOMIC_RELAXED, __HIP_MEMORY_SCOPE_AGENT); }
__device__ __forceinline__ unsigned xb_xcc_id() { return (unsigned)__builtin_amdgcn_s_getreg((3 << 11) | 20) & 0xFu; }
#define XB_SPIN(cond, bar) do { unsigned _sp = 0; while (cond) { __builtin_amdgcn_s_sleep(1); \
    if ((++_sp & 255u) == 0u) { if (xb_ld(&(bar)[XB_TMO])) break; if (_sp > XB_SPIN_CAP) { atomicAdd(&(bar)[XB_TMO], 1u); break; } } } } while (0)
struct XcdBarrier { unsigned* bar; unsigned x; volatile LAS unsigned* st; };
__device__ __forceinline__ XcdBarrier xcd_barrier_post(unsigned* bar, volatile LAS unsigned* st) {
    XcdBarrier b; b.bar = bar; b.x = xb_xcc_id(); b.st = st;
    if (threadIdx.x == 0) (void)xb_add(&bar[XB_XCNT(b.x)], 1u);
    return b;
}
__device__ __forceinline__ void xcd_barrier_complete(unsigned* bar, unsigned x, unsigned& nloc, unsigned& nx) {
    const unsigned G = gridDim.x * gridDim.y * gridDim.z;
    unsigned sum, cnt, mine, sp = 0u;
    for (;;) {
        sum = 0u; cnt = 0u; mine = 0u;
#pragma unroll
        for (unsigned j = 0; j < 16; ++j) { const unsigned c = xb_ld(&bar[XB_XCNT(j)]); sum += c; cnt += (c > 0u) ? 1u : 0u; mine = (j == x) ? c : mine; }
        if (sum == G) break;
        __builtin_amdgcn_s_sleep(1);
        if ((++sp & 255u) == 0u) { if (xb_ld(&bar[XB_TMO])) break; if (sp > XB_SPIN_CAP) { atomicAdd(&bar[XB_TMO], 1u); break; } }
    }
    nloc = mine > 0u ? mine : 1u; nx = cnt > 0u ? cnt : 1u;
}
__device__ __forceinline__ void xcd_barrier(const XcdBarrier& b) {
    asm volatile("s_waitcnt vmcnt(0)" ::: "memory");
    __syncthreads();
    if (threadIdx.x == 0) {
        unsigned* bar = b.bar;
        __builtin_amdgcn_s_waitcnt(0);
        unsigned nloc = b.st[0], nx = b.st[1];
        if (nloc == 0u) { xcd_barrier_complete(bar, b.x, nloc, nx); b.st[0] = nloc; b.st[1] = nx; }
        const unsigned old = xb_add(&bar[XB_XSUB(b.x)], 1u);
        const unsigned gen = old / nloc;
        if (old + 1u == (gen + 1u) * nloc) {
            __builtin_amdgcn_fence(__ATOMIC_RELEASE, "agent");
            asm volatile("s_waitcnt vmcnt(0)" ::: "memory");
            const unsigned og = xb_add(&bar[XB_TOP], 1u);
            const unsigned tg = og / nx;
            if (og + 1u == (tg + 1u) * nx) xb_add(&bar[XB_TOPGEN], 1u);
            else XB_SPIN(xb_ld(&bar[XB_TOPGEN]) == tg, bar);
            __builtin_amdgcn_fence(__ATOMIC_ACQUIRE, "agent");
            xb_add(&bar[XB_XGEN(b.x)], 1u);
            asm volatile("s_waitcnt vmcnt(0)" ::: "memory");
        } else {
            XB_SPIN(xb_ld(&bar[XB_XGEN(b.x)]) == gen, bar);
            __builtin_amdgcn_fence(__ATOMIC_ACQUIRE, "agent");
            asm volatile("s_waitcnt vmcnt(0)" ::: "memory");
        }
    }
    __syncthreads();
}

struct Args {
    const float* in[19];
    float* out;
    unsigned char* ws;
    int ph_lo, ph_hi, aux, pad;
};

namespace pg8 {
constexpr int BM = 256, BK = 64, HALF = 128, HTB = HALF * BK * 2;
__host__ __device__ __forceinline__ int lds_byte(int r, int c) { const int st = (r >> 4) * 2 + (c >> 5), rr = r & 15, cc = c & 31, ob = rr * 64 + cc * 2; return st * 1024 + (ob ^ (((ob >> 9) & 1) << 5)); }
__host__ __device__ __forceinline__ void stage_rc(int b, int& R, int& C) { const int st = b / 1024, sb = b % 1024, swz = sb ^ (((sb >> 9) & 1) << 5); R = (st >> 1) * 16 + swz / 64; C = (st & 1) * 32 + (swz % 64) / 2; }
__host__ __device__ __forceinline__ int perm32(int rho) { const int n = rho >> 4, i = rho & 15; return 8 * (i >> 2) + 4 * n + (i & 3); }

struct Unit { const char* A; const char* B; int p0, p1, p2, p3, ui; };

#define PG8_SA(b, h) (((b) * 2 + (h)) * HTB)
#define PG8_SB(b, h) ((4 + (b) * 2 + (h)) * HTB)
#define PG8_LDA(dst, b, h) do { _Pragma("unroll") for (int m = 0; m < 4; ++m) _Pragma("unroll") for (int k = 0; k < 2; ++k) dst[m][k] = *(const LAS bf16x8*)(lds + PG8_SA(b, h) + aoff + m * 2048 + k * 1024); } while (0)
#define PG8_LDB(dst, b, h) do { _Pragma("unroll") for (int n = 0; n < 2; ++n) _Pragma("unroll") for (int k = 0; k < 2; ++k) dst[n][k] = *(const LAS bf16x8*)(lds + PG8_SB(b, h) + boff + n * 2048 + k * 1024); } while (0)
#define PG8_MMA(ai, bj, At, Bt) do { __builtin_amdgcn_s_setprio(1); _Pragma("unroll") for (int m = 0; m < 4; ++m) _Pragma("unroll") for (int n = 0; n < 2; ++n) _Pragma("unroll") for (int k = 0; k < 2; ++k) \
        acc[ai][bj][m][n] = __builtin_amdgcn_mfma_f32_16x16x32_bf16(Bt[n][k], At[m][k], acc[ai][bj][m][n], 0, 0, 0); __builtin_amdgcn_s_setprio(0); } while (0)

template <class P>
__device__ __forceinline__ void gemm_simple(LAS unsigned char* lds, const P& S) {
    const int tid = threadIdx.x, wid = __builtin_amdgcn_readfirstlane(tid >> 6), lane = tid & 63, wr = wid >> 2, wc = wid & 3, fr = lane & 15, fq = lane >> 4;
    const int nt = S.nt();
    int R0, C0; stage_rc(tid * 16, R0, C0);
    unsigned offB[2];
#pragma unroll
    for (int i = 0; i < 2; ++i) { const int R = R0 + 64 * i; const int Rb = (R & ~31) + perm32(R & 31); offB[i] = (unsigned)Rb * S.ldb_bytes() + (unsigned)C0 * 2u; }
    const unsigned bhalf = 128u * S.ldb_bytes();
    const int aoff = lds_byte(wr * 64 + fr, fq * 8), boff = lds_byte(wc * 32 + fr, fq * 8);
    Unit u;
    for (int ui = 0; S.next(ui, u); ++ui) {
        unsigned offA[4]; S.aoff(u, R0, C0, offA);
        f32x4 acc[2][2][4][2];
#pragma unroll
        for (int a = 0; a < 2; ++a)
#pragma unroll
            for (int b = 0; b < 2; ++b)
#pragma unroll
                for (int m = 0; m < 4; ++m)
#pragma unroll
                    for (int n = 0; n < 2; ++n) acc[a][b][m][n] = (f32x4){0.f, 0.f, 0.f, 0.f};
        for (int t = 0; t < nt; ++t) {
            u32x4 ra[4], rb[4];
#pragma unroll
            for (int h = 0; h < 2; ++h)
#pragma unroll
                for (int i = 0; i < 2; ++i) {
                    ra[2 * h + i] = *(const u32x4*)(u.A + offA[2 * h + i] + (size_t)t * 128);
                    rb[2 * h + i] = *(const u32x4*)(u.B + (size_t)h * bhalf + offB[i] + (size_t)t * 128);
                }
            __syncthreads();
#pragma unroll
            for (int h = 0; h < 2; ++h)
#pragma unroll
                for (int i = 0; i < 2; ++i) {
                    *(LAS u32x4*)(lds + PG8_SA(0, h) + tid * 16 + i * 8192) = ra[2 * h + i];
                    *(LAS u32x4*)(lds + PG8_SB(0, h) + tid * 16 + i * 8192) = rb[2 * h + i];
                }
            __syncthreads();
            bf16x8 At[4][2], Bt[2][2];
#pragma unroll
            for (int ai = 0; ai < 2; ++ai) {
                PG8_LDA(At, 0, ai);
#pragma unroll
                for (int bj = 0; bj < 2; ++bj) { PG8_LDB(Bt, 0, bj); PG8_MMA(ai, bj, At, Bt); }
            }
        }
        S.epi(acc, u, wr, wc, fr, fq);
    }
    __syncthreads();
}

template <class P>
__device__ __forceinline__ void gemm_pipe(LAS unsigned char* lds, const P& S) {
    const int tid = threadIdx.x, wid = __builtin_amdgcn_readfirstlane(tid >> 6), lane = tid & 63, wr = wid >> 2, wc = wid & 3, fr = lane & 15, fq = lane >> 4;
    constexpr int KR = GEMM_KREP * P::KREP; const int nt1 = S.nt(), nt = nt1 * KR;
    int R0, C0; stage_rc(tid * 16, R0, C0);
    unsigned offB[2];
#pragma unroll
    for (int i = 0; i < 2; ++i) { const int R = R0 + 64 * i; const int Rb = (R & ~31) + perm32(R & 31); offB[i] = (unsigned)Rb * S.ldb_bytes() + (unsigned)C0 * 2u; }
    const size_t bhalf = (size_t)128u * S.ldb_bytes();
    const size_t kstep = 128;
    const unsigned ldsw = (unsigned)wid * 1024u;
    int aoffK[2], boffK[2];
#pragma unroll
    for (int k = 0; k < 2; ++k) { aoffK[k] = lds_byte(wr * 64 + fr, fq * 8) + k * 1024; boffK[k] = lds_byte(wc * 32 + fr, fq * 8) + k * 1024; }
#undef PG8_LDA
#undef PG8_LDB
#undef PG8_MMA
#define PG8_LDA(dst, b, h) do { _Pragma("unroll") for (int m = 0; m < 4; ++m) { \
        if constexpr (P::FP8) dst##8[m] = __builtin_shufflevector(*(const LAS v4i_t*)(lds + PG8_SA(b, h) + aoffK[0] + m * 2048), *(const LAS v4i_t*)(lds + PG8_SA(b, h) + aoffK[1] + m * 2048), 0, 1, 2, 3, 4, 5, 6, 7); \
        else { _Pragma("unroll") for (int k = 0; k < 2; ++k) dst[m][k] = *(const LAS bf16x8*)(lds + PG8_SA(b, h) + aoffK[k] + m * 2048); } } } while (0)
#define PG8_LDB(dst, b, h) do { _Pragma("unroll") for (int n = 0; n < 2; ++n) { \
        if constexpr (P::FP8) dst##8[n] = __builtin_shufflevector(*(const LAS v4i_t*)(lds + PG8_SB(b, h) + boffK[0] + n * 2048), *(const LAS v4i_t*)(lds + PG8_SB(b, h) + boffK[1] + n * 2048), 0, 1, 2, 3, 4, 5, 6, 7); \
        else { _Pragma("unroll") for (int k = 0; k < 2; ++k) dst[n][k] = *(const LAS bf16x8*)(lds + PG8_SB(b, h) + boffK[k] + n * 2048); } } } while (0)
#define PG8_MMA(ai, bj, At, Bt) do { if constexpr (P::FP8) __builtin_amdgcn_sched_barrier(0); __builtin_amdgcn_s_setprio(1); _Pragma("unroll") for (int m = 0; m < 4; ++m) _Pragma("unroll") for (int n = 0; n < 2; ++n) { \
        if constexpr (P::FP8) acc[ai][bj][m][n] = __builtin_amdgcn_mfma_scale_f32_16x16x128_f8f6f4(Bt##8[n], At##8[m], acc[ai][bj][m][n], 0, 0, 0, 127, 0, 127); \
        else { _Pragma("unroll") for (int k = 0; k < 2; ++k) acc[ai][bj][m][n] = __builtin_amdgcn_mfma_f32_16x16x32_bf16(Bt[n][k], At[m][k], acc[ai][bj][m][n], 0, 0, 0); } } \
        if constexpr (P::FP8) { _Pragma("unroll") for (int m = 0; m < 4; ++m) _Pragma("unroll") for (int n = 0; n < 2; ++n) asm volatile("" : "+v"(acc[ai][bj][m][n])); } \
        __builtin_amdgcn_s_setprio(0); if constexpr (P::FP8) __builtin_amdgcn_sched_barrier(0); } while (0)
#define PG8_STAGE_A(bufoff, gbase, OFF, h) do { _Pragma("unroll") for (int _i = 0; _i < 2; ++_i) \
        __builtin_amdgcn_global_load_lds((const unsigned*)((const char*)(gbase) + (OFF)[2 * (h) + _i]), (LAS unsigned*)(lds + (bufoff) + ldsw + _i * 8192), 16, 0, 0); } while (0)
#define PG8_STAGE_B(bufoff, gbase) do { _Pragma("unroll") for (int _i = 0; _i < 2; ++_i) \
        __builtin_amdgcn_global_load_lds((const unsigned*)((const char*)(gbase) + offB[_i]), (LAS unsigned*)(lds + (bufoff) + ldsw + _i * 8192), 16, 0, 0); } while (0)
#define PG8_WAIT_V(n) asm volatile("s_waitcnt vmcnt(" #n ")" ::: "memory")
#define PG8_WAIT_L(n) asm volatile("s_waitcnt lgkmcnt(" #n ")" ::: "memory")
#define PG8_BAR __builtin_amdgcn_s_barrier()
#define PG8_SCHED __builtin_amdgcn_sched_barrier(0)
    Unit cur, nxt; int ui = 0; int pend = -1;
    if (!S.next(0, cur)) return;
    f32x4 acc[2][2][4][2];
#pragma unroll
    for (int a = 0; a < 2; ++a)
#pragma unroll
        for (int b = 0; b < 2; ++b)
#pragma unroll
            for (int m = 0; m < 4; ++m)
#pragma unroll
                for (int n = 0; n < 2; ++n) acc[a][b][m][n] = (f32x4){0.f, 0.f, 0.f, 0.f};
    bf16x8 At[4][2], B0[2][2], B1[2][2];
    v8i_t At8[4], B08[2], B18[2];
    unsigned offC[4], offN[4];
    S.aoff(cur, R0, C0, offC);
    const char* cA = cur.A; const char* cB = cur.B;
    if constexpr (P::HAS_READY) S.a_ready(cur);
    PG8_STAGE_B(PG8_SB(0, 0), cB); PG8_STAGE_B(PG8_SB(0, 1), cB + bhalf); PG8_STAGE_A(PG8_SA(0, 0), cA, offC, 0); PG8_STAGE_A(PG8_SA(0, 1), cA, offC, 1);
    if (wr == 1) PG8_BAR;
    PG8_WAIT_V(2); PG8_BAR;
    PG8_STAGE_B(PG8_SB(1, 0), cB + kstep); PG8_STAGE_A(PG8_SA(1, 0), cA + kstep, offC, 0); PG8_STAGE_B(PG8_SB(1, 1), cB + bhalf + kstep);
    PG8_WAIT_V(6); PG8_BAR;
    for (;;) {
        const bool has_next = S.next(ui + 1, nxt);
        if (has_next) S.aoff(nxt, R0, C0, offN);
        else {
#pragma unroll
            for (int q = 0; q < 4; ++q) offN[q] = offC[q];
        }
        const char* nA = has_next ? nxt.A : cA; const char* nB = has_next ? nxt.B : cB;
        for (int t = 0; t < nt; t += 2) {
            const bool last = (t == nt - 2);
            const bool sf = P::SEAM_OPT && (ui > 0) && (t == 0);
            if constexpr (P::HAS_READY) { if (last && has_next) S.a_ready(nxt); }
            const char* a1 = cA + (size_t)((t + 1) % nt1) * kstep;
            const char* a2 = last ? nA : cA + (size_t)((t + 2) % nt1) * kstep; const char* b2 = last ? nB : cB + (size_t)((t + 2) % nt1) * kstep;
            const char* a3 = a2 + kstep; const char* b3 = b2 + kstep;
            unsigned o2[4];
#pragma unroll
            for (int q = 0; q < 4; ++q) o2[q] = last ? offN[q] : offC[q];
            PG8_LDB(B0, 0, 0); PG8_LDB(B1, 0, 1); PG8_SCHED; PG8_LDA(At, 0, 0); if (!sf) { PG8_STAGE_A(PG8_SA(1, 1), a1, offC, 1); PG8_WAIT_V(8); }
            PG8_WAIT_L(0); PG8_BAR; PG8_MMA(0, 0, At, B0); PG8_MMA(0, 1, At, B1); PG8_BAR; PG8_SCHED;
            PG8_LDA(At, 0, 1); PG8_STAGE_B(PG8_SB(0, 0), b2); PG8_STAGE_B(PG8_SB(0, 1), b2 + bhalf); PG8_STAGE_A(PG8_SA(0, 0), a2, o2, 0);
            if (!sf) PG8_WAIT_V(8); PG8_WAIT_L(0); PG8_BAR; PG8_MMA(1, 0, At, B0); PG8_MMA(1, 1, At, B1); PG8_BAR; PG8_SCHED;
            PG8_LDB(B0, 1, 0); PG8_LDB(B1, 1, 1); PG8_SCHED; PG8_LDA(At, 1, 0); PG8_STAGE_A(PG8_SA(0, 1), a2, o2, 1);
            if (!sf) PG8_WAIT_V(8); PG8_WAIT_L(0); PG8_BAR; PG8_MMA(0, 0, At, B0); PG8_MMA(0, 1, At, B1); PG8_BAR; PG8_SCHED;
            PG8_LDA(At, 1, 1); PG8_STAGE_B(PG8_SB(1, 0), b3); PG8_STAGE_B(PG8_SB(1, 1), b3 + bhalf); PG8_STAGE_A(PG8_SA(1, 0), a3, o2, 0);
            if (!sf) PG8_WAIT_V(8); PG8_WAIT_L(0); PG8_BAR; PG8_MMA(1, 0, At, B0); PG8_MMA(1, 1, At, B1); PG8_BAR; PG8_SCHED;
        }
        if constexpr (P::SEAM_OPT) PG8_STAGE_A(PG8_SA(1, 1), nA + kstep, offN, 1);
        if (wr == 0) PG8_BAR;
        if constexpr (P::SEAM_OPT) { PG8_WAIT_V(0);
            S.flush(pend); pend = -1; }
        if (KR != 1) {
#pragma unroll
            for (int a = 0; a < 2; ++a)
#pragma unroll
                for (int b = 0; b < 2; ++b)
#pragma unroll
                    for (int m = 0; m < 4; ++m)
#pragma unroll
                        for (int n = 0; n < 2; ++n) acc[a][b][m][n] = acc[a][b][m][n] * (1.0f / KR);
        }
        pend = S.epi(acc, cur, wr, wc, fr, fq);
        if constexpr (!P::SEAM_OPT) { if (pend >= 0) { PG8_WAIT_V(0); S.flush(pend); pend = -1; } }
        if (!has_next) break;
#pragma unroll
        for (int a = 0; a < 2; ++a)
#pragma unroll
            for (int b = 0; b < 2; ++b)
#pragma unroll
                for (int m = 0; m < 4; ++m)
#pragma unroll
                    for (int n = 0; n < 2; ++n) acc[a][b][m][n] = (f32x4){0.f, 0.f, 0.f, 0.f};
        cur = nxt; cA = nA; cB = nB; ++ui;
#pragma unroll
        for (int q = 0; q < 4; ++q) offC[q] = offN[q];
        if (wr == 1) PG8_BAR;
    }
    PG8_WAIT_V(0);
    S.flush(pend);
    PG8_BAR;
#undef PG8_STAGE_A
#undef PG8_STAGE_B
#undef PG8_WAIT_V
#undef PG8_WAIT_L
#undef PG8_BAR
#undef PG8_SCHED
}
}

struct Frame {
    LAS unsigned char* lds;
    volatile LAS unsigned* MISC;
    unsigned* ctl;
    int tid, lane, wave, vcu, G;
    unsigned char* ws;
    float* out;
};
typedef const float* cfptr_t;
__device__ __forceinline__ const float* inptr(int i) {
    const __attribute__((address_space(4))) cfptr_t* ka = (const __attribute__((address_space(4))) cfptr_t*)__builtin_amdgcn_kernarg_segment_ptr();
    asm volatile("" : "+s"(ka));
    const GAS float* g = (const GAS float*)ka[i];
    return (const float*)g;
}
#define WSP(F, off, type) ((type*)((F).ws + (off)))

template <class RowMap>
__device__ __forceinline__ void transpose_tile(const float* W, int K, int N, bf16_t* WT, LAS unsigned char* scr, int item, int lane, const RowMap& rm) {
    const int nblk = N / 64, kb = item / nblk, nb = item % nblk, k0 = 64 * kb, n0 = 64 * nb;
    const int kg = lane & 3, ng = lane >> 2;
    f32x4 v[4][4];
#pragma unroll
    for (int r = 0; r < 4; ++r)
#pragma unroll
        for (int i = 0; i < 4; ++i) v[r][i] = __builtin_nontemporal_load((const f32x4*)(W + (size_t)(k0 + 16 * r + 4 * kg + i) * N + n0 + 4 * ng));
#pragma unroll
    for (int r = 0; r < 4; ++r)
#pragma unroll
        for (int j = 0; j < 4; ++j)
            *(LAS u32x2*)(scr + (4 * ng + j) * 144 + (16 * r + 4 * kg) * 2) = (u32x2){cvt_pk_bf16(v[r][0][j], v[r][1][j]), cvt_pk_bf16(v[r][2][j], v[r][3][j])};
    asm volatile("s_waitcnt lgkmcnt(0)" ::: "memory");
    const int c = lane & 7;
#pragma unroll
    for (int q = 0; q < 8; ++q) { const int n = (lane >> 3) + 8 * q; const u32x4 o = *(const LAS u32x4*)(scr + n * 144 + c * 16); __builtin_nontemporal_store(o, (u32x4*)(WT + (size_t)rm(n0 + n) * K + k0 + 8 * c)); }
    asm volatile("s_waitcnt lgkmcnt(0)" ::: "memory");
}
template <class RowMap>
__device__ __forceinline__ void transpose_tile8(const float* W, int K, int N, unsigned char* WT, LAS unsigned char* scr, int item, int lane, const RowMap& rm) {
    const int nblk = N / 64, kb = item / nblk, nb = item % nblk, k0 = 128 * kb, n0 = 64 * nb;
    const int kg = lane & 3, ng = lane >> 2;
#pragma unroll
    for (int hb = 0; hb < 2; ++hb) {
        f32x4 v[4][4];
#pragma unroll
        for (int r = 0; r < 4; ++r)
#pragma unroll
            for (int i = 0; i < 4; ++i) v[r][i] = __builtin_nontemporal_load((const f32x4*)(W + (size_t)(k0 + 64 * hb + 16 * r + 4 * kg + i) * N + n0 + 4 * ng));
#pragma unroll
        for (int r = 0; r < 4; ++r)
#pragma unroll
            for (int j = 0; j < 4; ++j)
                *(LAS unsigned*)(scr + (4 * ng + j) * 144 + 64 * hb + 16 * r + 4 * kg) = pack_fp8x4(v[r][0][j] * W8_SCALE, v[r][1][j] * W8_SCALE, v[r][2][j] * W8_SCALE, v[r][3][j] * W8_SCALE);
    }
    asm volatile("s_waitcnt lgkmcnt(0)" ::: "memory");
    const int c = lane & 7;
#pragma unroll
    for (int q = 0; q < 8; ++q) { const int n = (lane >> 3) + 8 * q; const u32x4 o = *(const LAS u32x4*)(scr + n * 144 + c * 16); __builtin_nontemporal_store(o, (u32x4*)(WT + (size_t)rm(n0 + n) * K + k0 + 16 * c)); }
    asm volatile("s_waitcnt lgkmcnt(0)" ::: "memory");
}
struct RmId { __device__ __forceinline__ int operator()(int n) const { return n; } };
struct RmWin { __device__ __forceinline__ int operator()(int n) const {
        const int s = n >> 9; if (s != 4 && s != 5) return n;
        const int d = n & 127, dd = d & 63; const int p = 8 * (dd >> 2) + (dd & 3) + ((d >> 6) << 2); return n - d + p; } };
struct RmGu { __device__ __forceinline__ int operator()(int n) const { const int half = n >> 10, j = (n & 1023) >> 7, i = n & 127; return 256 * j + 128 * half + i; } };

__device__ __forceinline__ void p0_prologue(Frame& F) {
    const int tid = F.tid;
    {
        LAS float* red = (LAS float*)F.lds;
        const float* c = inptr(1);
        for (int u = F.vcu; u < 192; u += F.G) {
            const int l = u / 96, cg = u % 96, kq = tid >> 4, cq = tid & 15;
            const float* W = inptr(2) + (size_t)l * D * 6 * D + cg * 64 + cq * 4;
            f32x4 a = {0.f, 0.f, 0.f, 0.f};
#pragma unroll 8
            for (int j = 0; j < 32; ++j) { const int k = kq + 32 * j; const float cv = siluf_(c[k]); const f32x4 w = *(const f32x4*)(W + (size_t)k * 6 * D); a += w * cv; }
            __syncthreads();
            *(LAS f32x4*)(red + kq * 64 + cq * 4) = a;
            __syncthreads();
            if (tid < 64) { float s = 0.f;
#pragma unroll 8
                for (int k = 0; k < 32; ++k) s += red[k * 64 + tid];
                const int col = cg * 64 + tid;
                WSP(F, WS_MOD, float)[l * 6 * D + col] = s + inptr(3)[l * 6 * D + col]; }
        }
        __syncthreads();
    }
    if (F.vcu == 0) { const float* hb = inptr(5); const float a = hb[tid], b = hb[512 + tid]; WSP(F, WS_LB, float)[tid] = 1.0f / (1.0f + __expf(b - a)); }
    {
        bf16_t* rt = WSP(F, WS_RT, bf16_t); const float* wr = inptr(12);
        for (int idx = F.vcu * NTH + tid; idx < 2 * D * NE; idx += F.G * NTH) {
            const int l = idx >> 15, rem = idx & 32767, c = rem >> 5, e = rem & 31;
            const float w = wr[idx]; const unsigned hi = cvt_pk_bf16(w, 0.f) & 0xffffu; const float res = w - bflo(hi);
            rt[((size_t)(l * 2 + 0) * 32 + e) * D + c] = (bf16_t)hi; rt[((size_t)(l * 2 + 1) * 32 + e) * D + c] = (bf16_t)(cvt_pk_bf16(res, 0.f) & 0xffffu);
        }
    }
    {
        f32x2* rope = WSP(F, WS_ROPE, f32x2);
        for (int idx = F.vcu * NTH + tid; idx < T * 64; idx += F.G * NTH) {
            const int t = idx >> 6, d = idx & 63;
            const float inv = exp2f(-(float)d * (13.287712379549449f / 64.0f));
            const float ang = (float)t * inv;
            const double a = (double)ang; const double n = __builtin_rint(a * 0.15915494309189535); const double r = __builtin_fma(-n, 6.283185307179586, a);
            const float rf = (float)r;
            rope[idx] = (f32x2){__cosf(rf), __sinf(rf)};
        }
    }
    {
        LAS unsigned char* scr = F.lds + F.wave * 16384;
        const int gw = F.vcu * NWAVES + F.wave, NGW = F.G * NWAVES;
        constexpr int I_IN = 16 * 64, I_OUT = 16 * 16, I_POOL = 4 * 4 * 4;
        constexpr int NL8 = ((FP8_LAYERS & 1) ? 1 : 0) + ((FP8_LAYERS & 2) ? 1 : 0), NL16 = 2 - NL8;
        constexpr int S_GU = 32 * 8 * 32, S_DN = 32 * 8 * 16;
        constexpr int T_GU = 32 * 16 * 32, T_DN = 32 * 16 * 16;
        constexpr int N8 = NL8 * (S_GU + S_DN), N16 = NL16 * (T_GU + T_DN);
        constexpr int NITEMS = N8 + I_IN + I_OUT + I_POOL + N16;
        for (int it = gw; it < NITEMS; it += NGW) {
            int r = it;
            if (r < N8) {
                const int li = r / (S_GU + S_DN), layer = (NL8 == 2) ? li : ((FP8_LAYERS & 1) ? 0 : 1); r -= li * (S_GU + S_DN);
                if (r < S_GU) { const int m = layer * 32 + r / 256; transpose_tile8(inptr(14) + (size_t)m * D * 2048, D, 2048, (unsigned char*)(WSP(F, WS_WGUT, bf16_t) + (size_t)layer * NE * 2048 * D) + (size_t)(m & 31) * 2048 * D, scr, r % 256, F.lane, RmGu()); }
                else { r -= S_GU; const int m = layer * 32 + r / 128; transpose_tile8(inptr(16) + (size_t)m * D * D, D, D, (unsigned char*)(WSP(F, WS_WDNT, bf16_t) + (size_t)layer * NE * D * D) + (size_t)(m & 31) * D * D, scr, r % 128, F.lane, RmId()); }
                continue;
            }
            r -= N8;
            if (r < I_IN) { transpose_tile(inptr(4), D, INW, WSP(F, WS_WINT, bf16_t), scr, r, F.lane, RmWin()); continue; } r -= I_IN;
            if (r < I_OUT) { transpose_tile(inptr(8), D, D, WSP(F, WS_WOUTT, bf16_t), scr, r, F.lane, RmId()); continue; } r -= I_OUT;
            if (r < I_POOL) { const int g = r / 16; transpose_tile(inptr(9) + (size_t)g * 65536, 256, 256, WSP(F, WS_POOLT, bf16_t) + (size_t)g * 65536, scr, r % 16, F.lane, RmId()); continue; } r -= I_POOL;
            if (NL16 > 0) {
                const int li = r / (T_GU + T_DN), layer = (NL16 == 2) ? li : ((FP8_LAYERS & 1) ? 1 : 0); r -= li * (T_GU + T_DN);
                if (r < T_GU) { const int m = layer * 32 + r / 512; transpose_tile(inptr(14) + (size_t)m * D * 2048, D, 2048, WSP(F, WS_WGUT, bf16_t) + (size_t)m * 2048 * D, scr, r % 512, F.lane, RmGu()); }
                else { r -= T_GU; const int m = layer * 32 + r / 256; transpose_tile(inptr(16) + (size_t)m * D * D, D, D, WSP(F, WS_WDNT, bf16_t) + (size_t)m * D * D, scr, r % 256, F.lane, RmId()); }
            }
        }
    }
}

__device__ __forceinline__ void p1_norm_in(Frame& F) {
    const float* mod = WSP(F, WS_MOD, float);
    f32x4 sh[4], sc[4];
#pragma unroll
    for (int j = 0; j < 4; ++j) { sh[j] = *(const f32x4*)(mod + 0 * D + 4 * F.lane + 256 * j); sc[j] = *(const f32x4*)(mod + 1 * D + 4 * F.lane + 256 * j) + 1.0f; }
    const int gw = F.vcu * NWAVES + F.wave, NGW = F.G * NWAVES;
    for (int row = gw; row < T; row += NGW) {
        const f32x4* xr = (const f32x4*)(inptr(0) + (size_t)row * D) + F.lane;
        f32x4 v[4]; float s = 0.f;
#pragma unroll
        for (int j = 0; j < 4; ++j) { v[j] = xr[64 * j]; s += (v[j].x * v[j].x + v[j].y * v[j].y) + (v[j].z * v[j].z + v[j].w * v[j].w); }
        const float rstd = rsqrtf(wave_sum(s) * (1.f / D) + EPS);
        u32x2* o = (u32x2*)(WSP(F, WS_HN, bf16_t) + (size_t)row * D) + F.lane;
#pragma unroll
        for (int j = 0; j < 4; ++j) { const f32x4 h = v[j] * rstd * sc[j] + sh[j]; o[64 * j] = (u32x2){cvt_pk_bf16(h.x, h.y), cvt_pk_bf16(h.z, h.w)}; }
    }
}

using pg8::Unit;
typedef f32x4 AccT[2][2][4][2];

struct GemmBase {
    static constexpr bool SEAM_OPT = false;
    __device__ __forceinline__ void flush(int) const {}
    static constexpr bool HAS_READY = false;
    static constexpr bool FP8 = false;
    int G, vcu;
    __device__ __forceinline__ void aoff_lin(int R0, int C0, unsigned lda_bytes, unsigned (&off)[4]) const {
#pragma unroll
        for (int q = 0; q < 4; ++q) off[q] = (unsigned)(R0 + 64 * (q & 1) + 128 * (q >> 1)) * lda_bytes + (unsigned)C0 * 2u;
    }
};

struct PolWin : GemmBase {
    static constexpr int KREP = KREP_WIN;
    const bf16_t* A; const bf16_t* Bt; bf16_t* qkvg; _Float16* gbuf; const float* lb; const f32x2* rope;
    __device__ __forceinline__ int nt() const { return D / 64; }
    __device__ __forceinline__ unsigned ldb_bytes() const { return D * 2; }
    __device__ __forceinline__ bool next(int i, Unit& u) const {
        const int V = i * G + vcu; if (V >= 64 * 16) return false;
        const int c = (V & 15) >> 1, cg = c >> 2, cp = (c + i) & 3, sec = cg ? ((0x5730 >> (4 * cp)) & 15) : ((0x4621 >> (4 * cp)) & 15);
        u.p0 = V >> 4; u.p1 = 2 * sec + (V & 1); u.A = (const char*)(A + (size_t)u.p0 * 256 * D); u.B = (const char*)(Bt + (size_t)u.p1 * 256 * D); return true; }
    __device__ __forceinline__ void aoff(const Unit&, int R0, int C0, unsigned (&off)[4]) const { aoff_lin(R0, C0, D * 2, off); }
    __device__ __forceinline__ int epi(const AccT& acc, const Unit& u, int wr, int wc, int fr, int fq) const {
        const int pm = u.p0, pn = u.p1, s = pn >> 1;
        const int row0 = pm * 256 + wr * 64 + fr;
        const int o0 = (pn & 1) * 256 + wc * 32 + 8 * fq;
        const int dbase = (s & 3) * 1024 + (s >> 2) * 512;
        bf16_t* obase = qkvg + (size_t)row0 * INW + dbase;
        if (s == 4 || s == 5) {
            const int d0 = 4 * ((o0 & 127) >> 3);
            const float qs = (s == 5) ? 0.08838834764831845f : 1.0f;
#pragma unroll
            for (int ah = 0; ah < 2; ++ah) {
                f32x4 rc[4][2];
#pragma unroll
                for (int m = 0; m < 4; ++m) { const f32x4* rp = (const f32x4*)(rope + (size_t)(row0 + ah * 128 + m * 16) * 64 + d0); rc[m][0] = rp[0]; rc[m][1] = rp[1]; }
#pragma unroll
                for (int m = 0; m < 4; ++m) {
                    const f32x4 cs = {rc[m][0].x * qs, rc[m][0].z * qs, rc[m][1].x * qs, rc[m][1].z * qs}, sn = {rc[m][0].y * qs, rc[m][0].w * qs, rc[m][1].y * qs, rc[m][1].w * qs};
                    bf16_t* orow = obase + (size_t)(ah * 128 + m * 16) * INW;
#pragma unroll
                    for (int bj = 0; bj < 2; ++bj) {
                        const int hd = (o0 + bj * 128) & ~127;
                        const f32x4 v0 = acc[ah][bj][m][0], v1 = acc[ah][bj][m][1];
                        const f32x4 o1 = v0 * cs - v1 * sn, o2 = v0 * sn + v1 * cs;
                        *(u32x2*)(orow + hd + d0) = (u32x2){cvt_pk_bf16(o1.x, o1.y), cvt_pk_bf16(o1.z, o1.w)};
                        *(u32x2*)(orow + hd + d0 + 64) = (u32x2){cvt_pk_bf16(o2.x, o2.y), cvt_pk_bf16(o2.z, o2.w)};
                    }
                }
            }
        } else if (s == 1) {
#pragma unroll
            for (int bj = 0; bj < 2; ++bj) {
                const int o = o0 + bj * 128;
                const f32x4 l0 = *(const f32x4*)(lb + o), l1 = *(const f32x4*)(lb + o + 4), m0 = 1.0f - l0, m1 = 1.0f - l1;
#pragma unroll
                for (int am = 0; am < 8; ++am) {
                    const size_t ro = (size_t)((am >> 2) * 128 + (am & 3) * 16);
                    const f32x4 v0 = acc[am >> 2][bj][am & 3][0], v1 = acc[am >> 2][bj][am & 3][1];
                    f32x2 g0, g1, g2, g3;
                    const f32x2 k0 = fgate2(v0.xy, l0.xy, m0.xy, g0), k1 = fgate2(v0.zw, l0.zw, m0.zw, g1), k2 = fgate2(v1.xy, l1.xy, m1.xy, g2), k3 = fgate2(v1.zw, l1.zw, m1.zw, g3);
                    *(h16x8*)(gbuf + ((size_t)row0 + ro) * 512 + o) = (h16x8){(_Float16)g0.x, (_Float16)g0.y, (_Float16)g1.x, (_Float16)g1.y, (_Float16)g2.x, (_Float16)g2.y, (_Float16)g3.x, (_Float16)g3.y};
                    u32x4 w; w.x = cvt_pk_bf16(k0.x, k0.y); w.y = cvt_pk_bf16(k1.x, k1.y); w.z = cvt_pk_bf16(k2.x, k2.y); w.w = cvt_pk_bf16(k3.x, k3.y);
                    *(u32x4*)(obase + ro * INW + o) = w;
                }
            }
        } else {
            const bool act = (s == 0 || s == 3 || s == 7);
#pragma unroll
            for (int am = 0; am < 8; ++am) {
                const size_t ro = (size_t)((am >> 2) * 128 + (am & 3) * 16);
#pragma unroll
                for (int bj = 0; bj < 2; ++bj) {
                    f32x4 v0 = acc[am >> 2][bj][am & 3][0], v1 = acc[am >> 2][bj][am & 3][1];
                    if (act) { const f32x2 a0 = silu2(v0.xy), a1 = silu2(v0.zw), a2 = silu2(v1.xy), a3 = silu2(v1.zw); v0 = (f32x4){a0.x, a0.y, a1.x, a1.y}; v1 = (f32x4){a2.x, a2.y, a3.x, a3.y}; }
                    u32x4 w; w.x = cvt_pk_bf16(v0[0], v0[1]); w.y = cvt_pk_bf16(v0[2], v0[3]); w.z = cvt_pk_bf16(v1[0], v1[1]); w.w = cvt_pk_bf16(v1[2], v1[3]);
                    *(u32x4*)(obase + ro * INW + o0 + bj * 128) = w;
                }
            }
        }
            return -1;
    }
};

template <bool R16>
struct PolRes : GemmBase {
    static constexpr int KREP = KREP_RES;
    const bf16_t* A; const bf16_t* Bt; const float* resid; const bf16_t* resid16; bf16_t* outp; const float* gate; const float* bias; const float* scale;
    int K, lda, nN, kcol;
    __device__ __forceinline__ int nt() const { return K / 64; }
    __device__ __forceinline__ unsigned ldb_bytes() const { return (unsigned)K * 2u; }
    __device__ __forceinline__ bool next(int i, Unit& u) const {
        const int V = i * G + vcu; if (V >= 64 * nN) return false;
        u.p0 = V / nN; u.p1 = V % nN; u.A = (const char*)(A + (size_t)u.p0 * 256 * lda + (size_t)u.p1 * kcol); u.B = (const char*)(Bt + (size_t)u.p1 * 256 * K); return true; }
    __device__ __forceinline__ void aoff(const Unit&, int R0, int C0, unsigned (&off)[4]) const { aoff_lin(R0, C0, (unsigned)lda * 2u, off); }
    __device__ __forceinline__ int epi(const AccT& acc, const Unit& u, int wr, int wc, int fr, int fq) const {
        const int row0 = u.p0 * 256 + wr * 64 + fr, col0 = u.p1 * 256 + wc * 32 + 8 * fq;
#pragma unroll
        for (int bj = 0; bj < 2; ++bj) {
            const int c = col0 + bj * 128;
            const f32x4 g0 = *(const f32x4*)(gate + c), g1 = *(const f32x4*)(gate + c + 4);
            f32x4 b0 = {0.f, 0.f, 0.f, 0.f}, b1 = b0, s0 = {1.f, 1.f, 1.f, 1.f}, s1 = s0;
            if (bias) { b0 = *(const f32x4*)(bias + c); b1 = *(const f32x4*)(bias + c + 4); s0 = *(const f32x4*)(scale + c); s1 = *(const f32x4*)(scale + c + 4); }
#pragma unroll
            for (int ah = 0; ah < 2; ++ah) {
                f32x4 r[4][2];
                if constexpr (!R16) {
#pragma unroll
                    for (int m = 0; m < 4; ++m) { const size_t idx = (size_t)(row0 + ah * 128 + m * 16) * D + c; r[m][0] = *(const f32x4*)(resid + idx); r[m][1] = *(const f32x4*)(resid + idx + 4); }
                } else {
                    u32x4 q[4];
#pragma unroll
                    for (int m = 0; m < 4; ++m) q[m] = *(const u32x4*)(resid16 + (size_t)(row0 + ah * 128 + m * 16) * D + c);
#pragma unroll
                    for (int m = 0; m < 4; ++m) { r[m][0] = (f32x4){bflo(q[m].x), bfhi(q[m].x), bflo(q[m].y), bfhi(q[m].y)}; r[m][1] = (f32x4){bflo(q[m].z), bfhi(q[m].z), bflo(q[m].w), bfhi(q[m].w)}; }
                }
#pragma unroll
                for (int m = 0; m < 4; ++m) {
                    const size_t idx = (size_t)(row0 + ah * 128 + m * 16) * D + c;
                    const f32x4 o0 = r[m][0] + g0 * ((acc[ah][bj][m][0] + b0) * s0), o1 = r[m][1] + g1 * ((acc[ah][bj][m][1] + b1) * s1);
                    *(u32x4*)(outp + idx) = (u32x4){cvt_pk_bf16(o0.x, o0.y), cvt_pk_bf16(o0.z, o0.w), cvt_pk_bf16(o1.x, o1.y), cvt_pk_bf16(o1.z, o1.w)};
                }
            }
        }
            return -1;
    }
};

constexpr int MI_TPRE = 16, MI_CNT = 64, MI_MT2E = 128;
__device__ __forceinline__ void expert_tables(Frame& F, int layer) {
    if (F.tid < 64) {
        const int lane = F.lane;
        int c = 0;
        if (lane < NE) { c = (int)__hip_atomic_load(F.ctl + CW_CNT + 64 * layer + lane, __ATOMIC_RELAXED, __HIP_MEMORY_SCOPE_AGENT); if (c > LIST_CAP) c = LIST_CAP; }
        const int nt_ = (c + 255) >> 8;
        int pre = nt_;
#pragma unroll
        for (int off = 1; off < 32; off <<= 1) { const int v = __shfl_up(pre, off); if (lane >= off) pre += v; }
        const int excl = pre - nt_;
        if (lane < NE) { F.MISC[MI_TPRE + lane] = excl; F.MISC[MI_CNT + lane] = c; for (int q = 0; q < nt_; ++q) F.MISC[MI_MT2E + excl + q] = lane; }
        if (lane == NE - 1) F.MISC[MI_TPRE + NE] = pre;
    }
    __syncthreads();
}
constexpr int UPA_OFF = 131072;
struct PolG1 : GemmBase {
    static constexpr int KREP = KREP_G1;
    volatile LAS unsigned* MISC; LAS unsigned char* upa; const bf16_t* hn; const bf16_t* wgut; const float* bgu; const int* lslot; bf16_t* act;
    __device__ __forceinline__ int nt() const { return D / 64; }
    __device__ __forceinline__ unsigned ldb_bytes() const { return D * 2; }
    __device__ __forceinline__ bool next(int i, Unit& u) const {
        const int V = i * G + vcu, MT = (int)MISC[MI_TPRE + NE]; if (V >= MT * 8 || i >= 10) return false;
        const int mt = V >> 3, nt_ = V & 7, e = (int)MISC[MI_MT2E + mt];
        u.p0 = e; u.p1 = mt - (int)MISC[MI_TPRE + e]; u.p2 = nt_; u.p3 = mt; u.ui = i;
        u.A = (const char*)hn; u.B = (const char*)(wgut + ((size_t)e * 2048 + (size_t)nt_ * 256) * D); return true; }
    __device__ __forceinline__ void fill(int tid) const {
#pragma unroll
        for (int k = 0; k < 5; ++k) {
            const int j = tid + NTH * k, i = j >> 8, r = j & 255; Unit u;
            if (next(i, u)) {
                const int cnt = (int)MISC[MI_CNT + u.p0], li = u.p1 * 256 + r;
                ((LAS int*)(upa + i * 2048))[r] = (li < cnt) ? (lslot[(size_t)u.p0 * LIST_CAP + li] >> 2) : 0;
                ((LAS float*)(upa + i * 2048 + 1024))[r] = bgu[(size_t)u.p0 * 2048 + (r >> 7) * 1024 + u.p2 * 128 + (r & 127)];
            }
        }
    }
    __device__ __forceinline__ void aoff(const Unit& u, int R0, int C0, unsigned (&off)[4]) const {
        const LAS int* tk = (const LAS int*)(upa + u.ui * 2048);
#pragma unroll
        for (int q = 0; q < 4; ++q) off[q] = (unsigned)tk[R0 + 64 * (q & 1) + 128 * (q >> 1)] * (D * 2u) + (unsigned)C0 * 2u;
    }
    __device__ __forceinline__ int epi(const AccT& acc, const Unit& u, int wr, int wc, int fr, int fq) const {
        const int cl = wc * 32 + 8 * fq;
        const LAS float* bg = (const LAS float*)(upa + u.ui * 2048 + 1024);
        const f32x4 bgl0 = *(const LAS f32x4*)(bg + cl), bgl1 = *(const LAS f32x4*)(bg + cl + 4), bln0 = *(const LAS f32x4*)(bg + 128 + cl), bln1 = *(const LAS f32x4*)(bg + 128 + cl + 4);
        bf16_t* base = act + ((size_t)u.p3 * 256 + wr * 64 + fr) * D + u.p2 * 128 + cl;
#pragma unroll
        for (int ai = 0; ai < 2; ++ai)
#pragma unroll
            for (int m = 0; m < 4; ++m) {
                f32x4 gl0 = acc[ai][0][m][0] + bgl0, gl1 = acc[ai][0][m][1] + bgl1, ln0 = acc[ai][1][m][0] + bln0, ln1 = acc[ai][1][m][1] + bln1;
                f32x4 a0, a1;
#pragma unroll
                for (int j = 0; j < 4; ++j) {
                    const float x0 = fminf(gl0[j], SW_LIMIT), x1 = fminf(gl1[j], SW_LIMIT);
                    const float y0 = fminf(fmaxf(ln0[j], -SW_LIMIT), SW_LIMIT), y1 = fminf(fmaxf(ln1[j], -SW_LIMIT), SW_LIMIT);
                    a0[j] = x0 * sigmoidf_(SW_ALPHA * x0) * (y0 + 1.0f); a1[j] = x1 * sigmoidf_(SW_ALPHA * x1) * (y1 + 1.0f); }
                u32x4 w; w.x = cvt_pk_bf16(a0[0], a0[1]); w.y = cvt_pk_bf16(a0[2], a0[3]); w.z = cvt_pk_bf16(a1[0], a1[1]); w.w = cvt_pk_bf16(a1[2], a1[3]);
                *(u32x4*)(base + (size_t)(ai * 128 + m * 16) * D) = w;
            }
            return -1;
    }
};
struct PolG2 : GemmBase {
    static constexpr int KREP = KREP_G2;
    volatile LAS unsigned* MISC; LAS unsigned char* upa; const bf16_t* act; const bf16_t* wdnt; const float* bdn; const int* lslot; const float* lw; bf16_t* yslot;
    __device__ __forceinline__ int nt() const { return D / 64; }
    __device__ __forceinline__ unsigned ldb_bytes() const { return D * 2; }
    __device__ __forceinline__ bool next(int i, Unit& u) const {
        const int V = i * G + vcu, MT = (int)MISC[MI_TPRE + NE]; if (V >= MT * 4 || i >= 6) return false;
        const int mt = V >> 2, nt_ = V & 3, e = (int)MISC[MI_MT2E + mt];
        u.p0 = e; u.p1 = mt - (int)MISC[MI_TPRE + e]; u.p2 = nt_; u.p3 = mt; u.ui = i;
        u.A = (const char*)(act + (size_t)mt * 256 * D); u.B = (const char*)(wdnt + ((size_t)e * D + (size_t)nt_ * 256) * D); return true; }
    __device__ __forceinline__ void fill(int tid) const {
#pragma unroll
        for (int k = 0; k < 3; ++k) {
            const int j = tid + NTH * k, i = j >> 8, r = j & 255; Unit u;
            if (next(i, u)) {
                const int cnt = (int)MISC[MI_CNT + u.p0], li = u.p1 * 256 + r; const bool ok = li < cnt;
                ((LAS int*)(upa + i * 3072))[r] = ok ? lslot[(size_t)u.p0 * LIST_CAP + li] : -1;
                ((LAS float*)(upa + i * 3072 + 1024))[r] = ok ? lw[(size_t)u.p0 * LIST_CAP + li] : 0.f;
                ((LAS float*)(upa + i * 3072 + 2048))[r] = bdn[(size_t)u.p0 * D + u.p2 * 256 + r];
            }
        }
    }
    __device__ __forceinline__ void aoff(const Unit&, int R0, int C0, unsigned (&off)[4]) const { aoff_lin(R0, C0, D * 2, off); }
    __device__ __forceinline__ int epi(const AccT& acc, const Unit& u, int wr, int wc, int fr, int fq) const {
        const int cl = wc * 32 + 8 * fq;
        const LAS int* sl = (const LAS int*)(upa + u.ui * 3072); const LAS float* wl = (const LAS float*)(upa + u.ui * 3072 + 1024); const LAS float* bd = (const LAS float*)(upa + u.ui * 3072 + 2048);
        f32x4 b[2][2];
#pragma unroll
        for (int bj = 0; bj < 2; ++bj) { b[bj][0] = *(const LAS f32x4*)(bd + cl + bj * 128); b[bj][1] = *(const LAS f32x4*)(bd + cl + bj * 128 + 4); }
#pragma unroll
        for (int ai = 0; ai < 2; ++ai)
#pragma unroll
            for (int m = 0; m < 4; ++m) {
                const int rl = ai * 128 + wr * 64 + m * 16 + fr;
                const int slot = sl[rl]; const float w = wl[rl];
                if (slot >= 0) {
                    bf16_t* yr = yslot + (size_t)slot * D + u.p2 * 256 + cl;
#pragma unroll
                    for (int bj = 0; bj < 2; ++bj) {
                        const f32x4 v0 = (acc[ai][bj][m][0] + b[bj][0]) * w, v1 = (acc[ai][bj][m][1] + b[bj][1]) * w;
                        u32x4 o; o.x = cvt_pk_bf16(v0[0], v0[1]); o.y = cvt_pk_bf16(v0[2], v0[3]); o.z = cvt_pk_bf16(v1[0], v1[1]); o.w = cvt_pk_bf16(v1[2], v1[3]);
                        *(u32x4*)(yr + bj * 128) = o;
                    }
                }
            }
            return -1;
    }
};

typedef unsigned v4u_t __attribute__((ext_vector_type(4)));
template <bool F8>
struct PolMoE : GemmBase {
    static constexpr int KREP = 1;
    static constexpr bool HAS_READY = true;
    static constexpr bool FP8 = F8;
    static constexpr bool SEAM_OPT = true;
    static constexpr int EB = F8 ? 1 : 2;
    volatile LAS unsigned* MISC; LAS unsigned char* upa; const bf16_t* hn; const bf16_t* wgut; const float* bgu; const int* lslot; const float* lw; bf16_t* act;
    const bf16_t* wdnt; const float* bdn; bf16_t* yslot; unsigned* done; unsigned* tmo; __amdgpu_buffer_rsrc_t act_rsrc;
    __device__ __forceinline__ int nt() const { return D * EB / 128; }
    __device__ __forceinline__ unsigned ldb_bytes() const { return D * EB; }
    __device__ __forceinline__ bool next(int i, Unit& u) const {
        const int V = i * G + vcu, MT = (int)MISC[MI_TPRE + NE], N1 = MT * 8; if (i >= 14 || V >= MT * 12) return false;
        u.ui = i;
        if (V < N1) { const int mt = V >> 3, nt_ = V & 7, e = (int)MISC[MI_MT2E + mt];
            u.p0 = e; u.p1 = mt - (int)MISC[MI_TPRE + e]; u.p2 = nt_; u.p3 = mt;
            u.A = (const char*)hn; u.B = (const char*)wgut + ((size_t)e * 2048 + (size_t)nt_ * 256) * D * EB; }
        else { const int V2 = V - N1, mt = V2 >> 2, nt_ = V2 & 3, e = (int)MISC[MI_MT2E + mt];
            u.p0 = e; u.p1 = mt - (int)MISC[MI_TPRE + e]; u.p2 = nt_ | 8; u.p3 = mt;
            u.A = (const char*)act + (size_t)mt * 256 * D * EB; u.B = (const char*)wdnt + ((size_t)e * D + (size_t)nt_ * 256) * D * EB; }
        return true; }
    __device__ __forceinline__ void fill(int tid) const {
#pragma unroll
        for (int k = 0; k < 7; ++k) {
            const int j = tid + NTH * k, i = j >> 8, r = j & 255; Unit u;
            if (next(i, u)) {
                const int cnt = (int)MISC[MI_CNT + u.p0], li = u.p1 * 256 + r; const bool ok = li < cnt;
                if (!(u.p2 & 8)) {
                    ((LAS int*)(upa + i * 2048))[r] = ok ? (lslot[(size_t)u.p0 * LIST_CAP + li] >> 2) : 0;
                    ((LAS float*)(upa + i * 2048 + 1024))[r] = bgu[(size_t)u.p0 * 2048 + (r >> 7) * 1024 + u.p2 * 128 + (r & 127)] + (float)(r >> 7);
                } else {
                    unsigned pk = 0xffff0000u;
                    if (ok) { const unsigned sl = (unsigned)lslot[(size_t)u.p0 * LIST_CAP + li]; const float w = lw[(size_t)u.p0 * LIST_CAP + li]; pk = (sl & 0xffffu) | (cvt_pk_bf16(0.f, w) & 0xffff0000u); }
                    ((LAS unsigned*)(upa + i * 2048))[r] = pk;
                    ((LAS float*)(upa + i * 2048 + 1024))[r] = bdn[(size_t)u.p0 * D + (u.p2 & 7) * 256 + r];
                }
            }
        }
    }
    __device__ __forceinline__ void aoff(const Unit& u, int R0, int C0, unsigned (&off)[4]) const {
        if (!(u.p2 & 8)) { const LAS int* tk = (const LAS int*)(upa + u.ui * 2048);
#pragma unroll
            for (int q = 0; q < 4; ++q) off[q] = (unsigned)tk[R0 + 64 * (q & 1) + 128 * (q >> 1)] * (unsigned)(D * EB) + (unsigned)C0 * 2u;
        } else aoff_lin(R0, C0, D * EB, off);
    }
    __device__ __forceinline__ void flush(int pend) const {
        if (pend >= 0 && (threadIdx.x & 63) == 0) (void)__hip_atomic_fetch_add(done + 64 * pend, 1u, __ATOMIC_RELAXED, __HIP_MEMORY_SCOPE_AGENT);
    }
    __device__ __forceinline__ void a_ready(const Unit& u) const {
        if (!(u.p2 & 8)) return;
        if (threadIdx.x < 64) {
            unsigned* w = done + 64 * u.p3; unsigned polls = 0;
            while ((unsigned)__builtin_amdgcn_readfirstlane(__hip_atomic_load(w, __ATOMIC_RELAXED, __HIP_MEMORY_SCOPE_AGENT)) < 64u) {
                __builtin_amdgcn_s_sleep(2);
                if ((++polls & 1023u) == 0u) { if (__builtin_amdgcn_readfirstlane(__hip_atomic_load(tmo, __ATOMIC_RELAXED, __HIP_MEMORY_SCOPE_AGENT)) != 0u) break;
                    if (polls > (1u << 22)) { if (threadIdx.x == 0) __hip_atomic_store(tmo, 1u, __ATOMIC_RELAXED, __HIP_MEMORY_SCOPE_AGENT); break; } }
            }
            __builtin_amdgcn_fence(__ATOMIC_ACQUIRE, "agent");
            asm volatile("s_waitcnt vmcnt(0)" ::: "memory");
        }
        asm volatile("" ::: "memory"); __builtin_amdgcn_s_barrier(); asm volatile("" ::: "memory");
    }
    __device__ __forceinline__ int epi(const AccT& acc, const Unit& u, int wr, int wc, int fr, int fq) const {
        const int cl = wc * 32 + 8 * fq;
        if (!(u.p2 & 8)) {
            const LAS float* bg = (const LAS float*)(upa + u.ui * 2048 + 1024);
            const f32x4 bgl0 = *(const LAS f32x4*)(bg + cl), bgl1 = *(const LAS f32x4*)(bg + cl + 4), bln0 = *(const LAS f32x4*)(bg + 128 + cl), bln1 = *(const LAS f32x4*)(bg + 128 + cl + 4);
            const unsigned boff = (unsigned)((((size_t)u.p3 * 256 + wr * 64 + fr) * D + u.p2 * 128 + cl) * EB);
            constexpr float ws = F8 ? (1.0f / W8_SCALE) : 1.0f;
#pragma unroll
            for (int ai = 0; ai < 2; ++ai)
#pragma unroll
                for (int m = 0; m < 4; ++m) {
                    const f32x2 p0 = swiglu2(acc[ai][0][m][0].xy, acc[ai][1][m][0].xy, bgl0.xy, bln0.xy, ws), p1 = swiglu2(acc[ai][0][m][0].zw, acc[ai][1][m][0].zw, bgl0.zw, bln0.zw, ws);
                    const f32x2 p2 = swiglu2(acc[ai][0][m][1].xy, acc[ai][1][m][1].xy, bgl1.xy, bln1.xy, ws), p3 = swiglu2(acc[ai][0][m][1].zw, acc[ai][1][m][1].zw, bgl1.zw, bln1.zw, ws);
                    const f32x4 a0 = {p0.x, p0.y, p1.x, p1.y}, a1 = {p2.x, p2.y, p3.x, p3.y};
                    if constexpr (F8) { u32x2 w8 = {pack_fp8x4(a0[0], a0[1], a0[2], a0[3]), pack_fp8x4(a1[0], a1[1], a1[2], a1[3])};
                        __builtin_amdgcn_raw_buffer_store_b64(w8, act_rsrc, boff + (unsigned)((ai * 128 + m * 16) * D), 0,   16); }
                    else { v4u_t w; w.x = cvt_pk_bf16(a0[0], a0[1]); w.y = cvt_pk_bf16(a0[2], a0[3]); w.z = cvt_pk_bf16(a1[0], a1[1]); w.w = cvt_pk_bf16(a1[2], a1[3]);
                        __builtin_amdgcn_raw_buffer_store_b128(w, act_rsrc, boff + (unsigned)((ai * 128 + m * 16) * D * 2), 0,   16); }
                }
            return u.p3;
        } else {
            const LAS unsigned* sl = (const LAS unsigned*)(upa + u.ui * 2048); const LAS float* bd = (const LAS float*)(upa + u.ui * 2048 + 1024);
            f32x4 b[2][2];
#pragma unroll
            for (int bj = 0; bj < 2; ++bj) { b[bj][0] = *(const LAS f32x4*)(bd + cl + bj * 128); b[bj][1] = *(const LAS f32x4*)(bd + cl + bj * 128 + 4); }
#pragma unroll
            for (int ai = 0; ai < 2; ++ai)
#pragma unroll
                for (int m = 0; m < 4; ++m) {
                    const unsigned pk = sl[ai * 128 + wr * 64 + m * 16 + fr];
                    if ((pk >> 16) != 0xffffu) {
                        const float w = bfhi(pk); constexpr float ws = F8 ? (1.0f / W8_SCALE) : 1.0f;
                        bf16_t* yr = yslot + (size_t)(pk & 0xffffu) * D + (u.p2 & 7) * 256 + cl;
#pragma unroll
                        for (int bj = 0; bj < 2; ++bj) {
                            const f32x4 v0 = (acc[ai][bj][m][0] * ws + b[bj][0]) * w, v1 = (acc[ai][bj][m][1] * ws + b[bj][1]) * w;
                            u32x4 o; o.x = cvt_pk_bf16(v0[0], v0[1]); o.y = cvt_pk_bf16(v0[2], v0[3]); o.z = cvt_pk_bf16(v1[0], v1[1]); o.w = cvt_pk_bf16(v1[2], v1[3]);
                            *(u32x4*)(yr + bj * 128) = o;
                        }
                    }
                }
        }
            return -1;
    }
};

template <class P> __device__ __forceinline__ void run_gemm(Frame& F, const P& S) {
#if SIMPLE_GEMM
    pg8::gemm_simple<P>(F.lds, S);
#else
    pg8::gemm_pipe<P>(F.lds, S);
#endif
}

constexpr int LA_QA = 0, LA_QH = 17408, LA_KA = 34816, LA_VT = 52224, LA_AS = 70656, LA_ST = 79872, LA_QS = 114688, LA_PS = 118784;
constexpr int RS128 = 272, RS64 = 144;
__device__ __forceinline__ float ret_lg(int hh) { return __logf(1.0f - exp2f(-5.0f - (float)(hh - 4))); }
__device__ __forceinline__ u32x4 pack8(const float (&v)[8]) { return (u32x4){cvt_pk_bf16(v[0], v[1]), cvt_pk_bf16(v[2], v[3]), cvt_pk_bf16(v[4], v[5]), cvt_pk_bf16(v[6], v[7])}; }

__device__ __forceinline__ void la_cumsum(const float* gbuf, int hh, int t0, int d0, float (&b0)[8], float (&b1)[8]) {
    if (hh < 4) { float r0 = 0.f, r1 = 0.f;
#pragma unroll
        for (int i = 0; i < 8; ++i) { const f32x2 g = *(const f32x2*)(gbuf + (size_t)(t0 + i) * 512 + hh * 128 + d0); r0 += g.x; r1 += g.y; b0[i] = r0; b1[i] = r1; }
    } else { const float lg = ret_lg(hh);
#pragma unroll
        for (int i = 0; i < 8; ++i) { b0[i] = (float)(i + 1) * lg; b1[i] = b0[i]; }
    }
}

struct LaIn { f32x2 g[8]; unsigned qq[8], kk[8], vv[8]; u32x4 st[4]; u32x2 gt[4]; };
template <bool OUT>
__device__ __forceinline__ void la_load(LaIn& in, const bf16_t* qkvg, const _Float16* gbuf, const bf16_t* sprev, int unit, int oc, int d0, int tid) {
    const int hh = unit >> 8, n = unit & 255, t0 = n * 64 + oc * 8;
    if (hh < 4) {
#pragma unroll
        for (int i = 0; i < 8; ++i) { const h16x2 gh = *(const h16x2*)(gbuf + (size_t)(t0 + i) * 512 + hh * 128 + d0); in.g[i] = (f32x2){(float)gh.x, (float)gh.y}; }
    }
#pragma unroll
    for (int i = 0; i < 8; ++i) { const bf16_t* row = qkvg + (size_t)(t0 + i) * INW + hh * 128 + d0; if (OUT) in.qq[i] = *(const unsigned*)row; in.kk[i] = *(const unsigned*)(row + 1024); in.vv[i] = *(const unsigned*)(row + 2048); }
    if (OUT) {
        const bf16_t* sp = sprev + ((size_t)hh * 256 + n) * 16384;
#pragma unroll
        for (int j = 0; j < 4; ++j) { const int c = tid + NTH * j; in.st[j] = *(const u32x4*)(sp + (c >> 4) * 128 + (c & 15) * 8); }
        const int lane = tid & 63, fr = lane & 15, fq = lane >> 4, tt = oc >> 1, eh = oc & 1;
#pragma unroll
        for (int ei = 0; ei < 4; ++ei) in.gt[ei] = *(const u32x2*)(qkvg + (size_t)(n * 64 + 16 * tt + fr) * INW + 3072 + hh * 128 + 16 * (4 * eh + ei) + 4 * fq);
    }
}
__device__ __forceinline__ void la_cumsum_in(const LaIn& in, int hh, float (&b0)[8], float (&b1)[8]) {
    if (hh < 4) { float r0 = 0.f, r1 = 0.f;
#pragma unroll
        for (int i = 0; i < 8; ++i) { r0 += in.g[i].x; r1 += in.g[i].y; b0[i] = r0; b1[i] = r1; }
    } else { const float lg = ret_lg(hh);
#pragma unroll
        for (int i = 0; i < 8; ++i) { b0[i] = (float)(i + 1) * lg; b1[i] = b0[i]; }
    }
}

__device__ __forceinline__ void la_local_state(Frame& F) {
    const bf16_t* qkvg = WSP(F, WS_QKVG, bf16_t); const _Float16* gbuf = WSP(F, WS_GBUF, _Float16); bf16_t* kvt = WSP(F, WS_KVT, bf16_t); float* dec = WSP(F, WS_DEC, float);
    LAS unsigned char* lds = F.lds; LAS float* qs = (LAS float*)(lds + LA_QS);
    const int lane = F.lane, oc = F.wave, d0 = 2 * lane, fr = lane & 15, fq = lane >> 4;
    LaIn nx;
    if (F.vcu < 2048) la_load<false>(nx, qkvg, gbuf, nullptr, F.vcu, oc, d0, F.tid);
    for (int unit = F.vcu; unit < 2048; unit += F.G) {
        const int hh = unit >> 8, n = unit & 255;
        const LaIn in = nx;
        if (unit + F.G < 2048) la_load<false>(nx, qkvg, gbuf, nullptr, unit + F.G, oc, d0, F.tid);
        float b0[8], b1[8]; la_cumsum_in(in, hh, b0, b1);
        *(LAS f32x2*)(qs + oc * 128 + d0) = (f32x2){b0[7], b1[7]};
        const unsigned (&kk)[8] = in.kk; const unsigned (&vv)[8] = in.vv;
        __syncthreads();
        float base0 = 0.f, base1 = 0.f, tot0 = 0.f, tot1 = 0.f;
#pragma unroll
        for (int o = 0; o < 8; ++o) { const f32x2 q = *(const LAS f32x2*)(qs + o * 128 + d0); if (o < oc) { base0 += q.x; base1 += q.y; } tot0 += q.x; tot1 += q.y; }
        float a0[8], a1[8], c0[8], c1[8];
#pragma unroll
        for (int i = 0; i < 8; ++i) { a0[i] = bflo(kk[i]) * __expf(tot0 - base0 - b0[i]); a1[i] = bfhi(kk[i]) * __expf(tot1 - base1 - b1[i]); c0[i] = bflo(vv[i]); c1[i] = bfhi(vv[i]); }
        *(LAS u32x4*)(lds + LA_QA + d0 * RS64 + oc * 16) = pack8(a0); *(LAS u32x4*)(lds + LA_QA + (d0 + 1) * RS64 + oc * 16) = pack8(a1);
        *(LAS u32x4*)(lds + LA_VT + d0 * RS64 + oc * 16) = pack8(c0); *(LAS u32x4*)(lds + LA_VT + (d0 + 1) * RS64 + oc * 16) = pack8(c1);
        if (oc == 0) *(f32x2*)(dec + ((size_t)hh * 256 + n) * 128 + d0) = (f32x2){__expf(tot0), __expf(tot1)};
        __syncthreads();
        const int et = oc;
        bf16x8 vt[2];
#pragma unroll
        for (int ks = 0; ks < 2; ++ks) vt[ks] = *(const LAS bf16x8*)(lds + LA_VT + (16 * et + fr) * RS64 + (32 * ks + 8 * fq) * 2);
        bf16_t* orow = kvt + (((size_t)hh * 256 + n) * 128 + 16 * et + fr) * 128 + 4 * fq;
#pragma unroll
        for (int dt = 0; dt < 8; ++dt) {
            f32x4 acc = {0.f, 0.f, 0.f, 0.f};
#pragma unroll
            for (int ks = 0; ks < 2; ++ks) { const bf16x8 a = *(const LAS bf16x8*)(lds + LA_QA + (16 * dt + fr) * RS64 + (32 * ks + 8 * fq) * 2); acc = __builtin_amdgcn_mfma_f32_16x16x32_bf16(a, vt[ks], acc, 0, 0, 0); }
            *(u32x2*)(orow + 16 * dt) = (u32x2){cvt_pk_bf16(acc[0], acc[1]), cvt_pk_bf16(acc[2], acc[3])};
        }
        __syncthreads();
    }
}

__device__ __forceinline__ void la_scan(Frame& F) {
    const bf16_t* kvt = WSP(F, WS_KVT, bf16_t); const float* dec = WSP(F, WS_DEC, float); bf16_t* sprev = WSP(F, WS_SPREV, bf16_t);
    for (int idx = F.vcu * NTH + F.tid; idx < 8 * 16384; idx += F.G * NTH) {
        const int hh = idx >> 14, rem = idx & 16383, d = rem & 127;
        const bf16_t* kv = kvt + (size_t)hh * 256 * 16384 + rem; const float* dc = dec + (size_t)hh * 256 * 128 + d; bf16_t* sp = sprev + (size_t)hh * 256 * 16384 + rem;
        float S = 0.f;
        for (int n0 = 0; n0 < 256; n0 += 16) {
            float kvv[16], dd[16];
#pragma unroll
            for (int i = 0; i < 16; ++i) { kvv[i] = bf2f(kv[(size_t)(n0 + i) * 16384]); dd[i] = dc[(n0 + i) * 128]; }
#pragma unroll
            for (int i = 0; i < 16; ++i) { sp[(size_t)(n0 + i) * 16384] = (bf16_t)(cvt_pk_bf16(S, 0.f) & 0xffffu); S = dd[i] * S + kvv[i]; }
        }
    }
}

__device__ __forceinline__ void la_output(Frame& F) {
    const bf16_t* qkvg = WSP(F, WS_QKVG, bf16_t); const _Float16* gbuf = WSP(F, WS_GBUF, _Float16); const bf16_t* sprev = WSP(F, WS_SPREV, bf16_t); bf16_t* cat = WSP(F, WS_CAT, bf16_t);
    LAS unsigned char* lds = F.lds; LAS float* qs = (LAS float*)(lds + LA_QS); LAS float* ps = (LAS float*)(lds + LA_PS);
    const int tid = F.tid, lane = F.lane, oc = F.wave, d0 = 2 * lane, fr = lane & 15, fq = lane >> 4;
    LaIn nx;
    if (F.vcu < 2048) la_load<true>(nx, qkvg, gbuf, sprev, F.vcu, oc, d0, tid);
    for (int unit = F.vcu; unit < 2048; unit += F.G) {
        const int hh = unit >> 8, n = unit & 255;
        const LaIn in = nx;
        if (unit + F.G < 2048) la_load<true>(nx, qkvg, gbuf, sprev, unit + F.G, oc, d0, tid);
        float b0[8], b1[8]; la_cumsum_in(in, hh, b0, b1);
        *(LAS f32x2*)(qs + oc * 128 + d0) = (f32x2){b0[7], b1[7]};
        const unsigned (&qq)[8] = in.qq; const unsigned (&kk)[8] = in.kk; const unsigned (&vv)[8] = in.vv;
#pragma unroll
        for (int j = 0; j < 4; ++j) { const int c = tid + NTH * j; *(LAS u32x4*)(lds + LA_ST + (c >> 4) * RS128 + (c & 15) * 16) = in.st[j]; }
        __syncthreads();
        float base0 = 0.f, base1 = 0.f, bm0 = 0.f, bm1 = 0.f;
#pragma unroll
        for (int o = 0; o < 8; ++o) { const f32x2 q = *(const LAS f32x2*)(qs + o * 128 + d0); if (o < oc) { base0 += q.x; base1 += q.y; } if (o < 4) { bm0 += q.x; bm1 += q.y; } }
        float c0[8], c1[8];
#pragma unroll
        for (int i = 0; i < 8; ++i) {
            const int t = 8 * oc + i; const float bt0 = base0 + b0[i], bt1 = base1 + b1[i];
            const float q0 = bflo(qq[i]), q1 = bfhi(qq[i]), k0 = bflo(kk[i]), k1 = bfhi(kk[i]);
            *(LAS unsigned*)(lds + LA_QA + t * RS128 + d0 * 2) = cvt_pk_bf16(q0 * __expf(bt0 - bm0), q1 * __expf(bt1 - bm1));
            *(LAS unsigned*)(lds + LA_QH + t * RS128 + d0 * 2) = cvt_pk_bf16(q0 * __expf(bt0), q1 * __expf(bt1));
            *(LAS unsigned*)(lds + LA_KA + t * RS128 + d0 * 2) = cvt_pk_bf16(k0 * __expf(bm0 - bt0), k1 * __expf(bm1 - bt1));
            c0[i] = bflo(vv[i]); c1[i] = bfhi(vv[i]);
        }
        *(LAS u32x4*)(lds + LA_VT + d0 * RS64 + oc * 16) = pack8(c0); *(LAS u32x4*)(lds + LA_VT + (d0 + 1) * RS64 + oc * 16) = pack8(c1);
        __syncthreads();
        const int tt = oc >> 1, eh = oc & 1;
        {
            bf16x8 qf[4];
#pragma unroll
            for (int ks = 0; ks < 4; ++ks) qf[ks] = *(const LAS bf16x8*)(lds + LA_QA + (16 * tt + fr) * RS128 + (32 * ks + 8 * fq) * 2);
#pragma unroll
            for (int sti = 0; sti < 2; ++sti) {
                const int st = 2 * eh + sti;
                f32x4 acc = {0.f, 0.f, 0.f, 0.f};
                if (st <= tt) {
#pragma unroll
                    for (int ks = 0; ks < 4; ++ks) { const bf16x8 a = *(const LAS bf16x8*)(lds + LA_KA + (16 * st + fr) * RS128 + (32 * ks + 8 * fq) * 2); acc = __builtin_amdgcn_mfma_f32_16x16x32_bf16(a, qf[ks], acc, 0, 0, 0); }
                    if (st == tt) {
#pragma unroll
                        for (int r = 0; r < 4; ++r) if (4 * fq + r > fr) acc[r] = 0.f;
                    }
                }
                *(LAS u32x2*)(lds + LA_AS + (16 * tt + fr) * RS64 + (16 * st + 4 * fq) * 2) = (u32x2){cvt_pk_bf16(acc[0], acc[1]), cvt_pk_bf16(acc[2], acc[3])};
            }
        }
        __syncthreads();
        f32x4 o[4]; float ss = 0.f;
        {
            bf16x8 af[2], hf[4];
#pragma unroll
            for (int ks = 0; ks < 2; ++ks) af[ks] = *(const LAS bf16x8*)(lds + LA_AS + (16 * tt + fr) * RS64 + (32 * ks + 8 * fq) * 2);
#pragma unroll
            for (int ks = 0; ks < 4; ++ks) hf[ks] = *(const LAS bf16x8*)(lds + LA_QH + (16 * tt + fr) * RS128 + (32 * ks + 8 * fq) * 2);
#pragma unroll
            for (int ei = 0; ei < 4; ++ei) {
                const int et = 4 * eh + ei;
                f32x4 acc = {0.f, 0.f, 0.f, 0.f};
#pragma unroll
                for (int ks = 0; ks < 2; ++ks) { const bf16x8 a = *(const LAS bf16x8*)(lds + LA_VT + (16 * et + fr) * RS64 + (32 * ks + 8 * fq) * 2); acc = __builtin_amdgcn_mfma_f32_16x16x32_bf16(a, af[ks], acc, 0, 0, 0); }
#pragma unroll
                for (int ks = 0; ks < 4; ++ks) { const bf16x8 a = *(const LAS bf16x8*)(lds + LA_ST + (16 * et + fr) * RS128 + (32 * ks + 8 * fq) * 2); acc = __builtin_amdgcn_mfma_f32_16x16x32_bf16(a, hf[ks], acc, 0, 0, 0); }
                o[ei] = acc; ss += (acc[0] * acc[0] + acc[1] * acc[1]) + (acc[2] * acc[2] + acc[3] * acc[3]);
            }
        }
        ss += __shfl_xor(ss, 16); ss += __shfl_xor(ss, 32);
        if (lane < 16) ps[(tt * 2 + eh) * 16 + lane] = ss;
        __syncthreads();
        const float tot = ps[(tt * 2) * 16 + fr] + ps[(tt * 2 + 1) * 16 + fr];
        const float rstd = rsqrtf(tot * (1.f / 128.f) + EPS);
        const float* gain = (hh < 4) ? (inptr(6) + hh * 128) : (inptr(7) + (hh - 4) * 128);
        const size_t rowi = (size_t)(n * 64 + 16 * tt + fr);
#pragma unroll
        for (int ei = 0; ei < 4; ++ei) {
            const int e0 = 16 * (4 * eh + ei) + 4 * fq;
            const f32x4 gn = *(const f32x4*)(gain + e0);
            const u32x2 gt = in.gt[ei];
            const f32x4 v = o[ei] * rstd * gn;
            *(u32x2*)(cat + rowi * D + hh * 128 + e0) = (u32x2){cvt_pk_bf16(v[0] * bflo(gt.x), v[1] * bfhi(gt.x)), cvt_pk_bf16(v[2] * bflo(gt.y), v[3] * bfhi(gt.y))};
        }
        __syncthreads();
    }
}

constexpr int RT_STRIDE = 2064, RT_PART = 32 * RT_STRIDE;
__device__ __forceinline__ void sel4of8(float (&v)[8], const int (&ix)[8], float (&tv)[4], int (&ti)[4]) {
#pragma unroll
    for (int k = 0; k < 4; ++k) {
        float best = v[0]; int bi = ix[0];
#pragma unroll
        for (int q = 1; q < 8; ++q) { const bool better = (v[q] > best) || (v[q] == best && ix[q] < bi); best = better ? v[q] : best; bi = better ? ix[q] : bi; }
        tv[k] = best; ti[k] = bi;
#pragma unroll
        for (int q = 0; q < 8; ++q) v[q] = (ix[q] == bi) ? -INFINITY : v[q];
    }
}
__device__ __forceinline__ void p_route(Frame& F, int layer, const bf16_t* X, int aux = 0) {
    const int tid = F.tid, lane = F.lane;
    LAS unsigned char* lds = F.lds;
    LAS float* ssq = (LAS float*)(lds + 2 * RT_PART);
    LAS f32x4* lgx = (LAS f32x4*)(lds + 2 * RT_PART + 512);
    LAS int* pe = (LAS int*)(lds + 2 * RT_PART + 512 + 8192);
    LAS float* pw = (LAS float*)(pe + 256);
    LAS int* hist = (LAS int*)(pw + 256);
    LAS int* gbase = hist + 32;
    {
        const bf16_t* rt = WSP(F, WS_RT, bf16_t) + (size_t)layer * 2 * 32 * D;
#pragma unroll 4
        for (int j = 0; j < 16; ++j) { const int ch = tid + NTH * j, part = ch >> 12, row = (ch >> 7) & 31, c16 = ch & 127;
            *(LAS u32x4*)(lds + part * RT_PART + row * RT_STRIDE + c16 * 16) = *(const u32x4*)(rt + ((size_t)(part * 32 + row) * D + c16 * 8)); }
    }
    const float* mod = WSP(F, WS_MOD, float) + (size_t)layer * 6 * D;
    int* lslot = WSP(F, WS_LSLOT, int) + (size_t)layer * NE * LIST_CAP; float* lw = WSP(F, WS_LW, float) + (size_t)layer * NE * LIST_CAP;
    if (aux) { lslot = (int*)(F.ws + WS_END); lw = (float*)(F.ws + WS_END + 4 * MiB); }
    unsigned* cntw = F.ctl + CW_CNT + 64 * (layer + 2 * aux);
    const int tile = F.wave & 3, kh = F.wave >> 2, tk = lane & 15, kq = lane >> 4;
    const float* brt = inptr(13) + layer * NE;
    __syncthreads();
    for (int tb = F.vcu; tb < T / 64; tb += F.G) {
        if (tid < 32) hist[tid] = 0;
        const int row = tb * 64 + tile * 16 + tk;
        const bf16_t* xr = X + (size_t)row * D + kh * 512 + 8 * kq;
        float ss = 0.f;
#pragma unroll 8
        for (int s = 0; s < 16; ++s) { const u32x4 q = *(const u32x4*)(xr + 32 * s);
            const f32x4 a = {bflo(q.x), bfhi(q.x), bflo(q.y), bfhi(q.y)}, b = {bflo(q.z), bfhi(q.z), bflo(q.w), bfhi(q.w)};
            ss += (a.x * a.x + a.y * a.y) + (a.z * a.z + a.w * a.w) + (b.x * b.x + b.y * b.y) + (b.z * b.z + b.w * b.w); }
        ss += __shfl_xor(ss, 16); ss += __shfl_xor(ss, 32);
        if (kq == 0) ssq[F.wave * 16 + tk] = ss;
        __syncthreads();
        const float rstd = rsqrtf((ssq[tile * 16 + tk] + ssq[(tile + 4) * 16 + tk]) * (1.f / D) + EPS);
        f32x4 acc[2] = {{0.f, 0.f, 0.f, 0.f}, {0.f, 0.f, 0.f, 0.f}};
        bf16_t* hrow = WSP(F, WS_HN, bf16_t) + (size_t)row * D;
#pragma unroll 2
        for (int s = 0; s < 16; ++s) {
            const int col = kh * 512 + 32 * s + 8 * kq;
            const u32x4 q = *(const u32x4*)(xr + 32 * s);
            const f32x4 a = {bflo(q.x), bfhi(q.x), bflo(q.y), bfhi(q.y)}, b = {bflo(q.z), bfhi(q.z), bflo(q.w), bfhi(q.w)};
            const f32x4 sc0 = *(const f32x4*)(mod + 4 * D + col) + 1.0f, sc1 = *(const f32x4*)(mod + 4 * D + col + 4) + 1.0f;
            const f32x4 sh0 = *(const f32x4*)(mod + 3 * D + col), sh1 = *(const f32x4*)(mod + 3 * D + col + 4);
            const f32x4 h0 = a * rstd * sc0 + sh0, h1 = b * rstd * sc1 + sh1;
            u32x4 hi; hi.x = cvt_pk_bf16(h0.x, h0.y); hi.y = cvt_pk_bf16(h0.z, h0.w); hi.z = cvt_pk_bf16(h1.x, h1.y); hi.w = cvt_pk_bf16(h1.z, h1.w);
            if ((FP8_LAYERS >> layer) & 1) *(u32x2*)(WSP(F, WS_HN8, unsigned char) + (size_t)row * D + col) = (u32x2){pack_fp8x4(h0.x, h0.y, h0.z, h0.w), pack_fp8x4(h1.x, h1.y, h1.z, h1.w)};
            else *(u32x4*)(hrow + col) = hi;
            u32x4 lo; lo.x = cvt_pk_bf16(h0.x - bflo(hi.x), h0.y - bfhi(hi.x)); lo.y = cvt_pk_bf16(h0.z - bflo(hi.y), h0.w - bfhi(hi.y));
            lo.z = cvt_pk_bf16(h1.x - bflo(hi.z), h1.y - bfhi(hi.z)); lo.w = cvt_pk_bf16(h1.z - bflo(hi.w), h1.w - bfhi(hi.w));
            const bf16x8 bh = __builtin_bit_cast(bf16x8, hi), bl = __builtin_bit_cast(bf16x8, lo);
#pragma unroll
            for (int et = 0; et < 2; ++et) {
                const bf16x8 wh = *(const LAS bf16x8*)(lds + (16 * et + tk) * RT_STRIDE + col * 2);
                const bf16x8 wl = *(const LAS bf16x8*)(lds + RT_PART + (16 * et + tk) * RT_STRIDE + col * 2);
                acc[et] = __builtin_amdgcn_mfma_f32_16x16x32_bf16(wh, bh, acc[et], 0, 0, 0);
                acc[et] = __builtin_amdgcn_mfma_f32_16x16x32_bf16(wl, bh, acc[et], 0, 0, 0);
                acc[et] = __builtin_amdgcn_mfma_f32_16x16x32_bf16(wh, bl, acc[et], 0, 0, 0);
            }
        }
        if (kh == 1) { lgx[(tile * 2 + 0) * 64 + lane] = acc[0]; lgx[(tile * 2 + 1) * 64 + lane] = acc[1]; }
        __syncthreads();
        if (kh == 0) {
            float cv[8]; int ci[8];
#pragma unroll
            for (int et = 0; et < 2; ++et) { const f32x4 o = lgx[(tile * 2 + et) * 64 + lane]; const f32x4 bb = *(const f32x4*)(brt + 16 * et + 4 * kq);
#pragma unroll
                for (int r = 0; r < 4; ++r) { cv[et * 4 + r] = acc[et][r] + o[r] + bb[r]; ci[et * 4 + r] = 16 * et + 4 * kq + r; } }
            float tv[4]; int ti[4];
            sel4of8(cv, ci, tv, ti);
#pragma unroll
            for (int off = 16; off <= 32; off <<= 1) {
                float mv[8]; int mi[8];
#pragma unroll
                for (int k = 0; k < 4; ++k) { mv[k] = tv[k]; mi[k] = ti[k]; mv[4 + k] = __shfl_xor(tv[k], off); mi[4 + k] = __shfl_xor(ti[k], off); }
                sel4of8(mv, mi, tv, ti);
            }
            const float e1 = __expf(tv[1] - tv[0]), e2 = __expf(tv[2] - tv[0]), e3 = __expf(tv[3] - tv[0]); const float inv = 1.0f / (1.0f + e1 + e2 + e3);
            if (kq == 0) { const int tl = tile * 16 + tk;
                pe[tl * 4 + 0] = ti[0]; pe[tl * 4 + 1] = ti[1]; pe[tl * 4 + 2] = ti[2]; pe[tl * 4 + 3] = ti[3];
                pw[tl * 4 + 0] = inv; pw[tl * 4 + 1] = e1 * inv; pw[tl * 4 + 2] = e2 * inv; pw[tl * 4 + 3] = e3 * inv; }
        }
        __syncthreads();
        int myexp = 0, lpos = 0;
        if (tid < 256) { myexp = pe[tid]; lpos = __hip_atomic_fetch_add(hist + myexp, 1, __ATOMIC_RELAXED, __HIP_MEMORY_SCOPE_WORKGROUP); }
        __syncthreads();
        if (tid < 32) gbase[tid] = (int)atomicAdd(cntw + tid, (unsigned)hist[tid]);
        __syncthreads();
        if (tid < 256) { const int pos = gbase[myexp] + lpos; if (pos < LIST_CAP) { lslot[(size_t)myexp * LIST_CAP + pos] = tb * 256 + tid; lw[(size_t)myexp * LIST_CAP + pos] = pw[tid]; } }
        __syncthreads();
    }
}

template <int MODE>
__device__ __forceinline__ void p_combine(Frame& F, int layer, const bf16_t* Xin, void* Xout_) {
    const int lane = F.lane;
    const float* mod = WSP(F, WS_MOD, float) + (size_t)layer * 6 * D;
    const bf16_t* ys = WSP(F, WS_YSLOT, bf16_t);
    f32x4 gf[4], fnw[4];
#pragma unroll
    for (int j = 0; j < 4; ++j) { gf[j] = *(const f32x4*)(mod + 5 * D + 4 * lane + 256 * j); if (MODE == 1) fnw[j] = *(const f32x4*)(inptr(18) + 4 * lane + 256 * j); }
    for (int it = 0; it < (T / 64 + F.G - 1) / F.G * 8; ++it) {
        const int row = ((it >> 3) * F.G + F.vcu) * 64 + F.wave * 8 + (it & 7); if (row >= T) break;
        const u32x2* xr = (const u32x2*)(Xin + (size_t)row * D) + lane;
        f32x4 v[4]; float s = 0.f;
#pragma unroll
        for (int j = 0; j < 4; ++j) {
            f32x4 a = {0.f, 0.f, 0.f, 0.f};
#pragma unroll
            for (int k = 0; k < 4; ++k) { const u32x2 y = *((const u32x2*)(ys + ((size_t)row * 4 + k) * D) + lane + 64 * j); a += (f32x4){bflo(y.x), bfhi(y.x), bflo(y.y), bfhi(y.y)}; }
            const u32x2 xq = xr[64 * j];
            v[j] = (f32x4){bflo(xq.x), bfhi(xq.x), bflo(xq.y), bfhi(xq.y)} + gf[j] * a;
            if (MODE == 0) { const u32x2 w = {cvt_pk_bf16(v[j].x, v[j].y), cvt_pk_bf16(v[j].z, v[j].w)};
                ((u32x2*)((bf16_t*)Xout_ + (size_t)row * D) + lane)[64 * j] = w; v[j] = (f32x4){bflo(w.x), bfhi(w.x), bflo(w.y), bfhi(w.y)}; }
            s += (v[j].x * v[j].x + v[j].y * v[j].y) + (v[j].z * v[j].z + v[j].w * v[j].w);
        }
        const float rstd = rsqrtf(wave_sum(s) * (1.f / D) + EPS);
        if (MODE == 0) { if (lane == 0) WSP(F, WS_RSTD, float)[row] = rstd; }
        else { f32x4* o = (f32x4*)((float*)Xout_ + (size_t)row * D) + lane;
#pragma unroll
            for (int j = 0; j < 4; ++j) __builtin_nontemporal_store(v[j] * rstd * fnw[j], o + 64 * j);
        }
    }
}

template <int W>
__device__ __forceinline__ void pool_unit(const bf16_t* X, const float* rs, bf16_t* P, int c, int t0, float sh, float sc) {
    float hp[16], hc[16];
#pragma unroll
    for (int i = 0; i < 16; ++i) { const int t = t0 - 16 + i; hp[i] = (i >= 16 - (W - 1) && t >= 0) ? bf2f(X[(size_t)t * D + c]) * rs[t] * sc + sh : 0.f; }
    float sum = 0.f;
#pragma unroll
    for (int i = 1; i < W; ++i) sum += hp[16 - i];
#pragma unroll
    for (int blk = 0; blk < 2; ++blk) {
        const int tb = t0 + 16 * blk;
#pragma unroll
        for (int i = 0; i < 16; ++i) hc[i] = bf2f(X[(size_t)(tb + i) * D + c]) * rs[tb + i] * sc + sh;
#pragma unroll
        for (int i = 0; i < 16; ++i) {
            const int t = tb + i;
            sum += hc[i];
            const int cnt = (t + 1 < W) ? (t + 1) : W;
            const float p = sum / (float)cnt - hc[i];
            P[(size_t)t * D + c] = (bf16_t)(cvt_pk_bf16(p, 0.f) & 0xffffu);
            sum -= (i - (W - 1) >= 0) ? hc[(i - (W - 1)) & 15] : hp[(16 + i - (W - 1)) & 15];
        }
#pragma unroll
        for (int i = 0; i < 16; ++i) hp[i] = hc[i];
    }
}
__device__ __forceinline__ void p_pool(Frame& F, const bf16_t* X) {
    const float* mod = WSP(F, WS_MOD, float) + (size_t)1 * 6 * D; const float* rs = WSP(F, WS_RSTD, float); bf16_t* P = WSP(F, WS_HN, bf16_t);
    const int tid = F.tid;
    for (int u = F.vcu; u < 1024; u += F.G) {
        const int tt = u >> 2, g = u & 3;
        const int c = g * 256 + (tid & 255), t0 = tt * 64 + (tid >> 8) * 32;
        const float sh = mod[0 * D + c], sc = 1.0f + mod[1 * D + c];
        if (g == 0) pool_unit<2>(X, rs, P, c, t0, sh, sc);
        else if (g == 1) pool_unit<4>(X, rs, P, c, t0, sh, sc);
        else if (g == 2) pool_unit<8>(X, rs, P, c, t0, sh, sc);
        else pool_unit<16>(X, rs, P, c, t0, sh, sc);
    }
}

constexpr int PG_STRIDE = 2064;
constexpr int PG_RS = 64 * PG_STRIDE;
template <int W>
__device__ __forceinline__ void pool_pair(const bf16_t* xcol, const LAS float* rsl, LAS unsigned* Pd, int t0, f32x2 sh, f32x2 sc) {
    f32x2 hp[16], hc[16];
#pragma unroll
    for (int i = 0; i < 16; ++i) { const int t = t0 - 16 + i; hp[i] = (f32x2){0.f, 0.f};
        if (i >= 16 - (W - 1) && t >= 0) { const unsigned q = *(const unsigned*)(xcol + (size_t)t * D); hp[i] = (f32x2){bflo(q), bfhi(q)} * rsl[i] * sc + sh; } }
    f32x2 sum = {0.f, 0.f};
#pragma unroll
    for (int i = 1; i < W; ++i) sum += hp[16 - i];
#pragma unroll 2
    for (int blk = 0; blk < 4; ++blk) {
        const int tb = t0 + 16 * blk;
#pragma unroll
        for (int i = 0; i < 16; ++i) { const unsigned q = *(const unsigned*)(xcol + (size_t)(tb + i) * D); hc[i] = (f32x2){bflo(q), bfhi(q)} * rsl[16 + 16 * blk + i] * sc + sh; }
#pragma unroll
        for (int i = 0; i < 16; ++i) {
            const int t = tb + i;
            sum += hc[i];
            const float inv = 1.0f / (float)((t + 1 < W) ? (t + 1) : W);
            const f32x2 p = sum * inv - hc[i];
            Pd[(size_t)(16 * blk + i) * (PG_STRIDE / 4)] = cvt_pk_bf16(p.x, p.y);
            sum -= (i - (W - 1) >= 0) ? hc[(i - (W - 1)) & 15] : hp[(16 + i - (W - 1)) & 15];
        }
#pragma unroll
        for (int i = 0; i < 16; ++i) hp[i] = hc[i];
    }
}
__device__ __forceinline__ void p_pool_gemm(Frame& F, const bf16_t* X2, bf16_t* X1) {
    const float* mod = WSP(F, WS_MOD, float) + (size_t)1 * 6 * D; const float* rs = WSP(F, WS_RSTD, float); const bf16_t* pwt = WSP(F, WS_POOLT, bf16_t);
    const float* pb = inptr(10); const float* psc = inptr(11);
    LAS unsigned char* lds = F.lds; LAS float* rsl = (LAS float*)(lds + PG_RS);
    const int tid = F.tid, lane = F.lane, w = F.wave, fr = lane & 15, fq = lane >> 4;
    for (int tb = F.vcu; tb < T / 64; tb += F.G) {
        const int t0 = tb * 64;
        if (tid < 80) { const int t = t0 - 16 + tid; rsl[tid] = (t >= 0) ? rs[t] : 0.f; }
        __syncthreads();
        {
            const int c2 = 2 * tid, gq = w >> 1;
            const f32x2 sh = *(const f32x2*)(mod + 0 * D + c2), sc = *(const f32x2*)(mod + 1 * D + c2) + 1.0f;
            LAS unsigned* Pd = (LAS unsigned*)(lds + c2 * 2);
            if (gq == 0) pool_pair<2>(X2 + c2, rsl, Pd, t0, sh, sc);
            else if (gq == 1) pool_pair<4>(X2 + c2, rsl, Pd, t0, sh, sc);
            else if (gq == 2) pool_pair<8>(X2 + c2, rsl, Pd, t0, sh, sc);
            else pool_pair<16>(X2 + c2, rsl, Pd, t0, sh, sc);
        }
        __syncthreads();
#pragma unroll 1
        for (int g = 0; g < 4; ++g) {
            f32x4 acc[2][4];
#pragma unroll
            for (int nt = 0; nt < 2; ++nt)
#pragma unroll
                for (int tt = 0; tt < 4; ++tt) acc[nt][tt] = (f32x4){0.f, 0.f, 0.f, 0.f};
            bf16x8 wf[2][8];
#pragma unroll
            for (int nt = 0; nt < 2; ++nt)
#pragma unroll
                for (int ks = 0; ks < 8; ++ks) wf[nt][ks] = *(const bf16x8*)(pwt + ((size_t)g * 256 + 32 * w + 16 * nt + fr) * 256 + 32 * ks + 8 * fq);
            u32x2 xq[2][4];
#pragma unroll
            for (int nt = 0; nt < 2; ++nt)
#pragma unroll
                for (int tt = 0; tt < 4; ++tt) xq[nt][tt] = *(const u32x2*)(X2 + (size_t)(t0 + 16 * tt + fr) * D + 256 * g + 32 * w + 16 * nt + 4 * fq);
#pragma unroll
            for (int ks = 0; ks < 8; ++ks) {
                bf16x8 af[4];
#pragma unroll
                for (int tt = 0; tt < 4; ++tt) af[tt] = *(const LAS bf16x8*)(lds + (16 * tt + fr) * PG_STRIDE + (256 * g + 32 * ks + 8 * fq) * 2);
#pragma unroll
                for (int nt = 0; nt < 2; ++nt)
#pragma unroll
                    for (int tt = 0; tt < 4; ++tt) acc[nt][tt] = __builtin_amdgcn_mfma_f32_16x16x32_bf16(wf[nt][ks], af[tt], acc[nt][tt], 0, 0, 0);
            }
#pragma unroll
            for (int nt = 0; nt < 2; ++nt) {
                const int col = 256 * g + 32 * w + 16 * nt + 4 * fq;
                const f32x4 gmv = *(const f32x4*)(mod + 2 * D + col), bv = *(const f32x4*)(pb + col), sv = *(const f32x4*)(psc + col);
#pragma unroll
                for (int tt = 0; tt < 4; ++tt) {
                    const size_t idx = (size_t)(t0 + 16 * tt + fr) * D + col;
                    const f32x4 xv = {bflo(xq[nt][tt].x), bfhi(xq[nt][tt].x), bflo(xq[nt][tt].y), bfhi(xq[nt][tt].y)};
                    const f32x4 o = xv + gmv * ((acc[nt][tt] + bv) * sv);
                    *(u32x2*)(X1 + idx) = (u32x2){cvt_pk_bf16(o.x, o.y), cvt_pk_bf16(o.z, o.w)};
                }
            }
        }
        __syncthreads();
    }
}

constexpr int N_PHASES = 17;
__global__ void __launch_bounds__(NTH, 2) fwd_kernel(Args args) {
    extern __shared__ __attribute__((aligned(16))) unsigned char lds_raw[];
    Frame F;
    F.lds = (LAS unsigned char*)lds_raw;
    F.MISC = (volatile LAS unsigned*)(F.lds + MISC_OFF);
    F.tid = threadIdx.x; F.lane = F.tid & 63; F.wave = __builtin_amdgcn_readfirstlane(F.tid >> 6);
    F.G = gridDim.x; { const int bx = blockIdx.x; F.vcu = (F.G % 8 == 0) ? (bx % 8) * (F.G / 8) + bx / 8 : bx; }
    F.ws = args.ws; F.ctl = (unsigned*)(args.ws + WS_CTL); F.out = args.out;
    for (int u = F.tid; u < (LDS_BYTES - MISC_OFF) / 4; u += NTH) F.MISC[u] = 0u;
    __syncthreads();
#if N_LAUNCH_MODE == 1
    XcdBarrier bar = xcd_barrier_post(F.ctl + CW_BAR, F.MISC + 8);
#define GRID_BAR() xcd_barrier(bar)
#else
#define GRID_BAR() do { } while (0)
#endif
    const int lo = args.ph_lo, hi = args.ph_hi;
#define IN(k) (lo <= (k) && (k) < hi)
#define SEAM(k) do { if (IN(k) && IN((k) + 1)) GRID_BAR(); } while (0)
    GemmBase gb; gb.G = F.G; gb.vcu = F.vcu;
    bf16_t* X1 = WSP(F, WS_X1, bf16_t); bf16_t* X2 = WSP(F, WS_X2, bf16_t);
    const float* mod0 = WSP(F, WS_MOD, float); const float* mod1 = mod0 + 6 * D;

    if (IN(0)) { p0_prologue(F); } SEAM(0);
    if (IN(1)) { p1_norm_in(F); } SEAM(1);
    if (IN(2)) { PolWin P; (GemmBase&)P = gb; P.A = WSP(F, WS_HN, bf16_t); P.Bt = WSP(F, WS_WINT, bf16_t); P.qkvg = WSP(F, WS_QKVG, bf16_t); P.gbuf = WSP(F, WS_GBUF, _Float16);
        P.lb = WSP(F, WS_LB, float); P.rope = WSP(F, WS_ROPE, f32x2); run_gemm(F, P); } SEAM(2);
    if (IN(3)) { la_local_state(F); } SEAM(3);
    if (IN(4)) { la_scan(F); } SEAM(4);
    if (IN(5)) { la_output(F); } SEAM(5);
    if (IN(6)) { PolRes<false> P; (GemmBase&)P = gb; P.A = WSP(F, WS_CAT, bf16_t); P.Bt = WSP(F, WS_WOUTT, bf16_t); P.resid = inptr(0); P.resid16 = nullptr; P.outp = X1; P.gate = mod0 + 2 * D; P.bias = nullptr; P.scale = nullptr;
        P.K = D; P.lda = D; P.nN = 4; P.kcol = 0; run_gemm(F, P); } SEAM(6);
    if (IN(7)) { p_route(F, 0, X1, args.aux); } SEAM(7);
    if (IN(8)) { expert_tables(F, 0); PolMoE<((FP8_LAYERS >> 0) & 1) != 0> P; (GemmBase&)P = gb; P.MISC = F.MISC; P.upa = F.lds + UPA_OFF; P.hn = ((FP8_LAYERS >> 0) & 1) ? (const bf16_t*)WSP(F, WS_HN8, unsigned char) : WSP(F, WS_HN, bf16_t);
        P.wgut = WSP(F, WS_WGUT, bf16_t) + (size_t)0 * NE * 2048 * D; P.bgu = inptr(15) + (size_t)0 * NE * 2048; P.lslot = WSP(F, WS_LSLOT, int) + (size_t)0 * NE * LIST_CAP; P.lw = WSP(F, WS_LW, float) + (size_t)0 * NE * LIST_CAP;
        P.act = (bf16_t*)(F.ws + (0 ? WS_ACT2 : WS_ACT)); P.wdnt = WSP(F, WS_WDNT, bf16_t) + (size_t)0 * NE * D * D; P.bdn = inptr(17) + (size_t)0 * NE * D; P.yslot = WSP(F, WS_YSLOT, bf16_t);
        P.done = F.ctl + CW_DONE + 0 * DONE_LAYER; P.tmo = F.ctl + CW_TMO; P.act_rsrc = __builtin_amdgcn_make_buffer_rsrc((void*)P.act, (short)0, (int)((size_t)ACT_ROWS * D * 2), 0x00020000);
        P.fill(F.tid); __syncthreads(); run_gemm(F, P); } if (IN(8) && IN(10)) GRID_BAR();
    if (IN(10)) { p_combine<0>(F, 0, X1, X2); } SEAM(10);
    if (IN(11)) { p_pool_gemm(F, X2, X1); asm volatile("s_waitcnt vmcnt(0)" ::: "memory"); __syncthreads(); p_route(F, 1, X1, args.aux); } if (IN(11) && IN(14)) GRID_BAR();
    if (IN(14)) { expert_tables(F, 1); PolMoE<((FP8_LAYERS >> 1) & 1) != 0> P; (GemmBase&)P = gb; P.MISC = F.MISC; P.upa = F.lds + UPA_OFF; P.hn = ((FP8_LAYERS >> 1) & 1) ? (const bf16_t*)WSP(F, WS_HN8, unsigned char) : WSP(F, WS_HN, bf16_t);
        P.wgut = WSP(F, WS_WGUT, bf16_t) + (size_t)1 * NE * 2048 * D; P.bgu = inptr(15) + (size_t)1 * NE * 2048; P.lslot = WSP(F, WS_LSLOT, int) + (size_t)1 * NE * LIST_CAP; P.lw = WSP(F, WS_LW, float) + (size_t)1 * NE * LIST_CAP;
        P.act = (bf16_t*)(F.ws + (1 ? WS_ACT2 : WS_ACT)); P.wdnt = WSP(F, WS_WDNT, bf16_t) + (size_t)1 * NE * D * D; P.bdn = inptr(17) + (size_t)1 * NE * D; P.yslot = WSP(F, WS_YSLOT, bf16_t);
        P.done = F.ctl + CW_DONE + 1 * DONE_LAYER; P.tmo = F.ctl + CW_TMO; P.act_rsrc = __builtin_amdgcn_make_buffer_rsrc((void*)P.act, (short)0, (int)((size_t)ACT_ROWS * D * 2), 0x00020000);
        P.fill(F.tid); __syncthreads(); run_gemm(F, P); } if (IN(14) && IN(16)) GRID_BAR();
    if (IN(16)) { p_combine<1>(F, 1, X1, F.out); }
#undef IN
#undef SEAM
}

extern "C" void kernel_launch(void* const* d_in, const int* in_sizes, int n_in, void* d_out, int out_size, void* d_ws, size_t ws_size, hipStream_t stream) {
    static int grid = 0;
    if (grid == 0) {
        if (n_in != 19 || out_size != T * D || ws_size < WS_END) { fprintf(stderr, "kernel_launch: unexpected shapes (n_in %d, out %d, ws %zu)\n", n_in, out_size, ws_size); grid = -1; return; }
        int dev = 0, cus = 0, per_cu = 0;
        if (hipGetDevice(&dev) != hipSuccess || hipDeviceGetAttribute(&cus, hipDeviceAttributeMultiprocessorCount, dev) != hipSuccess) { grid = -1; return; }
        if (hipFuncSetAttribute((const void*)fwd_kernel, hipFuncAttributeMaxDynamicSharedMemorySize, LDS_BYTES) != hipSuccess) { fprintf(stderr, "kernel_launch: hipFuncSetAttribute failed\n"); grid = -1; return; }
        if (hipOccupancyMaxActiveBlocksPerMultiprocessor(&per_cu, (const void*)fwd_kernel, NTH, LDS_BYTES) != hipSuccess || per_cu < 1) { fprintf(stderr, "kernel_launch: occupancy query says %d\n", per_cu); }
        (void)hipGetLastError();
        grid = cus;
    }
    if (grid < 0) return;
    (void)hipMemsetAsync((char*)d_ws + WS_CTL, 0, CTL_BYTES, stream);
    Args a{};
    for (int i = 0; i < 19; ++i) a.in[i] = (const float*)d_in[i];
    a.out = (float*)d_out; a.ws = (unsigned char*)d_ws;
#if N_LAUNCH_MODE == 1
    a.ph_lo = 0; a.ph_hi = N_PHASES;
    void* kargs[] = {&a};
    hipError_t e = hipLaunchCooperativeKernel((const void*)fwd_kernel, dim3(grid), dim3(NTH), kargs, LDS_BYTES, stream);
    if (e != hipSuccess) fprintf(stderr, "cooperative launch failed: %s\n", hipGetErrorString(e));
#else
    for (int p = 0; p < N_PHASES; ++p) {
        a.ph_lo = p; a.ph_hi = p + 1;
        hipLaunchKernelGGL(fwd_kernel, dim3(grid), dim3(NTH), LDS_BYTES, stream, a);
        if (p == DUP_PHASE) { a.aux = 1; hipLaunchKernelGGL(fwd_kernel, dim3(grid), dim3(NTH), LDS_BYTES, stream, a); a.aux = 0; }
    }
#endif
}
```

```cpp
#include <hip/hip_runtime.h>
#include <cstdio>
#include <cstdint>

#ifndef N_LAUNCH_MODE
#define N_LAUNCH_MODE 1
#endif
#ifndef DUP_PHASE
#define DUP_PHASE -1
#endif
#ifndef KREP_WIN
#define KREP_WIN 1
#endif
#ifndef KREP_RES
#define KREP_RES 1
#endif
#ifndef KREP_G1
#define KREP_G1 1
#endif
#ifndef KREP_G2
#define KREP_G2 1
#endif
#ifndef GEMM_KREP
#define GEMM_KREP 1
#endif
#ifndef GEMM_EPIREP
#define GEMM_EPIREP 1
#endif
#ifndef FP8_LAYERS
#define FP8_LAYERS 3
#endif
#ifndef SIMPLE_GEMM
#define SIMPLE_GEMM 0
#endif

#define LAS __attribute__((address_space(3)))
#define GAS __attribute__((address_space(1)))
typedef unsigned short bf16_t;
typedef short bf16x8 __attribute__((ext_vector_type(8)));
typedef float f32x4 __attribute__((ext_vector_type(4)));
typedef float f32x2 __attribute__((ext_vector_type(2)));
typedef unsigned u32x4 __attribute__((ext_vector_type(4)));
typedef unsigned u32x2 __attribute__((ext_vector_type(2)));
typedef _Float16 h16x2 __attribute__((ext_vector_type(2)));
typedef _Float16 h16x8 __attribute__((ext_vector_type(8)));
typedef int v4i_t __attribute__((ext_vector_type(4)));
typedef int v8i_t __attribute__((ext_vector_type(8)));
constexpr float W8_SCALE = 32.0f;
__device__ __forceinline__ unsigned pack_fp8x4(float a, float b, float c, float d) { int w = __builtin_amdgcn_cvt_pk_fp8_f32(a, b, 0, false); w = __builtin_amdgcn_cvt_pk_fp8_f32(c, d, w, true); return (unsigned)w; }

constexpr int T = 16384, D = 1024, NE = 32, TOPK = 4, DEPTH = 2;
constexpr int INW = 4096;
constexpr int NTH = 512, NWAVES = 8;
constexpr float EPS = 1e-6f;
constexpr float SW_LIMIT = 7.0f, SW_ALPHA = 1.702f;
constexpr int LIST_CAP = T;
constexpr int ACT_ROWS = T * TOPK + NE * 256;

constexpr size_t MiB = 1u << 20;
constexpr size_t WS_CTL = 0, CTL_BYTES = 1 * MiB;
constexpr size_t WS_MOD = 1 * MiB;
constexpr size_t WS_LB = WS_MOD + 65536;
constexpr size_t WS_ROPE = 2 * MiB;
constexpr size_t WS_WINT = 10 * MiB;
constexpr size_t WS_WOUTT = 18 * MiB;
constexpr size_t WS_POOLT = 20 * MiB;
constexpr size_t WS_LSLOT = 22 * MiB;
constexpr size_t WS_LW = 26 * MiB;
constexpr size_t WS_RT = 21 * MiB;
constexpr size_t WS_RSTD = 30 * MiB;
constexpr size_t WS_WGUT = 32 * MiB;
constexpr size_t WS_WDNT = 288 * MiB;
constexpr size_t WS_HN = 416 * MiB;
constexpr size_t WS_QKVG = 448 * MiB;
constexpr size_t WS_GBUF = 576 * MiB;
constexpr size_t WS_KVT = 608 * MiB;
constexpr size_t WS_SPREV = 736 * MiB;
constexpr size_t WS_DEC = 800 * MiB;
constexpr size_t WS_CAT = 802 * MiB;
constexpr size_t WS_X1 = 834 * MiB;
constexpr size_t WS_X2 = 898 * MiB;
constexpr size_t WS_ACT = 962 * MiB;
constexpr size_t WS_YSLOT = 1106 * MiB;
constexpr size_t WS_ACT2 = 1234 * MiB;
constexpr size_t WS_HN8 = 1378 * MiB;
constexpr size_t WS_END = 1394 * MiB;
constexpr int CW_CNT = 64;
constexpr int CW_BAR = 4096;
constexpr int CW_TMO = 8;
constexpr int CW_DONE = 8192, DONE_LAYER = 320 * 64;

constexpr int SCR_BYTES = 156 * 1024;
constexpr int MISC_OFF = SCR_BYTES;
constexpr int LDS_BYTES = SCR_BYTES + 4096;

typedef __bf16 bf16x2_t __attribute__((ext_vector_type(2)));
__device__ __forceinline__ unsigned cvt_pk_bf16(float lo, float hi) { const f32x2 v = {lo, hi}; const bf16x2_t b = __builtin_convertvector(v, bf16x2_t); return __builtin_bit_cast(unsigned, b); }
__device__ __forceinline__ float bf2f(unsigned short b) { return __builtin_bit_cast(float, (unsigned)b << 16); }
__device__ __forceinline__ float bflo(unsigned w) { return __builtin_bit_cast(float, w << 16); }
__device__ __forceinline__ float bfhi(unsigned w) { return __builtin_bit_cast(float, w & 0xffff0000u); }
__device__ __forceinline__ float wave_sum(float v) {
#pragma unroll
    for (int o = 1; o < 64; o <<= 1) v += __shfl_xor(v, o);
    return v;
}
__device__ __forceinline__ float wave_max(float v) {
#pragma unroll
    for (int o = 1; o < 64; o <<= 1) v = fmaxf(v, __shfl_xor(v, o));
    return v;
}
__device__ __forceinline__ float sigmoidf_(float x) { return __builtin_amdgcn_rcpf(1.0f + __expf(-x)); }
__device__ __forceinline__ float siluf_(float x) { return x * sigmoidf_(x); }
__device__ __forceinline__ f32x2 sigmoid2(f32x2 v) {
    constexpr float c = -1.4426950408889634f; const f32x2 c2 = {c, c}, one = {1.0f, 1.0f};
    const f32x2 t = v * c2; const f32x2 e = {__builtin_amdgcn_exp2f(t.x), __builtin_amdgcn_exp2f(t.y)}; const f32x2 d = e + one;
    return (f32x2){__builtin_amdgcn_rcpf(d.x), __builtin_amdgcn_rcpf(d.y)};
}
__device__ __forceinline__ f32x2 silu2(f32x2 v) { return v * sigmoid2(v); }
__device__ __forceinline__ f32x2 fgate2(f32x2 v, f32x2 lbv, f32x2 oml, f32x2& g) {
    const f32x2 f = __builtin_elementwise_fma(oml, sigmoid2(v), lbv);
    const f32x2 l2 = {__builtin_amdgcn_logf(f.x), __builtin_amdgcn_logf(f.y)}; const f32x2 ln2 = {0.6931471805599453f, 0.6931471805599453f}, one = {1.0f, 1.0f};
    g = l2 * ln2; return one - f;
}
__device__ __forceinline__ f32x2 swiglu2(f32x2 ag, f32x2 al, f32x2 bg, f32x2 bl1, float ws) {
    const f32x2 ws2 = {ws, ws};
    const f32x2 G = __builtin_elementwise_fma(ag, ws2, bg), L = __builtin_elementwise_fma(al, ws2, bl1);
    const f32x2 x = {fminf(G.x, SW_LIMIT), fminf(G.y, SW_LIMIT)};
    const f32x2 y = {__builtin_amdgcn_fmed3f(L.x, 1.0f - SW_LIMIT, 1.0f + SW_LIMIT), __builtin_amdgcn_fmed3f(L.y, 1.0f - SW_LIMIT, 1.0f + SW_LIMIT)};
    constexpr float c = -SW_ALPHA * 1.4426950408889634f; const f32x2 c2 = {c, c};
    const f32x2 t = x * c2;
    const f32x2 e = {__builtin_amdgcn_exp2f(t.x), __builtin_amdgcn_exp2f(t.y)};
    const f32x2 one = {1.0f, 1.0f};
    const f32x2 d = e + one;
    const f32x2 r = {__builtin_amdgcn_rcpf(d.x), __builtin_amdgcn_rcpf(d.y)};
    return (x * r) * y;
}

#define XB_TMO      128
#define XB_XCNT(j)  (256  + 64 * (j))
#define XB_XSUB(j)  (1280 + 64 * (j))
#define XB_XGEN(j)  (2304 + 64 * (j))
#define XB_TOP      3328
#define XB_TOPGEN   3392
#define XCD_BAR_WORDS 3456
#define XB_SPIN_CAP (1u << 20)
__device__ __forceinline__ unsigned xb_ld(unsigned* p)              { return __hip_atomic_load(p, __ATOMIC_RELAXED, __HIP_MEMORY_SCOPE_AGENT); }
__device__ __forceinline__ unsigned xb_add(unsigned* p, unsigned v) { return __hip_atomic_fetch_add(p, v, __ATOMIC_RELAXED, __HIP_MEMORY_SCOPE_AGENT); }
__device__ __forceinline__ unsigned xb_xcc_id() { return (unsigned)__builtin_amdgcn_s_getreg((3 << 11) | 20) & 0xFu; }
#define XB_SPIN(cond, bar) do { unsigned _sp = 0; while (cond) { __builtin_amdgcn_s_sleep(1); \
    if ((++_sp & 255u) == 0u) { if (xb_ld(&(bar)[XB_TMO])) break; if (_sp > XB_SPIN_CAP) { atomicAdd(&(bar)[XB_TMO], 1u); break; } } } } while (0)
struct XcdBarrier { unsigned* bar; unsigned x; volatile LAS unsigned* st; };
__device__ __forceinline__ XcdBarrier xcd_barrier_post(unsigned* bar, volatile LAS unsigned* st) {
    XcdBarrier b; b.bar = bar; b.x = xb_xcc_id(); b.st = st;
    if (threadIdx.x == 0) (void)xb_add(&bar[XB_XCNT(b.x)], 1u);
    return b;
}
__device__ __forceinline__ void xcd_barrier_complete(unsigned* bar, unsigned x, unsigned& nloc, unsigned& nx) {
    const unsigned G = gridDim.x * gridDim.y * gridDim.z;
    unsigned sum, cnt, mine, sp = 0u;
    for (;;) {
        sum = 0u; cnt = 0u; mine = 0u;
#pragma unroll
        for (unsigned j = 0; j < 16; ++j) { const unsigned c = xb_ld(&bar[XB_XCNT(j)]); sum += c; cnt += (c > 0u) ? 1u : 0u; mine = (j == x) ? c : mine; }
        if (sum == G) break;
        __builtin_amdgcn_s_sleep(1);
        if ((++sp & 255u) == 0u) { if (xb_ld(&bar[XB_TMO])) break; if (sp > XB_SPIN_CAP) { atomicAdd(&bar[XB_TMO], 1u); break; } }
    }
    nloc = mine > 0u ? mine : 1u; nx = cnt > 0u ? cnt : 1u;
}
__device__ __forceinline__ void xcd_barrier(const XcdBarrier& b) {
    asm volatile("s_waitcnt vmcnt(0)" ::: "memory");
    __syncthreads();
    if (threadIdx.x == 0) {
        unsigned* bar = b.bar;
        __builtin_amdgcn_s_waitcnt(0);
        unsigned nloc = b.st[0], nx = b.st[1];
        if (nloc == 0u) { xcd_barrier_complete(bar, b.x, nloc, nx); b.st[0] = nloc; b.st[1] = nx; }
        const unsigned old = xb_add(&bar[XB_XSUB(b.x)], 1u);
        const unsigned gen = old / nloc;
        if (old + 1u == (gen + 1u) * nloc) {
            __builtin_amdgcn_fence(__ATOMIC_RELEASE, "agent");
            asm volatile("s_waitcnt vmcnt(0)" ::: "memory");
            (void)xb_add(&bar[XB_TOP], 1u);
            XB_SPIN(xb_ld(&bar[XB_TOP]) < (gen + 1u) * nx, bar);
            __builtin_amdgcn_fence(__ATOMIC_ACQUIRE, "agent");
            __hip_atomic_store(&bar[XB_XGEN(b.x)], gen + 1u, __ATOMIC_RELAXED, __HIP_MEMORY_SCOPE_AGENT);
        } else {
            XB_SPIN(xb_ld(&bar[XB_XGEN(b.x)]) <= gen, bar);
            __builtin_amdgcn_fence(__ATOMIC_ACQUIRE, "agent");
            asm volatile("s_waitcnt vmcnt(0)" ::: "memory");
        }
    }
    __syncthreads();
}

struct Args {
    const float* in[19];
    float* out;
    unsigned char* ws;
    int ph_lo, ph_hi, aux, pad;
};

namespace pg8 {
constexpr int BM = 256, BK = 64, HALF = 128, HTB = HALF * BK * 2;
__host__ __device__ __forceinline__ int lds_byte(int r, int c) { const int st = (r >> 4) * 2 + (c >> 5), rr = r & 15, cc = c & 31, ob = rr * 64 + cc * 2; return st * 1024 + (ob ^ (((ob >> 9) & 1) << 5)); }
__host__ __device__ __forceinline__ void stage_rc(int b, int& R, int& C) { const int st = b / 1024, sb = b % 1024, swz = sb ^ (((sb >> 9) & 1) << 5); R = (st >> 1) * 16 + swz / 64; C = (st & 1) * 32 + (swz % 64) / 2; }
__host__ __device__ __forceinline__ int perm32(int rho) { const int n = rho >> 4, i = rho & 15; return 8 * (i >> 2) + 4 * n + (i & 3); }

struct Unit { const char* A; const char* B; int p0, p1, p2, p3, ui; };

#define PG8_SA(b, h) (((b) * 2 + (h)) * HTB)
#define PG8_SB(b, h) ((4 + (b) * 2 + (h)) * HTB)
#define PG8_LDA(dst, b, h) do { _Pragma("unroll") for (int m = 0; m < 4; ++m) _Pragma("unroll") for (int k = 0; k < 2; ++k) dst[m][k] = *(const LAS bf16x8*)(lds + PG8_SA(b, h) + aoff + m * 2048 + k * 1024); } while (0)
#define PG8_LDB(dst, b, h) do { _Pragma("unroll") for (int n = 0; n < 2; ++n) _Pragma("unroll") for (int k = 0; k < 2; ++k) dst[n][k] = *(const LAS bf16x8*)(lds + PG8_SB(b, h) + boff + n * 2048 + k * 1024); } while (0)
#define PG8_MMA(ai, bj, At, Bt) do { __builtin_amdgcn_s_setprio(1); _Pragma("unroll") for (int m = 0; m < 4; ++m) _Pragma("unroll") for (int n = 0; n < 2; ++n) _Pragma("unroll") for (int k = 0; k < 2; ++k) \
        acc[ai][bj][m][n] = __builtin_amdgcn_mfma_f32_16x16x32_bf16(Bt[n][k], At[m][k], acc[ai][bj][m][n], 0, 0, 0); __builtin_amdgcn_s_setprio(0); } while (0)

template <class P>
__device__ __forceinline__ void gemm_simple(LAS unsigned char* lds, const P& S) {
    const int tid = threadIdx.x, wid = __builtin_amdgcn_readfirstlane(tid >> 6), lane = tid & 63, wr = wid >> 2, wc = wid & 3, fr = lane & 15, fq = lane >> 4;
    const int nt = S.nt();
    int R0, C0; stage_rc(tid * 16, R0, C0);
    unsigned offB[2];
#pragma unroll
    for (int i = 0; i < 2; ++i) { const int R = R0 + 64 * i; const int Rb = (R & ~31) + perm32(R & 31); offB[i] = (unsigned)Rb * S.ldb_bytes() + (unsigned)C0 * 2u; }
    const unsigned bhalf = 128u * S.ldb_bytes();
    const int aoff = lds_byte(wr * 64 + fr, fq * 8), boff = lds_byte(wc * 32 + fr, fq * 8);
    Unit u;
    for (int ui = 0; S.next(ui, u); ++ui) {
        unsigned offA[4]; S.aoff(u, R0, C0, offA);
        f32x4 acc[2][2][4][2];
#pragma unroll
        for (int a = 0; a < 2; ++a)
#pragma unroll
            for (int b = 0; b < 2; ++b)
#pragma unroll
                for (int m = 0; m < 4; ++m)
#pragma unroll
                    for (int n = 0; n < 2; ++n) acc[a][b][m][n] = (f32x4){0.f, 0.f, 0.f, 0.f};
        for (int t = 0; t < nt; ++t) {
            u32x4 ra[4], rb[4];
#pragma unroll
            for (int h = 0; h < 2; ++h)
#pragma unroll
                for (int i = 0; i < 2; ++i) {
                    ra[2 * h + i] = *(const u32x4*)(u.A + offA[2 * h + i] + (size_t)t * 128);
                    rb[2 * h + i] = *(const u32x4*)(u.B + (size_t)h * bhalf + offB[i] + (size_t)t * 128);
                }
            __syncthreads();
#pragma unroll
            for (int h = 0; h < 2; ++h)
#pragma unroll
                for (int i = 0; i < 2; ++i) {
                    *(LAS u32x4*)(lds + PG8_SA(0, h) + tid * 16 + i * 8192) = ra[2 * h + i];
                    *(LAS u32x4*)(lds + PG8_SB(0, h) + tid * 16 + i * 8192) = rb[2 * h + i];
                }
            __syncthreads();
            bf16x8 At[4][2], Bt[2][2];
#pragma unroll
            for (int ai = 0; ai < 2; ++ai) {
                PG8_LDA(At, 0, ai);
#pragma unroll
                for (int bj = 0; bj < 2; ++bj) { PG8_LDB(Bt, 0, bj); PG8_MMA(ai, bj, At, Bt); }
            }
        }
        S.epi(acc, u, wr, wc, fr, fq);
    }
    __syncthreads();
}

template <class P>
__device__ __forceinline__ void gemm_pipe(LAS unsigned char* lds, const P& S) {
    const int tid = threadIdx.x, wid = __builtin_amdgcn_readfirstlane(tid >> 6), lane = tid & 63, wr = wid >> 2, wc = wid & 3, fr = lane & 15, fq = lane >> 4;
    constexpr int KR = GEMM_KREP * P::KREP; const int nt1 = S.nt(), nt = nt1 * KR;
    int R0, C0; stage_rc(tid * 16, R0, C0);
    unsigned offB[2];
#pragma unroll
    for (int i = 0; i < 2; ++i) { const int R = R0 + 64 * i; const int Rb = (R & ~31) + perm32(R & 31); offB[i] = (unsigned)Rb * S.ldb_bytes() + (unsigned)C0 * 2u; }
    const size_t bhalf = (size_t)128u * S.ldb_bytes();
    const size_t kstep = 128;
    const unsigned ldsw = (unsigned)wid * 1024u;
    int aoffK[2], boffK[2];
#pragma unroll
    for (int k = 0; k < 2; ++k) { aoffK[k] = lds_byte(wr * 64 + fr, fq * 8) + k * 1024; boffK[k] = lds_byte(wc * 32 + fr, fq * 8) + k * 1024; }
#undef PG8_LDA
#undef PG8_LDB
#undef PG8_MMA
#define PG8_LDA(dst, b, h) do { _Pragma("unroll") for (int m = 0; m < 4; ++m) { \
        if constexpr (P::FP8) dst##8[m] = __builtin_shufflevector(*(const LAS v4i_t*)(lds + PG8_SA(b, h) + aoffK[0] + m * 2048), *(const LAS v4i_t*)(lds + PG8_SA(b, h) + aoffK[1] + m * 2048), 0, 1, 2, 3, 4, 5, 6, 7); \
        else { _Pragma("unroll") for (int k = 0; k < 2; ++k) dst[m][k] = *(const LAS bf16x8*)(lds + PG8_SA(b, h) + aoffK[k] + m * 2048); } } } while (0)
#define PG8_LDB(dst, b, h) do { _Pragma("unroll") for (int n = 0; n < 2; ++n) { \
        if constexpr (P::FP8) dst##8[n] = __builtin_shufflevector(*(const LAS v4i_t*)(lds + PG8_SB(b, h) + boffK[0] + n * 2048), *(const LAS v4i_t*)(lds + PG8_SB(b, h) + boffK[1] + n * 2048), 0, 1, 2, 3, 4, 5, 6, 7); \
        else { _Pragma("unroll") for (int k = 0; k < 2; ++k) dst[n][k] = *(const LAS bf16x8*)(lds + PG8_SB(b, h) + boffK[k] + n * 2048); } } } while (0)
#define PG8_MMA(ai, bj, At, Bt) do { if constexpr (P::FP8) __builtin_amdgcn_sched_barrier(0); __builtin_amdgcn_s_setprio(1); _Pragma("unroll") for (int m = 0; m < 4; ++m) _Pragma("unroll") for (int n = 0; n < 2; ++n) { \
        if constexpr (P::FP8) acc[ai][bj][m][n] = __builtin_amdgcn_mfma_scale_f32_16x16x128_f8f6f4(Bt##8[n], At##8[m], acc[ai][bj][m][n], 0, 0, 0, 127, 0, 127); \
        else { _Pragma("unroll") for (int k = 0; k < 2; ++k) acc[ai][bj][m][n] = __builtin_amdgcn_mfma_f32_16x16x32_bf16(Bt[n][k], At[m][k], acc[ai][bj][m][n], 0, 0, 0); } } \
        if constexpr (P::FP8) { _Pragma("unroll") for (int m = 0; m < 4; ++m) _Pragma("unroll") for (int n = 0; n < 2; ++n) asm volatile("" : "+v"(acc[ai][bj][m][n])); } \
        __builtin_amdgcn_s_setprio(0); if constexpr (P::FP8) __builtin_amdgcn_sched_barrier(0); } while (0)
#define PG8_STAGE_A(bufoff, gbase, OFF, h) do { _Pragma("unroll") for (int _i = 0; _i < 2; ++_i) \
        __builtin_amdgcn_global_load_lds((const unsigned*)((const char*)(gbase) + (OFF)[2 * (h) + _i]), (LAS unsigned*)(lds + (bufoff) + ldsw + _i * 8192), 16, 0, 0); } while (0)
#define PG8_STAGE_B(bufoff, gbase) do { _Pragma("unroll") for (int _i = 0; _i < 2; ++_i) \
        __builtin_amdgcn_global_load_lds((const unsigned*)((const char*)(gbase) + offB[_i]), (LAS unsigned*)(lds + (bufoff) + ldsw + _i * 8192), 16, 0, 0); } while (0)
#define PG8_WAIT_V(n) asm volatile("s_waitcnt vmcnt(" #n ")" ::: "memory")
#define PG8_WAIT_L(n) asm volatile("s_waitcnt lgkmcnt(" #n ")" ::: "memory")
#define PG8_BAR __builtin_amdgcn_s_barrier()
#define PG8_SCHED __builtin_amdgcn_sched_barrier(0)
    Unit cur, nxt; int ui = 0; int pend = -1;
    if (!S.next(0, cur)) return;
    f32x4 acc[2][2][4][2];
#pragma unroll
    for (int a = 0; a < 2; ++a)
#pragma unroll
        for (int b = 0; b < 2; ++b)
#pragma unroll
            for (int m = 0; m < 4; ++m)
#pragma unroll
                for (int n = 0; n < 2; ++n) acc[a][b][m][n] = (f32x4){0.f, 0.f, 0.f, 0.f};
    bf16x8 At[4][2], B0[2][2], B1[2][2];
    v8i_t At8[4], B08[2], B18[2];
    unsigned offC[4], offN[4];
    S.aoff(cur, R0, C0, offC);
    const char* cA = cur.A; const char* cB = cur.B;
    if constexpr (P::HAS_READY) S.a_ready(cur);
    PG8_STAGE_B(PG8_SB(0, 0), cB); PG8_STAGE_B(PG8_SB(0, 1), cB + bhalf); PG8_STAGE_A(PG8_SA(0, 0), cA, offC, 0); PG8_STAGE_A(PG8_SA(0, 1), cA, offC, 1);
    if (wr == 1) PG8_BAR;
    PG8_WAIT_V(2); PG8_BAR;
    PG8_STAGE_B(PG8_SB(1, 0), cB + kstep); PG8_STAGE_A(PG8_SA(1, 0), cA + kstep, offC, 0); PG8_STAGE_B(PG8_SB(1, 1), cB + bhalf + kstep);
    PG8_WAIT_V(6); PG8_BAR;
    for (;;) {
        const bool has_next = S.next(ui + 1, nxt);
        if (has_next) S.aoff(nxt, R0, C0, offN);
        else {
#pragma unroll
            for (int q = 0; q < 4; ++q) offN[q] = offC[q];
        }
        const char* nA = has_next ? nxt.A : cA; const char* nB = has_next ? nxt.B : cB;
        for (int t = 0; t < nt; t += 2) {
            const bool last = (t == nt - 2);
            const bool sf = P::SEAM_OPT && (ui > 0) && (t == 0);
            if constexpr (P::HAS_READY) { if (last && has_next) S.a_ready(nxt); }
            const char* a1 = cA + (size_t)((t + 1) % nt1) * kstep;
            const char* a2 = last ? nA : cA + (size_t)((t + 2) % nt1) * kstep; const char* b2 = last ? nB : cB + (size_t)((t + 2) % nt1) * kstep;
            const char* a3 = a2 + kstep; const char* b3 = b2 + kstep;
            unsigned o2[4];
#pragma unroll
            for (int q = 0; q < 4; ++q) o2[q] = last ? offN[q] : offC[q];
            PG8_LDB(B0, 0, 0); PG8_LDB(B1, 0, 1); PG8_SCHED; PG8_LDA(At, 0, 0); if (!sf) { PG8_STAGE_A(PG8_SA(1, 1), a1, offC, 1); PG8_WAIT_V(8); }
            PG8_WAIT_L(0); PG8_BAR; PG8_MMA(0, 0, At, B0); PG8_MMA(0, 1, At, B1); PG8_BAR; PG8_SCHED;
            PG8_LDA(At, 0, 1); PG8_STAGE_B(PG8_SB(0, 0), b2); PG8_STAGE_B(PG8_SB(0, 1), b2 + bhalf); PG8_STAGE_A(PG8_SA(0, 0), a2, o2, 0);
            if (!sf) PG8_WAIT_V(8); PG8_WAIT_L(0); PG8_BAR; PG8_MMA(1, 0, At, B0); PG8_MMA(1, 1, At, B1); PG8_BAR; PG8_SCHED;
            PG8_LDB(B0, 1, 0); PG8_LDB(B1, 1, 1); PG8_SCHED; PG8_LDA(At, 1, 0); PG8_STAGE_A(PG8_SA(0, 1), a2, o2, 1);
            if (!sf) PG8_WAIT_V(8); PG8_WAIT_L(0); PG8_BAR; PG8_MMA(0, 0, At, B0); PG8_MMA(0, 1, At, B1); PG8_BAR; PG8_SCHED;
            PG8_LDA(At, 1, 1); PG8_STAGE_B(PG8_SB(1, 0), b3); PG8_STAGE_B(PG8_SB(1, 1), b3 + bhalf); PG8_STAGE_A(PG8_SA(1, 0), a3, o2, 0);
            if (!sf) PG8_WAIT_V(8); PG8_WAIT_L(0); PG8_BAR; PG8_MMA(1, 0, At, B0); PG8_MMA(1, 1, At, B1); PG8_BAR; PG8_SCHED;
        }
        if constexpr (P::SEAM_OPT) PG8_STAGE_A(PG8_SA(1, 1), nA + kstep, offN, 1);
        if (wr == 0) PG8_BAR;
        if constexpr (P::SEAM_OPT) { PG8_WAIT_V(0);
            S.flush(pend); pend = -1; }
        if (KR != 1) {
#pragma unroll
            for (int a = 0; a < 2; ++a)
#pragma unroll
                for (int b = 0; b < 2; ++b)
#pragma unroll
                    for (int m = 0; m < 4; ++m)
#pragma unroll
                        for (int n = 0; n < 2; ++n) acc[a][b][m][n] = acc[a][b][m][n] * (1.0f / KR);
        }
        pend = S.epi(acc, cur, wr, wc, fr, fq);
        if constexpr (!P::SEAM_OPT) { if (pend >= 0) { PG8_WAIT_V(0); S.flush(pend); pend = -1; } }
        if (!has_next) break;
#pragma unroll
        for (int a = 0; a < 2; ++a)
#pragma unroll
            for (int b = 0; b < 2; ++b)
#pragma unroll
                for (int m = 0; m < 4; ++m)
#pragma unroll
                    for (int n = 0; n < 2; ++n) acc[a][b][m][n] = (f32x4){0.f, 0.f, 0.f, 0.f};
        cur = nxt; cA = nA; cB = nB; ++ui;
#pragma unroll
        for (int q = 0; q < 4; ++q) offC[q] = offN[q];
        if (wr == 1) PG8_BAR;
    }
    PG8_WAIT_V(0);
    S.flush(pend);
    PG8_BAR;
#undef PG8_STAGE_A
#undef PG8_STAGE_B
#undef PG8_WAIT_V
#undef PG8_WAIT_L
#undef PG8_BAR
#undef PG8_SCHED
}
}

struct Frame {
    LAS unsigned char* lds;
    volatile LAS unsigned* MISC;
    unsigned* ctl;
    int tid, lane, wave, vcu, G;
    unsigned char* ws;
    float* out;
};
typedef const float* cfptr_t;
__device__ __forceinline__ const float* inptr(int i) {
    const __attribute__((address_space(4))) cfptr_t* ka = (const __attribute__((address_space(4))) cfptr_t*)__builtin_amdgcn_kernarg_segment_ptr();
    asm volatile("" : "+s"(ka));
    const GAS float* g = (const GAS float*)ka[i];
    return (const float*)g;
}
#define WSP(F, off, type) ((type*)((F).ws + (off)))

template <class RowMap>
__device__ __forceinline__ void transpose_tile(const float* W, int K, int N, bf16_t* WT, LAS unsigned char* scr, int item, int lane, const RowMap& rm) {
    const int nblk = N / 64, kb = item / nblk, nb = item % nblk, k0 = 64 * kb, n0 = 64 * nb;
    const int kg = lane & 3, ng = lane >> 2;
    f32x4 v[4][4];
#pragma unroll
    for (int r = 0; r < 4; ++r)
#pragma unroll
        for (int i = 0; i < 4; ++i) v[r][i] = __builtin_nontemporal_load((const f32x4*)(W + (size_t)(k0 + 16 * r + 4 * kg + i) * N + n0 + 4 * ng));
#pragma unroll
    for (int r = 0; r < 4; ++r)
#pragma unroll
        for (int j = 0; j < 4; ++j)
            *(LAS u32x2*)(scr + (4 * ng + j) * 144 + (16 * r + 4 * kg) * 2) = (u32x2){cvt_pk_bf16(v[r][0][j], v[r][1][j]), cvt_pk_bf16(v[r][2][j], v[r][3][j])};
    asm volatile("s_waitcnt lgkmcnt(0)" ::: "memory");
    const int c = lane & 7;
#pragma unroll
    for (int q = 0; q < 8; ++q) { const int n = (lane >> 3) + 8 * q; const u32x4 o = *(const LAS u32x4*)(scr + n * 144 + c * 16); __builtin_nontemporal_store(o, (u32x4*)(WT + (size_t)rm(n0 + n) * K + k0 + 8 * c)); }
    asm volatile("s_waitcnt lgkmcnt(0)" ::: "memory");
}
template <class RowMap>
__device__ __forceinline__ void transpose_tile8(const float* W, int K, int N, unsigned char* WT, LAS unsigned char* scr, int item, int lane, const RowMap& rm) {
    const int nblk = N / 64, kb = item / nblk, nb = item % nblk, k0 = 128 * kb, n0 = 64 * nb;
    const int kg = lane & 3, ng = lane >> 2;
#pragma unroll
    for (int hb = 0; hb < 2; ++hb) {
        f32x4 v[4][4];
#pragma unroll
        for (int r = 0; r < 4; ++r)
#pragma unroll
            for (int i = 0; i < 4; ++i) v[r][i] = __builtin_nontemporal_load((const f32x4*)(W + (size_t)(k0 + 64 * hb + 16 * r + 4 * kg + i) * N + n0 + 4 * ng));
#pragma unroll
        for (int r = 0; r < 4; ++r)
#pragma unroll
            for (int j = 0; j < 4; ++j)
                *(LAS unsigned*)(scr + (4 * ng + j) * 144 + 64 * hb + 16 * r + 4 * kg) = pack_fp8x4(v[r][0][j] * W8_SCALE, v[r][1][j] * W8_SCALE, v[r][2][j] * W8_SCALE, v[r][3][j] * W8_SCALE);
    }
    asm volatile("s_waitcnt lgkmcnt(0)" ::: "memory");
    const int c = lane & 7;
#pragma unroll
    for (int q = 0; q < 8; ++q) { const int n = (lane >> 3) + 8 * q; const u32x4 o = *(const LAS u32x4*)(scr + n * 144 + c * 16); __builtin_nontemporal_store(o, (u32x4*)(WT + (size_t)rm(n0 + n) * K + k0 + 16 * c)); }
    asm volatile("s_waitcnt lgkmcnt(0)" ::: "memory");
}
struct RmId { __device__ __forceinline__ int operator()(int n) const { return n; } };
struct RmWin { __device__ __forceinline__ int operator()(int n) const {
        const int s = n >> 9; if (s != 4 && s != 5) return n;
        const int d = n & 127, dd = d & 63; const int p = 8 * (dd >> 2) + (dd & 3) + ((d >> 6) << 2); return n - d + p; } };
struct RmGu { __device__ __forceinline__ int operator()(int n) const { const int half = n >> 10, j = (n & 1023) >> 7, i = n & 127; return 256 * j + 128 * half + i; } };

__device__ __forceinline__ void p0_prologue(Frame& F) {
    const int tid = F.tid;
    {
        LAS float* red = (LAS float*)F.lds;
        const float* c = inptr(1);
        for (int u = F.vcu; u < 192; u += F.G) {
            const int l = u / 96, cg = u % 96, kq = tid >> 4, cq = tid & 15;
            const float* W = inptr(2) + (size_t)l * D * 6 * D + cg * 64 + cq * 4;
            f32x4 a = {0.f, 0.f, 0.f, 0.f};
#pragma unroll 8
            for (int j = 0; j < 32; ++j) { const int k = kq + 32 * j; const float cv = siluf_(c[k]); const f32x4 w = *(const f32x4*)(W + (size_t)k * 6 * D); a += w * cv; }
            __syncthreads();
            *(LAS f32x4*)(red + kq * 64 + cq * 4) = a;
            __syncthreads();
            if (tid < 64) { float s = 0.f;
#pragma unroll 8
                for (int k = 0; k < 32; ++k) s += red[k * 64 + tid];
                const int col = cg * 64 + tid;
                WSP(F, WS_MOD, float)[l * 6 * D + col] = s + inptr(3)[l * 6 * D + col]; }
        }
        __syncthreads();
    }
    if (F.vcu == 0) { const float* hb = inptr(5); const float a = hb[tid], b = hb[512 + tid]; WSP(F, WS_LB, float)[tid] = 1.0f / (1.0f + __expf(b - a)); }
    {
        bf16_t* rt = WSP(F, WS_RT, bf16_t); const float* wr = inptr(12);
        for (int idx = F.vcu * NTH + tid; idx < 2 * D * NE; idx += F.G * NTH) {
            const int l = idx >> 15, rem = idx & 32767, c = rem >> 5, e = rem & 31;
            const float w = wr[idx]; const unsigned hi = cvt_pk_bf16(w, 0.f) & 0xffffu; const float res = w - bflo(hi);
            rt[((size_t)(l * 2 + 0) * 32 + e) * D + c] = (bf16_t)hi; rt[((size_t)(l * 2 + 1) * 32 + e) * D + c] = (bf16_t)(cvt_pk_bf16(res, 0.f) & 0xffffu);
        }
    }
    {
        f32x2* rope = WSP(F, WS_ROPE, f32x2);
        for (int idx = F.vcu * NTH + tid; idx < T * 64; idx += F.G * NTH) {
            const int t = idx >> 6, d = idx & 63;
            const float inv = exp2f(-(float)d * (13.287712379549449f / 64.0f));
            const float ang = (float)t * inv;
            const double a = (double)ang; const double n = __builtin_rint(a * 0.15915494309189535); const double r = __builtin_fma(-n, 6.283185307179586, a);
            const float rf = (float)r;
            rope[idx] = (f32x2){__cosf(rf), __sinf(rf)};
        }
    }
    {
        LAS unsigned char* scr = F.lds + F.wave * 16384;
        const int gw = F.vcu * NWAVES + F.wave, NGW = F.G * NWAVES;
        constexpr int I_IN = 16 * 64, I_OUT = 16 * 16, I_POOL = 4 * 4 * 4;
        constexpr int NL8 = ((FP8_LAYERS & 1) ? 1 : 0) + ((FP8_LAYERS & 2) ? 1 : 0), NL16 = 2 - NL8;
        constexpr int S_GU = 32 * 8 * 32, S_DN = 32 * 8 * 16;
        constexpr int T_GU = 32 * 16 * 32, T_DN = 32 * 16 * 16;
        constexpr int N8 = NL8 * (S_GU + S_DN), N16 = NL16 * (T_GU + T_DN);
        constexpr int NITEMS = N8 + I_IN + I_OUT + I_POOL + N16;
        for (int it = gw; it < NITEMS; it += NGW) {
            int r = it;
            if (r < N8) {
                const int li = r / (S_GU + S_DN), layer = (NL8 == 2) ? li : ((FP8_LAYERS & 1) ? 0 : 1); r -= li * (S_GU + S_DN);
                if (r < S_GU) { const int m = layer * 32 + r / 256; transpose_tile8(inptr(14) + (size_t)m * D * 2048, D, 2048, (unsigned char*)(WSP(F, WS_WGUT, bf16_t) + (size_t)layer * NE * 2048 * D) + (size_t)(m & 31) * 2048 * D, scr, r % 256, F.lane, RmGu()); }
                else { r -= S_GU; const int m = layer * 32 + r / 128; transpose_tile8(inptr(16) + (size_t)m * D * D, D, D, (unsigned char*)(WSP(F, WS_WDNT, bf16_t) + (size_t)layer * NE * D * D) + (size_t)(m & 31) * D * D, scr, r % 128, F.lane, RmId()); }
                continue;
            }
            r -= N8;
            if (r < I_IN) { transpose_tile(inptr(4), D, INW, WSP(F, WS_WINT, bf16_t), scr, r, F.lane, RmWin()); continue; } r -= I_IN;
            if (r < I_OUT) { transpose_tile(inptr(8), D, D, WSP(F, WS_WOUTT, bf16_t), scr, r, F.lane, RmId()); continue; } r -= I_OUT;
            if (r < I_POOL) { const int g = r / 16; transpose_tile(inptr(9) + (size_t)g * 65536, 256, 256, WSP(F, WS_POOLT, bf16_t) + (size_t)g * 65536, scr, r % 16, F.lane, RmId()); continue; } r -= I_POOL;
            if (NL16 > 0) {
                const int li = r / (T_GU + T_DN), layer = (NL16 == 2) ? li : ((FP8_LAYERS & 1) ? 1 : 0); r -= li * (T_GU + T_DN);
                if (r < T_GU) { const int m = layer * 32 + r / 512; transpose_tile(inptr(14) + (size_t)m * D * 2048, D, 2048, WSP(F, WS_WGUT, bf16_t) + (size_t)m * 2048 * D, scr, r % 512, F.lane, RmGu()); }
                else { r -= T_GU; const int m = layer * 32 + r / 256; transpose_tile(inptr(16) + (size_t)m * D * D, D, D, WSP(F, WS_WDNT, bf16_t) + (size_t)m * D * D, scr, r % 256, F.lane, RmId()); }
            }
        }
    }
}

__device__ __forceinline__ void p1_norm_in(Frame& F) {
    const float* mod = WSP(F, WS_MOD, float);
    f32x4 sh[4], sc[4];
#pragma unroll
    for (int j = 0; j < 4; ++j) { sh[j] = *(const f32x4*)(mod + 0 * D + 4 * F.lane + 256 * j); sc[j] = *(const f32x4*)(mod + 1 * D + 4 * F.lane + 256 * j) + 1.0f; }
    const int gw = F.vcu * NWAVES + F.wave, NGW = F.G * NWAVES;
    for (int row = gw; row < T; row += NGW) {
        const f32x4* xr = (const f32x4*)(inptr(0) + (size_t)row * D) + F.lane;
        f32x4 v[4]; float s = 0.f;
#pragma unroll
        for (int j = 0; j < 4; ++j) { v[j] = xr[64 * j]; s += (v[j].x * v[j].x + v[j].y * v[j].y) + (v[j].z * v[j].z + v[j].w * v[j].w); }
        const float rstd = rsqrtf(wave_sum(s) * (1.f / D) + EPS);
        u32x2* o = (u32x2*)(WSP(F, WS_HN, bf16_t) + (size_t)row * D) + F.lane;
#pragma unroll
        for (int j = 0; j < 4; ++j) { const f32x4 h = v[j] * rstd * sc[j] + sh[j]; o[64 * j] = (u32x2){cvt_pk_bf16(h.x, h.y), cvt_pk_bf16(h.z, h.w)}; }
    }
}

using pg8::Unit;
typedef f32x4 AccT[2][2][4][2];

struct GemmBase {
    static constexpr bool SEAM_OPT = false;
    __device__ __forceinline__ void flush(int) const {}
    static constexpr bool HAS_READY = false;
    static constexpr bool FP8 = false;
    int G, vcu;
    __device__ __forceinline__ void aoff_lin(int R0, int C0, unsigned lda_bytes, unsigned (&off)[4]) const {
#pragma unroll
        for (int q = 0; q < 4; ++q) off[q] = (unsigned)(R0 + 64 * (q & 1) + 128 * (q >> 1)) * lda_bytes + (unsigned)C0 * 2u;
    }
};

struct PolWin : GemmBase {
    static constexpr int KREP = KREP_WIN;
    const bf16_t* A; const bf16_t* Bt; bf16_t* qkvg; _Float16* gbuf; const float* lb; const f32x2* rope;
    __device__ __forceinline__ int nt() const { return D / 64; }
    __device__ __forceinline__ unsigned ldb_bytes() const { return D * 2; }
    __device__ __forceinline__ bool next(int i, Unit& u) const {
        const int V = i * G + vcu; if (V >= 64 * 16) return false;
        const int c = (V & 15) >> 1, cg = c >> 2, cp = (c + i) & 3, sec = cg ? ((0x5730 >> (4 * cp)) & 15) : ((0x4621 >> (4 * cp)) & 15);
        u.p0 = V >> 4; u.p1 = 2 * sec + (V & 1); u.A = (const char*)(A + (size_t)u.p0 * 256 * D); u.B = (const char*)(Bt + (size_t)u.p1 * 256 * D); return true; }
    __device__ __forceinline__ void aoff(const Unit&, int R0, int C0, unsigned (&off)[4]) const { aoff_lin(R0, C0, D * 2, off); }
    __device__ __forceinline__ int epi(const AccT& acc, const Unit& u, int wr, int wc, int fr, int fq) const {
        const int pm = u.p0, pn = u.p1, s = pn >> 1;
        const int row0 = pm * 256 + wr * 64 + fr;
        const int o0 = (pn & 1) * 256 + wc * 32 + 8 * fq;
        const int dbase = (s & 3) * 1024 + (s >> 2) * 512;
        bf16_t* obase = qkvg + (size_t)row0 * INW + dbase;
        if (s == 4 || s == 5) {
            const int d0 = 4 * ((o0 & 127) >> 3);
            const float qs = (s == 5) ? 0.08838834764831845f : 1.0f;
#pragma unroll
            for (int ah = 0; ah < 2; ++ah) {
                f32x4 rc[4][2];
#pragma unroll
                for (int m = 0; m < 4; ++m) { const f32x4* rp = (const f32x4*)(rope + (size_t)(row0 + ah * 128 + m * 16) * 64 + d0); rc[m][0] = rp[0]; rc[m][1] = rp[1]; }
#pragma unroll
                for (int m = 0; m < 4; ++m) {
                    const f32x4 cs = {rc[m][0].x * qs, rc[m][0].z * qs, rc[m][1].x * qs, rc[m][1].z * qs}, sn = {rc[m][0].y * qs, rc[m][0].w * qs, rc[m][1].y * qs, rc[m][1].w * qs};
                    bf16_t* orow = obase + (size_t)(ah * 128 + m * 16) * INW;
#pragma unroll
                    for (int bj = 0; bj < 2; ++bj) {
                        const int hd = (o0 + bj * 128) & ~127;
                        const f32x4 v0 = acc[ah][bj][m][0], v1 = acc[ah][bj][m][1];
                        const f32x4 o1 = v0 * cs - v1 * sn, o2 = v0 * sn + v1 * cs;
                        *(u32x2*)(orow + hd + d0) = (u32x2){cvt_pk_bf16(o1.x, o1.y), cvt_pk_bf16(o1.z, o1.w)};
                        *(u32x2*)(orow + hd + d0 + 64) = (u32x2){cvt_pk_bf16(o2.x, o2.y), cvt_pk_bf16(o2.z, o2.w)};
                    }
                }
            }
        } else if (s == 1) {
#pragma unroll
            for (int bj = 0; bj < 2; ++bj) {
                const int o = o0 + bj * 128;
                const f32x4 l0 = *(const f32x4*)(lb + o), l1 = *(const f32x4*)(lb + o + 4), m0 = 1.0f - l0, m1 = 1.0f - l1;
#pragma unroll
                for (int am = 0; am < 8; ++am) {
                    const size_t ro = (size_t)((am >> 2) * 128 + (am & 3) * 16);
                    const f32x4 v0 = acc[am >> 2][bj][am & 3][0], v1 = acc[am >> 2][bj][am & 3][1];
                    f32x2 g0, g1, g2, g3;
                    const f32x2 k0 = fgate2(v0.xy, l0.xy, m0.xy, g0), k1 = fgate2(v0.zw, l0.zw, m0.zw, g1), k2 = fgate2(v1.xy, l1.xy, m1.xy, g2), k3 = fgate2(v1.zw, l1.zw, m1.zw, g3);
                    *(h16x8*)(gbuf + ((size_t)row0 + ro) * 512 + o) = (h16x8){(_Float16)g0.x, (_Float16)g0.y, (_Float16)g1.x, (_Float16)g1.y, (_Float16)g2.x, (_Float16)g2.y, (_Float16)g3.x, (_Float16)g3.y};
                    u32x4 w; w.x = cvt_pk_bf16(k0.x, k0.y); w.y = cvt_pk_bf16(k1.x, k1.y); w.z = cvt_pk_bf16(k2.x, k2.y); w.w = cvt_pk_bf16(k3.x, k3.y);
                    *(u32x4*)(obase + ro * INW + o) = w;
                }
            }
        } else {
            const bool act = (s == 0 || s == 3 || s == 7);
#pragma unroll
            for (int am = 0; am < 8; ++am) {
                const size_t ro = (size_t)((am >> 2) * 128 + (am & 3) * 16);
#pragma unroll
                for (int bj = 0; bj < 2; ++bj) {
                    f32x4 v0 = acc[am >> 2][bj][am & 3][0], v1 = acc[am >> 2][bj][am & 3][1];
                    if (act) { const f32x2 a0 = silu2(v0.xy), a1 = silu2(v0.zw), a2 = silu2(v1.xy), a3 = silu2(v1.zw); v0 = (f32x4){a0.x, a0.y, a1.x, a1.y}; v1 = (f32x4){a2.x, a2.y, a3.x, a3.y}; }
                    u32x4 w; w.x = cvt_pk_bf16(v0[0], v0[1]); w.y = cvt_pk_bf16(v0[2], v0[3]); w.z = cvt_pk_bf16(v1[0], v1[1]); w.w = cvt_pk_bf16(v1[2], v1[3]);
                    *(u32x4*)(obase + ro * INW + o0 + bj * 128) = w;
                }
            }
        }
            return -1;
    }
};

template <bool R16>
struct PolRes : GemmBase {
    static constexpr int KREP = KREP_RES;
    const bf16_t* A; const bf16_t* Bt; const float* resid; const bf16_t* resid16; bf16_t* outp; const float* gate; const float* bias; const float* scale;
    int K, lda, nN, kcol;
    __device__ __forceinline__ int nt() const { return K / 64; }
    __device__ __forceinline__ unsigned ldb_bytes() const { return (unsigned)K * 2u; }
    __device__ __forceinline__ bool next(int i, Unit& u) const {
        const int V = i * G + vcu; if (V >= 64 * nN) return false;
        u.p0 = V / nN; u.p1 = V % nN; u.A = (const char*)(A + (size_t)u.p0 * 256 * lda + (size_t)u.p1 * kcol); u.B = (const char*)(Bt + (size_t)u.p1 * 256 * K); return true; }
    __device__ __forceinline__ void aoff(const Unit&, int R0, int C0, unsigned (&off)[4]) const { aoff_lin(R0, C0, (unsigned)lda * 2u, off); }
    __device__ __forceinline__ int epi(const AccT& acc, const Unit& u, int wr, int wc, int fr, int fq) const {
        const int row0 = u.p0 * 256 + wr * 64 + fr, col0 = u.p1 * 256 + wc * 32 + 8 * fq;
#pragma unroll
        for (int bj = 0; bj < 2; ++bj) {
            const int c = col0 + bj * 128;
            const f32x4 g0 = *(const f32x4*)(gate + c), g1 = *(const f32x4*)(gate + c + 4);
            f32x4 b0 = {0.f, 0.f, 0.f, 0.f}, b1 = b0, s0 = {1.f, 1.f, 1.f, 1.f}, s1 = s0;
            if (bias) { b0 = *(const f32x4*)(bias + c); b1 = *(const f32x4*)(bias + c + 4); s0 = *(const f32x4*)(scale + c); s1 = *(const f32x4*)(scale + c + 4); }
#pragma unroll
            for (int ah = 0; ah < 2; ++ah) {
                f32x4 r[4][2];
                if constexpr (!R16) {
#pragma unroll
                    for (int m = 0; m < 4; ++m) { const size_t idx = (size_t)(row0 + ah * 128 + m * 16) * D + c; r[m][0] = *(const f32x4*)(resid + idx); r[m][1] = *(const f32x4*)(resid + idx + 4); }
                } else {
                    u32x4 q[4];
#pragma unroll
                    for (int m = 0; m < 4; ++m) q[m] = *(const u32x4*)(resid16 + (size_t)(row0 + ah * 128 + m * 16) * D + c);
#pragma unroll
                    for (int m = 0; m < 4; ++m) { r[m][0] = (f32x4){bflo(q[m].x), bfhi(q[m].x), bflo(q[m].y), bfhi(q[m].y)}; r[m][1] = (f32x4){bflo(q[m].z), bfhi(q[m].z), bflo(q[m].w), bfhi(q[m].w)}; }
                }
#pragma unroll
                for (int m = 0; m < 4; ++m) {
                    const size_t idx = (size_t)(row0 + ah * 128 + m * 16) * D + c;
                    const f32x4 o0 = r[m][0] + g0 * ((acc[ah][bj][m][0] + b0) * s0), o1 = r[m][1] + g1 * ((acc[ah][bj][m][1] + b1) * s1);
                    *(u32x4*)(outp + idx) = (u32x4){cvt_pk_bf16(o0.x, o0.y), cvt_pk_bf16(o0.z, o0.w), cvt_pk_bf16(o1.x, o1.y), cvt_pk_bf16(o1.z, o1.w)};
                }
            }
        }
            return -1;
    }
};

constexpr int MI_TPRE = 16, MI_CNT = 64, MI_MT2E = 128;
__device__ __forceinline__ void expert_tables(Frame& F, int layer) {
    if (F.tid < 64) {
        const int lane = F.lane;
        int c = 0;
        if (lane < NE) { c = (int)__hip_atomic_load(F.ctl + CW_CNT + 64 * layer + lane, __ATOMIC_RELAXED, __HIP_MEMORY_SCOPE_AGENT); if (c > LIST_CAP) c = LIST_CAP; }
        const int nt_ = (c + 255) >> 8;
        int pre = nt_;
#pragma unroll
        for (int off = 1; off < 32; off <<= 1) { const int v = __shfl_up(pre, off); if (lane >= off) pre += v; }
        const int excl = pre - nt_;
        if (lane < NE) { F.MISC[MI_TPRE + lane] = excl; F.MISC[MI_CNT + lane] = c; for (int q = 0; q < nt_; ++q) F.MISC[MI_MT2E + excl + q] = lane; }
        if (lane == NE - 1) F.MISC[MI_TPRE + NE] = pre;
    }
    __syncthreads();
}
constexpr int UPA_OFF = 131072;
struct PolG1 : GemmBase {
    static constexpr int KREP = KREP_G1;
    volatile LAS unsigned* MISC; LAS unsigned char* upa; const bf16_t* hn; const bf16_t* wgut; const float* bgu; const int* lslot; bf16_t* act;
    __device__ __forceinline__ int nt() const { return D / 64; }
    __device__ __forceinline__ unsigned ldb_bytes() const { return D * 2; }
    __device__ __forceinline__ bool next(int i, Unit& u) const {
        const int V = i * G + vcu, MT = (int)MISC[MI_TPRE + NE]; if (V >= MT * 8 || i >= 10) return false;
        const int mt = V >> 3, nt_ = V & 7, e = (int)MISC[MI_MT2E + mt];
        u.p0 = e; u.p1 = mt - (int)MISC[MI_TPRE + e]; u.p2 = nt_; u.p3 = mt; u.ui = i;
        u.A = (const char*)hn; u.B = (const char*)(wgut + ((size_t)e * 2048 + (size_t)nt_ * 256) * D); return true; }
    __device__ __forceinline__ void fill(int tid) const {
#pragma unroll
        for (int k = 0; k < 5; ++k) {
            const int j = tid + NTH * k, i = j >> 8, r = j & 255; Unit u;
            if (next(i, u)) {
                const int cnt = (int)MISC[MI_CNT + u.p0], li = u.p1 * 256 + r;
                ((LAS int*)(upa + i * 2048))[r] = (li < cnt) ? (lslot[(size_t)u.p0 * LIST_CAP + li] >> 2) : 0;
                ((LAS float*)(upa + i * 2048 + 1024))[r] = bgu[(size_t)u.p0 * 2048 + (r >> 7) * 1024 + u.p2 * 128 + (r & 127)];
            }
        }
    }
    __device__ __forceinline__ void aoff(const Unit& u, int R0, int C0, unsigned (&off)[4]) const {
        const LAS int* tk = (const LAS int*)(upa + u.ui * 2048);
#pragma unroll
        for (int q = 0; q < 4; ++q) off[q] = (unsigned)tk[R0 + 64 * (q & 1) + 128 * (q >> 1)] * (D * 2u) + (unsigned)C0 * 2u;
    }
    __device__ __forceinline__ int epi(const AccT& acc, const Unit& u, int wr, int wc, int fr, int fq) const {
        const int cl = wc * 32 + 8 * fq;
        const LAS float* bg = (const LAS float*)(upa + u.ui * 2048 + 1024);
        const f32x4 bgl0 = *(const LAS f32x4*)(bg + cl), bgl1 = *(const LAS f32x4*)(bg + cl + 4), bln0 = *(const LAS f32x4*)(bg + 128 + cl), bln1 = *(const LAS f32x4*)(bg + 128 + cl + 4);
        bf16_t* base = act + ((size_t)u.p3 * 256 + wr * 64 + fr) * D + u.p2 * 128 + cl;
#pragma unroll
        for (int ai = 0; ai < 2; ++ai)
#pragma unroll
            for (int m = 0; m < 4; ++m) {
                f32x4 gl0 = acc[ai][0][m][0] + bgl0, gl1 = acc[ai][0][m][1] + bgl1, ln0 = acc[ai][1][m][0] + bln0, ln1 = acc[ai][1][m][1] + bln1;
                f32x4 a0, a1;
#pragma unroll
                for (int j = 0; j < 4; ++j) {
                    const float x0 = fminf(gl0[j], SW_LIMIT), x1 = fminf(gl1[j], SW_LIMIT);
                    const float y0 = fminf(fmaxf(ln0[j], -SW_LIMIT), SW_LIMIT), y1 = fminf(fmaxf(ln1[j], -SW_LIMIT), SW_LIMIT);
                    a0[j] = x0 * sigmoidf_(SW_ALPHA * x0) * (y0 + 1.0f); a1[j] = x1 * sigmoidf_(SW_ALPHA * x1) * (y1 + 1.0f); }
                u32x4 w; w.x = cvt_pk_bf16(a0[0], a0[1]); w.y = cvt_pk_bf16(a0[2], a0[3]); w.z = cvt_pk_bf16(a1[0], a1[1]); w.w = cvt_pk_bf16(a1[2], a1[3]);
                *(u32x4*)(base + (size_t)(ai * 128 + m * 16) * D) = w;
            }
            return -1;
    }
};
struct PolG2 : GemmBase {
    static constexpr int KREP = KREP_G2;
    volatile LAS unsigned* MISC; LAS unsigned char* upa; const bf16_t* act; const bf16_t* wdnt; const float* bdn; const int* lslot; const float* lw; bf16_t* yslot;
    __device__ __forceinline__ int nt() const { return D / 64; }
    __device__ __forceinline__ unsigned ldb_bytes() const { return D * 2; }
    __device__ __forceinline__ bool next(int i, Unit& u) const {
        const int V = i * G + vcu, MT = (int)MISC[MI_TPRE + NE]; if (V >= MT * 4 || i >= 6) return false;
        const int mt = V >> 2, nt_ = V & 3, e = (int)MISC[MI_MT2E + mt];
        u.p0 = e; u.p1 = mt - (int)MISC[MI_TPRE + e]; u.p2 = nt_; u.p3 = mt; u.ui = i;
        u.A = (const char*)(act + (size_t)mt * 256 * D); u.B = (const char*)(wdnt + ((size_t)e * D + (size_t)nt_ * 256) * D); return true; }
    __device__ __forceinline__ void fill(int tid) const {
#pragma unroll
        for (int k = 0; k < 3; ++k) {
            const int j = tid + NTH * k, i = j >> 8, r = j & 255; Unit u;
            if (next(i, u)) {
                const int cnt = (int)MISC[MI_CNT + u.p0], li = u.p1 * 256 + r; const bool ok = li < cnt;
                ((LAS int*)(upa + i * 3072))[r] = ok ? lslot[(size_t)u.p0 * LIST_CAP + li] : -1;
                ((LAS float*)(upa + i * 3072 + 1024))[r] = ok ? lw[(size_t)u.p0 * LIST_CAP + li] : 0.f;
                ((LAS float*)(upa + i * 3072 + 2048))[r] = bdn[(size_t)u.p0 * D + u.p2 * 256 + r];
            }
        }
    }
    __device__ __forceinline__ void aoff(const Unit&, int R0, int C0, unsigned (&off)[4]) const { aoff_lin(R0, C0, D * 2, off); }
    __device__ __forceinline__ int epi(const AccT& acc, const Unit& u, int wr, int wc, int fr, int fq) const {
        const int cl = wc * 32 + 8 * fq;
        const LAS int* sl = (const LAS int*)(upa + u.ui * 3072); const LAS float* wl = (const LAS float*)(upa + u.ui * 3072 + 1024); const LAS float* bd = (const LAS float*)(upa + u.ui * 3072 + 2048);
        f32x4 b[2][2];
#pragma unroll
        for (int bj = 0; bj < 2; ++bj) { b[bj][0] = *(const LAS f32x4*)(bd + cl + bj * 128); b[bj][1] = *(const LAS f32x4*)(bd + cl + bj * 128 + 4); }
#pragma unroll
        for (int ai = 0; ai < 2; ++ai)
#pragma unroll
            for (int m = 0; m < 4; ++m) {
                const int rl = ai * 128 + wr * 64 + m * 16 + fr;
                const int slot = sl[rl]; const float w = wl[rl];
                if (slot >= 0) {
                    bf16_t* yr = yslot + (size_t)slot * D + u.p2 * 256 + cl;
#pragma unroll
                    for (int bj = 0; bj < 2; ++bj) {
                        const f32x4 v0 = (acc[ai][bj][m][0] + b[bj][0]) * w, v1 = (acc[ai][bj][m][1] + b[bj][1]) * w;
                        u32x4 o; o.x = cvt_pk_bf16(v0[0], v0[1]); o.y = cvt_pk_bf16(v0[2], v0[3]); o.z = cvt_pk_bf16(v1[0], v1[1]); o.w = cvt_pk_bf16(v1[2], v1[3]);
                        *(u32x4*)(yr + bj * 128) = o;
                    }
                }
            }
            return -1;
    }
};

typedef unsigned v4u_t __attribute__((ext_vector_type(4)));
template <bool F8>
struct PolMoE : GemmBase {
    static constexpr int KREP = 1;
    static constexpr bool HAS_READY = true;
    static constexpr bool FP8 = F8;
    static constexpr bool SEAM_OPT = true;
    static constexpr int EB = F8 ? 1 : 2;
    volatile LAS unsigned* MISC; LAS unsigned char* upa; const bf16_t* hn; const bf16_t* wgut; const float* bgu; const int* lslot; const float* lw; bf16_t* act;
    const bf16_t* wdnt; const float* bdn; bf16_t* yslot; unsigned* done; unsigned* tmo; __amdgpu_buffer_rsrc_t act_rsrc;
    __device__ __forceinline__ int nt() const { return D * EB / 128; }
    __device__ __forceinline__ unsigned ldb_bytes() const { return D * EB; }
    __device__ __forceinline__ bool next(int i, Unit& u) const {
        const int V = i * G + vcu, MT = (int)MISC[MI_TPRE + NE], N1 = MT * 8; if (i >= 14 || V >= MT * 12) return false;
        u.ui = i;
        if (V < N1) { const int mt = V >> 3, nt_ = V & 7, e = (int)MISC[MI_MT2E + mt];
            u.p0 = e; u.p1 = mt - (int)MISC[MI_TPRE + e]; u.p2 = nt_; u.p3 = mt;
            u.A = (const char*)hn; u.B = (const char*)wgut + ((size_t)e * 2048 + (size_t)nt_ * 256) * D * EB; }
        else { const int V2 = V - N1, mt = V2 >> 2, nt_ = V2 & 3, e = (int)MISC[MI_MT2E + mt];
            u.p0 = e; u.p1 = mt - (int)MISC[MI_TPRE + e]; u.p2 = nt_ | 8; u.p3 = mt;
            u.A = (const char*)act + (size_t)mt * 256 * D * EB; u.B = (const char*)wdnt + ((size_t)e * D + (size_t)nt_ * 256) * D * EB; }
        return true; }
    __device__ __forceinline__ void fill(int tid) const {
#pragma unroll
        for (int k = 0; k < 7; ++k) {
            const int j = tid + NTH * k, i = j >> 8, r = j & 255; Unit u;
            if (next(i, u)) {
                const int cnt = (int)MISC[MI_CNT + u.p0], li = u.p1 * 256 + r; const bool ok = li < cnt;
                if (!(u.p2 & 8)) {
                    ((LAS int*)(upa + i * 2048))[r] = ok ? (lslot[(size_t)u.p0 * LIST_CAP + li] >> 2) : 0;
                    ((LAS float*)(upa + i * 2048 + 1024))[r] = bgu[(size_t)u.p0 * 2048 + (r >> 7) * 1024 + u.p2 * 128 + (r & 127)] + (float)(r >> 7);
                } else {
                    unsigned pk = 0xffff0000u;
                    if (ok) { const unsigned sl = (unsigned)lslot[(size_t)u.p0 * LIST_CAP + li]; const float w = lw[(size_t)u.p0 * LIST_CAP + li]; pk = (sl & 0xffffu) | (cvt_pk_bf16(0.f, w) & 0xffff0000u); }
                    ((LAS unsigned*)(upa + i * 2048))[r] = pk;
                    ((LAS float*)(upa + i * 2048 + 1024))[r] = bdn[(size_t)u.p0 * D + (u.p2 & 7) * 256 + r];
                }
            }
        }
    }
    __device__ __forceinline__ void aoff(const Unit& u, int R0, int C0, unsigned (&off)[4]) const {
        if (!(u.p2 & 8)) { const LAS int* tk = (const LAS int*)(upa + u.ui * 2048);
#pragma unroll
            for (int q = 0; q < 4; ++q) off[q] = (unsigned)tk[R0 + 64 * (q & 1) + 128 * (q >> 1)] * (unsigned)(D * EB) + (unsigned)C0 * 2u;
        } else aoff_lin(R0, C0, D * EB, off);
    }
    __device__ __forceinline__ void flush(int pend) const {
        if (pend >= 0 && (threadIdx.x & 63) == 0) (void)__hip_atomic_fetch_add(done + 64 * pend, 1u, __ATOMIC_RELAXED, __HIP_MEMORY_SCOPE_AGENT);
    }
    __device__ __forceinline__ void a_ready(const Unit& u) const {
        if (!(u.p2 & 8)) return;
        if (threadIdx.x < 64) {
            unsigned* w = done + 64 * u.p3; unsigned polls = 0;
            while ((unsigned)__builtin_amdgcn_readfirstlane(__hip_atomic_load(w, __ATOMIC_RELAXED, __HIP_MEMORY_SCOPE_AGENT)) < 64u) {
                __builtin_amdgcn_s_sleep(2);
                if ((++polls & 1023u) == 0u) { if (__builtin_amdgcn_readfirstlane(__hip_atomic_load(tmo, __ATOMIC_RELAXED, __HIP_MEMORY_SCOPE_AGENT)) != 0u) break;
                    if (polls > (1u << 22)) { if (threadIdx.x == 0) __hip_atomic_store(tmo, 1u, __ATOMIC_RELAXED, __HIP_MEMORY_SCOPE_AGENT); break; } }
            }
            __builtin_amdgcn_fence(__ATOMIC_ACQUIRE, "agent");
            asm volatile("s_waitcnt vmcnt(0)" ::: "memory");
        }
        asm volatile("" ::: "memory"); __builtin_amdgcn_s_barrier(); asm volatile("" ::: "memory");
    }
    __device__ __forceinline__ int epi(const AccT& acc, const Unit& u, int wr, int wc, int fr, int fq) const {
        const int cl = wc * 32 + 8 * fq;
        if (!(u.p2 & 8)) {
            const LAS float* bg = (const LAS float*)(upa + u.ui * 2048 + 1024);
            const f32x4 bgl0 = *(const LAS f32x4*)(bg + cl), bgl1 = *(const LAS f32x4*)(bg + cl + 4), bln0 = *(const LAS f32x4*)(bg + 128 + cl), bln1 = *(const LAS f32x4*)(bg + 128 + cl + 4);
            const unsigned boff = (unsigned)((((size_t)u.p3 * 256 + wr * 64 + fr) * D + u.p2 * 128 + cl) * EB);
            constexpr float ws = F8 ? (1.0f / W8_SCALE) : 1.0f;
#pragma unroll
            for (int ai = 0; ai < 2; ++ai)
#pragma unroll
                for (int m = 0; m < 4; ++m) {
                    const f32x2 p0 = swiglu2(acc[ai][0][m][0].xy, acc[ai][1][m][0].xy, bgl0.xy, bln0.xy, ws), p1 = swiglu2(acc[ai][0][m][0].zw, acc[ai][1][m][0].zw, bgl0.zw, bln0.zw, ws);
                    const f32x2 p2 = swiglu2(acc[ai][0][m][1].xy, acc[ai][1][m][1].xy, bgl1.xy, bln1.xy, ws), p3 = swiglu2(acc[ai][0][m][1].zw, acc[ai][1][m][1].zw, bgl1.zw, bln1.zw, ws);
                    const f32x4 a0 = {p0.x, p0.y, p1.x, p1.y}, a1 = {p2.x, p2.y, p3.x, p3.y};
                    if constexpr (F8) { u32x2 w8 = {pack_fp8x4(a0[0], a0[1], a0[2], a0[3]), pack_fp8x4(a1[0], a1[1], a1[2], a1[3])};
                        __builtin_amdgcn_raw_buffer_store_b64(w8, act_rsrc, boff + (unsigned)((ai * 128 + m * 16) * D), 0,   16); }
                    else { v4u_t w; w.x = cvt_pk_bf16(a0[0], a0[1]); w.y = cvt_pk_bf16(a0[2], a0[3]); w.z = cvt_pk_bf16(a1[0], a1[1]); w.w = cvt_pk_bf16(a1[2], a1[3]);
                        __builtin_amdgcn_raw_buffer_store_b128(w, act_rsrc, boff + (unsigned)((ai * 128 + m * 16) * D * 2), 0,   16); }
                }
            return u.p3;
        } else {
            const LAS unsigned* sl = (const LAS unsigned*)(upa + u.ui * 2048); const LAS float* bd = (const LAS float*)(upa + u.ui * 2048 + 1024);
            f32x4 b[2][2];
#pragma unroll
            for (int bj = 0; bj < 2; ++bj) { b[bj][0] = *(const LAS f32x4*)(bd + cl + bj * 128); b[bj][1] = *(const LAS f32x4*)(bd + cl + bj * 128 + 4); }
#pragma unroll
            for (int ai = 0; ai < 2; ++ai)
#pragma unroll
                for (int m = 0; m < 4; ++m) {
                    const unsigned pk = sl[ai * 128 + wr * 64 + m * 16 + fr];
                    if ((pk >> 16) != 0xffffu) {
                        const float w = bfhi(pk); constexpr float ws = F8 ? (1.0f / W8_SCALE) : 1.0f;
                        bf16_t* yr = yslot + (size_t)(pk & 0xffffu) * D + (u.p2 & 7) * 256 + cl;
#pragma unroll
                        for (int bj = 0; bj < 2; ++bj) {
                            const f32x4 v0 = (acc[ai][bj][m][0] * ws + b[bj][0]) * w, v1 = (acc[ai][bj][m][1] * ws + b[bj][1]) * w;
                            u32x4 o; o.x = cvt_pk_bf16(v0[0], v0[1]); o.y = cvt_pk_bf16(v0[2], v0[3]); o.z = cvt_pk_bf16(v1[0], v1[1]); o.w = cvt_pk_bf16(v1[2], v1[3]);
                            *(u32x4*)(yr + bj * 128) = o;
                        }
                    }
                }
        }
            return -1;
    }
};

template <class P> __device__ __forceinline__ void run_gemm(Frame& F, const P& S) {
#if SIMPLE_GEMM
    pg8::gemm_simple<P>(F.lds, S);
#else
    pg8::gemm_pipe<P>(F.lds, S);
#endif
}

constexpr int LA_QA = 0, LA_QH = 17408, LA_KA = 34816, LA_VT = 52224, LA_AS = 70656, LA_ST = 79872, LA_QS = 114688, LA_PS = 118784;
constexpr int RS128 = 272, RS64 = 144;
__device__ __forceinline__ float ret_lg(int hh) { return __logf(1.0f - exp2f(-5.0f - (float)(hh - 4))); }
__device__ __forceinline__ u32x4 pack8(const float (&v)[8]) { return (u32x4){cvt_pk_bf16(v[0], v[1]), cvt_pk_bf16(v[2], v[3]), cvt_pk_bf16(v[4], v[5]), cvt_pk_bf16(v[6], v[7])}; }

__device__ __forceinline__ void la_cumsum(const float* gbuf, int hh, int t0, int d0, float (&b0)[8], float (&b1)[8]) {
    if (hh < 4) { float r0 = 0.f, r1 = 0.f;
#pragma unroll
        for (int i = 0; i < 8; ++i) { const f32x2 g = *(const f32x2*)(gbuf + (size_t)(t0 + i) * 512 + hh * 128 + d0); r0 += g.x; r1 += g.y; b0[i] = r0; b1[i] = r1; }
    } else { const float lg = ret_lg(hh);
#pragma unroll
        for (int i = 0; i < 8; ++i) { b0[i] = (float)(i + 1) * lg; b1[i] = b0[i]; }
    }
}

struct LaIn { f32x2 g[8]; unsigned qq[8], kk[8], vv[8]; u32x4 st[4]; u32x2 gt[4]; };
template <bool OUT>
__device__ __forceinline__ void la_load(LaIn& in, const bf16_t* qkvg, const _Float16* gbuf, const bf16_t* sprev, int unit, int oc, int d0, int tid) {
    const int hh = unit >> 8, n = unit & 255, t0 = n * 64 + oc * 8;
    if (hh < 4) {
#pragma unroll
        for (int i = 0; i < 8; ++i) { const h16x2 gh = *(const h16x2*)(gbuf + (size_t)(t0 + i) * 512 + hh * 128 + d0); in.g[i] = (f32x2){(float)gh.x, (float)gh.y}; }
    }
#pragma unroll
    for (int i = 0; i < 8; ++i) { const bf16_t* row = qkvg + (size_t)(t0 + i) * INW + hh * 128 + d0; if (OUT) in.qq[i] = *(const unsigned*)row; in.kk[i] = *(const unsigned*)(row + 1024); in.vv[i] = *(const unsigned*)(row + 2048); }
    if (OUT) {
        const bf16_t* sp = sprev + ((size_t)hh * 256 + n) * 16384;
#pragma unroll
        for (int j = 0; j < 4; ++j) { const int c = tid + NTH * j; in.st[j] = *(const u32x4*)(sp + (c >> 4) * 128 + (c & 15) * 8); }
        const int lane = tid & 63, fr = lane & 15, fq = lane >> 4, tt = oc >> 1, eh = oc & 1;
#pragma unroll
        for (int ei = 0; ei < 4; ++ei) in.gt[ei] = *(const u32x2*)(qkvg + (size_t)(n * 64 + 16 * tt + fr) * INW + 3072 + hh * 128 + 16 * (4 * eh + ei) + 4 * fq);
    }
}
__device__ __forceinline__ void la_cumsum_in(const LaIn& in, int hh, float (&b0)[8], float (&b1)[8]) {
    if (hh < 4) { float r0 = 0.f, r1 = 0.f;
#pragma unroll
        for (int i = 0; i < 8; ++i) { r0 += in.g[i].x; r1 += in.g[i].y; b0[i] = r0; b1[i] = r1; }
    } else { const float lg = ret_lg(hh);
#pragma unroll
        for (int i = 0; i < 8; ++i) { b0[i] = (float)(i + 1) * lg; b1[i] = b0[i]; }
    }
}

__device__ __forceinline__ void la_local_state(Frame& F) {
    const bf16_t* qkvg = WSP(F, WS_QKVG, bf16_t); const _Float16* gbuf = WSP(F, WS_GBUF, _Float16); bf16_t* kvt = WSP(F, WS_KVT, bf16_t); float* dec = WSP(F, WS_DEC, float);
    LAS unsigned char* lds = F.lds; LAS float* qs = (LAS float*)(lds + LA_QS);
    const int lane = F.lane, oc = F.wave, d0 = 2 * lane, fr = lane & 15, fq = lane >> 4;
    LaIn nx;
    if (F.vcu < 2048) la_load<false>(nx, qkvg, gbuf, nullptr, F.vcu, oc, d0, F.tid);
    for (int unit = F.vcu; unit < 2048; unit += F.G) {
        const int hh = unit >> 8, n = unit & 255;
        const LaIn in = nx;
        if (unit + F.G < 2048) la_load<false>(nx, qkvg, gbuf, nullptr, unit + F.G, oc, d0, F.tid);
        float b0[8], b1[8]; la_cumsum_in(in, hh, b0, b1);
        *(LAS f32x2*)(qs + oc * 128 + d0) = (f32x2){b0[7], b1[7]};
        const unsigned (&kk)[8] = in.kk; const unsigned (&vv)[8] = in.vv;
        __syncthreads();
        float base0 = 0.f, base1 = 0.f, tot0 = 0.f, tot1 = 0.f;
#pragma unroll
        for (int o = 0; o < 8; ++o) { const f32x2 q = *(const LAS f32x2*)(qs + o * 128 + d0); if (o < oc) { base0 += q.x; base1 += q.y; } tot0 += q.x; tot1 += q.y; }
        float a0[8], a1[8], c0[8], c1[8];
#pragma unroll
        for (int i = 0; i < 8; ++i) { a0[i] = bflo(kk[i]) * __expf(tot0 - base0 - b0[i]); a1[i] = bfhi(kk[i]) * __expf(tot1 - base1 - b1[i]); c0[i] = bflo(vv[i]); c1[i] = bfhi(vv[i]); }
        *(LAS u32x4*)(lds + LA_QA + d0 * RS64 + oc * 16) = pack8(a0); *(LAS u32x4*)(lds + LA_QA + (d0 + 1) * RS64 + oc * 16) = pack8(a1);
        *(LAS u32x4*)(lds + LA_VT + d0 * RS64 + oc * 16) = pack8(c0); *(LAS u32x4*)(lds + LA_VT + (d0 + 1) * RS64 + oc * 16) = pack8(c1);
        if (oc == 0) *(f32x2*)(dec + ((size_t)hh * 256 + n) * 128 + d0) = (f32x2){__expf(tot0), __expf(tot1)};
        __syncthreads();
        const int et = oc;
        bf16x8 vt[2];
#pragma unroll
        for (int ks = 0; ks < 2; ++ks) vt[ks] = *(const LAS bf16x8*)(lds + LA_VT + (16 * et + fr) * RS64 + (32 * ks + 8 * fq) * 2);
        bf16_t* orow = kvt + (((size_t)hh * 256 + n) * 128 + 16 * et + fr) * 128 + 4 * fq;
#pragma unroll
        for (int dt = 0; dt < 8; ++dt) {
            f32x4 acc = {0.f, 0.f, 0.f, 0.f};
#pragma unroll
            for (int ks = 0; ks < 2; ++ks) { const bf16x8 a = *(const LAS bf16x8*)(lds + LA_QA + (16 * dt + fr) * RS64 + (32 * ks + 8 * fq) * 2); acc = __builtin_amdgcn_mfma_f32_16x16x32_bf16(a, vt[ks], acc, 0, 0, 0); }
            *(u32x2*)(orow + 16 * dt) = (u32x2){cvt_pk_bf16(acc[0], acc[1]), cvt_pk_bf16(acc[2], acc[3])};
        }
        __syncthreads();
    }
}

__device__ __forceinline__ void la_scan(Frame& F) {
    const bf16_t* kvt = WSP(F, WS_KVT, bf16_t); const float* dec = WSP(F, WS_DEC, float); bf16_t* sprev = WSP(F, WS_SPREV, bf16_t);
    for (int idx = F.vcu * NTH + F.tid; idx < 8 * 16384; idx += F.G * NTH) {
        const int hh = idx >> 14, rem = idx & 16383, d = rem & 127;
        const bf16_t* kv = kvt + (size_t)hh * 256 * 16384 + rem; const float* dc = dec + (size_t)hh * 256 * 128 + d; bf16_t* sp = sprev + (size_t)hh * 256 * 16384 + rem;
        float S = 0.f;
        for (int n0 = 0; n0 < 256; n0 += 16) {
            float kvv[16], dd[16];
#pragma unroll
            for (int i = 0; i < 16; ++i) { kvv[i] = bf2f(kv[(size_t)(n0 + i) * 16384]); dd[i] = dc[(n0 + i) * 128]; }
#pragma unroll
            for (int i = 0; i < 16; ++i) { sp[(size_t)(n0 + i) * 16384] = (bf16_t)(cvt_pk_bf16(S, 0.f) & 0xffffu); S = dd[i] * S + kvv[i]; }
        }
    }
}

__device__ __forceinline__ void la_output(Frame& F) {
    const bf16_t* qkvg = WSP(F, WS_QKVG, bf16_t); const _Float16* gbuf = WSP(F, WS_GBUF, _Float16); const bf16_t* sprev = WSP(F, WS_SPREV, bf16_t); bf16_t* cat = WSP(F, WS_CAT, bf16_t);
    LAS unsigned char* lds = F.lds; LAS float* qs = (LAS float*)(lds + LA_QS); LAS float* ps = (LAS float*)(lds + LA_PS);
    const int tid = F.tid, lane = F.lane, oc = F.wave, d0 = 2 * lane, fr = lane & 15, fq = lane >> 4;
    LaIn nx;
    if (F.vcu < 2048) la_load<true>(nx, qkvg, gbuf, sprev, F.vcu, oc, d0, tid);
    for (int unit = F.vcu; unit < 2048; unit += F.G) {
        const int hh = unit >> 8, n = unit & 255;
        const LaIn in = nx;
        if (unit + F.G < 2048) la_load<true>(nx, qkvg, gbuf, sprev, unit + F.G, oc, d0, tid);
        float b0[8], b1[8]; la_cumsum_in(in, hh, b0, b1);
        *(LAS f32x2*)(qs + oc * 128 + d0) = (f32x2){b0[7], b1[7]};
        const unsigned (&qq)[8] = in.qq; const unsigned (&kk)[8] = in.kk; const unsigned (&vv)[8] = in.vv;
#pragma unroll
        for (int j = 0; j < 4; ++j) { const int c = tid + NTH * j; *(LAS u32x4*)(lds + LA_ST + (c >> 4) * RS128 + (c & 15) * 16) = in.st[j]; }
        __syncthreads();
        float base0 = 0.f, base1 = 0.f, bm0 = 0.f, bm1 = 0.f;
#pragma unroll
        for (int o = 0; o < 8; ++o) { const f32x2 q = *(const LAS f32x2*)(qs + o * 128 + d0); if (o < oc) { base0 += q.x; base1 += q.y; } if (o < 4) { bm0 += q.x; bm1 += q.y; } }
        float c0[8], c1[8];
#pragma unroll
        for (int i = 0; i < 8; ++i) {
            const int t = 8 * oc + i; const float bt0 = base0 + b0[i], bt1 = base1 + b1[i];
            const float q0 = bflo(qq[i]), q1 = bfhi(qq[i]), k0 = bflo(kk[i]), k1 = bfhi(kk[i]);
            *(LAS unsigned*)(lds + LA_QA + t * RS128 + d0 * 2) = cvt_pk_bf16(q0 * __expf(bt0 - bm0), q1 * __expf(bt1 - bm1));
            *(LAS unsigned*)(lds + LA_QH + t * RS128 + d0 * 2) = cvt_pk_bf16(q0 * __expf(bt0), q1 * __expf(bt1));
            *(LAS unsigned*)(lds + LA_KA + t * RS128 + d0 * 2) = cvt_pk_bf16(k0 * __expf(bm0 - bt0), k1 * __expf(bm1 - bt1));
            c0[i] = bflo(vv[i]); c1[i] = bfhi(vv[i]);
        }
        *(LAS u32x4*)(lds + LA_VT + d0 * RS64 + oc * 16) = pack8(c0); *(LAS u32x4*)(lds + LA_VT + (d0 + 1) * RS64 + oc * 16) = pack8(c1);
        __syncthreads();
        const int tt = oc >> 1, eh = oc & 1;
        {
            bf16x8 qf[4];
#pragma unroll
            for (int ks = 0; ks < 4; ++ks) qf[ks] = *(const LAS bf16x8*)(lds + LA_QA + (16 * tt + fr) * RS128 + (32 * ks + 8 * fq) * 2);
#pragma unroll
            for (int sti = 0; sti < 2; ++sti) {
                const int st = 2 * eh + sti;
                f32x4 acc = {0.f, 0.f, 0.f, 0.f};
                if (st <= tt) {
#pragma unroll
                    for (int ks = 0; ks < 4; ++ks) { const bf16x8 a = *(const LAS bf16x8*)(lds + LA_KA + (16 * st + fr) * RS128 + (32 * ks + 8 * fq) * 2); acc = __builtin_amdgcn_mfma_f32_16x16x32_bf16(a, qf[ks], acc, 0, 0, 0); }
                    if (st == tt) {
#pragma unroll
                        for (int r = 0; r < 4; ++r) if (4 * fq + r > fr) acc[r] = 0.f;
                    }
                }
                *(LAS u32x2*)(lds + LA_AS + (16 * tt + fr) * RS64 + (16 * st + 4 * fq) * 2) = (u32x2){cvt_pk_bf16(acc[0], acc[1]), cvt_pk_bf16(acc[2], acc[3])};
            }
        }
        __syncthreads();
        f32x4 o[4]; float ss = 0.f;
        {
            bf16x8 af[2], hf[4];
#pragma unroll
            for (int ks = 0; ks < 2; ++ks) af[ks] = *(const LAS bf16x8*)(lds + LA_AS + (16 * tt + fr) * RS64 + (32 * ks + 8 * fq) * 2);
#pragma unroll
            for (int ks = 0; ks < 4; ++ks) hf[ks] = *(const LAS bf16x8*)(lds + LA_QH + (16 * tt + fr) * RS128 + (32 * ks + 8 * fq) * 2);
#pragma unroll
            for (int ei = 0; ei < 4; ++ei) {
                const int et = 4 * eh + ei;
                f32x4 acc = {0.f, 0.f, 0.f, 0.f};
#pragma unroll
                for (int ks = 0; ks < 2; ++ks) { const bf16x8 a = *(const LAS bf16x8*)(lds + LA_VT + (16 * et + fr) * RS64 + (32 * ks + 8 * fq) * 2); acc = __builtin_amdgcn_mfma_f32_16x16x32_bf16(a, af[ks], acc, 0, 0, 0); }
#pragma unroll
                for (int ks = 0; ks < 4; ++ks) { const bf16x8 a = *(const LAS bf16x8*)(lds + LA_ST + (16 * et + fr) * RS128 + (32 * ks + 8 * fq) * 2); acc = __builtin_amdgcn_mfma_f32_16x16x32_bf16(a, hf[ks], acc, 0, 0, 0); }
                o[ei] = acc; ss += (acc[0] * acc[0] + acc[1] * acc[1]) + (acc[2] * acc[2] + acc[3] * acc[3]);
            }
        }
        ss += __shfl_xor(ss, 16); ss += __shfl_xor(ss, 32);
        if (lane < 16) ps[(tt * 2 + eh) * 16 + lane] = ss;
        __syncthreads();
        const float tot = ps[(tt * 2) * 16 + fr] + ps[(tt * 2 + 1) * 16 + fr];
        const float rstd = rsqrtf(tot * (1.f / 128.f) + EPS);
        const float* gain = (hh < 4) ? (inptr(6) + hh * 128) : (inptr(7) + (hh - 4) * 128);
        const size_t rowi = (size_t)(n * 64 + 16 * tt + fr);
#pragma unroll
        for (int ei = 0; ei < 4; ++ei) {
            const int e0 = 16 * (4 * eh + ei) + 4 * fq;
            const f32x4 gn = *(const f32x4*)(gain + e0);
            const u32x2 gt = in.gt[ei];
            const f32x4 v = o[ei] * rstd * gn;
            *(u32x2*)(cat + rowi * D + hh * 128 + e0) = (u32x2){cvt_pk_bf16(v[0] * bflo(gt.x), v[1] * bfhi(gt.x)), cvt_pk_bf16(v[2] * bflo(gt.y), v[3] * bfhi(gt.y))};
        }
        __syncthreads();
    }
}

constexpr int RT_STRIDE = 2064, RT_PART = 32 * RT_STRIDE;
__device__ __forceinline__ void sel4of8(float (&v)[8], const int (&ix)[8], float (&tv)[4], int (&ti)[4]) {
#pragma unroll
    for (int k = 0; k < 4; ++k) {
        float best = v[0]; int bi = ix[0];
#pragma unroll
        for (int q = 1; q < 8; ++q) { const bool better = (v[q] > best) || (v[q] == best && ix[q] < bi); best = better ? v[q] : best; bi = better ? ix[q] : bi; }
        tv[k] = best; ti[k] = bi;
#pragma unroll
        for (int q = 0; q < 8; ++q) v[q] = (ix[q] == bi) ? -INFINITY : v[q];
    }
}
__device__ __forceinline__ void p_route(Frame& F, int layer, const bf16_t* X, int aux = 0) {
    const int tid = F.tid, lane = F.lane;
    LAS unsigned char* lds = F.lds;
    LAS float* ssq = (LAS float*)(lds + 2 * RT_PART);
    LAS f32x4* lgx = (LAS f32x4*)(lds + 2 * RT_PART + 512);
    LAS int* pe = (LAS int*)(lds + 2 * RT_PART + 512 + 8192);
    LAS float* pw = (LAS float*)(pe + 256);
    LAS int* hist = (LAS int*)(pw + 256);
    LAS int* gbase = hist + 32;
    {
        const bf16_t* rt = WSP(F, WS_RT, bf16_t) + (size_t)layer * 2 * 32 * D;
#pragma unroll 4
        for (int j = 0; j < 16; ++j) { const int ch = tid + NTH * j, part = ch >> 12, row = (ch >> 7) & 31, c16 = ch & 127;
            *(LAS u32x4*)(lds + part * RT_PART + row * RT_STRIDE + c16 * 16) = *(const u32x4*)(rt + ((size_t)(part * 32 + row) * D + c16 * 8)); }
    }
    const float* mod = WSP(F, WS_MOD, float) + (size_t)layer * 6 * D;
    int* lslot = WSP(F, WS_LSLOT, int) + (size_t)layer * NE * LIST_CAP; float* lw = WSP(F, WS_LW, float) + (size_t)layer * NE * LIST_CAP;
    if (aux) { lslot = (int*)(F.ws + WS_END); lw = (float*)(F.ws + WS_END + 4 * MiB); }
    unsigned* cntw = F.ctl + CW_CNT + 64 * (layer + 2 * aux);
    const int tile = F.wave & 3, kh = F.wave >> 2, tk = lane & 15, kq = lane >> 4;
    const float* brt = inptr(13) + layer * NE;
    __syncthreads();
    for (int tb = F.vcu; tb < T / 64; tb += F.G) {
        if (tid < 32) hist[tid] = 0;
        const int row = tb * 64 + tile * 16 + tk;
        const bf16_t* xr = X + (size_t)row * D + kh * 512 + 8 * kq;
        float ss = 0.f;
#pragma unroll 8
        for (int s = 0; s < 16; ++s) { const u32x4 q = *(const u32x4*)(xr + 32 * s);
            const f32x4 a = {bflo(q.x), bfhi(q.x), bflo(q.y), bfhi(q.y)}, b = {bflo(q.z), bfhi(q.z), bflo(q.w), bfhi(q.w)};
            ss += (a.x * a.x + a.y * a.y) + (a.z * a.z + a.w * a.w) + (b.x * b.x + b.y * b.y) + (b.z * b.z + b.w * b.w); }
        ss += __shfl_xor(ss, 16); ss += __shfl_xor(ss, 32);
        if (kq == 0) ssq[F.wave * 16 + tk] = ss;
        __syncthreads();
        const float rstd = rsqrtf((ssq[tile * 16 + tk] + ssq[(tile + 4) * 16 + tk]) * (1.f / D) + EPS);
        f32x4 acc[2] = {{0.f, 0.f, 0.f, 0.f}, {0.f, 0.f, 0.f, 0.f}};
        bf16_t* hrow = WSP(F, WS_HN, bf16_t) + (size_t)row * D;
#pragma unroll 2
        for (int s = 0; s < 16; ++s) {
            const int col = kh * 512 + 32 * s + 8 * kq;
            const u32x4 q = *(const u32x4*)(xr + 32 * s);
            const f32x4 a = {bflo(q.x), bfhi(q.x), bflo(q.y), bfhi(q.y)}, b = {bflo(q.z), bfhi(q.z), bflo(q.w), bfhi(q.w)};
            const f32x4 sc0 = *(const f32x4*)(mod + 4 * D + col) + 1.0f, sc1 = *(const f32x4*)(mod + 4 * D + col + 4) + 1.0f;
            const f32x4 sh0 = *(const f32x4*)(mod + 3 * D + col), sh1 = *(const f32x4*)(mod + 3 * D + col + 4);
            const f32x4 h0 = a * rstd * sc0 + sh0, h1 = b * rstd * sc1 + sh1;
            u32x4 hi; hi.x = cvt_pk_bf16(h0.x, h0.y); hi.y = cvt_pk_bf16(h0.z, h0.w); hi.z = cvt_pk_bf16(h1.x, h1.y); hi.w = cvt_pk_bf16(h1.z, h1.w);
            if ((FP8_LAYERS >> layer) & 1) *(u32x2*)(WSP(F, WS_HN8, unsigned char) + (size_t)row * D + col) = (u32x2){pack_fp8x4(h0.x, h0.y, h0.z, h0.w), pack_fp8x4(h1.x, h1.y, h1.z, h1.w)};
            else *(u32x4*)(hrow + col) = hi;
            u32x4 lo; lo.x = cvt_pk_bf16(h0.x - bflo(hi.x), h0.y - bfhi(hi.x)); lo.y = cvt_pk_bf16(h0.z - bflo(hi.y), h0.w - bfhi(hi.y));
            lo.z = cvt_pk_bf16(h1.x - bflo(hi.z), h1.y - bfhi(hi.z)); lo.w = cvt_pk_bf16(h1.z - bflo(hi.w), h1.w - bfhi(hi.w));
            const bf16x8 bh = __builtin_bit_cast(bf16x8, hi), bl = __builtin_bit_cast(bf16x8, lo);
#pragma unroll
            for (int et = 0; et < 2; ++et) {
                const bf16x8 wh = *(const LAS bf16x8*)(lds + (16 * et + tk) * RT_STRIDE + col * 2);
                const bf16x8 wl = *(const LAS bf16x8*)(lds + RT_PART + (16 * et + tk) * RT_STRIDE + col * 2);
                acc[et] = __builtin_amdgcn_mfma_f32_16x16x32_bf16(wh, bh, acc[et], 0, 0, 0);
                acc[et] = __builtin_amdgcn_mfma_f32_16x16x32_bf16(wl, bh, acc[et], 0, 0, 0);
                acc[et] = __builtin_amdgcn_mfma_f32_16x16x32_bf16(wh, bl, acc[et], 0, 0, 0);
            }
        }
        if (kh == 1) { lgx[(tile * 2 + 0) * 64 + lane] = acc[0]; lgx[(tile * 2 + 1) * 64 + lane] = acc[1]; }
        __syncthreads();
        if (kh == 0) {
            float cv[8]; int ci[8];
#pragma unroll
            for (int et = 0; et < 2; ++et) { const f32x4 o = lgx[(tile * 2 + et) * 64 + lane]; const f32x4 bb = *(const f32x4*)(brt + 16 * et + 4 * kq);
#pragma unroll
                for (int r = 0; r < 4; ++r) { cv[et * 4 + r] = acc[et][r] + o[r] + bb[r]; ci[et * 4 + r] = 16 * et + 4 * kq + r; } }
            float tv[4]; int ti[4];
            sel4of8(cv, ci, tv, ti);
#pragma unroll
            for (int off = 16; off <= 32; off <<= 1) {
                float mv[8]; int mi[8];
#pragma unroll
                for (int k = 0; k < 4; ++k) { mv[k] = tv[k]; mi[k] = ti[k]; mv[4 + k] = __shfl_xor(tv[k], off); mi[4 + k] = __shfl_xor(ti[k], off); }
                sel4of8(mv, mi, tv, ti);
            }
            const float e1 = __expf(tv[1] - tv[0]), e2 = __expf(tv[2] - tv[0]), e3 = __expf(tv[3] - tv[0]); const float inv = 1.0f / (1.0f + e1 + e2 + e3);
            if (kq == 0) { const int tl = tile * 16 + tk;
                pe[tl * 4 + 0] = ti[0]; pe[tl * 4 + 1] = ti[1]; pe[tl * 4 + 2] = ti[2]; pe[tl * 4 + 3] = ti[3];
                pw[tl * 4 + 0] = inv; pw[tl * 4 + 1] = e1 * inv; pw[tl * 4 + 2] = e2 * inv; pw[tl * 4 + 3] = e3 * inv; }
        }
        __syncthreads();
        int myexp = 0, lpos = 0;
        if (tid < 256) { myexp = pe[tid]; lpos = __hip_atomic_fetch_add(hist + myexp, 1, __ATOMIC_RELAXED, __HIP_MEMORY_SCOPE_WORKGROUP); }
        __syncthreads();
        if (tid < 32) gbase[tid] = (int)atomicAdd(cntw + tid, (unsigned)hist[tid]);
        __syncthreads();
        if (tid < 256) { const int pos = gbase[myexp] + lpos; if (pos < LIST_CAP) { lslot[(size_t)myexp * LIST_CAP + pos] = tb * 256 + tid; lw[(size_t)myexp * LIST_CAP + pos] = pw[tid]; } }
        __syncthreads();
    }
}

template <int MODE>
__device__ __forceinline__ void p_combine(Frame& F, int layer, const bf16_t* Xin, void* Xout_) {
    const int lane = F.lane;
    const float* mod = WSP(F, WS_MOD, float) + (size_t)layer * 6 * D;
    const bf16_t* ys = WSP(F, WS_YSLOT, bf16_t);
    f32x4 gf[4], fnw[4];
#pragma unroll
    for (int j = 0; j < 4; ++j) { gf[j] = *(const f32x4*)(mod + 5 * D + 4 * lane + 256 * j); if (MODE == 1) fnw[j] = *(const f32x4*)(inptr(18) + 4 * lane + 256 * j); }
    for (int it = 0; it < (T / 64 + F.G - 1) / F.G * 8; ++it) {
        const int row = ((it >> 3) * F.G + F.vcu) * 64 + F.wave * 8 + (it & 7); if (row >= T) break;
        const u32x2* xr = (const u32x2*)(Xin + (size_t)row * D) + lane;
        f32x4 v[4]; float s = 0.f;
#pragma unroll
        for (int j = 0; j < 4; ++j) {
            f32x4 a = {0.f, 0.f, 0.f, 0.f};
#pragma unroll
            for (int k = 0; k < 4; ++k) { const u32x2 y = *((const u32x2*)(ys + ((size_t)row * 4 + k) * D) + lane + 64 * j); a += (f32x4){bflo(y.x), bfhi(y.x), bflo(y.y), bfhi(y.y)}; }
            const u32x2 xq = xr[64 * j];
            v[j] = (f32x4){bflo(xq.x), bfhi(xq.x), bflo(xq.y), bfhi(xq.y)} + gf[j] * a;
            if (MODE == 0) { const u32x2 w = {cvt_pk_bf16(v[j].x, v[j].y), cvt_pk_bf16(v[j].z, v[j].w)};
                ((u32x2*)((bf16_t*)Xout_ + (size_t)row * D) + lane)[64 * j] = w; v[j] = (f32x4){bflo(w.x), bfhi(w.x), bflo(w.y), bfhi(w.y)}; }
            s += (v[j].x * v[j].x + v[j].y * v[j].y) + (v[j].z * v[j].z + v[j].w * v[j].w);
        }
        const float rstd = rsqrtf(wave_sum(s) * (1.f / D) + EPS);
        if (MODE == 0) { if (lane == 0) WSP(F, WS_RSTD, float)[row] = rstd; }
        else { f32x4* o = (f32x4*)((float*)Xout_ + (size_t)row * D) + lane;
#pragma unroll
            for (int j = 0; j < 4; ++j) __builtin_nontemporal_store(v[j] * rstd * fnw[j], o + 64 * j);
        }
    }
}

template <int W>
__device__ __forceinline__ void pool_unit(const bf16_t* X, const float* rs, bf16_t* P, int c, int t0, float sh, float sc) {
    float hp[16], hc[16];
#pragma unroll
    for (int i = 0; i < 16; ++i) { const int t = t0 - 16 + i; hp[i] = (i >= 16 - (W - 1) && t >= 0) ? bf2f(X[(size_t)t * D + c]) * rs[t] * sc + sh : 0.f; }
    float sum = 0.f;
#pragma unroll
    for (int i = 1; i < W; ++i) sum += hp[16 - i];
#pragma unroll
    for (int blk = 0; blk < 2; ++blk) {
        const int tb = t0 + 16 * blk;
#pragma unroll
        for (int i = 0; i < 16; ++i) hc[i] = bf2f(X[(size_t)(tb + i) * D + c]) * rs[tb + i] * sc + sh;
#pragma unroll
        for (int i = 0; i < 16; ++i) {
            const int t = tb + i;
            sum += hc[i];
            const int cnt = (t + 1 < W) ? (t + 1) : W;
            const float p = sum / (float)cnt - hc[i];
            P[(size_t)t * D + c] = (bf16_t)(cvt_pk_bf16(p, 0.f) & 0xffffu);
            sum -= (i - (W - 1) >= 0) ? hc[(i - (W - 1)) & 15] : hp[(16 + i - (W - 1)) & 15];
        }
#pragma unroll
        for (int i = 0; i < 16; ++i) hp[i] = hc[i];
    }
}
__device__ __forceinline__ void p_pool(Frame& F, const bf16_t* X) {
    const float* mod = WSP(F, WS_MOD, float) + (size_t)1 * 6 * D; const float* rs = WSP(F, WS_RSTD, float); bf16_t* P = WSP(F, WS_HN, bf16_t);
    const int tid = F.tid;
    for (int u = F.vcu; u < 1024; u += F.G) {
        const int tt = u >> 2, g = u & 3;
        const int c = g * 256 + (tid & 255), t0 = tt * 64 + (tid >> 8) * 32;
        const float sh = mod[0 * D + c], sc = 1.0f + mod[1 * D + c];
        if (g == 0) pool_unit<2>(X, rs, P, c, t0, sh, sc);
        else if (g == 1) pool_unit<4>(X, rs, P, c, t0, sh, sc);
        else if (g == 2) pool_unit<8>(X, rs, P, c, t0, sh, sc);
        else pool_unit<16>(X, rs, P, c, t0, sh, sc);
    }
}

constexpr int PG_STRIDE = 2064;
constexpr int PG_RS = 64 * PG_STRIDE;
template <int W>
__device__ __forceinline__ void pool_pair(const bf16_t* xcol, const LAS float* rsl, LAS unsigned* Pd, int t0, f32x2 sh, f32x2 sc) {
    f32x2 hp[16], hc[16];
#pragma unroll
    for (int i = 0; i < 16; ++i) { const int t = t0 - 16 + i; hp[i] = (f32x2){0.f, 0.f};
        if (i >= 16 - (W - 1) && t >= 0) { const unsigned q = *(const unsigned*)(xcol + (size_t)t * D); hp[i] = (f32x2){bflo(q), bfhi(q)} * rsl[i] * sc + sh; } }
    f32x2 sum = {0.f, 0.f};
#pragma unroll
    for (int i = 1; i < W; ++i) sum += hp[16 - i];
#pragma unroll 2
    for (int blk = 0; blk < 4; ++blk) {
        const int tb = t0 + 16 * blk;
#pragma unroll
        for (int i = 0; i < 16; ++i) { const unsigned q = *(const unsigned*)(xcol + (size_t)(tb + i) * D); hc[i] = (f32x2){bflo(q), bfhi(q)} * rsl[16 + 16 * blk + i] * sc + sh; }
#pragma unroll
        for (int i = 0; i < 16; ++i) {
            const int t = tb + i;
            sum += hc[i];
            const float inv = 1.0f / (float)((t + 1 < W) ? (t + 1) : W);
            const f32x2 p = sum * inv - hc[i];
            Pd[(size_t)(16 * blk + i) * (PG_STRIDE / 4)] = cvt_pk_bf16(p.x, p.y);
            sum -= (i - (W - 1) >= 0) ? hc[(i - (W - 1)) & 15] : hp[(16 + i - (W - 1)) & 15];
        }
#pragma unroll
        for (int i = 0; i < 16; ++i) hp[i] = hc[i];
    }
}
__device__ __forceinline__ void p_pool_gemm(Frame& F, const bf16_t* X2, bf16_t* X1) {
    const float* mod = WSP(F, WS_MOD, float) + (size_t)1 * 6 * D; const float* rs = WSP(F, WS_RSTD, float); const bf16_t* pwt = WSP(F, WS_POOLT, bf16_t);
    const float* pb = inptr(10); const float* psc = inptr(11);
    LAS unsigned char* lds = F.lds; LAS float* rsl = (LAS float*)(lds + PG_RS);
    const int tid = F.tid, lane = F.lane, w = F.wave, fr = lane & 15, fq = lane >> 4;
    for (int tb = F.vcu; tb < T / 64; tb += F.G) {
        const int t0 = tb * 64;
        if (tid < 80) { const int t = t0 - 16 + tid; rsl[tid] = (t >= 0) ? rs[t] : 0.f; }
        __syncthreads();
        {
            const int c2 = 2 * tid, gq = w >> 1;
            const f32x2 sh = *(const f32x2*)(mod + 0 * D + c2), sc = *(const f32x2*)(mod + 1 * D + c2) + 1.0f;
            LAS unsigned* Pd = (LAS unsigned*)(lds + c2 * 2);
            if (gq == 0) pool_pair<2>(X2 + c2, rsl, Pd, t0, sh, sc);
            else if (gq == 1) pool_pair<4>(X2 + c2, rsl, Pd, t0, sh, sc);
            else if (gq == 2) pool_pair<8>(X2 + c2, rsl, Pd, t0, sh, sc);
            else pool_pair<16>(X2 + c2, rsl, Pd, t0, sh, sc);
        }
        __syncthreads();
#pragma unroll 1
        for (int g = 0; g < 4; ++g) {
            f32x4 acc[2][4];
#pragma unroll
            for (int nt = 0; nt < 2; ++nt)
#pragma unroll
                for (int tt = 0; tt < 4; ++tt) acc[nt][tt] = (f32x4){0.f, 0.f, 0.f, 0.f};
            bf16x8 wf[2][8];
#pragma unroll
            for (int nt = 0; nt < 2; ++nt)
#pragma unroll
                for (int ks = 0; ks < 8; ++ks) wf[nt][ks] = *(const bf16x8*)(pwt + ((size_t)g * 256 + 32 * w + 16 * nt + fr) * 256 + 32 * ks + 8 * fq);
            u32x2 xq[2][4];
#pragma unroll
            for (int nt = 0; nt < 2; ++nt)
#pragma unroll
                for (int tt = 0; tt < 4; ++tt) xq[nt][tt] = *(const u32x2*)(X2 + (size_t)(t0 + 16 * tt + fr) * D + 256 * g + 32 * w + 16 * nt + 4 * fq);
#pragma unroll
            for (int ks = 0; ks < 8; ++ks) {
                bf16x8 af[4];
#pragma unroll
                for (int tt = 0; tt < 4; ++tt) af[tt] = *(const LAS bf16x8*)(lds + (16 * tt + fr) * PG_STRIDE + (256 * g + 32 * ks + 8 * fq) * 2);
#pragma unroll
                for (int nt = 0; nt < 2; ++nt)
#pragma unroll
                    for (int tt = 0; tt < 4; ++tt) acc[nt][tt] = __builtin_amdgcn_mfma_f32_16x16x32_bf16(wf[nt][ks], af[tt], acc[nt][tt], 0, 0, 0);
            }
#pragma unroll
            for (int nt = 0; nt < 2; ++nt) {
                const int col = 256 * g + 32 * w + 16 * nt + 4 * fq;
                const f32x4 gmv = *(const f32x4*)(mod + 2 * D + col), bv = *(const f32x4*)(pb + col), sv = *(const f32x4*)(psc + col);
#pragma unroll
                for (int tt = 0; tt < 4; ++tt) {
                    const size_t idx = (size_t)(t0 + 16 * tt + fr) * D + col;
                    const f32x4 xv = {bflo(xq[nt][tt].x), bfhi(xq[nt][tt].x), bflo(xq[nt][tt].y), bfhi(xq[nt][tt].y)};
                    const f32x4 o = xv + gmv * ((acc[nt][tt] + bv) * sv);
                    *(u32x2*)(X1 + idx) = (u32x2){cvt_pk_bf16(o.x, o.y), cvt_pk_bf16(o.z, o.w)};
                }
            }
        }
        __syncthreads();
    }
}

constexpr int N_PHASES = 17;
__global__ void __launch_bounds__(NTH, 2) fwd_kernel(Args args) {
    extern __shared__ __attribute__((aligned(16))) unsigned char lds_raw[];
    Frame F;
    F.lds = (LAS unsigned char*)lds_raw;
    F.MISC = (volatile LAS unsigned*)(F.lds + MISC_OFF);
    F.tid = threadIdx.x; F.lane = F.tid & 63; F.wave = __builtin_amdgcn_readfirstlane(F.tid >> 6);
    F.G = gridDim.x; { const int bx = blockIdx.x; F.vcu = (F.G % 8 == 0) ? (bx % 8) * (F.G / 8) + bx / 8 : bx; }
    F.ws = args.ws; F.ctl = (unsigned*)(args.ws + WS_CTL); F.out = args.out;
    for (int u = F.tid; u < (LDS_BYTES - MISC_OFF) / 4; u += NTH) F.MISC[u] = 0u;
    __syncthreads();
#if N_LAUNCH_MODE == 1
    XcdBarrier bar = xcd_barrier_post(F.ctl + CW_BAR, F.MISC + 8);
#define GRID_BAR() xcd_barrier(bar)
#else
#define GRID_BAR() do { } while (0)
#endif
    const int lo = args.ph_lo, hi = args.ph_hi;
#define IN(k) (lo <= (k) && (k) < hi)
#define SEAM(k) do { if (IN(k) && IN((k) + 1)) GRID_BAR(); } while (0)
    GemmBase gb; gb.G = F.G; gb.vcu = F.vcu;
    bf16_t* X1 = WSP(F, WS_X1, bf16_t); bf16_t* X2 = WSP(F, WS_X2, bf16_t);
    const float* mod0 = WSP(F, WS_MOD, float); const float* mod1 = mod0 + 6 * D;

    if (IN(0)) { p0_prologue(F); } SEAM(0);
    if (IN(1)) { p1_norm_in(F); } SEAM(1);
    if (IN(2)) { PolWin P; (GemmBase&)P = gb; P.A = WSP(F, WS_HN, bf16_t); P.Bt = WSP(F, WS_WINT, bf16_t); P.qkvg = WSP(F, WS_QKVG, bf16_t); P.gbuf = WSP(F, WS_GBUF, _Float16);
        P.lb = WSP(F, WS_LB, float); P.rope = WSP(F, WS_ROPE, f32x2); run_gemm(F, P); } SEAM(2);
    if (IN(3)) { la_local_state(F); } SEAM(3);
    if (IN(4)) { la_scan(F); } SEAM(4);
    if (IN(5)) { la_output(F); } SEAM(5);
    if (IN(6)) { PolRes<false> P; (GemmBase&)P = gb; P.A = WSP(F, WS_CAT, bf16_t); P.Bt = WSP(F, WS_WOUTT, bf16_t); P.resid = inptr(0); P.resid16 = nullptr; P.outp = X1; P.gate = mod0 + 2 * D; P.bias = nullptr; P.scale = nullptr;
        P.K = D; P.lda = D; P.nN = 4; P.kcol = 0; run_gemm(F, P); } SEAM(6);
    if (IN(7)) { p_route(F, 0, X1, args.aux); } SEAM(7);
    if (IN(8)) { expert_tables(F, 0); PolMoE<((FP8_LAYERS >> 0) & 1) != 0> P; (GemmBase&)P = gb; P.MISC = F.MISC; P.upa = F.lds + UPA_OFF; P.hn = ((FP8_LAYERS >> 0) & 1) ? (const bf16_t*)WSP(F, WS_HN8, unsigned char) : WSP(F, WS_HN, bf16_t);
        P.wgut = WSP(F, WS_WGUT, bf16_t) + (size_t)0 * NE * 2048 * D; P.bgu = inptr(15) + (size_t)0 * NE * 2048; P.lslot = WSP(F, WS_LSLOT, int) + (size_t)0 * NE * LIST_CAP; P.lw = WSP(F, WS_LW, float) + (size_t)0 * NE * LIST_CAP;
        P.act = (bf16_t*)(F.ws + (0 ? WS_ACT2 : WS_ACT)); P.wdnt = WSP(F, WS_WDNT, bf16_t) + (size_t)0 * NE * D * D; P.bdn = inptr(17) + (size_t)0 * NE * D; P.yslot = WSP(F, WS_YSLOT, bf16_t);
        P.done = F.ctl + CW_DONE + 0 * DONE_LAYER; P.tmo = F.ctl + CW_TMO; P.act_rsrc = __builtin_amdgcn_make_buffer_rsrc((void*)P.act, (short)0, (int)((size_t)ACT_ROWS * D * 2), 0x00020000);
        P.fill(F.tid); __syncthreads(); run_gemm(F, P); } if (IN(8) && IN(10)) GRID_BAR();
    if (IN(10)) { p_combine<0>(F, 0, X1, X2); } SEAM(10);
    if (IN(11)) { p_pool_gemm(F, X2, X1); asm volatile("s_waitcnt vmcnt(0)" ::: "memory"); __syncthreads(); p_route(F, 1, X1, args.aux); } if (IN(11) && IN(14)) GRID_BAR();
    if (IN(14)) { expert_tables(F, 1); PolMoE<((FP8_LAYERS >> 1) & 1) != 0> P; (GemmBase&)P = gb; P.MISC = F.MISC; P.upa = F.lds + UPA_OFF; P.hn = ((FP8_LAYERS >> 1) & 1) ? (const bf16_t*)WSP(F, WS_HN8, unsigned char) : WSP(F, WS_HN, bf16_t);
        P.wgut = WSP(F, WS_WGUT, bf16_t) + (size_t)1 * NE * 2048 * D; P.bgu = inptr(15) + (size_t)1 * NE * 2048; P.lslot = WSP(F, WS_LSLOT, int) + (size_t)1 * NE * LIST_CAP; P.lw = WSP(F, WS_LW, float) + (size_t)1 * NE * LIST_CAP;
        P.act = (bf16_t*)(F.ws + (1 ? WS_ACT2 : WS_ACT)); P.wdnt = WSP(F, WS_WDNT, bf16_t) + (size_t)1 * NE * D * D; P.bdn = inptr(17) + (size_t)1 * NE * D; P.yslot = WSP(F, WS_YSLOT, bf16_t);
        P.done = F.ctl + CW_DONE + 1 * DONE_LAYER; P.tmo = F.ctl + CW_TMO; P.act_rsrc = __builtin_amdgcn_make_buffer_rsrc((void*)P.act, (short)0, (int)((size_t)ACT_ROWS * D * 2), 0x00020000);
        P.fill(F.tid); __syncthreads(); run_gemm(F, P); } if (IN(14) && IN(16)) GRID_BAR();
    if (IN(16)) { p_combine<1>(F, 1, X1, F.out); }
#undef IN
#undef SEAM
}

extern "C" void kernel_launch(void* const* d_in, const int* in_sizes, int n_in, void* d_out, int out_size, void* d_ws, size_t ws_size, hipStream_t stream) {
    static int grid = 0;
    if (grid == 0) {
        if (n_in != 19 || out_size != T * D || ws_size < WS_END) { fprintf(stderr, "kernel_launch: unexpected shapes (n_in %d, out %d, ws %zu)\n", n_in, out_size, ws_size); grid = -1; return; }
        int dev = 0, cus = 0, per_cu = 0;
        if (hipGetDevice(&dev) != hipSuccess || hipDeviceGetAttribute(&cus, hipDeviceAttributeMultiprocessorCount, dev) != hipSuccess) { grid = -1; return; }
        if (hipFuncSetAttribute((const void*)fwd_kernel, hipFuncAttributeMaxDynamicSharedMemorySize, LDS_BYTES) != hipSuccess) { fprintf(stderr, "kernel_launch: hipFuncSetAttribute failed\n"); grid = -1; return; }
        if (hipOccupancyMaxActiveBlocksPerMultiprocessor(&per_cu, (const void*)fwd_kernel, NTH, LDS_BYTES) != hipSuccess || per_cu < 1) { fprintf(stderr, "kernel_launch: occupancy query says %d\n", per_cu); }
        (void)hipGetLastError();
        grid = cus;
    }
    if (grid < 0) return;
    (void)hipMemsetAsync((char*)d_ws + WS_CTL, 0, CTL_BYTES, stream);
    Args a{};
    for (int i = 0; i < 19; ++i) a.in[i] = (const float*)d_in[i];
    a.out = (float*)d_out; a.ws = (unsigned char*)d_ws;
#if N_LAUNCH_MODE == 1
    a.ph_lo = 0; a.ph_hi = N_PHASES;
    void* kargs[] = {&a};
    hipError_t e = hipLaunchCooperativeKernel((const void*)fwd_kernel, dim3(grid), dim3(NTH), kargs, LDS_BYTES, stream);
    if (e != hipSuccess) fprintf(stderr, "cooperative launch failed: %s\n", hipGetErrorString(e));
#else
    for (int p = 0; p < N_PHASES; ++p) {
        a.ph_lo = p; a.ph_hi = p + 1;
        hipLaunchKernelGGL(fwd_kernel, dim3(grid), dim3(NTH), LDS_BYTES, stream, a);
        if (p == DUP_PHASE) { a.aux = 1; hipLaunchKernelGGL(fwd_kernel, dim3(grid), dim3(NTH), LDS_BYTES, stream, a); a.aux = 0; }
    }
#endif
}
```

```cpp
#include <hip/hip_runtime.h>
#include <cstdio>
#include <cstdint>

#ifndef N_LAUNCH_MODE
#define N_LAUNCH_MODE 1
#endif
#ifndef DUP_PHASE
#define DUP_PHASE -1
#endif
#ifndef KREP_WIN
#define KREP_WIN 1
#endif
#ifndef KREP_RES
#define KREP_RES 1
#endif
#ifndef KREP_G1
#define KREP_G1 1
#endif
#ifndef KREP_G2
#define KREP_G2 1
#endif
#ifndef GEMM_KREP
#define GEMM_KREP 1
#endif
#ifndef GEMM_EPIREP
#define GEMM_EPIREP 1
#endif
#ifndef FP8_LAYERS
#define FP8_LAYERS 3
#endif
#ifndef WIN_FP8
#define WIN_FP8 1
#endif
#ifndef SIMPLE_GEMM
#define SIMPLE_GEMM 0
#endif

#define LAS __attribute__((address_space(3)))
#define GAS __attribute__((address_space(1)))
typedef unsigned short bf16_t;
typedef short bf16x8 __attribute__((ext_vector_type(8)));
typedef float f32x4 __attribute__((ext_vector_type(4)));
typedef float f32x2 __attribute__((ext_vector_type(2)));
typedef unsigned u32x4 __attribute__((ext_vector_type(4)));
typedef unsigned u32x2 __attribute__((ext_vector_type(2)));
typedef _Float16 h16x2 __attribute__((ext_vector_type(2)));
typedef _Float16 h16x8 __attribute__((ext_vector_type(8)));
typedef int v4i_t __attribute__((ext_vector_type(4)));
typedef int v8i_t __attribute__((ext_vector_type(8)));
constexpr float W8_SCALE = 32.0f;
__device__ __forceinline__ unsigned pack_fp8x4(float a, float b, float c, float d) { int w = __builtin_amdgcn_cvt_pk_fp8_f32(a, b, 0, false); w = __builtin_amdgcn_cvt_pk_fp8_f32(c, d, w, true); return (unsigned)w; }

constexpr int T = 16384, D = 1024, NE = 32, TOPK = 4, DEPTH = 2;
constexpr int INW = 4096;
constexpr int NTH = 512, NWAVES = 8;
constexpr float EPS = 1e-6f;
constexpr float SW_LIMIT = 7.0f, SW_ALPHA = 1.702f;
constexpr int LIST_CAP = T;
constexpr int ACT_ROWS = T * TOPK + NE * 256;

constexpr size_t MiB = 1u << 20;
constexpr size_t WS_CTL = 0, CTL_BYTES = 1 * MiB;
constexpr size_t WS_MOD = 1 * MiB;
constexpr size_t WS_LB = WS_MOD + 65536;
constexpr size_t WS_ROPE = 2 * MiB;
constexpr size_t WS_WINT = 10 * MiB;
constexpr size_t WS_WOUTT = 18 * MiB;
constexpr size_t WS_POOLT = 20 * MiB;
constexpr size_t WS_LSLOT = 22 * MiB;
constexpr size_t WS_LW = 26 * MiB;
constexpr size_t WS_RT = 21 * MiB;
constexpr size_t WS_RSTD = 30 * MiB;
constexpr size_t WS_WGUT = 32 * MiB;
constexpr size_t WS_WDNT = 288 * MiB;
constexpr size_t WS_HN = 416 * MiB;
constexpr size_t WS_QKVG = 448 * MiB;
constexpr size_t WS_GBUF = 576 * MiB;
constexpr size_t WS_KVT = 608 * MiB;
constexpr size_t WS_SPREV = 736 * MiB;
constexpr size_t WS_DEC = 800 * MiB;
constexpr size_t WS_CAT = 802 * MiB;
constexpr size_t WS_X1 = 834 * MiB;
constexpr size_t WS_X2 = 898 * MiB;
constexpr size_t WS_ACT = 962 * MiB;
constexpr size_t WS_YSLOT = 1106 * MiB;
constexpr size_t WS_ACT2 = 1234 * MiB;
constexpr size_t WS_HN8 = 1378 * MiB;
constexpr size_t WS_END = 1394 * MiB;
constexpr int CW_CNT = 64;
constexpr int CW_BAR = 4096;
constexpr int CW_TMO = 8;
constexpr int CW_DONE = 8192, DONE_LAYER = 320 * 64;

constexpr int SCR_BYTES = 156 * 1024;
constexpr int MISC_OFF = SCR_BYTES;
constexpr int LDS_BYTES = SCR_BYTES + 4096;

typedef __bf16 bf16x2_t __attribute__((ext_vector_type(2)));
__device__ __forceinline__ unsigned cvt_pk_bf16(float lo, float hi) { const f32x2 v = {lo, hi}; const bf16x2_t b = __builtin_convertvector(v, bf16x2_t); return __builtin_bit_cast(unsigned, b); }
__device__ __forceinline__ float bf2f(unsigned short b) { return __builtin_bit_cast(float, (unsigned)b << 16); }
__device__ __forceinline__ float bflo(unsigned w) { return __builtin_bit_cast(float, w << 16); }
__device__ __forceinline__ float bfhi(unsigned w) { return __builtin_bit_cast(float, w & 0xffff0000u); }
__device__ __forceinline__ float wave_sum(float v) {
#pragma unroll
    for (int o = 1; o < 64; o <<= 1) v += __shfl_xor(v, o);
    return v;
}
__device__ __forceinline__ float wave_max(float v) {
#pragma unroll
    for (int o = 1; o < 64; o <<= 1) v = fmaxf(v, __shfl_xor(v, o));
    return v;
}
__device__ __forceinline__ float sigmoidf_(float x) { return __builtin_amdgcn_rcpf(1.0f + __expf(-x)); }
__device__ __forceinline__ float siluf_(float x) { return x * sigmoidf_(x); }
__device__ __forceinline__ f32x2 sigmoid2(f32x2 v) {
    constexpr float c = -1.4426950408889634f; const f32x2 c2 = {c, c}, one = {1.0f, 1.0f};
    const f32x2 t = v * c2; const f32x2 e = {__builtin_amdgcn_exp2f(t.x), __builtin_amdgcn_exp2f(t.y)}; const f32x2 d = e + one;
    return (f32x2){__builtin_amdgcn_rcpf(d.x), __builtin_amdgcn_rcpf(d.y)};
}
__device__ __forceinline__ f32x2 silu2(f32x2 v) { return v * sigmoid2(v); }
__device__ __forceinline__ f32x2 fgate2(f32x2 v, f32x2 lbv, f32x2 oml, f32x2& g) {
    const f32x2 f = __builtin_elementwise_fma(oml, sigmoid2(v), lbv);
    const f32x2 l2 = {__builtin_amdgcn_logf(f.x), __builtin_amdgcn_logf(f.y)}; const f32x2 ln2 = {0.6931471805599453f, 0.6931471805599453f}, one = {1.0f, 1.0f};
    g = l2 * ln2; return one - f;
}
__device__ __forceinline__ f32x2 swiglu2(f32x2 ag, f32x2 al, f32x2 bg, f32x2 bl1, float ws) {
    const f32x2 ws2 = {ws, ws};
    const f32x2 G = __builtin_elementwise_fma(ag, ws2, bg), L = __builtin_elementwise_fma(al, ws2, bl1);
    const f32x2 x = {fminf(G.x, SW_LIMIT), fminf(G.y, SW_LIMIT)};
    const f32x2 y = {__builtin_amdgcn_fmed3f(L.x, 1.0f - SW_LIMIT, 1.0f + SW_LIMIT), __builtin_amdgcn_fmed3f(L.y, 1.0f - SW_LIMIT, 1.0f + SW_LIMIT)};
    constexpr float c = -SW_ALPHA * 1.4426950408889634f; const f32x2 c2 = {c, c};
    const f32x2 t = x * c2;
    const f32x2 e = {__builtin_amdgcn_exp2f(t.x), __builtin_amdgcn_exp2f(t.y)};
    const f32x2 one = {1.0f, 1.0f};
    const f32x2 d = e + one;
    const f32x2 r = {__builtin_amdgcn_rcpf(d.x), __builtin_amdgcn_rcpf(d.y)};
    return (x * r) * y;
}

#define XB_TMO      128
#define XB_XCNT(j)  (256  + 64 * (j))
#define XB_XSUB(j)  (1280 + 64 * (j))
#define XB_XGEN(j)  (2304 + 64 * (j))
#define XB_TOP      3328
#define XB_TOPGEN   3392
#define XCD_BAR_WORDS 3456
#define XB_SPIN_CAP (1u << 20)
__device__ __forceinline__ unsigned xb_ld(unsigned* p)              { return __hip_atomic_load(p, __ATOMIC_RELAXED, __HIP_MEMORY_SCOPE_AGENT); }
__device__ __forceinline__ unsigned xb_add(unsigned* p, unsigned v) { return __hip_atomic_fetch_add(p, v, __ATOMIC_RELAXED, __HIP_MEMORY_SCOPE_AGENT); }
__device__ __forceinline__ unsigned xb_xcc_id() { return (unsigned)__builtin_amdgcn_s_getreg((3 << 11) | 20) & 0xFu; }
#define XB_SPIN(cond, bar) do { unsigned _sp = 0; while (cond) { __builtin_amdgcn_s_sleep(1); \
    if ((++_sp & 255u) == 0u) { if (xb_ld(&(bar)[XB_TMO])) break; if (_sp > XB_SPIN_CAP) { atomicAdd(&(bar)[XB_TMO], 1u); break; } } } } while (0)
struct XcdBarrier { unsigned* bar; unsigned x; volatile LAS unsigned* st; };
__device__ __forceinline__ XcdBarrier xcd_barrier_post(unsigned* bar, volatile LAS unsigned* st) {
    XcdBarrier b; b.bar = bar; b.x = xb_xcc_id(); b.st = st;
    if (threadIdx.x == 0) (void)xb_add(&bar[XB_XCNT(b.x)], 1u);
    return b;
}
__device__ __forceinline__ void xcd_barrier_complete(unsigned* bar, unsigned x, unsigned& nloc, unsigned& nx) {
    const unsigned G = gridDim.x * gridDim.y * gridDim.z;
    unsigned sum, cnt, mine, sp = 0u;
    for (;;) {
        sum = 0u; cnt = 0u; mine = 0u;
#pragma unroll
        for (unsigned j = 0; j < 16; ++j) { const unsigned c = xb_ld(&bar[XB_XCNT(j)]); sum += c; cnt += (c > 0u) ? 1u : 0u; mine = (j == x) ? c : mine; }
        if (sum == G) break;
        __builtin_amdgcn_s_sleep(1);
        if ((++sp & 255u) == 0u) { if (xb_ld(&bar[XB_TMO])) break; if (sp > XB_SPIN_CAP) { atomicAdd(&bar[XB_TMO], 1u); break; } }
    }
    nloc = mine > 0u ? mine : 1u; nx = cnt > 0u ? cnt : 1u;
}
__device__ __forceinline__ void xcd_barrier(const XcdBarrier& b) {
    asm volatile("s_waitcnt vmcnt(0)" ::: "memory");
    __syncthreads();
    if (threadIdx.x == 0) {
        unsigned* bar = b.bar;
        __builtin_amdgcn_s_waitcnt(0);
        unsigned nloc = b.st[0], nx = b.st[1];
        if (nloc == 0u) { xcd_barrier_complete(bar, b.x, nloc, nx); b.st[0] = nloc; b.st[1] = nx; }
        const unsigned old = xb_add(&bar[XB_XSUB(b.x)], 1u);
        const unsigned gen = old / nloc;
        if (old + 1u == (gen + 1u) * nloc) {
            __builtin_amdgcn_fence(__ATOMIC_RELEASE, "agent");
            asm volatile("s_waitcnt vmcnt(0)" ::: "memory");
            (void)xb_add(&bar[XB_TOP], 1u);
            XB_SPIN(xb_ld(&bar[XB_TOP]) < (gen + 1u) * nx, bar);
            __builtin_amdgcn_fence(__ATOMIC_ACQUIRE, "agent");
            __hip_atomic_store(&bar[XB_XGEN(b.x)], gen + 1u, __ATOMIC_RELAXED, __HIP_MEMORY_SCOPE_AGENT);
        } else {
            XB_SPIN(xb_ld(&bar[XB_XGEN(b.x)]) <= gen, bar);
            __builtin_amdgcn_fence(__ATOMIC_ACQUIRE, "agent");
            asm volatile("s_waitcnt vmcnt(0)" ::: "memory");
        }
    }
    __syncthreads();
}

struct Args {
    const float* in[19];
    float* out;
    unsigned char* ws;
    int ph_lo, ph_hi, aux, pad;
};

namespace pg8 {
constexpr int BM = 256, BK = 64, HALF = 128, HTB = HALF * BK * 2;
__host__ __device__ __forceinline__ int lds_byte(int r, int c) { const int st = (r >> 4) * 2 + (c >> 5), rr = r & 15, cc = c & 31, ob = rr * 64 + cc * 2; return st * 1024 + (ob ^ (((ob >> 9) & 1) << 5)); }
__host__ __device__ __forceinline__ void stage_rc(int b, int& R, int& C) { const int st = b / 1024, sb = b % 1024, swz = sb ^ (((sb >> 9) & 1) << 5); R = (st >> 1) * 16 + swz / 64; C = (st & 1) * 32 + (swz % 64) / 2; }
__host__ __device__ __forceinline__ int perm32(int rho) { const int n = rho >> 4, i = rho & 15; return 8 * (i >> 2) + 4 * n + (i & 3); }

struct Unit { const char* A; const char* B; int p0, p1, p2, p3, ui; };

#define PG8_SA(b, h) (((b) * 2 + (h)) * HTB)
#define PG8_SB(b, h) ((4 + (b) * 2 + (h)) * HTB)
#define PG8_LDA(dst, b, h) do { _Pragma("unroll") for (int m = 0; m < 4; ++m) _Pragma("unroll") for (int k = 0; k < 2; ++k) dst[m][k] = *(const LAS bf16x8*)(lds + PG8_SA(b, h) + aoff + m * 2048 + k * 1024); } while (0)
#define PG8_LDB(dst, b, h) do { _Pragma("unroll") for (int n = 0; n < 2; ++n) _Pragma("unroll") for (int k = 0; k < 2; ++k) dst[n][k] = *(const LAS bf16x8*)(lds + PG8_SB(b, h) + boff + n * 2048 + k * 1024); } while (0)
#define PG8_MMA(ai, bj, At, Bt) do { __builtin_amdgcn_s_setprio(1); _Pragma("unroll") for (int m = 0; m < 4; ++m) _Pragma("unroll") for (int n = 0; n < 2; ++n) _Pragma("unroll") for (int k = 0; k < 2; ++k) \
        acc[ai][bj][m][n] = __builtin_amdgcn_mfma_f32_16x16x32_bf16(Bt[n][k], At[m][k], acc[ai][bj][m][n], 0, 0, 0); __builtin_amdgcn_s_setprio(0); } while (0)

template <class P>
__device__ __forceinline__ void gemm_simple(LAS unsigned char* lds, const P& S) {
    const int tid = threadIdx.x, wid = __builtin_amdgcn_readfirstlane(tid >> 6), lane = tid & 63, wr = wid >> 2, wc = wid & 3, fr = lane & 15, fq = lane >> 4;
    const int nt = S.nt();
    int R0, C0; stage_rc(tid * 16, R0, C0);
    unsigned offB[2];
#pragma unroll
    for (int i = 0; i < 2; ++i) { const int R = R0 + 64 * i; const int Rb = (R & ~31) + perm32(R & 31); offB[i] = (unsigned)Rb * S.ldb_bytes() + (unsigned)C0 * 2u; }
    const unsigned bhalf = 128u * S.ldb_bytes();
    const int aoff = lds_byte(wr * 64 + fr, fq * 8), boff = lds_byte(wc * 32 + fr, fq * 8);
    Unit u;
    for (int ui = 0; S.next(ui, u); ++ui) {
        unsigned offA[4]; S.aoff(u, R0, C0, offA);
        f32x4 acc[2][2][4][2];
#pragma unroll
        for (int a = 0; a < 2; ++a)
#pragma unroll
            for (int b = 0; b < 2; ++b)
#pragma unroll
                for (int m = 0; m < 4; ++m)
#pragma unroll
                    for (int n = 0; n < 2; ++n) acc[a][b][m][n] = (f32x4){0.f, 0.f, 0.f, 0.f};
        for (int t = 0; t < nt; ++t) {
            u32x4 ra[4], rb[4];
#pragma unroll
            for (int h = 0; h < 2; ++h)
#pragma unroll
                for (int i = 0; i < 2; ++i) {
                    ra[2 * h + i] = *(const u32x4*)(u.A + offA[2 * h + i] + (size_t)t * 128);
                    rb[2 * h + i] = *(const u32x4*)(u.B + (size_t)h * bhalf + offB[i] + (size_t)t * 128);
                }
            __syncthreads();
#pragma unroll
            for (int h = 0; h < 2; ++h)
#pragma unroll
                for (int i = 0; i < 2; ++i) {
                    *(LAS u32x4*)(lds + PG8_SA(0, h) + tid * 16 + i * 8192) = ra[2 * h + i];
                    *(LAS u32x4*)(lds + PG8_SB(0, h) + tid * 16 + i * 8192) = rb[2 * h + i];
                }
            __syncthreads();
            bf16x8 At[4][2], Bt[2][2];
#pragma unroll
            for (int ai = 0; ai < 2; ++ai) {
                PG8_LDA(At, 0, ai);
#pragma unroll
                for (int bj = 0; bj < 2; ++bj) { PG8_LDB(Bt, 0, bj); PG8_MMA(ai, bj, At, Bt); }
            }
        }
        S.epi(acc, u, wr, wc, fr, fq);
    }
    __syncthreads();
}

template <class P>
__device__ __forceinline__ void gemm_pipe(LAS unsigned char* lds, const P& S) {
    const int tid = threadIdx.x, wid = __builtin_amdgcn_readfirstlane(tid >> 6), lane = tid & 63, wr = wid >> 2, wc = wid & 3, fr = lane & 15, fq = lane >> 4;
    constexpr int KR = GEMM_KREP * P::KREP; const int nt1 = S.nt(), nt = nt1 * KR;
    int R0, C0; stage_rc(tid * 16, R0, C0);
    unsigned offB[2];
#pragma unroll
    for (int i = 0; i < 2; ++i) { const int R = R0 + 64 * i; const int Rb = (R & ~31) + perm32(R & 31); offB[i] = (unsigned)Rb * S.ldb_bytes() + (unsigned)C0 * 2u; }
    const size_t bhalf = (size_t)128u * S.ldb_bytes();
    const size_t kstep = 128;
    const unsigned ldsw = (unsigned)wid * 1024u;
    int aoffK[2], boffK[2];
#pragma unroll
    for (int k = 0; k < 2; ++k) { aoffK[k] = lds_byte(wr * 64 + fr, fq * 8) + k * 1024; boffK[k] = lds_byte(wc * 32 + fr, fq * 8) + k * 1024; }
#undef PG8_LDA
#undef PG8_LDB
#undef PG8_MMA
#define PG8_LDA(dst, b, h) do { _Pragma("unroll") for (int m = 0; m < 4; ++m) { \
        if constexpr (P::FP8) dst##8[m] = __builtin_shufflevector(*(const LAS v4i_t*)(lds + PG8_SA(b, h) + aoffK[0] + m * 2048), *(const LAS v4i_t*)(lds + PG8_SA(b, h) + aoffK[1] + m * 2048), 0, 1, 2, 3, 4, 5, 6, 7); \
        else { _Pragma("unroll") for (int k = 0; k < 2; ++k) dst[m][k] = *(const LAS bf16x8*)(lds + PG8_SA(b, h) + aoffK[k] + m * 2048); } } } while (0)
#define PG8_LDB(dst, b, h) do { _Pragma("unroll") for (int n = 0; n < 2; ++n) { \
        if constexpr (P::FP8) dst##8[n] = __builtin_shufflevector(*(const LAS v4i_t*)(lds + PG8_SB(b, h) + boffK[0] + n * 2048), *(const LAS v4i_t*)(lds + PG8_SB(b, h) + boffK[1] + n * 2048), 0, 1, 2, 3, 4, 5, 6, 7); \
        else { _Pragma("unroll") for (int k = 0; k < 2; ++k) dst[n][k] = *(const LAS bf16x8*)(lds + PG8_SB(b, h) + boffK[k] + n * 2048); } } } while (0)
#define PG8_MMA(ai, bj, At, Bt) do { if constexpr (P::FP8) __builtin_amdgcn_sched_barrier(0); __builtin_amdgcn_s_setprio(1); _Pragma("unroll") for (int m = 0; m < 4; ++m) _Pragma("unroll") for (int n = 0; n < 2; ++n) { \
        if constexpr (P::FP8) acc[ai][bj][m][n] = __builtin_amdgcn_mfma_scale_f32_16x16x128_f8f6f4(Bt##8[n], At##8[m], acc[ai][bj][m][n], 0, 0, 0, 127, 0, 127); \
        else { _Pragma("unroll") for (int k = 0; k < 2; ++k) acc[ai][bj][m][n] = __builtin_amdgcn_mfma_f32_16x16x32_bf16(Bt[n][k], At[m][k], acc[ai][bj][m][n], 0, 0, 0); } } \
        if constexpr (P::FP8) { _Pragma("unroll") for (int m = 0; m < 4; ++m) _Pragma("unroll") for (int n = 0; n < 2; ++n) asm volatile("" : "+v"(acc[ai][bj][m][n])); } \
        __builtin_amdgcn_s_setprio(0); if constexpr (P::FP8) __builtin_amdgcn_sched_barrier(0); } while (0)
#define PG8_STAGE_A(bufoff, gbase, OFF, h) do { _Pragma("unroll") for (int _i = 0; _i < 2; ++_i) \
        __builtin_amdgcn_global_load_lds((const unsigned*)((const char*)(gbase) + (OFF)[2 * (h) + _i]), (LAS unsigned*)(lds + (bufoff) + ldsw + _i * 8192), 16, 0, 0); } while (0)
#define PG8_STAGE_B(bufoff, gbase) do { _Pragma("unroll") for (int _i = 0; _i < 2; ++_i) \
        __builtin_amdgcn_global_load_lds((const unsigned*)((const char*)(gbase) + offB[_i]), (LAS unsigned*)(lds + (bufoff) + ldsw + _i * 8192), 16, 0, 0); } while (0)
#define PG8_WAIT_V(n) asm volatile("s_waitcnt vmcnt(" #n ")" ::: "memory")
#define PG8_WAIT_L(n) asm volatile("s_waitcnt lgkmcnt(" #n ")" ::: "memory")
#define PG8_BAR __builtin_amdgcn_s_barrier()
#define PG8_SCHED __builtin_amdgcn_sched_barrier(0)
    Unit cur, nxt; int ui = 0; int pend = -1;
    if (!S.next(0, cur)) return;
    f32x4 acc[2][2][4][2];
#pragma unroll
    for (int a = 0; a < 2; ++a)
#pragma unroll
        for (int b = 0; b < 2; ++b)
#pragma unroll
            for (int m = 0; m < 4; ++m)
#pragma unroll
                for (int n = 0; n < 2; ++n) acc[a][b][m][n] = (f32x4){0.f, 0.f, 0.f, 0.f};
    bf16x8 At[4][2], B0[2][2], B1[2][2];
    v8i_t At8[4], B08[2], B18[2];
    unsigned offC[4], offN[4];
    S.aoff(cur, R0, C0, offC);
    const char* cA = cur.A; const char* cB = cur.B;
    if constexpr (P::HAS_READY) S.a_ready(cur);
    PG8_STAGE_B(PG8_SB(0, 0), cB); PG8_STAGE_B(PG8_SB(0, 1), cB + bhalf); PG8_STAGE_A(PG8_SA(0, 0), cA, offC, 0); PG8_STAGE_A(PG8_SA(0, 1), cA, offC, 1);
    if (wr == 1) PG8_BAR;
    PG8_WAIT_V(2); PG8_BAR;
    PG8_STAGE_B(PG8_SB(1, 0), cB + kstep); PG8_STAGE_A(PG8_SA(1, 0), cA + kstep, offC, 0); PG8_STAGE_B(PG8_SB(1, 1), cB + bhalf + kstep);
    PG8_WAIT_V(6); PG8_BAR;
    for (;;) {
        const bool has_next = S.next(ui + 1, nxt);
        if (has_next) S.aoff(nxt, R0, C0, offN);
        else {
#pragma unroll
            for (int q = 0; q < 4; ++q) offN[q] = offC[q];
        }
        const char* nA = has_next ? nxt.A : cA; const char* nB = has_next ? nxt.B : cB;
        for (int t = 0; t < nt; t += 2) {
            const bool last = (t == nt - 2);
            const bool sf = P::SEAM_OPT && (ui > 0) && (t == 0);
            if constexpr (P::HAS_READY) { if (last && has_next) S.a_ready(nxt); }
            const char* a1 = cA + (size_t)((t + 1) % nt1) * kstep;
            const char* a2 = last ? nA : cA + (size_t)((t + 2) % nt1) * kstep; const char* b2 = last ? nB : cB + (size_t)((t + 2) % nt1) * kstep;
            const char* a3 = a2 + kstep; const char* b3 = b2 + kstep;
            unsigned o2[4];
#pragma unroll
            for (int q = 0; q < 4; ++q) o2[q] = last ? offN[q] : offC[q];
            PG8_LDB(B0, 0, 0); PG8_LDB(B1, 0, 1); PG8_SCHED; PG8_LDA(At, 0, 0); if (!sf) { PG8_STAGE_A(PG8_SA(1, 1), a1, offC, 1); PG8_WAIT_V(8); }
            PG8_WAIT_L(0); PG8_BAR; PG8_MMA(0, 0, At, B0); PG8_MMA(0, 1, At, B1); PG8_BAR; PG8_SCHED;
            PG8_LDA(At, 0, 1); PG8_STAGE_B(PG8_SB(0, 0), b2); PG8_STAGE_B(PG8_SB(0, 1), b2 + bhalf); PG8_STAGE_A(PG8_SA(0, 0), a2, o2, 0);
            if (!sf) PG8_WAIT_V(8); PG8_WAIT_L(0); PG8_BAR; PG8_MMA(1, 0, At, B0); PG8_MMA(1, 1, At, B1); PG8_BAR; PG8_SCHED;
            PG8_LDB(B0, 1, 0); PG8_LDB(B1, 1, 1); PG8_SCHED; PG8_LDA(At, 1, 0); PG8_STAGE_A(PG8_SA(0, 1), a2, o2, 1);
            if (!sf) PG8_WAIT_V(8); PG8_WAIT_L(0); PG8_BAR; PG8_MMA(0, 0, At, B0); PG8_MMA(0, 1, At, B1); PG8_BAR; PG8_SCHED;
            PG8_LDA(At, 1, 1); PG8_STAGE_B(PG8_SB(1, 0), b3); PG8_STAGE_B(PG8_SB(1, 1), b3 + bhalf); PG8_STAGE_A(PG8_SA(1, 0), a3, o2, 0);
            if (!sf) PG8_WAIT_V(8); PG8_WAIT_L(0); PG8_BAR; PG8_MMA(1, 0, At, B0); PG8_MMA(1, 1, At, B1); PG8_BAR; PG8_SCHED;
        }
        if constexpr (P::SEAM_OPT) PG8_STAGE_A(PG8_SA(1, 1), nA + kstep, offN, 1);
        if (wr == 0) PG8_BAR;
        if constexpr (P::SEAM_OPT) { PG8_WAIT_V(0);
            S.flush(pend); pend = -1; }
        if (KR != 1) {
#pragma unroll
            for (int a = 0; a < 2; ++a)
#pragma unroll
                for (int b = 0; b < 2; ++b)
#pragma unroll
                    for (int m = 0; m < 4; ++m)
#pragma unroll
                        for (int n = 0; n < 2; ++n) acc[a][b][m][n] = acc[a][b][m][n] * (1.0f / KR);
        }
        pend = S.epi(acc, cur, wr, wc, fr, fq);
        if constexpr (!P::SEAM_OPT) { if (pend >= 0) { PG8_WAIT_V(0); S.flush(pend); pend = -1; } }
        if (!has_next) break;
#pragma unroll
        for (int a = 0; a < 2; ++a)
#pragma unroll
            for (int b = 0; b < 2; ++b)
#pragma unroll
                for (int m = 0; m < 4; ++m)
#pragma unroll
                    for (int n = 0; n < 2; ++n) acc[a][b][m][n] = (f32x4){0.f, 0.f, 0.f, 0.f};
        cur = nxt; cA = nA; cB = nB; ++ui;
#pragma unroll
        for (int q = 0; q < 4; ++q) offC[q] = offN[q];
        if (wr == 1) PG8_BAR;
    }
    PG8_WAIT_V(0);
    S.flush(pend);
    PG8_BAR;
#undef PG8_STAGE_A
#undef PG8_STAGE_B
#undef PG8_WAIT_V
#undef PG8_WAIT_L
#undef PG8_BAR
#undef PG8_SCHED
}
}

struct Frame {
    LAS unsigned char* lds;
    volatile LAS unsigned* MISC;
    unsigned* ctl;
    int tid, lane, wave, vcu, G;
    unsigned char* ws;
    float* out;
};
typedef const float* cfptr_t;
__device__ __forceinline__ const float* inptr(int i) {
    const __attribute__((address_space(4))) cfptr_t* ka = (const __attribute__((address_space(4))) cfptr_t*)__builtin_amdgcn_kernarg_segment_ptr();
    asm volatile("" : "+s"(ka));
    const GAS float* g = (const GAS float*)ka[i];
    return (const float*)g;
}
#define WSP(F, off, type) ((type*)((F).ws + (off)))

template <class RowMap>
__device__ __forceinline__ void transpose_tile(const float* W, int K, int N, bf16_t* WT, LAS unsigned char* scr, int item, int lane, const RowMap& rm) {
    const int nblk = N / 64, kb = item / nblk, nb = item % nblk, k0 = 64 * kb, n0 = 64 * nb;
    const int kg = lane & 3, ng = lane >> 2;
    f32x4 v[4][4];
#pragma unroll
    for (int r = 0; r < 4; ++r)
#pragma unroll
        for (int i = 0; i < 4; ++i) v[r][i] = __builtin_nontemporal_load((const f32x4*)(W + (size_t)(k0 + 16 * r + 4 * kg + i) * N + n0 + 4 * ng));
#pragma unroll
    for (int r = 0; r < 4; ++r)
#pragma unroll
        for (int j = 0; j < 4; ++j)
            *(LAS u32x2*)(scr + (4 * ng + j) * 144 + (16 * r + 4 * kg) * 2) = (u32x2){cvt_pk_bf16(v[r][0][j], v[r][1][j]), cvt_pk_bf16(v[r][2][j], v[r][3][j])};
    asm volatile("s_waitcnt lgkmcnt(0)" ::: "memory");
    const int c = lane & 7;
#pragma unroll
    for (int q = 0; q < 8; ++q) { const int n = (lane >> 3) + 8 * q; const u32x4 o = *(const LAS u32x4*)(scr + n * 144 + c * 16); __builtin_nontemporal_store(o, (u32x4*)(WT + (size_t)rm(n0 + n) * K + k0 + 8 * c)); }
    asm volatile("s_waitcnt lgkmcnt(0)" ::: "memory");
}
template <class RowMap>
__device__ __forceinline__ void transpose_tile8(const float* W, int K, int N, unsigned char* WT, LAS unsigned char* scr, int item, int lane, const RowMap& rm) {
    const int nblk = N / 64, kb = item / nblk, nb = item % nblk, k0 = 128 * kb, n0 = 64 * nb;
    const int kg = lane & 3, ng = lane >> 2;
#pragma unroll
    for (int hb = 0; hb < 2; ++hb) {
        f32x4 v[4][4];
#pragma unroll
        for (int r = 0; r < 4; ++r)
#pragma unroll
            for (int i = 0; i < 4; ++i) v[r][i] = __builtin_nontemporal_load((const f32x4*)(W + (size_t)(k0 + 64 * hb + 16 * r + 4 * kg + i) * N + n0 + 4 * ng));
#pragma unroll
        for (int r = 0; r < 4; ++r)
#pragma unroll
            for (int j = 0; j < 4; ++j)
                *(LAS unsigned*)(scr + (4 * ng + j) * 144 + 64 * hb + 16 * r + 4 * kg) = pack_fp8x4(v[r][0][j] * W8_SCALE, v[r][1][j] * W8_SCALE, v[r][2][j] * W8_SCALE, v[r][3][j] * W8_SCALE);
    }
    asm volatile("s_waitcnt lgkmcnt(0)" ::: "memory");
    const int c = lane & 7;
#pragma unroll
    for (int q = 0; q < 8; ++q) { const int n = (lane >> 3) + 8 * q; const u32x4 o = *(const LAS u32x4*)(scr + n * 144 + c * 16); __builtin_nontemporal_store(o, (u32x4*)(WT + (size_t)rm(n0 + n) * K + k0 + 16 * c)); }
    asm volatile("s_waitcnt lgkmcnt(0)" ::: "memory");
}
struct RmId { __device__ __forceinline__ int operator()(int n) const { return n; } };
struct RmWin { __device__ __forceinline__ int operator()(int n) const {
        const int s = n >> 9; if (s != 4 && s != 5) return n;
        const int d = n & 127, dd = d & 63; const int p = 8 * (dd >> 2) + (dd & 3) + ((d >> 6) << 2); return n - d + p; } };
struct RmGu { __device__ __forceinline__ int operator()(int n) const { const int half = n >> 10, j = (n & 1023) >> 7, i = n & 127; return 256 * j + 128 * half + i; } };

__device__ __forceinline__ void p0_prologue(Frame& F) {
    const int tid = F.tid;
    {
        LAS float* red = (LAS float*)F.lds;
        const float* c = inptr(1);
        for (int u = F.vcu; u < 192; u += F.G) {
            const int l = u / 96, cg = u % 96, kq = tid >> 4, cq = tid & 15;
            const float* W = inptr(2) + (size_t)l * D * 6 * D + cg * 64 + cq * 4;
            f32x4 a = {0.f, 0.f, 0.f, 0.f};
#pragma unroll 8
            for (int j = 0; j < 32; ++j) { const int k = kq + 32 * j; const float cv = siluf_(c[k]); const f32x4 w = *(const f32x4*)(W + (size_t)k * 6 * D); a += w * cv; }
            __syncthreads();
            *(LAS f32x4*)(red + kq * 64 + cq * 4) = a;
            __syncthreads();
            if (tid < 64) { float s = 0.f;
#pragma unroll 8
                for (int k = 0; k < 32; ++k) s += red[k * 64 + tid];
                const int col = cg * 64 + tid;
                WSP(F, WS_MOD, float)[l * 6 * D + col] = s + inptr(3)[l * 6 * D + col]; }
        }
        __syncthreads();
    }
    if (F.vcu == 0) { const float* hb = inptr(5); const float a = hb[tid], b = hb[512 + tid]; WSP(F, WS_LB, float)[tid] = 1.0f / (1.0f + __expf(b - a)); }
    {
        bf16_t* rt = WSP(F, WS_RT, bf16_t); const float* wr = inptr(12);
        for (int idx = F.vcu * NTH + tid; idx < 2 * D * NE; idx += F.G * NTH) {
            const int l = idx >> 15, rem = idx & 32767, c = rem >> 5, e = rem & 31;
            const float w = wr[idx]; const unsigned hi = cvt_pk_bf16(w, 0.f) & 0xffffu; const float res = w - bflo(hi);
            rt[((size_t)(l * 2 + 0) * 32 + e) * D + c] = (bf16_t)hi; rt[((size_t)(l * 2 + 1) * 32 + e) * D + c] = (bf16_t)(cvt_pk_bf16(res, 0.f) & 0xffffu);
        }
    }
    {
        f32x2* rope = WSP(F, WS_ROPE, f32x2);
        for (int idx = F.vcu * NTH + tid; idx < T * 64; idx += F.G * NTH) {
            const int t = idx >> 6, d = idx & 63;
            const float inv = exp2f(-(float)d * (13.287712379549449f / 64.0f));
            const float ang = (float)t * inv;
            const double a = (double)ang; const double n = __builtin_rint(a * 0.15915494309189535); const double r = __builtin_fma(-n, 6.283185307179586, a);
            const float rf = (float)r;
            rope[idx] = (f32x2){__cosf(rf), __sinf(rf)};
        }
    }
    {
        LAS unsigned char* scr = F.lds + F.wave * 16384;
        const int gw = F.vcu * NWAVES + F.wave, NGW = F.G * NWAVES;
        constexpr int I_IN = WIN_FP8 ? 8 * 64 : 16 * 64, I_OUT = 16 * 16, I_POOL = 4 * 4 * 4;
        constexpr int NL8 = ((FP8_LAYERS & 1) ? 1 : 0) + ((FP8_LAYERS & 2) ? 1 : 0), NL16 = 2 - NL8;
        constexpr int S_GU = 32 * 8 * 32, S_DN = 32 * 8 * 16;
        constexpr int T_GU = 32 * 16 * 32, T_DN = 32 * 16 * 16;
        constexpr int N8 = NL8 * (S_GU + S_DN), N16 = NL16 * (T_GU + T_DN);
        constexpr int NITEMS = N8 + I_IN + I_OUT + I_POOL + N16;
        for (int it = gw; it < NITEMS; it += NGW) {
            int r = it;
            if (r < N8) {
                const int li = r / (S_GU + S_DN), layer = (NL8 == 2) ? li : ((FP8_LAYERS & 1) ? 0 : 1); r -= li * (S_GU + S_DN);
                if (r < S_GU) { const int m = layer * 32 + r / 256; transpose_tile8(inptr(14) + (size_t)m * D * 2048, D, 2048, (unsigned char*)(WSP(F, WS_WGUT, bf16_t) + (size_t)layer * NE * 2048 * D) + (size_t)(m & 31) * 2048 * D, scr, r % 256, F.lane, RmGu()); }
                else { r -= S_GU; const int m = layer * 32 + r / 128; transpose_tile8(inptr(16) + (size_t)m * D * D, D, D, (unsigned char*)(WSP(F, WS_WDNT, bf16_t) + (size_t)layer * NE * D * D) + (size_t)(m & 31) * D * D, scr, r % 128, F.lane, RmId()); }
                continue;
            }
            r -= N8;
            if (r < I_IN) { if (WIN_FP8) transpose_tile8(inptr(4), D, INW, WSP(F, WS_WINT, unsigned char), scr, r, F.lane, RmWin()); else transpose_tile(inptr(4), D, INW, WSP(F, WS_WINT, bf16_t), scr, r, F.lane, RmWin()); continue; } r -= I_IN;
            if (r < I_OUT) { transpose_tile(inptr(8), D, D, WSP(F, WS_WOUTT, bf16_t), scr, r, F.lane, RmId()); continue; } r -= I_OUT;
            if (r < I_POOL) { const int g = r / 16; transpose_tile(inptr(9) + (size_t)g * 65536, 256, 256, WSP(F, WS_POOLT, bf16_t) + (size_t)g * 65536, scr, r % 16, F.lane, RmId()); continue; } r -= I_POOL;
            if (NL16 > 0) {
                const int li = r / (T_GU + T_DN), layer = (NL16 == 2) ? li : ((FP8_LAYERS & 1) ? 1 : 0); r -= li * (T_GU + T_DN);
                if (r < T_GU) { const int m = layer * 32 + r / 512; transpose_tile(inptr(14) + (size_t)m * D * 2048, D, 2048, WSP(F, WS_WGUT, bf16_t) + (size_t)m * 2048 * D, scr, r % 512, F.lane, RmGu()); }
                else { r -= T_GU; const int m = layer * 32 + r / 256; transpose_tile(inptr(16) + (size_t)m * D * D, D, D, WSP(F, WS_WDNT, bf16_t) + (size_t)m * D * D, scr, r % 256, F.lane, RmId()); }
            }
        }
    }
}

__device__ __forceinline__ void p1_norm_in(Frame& F) {
    const float* mod = WSP(F, WS_MOD, float);
    f32x4 sh[4], sc[4];
#pragma unroll
    for (int j = 0; j < 4; ++j) { sh[j] = *(const f32x4*)(mod + 0 * D + 4 * F.lane + 256 * j); sc[j] = *(const f32x4*)(mod + 1 * D + 4 * F.lane + 256 * j) + 1.0f; }
    const int gw = F.vcu * NWAVES + F.wave, NGW = F.G * NWAVES;
    for (int row = gw; row < T; row += NGW) {
        const f32x4* xr = (const f32x4*)(inptr(0) + (size_t)row * D) + F.lane;
        f32x4 v[4]; float s = 0.f;
#pragma unroll
        for (int j = 0; j < 4; ++j) { v[j] = xr[64 * j]; s += (v[j].x * v[j].x + v[j].y * v[j].y) + (v[j].z * v[j].z + v[j].w * v[j].w); }
        const float rstd = rsqrtf(wave_sum(s) * (1.f / D) + EPS);
        u32x2* o = (u32x2*)(WSP(F, WS_HN, bf16_t) + (size_t)row * D) + F.lane; unsigned* o8 = (unsigned*)(WSP(F, WS_HN8, unsigned char) + (size_t)row * D) + F.lane;
#pragma unroll
        for (int j = 0; j < 4; ++j) { const f32x4 h = v[j] * rstd * sc[j] + sh[j]; if (WIN_FP8) o8[64 * j] = pack_fp8x4(h.x, h.y, h.z, h.w); else o[64 * j] = (u32x2){cvt_pk_bf16(h.x, h.y), cvt_pk_bf16(h.z, h.w)}; }
    }
}

using pg8::Unit;
typedef f32x4 AccT[2][2][4][2];

struct GemmBase {
    static constexpr bool SEAM_OPT = false;
    __device__ __forceinline__ void flush(int) const {}
    static constexpr bool HAS_READY = false;
    static constexpr bool FP8 = false;
    int G, vcu;
    __device__ __forceinline__ void aoff_lin(int R0, int C0, unsigned lda_bytes, unsigned (&off)[4]) const {
#pragma unroll
        for (int q = 0; q < 4; ++q) off[q] = (unsigned)(R0 + 64 * (q & 1) + 128 * (q >> 1)) * lda_bytes + (unsigned)C0 * 2u;
    }
};

struct PolWin : GemmBase {
    static constexpr int KREP = KREP_WIN;
    static constexpr bool FP8 = (WIN_FP8 != 0);
    static constexpr int EB = FP8 ? 1 : 2;
    static constexpr float WS = FP8 ? (1.0f / W8_SCALE) : 1.0f;
    const bf16_t* A; const bf16_t* Bt; bf16_t* qkvg; _Float16* gbuf; const float* lb; const f32x2* rope;
    __device__ __forceinline__ int nt() const { return D * EB / 128; }
    __device__ __forceinline__ unsigned ldb_bytes() const { return D * EB; }
    __device__ __forceinline__ bool next(int i, Unit& u) const {
        const int V = i * G + vcu; if (V >= 64 * 16) return false;
        const int c = (V & 15) >> 1, cg = c >> 2, cp = (c + i) & 3, sec = cg ? ((0x5730 >> (4 * cp)) & 15) : ((0x4621 >> (4 * cp)) & 15);
        u.p0 = V >> 4; u.p1 = 2 * sec + (V & 1); u.A = (const char*)A + (size_t)u.p0 * 256 * D * EB; u.B = (const char*)Bt + (size_t)u.p1 * 256 * D * EB; return true; }
    __device__ __forceinline__ void aoff(const Unit&, int R0, int C0, unsigned (&off)[4]) const { aoff_lin(R0, C0, D * EB, off); }
    __device__ __forceinline__ int epi(const AccT& acc, const Unit& u, int wr, int wc, int fr, int fq) const {
        const int pm = u.p0, pn = u.p1, s = pn >> 1;
        const int row0 = pm * 256 + wr * 64 + fr;
        const int o0 = (pn & 1) * 256 + wc * 32 + 8 * fq;
        const int dbase = (s & 3) * 1024 + (s >> 2) * 512;
        bf16_t* obase = qkvg + (size_t)row0 * INW + dbase;
        if (s == 4 || s == 5) {
            const int d0 = 4 * ((o0 & 127) >> 3);
            const float qs = ((s == 5) ? 0.08838834764831845f : 1.0f) * WS;
#pragma unroll
            for (int ah = 0; ah < 2; ++ah) {
                f32x4 rc[4][2];
#pragma unroll
                for (int m = 0; m < 4; ++m) { const f32x4* rp = (const f32x4*)(rope + (size_t)(row0 + ah * 128 + m * 16) * 64 + d0); rc[m][0] = rp[0]; rc[m][1] = rp[1]; }
#pragma unroll
                for (int m = 0; m < 4; ++m) {
                    const f32x4 cs = {rc[m][0].x * qs, rc[m][0].z * qs, rc[m][1].x * qs, rc[m][1].z * qs}, sn = {rc[m][0].y * qs, rc[m][0].w * qs, rc[m][1].y * qs, rc[m][1].w * qs};
                    bf16_t* orow = obase + (size_t)(ah * 128 + m * 16) * INW;
#pragma unroll
                    for (int bj = 0; bj < 2; ++bj) {
                        const int hd = (o0 + bj * 128) & ~127;
                        const f32x4 v0 = acc[ah][bj][m][0], v1 = acc[ah][bj][m][1];
                        const f32x4 o1 = v0 * cs - v1 * sn, o2 = v0 * sn + v1 * cs;
                        *(u32x2*)(orow + hd + d0) = (u32x2){cvt_pk_bf16(o1.x, o1.y), cvt_pk_bf16(o1.z, o1.w)};
                        *(u32x2*)(orow + hd + d0 + 64) = (u32x2){cvt_pk_bf16(o2.x, o2.y), cvt_pk_bf16(o2.z, o2.w)};
                    }
                }
            }
        } else if (s == 1) {
#pragma unroll
            for (int bj = 0; bj < 2; ++bj) {
                const int o = o0 + bj * 128;
                const f32x4 l0 = *(const f32x4*)(lb + o), l1 = *(const f32x4*)(lb + o + 4), m0 = 1.0f - l0, m1 = 1.0f - l1;
#pragma unroll
                for (int am = 0; am < 8; ++am) {
                    const size_t ro = (size_t)((am >> 2) * 128 + (am & 3) * 16);
                    const f32x4 v0 = acc[am >> 2][bj][am & 3][0] * WS, v1 = acc[am >> 2][bj][am & 3][1] * WS;
                    f32x2 g0, g1, g2, g3;
                    const f32x2 k0 = fgate2(v0.xy, l0.xy, m0.xy, g0), k1 = fgate2(v0.zw, l0.zw, m0.zw, g1), k2 = fgate2(v1.xy, l1.xy, m1.xy, g2), k3 = fgate2(v1.zw, l1.zw, m1.zw, g3);
                    *(h16x8*)(gbuf + ((size_t)row0 + ro) * 512 + o) = (h16x8){(_Float16)g0.x, (_Float16)g0.y, (_Float16)g1.x, (_Float16)g1.y, (_Float16)g2.x, (_Float16)g2.y, (_Float16)g3.x, (_Float16)g3.y};
                    u32x4 w; w.x = cvt_pk_bf16(k0.x, k0.y); w.y = cvt_pk_bf16(k1.x, k1.y); w.z = cvt_pk_bf16(k2.x, k2.y); w.w = cvt_pk_bf16(k3.x, k3.y);
                    *(u32x4*)(obase + ro * INW + o) = w;
                }
            }
        } else {
            const bool act = (s == 0 || s == 3 || s == 7);
#pragma unroll
            for (int am = 0; am < 8; ++am) {
                const size_t ro = (size_t)((am >> 2) * 128 + (am & 3) * 16);
#pragma unroll
                for (int bj = 0; bj < 2; ++bj) {
                    f32x4 v0 = acc[am >> 2][bj][am & 3][0] * WS, v1 = acc[am >> 2][bj][am & 3][1] * WS;
                    if (act) { const f32x2 a0 = silu2(v0.xy), a1 = silu2(v0.zw), a2 = silu2(v1.xy), a3 = silu2(v1.zw); v0 = (f32x4){a0.x, a0.y, a1.x, a1.y}; v1 = (f32x4){a2.x, a2.y, a3.x, a3.y}; }
                    u32x4 w; w.x = cvt_pk_bf16(v0[0], v0[1]); w.y = cvt_pk_bf16(v0[2], v0[3]); w.z = cvt_pk_bf16(v1[0], v1[1]); w.w = cvt_pk_bf16(v1[2], v1[3]);
                    *(u32x4*)(obase + ro * INW + o0 + bj * 128) = w;
                }
            }
        }
            return -1;
    }
};

template <bool R16>
struct PolRes : GemmBase {
    static constexpr int KREP = KREP_RES;
    const bf16_t* A; const bf16_t* Bt; const float* resid; const bf16_t* resid16; bf16_t* outp; const float* gate; const float* bias; const float* scale;
    int K, lda, nN, kcol;
    __device__ __forceinline__ int nt() const { return K / 64; }
    __device__ __forceinline__ unsigned ldb_bytes() const { return (unsigned)K * 2u; }
    __device__ __forceinline__ bool next(int i, Unit& u) const {
        const int V = i * G + vcu; if (V >= 64 * nN) return false;
        u.p0 = V / nN; u.p1 = V % nN; u.A = (const char*)(A + (size_t)u.p0 * 256 * lda + (size_t)u.p1 * kcol); u.B = (const char*)(Bt + (size_t)u.p1 * 256 * K); return true; }
    __device__ __forceinline__ void aoff(const Unit&, int R0, int C0, unsigned (&off)[4]) const { aoff_lin(R0, C0, (unsigned)lda * 2u, off); }
    __device__ __forceinline__ int epi(const AccT& acc, const Unit& u, int wr, int wc, int fr, int fq) const {
        const int row0 = u.p0 * 256 + wr * 64 + fr, col0 = u.p1 * 256 + wc * 32 + 8 * fq;
#pragma unroll
        for (int bj = 0; bj < 2; ++bj) {
            const int c = col0 + bj * 128;
            const f32x4 g0 = *(const f32x4*)(gate + c), g1 = *(const f32x4*)(gate + c + 4);
            f32x4 b0 = {0.f, 0.f, 0.f, 0.f}, b1 = b0, s0 = {1.f, 1.f, 1.f, 1.f}, s1 = s0;
            if (bias) { b0 = *(const f32x4*)(bias + c); b1 = *(const f32x4*)(bias + c + 4); s0 = *(const f32x4*)(scale + c); s1 = *(const f32x4*)(scale + c + 4); }
#pragma unroll
            for (int ah = 0; ah < 2; ++ah) {
                f32x4 r[4][2];
                if constexpr (!R16) {
#pragma unroll
                    for (int m = 0; m < 4; ++m) { const size_t idx = (size_t)(row0 + ah * 128 + m * 16) * D + c; r[m][0] = *(const f32x4*)(resid + idx); r[m][1] = *(const f32x4*)(resid + idx + 4); }
                } else {
                    u32x4 q[4];
#pragma unroll
                    for (int m = 0; m < 4; ++m) q[m] = *(const u32x4*)(resid16 + (size_t)(row0 + ah * 128 + m * 16) * D + c);
#pragma unroll
                    for (int m = 0; m < 4; ++m) { r[m][0] = (f32x4){bflo(q[m].x), bfhi(q[m].x), bflo(q[m].y), bfhi(q[m].y)}; r[m][1] = (f32x4){bflo(q[m].z), bfhi(q[m].z), bflo(q[m].w), bfhi(q[m].w)}; }
                }
#pragma unroll
                for (int m = 0; m < 4; ++m) {
                    const size_t idx = (size_t)(row0 + ah * 128 + m * 16) * D + c;
                    const f32x4 o0 = r[m][0] + g0 * ((acc[ah][bj][m][0] + b0) * s0), o1 = r[m][1] + g1 * ((acc[ah][bj][m][1] + b1) * s1);
                    *(u32x4*)(outp + idx) = (u32x4){cvt_pk_bf16(o0.x, o0.y), cvt_pk_bf16(o0.z, o0.w), cvt_pk_bf16(o1.x, o1.y), cvt_pk_bf16(o1.z, o1.w)};
                }
            }
        }
            return -1;
    }
};

constexpr int MI_TPRE = 16, MI_CNT = 64, MI_MT2E = 128;
__device__ __forceinline__ void expert_tables(Frame& F, int layer) {
    if (F.tid < 64) {
        const int lane = F.lane;
        int c = 0;
        if (lane < NE) { c = (int)__hip_atomic_load(F.ctl + CW_CNT + 64 * layer + lane, __ATOMIC_RELAXED, __HIP_MEMORY_SCOPE_AGENT); if (c > LIST_CAP) c = LIST_CAP; }
        const int nt_ = (c + 255) >> 8;
        int pre = nt_;
#pragma unroll
        for (int off = 1; off < 32; off <<= 1) { const int v = __shfl_up(pre, off); if (lane >= off) pre += v; }
        const int excl = pre - nt_;
        if (lane < NE) { F.MISC[MI_TPRE + lane] = excl; F.MISC[MI_CNT + lane] = c; for (int q = 0; q < nt_; ++q) F.MISC[MI_MT2E + excl + q] = lane; }
        if (lane == NE - 1) F.MISC[MI_TPRE + NE] = pre;
    }
    __syncthreads();
}
constexpr int UPA_OFF = 131072;
struct PolG1 : GemmBase {
    static constexpr int KREP = KREP_G1;
    volatile LAS unsigned* MISC; LAS unsigned char* upa; const bf16_t* hn; const bf16_t* wgut; const float* bgu; const int* lslot; bf16_t* act;
    __device__ __forceinline__ int nt() const { return D / 64; }
    __device__ __forceinline__ unsigned ldb_bytes() const { return D * 2; }
    __device__ __forceinline__ bool next(int i, Unit& u) const {
        const int V = i * G + vcu, MT = (int)MISC[MI_TPRE + NE]; if (V >= MT * 8 || i >= 10) return false;
        const int mt = V >> 3, nt_ = V & 7, e = (int)MISC[MI_MT2E + mt];
        u.p0 = e; u.p1 = mt - (int)MISC[MI_TPRE + e]; u.p2 = nt_; u.p3 = mt; u.ui = i;
        u.A = (const char*)hn; u.B = (const char*)(wgut + ((size_t)e * 2048 + (size_t)nt_ * 256) * D); return true; }
    __device__ __forceinline__ void fill(int tid) const {
#pragma unroll
        for (int k = 0; k < 5; ++k) {
            const int j = tid + NTH * k, i = j >> 8, r = j & 255; Unit u;
            if (next(i, u)) {
                const int cnt = (int)MISC[MI_CNT + u.p0], li = u.p1 * 256 + r;
                ((LAS int*)(upa + i * 2048))[r] = (li < cnt) ? (lslot[(size_t)u.p0 * LIST_CAP + li] >> 2) : 0;
                ((LAS float*)(upa + i * 2048 + 1024))[r] = bgu[(size_t)u.p0 * 2048 + (r >> 7) * 1024 + u.p2 * 128 + (r & 127)];
            }
        }
    }
    __device__ __forceinline__ void aoff(const Unit& u, int R0, int C0, unsigned (&off)[4]) const {
        const LAS int* tk = (const LAS int*)(upa + u.ui * 2048);
#pragma unroll
        for (int q = 0; q < 4; ++q) off[q] = (unsigned)tk[R0 + 64 * (q & 1) + 128 * (q >> 1)] * (D * 2u) + (unsigned)C0 * 2u;
    }
    __device__ __forceinline__ int epi(const AccT& acc, const Unit& u, int wr, int wc, int fr, int fq) const {
        const int cl = wc * 32 + 8 * fq;
        const LAS float* bg = (const LAS float*)(upa + u.ui * 2048 + 1024);
        const f32x4 bgl0 = *(const LAS f32x4*)(bg + cl), bgl1 = *(const LAS f32x4*)(bg + cl + 4), bln0 = *(const LAS f32x4*)(bg + 128 + cl), bln1 = *(const LAS f32x4*)(bg + 128 + cl + 4);
        bf16_t* base = act + ((size_t)u.p3 * 256 + wr * 64 + fr) * D + u.p2 * 128 + cl;
#pragma unroll
        for (int ai = 0; ai < 2; ++ai)
#pragma unroll
            for (int m = 0; m < 4; ++m) {
                f32x4 gl0 = acc[ai][0][m][0] + bgl0, gl1 = acc[ai][0][m][1] + bgl1, ln0 = acc[ai][1][m][0] + bln0, ln1 = acc[ai][1][m][1] + bln1;
                f32x4 a0, a1;
#pragma unroll
                for (int j = 0; j < 4; ++j) {
                    const float x0 = fminf(gl0[j], SW_LIMIT), x1 = fminf(gl1[j], SW_LIMIT);
                    const float y0 = fminf(fmaxf(ln0[j], -SW_LIMIT), SW_LIMIT), y1 = fminf(fmaxf(ln1[j], -SW_LIMIT), SW_LIMIT);
                    a0[j] = x0 * sigmoidf_(SW_ALPHA * x0) * (y0 + 1.0f); a1[j] = x1 * sigmoidf_(SW_ALPHA * x1) * (y1 + 1.0f); }
                u32x4 w; w.x = cvt_pk_bf16(a0[0], a0[1]); w.y = cvt_pk_bf16(a0[2], a0[3]); w.z = cvt_pk_bf16(a1[0], a1[1]); w.w = cvt_pk_bf16(a1[2], a1[3]);
                *(u32x4*)(base + (size_t)(ai * 128 + m * 16) * D) = w;
            }
            return -1;
    }
};
struct PolG2 : GemmBase {
    static constexpr int KREP = KREP_G2;
    volatile LAS unsigned* MISC; LAS unsigned char* upa; const bf16_t* act; const bf16_t* wdnt; const float* bdn; const int* lslot; const float* lw; bf16_t* yslot;
    __device__ __forceinline__ int nt() const { return D / 64; }
    __device__ __forceinline__ unsigned ldb_bytes() const { return D * 2; }
    __device__ __forceinline__ bool next(int i, Unit& u) const {
        const int V = i * G + vcu, MT = (int)MISC[MI_TPRE + NE]; if (V >= MT * 4 || i >= 6) return false;
        const int mt = V >> 2, nt_ = V & 3, e = (int)MISC[MI_MT2E + mt];
        u.p0 = e; u.p1 = mt - (int)MISC[MI_TPRE + e]; u.p2 = nt_; u.p3 = mt; u.ui = i;
        u.A = (const char*)(act + (size_t)mt * 256 * D); u.B = (const char*)(wdnt + ((size_t)e * D + (size_t)nt_ * 256) * D); return true; }
    __device__ __forceinline__ void fill(int tid) const {
#pragma unroll
        for (int k = 0; k < 3; ++k) {
            const int j = tid + NTH * k, i = j >> 8, r = j & 255; Unit u;
            if (next(i, u)) {
                const int cnt = (int)MISC[MI_CNT + u.p0], li = u.p1 * 256 + r; const bool ok = li < cnt;
                ((LAS int*)(upa + i * 3072))[r] = ok ? lslot[(size_t)u.p0 * LIST_CAP + li] : -1;
                ((LAS float*)(upa + i * 3072 + 1024))[r] = ok ? lw[(size_t)u.p0 * LIST_CAP + li] : 0.f;
                ((LAS float*)(upa + i * 3072 + 2048))[r] = bdn[(size_t)u.p0 * D + u.p2 * 256 + r];
            }
        }
    }
    __device__ __forceinline__ void aoff(const Unit&, int R0, int C0, unsigned (&off)[4]) const { aoff_lin(R0, C0, D * 2, off); }
    __device__ __forceinline__ int epi(const AccT& acc, const Unit& u, int wr, int wc, int fr, int fq) const {
        const int cl = wc * 32 + 8 * fq;
        const LAS int* sl = (const LAS int*)(upa + u.ui * 3072); const LAS float* wl = (const LAS float*)(upa + u.ui * 3072 + 1024); const LAS float* bd = (const LAS float*)(upa + u.ui * 3072 + 2048);
        f32x4 b[2][2];
#pragma unroll
        for (int bj = 0; bj < 2; ++bj) { b[bj][0] = *(const LAS f32x4*)(bd + cl + bj * 128); b[bj][1] = *(const LAS f32x4*)(bd + cl + bj * 128 + 4); }
#pragma unroll
        for (int ai = 0; ai < 2; ++ai)
#pragma unroll
            for (int m = 0; m < 4; ++m) {
                const int rl = ai * 128 + wr * 64 + m * 16 + fr;
                const int slot = sl[rl]; const float w = wl[rl];
                if (slot >= 0) {
                    bf16_t* yr = yslot + (size_t)slot * D + u.p2 * 256 + cl;
#pragma unroll
                    for (int bj = 0; bj < 2; ++bj) {
                        const f32x4 v0 = (acc[ai][bj][m][0] + b[bj][0]) * w, v1 = (acc[ai][bj][m][1] + b[bj][1]) * w;
                        u32x4 o; o.x = cvt_pk_bf16(v0[0], v0[1]); o.y = cvt_pk_bf16(v0[2], v0[3]); o.z = cvt_pk_bf16(v1[0], v1[1]); o.w = cvt_pk_bf16(v1[2], v1[3]);
                        *(u32x4*)(yr + bj * 128) = o;
                    }
                }
            }
            return -1;
    }
};

typedef unsigned v4u_t __attribute__((ext_vector_type(4)));
template <bool F8>
struct PolMoE : GemmBase {
    static constexpr int KREP = 1;
    static constexpr bool HAS_READY = true;
    static constexpr bool FP8 = F8;
    static constexpr bool SEAM_OPT = true;
    static constexpr int EB = F8 ? 1 : 2;
    volatile LAS unsigned* MISC; LAS unsigned char* upa; const bf16_t* hn; const bf16_t* wgut; const float* bgu; const int* lslot; const float* lw; bf16_t* act;
    const bf16_t* wdnt; const float* bdn; bf16_t* yslot; unsigned* done; unsigned* tmo; __amdgpu_buffer_rsrc_t act_rsrc;
    __device__ __forceinline__ int nt() const { return D * EB / 128; }
    __device__ __forceinline__ unsigned ldb_bytes() const { return D * EB; }
    __device__ __forceinline__ bool next(int i, Unit& u) const {
        const int V = i * G + vcu, MT = (int)MISC[MI_TPRE + NE], N1 = MT * 8; if (i >= 14 || V >= MT * 12) return false;
        u.ui = i;
        if (V < N1) { const int mt = V >> 3, nt_ = V & 7, e = (int)MISC[MI_MT2E + mt];
            u.p0 = e; u.p1 = mt - (int)MISC[MI_TPRE + e]; u.p2 = nt_; u.p3 = mt;
            u.A = (const char*)hn; u.B = (const char*)wgut + ((size_t)e * 2048 + (size_t)nt_ * 256) * D * EB; }
        else { const int V2 = V - N1, mt = V2 >> 2, nt_ = V2 & 3, e = (int)MISC[MI_MT2E + mt];
            u.p0 = e; u.p1 = mt - (int)MISC[MI_TPRE + e]; u.p2 = nt_ | 8; u.p3 = mt;
            u.A = (const char*)act + (size_t)mt * 256 * D * EB; u.B = (const char*)wdnt + ((size_t)e * D + (size_t)nt_ * 256) * D * EB; }
        return true; }
    __device__ __forceinline__ void fill(int tid) const {
#pragma unroll
        for (int k = 0; k < 7; ++k) {
            const int j = tid + NTH * k, i = j >> 8, r = j & 255; Unit u;
            if (next(i, u)) {
                const int cnt = (int)MISC[MI_CNT + u.p0], li = u.p1 * 256 + r; const bool ok = li < cnt;
                if (!(u.p2 & 8)) {
                    ((LAS int*)(upa + i * 2048))[r] = ok ? (lslot[(size_t)u.p0 * LIST_CAP + li] >> 2) : 0;
                    ((LAS float*)(upa + i * 2048 + 1024))[r] = bgu[(size_t)u.p0 * 2048 + (r >> 7) * 1024 + u.p2 * 128 + (r & 127)] + (float)(r >> 7);
                } else {
                    unsigned pk = 0xffff0000u;
                    if (ok) { const unsigned sl = (unsigned)lslot[(size_t)u.p0 * LIST_CAP + li]; const float w = lw[(size_t)u.p0 * LIST_CAP + li]; pk = (sl & 0xffffu) | (cvt_pk_bf16(0.f, w) & 0xffff0000u); }
                    ((LAS unsigned*)(upa + i * 2048))[r] = pk;
                    ((LAS float*)(upa + i * 2048 + 1024))[r] = bdn[(size_t)u.p0 * D + (u.p2 & 7) * 256 + r];
                }
            }
        }
    }
    __device__ __forceinline__ void aoff(const Unit& u, int R0, int C0, unsigned (&off)[4]) const {
        if (!(u.p2 & 8)) { const LAS int* tk = (const LAS int*)(upa + u.ui * 2048);
#pragma unroll
            for (int q = 0; q < 4; ++q) off[q] = (unsigned)tk[R0 + 64 * (q & 1) + 128 * (q >> 1)] * (unsigned)(D * EB) + (unsigned)C0 * 2u;
        } else aoff_lin(R0, C0, D * EB, off);
    }
    __device__ __forceinline__ void flush(int pend) const {
        if (pend >= 0 && (threadIdx.x & 63) == 0) (void)__hip_atomic_fetch_add(done + 64 * pend, 1u, __ATOMIC_RELAXED, __HIP_MEMORY_SCOPE_AGENT);
    }
    __device__ __forceinline__ void a_ready(const Unit& u) const {
        if (!(u.p2 & 8)) return;
        if (threadIdx.x < 64) {
            unsigned* w = done + 64 * u.p3; unsigned polls = 0;
            while ((unsigned)__builtin_amdgcn_readfirstlane(__hip_atomic_load(w, __ATOMIC_RELAXED, __HIP_MEMORY_SCOPE_AGENT)) < 64u) {
                __builtin_amdgcn_s_sleep(2);
                if ((++polls & 1023u) == 0u) { if (__builtin_amdgcn_readfirstlane(__hip_atomic_load(tmo, __ATOMIC_RELAXED, __HIP_MEMORY_SCOPE_AGENT)) != 0u) break;
                    if (polls > (1u << 22)) { if (threadIdx.x == 0) __hip_atomic_store(tmo, 1u, __ATOMIC_RELAXED, __HIP_MEMORY_SCOPE_AGENT); break; } }
            }
            __builtin_amdgcn_fence(__ATOMIC_ACQUIRE, "agent");
            asm volatile("s_waitcnt vmcnt(0)" ::: "memory");
        }
        asm volatile("" ::: "memory"); __builtin_amdgcn_s_barrier(); asm volatile("" ::: "memory");
    }
    __device__ __forceinline__ int epi(const AccT& acc, const Unit& u, int wr, int wc, int fr, int fq) const {
        const int cl = wc * 32 + 8 * fq;
        if (!(u.p2 & 8)) {
            const LAS float* bg = (const LAS float*)(upa + u.ui * 2048 + 1024);
            const f32x4 bgl0 = *(const LAS f32x4*)(bg + cl), bgl1 = *(const LAS f32x4*)(bg + cl + 4), bln0 = *(const LAS f32x4*)(bg + 128 + cl), bln1 = *(const LAS f32x4*)(bg + 128 + cl + 4);
            const unsigned boff = (unsigned)((((size_t)u.p3 * 256 + wr * 64 + fr) * D + u.p2 * 128 + cl) * EB);
            constexpr float ws = F8 ? (1.0f / W8_SCALE) : 1.0f;
#pragma unroll
            for (int ai = 0; ai < 2; ++ai)
#pragma unroll
                for (int m = 0; m < 4; ++m) {
                    const f32x2 p0 = swiglu2(acc[ai][0][m][0].xy, acc[ai][1][m][0].xy, bgl0.xy, bln0.xy, ws), p1 = swiglu2(acc[ai][0][m][0].zw, acc[ai][1][m][0].zw, bgl0.zw, bln0.zw, ws);
                    const f32x2 p2 = swiglu2(acc[ai][0][m][1].xy, acc[ai][1][m][1].xy, bgl1.xy, bln1.xy, ws), p3 = swiglu2(acc[ai][0][m][1].zw, acc[ai][1][m][1].zw, bgl1.zw, bln1.zw, ws);
                    const f32x4 a0 = {p0.x, p0.y, p1.x, p1.y}, a1 = {p2.x, p2.y, p3.x, p3.y};
                    if constexpr (F8) { u32x2 w8 = {pack_fp8x4(a0[0], a0[1], a0[2], a0[3]), pack_fp8x4(a1[0], a1[1], a1[2], a1[3])};
                        __builtin_amdgcn_raw_buffer_store_b64(w8, act_rsrc, boff + (unsigned)((ai * 128 + m * 16) * D), 0,   16); }
                    else { v4u_t w; w.x = cvt_pk_bf16(a0[0], a0[1]); w.y = cvt_pk_bf16(a0[2], a0[3]); w.z = cvt_pk_bf16(a1[0], a1[1]); w.w = cvt_pk_bf16(a1[2], a1[3]);
                        __builtin_amdgcn_raw_buffer_store_b128(w, act_rsrc, boff + (unsigned)((ai * 128 + m * 16) * D * 2), 0,   16); }
                }
            return u.p3;
        } else {
            const LAS unsigned* sl = (const LAS unsigned*)(upa + u.ui * 2048); const LAS float* bd = (const LAS float*)(upa + u.ui * 2048 + 1024);
            f32x4 b[2][2];
#pragma unroll
            for (int bj = 0; bj < 2; ++bj) { b[bj][0] = *(const LAS f32x4*)(bd + cl + bj * 128); b[bj][1] = *(const LAS f32x4*)(bd + cl + bj * 128 + 4); }
#pragma unroll
            for (int ai = 0; ai < 2; ++ai)
#pragma unroll
                for (int m = 0; m < 4; ++m) {
                    const unsigned pk = sl[ai * 128 + wr * 64 + m * 16 + fr];
                    if ((pk >> 16) != 0xffffu) {
                        const float w = bfhi(pk); constexpr float ws = F8 ? (1.0f / W8_SCALE) : 1.0f;
                        bf16_t* yr = yslot + (size_t)(pk & 0xffffu) * D + (u.p2 & 7) * 256 + cl;
#pragma unroll
                        for (int bj = 0; bj < 2; ++bj) {
                            const f32x4 v0 = (acc[ai][bj][m][0] * ws + b[bj][0]) * w, v1 = (acc[ai][bj][m][1] * ws + b[bj][1]) * w;
                            u32x4 o; o.x = cvt_pk_bf16(v0[0], v0[1]); o.y = cvt_pk_bf16(v0[2], v0[3]); o.z = cvt_pk_bf16(v1[0], v1[1]); o.w = cvt_pk_bf16(v1[2], v1[3]);
                            *(u32x4*)(yr + bj * 128) = o;
                        }
                    }
                }
        }
            return -1;
    }
};

template <class P> __device__ __forceinline__ void run_gemm(Frame& F, const P& S) {
#if SIMPLE_GEMM
    pg8::gemm_simple<P>(F.lds, S);
#else
    pg8::gemm_pipe<P>(F.lds, S);
#endif
}

constexpr int LA_QA = 0, LA_QH = 17408, LA_KA = 34816, LA_VT = 52224, LA_AS = 70656, LA_ST = 79872, LA_QS = 114688, LA_PS = 118784;
constexpr int RS128 = 272, RS64 = 144;
__device__ __forceinline__ float ret_lg(int hh) { return __logf(1.0f - exp2f(-5.0f - (float)(hh - 4))); }
__device__ __forceinline__ u32x4 pack8(const float (&v)[8]) { return (u32x4){cvt_pk_bf16(v[0], v[1]), cvt_pk_bf16(v[2], v[3]), cvt_pk_bf16(v[4], v[5]), cvt_pk_bf16(v[6], v[7])}; }

__device__ __forceinline__ void la_cumsum(const float* gbuf, int hh, int t0, int d0, float (&b0)[8], float (&b1)[8]) {
    if (hh < 4) { float r0 = 0.f, r1 = 0.f;
#pragma unroll
        for (int i = 0; i < 8; ++i) { const f32x2 g = *(const f32x2*)(gbuf + (size_t)(t0 + i) * 512 + hh * 128 + d0); r0 += g.x; r1 += g.y; b0[i] = r0; b1[i] = r1; }
    } else { const float lg = ret_lg(hh);
#pragma unroll
        for (int i = 0; i < 8; ++i) { b0[i] = (float)(i + 1) * lg; b1[i] = b0[i]; }
    }
}

struct LaIn { f32x2 g[8]; unsigned qq[8], kk[8], vv[8]; u32x4 st[4]; u32x2 gt[4]; };
template <bool OUT>
__device__ __forceinline__ void la_load(LaIn& in, const bf16_t* qkvg, const _Float16* gbuf, const bf16_t* sprev, int unit, int oc, int d0, int tid) {
    const int hh = unit >> 8, n = unit & 255, t0 = n * 64 + oc * 8;
    if (hh < 4) {
#pragma unroll
        for (int i = 0; i < 8; ++i) { const h16x2 gh = *(const h16x2*)(gbuf + (size_t)(t0 + i) * 512 + hh * 128 + d0); in.g[i] = (f32x2){(float)gh.x, (float)gh.y}; }
    }
#pragma unroll
    for (int i = 0; i < 8; ++i) { const bf16_t* row = qkvg + (size_t)(t0 + i) * INW + hh * 128 + d0; if (OUT) in.qq[i] = *(const unsigned*)row; in.kk[i] = *(const unsigned*)(row + 1024); in.vv[i] = *(const unsigned*)(row + 2048); }
    if (OUT) {
        const bf16_t* sp = sprev + ((size_t)hh * 256 + n) * 16384;
#pragma unroll
        for (int j = 0; j < 4; ++j) { const int c = tid + NTH * j; in.st[j] = *(const u32x4*)(sp + (c >> 4) * 128 + (c & 15) * 8); }
        const int lane = tid & 63, fr = lane & 15, fq = lane >> 4, tt = oc >> 1, eh = oc & 1;
#pragma unroll
        for (int ei = 0; ei < 4; ++ei) in.gt[ei] = *(const u32x2*)(qkvg + (size_t)(n * 64 + 16 * tt + fr) * INW + 3072 + hh * 128 + 16 * (4 * eh + ei) + 4 * fq);
    }
}
__device__ __forceinline__ void la_cumsum_in(const LaIn& in, int hh, float (&b0)[8], float (&b1)[8]) {
    if (hh < 4) { float r0 = 0.f, r1 = 0.f;
#pragma unroll
        for (int i = 0; i < 8; ++i) { r0 += in.g[i].x; r1 += in.g[i].y; b0[i] = r0; b1[i] = r1; }
    } else { const float lg = ret_lg(hh);
#pragma unroll
        for (int i = 0; i < 8; ++i) { b0[i] = (float)(i + 1) * lg; b1[i] = b0[i]; }
    }
}

__device__ __forceinline__ void la_local_state(Frame& F) {
    const bf16_t* qkvg = WSP(F, WS_QKVG, bf16_t); const _Float16* gbuf = WSP(F, WS_GBUF, _Float16); bf16_t* kvt = WSP(F, WS_KVT, bf16_t); float* dec = WSP(F, WS_DEC, float);
    LAS unsigned char* lds = F.lds; LAS float* qs = (LAS float*)(lds + LA_QS);
    const int lane = F.lane, oc = F.wave, d0 = 2 * lane, fr = lane & 15, fq = lane >> 4;
    LaIn nx;
    if (F.vcu < 2048) la_load<false>(nx, qkvg, gbuf, nullptr, F.vcu, oc, d0, F.tid);
    for (int unit = F.vcu; unit < 2048; unit += F.G) {
        const int hh = unit >> 8, n = unit & 255;
        const LaIn in = nx;
        if (unit + F.G < 2048) la_load<false>(nx, qkvg, gbuf, nullptr, unit + F.G, oc, d0, F.tid);
        float b0[8], b1[8]; la_cumsum_in(in, hh, b0, b1);
        *(LAS f32x2*)(qs + oc * 128 + d0) = (f32x2){b0[7], b1[7]};
        const unsigned (&kk)[8] = in.kk; const unsigned (&vv)[8] = in.vv;
        __syncthreads();
        float base0 = 0.f, base1 = 0.f, tot0 = 0.f, tot1 = 0.f;
#pragma unroll
        for (int o = 0; o < 8; ++o) { const f32x2 q = *(const LAS f32x2*)(qs + o * 128 + d0); if (o < oc) { base0 += q.x; base1 += q.y; } tot0 += q.x; tot1 += q.y; }
        float a0[8], a1[8], c0[8], c1[8];
#pragma unroll
        for (int i = 0; i < 8; ++i) { a0[i] = bflo(kk[i]) * __expf(tot0 - base0 - b0[i]); a1[i] = bfhi(kk[i]) * __expf(tot1 - base1 - b1[i]); c0[i] = bflo(vv[i]); c1[i] = bfhi(vv[i]); }
        *(LAS u32x4*)(lds + LA_QA + d0 * RS64 + oc * 16) = pack8(a0); *(LAS u32x4*)(lds + LA_QA + (d0 + 1) * RS64 + oc * 16) = pack8(a1);
        *(LAS u32x4*)(lds + LA_VT + d0 * RS64 + oc * 16) = pack8(c0); *(LAS u32x4*)(lds + LA_VT + (d0 + 1) * RS64 + oc * 16) = pack8(c1);
        if (oc == 0) *(f32x2*)(dec + ((size_t)hh * 256 + n) * 128 + d0) = (f32x2){__expf(tot0), __expf(tot1)};
        __syncthreads();
        const int et = oc;
        bf16x8 vt[2];
#pragma unroll
        for (int ks = 0; ks < 2; ++ks) vt[ks] = *(const LAS bf16x8*)(lds + LA_VT + (16 * et + fr) * RS64 + (32 * ks + 8 * fq) * 2);
        bf16_t* orow = kvt + (((size_t)hh * 256 + n) * 128 + 16 * et + fr) * 128 + 4 * fq;
#pragma unroll
        for (int dt = 0; dt < 8; ++dt) {
            f32x4 acc = {0.f, 0.f, 0.f, 0.f};
#pragma unroll
            for (int ks = 0; ks < 2; ++ks) { const bf16x8 a = *(const LAS bf16x8*)(lds + LA_QA + (16 * dt + fr) * RS64 + (32 * ks + 8 * fq) * 2); acc = __builtin_amdgcn_mfma_f32_16x16x32_bf16(a, vt[ks], acc, 0, 0, 0); }
            *(u32x2*)(orow + 16 * dt) = (u32x2){cvt_pk_bf16(acc[0], acc[1]), cvt_pk_bf16(acc[2], acc[3])};
        }
        __syncthreads();
    }
}

__device__ __forceinline__ void la_scan(Frame& F) {
    const bf16_t* kvt = WSP(F, WS_KVT, bf16_t); const float* dec = WSP(F, WS_DEC, float); bf16_t* sprev = WSP(F, WS_SPREV, bf16_t);
    for (int idx = F.vcu * NTH + F.tid; idx < 8 * 16384; idx += F.G * NTH) {
        const int hh = idx >> 14, rem = idx & 16383, d = rem & 127;
        const bf16_t* kv = kvt + (size_t)hh * 256 * 16384 + rem; const float* dc = dec + (size_t)hh * 256 * 128 + d; bf16_t* sp = sprev + (size_t)hh * 256 * 16384 + rem;
        float S = 0.f;
        for (int n0 = 0; n0 < 256; n0 += 16) {
            float kvv[16], dd[16];
#pragma unroll
            for (int i = 0; i < 16; ++i) { kvv[i] = bf2f(kv[(size_t)(n0 + i) * 16384]); dd[i] = dc[(n0 + i) * 128]; }
#pragma unroll
            for (int i = 0; i < 16; ++i) { sp[(size_t)(n0 + i) * 16384] = (bf16_t)(cvt_pk_bf16(S, 0.f) & 0xffffu); S = dd[i] * S + kvv[i]; }
        }
    }
}

__device__ __forceinline__ void la_output(Frame& F) {
    const bf16_t* qkvg = WSP(F, WS_QKVG, bf16_t); const _Float16* gbuf = WSP(F, WS_GBUF, _Float16); const bf16_t* sprev = WSP(F, WS_SPREV, bf16_t); bf16_t* cat = WSP(F, WS_CAT, bf16_t);
    LAS unsigned char* lds = F.lds; LAS float* qs = (LAS float*)(lds + LA_QS); LAS float* ps = (LAS float*)(lds + LA_PS);
    const int tid = F.tid, lane = F.lane, oc = F.wave, d0 = 2 * lane, fr = lane & 15, fq = lane >> 4;
    LaIn nx;
    if (F.vcu < 2048) la_load<true>(nx, qkvg, gbuf, sprev, F.vcu, oc, d0, tid);
    for (int unit = F.vcu; unit < 2048; unit += F.G) {
        const int hh = unit >> 8, n = unit & 255;
        const LaIn in = nx;
        if (unit + F.G < 2048) la_load<true>(nx, qkvg, gbuf, sprev, unit + F.G, oc, d0, tid);
        float b0[8], b1[8]; la_cumsum_in(in, hh, b0, b1);
        *(LAS f32x2*)(qs + oc * 128 + d0) = (f32x2){b0[7], b1[7]};
        const unsigned (&qq)[8] = in.qq; const unsigned (&kk)[8] = in.kk; const unsigned (&vv)[8] = in.vv;
#pragma unroll
        for (int j = 0; j < 4; ++j) { const int c = tid + NTH * j; *(LAS u32x4*)(lds + LA_ST + (c >> 4) * RS128 + (c & 15) * 16) = in.st[j]; }
        __syncthreads();
        float base0 = 0.f, base1 = 0.f, bm0 = 0.f, bm1 = 0.f;
#pragma unroll
        for (int o = 0; o < 8; ++o) { const f32x2 q = *(const LAS f32x2*)(qs + o * 128 + d0); if (o < oc) { base0 += q.x; base1 += q.y; } if (o < 4) { bm0 += q.x; bm1 += q.y; } }
        float c0[8], c1[8];
#pragma unroll
        for (int i = 0; i < 8; ++i) {
            const int t = 8 * oc + i; const float bt0 = base0 + b0[i], bt1 = base1 + b1[i];
            const float q0 = bflo(qq[i]), q1 = bfhi(qq[i]), k0 = bflo(kk[i]), k1 = bfhi(kk[i]);
            *(LAS unsigned*)(lds + LA_QA + t * RS128 + d0 * 2) = cvt_pk_bf16(q0 * __expf(bt0 - bm0), q1 * __expf(bt1 - bm1));
            *(LAS unsigned*)(lds + LA_QH + t * RS128 + d0 * 2) = cvt_pk_bf16(q0 * __expf(bt0), q1 * __expf(bt1));
            *(LAS unsigned*)(lds + LA_KA + t * RS128 + d0 * 2) = cvt_pk_bf16(k0 * __expf(bm0 - bt0), k1 * __expf(bm1 - bt1));
            c0[i] = bflo(vv[i]); c1[i] = bfhi(vv[i]);
        }
        *(LAS u32x4*)(lds + LA_VT + d0 * RS64 + oc * 16) = pack8(c0); *(LAS u32x4*)(lds + LA_VT + (d0 + 1) * RS64 + oc * 16) = pack8(c1);
        __syncthreads();
        const int tt = oc >> 1, eh = oc & 1;
        {
            bf16x8 qf[4];
#pragma unroll
            for (int ks = 0; ks < 4; ++ks) qf[ks] = *(const LAS bf16x8*)(lds + LA_QA + (16 * tt + fr) * RS128 + (32 * ks + 8 * fq) * 2);
#pragma unroll
            for (int sti = 0; sti < 2; ++sti) {
                const int st = 2 * eh + sti;
                f32x4 acc = {0.f, 0.f, 0.f, 0.f};
                if (st <= tt) {
#pragma unroll
                    for (int ks = 0; ks < 4; ++ks) { const bf16x8 a = *(const LAS bf16x8*)(lds + LA_KA + (16 * st + fr) * RS128 + (32 * ks + 8 * fq) * 2); acc = __builtin_amdgcn_mfma_f32_16x16x32_bf16(a, qf[ks], acc, 0, 0, 0); }
                    if (st == tt) {
#pragma unroll
                        for (int r = 0; r < 4; ++r) if (4 * fq + r > fr) acc[r] = 0.f;
                    }
                }
                *(LAS u32x2*)(lds + LA_AS + (16 * tt + fr) * RS64 + (16 * st + 4 * fq) * 2) = (u32x2){cvt_pk_bf16(acc[0], acc[1]), cvt_pk_bf16(acc[2], acc[3])};
            }
        }
        __syncthreads();
        f32x4 o[4]; float ss = 0.f;
        {
            bf16x8 af[2], hf[4];
#pragma unroll
            for (int ks = 0; ks < 2; ++ks) af[ks] = *(const LAS bf16x8*)(lds + LA_AS + (16 * tt + fr) * RS64 + (32 * ks + 8 * fq) * 2);
#pragma unroll
            for (int ks = 0; ks < 4; ++ks) hf[ks] = *(const LAS bf16x8*)(lds + LA_QH + (16 * tt + fr) * RS128 + (32 * ks + 8 * fq) * 2);
#pragma unroll
            for (int ei = 0; ei < 4; ++ei) {
                const int et = 4 * eh + ei;
                f32x4 acc = {0.f, 0.f, 0.f, 0.f};
#pragma unroll
                for (int ks = 0; ks < 2; ++ks) { const bf16x8 a = *(const LAS bf16x8*)(lds + LA_VT + (16 * et + fr) * RS64 + (32 * ks + 8 * fq) * 2); acc = __builtin_amdgcn_mfma_f32_16x16x32_bf16(a, af[ks], acc, 0, 0, 0); }
#pragma unroll
                for (int ks = 0; ks < 4; ++ks) { const bf16x8 a = *(const LAS bf16x8*)(lds + LA_ST + (16 * et + fr) * RS128 + (32 * ks + 8 * fq) * 2); acc = __builtin_amdgcn_mfma_f32_16x16x32_bf16(a, hf[ks], acc, 0, 0, 0); }
                o[ei] = acc; ss += (acc[0] * acc[0] + acc[1] * acc[1]) + (acc[2] * acc[2] + acc[3] * acc[3]);
            }
        }
        ss += __shfl_xor(ss, 16); ss += __shfl_xor(ss, 32);
        if (lane < 16) ps[(tt * 2 + eh) * 16 + lane] = ss;
        __syncthreads();
        const float tot = ps[(tt * 2) * 16 + fr] + ps[(tt * 2 + 1) * 16 + fr];
        const float rstd = rsqrtf(tot * (1.f / 128.f) + EPS);
        const float* gain = (hh < 4) ? (inptr(6) + hh * 128) : (inptr(7) + (hh - 4) * 128);
        const size_t rowi = (size_t)(n * 64 + 16 * tt + fr);
#pragma unroll
        for (int ei = 0; ei < 4; ++ei) {
            const int e0 = 16 * (4 * eh + ei) + 4 * fq;
            const f32x4 gn = *(const f32x4*)(gain + e0);
            const u32x2 gt = in.gt[ei];
            const f32x4 v = o[ei] * rstd * gn;
            *(u32x2*)(cat + rowi * D + hh * 128 + e0) = (u32x2){cvt_pk_bf16(v[0] * bflo(gt.x), v[1] * bfhi(gt.x)), cvt_pk_bf16(v[2] * bflo(gt.y), v[3] * bfhi(gt.y))};
        }
        __syncthreads();
    }
}

constexpr int RT_STRIDE = 2064, RT_PART = 32 * RT_STRIDE;
__device__ __forceinline__ void sel4of8(float (&v)[8], const int (&ix)[8], float (&tv)[4], int (&ti)[4]) {
#pragma unroll
    for (int k = 0; k < 4; ++k) {
        float best = v[0]; int bi = ix[0];
#pragma unroll
        for (int q = 1; q < 8; ++q) { const bool better = (v[q] > best) || (v[q] == best && ix[q] < bi); best = better ? v[q] : best; bi = better ? ix[q] : bi; }
        tv[k] = best; ti[k] = bi;
#pragma unroll
        for (int q = 0; q < 8; ++q) v[q] = (ix[q] == bi) ? -INFINITY : v[q];
    }
}
__device__ __forceinline__ void p_route(Frame& F, int layer, const bf16_t* X, int aux = 0) {
    const int tid = F.tid, lane = F.lane;
    LAS unsigned char* lds = F.lds;
    LAS float* ssq = (LAS float*)(lds + 2 * RT_PART);
    LAS f32x4* lgx = (LAS f32x4*)(lds + 2 * RT_PART + 512);
    LAS int* pe = (LAS int*)(lds + 2 * RT_PART + 512 + 8192);
    LAS float* pw = (LAS float*)(pe + 256);
    LAS int* hist = (LAS int*)(pw + 256);
    LAS int* gbase = hist + 32;
    {
        const bf16_t* rt = WSP(F, WS_RT, bf16_t) + (size_t)layer * 2 * 32 * D;
#pragma unroll 4
        for (int j = 0; j < 16; ++j) { const int ch = tid + NTH * j, part = ch >> 12, row = (ch >> 7) & 31, c16 = ch & 127;
            *(LAS u32x4*)(lds + part * RT_PART + row * RT_STRIDE + c16 * 16) = *(const u32x4*)(rt + ((size_t)(part * 32 + row) * D + c16 * 8)); }
    }
    const float* mod = WSP(F, WS_MOD, float) + (size_t)layer * 6 * D;
    int* lslot = WSP(F, WS_LSLOT, int) + (size_t)layer * NE * LIST_CAP; float* lw = WSP(F, WS_LW, float) + (size_t)layer * NE * LIST_CAP;
    if (aux) { lslot = (int*)(F.ws + WS_END); lw = (float*)(F.ws + WS_END + 4 * MiB); }
    unsigned* cntw = F.ctl + CW_CNT + 64 * (layer + 2 * aux);
    const int tile = F.wave & 3, kh = F.wave >> 2, tk = lane & 15, kq = lane >> 4;
    const float* brt = inptr(13) + layer * NE;
    __syncthreads();
    for (int tb = F.vcu; tb < T / 64; tb += F.G) {
        if (tid < 32) hist[tid] = 0;
        const int row = tb * 64 + tile * 16 + tk;
        const bf16_t* xr = X + (size_t)row * D + kh * 512 + 8 * kq;
        float ss = 0.f;
#pragma unroll 8
        for (int s = 0; s < 16; ++s) { const u32x4 q = *(const u32x4*)(xr + 32 * s);
            const f32x4 a = {bflo(q.x), bfhi(q.x), bflo(q.y), bfhi(q.y)}, b = {bflo(q.z), bfhi(q.z), bflo(q.w), bfhi(q.w)};
            ss += (a.x * a.x + a.y * a.y) + (a.z * a.z + a.w * a.w) + (b.x * b.x + b.y * b.y) + (b.z * b.z + b.w * b.w); }
        ss += __shfl_xor(ss, 16); ss += __shfl_xor(ss, 32);
        if (kq == 0) ssq[F.wave * 16 + tk] = ss;
        __syncthreads();
        const float rstd = rsqrtf((ssq[tile * 16 + tk] + ssq[(tile + 4) * 16 + tk]) * (1.f / D) + EPS);
        f32x4 acc[2] = {{0.f, 0.f, 0.f, 0.f}, {0.f, 0.f, 0.f, 0.f}};
        bf16_t* hrow = WSP(F, WS_HN, bf16_t) + (size_t)row * D;
#pragma unroll 2
        for (int s = 0; s < 16; ++s) {
            const int col = kh * 512 + 32 * s + 8 * kq;
            const u32x4 q = *(const u32x4*)(xr + 32 * s);
            const f32x4 a = {bflo(q.x), bfhi(q.x), bflo(q.y), bfhi(q.y)}, b = {bflo(q.z), bfhi(q.z), bflo(q.w), bfhi(q.w)};
            const f32x4 sc0 = *(const f32x4*)(mod + 4 * D + col) + 1.0f, sc1 = *(const f32x4*)(mod + 4 * D + col + 4) + 1.0f;
            const f32x4 sh0 = *(const f32x4*)(mod + 3 * D + col), sh1 = *(const f32x4*)(mod + 3 * D + col + 4);
            const f32x4 h0 = a * rstd * sc0 + sh0, h1 = b * rstd * sc1 + sh1;
            u32x4 hi; hi.x = cvt_pk_bf16(h0.x, h0.y); hi.y = cvt_pk_bf16(h0.z, h0.w); hi.z = cvt_pk_bf16(h1.x, h1.y); hi.w = cvt_pk_bf16(h1.z, h1.w);
            if ((FP8_LAYERS >> layer) & 1) *(u32x2*)(WSP(F, WS_HN8, unsigned char) + (size_t)row * D + col) = (u32x2){pack_fp8x4(h0.x, h0.y, h0.z, h0.w), pack_fp8x4(h1.x, h1.y, h1.z, h1.w)};
            else *(u32x4*)(hrow + col) = hi;
            u32x4 lo; lo.x = cvt_pk_bf16(h0.x - bflo(hi.x), h0.y - bfhi(hi.x)); lo.y = cvt_pk_bf16(h0.z - bflo(hi.y), h0.w - bfhi(hi.y));
            lo.z = cvt_pk_bf16(h1.x - bflo(hi.z), h1.y - bfhi(hi.z)); lo.w = cvt_pk_bf16(h1.z - bflo(hi.w), h1.w - bfhi(hi.w));
            const bf16x8 bh = __builtin_bit_cast(bf16x8, hi), bl = __builtin_bit_cast(bf16x8, lo);
#pragma unroll
            for (int et = 0; et < 2; ++et) {
                const bf16x8 wh = *(const LAS bf16x8*)(lds + (16 * et + tk) * RT_STRIDE + col * 2);
                const bf16x8 wl = *(const LAS bf16x8*)(lds + RT_PART + (16 * et + tk) * RT_STRIDE + col * 2);
                acc[et] = __builtin_amdgcn_mfma_f32_16x16x32_bf16(wh, bh, acc[et], 0, 0, 0);
                acc[et] = __builtin_amdgcn_mfma_f32_16x16x32_bf16(wl, bh, acc[et], 0, 0, 0);
                acc[et] = __builtin_amdgcn_mfma_f32_16x16x32_bf16(wh, bl, acc[et], 0, 0, 0);
            }
        }
        if (kh == 1) { lgx[(tile * 2 + 0) * 64 + lane] = acc[0]; lgx[(tile * 2 + 1) * 64 + lane] = acc[1]; }
        __syncthreads();
        if (kh == 0) {
            float cv[8]; int ci[8];
#pragma unroll
            for (int et = 0; et < 2; ++et) { const f32x4 o = lgx[(tile * 2 + et) * 64 + lane]; const f32x4 bb = *(const f32x4*)(brt + 16 * et + 4 * kq);
#pragma unroll
                for (int r = 0; r < 4; ++r) { cv[et * 4 + r] = acc[et][r] + o[r] + bb[r]; ci[et * 4 + r] = 16 * et + 4 * kq + r; } }
            float tv[4]; int ti[4];
            sel4of8(cv, ci, tv, ti);
#pragma unroll
            for (int off = 16; off <= 32; off <<= 1) {
                float mv[8]; int mi[8];
#pragma unroll
                for (int k = 0; k < 4; ++k) { mv[k] = tv[k]; mi[k] = ti[k]; mv[4 + k] = __shfl_xor(tv[k], off); mi[4 + k] = __shfl_xor(ti[k], off); }
                sel4of8(mv, mi, tv, ti);
            }
            const float e1 = __expf(tv[1] - tv[0]), e2 = __expf(tv[2] - tv[0]), e3 = __expf(tv[3] - tv[0]); const float inv = 1.0f / (1.0f + e1 + e2 + e3);
            if (kq == 0) { const int tl = tile * 16 + tk;
                pe[tl * 4 + 0] = ti[0]; pe[tl * 4 + 1] = ti[1]; pe[tl * 4 + 2] = ti[2]; pe[tl * 4 + 3] = ti[3];
                pw[tl * 4 + 0] = inv; pw[tl * 4 + 1] = e1 * inv; pw[tl * 4 + 2] = e2 * inv; pw[tl * 4 + 3] = e3 * inv; }
        }
        __syncthreads();
        int myexp = 0, lpos = 0;
        if (tid < 256) { myexp = pe[tid]; lpos = __hip_atomic_fetch_add(hist + myexp, 1, __ATOMIC_RELAXED, __HIP_MEMORY_SCOPE_WORKGROUP); }
        __syncthreads();
        if (tid < 32) gbase[tid] = (int)atomicAdd(cntw + tid, (unsigned)hist[tid]);
        __syncthreads();
        if (tid < 256) { const int pos = gbase[myexp] + lpos; if (pos < LIST_CAP) { lslot[(size_t)myexp * LIST_CAP + pos] = tb * 256 + tid; lw[(size_t)myexp * LIST_CAP + pos] = pw[tid]; } }
        __syncthreads();
    }
}

template <int MODE>
__device__ __forceinline__ void p_combine(Frame& F, int layer, const bf16_t* Xin, void* Xout_) {
    const int lane = F.lane;
    const float* mod = WSP(F, WS_MOD, float) + (size_t)layer * 6 * D;
    const bf16_t* ys = WSP(F, WS_YSLOT, bf16_t);
    f32x4 gf[4], fnw[4];
#pragma unroll
    for (int j = 0; j < 4; ++j) { gf[j] = *(const f32x4*)(mod + 5 * D + 4 * lane + 256 * j); if (MODE == 1) fnw[j] = *(const f32x4*)(inptr(18) + 4 * lane + 256 * j); }
    for (int it = 0; it < (T / 64 + F.G - 1) / F.G * 8; ++it) {
        const int row = ((it >> 3) * F.G + F.vcu) * 64 + F.wave * 8 + (it & 7); if (row >= T) break;
        const u32x2* xr = (const u32x2*)(Xin + (size_t)row * D) + lane;
        f32x4 v[4]; float s = 0.f;
#pragma unroll
        for (int j = 0; j < 4; ++j) {
            f32x4 a = {0.f, 0.f, 0.f, 0.f};
#pragma unroll
            for (int k = 0; k < 4; ++k) { const u32x2 y = *((const u32x2*)(ys + ((size_t)row * 4 + k) * D) + lane + 64 * j); a += (f32x4){bflo(y.x), bfhi(y.x), bflo(y.y), bfhi(y.y)}; }
            const u32x2 xq = xr[64 * j];
            v[j] = (f32x4){bflo(xq.x), bfhi(xq.x), bflo(xq.y), bfhi(xq.y)} + gf[j] * a;
            if (MODE == 0) { const u32x2 w = {cvt_pk_bf16(v[j].x, v[j].y), cvt_pk_bf16(v[j].z, v[j].w)};
                ((u32x2*)((bf16_t*)Xout_ + (size_t)row * D) + lane)[64 * j] = w; v[j] = (f32x4){bflo(w.x), bfhi(w.x), bflo(w.y), bfhi(w.y)}; }
            s += (v[j].x * v[j].x + v[j].y * v[j].y) + (v[j].z * v[j].z + v[j].w * v[j].w);
        }
        const float rstd = rsqrtf(wave_sum(s) * (1.f / D) + EPS);
        if (MODE == 0) { if (lane == 0) WSP(F, WS_RSTD, float)[row] = rstd; }
        else { f32x4* o = (f32x4*)((float*)Xout_ + (size_t)row * D) + lane;
#pragma unroll
            for (int j = 0; j < 4; ++j) __builtin_nontemporal_store(v[j] * rstd * fnw[j], o + 64 * j);
        }
    }
}

template <int W>
__device__ __forceinline__ void pool_unit(const bf16_t* X, const float* rs, bf16_t* P, int c, int t0, float sh, float sc) {
    float hp[16], hc[16];
#pragma unroll
    for (int i = 0; i < 16; ++i) { const int t = t0 - 16 + i; hp[i] = (i >= 16 - (W - 1) && t >= 0) ? bf2f(X[(size_t)t * D + c]) * rs[t] * sc + sh : 0.f; }
    float sum = 0.f;
#pragma unroll
    for (int i = 1; i < W; ++i) sum += hp[16 - i];
#pragma unroll
    for (int blk = 0; blk < 2; ++blk) {
        const int tb = t0 + 16 * blk;
#pragma unroll
        for (int i = 0; i < 16; ++i) hc[i] = bf2f(X[(size_t)(tb + i) * D + c]) * rs[tb + i] * sc + sh;
#pragma unroll
        for (int i = 0; i < 16; ++i) {
            const int t = tb + i;
            sum += hc[i];
            const int cnt = (t + 1 < W) ? (t + 1) : W;
            const float p = sum / (float)cnt - hc[i];
            P[(size_t)t * D + c] = (bf16_t)(cvt_pk_bf16(p, 0.f) & 0xffffu);
            sum -= (i - (W - 1) >= 0) ? hc[(i - (W - 1)) & 15] : hp[(16 + i - (W - 1)) & 15];
        }
#pragma unroll
        for (int i = 0; i < 16; ++i) hp[i] = hc[i];
    }
}
__device__ __forceinline__ void p_pool(Frame& F, const bf16_t* X) {
    const float* mod = WSP(F, WS_MOD, float) + (size_t)1 * 6 * D; const float* rs = WSP(F, WS_RSTD, float); bf16_t* P = WSP(F, WS_HN, bf16_t);
    const int tid = F.tid;
    for (int u = F.vcu; u < 1024; u += F.G) {
        const int tt = u >> 2, g = u & 3;
        const int c = g * 256 + (tid & 255), t0 = tt * 64 + (tid >> 8) * 32;
        const float sh = mod[0 * D + c], sc = 1.0f + mod[1 * D + c];
        if (g == 0) pool_unit<2>(X, rs, P, c, t0, sh, sc);
        else if (g == 1) pool_unit<4>(X, rs, P, c, t0, sh, sc);
        else if (g == 2) pool_unit<8>(X, rs, P, c, t0, sh, sc);
        else pool_unit<16>(X, rs, P, c, t0, sh, sc);
    }
}

constexpr int PG_STRIDE = 2064;
constexpr int PG_RS = 64 * PG_STRIDE;
template <int W>
__device__ __forceinline__ void pool_pair(const bf16_t* xcol, const LAS float* rsl, LAS unsigned* Pd, int t0, f32x2 sh, f32x2 sc) {
    f32x2 hp[16], hc[16];
#pragma unroll
    for (int i = 0; i < 16; ++i) { const int t = t0 - 16 + i; hp[i] = (f32x2){0.f, 0.f};
        if (i >= 16 - (W - 1) && t >= 0) { const unsigned q = *(const unsigned*)(xcol + (size_t)t * D); hp[i] = (f32x2){bflo(q), bfhi(q)} * rsl[i] * sc + sh; } }
    f32x2 sum = {0.f, 0.f};
#pragma unroll
    for (int i = 1; i < W; ++i) sum += hp[16 - i];
#pragma unroll 2
    for (int blk = 0; blk < 4; ++blk) {
        const int tb = t0 + 16 * blk;
#pragma unroll
        for (int i = 0; i < 16; ++i) { const unsigned q = *(const unsigned*)(xcol + (size_t)(tb + i) * D); hc[i] = (f32x2){bflo(q), bfhi(q)} * rsl[16 + 16 * blk + i] * sc + sh; }
#pragma unroll
        for (int i = 0; i < 16; ++i) {
            const int t = tb + i;
            sum += hc[i];
            const float inv = 1.0f / (float)((t + 1 < W) ? (t + 1) : W);
            const f32x2 p = sum * inv - hc[i];
            Pd[(size_t)(16 * blk + i) * (PG_STRIDE / 4)] = cvt_pk_bf16(p.x, p.y);
            sum -= (i - (W - 1) >= 0) ? hc[(i - (W - 1)) & 15] : hp[(16 + i - (W - 1)) & 15];
        }
#pragma unroll
        for (int i = 0; i < 16; ++i) hp[i] = hc[i];
    }
}
__device__ __forceinline__ void p_pool_gemm(Frame& F, const bf16_t* X2, bf16_t* X1) {
    const float* mod = WSP(F, WS_MOD, float) + (size_t)1 * 6 * D; const float* rs = WSP(F, WS_RSTD, float); const bf16_t* pwt = WSP(F, WS_POOLT, bf16_t);
    const float* pb = inptr(10); const float* psc = inptr(11);
    LAS unsigned char* lds = F.lds; LAS float* rsl = (LAS float*)(lds + PG_RS);
    const int tid = F.tid, lane = F.lane, w = F.wave, fr = lane & 15, fq = lane >> 4;
    for (int tb = F.vcu; tb < T / 64; tb += F.G) {
        const int t0 = tb * 64;
        if (tid < 80) { const int t = t0 - 16 + tid; rsl[tid] = (t >= 0) ? rs[t] : 0.f; }
        __syncthreads();
        {
            const int c2 = 2 * tid, gq = w >> 1;
            const f32x2 sh = *(const f32x2*)(mod + 0 * D + c2), sc = *(const f32x2*)(mod + 1 * D + c2) + 1.0f;
            LAS unsigned* Pd = (LAS unsigned*)(lds + c2 * 2);
            if (gq == 0) pool_pair<2>(X2 + c2, rsl, Pd, t0, sh, sc);
            else if (gq == 1) pool_pair<4>(X2 + c2, rsl, Pd, t0, sh, sc);
            else if (gq == 2) pool_pair<8>(X2 + c2, rsl, Pd, t0, sh, sc);
            else pool_pair<16>(X2 + c2, rsl, Pd, t0, sh, sc);
        }
        __syncthreads();
#pragma unroll 1
        for (int g = 0; g < 4; ++g) {
            f32x4 acc[2][4];
#pragma unroll
            for (int nt = 0; nt < 2; ++nt)
#pragma unroll
                for (int tt = 0; tt < 4; ++tt) acc[nt][tt] = (f32x4){0.f, 0.f, 0.f, 0.f};
            bf16x8 wf[2][8];
#pragma unroll
            for (int nt = 0; nt < 2; ++nt)
#pragma unroll
                for (int ks = 0; ks < 8; ++ks) wf[nt][ks] = *(const bf16x8*)(pwt + ((size_t)g * 256 + 32 * w + 16 * nt + fr) * 256 + 32 * ks + 8 * fq);
            u32x2 xq[2][4];
#pragma unroll
            for (int nt = 0; nt < 2; ++nt)
#pragma unroll
                for (int tt = 0; tt < 4; ++tt) xq[nt][tt] = *(const u32x2*)(X2 + (size_t)(t0 + 16 * tt + fr) * D + 256 * g + 32 * w + 16 * nt + 4 * fq);
#pragma unroll
            for (int ks = 0; ks < 8; ++ks) {
                bf16x8 af[4];
#pragma unroll
                for (int tt = 0; tt < 4; ++tt) af[tt] = *(const LAS bf16x8*)(lds + (16 * tt + fr) * PG_STRIDE + (256 * g + 32 * ks + 8 * fq) * 2);
#pragma unroll
                for (int nt = 0; nt < 2; ++nt)
#pragma unroll
                    for (int tt = 0; tt < 4; ++tt) acc[nt][tt] = __builtin_amdgcn_mfma_f32_16x16x32_bf16(wf[nt][ks], af[tt], acc[nt][tt], 0, 0, 0);
            }
#pragma unroll
            for (int nt = 0; nt < 2; ++nt) {
                const int col = 256 * g + 32 * w + 16 * nt + 4 * fq;
                const f32x4 gmv = *(const f32x4*)(mod + 2 * D + col), bv = *(const f32x4*)(pb + col), sv = *(const f32x4*)(psc + col);
#pragma unroll
                for (int tt = 0; tt < 4; ++tt) {
                    const size_t idx = (size_t)(t0 + 16 * tt + fr) * D + col;
                    const f32x4 xv = {bflo(xq[nt][tt].x), bfhi(xq[nt][tt].x), bflo(xq[nt][tt].y), bfhi(xq[nt][tt].y)};
                    const f32x4 o = xv + gmv * ((acc[nt][tt] + bv) * sv);
                    *(u32x2*)(X1 + idx) = (u32x2){cvt_pk_bf16(o.x, o.y), cvt_pk_bf16(o.z, o.w)};
                }
            }
        }
        __syncthreads();
    }
}

constexpr int N_PHASES = 17;
__global__ void __launch_bounds__(NTH, 2) fwd_kernel(Args args) {
    extern __shared__ __attribute__((aligned(16))) unsigned char lds_raw[];
    Frame F;
    F.lds = (LAS unsigned char*)lds_raw;
    F.MISC = (volatile LAS unsigned*)(F.lds + MISC_OFF);
    F.tid = threadIdx.x; F.lane = F.tid & 63; F.wave = __builtin_amdgcn_readfirstlane(F.tid >> 6);
    F.G = gridDim.x; { const int bx = blockIdx.x; F.vcu = (F.G % 8 == 0) ? (bx % 8) * (F.G / 8) + bx / 8 : bx; }
    F.ws = args.ws; F.ctl = (unsigned*)(args.ws + WS_CTL); F.out = args.out;
    for (int u = F.tid; u < (LDS_BYTES - MISC_OFF) / 4; u += NTH) F.MISC[u] = 0u;
    __syncthreads();
#if N_LAUNCH_MODE == 1
    XcdBarrier bar = xcd_barrier_post(F.ctl + CW_BAR, F.MISC + 8);
#define GRID_BAR() xcd_barrier(bar)
#else
#define GRID_BAR() do { } while (0)
#endif
    const int lo = args.ph_lo, hi = args.ph_hi;
#define IN(k) (lo <= (k) && (k) < hi)
#define SEAM(k) do { if (IN(k) && IN((k) + 1)) GRID_BAR(); } while (0)
    GemmBase gb; gb.G = F.G; gb.vcu = F.vcu;
    bf16_t* X1 = WSP(F, WS_X1, bf16_t); bf16_t* X2 = WSP(F, WS_X2, bf16_t);
    const float* mod0 = WSP(F, WS_MOD, float); const float* mod1 = mod0 + 6 * D;

    if (IN(0)) { p0_prologue(F); } SEAM(0);
    if (IN(1)) { p1_norm_in(F); } SEAM(1);
    if (IN(2)) { PolWin P; (GemmBase&)P = gb; P.A = WIN_FP8 ? WSP(F, WS_HN8, bf16_t) : WSP(F, WS_HN, bf16_t); P.Bt = WSP(F, WS_WINT, bf16_t); P.qkvg = WSP(F, WS_QKVG, bf16_t); P.gbuf = WSP(F, WS_GBUF, _Float16);
        P.lb = WSP(F, WS_LB, float); P.rope = WSP(F, WS_ROPE, f32x2); run_gemm(F, P); } SEAM(2);
    if (IN(3)) { la_local_state(F); } SEAM(3);
    if (IN(4)) { la_scan(F); } SEAM(4);
    if (IN(5)) { la_output(F); } SEAM(5);
    if (IN(6)) { PolRes<false> P; (GemmBase&)P = gb; P.A = WSP(F, WS_CAT, bf16_t); P.Bt = WSP(F, WS_WOUTT, bf16_t); P.resid = inptr(0); P.resid16 = nullptr; P.outp = X1; P.gate = mod0 + 2 * D; P.bias = nullptr; P.scale = nullptr;
        P.K = D; P.lda = D; P.nN = 4; P.kcol = 0; run_gemm(F, P); } SEAM(6);
    if (IN(7)) { p_route(F, 0, X1, args.aux); } SEAM(7);
    if (IN(8)) { expert_tables(F, 0); PolMoE<((FP8_LAYERS >> 0) & 1) != 0> P; (GemmBase&)P = gb; P.MISC = F.MISC; P.upa = F.lds + UPA_OFF; P.hn = ((FP8_LAYERS >> 0) & 1) ? (const bf16_t*)WSP(F, WS_HN8, unsigned char) : WSP(F, WS_HN, bf16_t);
        P.wgut = WSP(F, WS_WGUT, bf16_t) + (size_t)0 * NE * 2048 * D; P.bgu = inptr(15) + (size_t)0 * NE * 2048; P.lslot = WSP(F, WS_LSLOT, int) + (size_t)0 * NE * LIST_CAP; P.lw = WSP(F, WS_LW, float) + (size_t)0 * NE * LIST_CAP;
        P.act = (bf16_t*)(F.ws + (0 ? WS_ACT2 : WS_ACT)); P.wdnt = WSP(F, WS_WDNT, bf16_t) + (size_t)0 * NE * D * D; P.bdn = inptr(17) + (size_t)0 * NE * D; P.yslot = WSP(F, WS_YSLOT, bf16_t);
        P.done = F.ctl + CW_DONE + 0 * DONE_LAYER; P.tmo = F.ctl + CW_TMO; P.act_rsrc = __builtin_amdgcn_make_buffer_rsrc((void*)P.act, (short)0, (int)((size_t)ACT_ROWS * D * 2), 0x00020000);
        P.fill(F.tid); __syncthreads(); run_gemm(F, P); } if (IN(8) && IN(10)) GRID_BAR();
    if (IN(10)) { p_combine<0>(F, 0, X1, X2); } SEAM(10);
    if (IN(11)) { p_pool_gemm(F, X2, X1); asm volatile("s_waitcnt vmcnt(0)" ::: "memory"); __syncthreads(); p_route(F, 1, X1, args.aux); } if (IN(11) && IN(14)) GRID_BAR();
    if (IN(14)) { expert_tables(F, 1); PolMoE<((FP8_LAYERS >> 1) & 1) != 0> P; (GemmBase&)P = gb; P.MISC = F.MISC; P.upa = F.lds + UPA_OFF; P.hn = ((FP8_LAYERS >> 1) & 1) ? (const bf16_t*)WSP(F, WS_HN8, unsigned char) : WSP(F, WS_HN, bf16_t);
        P.wgut = WSP(F, WS_WGUT, bf16_t) + (size_t)1 * NE * 2048 * D; P.bgu = inptr(15) + (size_t)1 * NE * 2048; P.lslot = WSP(F, WS_LSLOT, int) + (size_t)1 * NE * LIST_CAP; P.lw = WSP(F, WS_LW, float) + (size_t)1 * NE * LIST_CAP;
        P.act = (bf16_t*)(F.ws + (1 ? WS_ACT2 : WS_ACT)); P.wdnt = WSP(F, WS_WDNT, bf16_t) + (size_t)1 * NE * D * D; P.bdn = inptr(17) + (size_t)1 * NE * D; P.yslot = WSP(F, WS_YSLOT, bf16_t);
        P.done = F.ctl + CW_DONE + 1 * DONE_LAYER; P.tmo = F.ctl + CW_TMO; P.act_rsrc = __builtin_amdgcn_make_buffer_rsrc((void*)P.act, (short)0, (int)((size_t)ACT_ROWS * D * 2), 0x00020000);
        P.fill(F.tid); __syncthreads(); run_gemm(F, P); } if (IN(14) && IN(16)) GRID_BAR();
    if (IN(16)) { p_combine<1>(F, 1, X1, F.out); }
#undef IN
#undef SEAM
}

extern "C" void kernel_launch(void* const* d_in, const int* in_sizes, int n_in, void* d_out, int out_size, void* d_ws, size_t ws_size, hipStream_t stream) {
    static int grid = 0;
    if (grid == 0) {
        if (n_in != 19 || out_size != T * D || ws_size < WS_END) { fprintf(stderr, "kernel_launch: unexpected shapes (n_in %d, out %d, ws %zu)\n", n_in, out_size, ws_size); grid = -1; return; }
        int dev = 0, cus = 0, per_cu = 0;
        if (hipGetDevice(&dev) != hipSuccess || hipDeviceGetAttribute(&cus, hipDeviceAttributeMultiprocessorCount, dev) != hipSuccess) { grid = -1; return; }
        if (hipFuncSetAttribute((const void*)fwd_kernel, hipFuncAttributeMaxDynamicSharedMemorySize, LDS_BYTES) != hipSuccess) { fprintf(stderr, "kernel_launch: hipFuncSetAttribute failed\n"); grid = -1; return; }
        if (hipOccupancyMaxActiveBlocksPerMultiprocessor(&per_cu, (const void*)fwd_kernel, NTH, LDS_BYTES) != hipSuccess || per_cu < 1) { fprintf(stderr, "kernel_launch: occupancy query says %d\n", per_cu); }
        (void)hipGetLastError();
        grid = cus;
    }
    if (grid < 0) return;
    (void)hipMemsetAsync((char*)d_ws + WS_CTL, 0, CTL_BYTES, stream);
    Args a{};
    for (int i = 0; i < 19; ++i) a.in[i] = (const float*)d_in[i];
    a.out = (float*)d_out; a.ws = (unsigned char*)d_ws;
#if N_LAUNCH_MODE == 1
    a.ph_lo = 0; a.ph_hi = N_PHASES;
    void* kargs[] = {&a};
    hipError_t e = hipLaunchCooperativeKernel((const void*)fwd_kernel, dim3(grid), dim3(NTH), kargs, LDS_BYTES, stream);
    if (e != hipSuccess) fprintf(stderr, "cooperative launch failed: %s\n", hipGetErrorString(e));
#else
    for (int p = 0; p < N_PHASES; ++p) {
        a.ph_lo = p; a.ph_hi = p + 1;
        hipLaunchKernelGGL(fwd_kernel, dim3(grid), dim3(NTH), LDS_BYTES, stream, a);
        if (p == DUP_PHASE) { a.aux = 1; hipLaunchKernelGGL(fwd_kernel, dim3(grid), dim3(NTH), LDS_BYTES, stream, a); a.aux = 0; }
    }
#endif
}
```
